# Optimizing an MI355X kernel written in HIP

```python
import jax
import jax.numpy as jnp
from jax import lax
import numpy as np

D_MODEL = 1024
BATCH = 1
SEQ = 16384
DEPTH = 1

GRID_W = 64
CTX_LEN = 256
N_DIR = 2
N_MOD = 6
NORM_EPS = 1e-6

RWKV_HEAD = 64
RWKV_HEADS = 8
D_RWKV = RWKV_HEADS * RWKV_HEAD
LORA_W = 64
LORA_A = 64
LORA_G = 128
RWKV_COLS = 3 * D_RWKV + LORA_W + LORA_A + LORA_G
GN_EPS = 64e-5

MLSTM_HEADS = 4
MLSTM_DQK = 64
MLSTM_DV = 128
D_MLSTM_QK = MLSTM_HEADS * MLSTM_DQK
D_MLSTM = MLSTM_HEADS * MLSTM_DV
MLSTM_CHUNK = 64

IN_SIZES = (RWKV_COLS, 2 * D_MLSTM_QK, D_MLSTM, N_DIR * MLSTM_HEADS, N_DIR * MLSTM_HEADS, D_MLSTM, D_MODEL, D_MODEL)
IN_COLS = RWKV_COLS + 2 * D_MLSTM_QK + 2 * D_MLSTM + 2 * N_DIR * MLSTM_HEADS + 2 * D_MODEL

PEER_HEADS = 8
N_KEYS = 128
N_EXPERTS = N_KEYS * N_KEYS
PEER_TOPK = 16
PEER_QDIM = 256
KEY_DIM = PEER_QDIM // 2
PEER_BLOCK = 128

kernel_name = "hybrid_rwkv7_mlstm_peer_dit_layer"


def split_sizes(z, sizes):
    return jnp.split(z, np.cumsum(sizes)[:-1].tolist(), axis=-1)


def rmsnorm(z, g):
    zf = z.astype(jnp.float32)
    y = zf * lax.rsqrt(jnp.mean(zf * zf, axis=-1, keepdims=True) + NORM_EPS)
    return y.astype(z.dtype) * g


def modulate(h, shift, scale):
    return h * (1.0 + scale) + shift


def centred_conv3(z, w, axis):
    n = z.shape[axis]
    pad = [(0, 0)] * z.ndim
    pad[axis] = (1, 1)
    zp = jnp.pad(z, pad)
    prev = lax.slice_in_dim(zp, 0, n, axis=axis)
    nxt = lax.slice_in_dim(zp, 2, n + 2, axis=axis)
    return w[0] * prev + w[1] * z + w[2] * nxt


def both_dirs(z):
    return jnp.stack([z, jnp.flip(z, axis=1)], axis=2)


def orient(z):
    return jnp.stack([z[:, :, 0], jnp.flip(z[:, :, 1], axis=1)], axis=2)


def rwkv_branch(feats, S0, lp, need_out):
    B, T, _ = feats.shape
    r, k, v, wd, ad, gd = split_sizes(feats.astype(jnp.float32), (D_RWKV, D_RWKV, D_RWKV, LORA_W, LORA_A, LORA_G))
    w_log = -jax.nn.softplus(-(lp["rwkv_w0"] + jnp.einsum("btr,zrc->btzc", jnp.tanh(wd), lp["rwkv_w_up"]))) - 0.5
    decay = jnp.exp(-jnp.exp(w_log))
    a = jax.nn.sigmoid(lp["rwkv_a0"] + jnp.einsum("btr,zrc->btzc", ad, lp["rwkv_a_up"]))
    kk = (k * lp["rwkv_k_k"]).reshape(B, T, RWKV_HEADS, RWKV_HEAD)
    kk = (kk / jnp.maximum(jnp.linalg.norm(kk, axis=-1, keepdims=True), 1e-12)).reshape(B, T, D_RWKV)
    k_eff = k[:, :, None] * (1.0 + (a - 1.0) * lp["rwkv_k_a"])

    def heads(z):
        return jnp.moveaxis(z.reshape(B, T, N_DIR, RWKV_HEADS, RWKV_HEAD), 1, 0)

    xs = (heads(orient(k_eff)), heads(both_dirs(v)), heads(orient(decay)), heads(both_dirs(kk)), heads(orient(a)))
    if need_out:
        xs = xs + (heads(both_dirs(r)),)

    def step(S, inp):
        k_t, v_t, w_t, kk_t, a_t = inp[:5]
        s_kk = jnp.einsum("...vk,...k->...v", S, kk_t)
        S = S * w_t[..., None, :] - s_kk[..., :, None] * (kk_t * a_t)[..., None, :] + v_t[..., :, None] * k_t[..., None, :]
        if need_out:
            return S, jnp.einsum("...vk,...k->...v", S, inp[5])
        return S, None

    S, out = lax.scan(step, S0, xs)
    if not need_out:
        return None, S
    out = orient(jnp.moveaxis(out, 0, 1))
    mu = jnp.mean(out, axis=-1, keepdims=True)
    var = jnp.mean((out - mu) ** 2, axis=-1, keepdims=True)
    ln_w = lp["rwkv_ln_w"].reshape(RWKV_HEADS, RWKV_HEAD)
    ln_b = lp["rwkv_ln_b"].reshape(RWKV_HEADS, RWKV_HEAD)
    gn = (out - mu) * lax.rsqrt(var + GN_EPS) * ln_w + ln_b
    rh = r.reshape(B, T, 1, RWKV_HEADS, RWKV_HEAD)
    kh = k_eff.reshape(B, T, N_DIR, RWKV_HEADS, RWKV_HEAD)
    vh = v.reshape(B, T, 1, RWKV_HEADS, RWKV_HEAD)
    bonus = jnp.sum(rh * kh * lp["rwkv_r_k"].reshape(RWKV_HEADS, RWKV_HEAD), axis=-1, keepdims=True) * vh
    y = jnp.sum(gn + bonus, axis=2).reshape(B, T, D_RWKV)
    g = jax.nn.sigmoid(gd) @ lp["rwkv_g_up"]
    return (y * g).astype(feats.dtype), S


def mlstm_branch(qk, v, i_pre, f_pre, o_pre, state0, lp, need_out):
    B, T, _ = v.shape
    H = MLSTM_HEADS
    nc = T // MLSTM_CHUNK
    q, k = jnp.split(jax.nn.silu(qk.astype(jnp.float32)), 2, axis=-1)
    q = both_dirs(q.reshape(B, T, H, MLSTM_DQK))
    k = both_dirs(k.reshape(B, T, H, MLSTM_DQK) * MLSTM_DQK ** -0.5)
    vv = both_dirs(v.astype(jnp.float32).reshape(B, T, H, MLSTM_DV))
    ig = orient(i_pre.astype(jnp.float32).reshape(B, T, N_DIR, H) + lp["mlstm_i_b"])
    lf = orient(jax.nn.log_sigmoid(f_pre.astype(jnp.float32).reshape(B, T, N_DIR, H) + lp["mlstm_f_b"]))

    def chunks(z):
        z = z.reshape((B, nc, MLSTM_CHUNK) + z.shape[2:])
        return jnp.moveaxis(jnp.moveaxis(z, 1, 0), 2, 4)

    causal = jnp.tril(jnp.ones((MLSTM_CHUNK, MLSTM_CHUNK), dtype=bool))

    def step(carry, inp):
        C, n, m = carry
        kc, vc, ic, fc = inp[:4]
        b = jnp.cumsum(fc, axis=-1)
        b_end = b[..., -1]
        g_end = b_end[..., None] - b + ic
        m_new = jnp.maximum(b_end + m, jnp.max(g_end, axis=-1))
        w_end = jnp.exp(g_end - m_new[..., None])
        keep = jnp.exp(b_end + m - m_new)
        C_new = keep[..., None, None] * C + jnp.einsum("...sv,...sd->...vd", vc * w_end[..., None], kc)
        n_new = keep[..., None] * n + jnp.einsum("...s,...sd->...d", w_end, kc)
        if not need_out:
            return (C_new, n_new, m_new), None
        qc = inp[4]
        log_d = jnp.where(causal, b[..., :, None] - b[..., None, :] + ic[..., None, :], -jnp.inf)
        inter = b + m[..., None]
        m_row = jnp.maximum(inter, jnp.max(log_d, axis=-1))
        s = jnp.einsum("...jd,...sd->...js", qc, kc) * jnp.exp(log_d - m_row[..., None])
        a_inter = jnp.exp(inter - m_row)
        num = jnp.einsum("...js,...sv->...jv", s, vc) + a_inter[..., None] * jnp.einsum("...vd,...jd->...jv", C, qc)
        den = jnp.sum(s, axis=-1) + a_inter * jnp.einsum("...d,...jd->...j", n, qc)
        h = num / jnp.maximum(jnp.abs(den), jnp.exp(-m_row))[..., None]
        return (C_new, n_new, m_new), h

    xs = (chunks(k), chunks(vv), chunks(ig), chunks(lf))
    if need_out:
        xs = xs + (chunks(q),)
    state, h = lax.scan(step, state0, xs)
    if not need_out:
        return None, state
    h = jnp.moveaxis(jnp.moveaxis(h, 4, 2), 0, 1).reshape(B, T, N_DIR, H, MLSTM_DV)
    h = orient(h)
    h = h * lax.rsqrt(jnp.mean(h * h, axis=-1, keepdims=True) + NORM_EPS) * lp["mlstm_norm_g"].reshape(H, MLSTM_DV)
    y = jnp.sum(h, axis=2).reshape(B, T, D_MLSTM) * jax.nn.sigmoid(o_pre.astype(jnp.float32))
    return y.astype(v.dtype), state


def token_mixer(P, rwkv_s0, mlstm_s0, lp, on_grid, need_out):
    B, T, _ = P.shape
    rw, qk, mv, ml_i, ml_f, ml_o, gate_a, gate_b = split_sizes(P, IN_SIZES)
    if on_grid:
        rows = T // GRID_W
        rw = centred_conv3(rw.reshape(B, rows, GRID_W, -1), lp["rwkv_conv"], 2).reshape(B, T, -1)

        def to_col(z):
            return z.reshape(B, rows, GRID_W, -1).transpose(0, 2, 1, 3)

        qk = centred_conv3(to_col(qk), lp["mlstm_conv"], 2).reshape(B, T, -1)
        mv, ml_i, ml_f, ml_o = [to_col(z).reshape(B, T, -1) for z in (mv, ml_i, ml_f, ml_o)]
    else:
        rw = centred_conv3(rw, lp["rwkv_conv"], 1)
        qk = centred_conv3(qk, lp["mlstm_conv"], 1)
    y_a, rwkv_s = rwkv_branch(rw, rwkv_s0, lp, need_out)
    y_b, mlstm_s = mlstm_branch(qk, mv, ml_i, ml_f, ml_o, mlstm_s0, lp, need_out)
    if not need_out:
        return None, rwkv_s, mlstm_s
    if on_grid:
        y_b = y_b.reshape(B, GRID_W, rows, -1).transpose(0, 2, 1, 3).reshape(B, T, -1)
    merged = jax.nn.sigmoid(gate_a) * (y_a @ lp["w_branch_a"]) + jax.nn.sigmoid(gate_b) * (y_b @ lp["w_branch_b"])
    return merged @ lp["w_out"], rwkv_s, mlstm_s


def peer_ffn(h, wq, keys, u, v):
    B, T, D = h.shape
    nb = (B * T) // PEER_BLOCK

    def block(hb):
        q = (hb @ wq).reshape(PEER_BLOCK, PEER_HEADS, 2, KEY_DIM)
        s = jnp.einsum("mhpd,hpkd->mhpk", q, keys).astype(jnp.float32)
        s1, i1 = lax.top_k(s[:, :, 0], PEER_TOPK)
        s2, i2 = lax.top_k(s[:, :, 1], PEER_TOPK)
        cand = (s1[..., :, None] + s2[..., None, :]).reshape(PEER_BLOCK, PEER_HEADS, PEER_TOPK * PEER_TOPK)
        sc, ci = lax.top_k(cand, PEER_TOPK)
        idx = (jnp.take_along_axis(i1, ci // PEER_TOPK, axis=-1) * N_KEYS
               + jnp.take_along_axis(i2, ci % PEER_TOPK, axis=-1)).reshape(PEER_BLOCK, -1)
        g = jax.nn.softmax(sc, axis=-1).reshape(PEER_BLOCK, -1)
        act = jax.nn.gelu(jnp.einsum("med,md->me", u[idx], hb), approximate=False)
        return jnp.einsum("me,med->md", (g * act).astype(hb.dtype), v[idx])

    return lax.map(block, h.reshape(nb, PEER_BLOCK, D)).reshape(B, T, D)


def setup_inputs(seed: int = 0) -> dict:
    key = jax.random.key(seed)
    ks = jax.random.split(key, 32)
    L = DEPTH

    def nrm(k, shape, s):
        return jax.random.normal(k, shape, jnp.float32) * s

    shift_init = jnp.array([0.25, 0.5, 0.25], jnp.float32)[None, :, None]
    return {
        "x": nrm(ks[0], (BATCH, SEQ, D_MODEL), 1.0),
        "c": nrm(ks[1], (BATCH, D_MODEL), 1.0),
        "ctx": nrm(ks[2], (BATCH, CTX_LEN, D_MODEL), 1.0),
        "c_ctx": nrm(ks[3], (D_MODEL,), 1.0),
        "ada_w": nrm(ks[4], (L, D_MODEL, N_MOD * D_MODEL), 0.3 * D_MODEL ** -0.5),
        "ada_b": nrm(ks[5], (L, N_MOD * D_MODEL), 0.02),
        "norm1_g": 1.0 + nrm(ks[6], (L, D_MODEL), 0.1),
        "w_in": nrm(ks[7], (L, D_MODEL, IN_COLS), D_MODEL ** -0.5),
        "rwkv_conv": shift_init + nrm(ks[8], (L, 3, RWKV_COLS), 0.05),
        "rwkv_w0": jax.random.uniform(ks[9], (L, N_DIR, D_RWKV), jnp.float32, minval=-6.0, maxval=1.0),
        "rwkv_w_up": nrm(ks[10], (L, N_DIR, LORA_W, D_RWKV), 0.5 * LORA_W ** -0.5),
        "rwkv_a0": nrm(ks[11], (L, N_DIR, D_RWKV), 0.5),
        "rwkv_a_up": nrm(ks[12], (L, N_DIR, LORA_A, D_RWKV), 0.5 * LORA_A ** -0.5),
        "rwkv_g_up": nrm(ks[13], (L, LORA_G, D_RWKV), LORA_G ** -0.5),
        "rwkv_k_k": 0.85 + nrm(ks[14], (L, D_RWKV), 0.05),
        "rwkv_k_a": 1.0 + nrm(ks[15], (L, D_RWKV), 0.05),
        "rwkv_r_k": nrm(ks[16], (L, D_RWKV), 0.1),
        "rwkv_ln_w": 1.0 + nrm(ks[17], (L, D_RWKV), 0.1),
        "rwkv_ln_b": nrm(ks[18], (L, D_RWKV), 0.01),
        "mlstm_conv": shift_init + nrm(ks[19], (L, 3, 2 * D_MLSTM_QK), 0.05),
        "mlstm_i_b": nrm(ks[20], (L, N_DIR, MLSTM_HEADS), 0.5),
        "mlstm_f_b": 3.0 + nrm(ks[21], (L, N_DIR, MLSTM_HEADS), 0.5),
        "mlstm_norm_g": 1.0 + nrm(ks[22], (L, D_MLSTM), 0.1),
        "w_branch_a": nrm(ks[23], (L, D_RWKV, D_MODEL), D_RWKV ** -0.5),
        "w_branch_b": nrm(ks[24], (L, D_MLSTM, D_MODEL), D_MLSTM ** -0.5),
        "w_out": nrm(ks[25], (L, D_MODEL, D_MODEL), D_MODEL ** -0.5),
        "norm2_g": 1.0 + nrm(ks[26], (L, D_MODEL), 0.1),
        "peer_wq": nrm(ks[27], (L, D_MODEL, PEER_HEADS * PEER_QDIM), D_MODEL ** -0.5),
        "peer_keys": nrm(ks[28], (L, PEER_HEADS, 2, N_KEYS, KEY_DIM), KEY_DIM ** -0.5),
        "peer_u": nrm(ks[29], (L, N_EXPERTS, D_MODEL), D_MODEL ** -0.5),
        "peer_v": nrm(ks[30], (L, N_EXPERTS, D_MODEL), PEER_HEADS ** -0.5),
        "final_g": 1.0 + nrm(ks[31], (D_MODEL,), 0.1),
    }


def reference(x, c, ctx, c_ctx, ada_w, ada_b, norm1_g, w_in, rwkv_conv, rwkv_w0, rwkv_w_up, rwkv_a0,
              rwkv_a_up, rwkv_g_up, rwkv_k_k, rwkv_k_a, rwkv_r_k, rwkv_ln_w, rwkv_ln_b, mlstm_conv,
              mlstm_i_b, mlstm_f_b, mlstm_norm_g, w_branch_a, w_branch_b, w_out, norm2_g, peer_wq,
              peer_keys, peer_u, peer_v, final_g):
    B = x.shape[0]
    silu_c = jax.nn.silu(c)
    silu_cc = jax.nn.silu(c_ctx)
    for i in range(DEPTH):
        last = i == DEPTH - 1
        lp = {
            "rwkv_conv": rwkv_conv[i], "rwkv_w0": rwkv_w0[i], "rwkv_w_up": rwkv_w_up[i],
            "rwkv_a0": rwkv_a0[i], "rwkv_a_up": rwkv_a_up[i], "rwkv_g_up": rwkv_g_up[i],
            "rwkv_k_k": rwkv_k_k[i], "rwkv_k_a": rwkv_k_a[i], "rwkv_r_k": rwkv_r_k[i],
            "rwkv_ln_w": rwkv_ln_w[i], "rwkv_ln_b": rwkv_ln_b[i], "mlstm_conv": mlstm_conv[i],
            "mlstm_i_b": mlstm_i_b[i], "mlstm_f_b": mlstm_f_b[i], "mlstm_norm_g": mlstm_norm_g[i],
            "w_branch_a": w_branch_a[i], "w_branch_b": w_branch_b[i], "w_out": w_out[i],
        }
        sh1, sc1, gt1, sh2, sc2, gt2 = [z[:, None] for z in jnp.split(silu_c @ ada_w[i] + ada_b[i], N_MOD, axis=-1)]
        csh1, csc1, cgt1, csh2, csc2, cgt2 = jnp.split(silu_cc @ ada_w[i] + ada_b[i], N_MOD, axis=-1)

        rwkv0 = jnp.zeros((B, N_DIR, RWKV_HEADS, RWKV_HEAD, RWKV_HEAD), jnp.float32)
        mlstm0 = (jnp.zeros((B, N_DIR, MLSTM_HEADS, MLSTM_DV, MLSTM_DQK), jnp.float32),
                  jnp.zeros((B, N_DIR, MLSTM_HEADS, MLSTM_DQK), jnp.float32),
                  jnp.zeros((B, N_DIR, MLSTM_HEADS), jnp.float32))
        hc = modulate(rmsnorm(ctx, norm1_g[i]), csh1, csc1)
        out_c, rwkv_s, mlstm_s = token_mixer(hc @ w_in[i], rwkv0, mlstm0, lp, False, not last)

        hx = modulate(rmsnorm(x, norm1_g[i]), sh1, sc1)
        out_x, _, _ = token_mixer(hx @ w_in[i], rwkv_s, mlstm_s, lp, True, True)
        x = x + gt1 * out_x
        x = x + gt2 * peer_ffn(modulate(rmsnorm(x, norm2_g[i]), sh2, sc2), peer_wq[i], peer_keys[i], peer_u[i], peer_v[i])

        if not last:
            ctx = ctx + cgt1 * out_c
            ctx = ctx + cgt2 * peer_ffn(modulate(rmsnorm(ctx, norm2_g[i]), csh2, csc2), peer_wq[i], peer_keys[i], peer_u[i], peer_v[i])
    return rmsnorm(x, final_g)
```

```cpp
#include <hip/hip_runtime.h>
#include <hip/hip_cooperative_groups.h>
#include <cstdio>
#include <cstdint>
namespace cg = cooperative_groups;

#ifndef MEGA
#define MEGA 1
#endif
#ifndef ONLY
#define ONLY -1
#endif

typedef unsigned short bf16_t;
using bf16x8 = __attribute__((ext_vector_type(8))) short;
using f32x4 = __attribute__((ext_vector_type(4))) float;
using u32x4 = __attribute__((ext_vector_type(4))) unsigned;
#define DEVI __device__ __forceinline__

constexpr int T_CTX = 256, T_LAT = 16384, T_ALL = 16640;
constexpr int NIN = 5392, NP = 5376;
constexpr int NCH = 128, LCH = 130;
constexpr int SVH = 576;
constexpr int SMEM_BYTES = 71680;

enum { I_X = 0, I_C, I_CTX, I_CCTX, I_ADAW, I_ADAB, I_N1G, I_WIN, I_RCONV, I_RW0, I_RWUP, I_RA0, I_RAUP, I_RGUP,
       I_RKK, I_RKA, I_RRK, I_RLNW, I_RLNB, I_MCONV, I_MIB, I_MFB, I_MNG, I_WBA, I_WBB, I_WOUT, I_N2G, I_WQ,
       I_KEYS, I_PU, I_PV, I_FG };

struct Params { const float* in[32]; float* out; unsigned char* ws; };

constexpr size_t A256(size_t x) { return (x + 255) & ~(size_t)255; }
constexpr size_t O_MODP = 0;
constexpr size_t O_WBA = A256(O_MODP + (size_t)16 * 2 * 6144 * 4);
constexpr size_t O_WBB = A256(O_WBA + (size_t)1024 * 512 * 2);
constexpr size_t O_WOUT = A256(O_WBB + (size_t)1024 * 512 * 2);
constexpr size_t O_WQ = A256(O_WOUT + (size_t)1024 * 1024 * 2);
constexpr size_t O_KEYS = A256(O_WQ + (size_t)2048 * 1024 * 2);
constexpr size_t O_WUP = A256(O_KEYS + (size_t)16 * 128 * 128 * 2);
constexpr size_t O_AUP = A256(O_WUP + (size_t)1024 * 64 * 2);
constexpr size_t O_GUP = A256(O_AUP + (size_t)1024 * 64 * 2);
constexpr size_t O_BEND = A256(O_GUP + (size_t)512 * 128 * 2);
constexpr size_t O_MLOC = A256(O_BEND + (size_t)260 * 8 * 4);
constexpr size_t O_MST = A256(O_MLOC + (size_t)260 * 8 * 4);
constexpr size_t O_NT = A256(O_MST + (size_t)260 * 8 * 4);
constexpr size_t O_BONUS = A256(O_NT + (size_t)260 * 8 * 64 * 4);
constexpr size_t O_PG = A256(O_BONUS + (size_t)T_ALL * 16 * 4);
constexpr size_t O_PO = A256(O_PG + (size_t)T_LAT * 2048 * 2);
constexpr size_t O_R = A256(O_PO + (size_t)T_LAT * 512 * 2);
constexpr size_t R_HX = O_R;
constexpr size_t R_WIN = A256(R_HX + (size_t)T_ALL * 1024 * 2);
constexpr size_t R_PQK = A256(R_WIN + (size_t)NP * 1024 * 2);
constexpr size_t R_PV = A256(R_PQK + (size_t)T_ALL * 512 * 2);
constexpr size_t R_GIF = A256(R_PV + (size_t)T_ALL * 512 * 2);
constexpr size_t R_U = A256(R_GIF + (size_t)T_ALL * 16 * 4);
constexpr size_t R_END1 = A256(R_U + (size_t)260 * 8 * 8192 * 4);
constexpr size_t R_SV = O_R;
constexpr size_t R_YA = A256(R_SV + (size_t)T_ALL * 8 * SVH * 2);
constexpr size_t R_END2 = A256(R_YA + (size_t)T_LAT * 512 * 2);
constexpr size_t R_MERGED = O_R;
constexpr size_t R_H2 = A256(R_MERGED + (size_t)T_LAT * 1024 * 2);
constexpr size_t R_TOPS = A256(R_H2 + (size_t)T_LAT * 1024 * 2);
constexpr size_t R_TOPI = A256(R_TOPS + (size_t)T_LAT * 256 * 4);
constexpr size_t R_END3 = A256(R_TOPI + (size_t)T_LAT * 256 * 4);
constexpr size_t WS_NEED = (R_END1 > R_END2 ? (R_END1 > R_END3 ? R_END1 : R_END3) : (R_END2 > R_END3 ? R_END2 : R_END3));
constexpr size_t OUT_BC = (size_t)NCH * 16 * 4096 * 4;

DEVI bf16_t f2bf(float f) { unsigned u = __float_as_uint(f); u += 0x7fffu + ((u >> 16) & 1u); return (bf16_t)(u >> 16); }
DEVI float bf2f(bf16_t h) { return __uint_as_float(((unsigned)h) << 16); }
DEVI float bflo(unsigned u) { return __uint_as_float(u << 16); }
DEVI float bfhi(unsigned u) { return __uint_as_float(u & 0xffff0000u); }
DEVI unsigned pack2(float a, float b) { return (unsigned)f2bf(a) | ((unsigned)f2bf(b) << 16); }
DEVI void unpack8(const uint4& u, float* f) {
  f[0] = bflo(u.x); f[1] = bfhi(u.x); f[2] = bflo(u.y); f[3] = bfhi(u.y);
  f[4] = bflo(u.z); f[5] = bfhi(u.z); f[6] = bflo(u.w); f[7] = bfhi(u.w);
}
DEVI uint4 pack8(const float* f) { return make_uint4(pack2(f[0], f[1]), pack2(f[2], f[3]), pack2(f[4], f[5]), pack2(f[6], f[7])); }
DEVI float wave_sum(float v) {
#pragma unroll
  for (int o = 32; o; o >>= 1) v += __shfl_xor(v, o);
  return v;
}
DEVI float wave_max(float v) {
#pragma unroll
  for (int o = 32; o; o >>= 1) v = fmaxf(v, __shfl_xor(v, o));
  return v;
}
DEVI float sigm(float x) { return 1.f / (1.f + __expf(-x)); }
DEVI float siluf(float x) { return x / (1.f + __expf(-x)); }
DEVI float logsig(float x) { return fminf(x, 0.f) - log1pf(expf(-fabsf(x))); }
DEVI float allred8(float v) { v += __shfl_xor(v, 1); v += __shfl_xor(v, 2); v += __shfl_xor(v, 4); return v; }

DEVI int ml_row(int c, int j) {
  if (c < 4) return c * 64 + j;
  int cc = c - 4; int col = cc >> 2; int gr = (cc & 3) * 64 + j;
  return T_CTX + gr * 64 + col;
}
DEVI int ml_sc(int c, int dir) { return dir == 0 ? c : (c < 4 ? 3 - c : 263 - c); }
DEVI int rw_row(int p, int dir) { return dir == 0 ? p : (p < T_CTX ? (T_CTX - 1 - p) : (T_ALL + T_CTX - 1 - p)); }

DEVI float mod_val(const Params& p, int which, int col) {
  const float* modp = (const float*)(p.ws + O_MODP);
  float s = p.in[I_ADAB][col];
#pragma unroll
  for (int rs = 0; rs < 16; ++rs) s += modp[(rs * 2 + which) * 6144 + col];
  return s;
}

DEVI void gemm_core(const bf16_t* __restrict__ A, int lda, const bf16_t* __restrict__ Bt, int ldb, int K,
                    f32x4 (&acc)[4][4], unsigned char* smem) {
  bf16_t(*sa)[72] = (bf16_t(*)[72])smem;
  bf16_t(*sb)[72] = (bf16_t(*)[72])(smem + 128 * 72 * 2);
  const int tid = threadIdx.x, lane = tid & 63, warp = tid >> 6, wm = warp >> 1, wn = warp & 1;
  u32x4 ra[4], rb[4];
#pragma unroll
  for (int i = 0; i < 4; ++i) {
    int pc = tid + 256 * i; int r = pc >> 3, kc = (pc & 7) * 8;
    ra[i] = *(const u32x4*)(A + (size_t)r * lda + kc);
    rb[i] = *(const u32x4*)(Bt + (size_t)r * ldb + kc);
  }
  for (int k0 = 0; k0 < K; k0 += 64) {
    __syncthreads();
#pragma unroll
    for (int i = 0; i < 4; ++i) {
      int pc = tid + 256 * i; int r = pc >> 3, kc = (pc & 7) * 8;
      *(u32x4*)&sa[r][kc] = ra[i];
      *(u32x4*)&sb[r][kc] = rb[i];
    }
    __syncthreads();
    if (k0 + 64 < K) {
#pragma unroll
      for (int i = 0; i < 4; ++i) {
        int pc = tid + 256 * i; int r = pc >> 3, kc = (pc & 7) * 8;
        ra[i] = *(const u32x4*)(A + (size_t)r * lda + k0 + 64 + kc);
        rb[i] = *(const u32x4*)(Bt + (size_t)r * ldb + k0 + 64 + kc);
      }
    }
#pragma unroll
    for (int ks = 0; ks < 2; ++ks) {
      bf16x8 af[4], bq[4];
#pragma unroll
      for (int i = 0; i < 4; ++i) af[i] = *(const bf16x8*)&sa[wm * 64 + i * 16 + (lane & 15)][ks * 32 + (lane >> 4) * 8];
#pragma unroll
      for (int j = 0; j < 4; ++j) bq[j] = *(const bf16x8*)&sb[wn * 64 + j * 16 + (lane & 15)][ks * 32 + (lane >> 4) * 8];
#pragma unroll
      for (int i = 0; i < 4; ++i)
#pragma unroll
        for (int j = 0; j < 4; ++j) acc[i][j] = __builtin_amdgcn_mfma_f32_16x16x32_bf16(bq[j], af[i], acc[i][j], 0, 0, 0);
    }
  }
  __syncthreads();
}
DEVI void zero_acc(f32x4 (&acc)[4][4]) {
#pragma unroll
  for (int i = 0; i < 4; ++i)
#pragma unroll
    for (int j = 0; j < 4; ++j) acc[i][j] = f32x4{0.f, 0.f, 0.f, 0.f};
}

DEVI void tr_tile(const float* __restrict__ src, int lds, int k0, int n0src, bf16_t* __restrict__ dst, int ldd, int n0dst,
                  unsigned char* smem) {
  float(*tile)[65] = (float(*)[65])smem;
  const int tid = threadIdx.x, j = tid & 63, i0 = tid >> 6;
#pragma unroll 4
  for (int ii = 0; ii < 16; ++ii) { int i = i0 + 4 * ii; tile[i][j] = src[(size_t)(k0 + i) * lds + n0src + j]; }
  __syncthreads();
#pragma unroll 4
  for (int jj = 0; jj < 16; ++jj) { int jn = i0 + 4 * jj; dst[(size_t)(n0dst + jn) * ldd + k0 + j] = f2bf(tile[j][jn]); }
  __syncthreads();
}

DEVI void phase0(const Params& p, unsigned char* smem) {
  const int tid = threadIdx.x;
  constexpr int N_MOD = 384, N_WIN = 16 * 84, N_WB = 128, N_WOUT = 256, N_WQ = 512, N_LORA = 16, N_GUP = 16, N_KEYS = 128;
  constexpr int E0 = N_MOD, E1 = E0 + N_WIN, E2 = E1 + N_WB, E3 = E2 + N_WB, E4 = E3 + N_WOUT, E5 = E4 + N_WQ,
                E6 = E5 + N_LORA, E7 = E6 + N_LORA, E8 = E7 + N_GUP, E9 = E8 + N_KEYS;
  for (int it = blockIdx.x; it < E9; it += gridDim.x) {
    if (it < E0) {
      int cb = it % 24, rs = it / 24; int col = cb * 256 + tid;
      const float* aw = p.in[I_ADAW];
      float ax = 0.f, ac = 0.f;
#pragma unroll 8
      for (int r = rs * 64; r < rs * 64 + 64; ++r) {
        float w = aw[(size_t)r * 6144 + col];
        ax += siluf(p.in[I_C][r]) * w;
        ac += siluf(p.in[I_CCTX][r]) * w;
      }
      float* modp = (float*)(p.ws + O_MODP);
      modp[(rs * 2 + 0) * 6144 + col] = ax;
      modp[(rs * 2 + 1) * 6144 + col] = ac;
    } else if (it < E1) {
      int t = it - E0; int kt = t / 84, nt = t % 84; int n0 = nt * 64;
      tr_tile(p.in[I_WIN], NIN, kt * 64, n0 < 2816 ? n0 : n0 + 16, (bf16_t*)(p.ws + R_WIN), 1024, n0, smem);
    } else if (it < E2) {
      int t = it - E1; tr_tile(p.in[I_WBA], 1024, (t / 16) * 64, (t % 16) * 64, (bf16_t*)(p.ws + O_WBA), 512, (t % 16) * 64, smem);
    } else if (it < E3) {
      int t = it - E2; tr_tile(p.in[I_WBB], 1024, (t / 16) * 64, (t % 16) * 64, (bf16_t*)(p.ws + O_WBB), 512, (t % 16) * 64, smem);
    } else if (it < E4) {
      int t = it - E3; tr_tile(p.in[I_WOUT], 1024, (t / 16) * 64, (t % 16) * 64, (bf16_t*)(p.ws + O_WOUT), 1024, (t % 16) * 64, smem);
    } else if (it < E5) {
      int t = it - E4; tr_tile(p.in[I_WQ], 2048, (t / 32) * 64, (t % 32) * 64, (bf16_t*)(p.ws + O_WQ), 1024, (t % 32) * 64, smem);
    } else if (it < E6) {
      int t = it - E5; int dir = t / 8, nt = t % 8;
      tr_tile(p.in[I_RWUP] + (size_t)dir * 64 * 512, 512, 0, nt * 64, (bf16_t*)(p.ws + O_WUP) + (size_t)dir * 512 * 64, 64, nt * 64, smem);
    } else if (it < E7) {
      int t = it - E6; int dir = t / 8, nt = t % 8;
      tr_tile(p.in[I_RAUP] + (size_t)dir * 64 * 512, 512, 0, nt * 64, (bf16_t*)(p.ws + O_AUP) + (size_t)dir * 512 * 64, 64, nt * 64, smem);
    } else if (it < E8) {
      int t = it - E7; tr_tile(p.in[I_RGUP], 512, (t / 8) * 64, (t % 8) * 64, (bf16_t*)(p.ws + O_GUP), 128, (t % 8) * 64, smem);
    } else {
      int t = it - E8; size_t base = (size_t)t * 2048 + tid * 8;
      const float* s = p.in[I_KEYS] + base;
      float f[8];
      float4 a = *(const float4*)s, b = *(const float4*)(s + 4);
      f[0] = a.x; f[1] = a.y; f[2] = a.z; f[3] = a.w; f[4] = b.x; f[5] = b.y; f[6] = b.z; f[7] = b.w;
      *(uint4*)((bf16_t*)(p.ws + O_KEYS) + base) = pack8(f);
    }
  }
}

DEVI void phase1(const Params& p, unsigned char* smem) {
  float* smod = (float*)smem;
  const int tid = threadIdx.x, lane = tid & 63, warp = tid >> 6;
  for (int i = tid; i < 4096; i += 256) { int which = i >> 10; smod[i] = mod_val(p, which >> 1, (which & 1) * 1024 + (i & 1023)); }
  __syncthreads();
  bf16_t* hx = (bf16_t*)(p.ws + R_HX);
  float* gif = (float*)(p.ws + R_GIF);
  const float* win = p.in[I_WIN];
  for (int row = blockIdx.x * 4 + warp; row < T_ALL; row += gridDim.x * 4) {
    const float* src = row < T_CTX ? p.in[I_CTX] + (size_t)row * 1024 : p.in[I_X] + (size_t)(row - T_CTX) * 1024;
    const float* sh = smod + (row < T_CTX ? 2048 : 0);
    const float* sc = sh + 1024;
    float h[16]; float ss = 0.f;
#pragma unroll
    for (int i = 0; i < 4; ++i) {
      float4 v = *(const float4*)(src + i * 256 + lane * 4);
      h[4 * i] = v.x; h[4 * i + 1] = v.y; h[4 * i + 2] = v.z; h[4 * i + 3] = v.w;
      ss += v.x * v.x + v.y * v.y + v.z * v.z + v.w * v.w;
    }
    ss = wave_sum(ss);
    float rstd = rsqrtf(ss * (1.f / 1024.f) + 1e-6f);
    float g[16];
#pragma unroll
    for (int j = 0; j < 16; ++j) g[j] = 0.f;
#pragma unroll
    for (int i = 0; i < 4; ++i) {
#pragma unroll
      for (int e = 0; e < 4; ++e) {
        int k = i * 256 + lane * 4 + e;
        float y = h[4 * i + e] * rstd * p.in[I_N1G][k];
        y = y * (1.f + sc[k]) + sh[k];
        h[4 * i + e] = y;
        const float* wr = win + (size_t)k * NIN + 2816;
#pragma unroll
        for (int q = 0; q < 4; ++q) {
          float4 w = *(const float4*)(wr + 4 * q);
          g[4 * q] += y * w.x; g[4 * q + 1] += y * w.y; g[4 * q + 2] += y * w.z; g[4 * q + 3] += y * w.w;
        }
      }
      *(uint2*)(hx + (size_t)row * 1024 + i * 256 + lane * 4) = make_uint2(pack2(h[4 * i], h[4 * i + 1]), pack2(h[4 * i + 2], h[4 * i + 3]));
    }
    float mine = 0.f;
#pragma unroll
    for (int j = 0; j < 16; ++j) { float s = wave_sum(g[j]); if (lane == j) mine = s; }
    if (lane < 16) gif[(size_t)row * 16 + lane] = mine;
  }
}

DEVI void phase2(const Params& p, unsigned char* smem) {
  const int lane = threadIdx.x & 63, warp = threadIdx.x >> 6, wm = warp >> 1, wn = warp & 1;
  const bf16_t* hx = (const bf16_t*)(p.ws + R_HX);
  const bf16_t* wt = (const bf16_t*)(p.ws + R_WIN);
  bf16_t* prw = (bf16_t*)p.out;
  bf16_t* pqk = (bf16_t*)(p.ws + R_PQK);
  bf16_t* pv = (bf16_t*)(p.ws + R_PV);
  bf16_t* po = (bf16_t*)(p.ws + O_PO);
  bf16_t* pg = (bf16_t*)(p.ws + O_PG);
  for (int t = blockIdx.x; t < 130 * 42; t += gridDim.x) {
    int mt = t / 42, nt = t % 42;
    if (mt < 2 && nt >= 22) continue;
    f32x4 acc[4][4];
    zero_acc(acc);
    gemm_core(hx + (size_t)mt * 128 * 1024, 1024, wt + (size_t)nt * 128 * 1024, 1024, 1024, acc, smem);
    bf16_t* dst; int ld, nb; int rofs = 0; bool sg = false;
    if (nt < 14) { dst = prw; ld = 1792; nb = nt * 128; }
    else if (nt < 18) { dst = pqk; ld = 512; nb = (nt - 14) * 128; }
    else if (nt < 22) { dst = pv; ld = 512; nb = (nt - 18) * 128; }
    else if (nt < 26) { dst = po; ld = 512; nb = (nt - 22) * 128; rofs = T_CTX; }
    else { dst = pg; ld = 2048; nb = (nt - 26) * 128; rofs = T_CTX; sg = true; }
#pragma unroll
    for (int i = 0; i < 4; ++i) {
      int row = mt * 128 + wm * 64 + i * 16 + (lane & 15) - rofs;
#pragma unroll
      for (int j = 0; j < 4; ++j) {
        int n = nb + wn * 64 + j * 16 + (lane >> 4) * 4;
        f32x4 v = acc[i][j];
        if (sg) { v[0] = sigm(v[0]); v[1] = sigm(v[1]); v[2] = sigm(v[2]); v[3] = sigm(v[3]); }
        *(uint2*)(dst + (size_t)row * ld + n) = make_uint2(pack2(v[0], v[1]), pack2(v[2], v[3]));
      }
    }
  }
}

DEVI void ml_qk8(const Params& p, int c, int j, int chan, float* o) {
  const bf16_t* pqk = (const bf16_t*)(p.ws + R_PQK);
  int row = ml_row(c, j);
  bool hp, hn; int rp, rn;
  if (c < 4) { hp = row > 0; hn = row < T_CTX - 1; rp = row - 1; rn = row + 1; }
  else { int gr = ((c - 4) & 3) * 64 + j; hp = gr > 0; hn = gr < 255; rp = row - 64; rn = row + 64; }
  const float* cw = p.in[I_MCONV];
  float cur[8], pr[8], nx[8];
  unpack8(*(const uint4*)(pqk + (size_t)row * 512 + chan), cur);
  if (hp) unpack8(*(const uint4*)(pqk + (size_t)rp * 512 + chan), pr);
  if (hn) unpack8(*(const uint4*)(pqk + (size_t)rn * 512 + chan), nx);
#pragma unroll
  for (int e = 0; e < 8; ++e) {
    float v = cw[512 + chan + e] * cur[e];
    if (hp) v += cw[chan + e] * pr[e];
    if (hn) v += cw[1024 + chan + e] * nx[e];
    o[e] = siluf(v);
  }
}

DEVI void phase3(const Params& p, unsigned char* smem) {
  bf16_t(*KT)[72] = (bf16_t(*)[72])smem;
  bf16_t(*VwT)[72] = (bf16_t(*)[72])(smem + 64 * 72 * 2);
  float* wgt = (float*)(smem + 64 * 72 * 2 + 256 * 72 * 2);
  const int tid = threadIdx.x, lane = tid & 63, warp = tid >> 6;
  const float* gif = (const float*)(p.ws + R_GIF);
  const bf16_t* pv = (const bf16_t*)(p.ws + R_PV);
  float* U = (float*)(p.ws + R_U);
  float* NT = (float*)(p.ws + O_NT);
  float* bend = (float*)(p.ws + O_BEND);
  float* mloc = (float*)(p.ws + O_MLOC);
  for (int it = blockIdx.x; it < 260 * 4; it += gridDim.x) {
    int c = it >> 2, h = it & 3;
    if (warp < 2) {
      int dir = warp; int j = dir ? 63 - lane : lane;
      int row = ml_row(c, j);
      float ig = gif[(size_t)row * 16 + dir * 4 + h] + p.in[I_MIB][dir * 4 + h];
      float lf = logsig(gif[(size_t)row * 16 + 8 + dir * 4 + h] + p.in[I_MFB][dir * 4 + h]);
      float b = lf;
#pragma unroll
      for (int o = 1; o < 64; o <<= 1) { float t = __shfl_up(b, o); if (lane >= o) b += t; }
      float be = __shfl(b, 63);
      float ge = be - b + ig;
      float ml = wave_max(ge);
      wgt[dir * 64 + j] = expf(ge - ml);
      if (lane == 0) { int sc = ml_sc(c, dir); bend[sc * 8 + dir * 4 + h] = be; mloc[sc * 8 + dir * 4 + h] = ml; }
    }
    __syncthreads();
    {
      int j = tid >> 2, part = tid & 3;
      float f[8];
#pragma unroll
      for (int q = 0; q < 2; ++q) {
        int d0 = part * 16 + q * 8;
        ml_qk8(p, c, j, 256 + h * 64 + d0, f);
#pragma unroll
        for (int e = 0; e < 8; ++e) KT[d0 + e][j] = f2bf(f[e] * 0.125f);
      }
      int row = ml_row(c, j);
      float w0 = wgt[j], w1 = wgt[64 + j];
#pragma unroll
      for (int q = 0; q < 4; ++q) {
        int v0 = part * 32 + q * 8;
        unpack8(*(const uint4*)(pv + (size_t)row * 512 + h * 128 + v0), f);
#pragma unroll
        for (int e = 0; e < 8; ++e) { VwT[v0 + e][j] = f2bf(f[e] * w0); VwT[128 + v0 + e][j] = f2bf(f[e] * w1); }
      }
    }
    __syncthreads();
#pragma unroll
    for (int dir = 0; dir < 2; ++dir) {
      int sc = ml_sc(c, dir);
      float* Ud = U + ((size_t)sc * 8 + dir * 4 + h) * 8192;
#pragma unroll
      for (int vi = 0; vi < 2; ++vi) {
        int vt = warp * 2 + vi;
        bf16x8 bv[2];
#pragma unroll
        for (int ks = 0; ks < 2; ++ks) bv[ks] = *(const bf16x8*)&VwT[dir * 128 + vt * 16 + (lane & 15)][ks * 32 + (lane >> 4) * 8];
#pragma unroll
        for (int dt = 0; dt < 4; ++dt) {
          f32x4 a = {0.f, 0.f, 0.f, 0.f};
#pragma unroll
          for (int ks = 0; ks < 2; ++ks) {
            bf16x8 ak = *(const bf16x8*)&KT[dt * 16 + (lane & 15)][ks * 32 + (lane >> 4) * 8];
            a = __builtin_amdgcn_mfma_f32_16x16x32_bf16(ak, bv[ks], a, 0, 0, 0);
          }
          *(float4*)(Ud + (size_t)(vt * 16 + (lane & 15)) * 64 + dt * 16 + (lane >> 4) * 4) = make_float4(a[0], a[1], a[2], a[3]);
        }
      }
    }
    if (tid < 128) {
      int dir = tid >> 6, d = tid & 63; float s = 0.f;
      for (int j = 0; j < 64; ++j) s += wgt[dir * 64 + j] * bf2f(KT[d][j]);
      NT[((size_t)ml_sc(c, dir) * 8 + dir * 4 + h) * 64 + d] = s;
    }
    __syncthreads();
  }
}

DEVI void phase4(const Params& p) {
  float* U = (float*)(p.ws + R_U);
  float* NT = (float*)(p.ws + O_NT);
  const float* bend = (const float*)(p.ws + O_BEND);
  const float* mloc = (const float*)(p.ws + O_MLOC);
  float* mst = (float*)(p.ws + O_MST);
  for (int g = blockIdx.x * 256 + threadIdx.x; g < 8 * 8256; g += gridDim.x * 256) {
    int pr = g / 8256, e = g % 8256;
    float* base; size_t stride;
    if (e < 8192) { base = U + (size_t)pr * 8192 + e; stride = 8 * 8192; }
    else { base = NT + (size_t)pr * 64 + (e - 8192); stride = 8 * 64; }
    float m = 0.f, C = 0.f;
    for (int sc = 0; sc < 260; sc += 4) {
      float u[4];
#pragma unroll
      for (int q = 0; q < 4; ++q) u[q] = base[(size_t)(sc + q) * stride];
#pragma unroll
      for (int q = 0; q < 4; ++q) {
        float be = bend[(sc + q) * 8 + pr], ml = mloc[(sc + q) * 8 + pr];
        float mn = fmaxf(be + m, ml);
        float keep = expf(be + m - mn), s = expf(ml - mn);
        base[(size_t)(sc + q) * stride] = C;
        if (e == 0) mst[(sc + q) * 8 + pr] = m;
        C = keep * C + s * u[q];
        m = mn;
      }
    }
  }
}

DEVI void phase5(const Params& p, unsigned char* smem) {
  bf16_t(*Qs)[72] = (bf16_t(*)[72])smem;
  bf16_t(*Ks)[72] = (bf16_t(*)[72])(smem + 9216);
  bf16_t(*Pm)[72] = (bf16_t(*)[72])(smem + 2 * 9216);
  bf16_t(*VT)[72] = (bf16_t(*)[72])(smem + 3 * 9216);
  float* evec = (float*)(smem + 3 * 9216 + 144 * 72 * 2);
  float* Mvec = evec + 128;
  float* bvec = Mvec + 128;
  const int tid = threadIdx.x, lane = tid & 63, warp = tid >> 6;
  const float* gif = (const float*)(p.ws + R_GIF);
  const bf16_t* pv = (const bf16_t*)(p.ws + R_PV);
  bf16_t* po = (bf16_t*)(p.ws + O_PO);
  const float* U = (const float*)(p.ws + R_U);
  const float* NT = (const float*)(p.ws + O_NT);
  const float* mst = (const float*)(p.ws + O_MST);
  for (int it = blockIdx.x; it < 256 * 4; it += gridDim.x) {
    int c = 4 + (it >> 2), h = it & 3;
    if (warp < 2) {
      int dir = warp; int j = dir ? 63 - lane : lane;
      int row = ml_row(c, j);
      float ig = gif[(size_t)row * 16 + dir * 4 + h] + p.in[I_MIB][dir * 4 + h];
      float lf = logsig(gif[(size_t)row * 16 + 8 + dir * 4 + h] + p.in[I_MFB][dir * 4 + h]);
      float b = lf;
#pragma unroll
      for (int o = 1; o < 64; o <<= 1) { float t = __shfl_up(b, o); if (lane >= o) b += t; }
      float e = ig - b;
      float pm = e;
#pragma unroll
      for (int o = 1; o < 64; o <<= 1) { float t = __shfl_up(pm, o); if (lane >= o) pm = fmaxf(pm, t); }
      float m0 = mst[ml_sc(c, dir) * 8 + dir * 4 + h];
      evec[dir * 64 + j] = e; Mvec[dir * 64 + j] = fmaxf(m0, pm); bvec[dir * 64 + j] = b;
    }
    {
      int j = tid >> 2, part = tid & 3;
      float f[8];
#pragma unroll
      for (int q = 0; q < 2; ++q) {
        int d0 = part * 16 + q * 8;
        ml_qk8(p, c, j, h * 64 + d0, f);
        *(uint4*)&Qs[j][d0] = pack8(f);
        ml_qk8(p, c, j, 256 + h * 64 + d0, f);
#pragma unroll
        for (int e = 0; e < 8; ++e) f[e] *= 0.125f;
        *(uint4*)&Ks[j][d0] = pack8(f);
      }
      int row = ml_row(c, j);
#pragma unroll
      for (int q = 0; q < 4; ++q) {
        int v0 = part * 32 + q * 8;
        unpack8(*(const uint4*)(pv + (size_t)row * 512 + h * 128 + v0), f);
#pragma unroll
        for (int e = 0; e < 8; ++e) VT[v0 + e][j] = f2bf(f[e]);
      }
      for (int i = tid; i < 16 * 64; i += 256) VT[128 + (i >> 6)][i & 63] = (i < 64) ? (bf16_t)0x3f80 : (bf16_t)0;
    }
    __syncthreads();
    const int jl = warp * 16 + (lane & 15);
    f32x4 s0[4];
    bf16x8 qf[2];
#pragma unroll
    for (int ks = 0; ks < 2; ++ks) qf[ks] = *(const bf16x8*)&Qs[jl][ks * 32 + (lane >> 4) * 8];
#pragma unroll
    for (int st = 0; st < 4; ++st) {
      f32x4 a = {0.f, 0.f, 0.f, 0.f};
#pragma unroll
      for (int ks = 0; ks < 2; ++ks) {
        bf16x8 kf = *(const bf16x8*)&Ks[st * 16 + (lane & 15)][ks * 32 + (lane >> 4) * 8];
        a = __builtin_amdgcn_mfma_f32_16x16x32_bf16(kf, qf[ks], a, 0, 0, 0);
      }
      s0[st] = a;
    }
    f32x4 ysum[8];
#pragma unroll
    for (int vt = 0; vt < 8; ++vt) ysum[vt] = f32x4{0.f, 0.f, 0.f, 0.f};
#pragma unroll 1
    for (int dir = 0; dir < 2; ++dir) {
      float Mj = Mvec[dir * 64 + jl], bj = bvec[dir * 64 + jl];
      float m0 = mst[ml_sc(c, dir) * 8 + dir * 4 + h];
#pragma unroll
      for (int st = 0; st < 4; ++st) {
        float pvv[4];
#pragma unroll
        for (int r = 0; r < 4; ++r) {
          int s = st * 16 + (lane >> 4) * 4 + r;
          bool ok = dir == 0 ? (s <= jl) : (s >= jl);
          pvv[r] = ok ? s0[st][r] * expf(evec[dir * 64 + s] - Mj) : 0.f;
        }
        *(uint2*)&Pm[jl][st * 16 + (lane >> 4) * 4] = make_uint2(pack2(pvv[0], pvv[1]), pack2(pvv[2], pvv[3]));
      }
      __syncthreads();
      bf16x8 pf[2];
#pragma unroll
      for (int ks = 0; ks < 2; ++ks) pf[ks] = *(const bf16x8*)&Pm[jl][ks * 32 + (lane >> 4) * 8];
      const float* Cst = U + ((size_t)ml_sc(c, dir) * 8 + dir * 4 + h) * 8192;
      const float* nst = NT + ((size_t)ml_sc(c, dir) * 8 + dir * 4 + h) * 64;
      float ai = expf(m0 - Mj);
      f32x4 hh[9];
#pragma unroll
      for (int vt = 0; vt < 9; ++vt) {
        f32x4 a1 = {0.f, 0.f, 0.f, 0.f}, a2 = {0.f, 0.f, 0.f, 0.f};
#pragma unroll
        for (int ks = 0; ks < 2; ++ks) {
          bf16x8 vf = *(const bf16x8*)&VT[vt * 16 + (lane & 15)][ks * 32 + (lane >> 4) * 8];
          a1 = __builtin_amdgcn_mfma_f32_16x16x32_bf16(vf, pf[ks], a1, 0, 0, 0);
          int v = vt * 16 + (lane & 15);
          const float* cp = v < 128 ? Cst + (size_t)v * 64 + ks * 32 + (lane >> 4) * 8 : nst + ks * 32 + (lane >> 4) * 8;
          float cf[8];
          if (v <= 128) {
            float4 x0 = *(const float4*)cp, x1 = *(const float4*)(cp + 4);
            cf[0] = x0.x; cf[1] = x0.y; cf[2] = x0.z; cf[3] = x0.w; cf[4] = x1.x; cf[5] = x1.y; cf[6] = x1.z; cf[7] = x1.w;
          } else {
#pragma unroll
            for (int e = 0; e < 8; ++e) cf[e] = 0.f;
          }
          uint4 pk = pack8(cf);
          bf16x8 cfr;
          cfr[0] = (short)(pk.x & 0xffff); cfr[1] = (short)(pk.x >> 16); cfr[2] = (short)(pk.y & 0xffff); cfr[3] = (short)(pk.y >> 16);
          cfr[4] = (short)(pk.z & 0xffff); cfr[5] = (short)(pk.z >> 16); cfr[6] = (short)(pk.w & 0xffff); cfr[7] = (short)(pk.w >> 16);
          a2 = __builtin_amdgcn_mfma_f32_16x16x32_bf16(cfr, qf[ks], a2, 0, 0, 0);
        }
#pragma unroll
        for (int r = 0; r < 4; ++r) hh[vt][r] = a1[r] + ai * a2[r];
      }
      float den = __shfl(hh[8][0], lane & 15);
      float dn = fmaxf(fabsf(den), expf(-(bj + Mj)));
      float inv = 1.f / dn;
      float ss = 0.f;
#pragma unroll
      for (int vt = 0; vt < 8; ++vt)
#pragma unroll
        for (int r = 0; r < 4; ++r) { float x = hh[vt][r] * inv; hh[vt][r] = x; ss += x * x; }
      ss += __shfl_xor(ss, 16); ss += __shfl_xor(ss, 32);
      float rs = rsqrtf(ss * (1.f / 128.f) + 1e-6f);
#pragma unroll
      for (int vt = 0; vt < 8; ++vt)
#pragma unroll
        for (int r = 0; r < 4; ++r) ysum[vt][r] += hh[vt][r] * rs * p.in[I_MNG][h * 128 + vt * 16 + (lane >> 4) * 4 + r];
      __syncthreads();
    }
    {
      int row = ml_row(c, jl) - T_CTX;
#pragma unroll
      for (int vt = 0; vt < 8; ++vt) {
        bf16_t* op = po + (size_t)row * 512 + h * 128 + vt * 16 + (lane >> 4) * 4;
        uint2 o = *(const uint2*)op;
        float y0 = ysum[vt][0] * sigm(bflo(o.x)), y1 = ysum[vt][1] * sigm(bfhi(o.x)), y2 = ysum[vt][2] * sigm(bflo(o.y)), y3 = ysum[vt][3] * sigm(bfhi(o.y));
        *(uint2*)op = make_uint2(pack2(y0, y1), pack2(y2, y3));
      }
    }
    __syncthreads();
  }
}

DEVI void phase6(const Params& p, unsigned char* smem) {
  float(*rs)[65] = (float(*)[65])smem;
  float(*ks)[65] = (float(*)[65])(smem + 64 * 65 * 4);
  bf16_t(*TW)[72] = (bf16_t(*)[72])(smem + 2 * 64 * 65 * 4);
  bf16_t(*TA)[72] = (bf16_t(*)[72])(smem + 2 * 64 * 65 * 4 + 9216);
  bf16_t(*TG)[136] = (bf16_t(*)[136])(smem + 2 * 64 * 65 * 4 + 2 * 9216);
  float* rn = (float*)(smem + 2 * 64 * 65 * 4 + 2 * 9216 + 64 * 136 * 2);
  const int tid = threadIdx.x, lane = tid & 63, warp = tid >> 6;
  const bf16_t* prw = (const bf16_t*)p.out;
  bf16_t* SV = (bf16_t*)(p.ws + R_SV);
  float* bonus = (float*)(p.ws + O_BONUS);
  const float* cw = p.in[I_RCONV];
  const bf16_t* WUP = (const bf16_t*)(p.ws + O_WUP);
  const bf16_t* AUP = (const bf16_t*)(p.ws + O_AUP);
  const bf16_t* GUP = (const bf16_t*)(p.ws + O_GUP);
  for (int it = blockIdx.x; it < 260 * 8; it += gridDim.x) {
    int tile = it >> 3, head = it & 7;
    int row0 = tile * 64;
    int seg0 = tile < 4 ? 0 : row0, seg1 = tile < 4 ? T_CTX : row0 + 64;
    for (int pc = tid; pc < 64 * 56; pc += 256) {
      int j = pc / 56, q = pc % 56;
      int row = row0 + j;
      int col = q < 24 ? (q >> 3) * 512 + head * 64 + (q & 7) * 8 : 1536 + (q - 24) * 8;
      bool hp = row > seg0, hn = row < seg1 - 1;
      float cur[8], pr[8], nx[8], o[8];
      unpack8(*(const uint4*)(prw + (size_t)row * 1792 + col), cur);
      if (hp) unpack8(*(const uint4*)(prw + (size_t)(row - 1) * 1792 + col), pr);
      if (hn) unpack8(*(const uint4*)(prw + (size_t)(row + 1) * 1792 + col), nx);
#pragma unroll
      for (int e = 0; e < 8; ++e) {
        float v = cw[1792 + col + e] * cur[e];
        if (hp) v += cw[col + e] * pr[e];
        if (hn) v += cw[2 * 1792 + col + e] * nx[e];
        o[e] = v;
      }
      if (q < 8) {
#pragma unroll
        for (int e = 0; e < 8; ++e) rs[j][(q & 7) * 8 + e] = o[e];
      } else if (q < 16) {
#pragma unroll
        for (int e = 0; e < 8; ++e) ks[j][(q & 7) * 8 + e] = o[e];
      } else if (q < 24) {
        *(uint4*)(SV + ((size_t)row * 8 + head) * SVH + 2 * 64 + (q & 7) * 8) = pack8(o);
      } else if (q < 32) {
#pragma unroll
        for (int e = 0; e < 8; ++e) o[e] = tanhf(o[e]);
        *(uint4*)&TW[j][(q - 24) * 8] = pack8(o);
      } else if (q < 40) {
        *(uint4*)&TA[j][(q - 32) * 8] = pack8(o);
      } else {
#pragma unroll
        for (int e = 0; e < 8; ++e) o[e] = sigm(o[e]);
        *(uint4*)&TG[j][(q - 40) * 8] = pack8(o);
      }
    }
    __syncthreads();
    {
      int j = tid >> 2, part = tid & 3; float ss = 0.f;
#pragma unroll
      for (int e = 0; e < 16; ++e) { float v = ks[j][part * 16 + e] * p.in[I_RKK][head * 64 + part * 16 + e]; ss += v * v; }
      ss += __shfl_xor(ss, 1); ss += __shfl_xor(ss, 2);
      if (part == 0) rn[j] = 1.f / fmaxf(sqrtf(ss), 1e-12f);
    }
    __syncthreads();
    for (int pc = tid; pc < 64 * 8; pc += 256) {
      int j = pc >> 3, c8 = (pc & 7) * 8; int row = row0 + j;
      float fr[8], fk[8], fkk[8];
#pragma unroll
      for (int e = 0; e < 8; ++e) { fr[e] = rs[j][c8 + e]; fk[e] = ks[j][c8 + e]; fkk[e] = fk[e] * p.in[I_RKK][head * 64 + c8 + e] * rn[j]; }
      bf16_t* b = SV + ((size_t)row * 8 + head) * SVH;
      *(uint4*)(b + 0 * 64 + c8) = pack8(fr);
      *(uint4*)(b + 1 * 64 + c8) = pack8(fk);
      *(uint4*)(b + 3 * 64 + c8) = pack8(fkk);
    }
    {
      const int jl = warp * 16 + (lane & 15); const int row = row0 + jl;
      bf16x8 tw[2], ta[2], tg[4];
#pragma unroll
      for (int s = 0; s < 2; ++s) { tw[s] = *(const bf16x8*)&TW[jl][s * 32 + (lane >> 4) * 8]; ta[s] = *(const bf16x8*)&TA[jl][s * 32 + (lane >> 4) * 8]; }
#pragma unroll
      for (int s = 0; s < 4; ++s) tg[s] = *(const bf16x8*)&TG[jl][s * 32 + (lane >> 4) * 8];
      bf16_t* b = SV + ((size_t)row * 8 + head) * SVH;
      float bon[2] = {0.f, 0.f};
#pragma unroll
      for (int ct = 0; ct < 4; ++ct) {
        const int ch0 = ct * 16 + (lane >> 4) * 4;
        const int C0 = head * 64 + ch0;
        {
          f32x4 a = {0.f, 0.f, 0.f, 0.f};
#pragma unroll
          for (int s = 0; s < 4; ++s) {
            bf16x8 wf = *(const bf16x8*)(GUP + (size_t)(head * 64 + ct * 16 + (lane & 15)) * 128 + s * 32 + (lane >> 4) * 8);
            a = __builtin_amdgcn_mfma_f32_16x16x32_bf16(wf, tg[s], a, 0, 0, 0);
          }
          *(uint2*)(b + 8 * 64 + ch0) = make_uint2(pack2(a[0], a[1]), pack2(a[2], a[3]));
        }
#pragma unroll
        for (int dir = 0; dir < 2; ++dir) {
          f32x4 aw = {0.f, 0.f, 0.f, 0.f}, aa = {0.f, 0.f, 0.f, 0.f};
#pragma unroll
          for (int s = 0; s < 2; ++s) {
            size_t wo = (size_t)(dir * 512 + head * 64 + ct * 16 + (lane & 15)) * 64 + s * 32 + (lane >> 4) * 8;
            bf16x8 wf = *(const bf16x8*)(WUP + wo);
            bf16x8 af = *(const bf16x8*)(AUP + wo);
            aw = __builtin_amdgcn_mfma_f32_16x16x32_bf16(wf, tw[s], aw, 0, 0, 0);
            aa = __builtin_amdgcn_mfma_f32_16x16x32_bf16(af, ta[s], aa, 0, 0, 0);
          }
          float we[4], av[4];
#pragma unroll
          for (int r = 0; r < 4; ++r) {
            we[r] = 0.60653066f * sigm(p.in[I_RW0][dir * 512 + C0 + r] + aw[r]);
            av[r] = sigm(p.in[I_RA0][dir * 512 + C0 + r] + aa[r]);
            float kv = ks[jl][ch0 + r];
            float keff = kv * (1.f + (av[r] - 1.f) * p.in[I_RKA][C0 + r]);
            bon[dir] += rs[jl][ch0 + r] * keff * p.in[I_RRK][C0 + r];
          }
          *(uint2*)(b + (4 + 2 * dir) * 64 + ch0) = make_uint2(pack2(we[0], we[1]), pack2(we[2], we[3]));
          *(uint2*)(b + (5 + 2 * dir) * 64 + ch0) = make_uint2(pack2(av[0], av[1]), pack2(av[2], av[3]));
        }
      }
#pragma unroll
      for (int dir = 0; dir < 2; ++dir) {
        float s = bon[dir]; s += __shfl_xor(s, 16); s += __shfl_xor(s, 32);
        if (lane < 16) bonus[(size_t)row * 16 + dir * 8 + head] = s;
      }
    }
    __syncthreads();
  }
}

struct RwVec { uint4 k, kk, w, a, v, r; };
DEVI void rw_load(RwVec& x, const bf16_t* SV, int row, int head, int dir, int i, int jg, bool need_r) {
  const bf16_t* b = SV + ((size_t)row * 8 + head) * SVH;
  x.k = *(const uint4*)(b + 1 * 64 + jg * 8);
  x.kk = *(const uint4*)(b + 3 * 64 + jg * 8);
  x.w = *(const uint4*)(b + (4 + 2 * dir) * 64 + jg * 8);
  x.a = *(const uint4*)(b + (5 + 2 * dir) * 64 + jg * 8);
  x.v = *(const uint4*)(b + 2 * 64 + i * 8);
  if (need_r) x.r = *(const uint4*)(b + 0 * 64 + jg * 8);
}

DEVI void phase7(const Params& p) {
  const int lane = threadIdx.x & 63, warp = threadIdx.x >> 6, i = lane >> 3, jg = lane & 7;
  const bf16_t* SV = (const bf16_t*)(p.ws + R_SV);
  float* Pc = (float*)p.out;
  float* Bc = (float*)((unsigned char*)p.out + OUT_BC);
  for (int it = blockIdx.x * 4 + warp; it < (NCH - 1) * 16; it += gridDim.x * 4) {
    const int chunk = it >> 4, pair = it & 15, dir = pair >> 3, head = pair & 7;
    float S[8][8], P[8][8], ka[8];
#pragma unroll
    for (int a = 0; a < 8; ++a)
#pragma unroll
      for (int b = 0; b < 8; ++b) { S[a][b] = 0.f; P[a][b] = (i * 8 + a == jg * 8 + b) ? 1.f : 0.f; }
#pragma unroll
    for (int b = 0; b < 8; ++b) ka[b] = p.in[I_RKA][head * 64 + jg * 8 + b];
    RwVec nx;
    rw_load(nx, SV, rw_row(chunk * LCH, dir), head, dir, i, jg, false);
#pragma unroll 1
    for (int t = 0; t < LCH; ++t) {
      RwVec cu = nx;
      if (t + 1 < LCH) rw_load(nx, SV, rw_row(chunk * LCH + t + 1, dir), head, dir, i, jg, false);
      float kv[8], kk[8], w[8], av[8], vv[8], kka[8], keff[8];
      unpack8(cu.k, kv); unpack8(cu.kk, kk); unpack8(cu.w, w); unpack8(cu.a, av); unpack8(cu.v, vv);
#pragma unroll
      for (int b = 0; b < 8; ++b) { w[b] = __expf(-w[b]); kka[b] = -kk[b] * av[b]; keff[b] = kv[b] * (1.f + (av[b] - 1.f) * ka[b]); }
#pragma unroll
      for (int a = 0; a < 8; ++a) {
        float s = 0.f, q = 0.f;
#pragma unroll
        for (int b = 0; b < 8; ++b) { s += S[a][b] * kk[b]; q += P[a][b] * kk[b]; }
        s = allred8(s); q = allred8(q);
#pragma unroll
        for (int b = 0; b < 8; ++b) {
          S[a][b] = S[a][b] * w[b] + s * kka[b] + vv[a] * keff[b];
          P[a][b] = P[a][b] * w[b] + q * kka[b];
        }
      }
    }
    float* po = Pc + ((size_t)chunk * 16 + pair) * 4096;
    float* bo = Bc + ((size_t)chunk * 16 + pair) * 4096;
#pragma unroll
    for (int a = 0; a < 8; ++a) {
      *(float4*)(po + (i * 8 + a) * 64 + jg * 8) = make_float4(P[a][0], P[a][1], P[a][2], P[a][3]);
      *(float4*)(po + (i * 8 + a) * 64 + jg * 8 + 4) = make_float4(P[a][4], P[a][5], P[a][6], P[a][7]);
      *(float4*)(bo + (i * 8 + a) * 64 + jg * 8) = make_float4(S[a][0], S[a][1], S[a][2], S[a][3]);
      *(float4*)(bo + (i * 8 + a) * 64 + jg * 8 + 4) = make_float4(S[a][4], S[a][5], S[a][6], S[a][7]);
    }
  }
}

DEVI void phase8(const Params& p, unsigned char* smem) {
  float(*Pb)[64][64] = (float(*)[64][64])smem;
  float(*Sb)[64] = (float(*)[64])(smem + 2 * 64 * 64 * 4);
  const int tid = threadIdx.x, rr = tid >> 4, cg4 = (tid & 15) * 4;
  const float* Pc = (const float*)p.out;
  float* Bc = (float*)((unsigned char*)p.out + OUT_BC);
  for (int it = blockIdx.x; it < 64; it += gridDim.x) {
    const int pair = it >> 2, rg = it & 3; const int vrow = rg * 16 + rr;
    __syncthreads();
    *(float4*)&Sb[rr][cg4] = *(const float4*)(Bc + ((size_t)0 * 16 + pair) * 4096 + vrow * 64 + cg4);
    {
      const float* src = Pc + ((size_t)1 * 16 + pair) * 4096;
#pragma unroll
      for (int q = 0; q < 4; ++q) { int idx = tid + 256 * q; *(float4*)&Pb[1][idx >> 4][(idx & 15) * 4] = *(const float4*)(src + idx * 4); }
    }
    __syncthreads();
    for (int c = 1; c < NCH - 1; ++c) {
      f32x4 pre[4];
      if (c + 1 < NCH - 1) {
        const float* src = Pc + ((size_t)(c + 1) * 16 + pair) * 4096;
#pragma unroll
        for (int q = 0; q < 4; ++q) pre[q] = *(const f32x4*)(src + (tid + 256 * q) * 4);
      }
      float* bp = Bc + ((size_t)c * 16 + pair) * 4096 + vrow * 64 + cg4;
      float4 acc = *(const float4*)bp;
      const int pb = c & 1;
#pragma unroll 8
      for (int k = 0; k < 64; ++k) {
        float s = Sb[rr][k]; float4 pvv = *(const float4*)&Pb[pb][k][cg4];
        acc.x += s * pvv.x; acc.y += s * pvv.y; acc.z += s * pvv.z; acc.w += s * pvv.w;
      }
      __syncthreads();
      *(float4*)&Sb[rr][cg4] = acc;
      *(float4*)bp = acc;
      if (c + 1 < NCH - 1) {
#pragma unroll
        for (int q = 0; q < 4; ++q) { int idx = tid + 256 * q; *(f32x4*)&Pb[pb ^ 1][idx >> 4][(idx & 15) * 4] = pre[q]; }
      }
      __syncthreads();
    }
  }
}

DEVI void phase9(const Params& p) {
  const int lane = threadIdx.x & 63, warp = threadIdx.x >> 6, i = lane >> 3, jg = lane & 7;
  const bf16_t* SV = (const bf16_t*)(p.ws + R_SV);
  const float* Bc = (const float*)((unsigned char*)p.out + OUT_BC);
  bf16_t* odir = (bf16_t*)p.out;
  for (int it = blockIdx.x * 4 + warp; it < NCH * 16; it += gridDim.x * 4) {
    const int chunk = it >> 4, pair = it & 15, dir = pair >> 3, head = pair & 7;
    float S[8][8], ka[8];
    if (chunk == 0) {
#pragma unroll
      for (int a = 0; a < 8; ++a)
#pragma unroll
        for (int b = 0; b < 8; ++b) S[a][b] = 0.f;
    } else {
      const float* bs = Bc + ((size_t)(chunk - 1) * 16 + pair) * 4096;
#pragma unroll
      for (int a = 0; a < 8; ++a) {
        float4 x0 = *(const float4*)(bs + (i * 8 + a) * 64 + jg * 8), x1 = *(const float4*)(bs + (i * 8 + a) * 64 + jg * 8 + 4);
        S[a][0] = x0.x; S[a][1] = x0.y; S[a][2] = x0.z; S[a][3] = x0.w; S[a][4] = x1.x; S[a][5] = x1.y; S[a][6] = x1.z; S[a][7] = x1.w;
      }
    }
#pragma unroll
    for (int b = 0; b < 8; ++b) ka[b] = p.in[I_RKA][head * 64 + jg * 8 + b];
    RwVec nx;
    rw_load(nx, SV, rw_row(chunk * LCH, dir), head, dir, i, jg, true);
#pragma unroll 1
    for (int t = 0; t < LCH; ++t) {
      RwVec cu = nx;
      const int row = rw_row(chunk * LCH + t, dir);
      if (t + 1 < LCH) rw_load(nx, SV, rw_row(chunk * LCH + t + 1, dir), head, dir, i, jg, true);
      float kv[8], kk[8], w[8], av[8], vv[8], rr[8], kka[8], keff[8];
      unpack8(cu.k, kv); unpack8(cu.kk, kk); unpack8(cu.w, w); unpack8(cu.a, av); unpack8(cu.v, vv); unpack8(cu.r, rr);
#pragma unroll
      for (int b = 0; b < 8; ++b) { w[b] = __expf(-w[b]); kka[b] = -kk[b] * av[b]; keff[b] = kv[b] * (1.f + (av[b] - 1.f) * ka[b]); }
      float ov = 0.f;
#pragma unroll
      for (int a = 0; a < 8; ++a) {
        float s = 0.f;
#pragma unroll
        for (int b = 0; b < 8; ++b) s += S[a][b] * kk[b];
        s = allred8(s);
        float o = 0.f;
#pragma unroll
        for (int b = 0; b < 8; ++b) {
          S[a][b] = S[a][b] * w[b] + s * kka[b] + vv[a] * keff[b];
          o += S[a][b] * rr[b];
        }
        o = allred8(o);
        if (jg == a) ov = o;
      }
      if (row >= T_CTX) odir[((size_t)dir * T_LAT + (row - T_CTX)) * 512 + head * 64 + i * 8 + jg] = f2bf(ov);
    }
  }
}

DEVI void phase10(const Params& p) {
  const int lane = threadIdx.x & 63, warp = threadIdx.x >> 6;
  const bf16_t* odir = (const bf16_t*)p.out;
  const bf16_t* SV = (const bf16_t*)(p.ws + R_SV);
  const float* bonus = (const float*)(p.ws + O_BONUS);
  bf16_t* ya = (bf16_t*)(p.ws + R_YA);
  const int head = lane >> 3, c8 = (lane & 7) * 8, C0 = lane * 8;
  for (int t = blockIdx.x * 4 + warp; t < T_LAT; t += gridDim.x * 4) {
    const int row = t + T_CTX;
    const bf16_t* b = SV + ((size_t)row * 8 + head) * SVH;
    float v[8], g[8], y[8];
    unpack8(*(const uint4*)(b + 2 * 64 + c8), v);
    unpack8(*(const uint4*)(b + 8 * 64 + c8), g);
    float bs = bonus[(size_t)row * 16 + head] + bonus[(size_t)row * 16 + 8 + head];
#pragma unroll
    for (int e = 0; e < 8; ++e) y[e] = bs * v[e];
#pragma unroll
    for (int dir = 0; dir < 2; ++dir) {
      float o[8];
      unpack8(*(const uint4*)(odir + ((size_t)dir * T_LAT + t) * 512 + C0), o);
      float s = 0.f;
#pragma unroll
      for (int e = 0; e < 8; ++e) s += o[e];
      s = allred8(s);
      float mu = s * (1.f / 64.f);
      float q = 0.f;
#pragma unroll
      for (int e = 0; e < 8; ++e) { o[e] -= mu; q += o[e] * o[e]; }
      q = allred8(q);
      float rsd = rsqrtf(q * (1.f / 64.f) + 64e-5f);
#pragma unroll
      for (int e = 0; e < 8; ++e) y[e] += o[e] * rsd * p.in[I_RLNW][C0 + e] + p.in[I_RLNB][C0 + e];
    }
#pragma unroll
    for (int e = 0; e < 8; ++e) y[e] *= g[e];
    *(uint4*)(ya + (size_t)t * 512 + C0) = pack8(y);
  }
}

DEVI void phase11(const Params& p, unsigned char* smem) {
  const int lane = threadIdx.x & 63, warp = threadIdx.x >> 6, wm = warp >> 1, wn = warp & 1;
  const bf16_t* ya = (const bf16_t*)(p.ws + R_YA);
  const bf16_t* yb = (const bf16_t*)(p.ws + O_PO);
  const bf16_t* pg = (const bf16_t*)(p.ws + O_PG);
  bf16_t* mg = (bf16_t*)(p.ws + R_MERGED);
  for (int t = blockIdx.x; t < 128 * 8; t += gridDim.x) {
    int mt = t >> 3, nt = t & 7;
    f32x4 acc[4][4];
    zero_acc(acc);
    gemm_core(ya + (size_t)mt * 128 * 512, 512, (const bf16_t*)(p.ws + O_WBA) + (size_t)nt * 128 * 512, 512, 512, acc, smem);
#pragma unroll
    for (int i = 0; i < 4; ++i) {
      int row = mt * 128 + wm * 64 + i * 16 + (lane & 15);
#pragma unroll
      for (int j = 0; j < 4; ++j) {
        int n = nt * 128 + wn * 64 + j * 16 + (lane >> 4) * 4;
        uint2 s = *(const uint2*)(pg + (size_t)row * 2048 + n);
        *(uint2*)(mg + (size_t)row * 1024 + n) = make_uint2(pack2(acc[i][j][0] * bflo(s.x), acc[i][j][1] * bfhi(s.x)), pack2(acc[i][j][2] * bflo(s.y), acc[i][j][3] * bfhi(s.y)));
      }
    }
    zero_acc(acc);
    gemm_core(yb + (size_t)mt * 128 * 512, 512, (const bf16_t*)(p.ws + O_WBB) + (size_t)nt * 128 * 512, 512, 512, acc, smem);
#pragma unroll
    for (int i = 0; i < 4; ++i) {
      int row = mt * 128 + wm * 64 + i * 16 + (lane & 15);
#pragma unroll
      for (int j = 0; j < 4; ++j) {
        int n = nt * 128 + wn * 64 + j * 16 + (lane >> 4) * 4;
        uint2 s = *(const uint2*)(pg + (size_t)row * 2048 + 1024 + n);
        uint2 m0 = *(const uint2*)(mg + (size_t)row * 1024 + n);
        float v0 = bflo(m0.x) + acc[i][j][0] * bflo(s.x), v1 = bfhi(m0.x) + acc[i][j][1] * bfhi(s.x);
        float v2 = bflo(m0.y) + acc[i][j][2] * bflo(s.y), v3 = bfhi(m0.y) + acc[i][j][3] * bfhi(s.y);
        *(uint2*)(mg + (size_t)row * 1024 + n) = make_uint2(pack2(v0, v1), pack2(v2, v3));
      }
    }
  }
}

DEVI void phase12(const Params& p, unsigned char* smem) {
  float* gt = (float*)(smem + 40960);
  const int tid = threadIdx.x, lane = tid & 63, warp = tid >> 6, wm = warp >> 1, wn = warp & 1;
  for (int i = tid; i < 1024; i += 256) gt[i] = mod_val(p, 0, 2048 + i);
  __syncthreads();
  const bf16_t* mg = (const bf16_t*)(p.ws + R_MERGED);
  const float* x = p.in[I_X];
  float* x1 = p.out;
  for (int t = blockIdx.x; t < 128 * 8; t += gridDim.x) {
    int mt = t >> 3, nt = t & 7;
    f32x4 acc[4][4];
    zero_acc(acc);
    gemm_core(mg + (size_t)mt * 128 * 1024, 1024, (const bf16_t*)(p.ws + O_WOUT) + (size_t)nt * 128 * 1024, 1024, 1024, acc, smem);
#pragma unroll
    for (int i = 0; i < 4; ++i) {
      int row = mt * 128 + wm * 64 + i * 16 + (lane & 15);
#pragma unroll
      for (int j = 0; j < 4; ++j) {
        int n = nt * 128 + wn * 64 + j * 16 + (lane >> 4) * 4;
        float4 xv = *(const float4*)(x + (size_t)row * 1024 + n);
        xv.x += gt[n] * acc[i][j][0]; xv.y += gt[n + 1] * acc[i][j][1]; xv.z += gt[n + 2] * acc[i][j][2]; xv.w += gt[n + 3] * acc[i][j][3];
        *(float4*)(x1 + (size_t)row * 1024 + n) = xv;
      }
    }
  }
}

DEVI void phase13(const Params& p, unsigned char* smem) {
  float* smod = (float*)smem;
  const int tid = threadIdx.x, lane = tid & 63, warp = tid >> 6;
  for (int i = tid; i < 2048; i += 256) smod[i] = mod_val(p, 0, 3072 + i);
  __syncthreads();
  const float* x1 = p.out;
  bf16_t* h2 = (bf16_t*)(p.ws + R_H2);
  for (int row = blockIdx.x * 4 + warp; row < T_LAT; row += gridDim.x * 4) {
    float h[16]; float ss = 0.f;
#pragma unroll
    for (int i = 0; i < 4; ++i) {
      float4 v = *(const float4*)(x1 + (size_t)row * 1024 + i * 256 + lane * 4);
      h[4 * i] = v.x; h[4 * i + 1] = v.y; h[4 * i + 2] = v.z; h[4 * i + 3] = v.w;
      ss += v.x * v.x + v.y * v.y + v.z * v.z + v.w * v.w;
    }
    ss = wave_sum(ss);
    float rstd = rsqrtf(ss * (1.f / 1024.f) + 1e-6f);
#pragma unroll
    for (int i = 0; i < 4; ++i) {
#pragma unroll
      for (int e = 0; e < 4; ++e) {
        int k = i * 256 + lane * 4 + e;
        float y = h[4 * i + e] * rstd * p.in[I_N2G][k];
        h[4 * i + e] = y * (1.f + smod[1024 + k]) + smod[k];
      }
      *(uint2*)(h2 + (size_t)row * 1024 + i * 256 + lane * 4) = make_uint2(pack2(h[4 * i], h[4 * i + 1]), pack2(h[4 * i + 2], h[4 * i + 3]));
    }
  }
}

DEVI void phase14(const Params& p, unsigned char* smem) {
  bf16_t(*Qt)[136] = (bf16_t(*)[136])smem;
  float* Sc = (float*)smem;
  const int tid = threadIdx.x, lane = tid & 63, warp = tid >> 6, wm = warp >> 1, wn = warp & 1;
  const bf16_t* h2 = (const bf16_t*)(p.ws + R_H2);
  const bf16_t* keys = (const bf16_t*)(p.ws + O_KEYS);
  float* tops = (float*)(p.ws + R_TOPS);
  int* topi = (int*)(p.ws + R_TOPI);
  for (int t = blockIdx.x; t < 128 * 16; t += gridDim.x) {
    int mt = t >> 4, hp = t & 15;
    f32x4 acc[4][4];
    zero_acc(acc);
    gemm_core(h2 + (size_t)mt * 128 * 1024, 1024, (const bf16_t*)(p.ws + O_WQ) + (size_t)hp * 128 * 1024, 1024, 1024, acc, smem);
#pragma unroll
    for (int i = 0; i < 4; ++i)
#pragma unroll
      for (int j = 0; j < 4; ++j)
        *(uint2*)&Qt[wm * 64 + i * 16 + (lane & 15)][wn * 64 + j * 16 + (lane >> 4) * 4] =
            make_uint2(pack2(acc[i][j][0], acc[i][j][1]), pack2(acc[i][j][2], acc[i][j][3]));
    __syncthreads();
    zero_acc(acc);
#pragma unroll
    for (int ks = 0; ks < 4; ++ks) {
      bf16x8 qf[4], kf[4];
#pragma unroll
      for (int i = 0; i < 4; ++i) qf[i] = *(const bf16x8*)&Qt[wm * 64 + i * 16 + (lane & 15)][ks * 32 + (lane >> 4) * 8];
#pragma unroll
      for (int j = 0; j < 4; ++j) kf[j] = *(const bf16x8*)(keys + ((size_t)hp * 128 + wn * 64 + j * 16 + (lane & 15)) * 128 + ks * 32 + (lane >> 4) * 8);
#pragma unroll
      for (int i = 0; i < 4; ++i)
#pragma unroll
        for (int j = 0; j < 4; ++j) acc[i][j] = __builtin_amdgcn_mfma_f32_16x16x32_bf16(kf[j], qf[i], acc[i][j], 0, 0, 0);
    }
    __syncthreads();
#pragma unroll
    for (int i = 0; i < 4; ++i)
#pragma unroll
      for (int j = 0; j < 4; ++j) {
        float* d = Sc + (wm * 64 + i * 16 + (lane & 15)) * 129 + wn * 64 + j * 16 + (lane >> 4) * 4;
        d[0] = acc[i][j][0]; d[1] = acc[i][j][1]; d[2] = acc[i][j][2]; d[3] = acc[i][j][3];
      }
    __syncthreads();
    if (tid < 128) {
      float* rowp = Sc + tid * 129;
      size_t ob = ((size_t)(mt * 128 + tid) * 16 + hp) * 16;
      for (int r = 0; r < 16; ++r) {
        float best = -INFINITY; int bi = 0;
#pragma unroll 8
        for (int k = 0; k < 128; ++k) { float v = rowp[k]; if (v > best) { best = v; bi = k; } }
        tops[ob + r] = best; topi[ob + r] = bi; rowp[bi] = -INFINITY;
      }
    }
    __syncthreads();
  }
}

DEVI void phase15(const Params& p, unsigned char* smem) {
  float* gt = (float*)smem;
  const int tid = threadIdx.x, lane = tid & 63, warp = tid >> 6;
  for (int i = tid; i < 1024; i += 256) gt[i] = mod_val(p, 0, 5120 + i);
  __syncthreads();
  const bf16_t* h2 = (const bf16_t*)(p.ws + R_H2);
  const float* tops = (const float*)(p.ws + R_TOPS);
  const int* topi = (const int*)(p.ws + R_TOPI);
  const float* pu = p.in[I_PU];
  const float* pvw = p.in[I_PV];
  float* xo = p.out;
  int ca, cb;
  {
    int l = lane;
    if (l < 16) { ca = 0; cb = l; } else if (l < 24) { ca = 1; cb = l - 16; } else if (l < 29) { ca = 2; cb = l - 24; }
    else if (l < 33) { ca = 3; cb = l - 29; } else if (l < 36) { ca = 4; cb = l - 33; } else if (l < 38) { ca = 5; cb = l - 36; }
    else if (l < 40) { ca = 6; cb = l - 38; } else if (l < 42) { ca = 7; cb = l - 40; } else if (l < 50) { ca = l - 34; cb = 0; }
    else { ca = 0; cb = 0; }
  }
  const int flat = ca * 16 + cb;
  for (int t = blockIdx.x * 4 + warp; t < T_LAT; t += gridDim.x * 4) {
    float hv[16], out[16];
#pragma unroll
    for (int i = 0; i < 4; ++i) {
      uint2 u = *(const uint2*)(h2 + (size_t)t * 1024 + i * 256 + lane * 4);
      hv[4 * i] = bflo(u.x); hv[4 * i + 1] = bfhi(u.x); hv[4 * i + 2] = bflo(u.y); hv[4 * i + 3] = bfhi(u.y);
      out[4 * i] = 0.f; out[4 * i + 1] = 0.f; out[4 * i + 2] = 0.f; out[4 * i + 3] = 0.f;
    }
#pragma unroll 1
    for (int hd = 0; hd < 8; ++hd) {
      const size_t b1 = ((size_t)t * 16 + hd * 2) * 16, b2 = b1 + 16;
      float val = lane < 50 ? tops[b1 + ca] + tops[b2 + cb] : -INFINITY;
      int idx = topi[b1 + ca] * 128 + topi[b2 + cb];
      int cnt = 0;
#pragma unroll
      for (int i = 0; i < 50; ++i) {
        float vi = __int_as_float(__builtin_amdgcn_readlane(__float_as_int(val), i));
        int fi = __builtin_amdgcn_readlane(flat, i);
        cnt += ((vi > val) || (vi == val && fi < flat)) ? 1 : 0;
      }
      bool sel = lane < 50 && cnt < 16;
      float vmax = __int_as_float(__builtin_amdgcn_readlane(__float_as_int(val), 0));
      float ex = sel ? __expf(val - vmax) : 0.f;
      float gsum = wave_sum(ex);
      float g = ex / gsum;
      unsigned long long mask = __ballot(sel);
      float coef = 0.f;
      unsigned long long m1 = mask;
      while (m1) {
        int src = __ffsll((long long)m1) - 1; m1 &= m1 - 1;
        int e = __builtin_amdgcn_readlane(idx, src);
        const float* ur = pu + (size_t)e * 1024;
        float d = 0.f;
#pragma unroll
        for (int i = 0; i < 4; ++i) {
          float4 u = *(const float4*)(ur + i * 256 + lane * 4);
          d += u.x * hv[4 * i] + u.y * hv[4 * i + 1] + u.z * hv[4 * i + 2] + u.w * hv[4 * i + 3];
        }
        d = wave_sum(d);
        float act = 0.5f * d * (1.f + erff(d * 0.70710678118f));
        if (lane == src) coef = g * act;
      }
      m1 = mask;
      while (m1) {
        int src = __ffsll((long long)m1) - 1; m1 &= m1 - 1;
        int e = __builtin_amdgcn_readlane(idx, src);
        float cf = __int_as_float(__builtin_amdgcn_readlane(__float_as_int(coef), src));
        const float* vr = pvw + (size_t)e * 1024;
#pragma unroll
        for (int i = 0; i < 4; ++i) {
          float4 u = *(const float4*)(vr + i * 256 + lane * 4);
          out[4 * i] += cf * u.x; out[4 * i + 1] += cf * u.y; out[4 * i + 2] += cf * u.z; out[4 * i + 3] += cf * u.w;
        }
      }
    }
    float xs[16]; float ss = 0.f;
#pragma unroll
    for (int i = 0; i < 4; ++i) {
      float4 v = *(const float4*)(xo + (size_t)t * 1024 + i * 256 + lane * 4);
      int k = i * 256 + lane * 4;
      xs[4 * i] = v.x + gt[k] * out[4 * i]; xs[4 * i + 1] = v.y + gt[k + 1] * out[4 * i + 1];
      xs[4 * i + 2] = v.z + gt[k + 2] * out[4 * i + 2]; xs[4 * i + 3] = v.w + gt[k + 3] * out[4 * i + 3];
      ss += xs[4 * i] * xs[4 * i] + xs[4 * i + 1] * xs[4 * i + 1] + xs[4 * i + 2] * xs[4 * i + 2] + xs[4 * i + 3] * xs[4 * i + 3];
    }
    ss = wave_sum(ss);
    float rstd = rsqrtf(ss * (1.f / 1024.f) + 1e-6f);
#pragma unroll
    for (int i = 0; i < 4; ++i) {
      int k = i * 256 + lane * 4;
      float4 g4 = *(const float4*)(p.in[I_FG] + k);
      *(float4*)(xo + (size_t)t * 1024 + k) = make_float4(xs[4 * i] * rstd * g4.x, xs[4 * i + 1] * rstd * g4.y, xs[4 * i + 2] * rstd * g4.z, xs[4 * i + 3] * rstd * g4.w);
    }
  }
}

constexpr int NPHASE = 16;
__global__ void __launch_bounds__(256, 2) mk(Params p, int ph0, int ph1, int coop) {
  __shared__ __attribute__((aligned(16))) unsigned char smem[SMEM_BYTES];
#define RUN_PHASE(n, call)                                   \
  if (ph0 <= n && n < ph1) {                                 \
    if (ONLY < 0 || ONLY == n) { call; }                     \
    if (coop && n + 1 < ph1) cg::this_grid().sync();         \
  }
  RUN_PHASE(0, phase0(p, smem))
  RUN_PHASE(1, phase1(p, smem))
  RUN_PHASE(2, phase2(p, smem))
  RUN_PHASE(3, phase3(p, smem))
  RUN_PHASE(4, phase4(p))
  RUN_PHASE(5, phase5(p, smem))
  RUN_PHASE(6, phase6(p, smem))
  RUN_PHASE(7, phase7(p))
  RUN_PHASE(8, phase8(p, smem))
  RUN_PHASE(9, phase9(p))
  RUN_PHASE(10, phase10(p))
  RUN_PHASE(11, phase11(p, smem))
  RUN_PHASE(12, phase12(p, smem))
  RUN_PHASE(13, phase13(p, smem))
  RUN_PHASE(14, phase14(p, smem))
  RUN_PHASE(15, phase15(p, smem))
}

extern "C" void kernel_launch(void* const* d_in, const int* in_sizes, int n_in, void* d_out, int out_size, void* d_ws,
                              size_t ws_size, hipStream_t stream) {
  static int grid_blocks = 0;
  if (!grid_blocks) {
    int dev = 0, cus = 0, per_cu = 0;
    hipGetDevice(&dev);
    hipDeviceGetAttribute(&cus, hipDeviceAttributeMultiprocessorCount, dev);
    hipOccupancyMaxActiveBlocksPerMultiprocessor(&per_cu, mk, 256, 0);
    if (per_cu < 1) per_cu = 1;
    if (per_cu > 2) per_cu = 2;
    grid_blocks = cus * per_cu;
  }
  if (ws_size < WS_NEED) { fprintf(stderr, "workspace too small: %zu < %zu\n", ws_size, (size_t)WS_NEED); return; }
  Params p{};
  for (int i = 0; i < 32; ++i) p.in[i] = (const float*)d_in[i];
  p.out = (float*)d_out;
  p.ws = (unsigned char*)d_ws;
#if MEGA
  int ph0 = 0, ph1 = NPHASE, coop = 1;
  void* args[] = {&p, &ph0, &ph1, &coop};
  hipError_t e = hipLaunchCooperativeKernel((void*)mk, dim3(grid_blocks), dim3(256), args, 0, stream);
  if (e != hipSuccess) fprintf(stderr, "cooperative launch failed: %s (grid %d)\n", hipGetErrorString(e), grid_blocks);
#else
  for (int ph = 0; ph < NPHASE; ++ph) mk<<<grid_blocks, 256, 0, stream>>>(p, ph, ph + 1, 0);
#endif
}
```

```cpp
#include <hip/hip_runtime.h>
#include <hip/hip_cooperative_groups.h>
#include <cstdio>
#include <cstdint>
namespace cg = cooperative_groups;

#ifndef MEGA
#define MEGA 1
#endif
#ifndef ONLY
#define ONLY -1
#endif
#ifndef REPEAT_PH
#define REPEAT_PH -1
#endif
#ifndef DRY_PH
#define DRY_PH -1
#endif

typedef unsigned short bf16_t;
using bf16x8 = __attribute__((ext_vector_type(8))) short;
using f32x4 = __attribute__((ext_vector_type(4))) float;
using u32x4 = __attribute__((ext_vector_type(4))) unsigned;
#define DEVI __device__ __forceinline__

constexpr int T_CTX = 256, T_LAT = 16384, T_ALL = 16640;
constexpr int NIN = 5392, NP = 5376;
constexpr int NCH = 128, LCH = 130;
constexpr int SVH = 576;
constexpr int SMEM_BYTES = 71680;

enum { I_X = 0, I_C, I_CTX, I_CCTX, I_ADAW, I_ADAB, I_N1G, I_WIN, I_RCONV, I_RW0, I_RWUP, I_RA0, I_RAUP, I_RGUP,
       I_RKK, I_RKA, I_RRK, I_RLNW, I_RLNB, I_MCONV, I_MIB, I_MFB, I_MNG, I_WBA, I_WBB, I_WOUT, I_N2G, I_WQ,
       I_KEYS, I_PU, I_PV, I_FG };

struct Params { const float* in[32]; float* out; unsigned char* ws; };

constexpr size_t A256(size_t x) { return (x + 255) & ~(size_t)255; }
constexpr size_t O_MODP = 0;
constexpr size_t O_WBA = A256(O_MODP + (size_t)16 * 2 * 6144 * 4);
constexpr size_t O_WBB = A256(O_WBA + (size_t)1024 * 512 * 2);
constexpr size_t O_WOUT = A256(O_WBB + (size_t)1024 * 512 * 2);
constexpr size_t O_WQ = A256(O_WOUT + (size_t)1024 * 1024 * 2);
constexpr size_t O_KEYS = A256(O_WQ + (size_t)2048 * 1024 * 2);
constexpr size_t O_WUP = A256(O_KEYS + (size_t)16 * 128 * 128 * 2);
constexpr size_t O_AUP = A256(O_WUP + (size_t)1024 * 64 * 2);
constexpr size_t O_GUP = A256(O_AUP + (size_t)1024 * 64 * 2);
constexpr size_t O_BEND = A256(O_GUP + (size_t)512 * 128 * 2);
constexpr size_t O_MLOC = A256(O_BEND + (size_t)260 * 8 * 4);
constexpr size_t O_MST = A256(O_MLOC + (size_t)260 * 8 * 4);
constexpr size_t O_NT = A256(O_MST + (size_t)260 * 8 * 4);
constexpr size_t O_BONUS = A256(O_NT + (size_t)260 * 8 * 64 * 4);
constexpr size_t O_STAMP = A256(O_BONUS + (size_t)T_ALL * 16 * 4);
constexpr size_t O_BAR = A256(O_STAMP + 1024);
constexpr size_t O_PG = A256(O_BAR + 3456 * 4);
constexpr size_t O_PO = A256(O_PG + (size_t)T_LAT * 2048 * 2);
constexpr size_t O_R = A256(O_PO + (size_t)T_LAT * 512 * 2);
constexpr size_t R_HX = O_R;
constexpr size_t R_WIN = A256(R_HX + (size_t)T_ALL * 1024 * 2);
constexpr size_t R_PQK = A256(R_WIN + (size_t)NP * 1024 * 2);
constexpr size_t R_PV = A256(R_PQK + (size_t)T_ALL * 512 * 2);
constexpr size_t R_GIF = A256(R_PV + (size_t)T_ALL * 512 * 2);
constexpr size_t R_U = A256(R_GIF + (size_t)T_ALL * 16 * 4);
constexpr size_t R_END1 = A256(R_U + (size_t)260 * 8 * 8192 * 4);
constexpr size_t R_SV = O_R;
constexpr size_t R_YA = A256(R_SV + (size_t)T_ALL * 8 * SVH * 2);
constexpr size_t R_END2 = A256(R_YA + (size_t)T_LAT * 512 * 2);
constexpr size_t R_MERGED = O_R;
constexpr size_t R_H2 = A256(R_MERGED + (size_t)T_LAT * 1024 * 2);
constexpr size_t R_TOPS = A256(R_H2 + (size_t)T_LAT * 1024 * 2);
constexpr size_t R_TOPI = A256(R_TOPS + (size_t)T_LAT * 256 * 4);
constexpr size_t R_UBF = A256(R_TOPI + (size_t)T_LAT * 256 * 4);
constexpr size_t R_VBF = A256(R_UBF + (size_t)16384 * 1024 * 2);
constexpr size_t R_END3 = A256(R_VBF + (size_t)16384 * 1024 * 2);
constexpr size_t WS_NEED = (R_END1 > R_END2 ? (R_END1 > R_END3 ? R_END1 : R_END3) : (R_END2 > R_END3 ? R_END2 : R_END3));
constexpr size_t OUT_BC = (size_t)NCH * 16 * 4096 * 4;

DEVI bf16_t f2bf(float f) { unsigned u = __float_as_uint(f); u += 0x7fffu + ((u >> 16) & 1u); return (bf16_t)(u >> 16); }
DEVI float bf2f(bf16_t h) { return __uint_as_float(((unsigned)h) << 16); }
DEVI float bflo(unsigned u) { return __uint_as_float(u << 16); }
DEVI float bfhi(unsigned u) { return __uint_as_float(u & 0xffff0000u); }
DEVI unsigned pack2(float a, float b) { return (unsigned)f2bf(a) | ((unsigned)f2bf(b) << 16); }
DEVI void unpack8(const uint4& u, float* f) {
  f[0] = bflo(u.x); f[1] = bfhi(u.x); f[2] = bflo(u.y); f[3] = bfhi(u.y);
  f[4] = bflo(u.z); f[5] = bfhi(u.z); f[6] = bflo(u.w); f[7] = bfhi(u.w);
}
DEVI uint4 pack8(const float* f) { return make_uint4(pack2(f[0], f[1]), pack2(f[2], f[3]), pack2(f[4], f[5]), pack2(f[6], f[7])); }
DEVI float wave_sum(float v) {
#pragma unroll
  for (int o = 32; o; o >>= 1) v += __shfl_xor(v, o);
  return v;
}
DEVI float wave_max(float v) {
#pragma unroll
  for (int o = 32; o; o >>= 1) v = fmaxf(v, __shfl_xor(v, o));
  return v;
}
DEVI float sigm(float x) { return 1.f / (1.f + __expf(-x)); }
DEVI float siluf(float x) { return x / (1.f + __expf(-x)); }
DEVI float logsig(float x) { return fminf(x, 0.f) - log1pf(expf(-fabsf(x))); }
template <int CTRL> DEVI float dppf(float v) { return __int_as_float(__builtin_amdgcn_update_dpp(0, __float_as_int(v), CTRL, 0xf, 0xf, true)); }
DEVI float rlf(float v, int l) { return __int_as_float(__builtin_amdgcn_readlane(__float_as_int(v), l)); }
DEVI float wave_sum_u(float v) {
  v += dppf<0xB1>(v); v += dppf<0x4E>(v); v += dppf<0x141>(v); v += dppf<0x140>(v);
  return (rlf(v, 0) + rlf(v, 16)) + (rlf(v, 32) + rlf(v, 48));
}
typedef __attribute__((ext_vector_type(2))) short s16x2;
DEVI float dot2bf(unsigned a, unsigned b, float c) { return __builtin_amdgcn_fdot2_f32_bf16(__builtin_bit_cast(s16x2, a), __builtin_bit_cast(s16x2, b), c, false); }
typedef __attribute__((ext_vector_type(2))) float f32x2;
DEVI void convert_fp8(const float* __restrict__ src, unsigned char* __restrict__ dst, size_t n16, float scale) {
  for (size_t g = (size_t)blockIdx.x * 256 + threadIdx.x; g < n16; g += (size_t)gridDim.x * 256) {
    u32x4 o;
#pragma unroll
    for (int q = 0; q < 4; ++q) {
      float4 a = *(const float4*)(src + g * 16 + q * 4);
      int pk = __builtin_amdgcn_cvt_pk_fp8_f32(a.x * scale, a.y * scale, 0, false);
      pk = __builtin_amdgcn_cvt_pk_fp8_f32(a.z * scale, a.w * scale, pk, true);
      o[q] = (unsigned)pk;
    }
    *(u32x4*)(dst + g * 16) = o;
  }
}
DEVI void unpack_fp8x16(const u32x4& u, float* f) {
#pragma unroll
  for (int q = 0; q < 4; ++q) {
    f32x2 lo = __builtin_amdgcn_cvt_pk_f32_fp8((int)u[q], false), hi = __builtin_amdgcn_cvt_pk_f32_fp8((int)u[q], true);
    f[4 * q] = lo[0]; f[4 * q + 1] = lo[1]; f[4 * q + 2] = hi[0]; f[4 * q + 3] = hi[1];
  }
}
DEVI void convert_bf16(const float* __restrict__ src, bf16_t* __restrict__ dst, size_t n8) {
  for (size_t g = (size_t)blockIdx.x * 256 + threadIdx.x; g < n8; g += (size_t)gridDim.x * 256) {
    float4 a = *(const float4*)(src + g * 8), b = *(const float4*)(src + g * 8 + 4);
    *(uint4*)(dst + g * 8) = make_uint4(pack2(a.x, a.y), pack2(a.z, a.w), pack2(b.x, b.y), pack2(b.z, b.w));
  }
}
DEVI float allred8(float v) { v += dppf<0xB1>(v); v += dppf<0x4E>(v); v += dppf<0x141>(v); return v; }

DEVI int ml_row(int c, int j) {
  if (c < 4) return c * 64 + j;
  int cc = c - 4; int col = cc >> 2; int gr = (cc & 3) * 64 + j;
  return T_CTX + gr * 64 + col;
}
DEVI int ml_sc(int c, int dir) { return dir == 0 ? c : (c < 4 ? 3 - c : 263 - c); }
DEVI int rw_row(int p, int dir) { return dir == 0 ? p : (p < T_CTX ? (T_CTX - 1 - p) : (T_ALL + T_CTX - 1 - p)); }

DEVI float mod_val(const Params& p, int which, int col) {
  const float* modp = (const float*)(p.ws + O_MODP);
  float s = p.in[I_ADAB][col];
#pragma unroll
  for (int rs = 0; rs < 16; ++rs) s += modp[(rs * 2 + which) * 6144 + col];
  return s;
}

DEVI void gemm_core(const bf16_t* __restrict__ A, int lda, const bf16_t* __restrict__ Bt, int ldb, int K,
                    f32x4 (&acc)[4][4], unsigned char* smem) {
  bf16_t(*sa)[80] = (bf16_t(*)[80])smem;
  bf16_t(*sb)[80] = (bf16_t(*)[80])(smem + 128 * 80 * 2);
  const int tid = threadIdx.x, lane = tid & 63, warp = tid >> 6, wm = warp >> 1, wn = warp & 1;
  const int lr = tid >> 3, lk = (tid & 7) * 8;
  const bf16_t* Ap = A + (size_t)lr * lda + lk;
  const bf16_t* Bp = Bt + (size_t)lr * ldb + lk;
  u32x4 ra0[4], rb0[4], ra1[4], rb1[4];
#pragma unroll
  for (int i = 0; i < 4; ++i) {
    ra0[i] = *(const u32x4*)(Ap + (size_t)(32 * i) * lda); rb0[i] = *(const u32x4*)(Bp + (size_t)(32 * i) * ldb);
    ra1[i] = *(const u32x4*)(Ap + (size_t)(32 * i) * lda + 64); rb1[i] = *(const u32x4*)(Bp + (size_t)(32 * i) * ldb + 64);
  }
#define GEMM_STEP(k0, ra, rb)                                                                                 \
  {                                                                                                           \
    __syncthreads();                                                                                          \
    _Pragma("unroll") for (int i = 0; i < 4; ++i) { *(u32x4*)&sa[lr + 32 * i][lk] = ra[i]; *(u32x4*)&sb[lr + 32 * i][lk] = rb[i]; } \
    __syncthreads();                                                                                          \
    if ((k0) + 128 < K) {                                                                                     \
      _Pragma("unroll") for (int i = 0; i < 4; ++i) {                                                         \
        ra[i] = *(const u32x4*)(Ap + (size_t)(32 * i) * lda + (k0) + 128);                                    \
        rb[i] = *(const u32x4*)(Bp + (size_t)(32 * i) * ldb + (k0) + 128);                                    \
      }                                                                                                       \
    }                                                                                                         \
    __builtin_amdgcn_s_setprio(1);                                                                            \
    _Pragma("unroll") for (int ks = 0; ks < 2; ++ks) {                                                        \
      bf16x8 af[4], bq[4];                                                                                    \
      _Pragma("unroll") for (int i = 0; i < 4; ++i) af[i] = *(const bf16x8*)&sa[wm * 64 + i * 16 + (lane & 15)][ks * 32 + (lane >> 4) * 8]; \
      _Pragma("unroll") for (int j = 0; j < 4; ++j) bq[j] = *(const bf16x8*)&sb[wn * 64 + j * 16 + (lane & 15)][ks * 32 + (lane >> 4) * 8]; \
      _Pragma("unroll") for (int i = 0; i < 4; ++i)                                                           \
        _Pragma("unroll") for (int j = 0; j < 4; ++j) acc[i][j] = __builtin_amdgcn_mfma_f32_16x16x32_bf16(bq[j], af[i], acc[i][j], 0, 0, 0); \
    }                                                                                                         \
    __builtin_amdgcn_s_setprio(0);                                                                            \
  }
  for (int k0 = 0; k0 < K; k0 += 128) {
    GEMM_STEP(k0, ra0, rb0)
    GEMM_STEP(k0 + 64, ra1, rb1)
  }
#undef GEMM_STEP
  __syncthreads();
}
DEVI void zero_acc(f32x4 (&acc)[4][4]) {
#pragma unroll
  for (int i = 0; i < 4; ++i)
#pragma unroll
    for (int j = 0; j < 4; ++j) acc[i][j] = f32x4{0.f, 0.f, 0.f, 0.f};
}

struct XcdMap { int v, nx, slot, slots; };
template <typename F> DEVI void for_tiles_xcd(const XcdMap& xm, int MT, int NT, int SM, int SN, F&& f) {
  const int nsn = (NT + SN - 1) / SN, nst = ((MT + SM - 1) / SM) * nsn, per = SM * SN;
  const int n_my = (nst - xm.v + xm.nx - 1) / xm.nx;
  for (int g = xm.slot; g < n_my * per; g += xm.slots) {
    const int s = xm.v + (g / per) * xm.nx, idx = g % per;
    const int sm = s / nsn, sn = s % nsn;
    const int mt = sm * SM + idx / SN, nt = sn * SN + idx % SN;
    if (mt < MT && nt < NT) f(mt, nt);
  }
}

DEVI void tr_tile(const float* __restrict__ src, int lds, int k0, int n0src, bf16_t* __restrict__ dst, int ldd, int n0dst,
                  unsigned char* smem) {
  float(*tile)[65] = (float(*)[65])smem;
  const int tid = threadIdx.x, j = tid & 63, i0 = tid >> 6;
#pragma unroll 4
  for (int ii = 0; ii < 16; ++ii) { int i = i0 + 4 * ii; tile[i][j] = src[(size_t)(k0 + i) * lds + n0src + j]; }
  __syncthreads();
#pragma unroll 4
  for (int jj = 0; jj < 16; ++jj) { int jn = i0 + 4 * jj; dst[(size_t)(n0dst + jn) * ldd + k0 + j] = f2bf(tile[j][jn]); }
  __syncthreads();
}

DEVI void phase0(const Params& p, unsigned char* smem) {
  const int tid = threadIdx.x;
  constexpr int N_MOD = 384, N_WIN = 16 * 84, N_WB = 128, N_WOUT = 256, N_WQ = 512, N_LORA = 16, N_GUP = 16, N_KEYS = 128;
  constexpr int E0 = N_MOD, E1 = E0 + N_WIN, E2 = E1 + N_WB, E3 = E2 + N_WB, E4 = E3 + N_WOUT, E5 = E4 + N_WQ,
                E6 = E5 + N_LORA, E7 = E6 + N_LORA, E8 = E7 + N_GUP, E9 = E8 + N_KEYS;
  for (int it = blockIdx.x; it < E9; it += gridDim.x) {
    if (it < E0) {
      int cb = it % 24, rs = it / 24; int col = cb * 256 + tid;
      const float* aw = p.in[I_ADAW];
      float ax = 0.f, ac = 0.f;
#pragma unroll 8
      for (int r = rs * 64; r < rs * 64 + 64; ++r) {
        float w = aw[(size_t)r * 6144 + col];
        ax += siluf(p.in[I_C][r]) * w;
        ac += siluf(p.in[I_CCTX][r]) * w;
      }
      float* modp = (float*)(p.ws + O_MODP);
      modp[(rs * 2 + 0) * 6144 + col] = ax;
      modp[(rs * 2 + 1) * 6144 + col] = ac;
    } else if (it < E1) {
      int t = it - E0; int kt = t / 84, nt = t % 84; int n0 = nt * 64;
      tr_tile(p.in[I_WIN], NIN, kt * 64, n0 < 2816 ? n0 : n0 + 16, (bf16_t*)(p.ws + R_WIN), 1024, n0, smem);
    } else if (it < E2) {
      int t = it - E1; tr_tile(p.in[I_WBA], 1024, (t / 16) * 64, (t % 16) * 64, (bf16_t*)(p.ws + O_WBA), 512, (t % 16) * 64, smem);
    } else if (it < E3) {
      int t = it - E2; tr_tile(p.in[I_WBB], 1024, (t / 16) * 64, (t % 16) * 64, (bf16_t*)(p.ws + O_WBB), 512, (t % 16) * 64, smem);
    } else if (it < E4) {
      int t = it - E3; tr_tile(p.in[I_WOUT], 1024, (t / 16) * 64, (t % 16) * 64, (bf16_t*)(p.ws + O_WOUT), 1024, (t % 16) * 64, smem);
    } else if (it < E5) {
      int t = it - E4; tr_tile(p.in[I_WQ], 2048, (t / 32) * 64, (t % 32) * 64, (bf16_t*)(p.ws + O_WQ), 1024, (t % 32) * 64, smem);
    } else if (it < E6) {
      int t = it - E5; int dir = t / 8, nt = t % 8;
      tr_tile(p.in[I_RWUP] + (size_t)dir * 64 * 512, 512, 0, nt * 64, (bf16_t*)(p.ws + O_WUP) + (size_t)dir * 512 * 64, 64, nt * 64, smem);
    } else if (it < E7) {
      int t = it - E6; int dir = t / 8, nt = t % 8;
      tr_tile(p.in[I_RAUP] + (size_t)dir * 64 * 512, 512, 0, nt * 64, (bf16_t*)(p.ws + O_AUP) + (size_t)dir * 512 * 64, 64, nt * 64, smem);
    } else if (it < E8) {
      int t = it - E7; tr_tile(p.in[I_RGUP], 512, (t / 8) * 64, (t % 8) * 64, (bf16_t*)(p.ws + O_GUP), 128, (t % 8) * 64, smem);
    } else {
      int t = it - E8; size_t base = (size_t)t * 2048 + tid * 8;
      const float* s = p.in[I_KEYS] + base;
      float f[8];
      float4 a = *(const float4*)s, b = *(const float4*)(s + 4);
      f[0] = a.x; f[1] = a.y; f[2] = a.z; f[3] = a.w; f[4] = b.x; f[5] = b.y; f[6] = b.z; f[7] = b.w;
      *(uint4*)((bf16_t*)(p.ws + O_KEYS) + base) = pack8(f);
    }
  }
}

DEVI void phase1(const Params& p, unsigned char* smem) {
  float* smod = (float*)smem;
  const int tid = threadIdx.x, lane = tid & 63, warp = tid >> 6;
  for (int i = tid; i < 4096; i += 256) { int which = i >> 10; smod[i] = mod_val(p, which >> 1, (which & 1) * 1024 + (i & 1023)); }
  __syncthreads();
  bf16_t* hx = (bf16_t*)(p.ws + R_HX);
  float* gif = (float*)(p.ws + R_GIF);
  const float* win = p.in[I_WIN];
  constexpr int RPW = 4;
  for (int rg = blockIdx.x * 4 + warp; rg < T_ALL / RPW; rg += gridDim.x * 4) {
    const int row0 = rg * RPW;
    const float* sh = smod + (row0 < T_CTX ? 2048 : 0);
    const float* sc = sh + 1024;
    const float* src0 = row0 < T_CTX ? p.in[I_CTX] + (size_t)row0 * 1024 : p.in[I_X] + (size_t)(row0 - T_CTX) * 1024;
    float rstd[RPW];
#pragma unroll
    for (int r = 0; r < RPW; ++r) {
      float ss = 0.f;
#pragma unroll
      for (int i = 0; i < 4; ++i) {
        float4 v = *(const float4*)(src0 + (size_t)r * 1024 + i * 256 + lane * 4);
        ss += v.x * v.x + v.y * v.y + v.z * v.z + v.w * v.w;
      }
      ss = wave_sum_u(ss);
      rstd[r] = rsqrtf(ss * (1.f / 1024.f) + 1e-6f);
    }
    float g[RPW][16];
#pragma unroll
    for (int r = 0; r < RPW; ++r)
#pragma unroll
      for (int j = 0; j < 16; ++j) g[r][j] = 0.f;
#pragma unroll 2
    for (int i = 0; i < 4; ++i) {
      const int k0 = i * 256 + lane * 4;
      float y[RPW][4];
      {
        const float4 gk = *(const float4*)(p.in[I_N1G] + k0);
        const float4 s4 = *(const float4*)(sc + k0), h4 = *(const float4*)(sh + k0);
#pragma unroll
        for (int r = 0; r < RPW; ++r) {
          float4 v = *(const float4*)(src0 + (size_t)r * 1024 + k0);
          y[r][0] = v.x * rstd[r] * gk.x * (1.f + s4.x) + h4.x; y[r][1] = v.y * rstd[r] * gk.y * (1.f + s4.y) + h4.y;
          y[r][2] = v.z * rstd[r] * gk.z * (1.f + s4.z) + h4.z; y[r][3] = v.w * rstd[r] * gk.w * (1.f + s4.w) + h4.w;
          *(uint2*)(hx + (size_t)(row0 + r) * 1024 + k0) = make_uint2(pack2(y[r][0], y[r][1]), pack2(y[r][2], y[r][3]));
        }
      }
#pragma unroll
      for (int e = 0; e < 4; ++e) {
        const float* wr = win + (size_t)(k0 + e) * NIN + 2816;
        float w[16];
#pragma unroll
        for (int q = 0; q < 4; ++q) { float4 t4 = *(const float4*)(wr + 4 * q); w[4 * q] = t4.x; w[4 * q + 1] = t4.y; w[4 * q + 2] = t4.z; w[4 * q + 3] = t4.w; }
#pragma unroll
        for (int r = 0; r < RPW; ++r)
#pragma unroll
          for (int q = 0; q < 16; ++q) g[r][q] += y[r][e] * w[q];
      }
    }
#pragma unroll
    for (int r = 0; r < RPW; ++r) {
      float mine = 0.f;
#pragma unroll
      for (int j = 0; j < 16; ++j) { float s2 = wave_sum_u(g[r][j]); if (lane == j) mine = s2; }
      if (lane < 16) gif[(size_t)(row0 + r) * 16 + lane] = mine;
    }
  }
}

DEVI void phase2(const Params& p, unsigned char* smem, const XcdMap& xm) {
  const int lane = threadIdx.x & 63, warp = threadIdx.x >> 6, wm = warp >> 1, wn = warp & 1;
  const bf16_t* hx = (const bf16_t*)(p.ws + R_HX);
  const bf16_t* wt = (const bf16_t*)(p.ws + R_WIN);
  bf16_t* prw = (bf16_t*)p.out;
  bf16_t* pqk = (bf16_t*)(p.ws + R_PQK);
  bf16_t* pv = (bf16_t*)(p.ws + R_PV);
  bf16_t* po = (bf16_t*)(p.ws + O_PO);
  bf16_t* pg = (bf16_t*)(p.ws + O_PG);
  for_tiles_xcd(xm, 130, 42, 5, 6, [&](int mt, int nt) {
    if (mt < 2 && nt >= 22) return;
    f32x4 acc[4][4];
    zero_acc(acc);
    gemm_core(hx + (size_t)mt * 128 * 1024, 1024, wt + (size_t)nt * 128 * 1024, 1024, 1024, acc, smem);
    bf16_t* dst; int ld, nb; int rofs = 0; bool sg = false;
    if (nt < 14) { dst = prw; ld = 1792; nb = nt * 128; }
    else if (nt < 18) { dst = pqk; ld = 512; nb = (nt - 14) * 128; }
    else if (nt < 22) { dst = pv; ld = 512; nb = (nt - 18) * 128; }
    else if (nt < 26) { dst = po; ld = 512; nb = (nt - 22) * 128; rofs = T_CTX; }
    else { dst = pg; ld = 2048; nb = (nt - 26) * 128; rofs = T_CTX; sg = true; }
    bf16_t(*Ct)[136] = (bf16_t(*)[136])smem;
#pragma unroll
    for (int i = 0; i < 4; ++i) {
#pragma unroll
      for (int j = 0; j < 4; ++j) {
        f32x4 v = acc[i][j];
        if (sg) { v[0] = sigm(v[0]); v[1] = sigm(v[1]); v[2] = sigm(v[2]); v[3] = sigm(v[3]); }
        *(uint2*)&Ct[wm * 64 + i * 16 + (lane & 15)][wn * 64 + j * 16 + (lane >> 4) * 4] = make_uint2(pack2(v[0], v[1]), pack2(v[2], v[3]));
      }
    }
    __syncthreads();
#pragma unroll
    for (int q = 0; q < 8; ++q) {
      const int pc = threadIdx.x + 256 * q; const int r = pc >> 4, c8 = (pc & 15) * 8;
      const int row = mt * 128 + r - rofs;
      *(u32x4*)(dst + (size_t)row * ld + nb + c8) = *(const u32x4*)&Ct[r][c8];
    }
    __syncthreads();
  });
}

DEVI void ml_qk8(const Params& p, int c, int j, int chan, float* o) {
  const bf16_t* pqk = (const bf16_t*)(p.ws + R_PQK);
  int row = ml_row(c, j);
  bool hp, hn; int rp, rn;
  if (c < 4) { hp = row > 0; hn = row < T_CTX - 1; rp = row - 1; rn = row + 1; }
  else { int gr = ((c - 4) & 3) * 64 + j; hp = gr > 0; hn = gr < 255; rp = row - 64; rn = row + 64; }
  const float* cw = p.in[I_MCONV];
  float cur[8], pr[8], nx[8];
  unpack8(*(const uint4*)(pqk + (size_t)row * 512 + chan), cur);
  if (hp) unpack8(*(const uint4*)(pqk + (size_t)rp * 512 + chan), pr);
  if (hn) unpack8(*(const uint4*)(pqk + (size_t)rn * 512 + chan), nx);
#pragma unroll
  for (int e = 0; e < 8; ++e) {
    float v = cw[512 + chan + e] * cur[e];
    if (hp) v += cw[chan + e] * pr[e];
    if (hn) v += cw[1024 + chan + e] * nx[e];
    o[e] = siluf(v);
  }
}

DEVI void phase3(const Params& p, unsigned char* smem) {
  bf16_t(*KT)[72] = (bf16_t(*)[72])smem;
  bf16_t(*VwT)[72] = (bf16_t(*)[72])(smem + 64 * 72 * 2);
  float* wgt = (float*)(smem + 64 * 72 * 2 + 256 * 72 * 2);
  const int tid = threadIdx.x, lane = tid & 63, warp = tid >> 6;
  const float* gif = (const float*)(p.ws + R_GIF);
  const bf16_t* pv = (const bf16_t*)(p.ws + R_PV);
  float* U = (float*)(p.ws + R_U);
  float* NT = (float*)(p.ws + O_NT);
  float* bend = (float*)(p.ws + O_BEND);
  float* mloc = (float*)(p.ws + O_MLOC);
  for (int it = blockIdx.x; it < 260 * 4; it += gridDim.x) {
    int c = it >> 2, h = it & 3;
    if (warp < 2) {
      int dir = warp; int j = dir ? 63 - lane : lane;
      int row = ml_row(c, j);
      float ig = gif[(size_t)row * 16 + dir * 4 + h] + p.in[I_MIB][dir * 4 + h];
      float lf = logsig(gif[(size_t)row * 16 + 8 + dir * 4 + h] + p.in[I_MFB][dir * 4 + h]);
      float b = lf;
#pragma unroll
      for (int o = 1; o < 64; o <<= 1) { float t = __shfl_up(b, o); if (lane >= o) b += t; }
      float be = __shfl(b, 63);
      float ge = be - b + ig;
      float ml = wave_max(ge);
      wgt[dir * 64 + j] = expf(ge - ml);
      if (lane == 0) { int sc = ml_sc(c, dir); bend[sc * 8 + dir * 4 + h] = be; mloc[sc * 8 + dir * 4 + h] = ml; }
    }
    __syncthreads();
    {
      int j = tid >> 2, part = tid & 3;
      float f[8];
#pragma unroll
      for (int q = 0; q < 2; ++q) {
        int d0 = part * 16 + q * 8;
        ml_qk8(p, c, j, 256 + h * 64 + d0, f);
#pragma unroll
        for (int e = 0; e < 8; ++e) KT[d0 + e][j] = f2bf(f[e] * 0.125f);
      }
      int row = ml_row(c, j);
      float w0 = wgt[j], w1 = wgt[64 + j];
#pragma unroll
      for (int q = 0; q < 4; ++q) {
        int v0 = part * 32 + q * 8;
        unpack8(*(const uint4*)(pv + (size_t)row * 512 + h * 128 + v0), f);
#pragma unroll
        for (int e = 0; e < 8; ++e) { VwT[v0 + e][j] = f2bf(f[e] * w0); VwT[128 + v0 + e][j] = f2bf(f[e] * w1); }
      }
    }
    __syncthreads();
#pragma unroll
    for (int dir = 0; dir < 2; ++dir) {
      int sc = ml_sc(c, dir);
      float* Ud = U + ((size_t)sc * 8 + dir * 4 + h) * 8192;
#pragma unroll
      for (int vi = 0; vi < 2; ++vi) {
        int vt = warp * 2 + vi;
        bf16x8 bv[2];
#pragma unroll
        for (int ks = 0; ks < 2; ++ks) bv[ks] = *(const bf16x8*)&VwT[dir * 128 + vt * 16 + (lane & 15)][ks * 32 + (lane >> 4) * 8];
#pragma unroll
        for (int dt = 0; dt < 4; ++dt) {
          f32x4 a = {0.f, 0.f, 0.f, 0.f};
#pragma unroll
          for (int ks = 0; ks < 2; ++ks) {
            bf16x8 ak = *(const bf16x8*)&KT[dt * 16 + (lane & 15)][ks * 32 + (lane >> 4) * 8];
            a = __builtin_amdgcn_mfma_f32_16x16x32_bf16(ak, bv[ks], a, 0, 0, 0);
          }
          *(float4*)(Ud + (size_t)(vt * 16 + (lane & 15)) * 64 + dt * 16 + (lane >> 4) * 4) = make_float4(a[0], a[1], a[2], a[3]);
        }
      }
    }
    if (tid < 128) {
      int dir = tid >> 6, d = tid & 63; float s = 0.f;
      for (int j = 0; j < 64; ++j) s += wgt[dir * 64 + j] * bf2f(KT[d][j]);
      NT[((size_t)ml_sc(c, dir) * 8 + dir * 4 + h) * 64 + d] = s;
    }
    __syncthreads();
  }
}

template <bool DRY> DEVI void phase4(const Params& p) {
  const bool wr = !DRY || (p.in[I_FG][0] == 1234.5f);
  float* U = (float*)(p.ws + R_U);
  float* NT = (float*)(p.ws + O_NT);
  const float* bend = (const float*)(p.ws + O_BEND);
  const float* mloc = (const float*)(p.ws + O_MLOC);
  float* mst = (float*)(p.ws + O_MST);
  for (int g = blockIdx.x * 256 + threadIdx.x; g < 8 * 8256; g += gridDim.x * 256) {
    int pr = g / 8256, e = g % 8256;
    float* base; size_t stride;
    if (e < 8192) { base = U + (size_t)pr * 8192 + e; stride = 8 * 8192; }
    else { base = NT + (size_t)pr * 64 + (e - 8192); stride = 8 * 64; }
    float m = 0.f, C = 0.f;
    for (int sc = 0; sc < 260; sc += 20) {
      float u[20];
#pragma unroll
      for (int q = 0; q < 20; ++q) u[q] = base[(size_t)(sc + q) * stride];
#pragma unroll
      for (int q = 0; q < 20; ++q) {
        float be = bend[(sc + q) * 8 + pr], ml = mloc[(sc + q) * 8 + pr];
        float mn = fmaxf(be + m, ml);
        float keep = expf(be + m - mn), s = expf(ml - mn);
        if (wr) base[(size_t)(sc + q) * stride] = C;
        if (wr && e == 0) mst[(sc + q) * 8 + pr] = m;
        C = keep * C + s * u[q];
        m = mn;
      }
    }
  }
}

template <bool DRY> DEVI void phase5(const Params& p, unsigned char* smem) {
  const bool wr = !DRY || (p.in[I_FG][0] == 1234.5f);
  bf16_t(*Qs)[72] = (bf16_t(*)[72])smem;
  bf16_t(*Ks)[72] = (bf16_t(*)[72])(smem + 9216);
  bf16_t(*Pm)[72] = (bf16_t(*)[72])(smem + 2 * 9216);
  bf16_t(*VT)[72] = (bf16_t(*)[72])(smem + 3 * 9216);
  float* evec = (float*)(smem + 3 * 9216 + 144 * 72 * 2);
  float* Mvec = evec + 128;
  float* bvec = Mvec + 128;
  const int tid = threadIdx.x, lane = tid & 63, warp = tid >> 6;
  const float* gif = (const float*)(p.ws + R_GIF);
  const bf16_t* pv = (const bf16_t*)(p.ws + R_PV);
  const bf16_t* po = (const bf16_t*)(p.ws + O_PO);
  bf16_t* yb = (bf16_t*)(p.ws + R_YA);
  const float* U = (const float*)(p.ws + R_U);
  const float* NT = (const float*)(p.ws + O_NT);
  const float* mst = (const float*)(p.ws + O_MST);
  for (int it = blockIdx.x; it < 256 * 4; it += gridDim.x) {
    int c = 4 + (it >> 2), h = it & 3;
    if (warp < 2) {
      int dir = warp; int j = dir ? 63 - lane : lane;
      int row = ml_row(c, j);
      float ig = gif[(size_t)row * 16 + dir * 4 + h] + p.in[I_MIB][dir * 4 + h];
      float lf = logsig(gif[(size_t)row * 16 + 8 + dir * 4 + h] + p.in[I_MFB][dir * 4 + h]);
      float b = lf;
#pragma unroll
      for (int o = 1; o < 64; o <<= 1) { float t = __shfl_up(b, o); if (lane >= o) b += t; }
      float e = ig - b;
      float pm = e;
#pragma unroll
      for (int o = 1; o < 64; o <<= 1) { float t = __shfl_up(pm, o); if (lane >= o) pm = fmaxf(pm, t); }
      float m0 = mst[ml_sc(c, dir) * 8 + dir * 4 + h];
      evec[dir * 64 + j] = e; Mvec[dir * 64 + j] = fmaxf(m0, pm); bvec[dir * 64 + j] = b;
    }
    {
      int j = tid >> 2, part = tid & 3;
      float f[8];
#pragma unroll
      for (int q = 0; q < 2; ++q) {
        int d0 = part * 16 + q * 8;
        ml_qk8(p, c, j, h * 64 + d0, f);
        *(uint4*)&Qs[j][d0] = pack8(f);
        ml_qk8(p, c, j, 256 + h * 64 + d0, f);
#pragma unroll
        for (int e = 0; e < 8; ++e) f[e] *= 0.125f;
        *(uint4*)&Ks[j][d0] = pack8(f);
      }
      int row = ml_row(c, j);
#pragma unroll
      for (int q = 0; q < 4; ++q) {
        int v0 = part * 32 + q * 8;
        unpack8(*(const uint4*)(pv + (size_t)row * 512 + h * 128 + v0), f);
#pragma unroll
        for (int e = 0; e < 8; ++e) VT[v0 + e][j] = f2bf(f[e]);
      }
      for (int i = tid; i < 16 * 64; i += 256) VT[128 + (i >> 6)][i & 63] = (i < 64) ? (bf16_t)0x3f80 : (bf16_t)0;
    }
    __syncthreads();
    const int jl = warp * 16 + (lane & 15);
    f32x4 s0[4];
    bf16x8 qf[2];
#pragma unroll
    for (int ks = 0; ks < 2; ++ks) qf[ks] = *(const bf16x8*)&Qs[jl][ks * 32 + (lane >> 4) * 8];
#pragma unroll
    for (int st = 0; st < 4; ++st) {
      f32x4 a = {0.f, 0.f, 0.f, 0.f};
#pragma unroll
      for (int ks = 0; ks < 2; ++ks) {
        bf16x8 kf = *(const bf16x8*)&Ks[st * 16 + (lane & 15)][ks * 32 + (lane >> 4) * 8];
        a = __builtin_amdgcn_mfma_f32_16x16x32_bf16(kf, qf[ks], a, 0, 0, 0);
      }
      s0[st] = a;
    }
    f32x4 ysum[8];
#pragma unroll
    for (int vt = 0; vt < 8; ++vt) ysum[vt] = f32x4{0.f, 0.f, 0.f, 0.f};
#pragma unroll 1
    for (int dir = 0; dir < 2; ++dir) {
      float Mj = Mvec[dir * 64 + jl], bj = bvec[dir * 64 + jl];
      float m0 = mst[ml_sc(c, dir) * 8 + dir * 4 + h];
#pragma unroll
      for (int st = 0; st < 4; ++st) {
        float pvv[4];
#pragma unroll
        for (int r = 0; r < 4; ++r) {
          int s = st * 16 + (lane >> 4) * 4 + r;
          bool ok = dir == 0 ? (s <= jl) : (s >= jl);
          pvv[r] = ok ? s0[st][r] * expf(evec[dir * 64 + s] - Mj) : 0.f;
        }
        *(uint2*)&Pm[jl][st * 16 + (lane >> 4) * 4] = make_uint2(pack2(pvv[0], pvv[1]), pack2(pvv[2], pvv[3]));
      }
      __syncthreads();
      bf16x8 pf[2];
#pragma unroll
      for (int ks = 0; ks < 2; ++ks) pf[ks] = *(const bf16x8*)&Pm[jl][ks * 32 + (lane >> 4) * 8];
      const float* Cst = U + ((size_t)ml_sc(c, dir) * 8 + dir * 4 + h) * 8192;
      const float* nst = NT + ((size_t)ml_sc(c, dir) * 8 + dir * 4 + h) * 64;
      float ai = expf(m0 - Mj);
      f32x4 hh[9];
#pragma unroll
      for (int vt = 0; vt < 9; ++vt) {
        f32x4 a1 = {0.f, 0.f, 0.f, 0.f}, a2 = {0.f, 0.f, 0.f, 0.f};
#pragma unroll
        for (int ks = 0; ks < 2; ++ks) {
          bf16x8 vf = *(const bf16x8*)&VT[vt * 16 + (lane & 15)][ks * 32 + (lane >> 4) * 8];
          a1 = __builtin_amdgcn_mfma_f32_16x16x32_bf16(vf, pf[ks], a1, 0, 0, 0);
          int v = vt * 16 + (lane & 15);
          const float* cp = v < 128 ? Cst + (size_t)v * 64 + ks * 32 + (lane >> 4) * 8 : nst + ks * 32 + (lane >> 4) * 8;
          float cf[8];
          if (v <= 128) {
            float4 x0 = *(const float4*)cp, x1 = *(const float4*)(cp + 4);
            cf[0] = x0.x; cf[1] = x0.y; cf[2] = x0.z; cf[3] = x0.w; cf[4] = x1.x; cf[5] = x1.y; cf[6] = x1.z; cf[7] = x1.w;
          } else {
#pragma unroll
            for (int e = 0; e < 8; ++e) cf[e] = 0.f;
          }
          uint4 pk = pack8(cf);
          bf16x8 cfr;
          cfr[0] = (short)(pk.x & 0xffff); cfr[1] = (short)(pk.x >> 16); cfr[2] = (short)(pk.y & 0xffff); cfr[3] = (short)(pk.y >> 16);
          cfr[4] = (short)(pk.z & 0xffff); cfr[5] = (short)(pk.z >> 16); cfr[6] = (short)(pk.w & 0xffff); cfr[7] = (short)(pk.w >> 16);
          a2 = __builtin_amdgcn_mfma_f32_16x16x32_bf16(cfr, qf[ks], a2, 0, 0, 0);
        }
#pragma unroll
        for (int r = 0; r < 4; ++r) hh[vt][r] = a1[r] + ai * a2[r];
      }
      float den = __shfl(hh[8][0], lane & 15);
      float dn = fmaxf(fabsf(den), expf(-(bj + Mj)));
      float inv = 1.f / dn;
      float ss = 0.f;
#pragma unroll
      for (int vt = 0; vt < 8; ++vt)
#pragma unroll
        for (int r = 0; r < 4; ++r) { float x = hh[vt][r] * inv; hh[vt][r] = x; ss += x * x; }
      ss += __shfl_xor(ss, 16); ss += __shfl_xor(ss, 32);
      float rs = rsqrtf(ss * (1.f / 128.f) + 1e-6f);
#pragma unroll
      for (int vt = 0; vt < 8; ++vt)
#pragma unroll
        for (int r = 0; r < 4; ++r) ysum[vt][r] += hh[vt][r] * rs * p.in[I_MNG][h * 128 + vt * 16 + (lane >> 4) * 4 + r];
      __syncthreads();
    }
    {
      int row = ml_row(c, jl) - T_CTX;
#pragma unroll
      for (int vt = 0; vt < 8; ++vt) {
        const bf16_t* op = po + (size_t)row * 512 + h * 128 + vt * 16 + (lane >> 4) * 4;
        uint2 o = *(const uint2*)op;
        float y0 = ysum[vt][0] * sigm(bflo(o.x)), y1 = ysum[vt][1] * sigm(bfhi(o.x)), y2 = ysum[vt][2] * sigm(bflo(o.y)), y3 = ysum[vt][3] * sigm(bfhi(o.y));
        if (wr) *(uint2*)(yb + (size_t)row * 512 + h * 128 + vt * 16 + (lane >> 4) * 4) = make_uint2(pack2(y0, y1), pack2(y2, y3));
      }
    }
    __syncthreads();
  }
}

DEVI void phase6(const Params& p, unsigned char* smem, int item_lo, int item_hi, int blk0, int nblk) {
  float(*rs)[65] = (float(*)[65])smem;
  float(*ks)[65] = (float(*)[65])(smem + 64 * 65 * 4);
  bf16_t(*TW)[72] = (bf16_t(*)[72])(smem + 2 * 64 * 65 * 4);
  bf16_t(*TA)[72] = (bf16_t(*)[72])(smem + 2 * 64 * 65 * 4 + 9216);
  bf16_t(*TG)[136] = (bf16_t(*)[136])(smem + 2 * 64 * 65 * 4 + 2 * 9216);
  float* rn = (float*)(smem + 2 * 64 * 65 * 4 + 2 * 9216 + 64 * 136 * 2);
  const int tid = threadIdx.x, lane = tid & 63, warp = tid >> 6;
  const bf16_t* prw = (const bf16_t*)p.out;
  bf16_t* SV = (bf16_t*)(p.ws + R_SV);
  float* bonus = (float*)(p.ws + O_BONUS);
  const float* cw = p.in[I_RCONV];
  const bf16_t* WUP = (const bf16_t*)(p.ws + O_WUP);
  const bf16_t* AUP = (const bf16_t*)(p.ws + O_AUP);
  const bf16_t* GUP = (const bf16_t*)(p.ws + O_GUP);
  if ((int)blockIdx.x < blk0) return;
  for (int it = item_lo + ((int)blockIdx.x - blk0); it < item_hi; it += nblk) {
    int tile = it >> 3, head = it & 7;
    int row0 = tile * 64;
    int seg0 = tile < 4 ? 0 : row0, seg1 = tile < 4 ? T_CTX : row0 + 64;
#pragma unroll 1
    for (int ub = 0; ub < 2; ++ub) {
      u32x4 lc[7], lp[7], ln[7];
#pragma unroll
      for (int it7 = 0; it7 < 7; ++it7) {
        const int u = warp + 4 * (ub * 7 + it7);
        const int grp = u >> 3;
        const int j = (u & 7) * 8 + (lane >> 3), q = grp * 8 + (lane & 7);
        const int row = row0 + j;
        const int col = q < 24 ? (q >> 3) * 512 + head * 64 + (q & 7) * 8 : 1536 + (q - 24) * 8;
        const bool hp = row > seg0, hn = row < seg1 - 1;
        lc[it7] = *(const u32x4*)(prw + (size_t)row * 1792 + col);
        lp[it7] = hp ? *(const u32x4*)(prw + (size_t)(row - 1) * 1792 + col) : u32x4{0u, 0u, 0u, 0u};
        ln[it7] = hn ? *(const u32x4*)(prw + (size_t)(row + 1) * 1792 + col) : u32x4{0u, 0u, 0u, 0u};
      }
#pragma unroll
      for (int it7 = 0; it7 < 7; ++it7) {
        const int u = warp + 4 * (ub * 7 + it7);
        const int grp = u >> 3;
        const int j = (u & 7) * 8 + (lane >> 3), q = grp * 8 + (lane & 7);
        const int row = row0 + j;
        const int col = q < 24 ? (q >> 3) * 512 + head * 64 + (q & 7) * 8 : 1536 + (q - 24) * 8;
        float cur[8], pr[8], nx[8], o[8];
        unpack8(make_uint4(lc[it7][0], lc[it7][1], lc[it7][2], lc[it7][3]), cur);
        unpack8(make_uint4(lp[it7][0], lp[it7][1], lp[it7][2], lp[it7][3]), pr);
        unpack8(make_uint4(ln[it7][0], ln[it7][1], ln[it7][2], ln[it7][3]), nx);
        {
          float4 c0 = *(const float4*)(cw + col), c1 = *(const float4*)(cw + col + 4);
          float4 d0 = *(const float4*)(cw + 1792 + col), d1 = *(const float4*)(cw + 1792 + col + 4);
          float4 e0 = *(const float4*)(cw + 3584 + col), e1 = *(const float4*)(cw + 3584 + col + 4);
          float wp[8] = {c0.x, c0.y, c0.z, c0.w, c1.x, c1.y, c1.z, c1.w};
          float wc[8] = {d0.x, d0.y, d0.z, d0.w, d1.x, d1.y, d1.z, d1.w};
          float wn_[8] = {e0.x, e0.y, e0.z, e0.w, e1.x, e1.y, e1.z, e1.w};
#pragma unroll
          for (int e = 0; e < 8; ++e) o[e] = wc[e] * cur[e] + wp[e] * pr[e] + wn_[e] * nx[e];
        }
        if (grp == 0) {
#pragma unroll
          for (int e = 0; e < 8; ++e) rs[j][(q & 7) * 8 + e] = o[e];
        } else if (grp == 1) {
#pragma unroll
          for (int e = 0; e < 8; ++e) ks[j][(q & 7) * 8 + e] = o[e];
        } else if (grp == 2) {
          *(uint4*)(SV + ((size_t)row * 8 + head) * SVH + 2 * 64 + (q & 7) * 8) = pack8(o);
        } else if (grp == 3) {
#pragma unroll
          for (int e = 0; e < 8; ++e) o[e] = 1.f - 2.f / (1.f + __expf(2.f * o[e]));
          *(uint4*)&TW[j][(q - 24) * 8] = pack8(o);
        } else if (grp == 4) {
          *(uint4*)&TA[j][(q - 32) * 8] = pack8(o);
        } else {
#pragma unroll
          for (int e = 0; e < 8; ++e) o[e] = sigm(o[e]);
          *(uint4*)&TG[j][(q - 40) * 8] = pack8(o);
        }
      }
    }
    __syncthreads();
    {
      int j = tid >> 2, part = tid & 3; float ss = 0.f;
#pragma unroll
      for (int e = 0; e < 16; ++e) { float v = ks[j][part * 16 + e] * p.in[I_RKK][head * 64 + part * 16 + e]; ss += v * v; }
      ss += __shfl_xor(ss, 1); ss += __shfl_xor(ss, 2);
      if (part == 0) rn[j] = 1.f / fmaxf(sqrtf(ss), 1e-12f);
    }
    __syncthreads();
    for (int pc = tid; pc < 64 * 8; pc += 256) {
      int j = pc >> 3, c8 = (pc & 7) * 8; int row = row0 + j;
      float fr[8], fk[8], fkk[8];
#pragma unroll
      for (int e = 0; e < 8; ++e) { fr[e] = rs[j][c8 + e]; fk[e] = ks[j][c8 + e]; fkk[e] = fk[e] * p.in[I_RKK][head * 64 + c8 + e] * rn[j]; }
      bf16_t* b = SV + ((size_t)row * 8 + head) * SVH;
      *(uint4*)(b + 0 * 64 + c8) = pack8(fr);
      *(uint4*)(b + 1 * 64 + c8) = pack8(fk);
      *(uint4*)(b + 3 * 64 + c8) = pack8(fkk);
    }
    {
      const int jl = warp * 16 + (lane & 15); const int row = row0 + jl;
      bf16x8 tw[2], ta[2], tg[4];
#pragma unroll
      for (int s2 = 0; s2 < 2; ++s2) { tw[s2] = *(const bf16x8*)&TW[jl][s2 * 32 + (lane >> 4) * 8]; ta[s2] = *(const bf16x8*)&TA[jl][s2 * 32 + (lane >> 4) * 8]; }
#pragma unroll
      for (int s2 = 0; s2 < 4; ++s2) tg[s2] = *(const bf16x8*)&TG[jl][s2 * 32 + (lane >> 4) * 8];
      __syncthreads();
      bf16_t(*OB)[64][72] = (bf16_t(*)[64][72])(smem + 2 * 64 * 65 * 4);
      float bon[2] = {0.f, 0.f};
#pragma unroll
      for (int dir = 0; dir < 2; ++dir) {
#pragma unroll
        for (int ct = 0; ct < 4; ++ct) {
          const int ch0 = ct * 16 + (lane >> 4) * 4;
          const int C0 = head * 64 + ch0;
          if (dir == 0) {
            f32x4 a = {0.f, 0.f, 0.f, 0.f};
#pragma unroll
            for (int s2 = 0; s2 < 4; ++s2) {
              bf16x8 wf = *(const bf16x8*)(GUP + (size_t)(head * 64 + ct * 16 + (lane & 15)) * 128 + s2 * 32 + (lane >> 4) * 8);
              a = __builtin_amdgcn_mfma_f32_16x16x32_bf16(wf, tg[s2], a, 0, 0, 0);
            }
            *(uint2*)&OB[2][jl][ch0] = make_uint2(pack2(a[0], a[1]), pack2(a[2], a[3]));
          }
          f32x4 aw = {0.f, 0.f, 0.f, 0.f}, aa = {0.f, 0.f, 0.f, 0.f};
#pragma unroll
          for (int s2 = 0; s2 < 2; ++s2) {
            size_t wo = (size_t)(dir * 512 + head * 64 + ct * 16 + (lane & 15)) * 64 + s2 * 32 + (lane >> 4) * 8;
            bf16x8 wf = *(const bf16x8*)(WUP + wo);
            bf16x8 af = *(const bf16x8*)(AUP + wo);
            aw = __builtin_amdgcn_mfma_f32_16x16x32_bf16(wf, tw[s2], aw, 0, 0, 0);
            aa = __builtin_amdgcn_mfma_f32_16x16x32_bf16(af, ta[s2], aa, 0, 0, 0);
          }
          const float4 w04 = *(const float4*)(p.in[I_RW0] + dir * 512 + C0), a04 = *(const float4*)(p.in[I_RA0] + dir * 512 + C0);
          const float4 ka4 = *(const float4*)(p.in[I_RKA] + C0), rk4 = *(const float4*)(p.in[I_RRK] + C0);
          const float w0v[4] = {w04.x, w04.y, w04.z, w04.w}, a0v[4] = {a04.x, a04.y, a04.z, a04.w};
          const float kav[4] = {ka4.x, ka4.y, ka4.z, ka4.w}, rkv[4] = {rk4.x, rk4.y, rk4.z, rk4.w};
          float we[4], av[4];
#pragma unroll
          for (int r = 0; r < 4; ++r) {
            we[r] = 0.60653066f * sigm(w0v[r] + aw[r]);
            av[r] = sigm(a0v[r] + aa[r]);
            float kv = ks[jl][ch0 + r];
            float keff = kv * (1.f + (av[r] - 1.f) * kav[r]);
            bon[dir] += rs[jl][ch0 + r] * keff * rkv[r];
          }
          *(uint2*)&OB[0][jl][ch0] = make_uint2(pack2(we[0], we[1]), pack2(we[2], we[3]));
          *(uint2*)&OB[1][jl][ch0] = make_uint2(pack2(av[0], av[1]), pack2(av[2], av[3]));
        }
        __syncthreads();
        for (int pc = tid; pc < (dir == 0 ? 3 : 2) * 64 * 8; pc += 256) {
          const int vsel = pc >> 9, j = (pc >> 3) & 63, c8 = (pc & 7) * 8;
          const int vec = vsel == 2 ? 8 : (4 + 2 * dir + vsel);
          *(u32x4*)(SV + ((size_t)(row0 + j) * 8 + head) * SVH + vec * 64 + c8) = *(const u32x4*)&OB[vsel][j][c8];
        }
        __syncthreads();
      }
#pragma unroll
      for (int dir = 0; dir < 2; ++dir) {
        float sb = bon[dir]; sb += __shfl_xor(sb, 16); sb += __shfl_xor(sb, 32);
        if (lane < 16) bonus[(size_t)row * 16 + dir * 8 + head] = sb;
      }
    }
    __syncthreads();
  }
}

struct RwVec { uint4 k, kk, w, a, v, r; };
DEVI void unpack8p(const uint4& u, f32x2* f) {
  f[0] = f32x2{bflo(u.x), bfhi(u.x)}; f[1] = f32x2{bflo(u.y), bfhi(u.y)}; f[2] = f32x2{bflo(u.z), bfhi(u.z)}; f[3] = f32x2{bflo(u.w), bfhi(u.w)};
}
DEVI f32x2 bc2(float x) { return f32x2{x, x}; }
DEVI void rw_load(RwVec& x, const bf16_t* SV, int row, int head, int dir, int i, int jg, bool need_r) {
  const bf16_t* b = SV + ((size_t)row * 8 + head) * SVH;
  x.k = *(const uint4*)(b + 1 * 64 + jg * 8);
  x.kk = *(const uint4*)(b + 3 * 64 + jg * 8);
  x.w = *(const uint4*)(b + (4 + 2 * dir) * 64 + jg * 8);
  x.a = *(const uint4*)(b + (5 + 2 * dir) * 64 + jg * 8);
  x.v = *(const uint4*)(b + 2 * 64 + i * 8);
  if (need_r) x.r = *(const uint4*)(b + 0 * 64 + jg * 8);
}

DEVI void phase7(const Params& p) {
  const int lane = threadIdx.x & 63, warp = threadIdx.x >> 6, i = lane >> 3, jg = lane & 7;
  const bf16_t* SV = (const bf16_t*)(p.ws + R_SV);
  float* Pc = (float*)p.out;
  float* Bc = (float*)((unsigned char*)p.out + OUT_BC);
  for (int it = blockIdx.x * 4 + warp; it < (NCH - 1) * 16; it += gridDim.x * 4) {
    const int chunk = it >> 4, pair = it & 15, dir = pair >> 3, head = pair & 7;
    f32x2 S[8][4], P[8][4], ka[4];
#pragma unroll
    for (int a = 0; a < 8; ++a)
#pragma unroll
      for (int c = 0; c < 4; ++c) {
        S[a][c] = f32x2{0.f, 0.f};
        P[a][c] = f32x2{(i * 8 + a == jg * 8 + 2 * c) ? 1.f : 0.f, (i * 8 + a == jg * 8 + 2 * c + 1) ? 1.f : 0.f};
      }
#pragma unroll
    for (int c = 0; c < 4; ++c) ka[c] = f32x2{p.in[I_RKA][head * 64 + jg * 8 + 2 * c], p.in[I_RKA][head * 64 + jg * 8 + 2 * c + 1]};
    RwVec nx;
    rw_load(nx, SV, rw_row(chunk * LCH, dir), head, dir, i, jg, false);
#pragma unroll 1
    for (int t = 0; t < LCH; ++t) {
      RwVec cu = nx;
      if (t + 1 < LCH) rw_load(nx, SV, rw_row(chunk * LCH + t + 1, dir), head, dir, i, jg, false);
      f32x2 kv[4], kk[4], w[4], av[4], kka[4], keff[4]; float vv[8];
      unpack8p(cu.k, kv); unpack8p(cu.kk, kk); unpack8p(cu.w, w); unpack8p(cu.a, av); unpack8(cu.v, vv);
#pragma unroll
      for (int c = 0; c < 4; ++c) {
        w[c] = f32x2{__expf(-w[c][0]), __expf(-w[c][1])};
        kka[c] = -kk[c] * av[c];
        keff[c] = kv[c] * (bc2(1.f) + (av[c] - bc2(1.f)) * ka[c]);
      }
#pragma unroll
      for (int a = 0; a < 8; ++a) {
        f32x2 sa = S[a][0] * kk[0], qa = P[a][0] * kk[0];
#pragma unroll
        for (int c = 1; c < 4; ++c) { sa += S[a][c] * kk[c]; qa += P[a][c] * kk[c]; }
        float s1 = allred8(sa[0] + sa[1]), q1 = allred8(qa[0] + qa[1]);
        const f32x2 s2 = bc2(s1), q2 = bc2(q1), v2 = bc2(vv[a]);
#pragma unroll
        for (int c = 0; c < 4; ++c) {
          S[a][c] = S[a][c] * w[c] + s2 * kka[c] + v2 * keff[c];
          P[a][c] = P[a][c] * w[c] + q2 * kka[c];
        }
      }
    }
    float* po = Pc + ((size_t)chunk * 16 + pair) * 4096;
    float* bo = Bc + ((size_t)chunk * 16 + pair) * 4096;
#pragma unroll
    for (int a = 0; a < 8; ++a) {
      *(float4*)(po + (i * 8 + a) * 64 + jg * 8) = make_float4(P[a][0][0], P[a][0][1], P[a][1][0], P[a][1][1]);
      *(float4*)(po + (i * 8 + a) * 64 + jg * 8 + 4) = make_float4(P[a][2][0], P[a][2][1], P[a][3][0], P[a][3][1]);
      *(float4*)(bo + (i * 8 + a) * 64 + jg * 8) = make_float4(S[a][0][0], S[a][0][1], S[a][1][0], S[a][1][1]);
      *(float4*)(bo + (i * 8 + a) * 64 + jg * 8 + 4) = make_float4(S[a][2][0], S[a][2][1], S[a][3][0], S[a][3][1]);
    }
  }
}

template <bool DRY> DEVI void phase8(const Params& p, unsigned char* smem) {
  const bool wr = !DRY || (p.in[I_FG][0] == 1234.5f);
  float(*Sb)[16][68] = (float(*)[16][68])smem;
  const int tid = threadIdx.x, lane = tid & 63, warp = tid >> 6, q = lane >> 4, c16 = lane & 15;
  const float* Pc = (const float*)p.out;
  float* Bc = (float*)((unsigned char*)p.out + OUT_BC);
  constexpr int NS = NCH - 1;
  const size_t CS = (size_t)16 * 4096;
  for (int it = blockIdx.x; it < 64; it += gridDim.x) {
    const int pair = it >> 2, rg = it & 3;
    const float* Pp = Pc + (size_t)pair * 4096 + q * 64 + warp * 16 + c16;
    float* Bp = Bc + (size_t)pair * 4096 + (size_t)(rg * 16 + q * 4) * 64 + warp * 16 + c16;
    __syncthreads();
    {
      const int row = tid >> 4, c4 = (tid & 15) * 4;
      float4 v = *(const float4*)(Bc + (size_t)pair * 4096 + (size_t)(rg * 16 + row) * 64 + c4);
      Sb[0][row][c4] = v.x; Sb[0][row][c4 + 1] = v.y; Sb[0][row][c4 + 2] = v.z; Sb[0][row][c4 + 3] = v.w;
    }
    float pa[16], pb[16]; f32x4 ba, bb;
#pragma unroll
    for (int s2 = 0; s2 < 16; ++s2) { pa[s2] = Pp[CS + s2 * 256]; pb[s2] = Pp[2 * CS + s2 * 256]; }
#pragma unroll
    for (int r = 0; r < 4; ++r) { ba[r] = Bp[CS + r * 64]; bb[r] = Bp[2 * CS + r * 64]; }
    __syncthreads();
#define P8_STEP(c, pp, bv)                                                                                  \
    {                                                                                                        \
      const int rb = ((c) - 1) & 1;                                                                          \
      f32x4 acc0 = bv, acc1 = f32x4{0.f, 0.f, 0.f, 0.f};                                                     \
      _Pragma("unroll") for (int s2 = 0; s2 < 16; s2 += 2) {                                                 \
        acc0 = __builtin_amdgcn_mfma_f32_16x16x4f32(Sb[rb][c16][4 * s2 + q], pp[s2], acc0, 0, 0, 0);         \
        acc1 = __builtin_amdgcn_mfma_f32_16x16x4f32(Sb[rb][c16][4 * s2 + 4 + q], pp[s2 + 1], acc1, 0, 0, 0); \
      }                                                                                                      \
      acc0 += acc1;                                                                                          \
      if ((c) + 2 < NS) {                                                                                    \
        _Pragma("unroll") for (int s2 = 0; s2 < 16; ++s2) pp[s2] = Pp[(size_t)((c) + 2) * CS + s2 * 256];    \
        _Pragma("unroll") for (int r = 0; r < 4; ++r) bv[r] = Bp[(size_t)((c) + 2) * CS + r * 64];           \
      }                                                                                                      \
      _Pragma("unroll") for (int r = 0; r < 4; ++r) {                                                        \
        Sb[rb ^ 1][q * 4 + r][warp * 16 + c16] = acc0[r];                                                    \
        if (wr) Bp[(size_t)(c) * CS + r * 64] = acc0[r];                                                     \
      }                                                                                                      \
      __syncthreads();                                                                                       \
    }
    for (int c = 1; c < NS; c += 2) {
      P8_STEP(c, pa, ba)
      if (c + 1 < NS) P8_STEP(c + 1, pb, bb)
    }
#undef P8_STEP
  }
}

DEVI void phase9(const Params& p) {
  const int lane = threadIdx.x & 63, warp = threadIdx.x >> 6, i = lane >> 3, jg = lane & 7;
  const bf16_t* SV = (const bf16_t*)(p.ws + R_SV);
  const float* Bc = (const float*)((unsigned char*)p.out + OUT_BC);
  bf16_t* odir = (bf16_t*)p.out;
  for (int it = blockIdx.x * 4 + warp; it < NCH * 16; it += gridDim.x * 4) {
    const int chunk = it >> 4, pair = it & 15, dir = pair >> 3, head = pair & 7;
    f32x2 S[8][4], ka[4];
    if (chunk == 0) {
#pragma unroll
      for (int a = 0; a < 8; ++a)
#pragma unroll
        for (int c = 0; c < 4; ++c) S[a][c] = f32x2{0.f, 0.f};
    } else {
      const float* bs = Bc + ((size_t)(chunk - 1) * 16 + pair) * 4096;
#pragma unroll
      for (int a = 0; a < 8; ++a) {
        float4 x0 = *(const float4*)(bs + (i * 8 + a) * 64 + jg * 8), x1 = *(const float4*)(bs + (i * 8 + a) * 64 + jg * 8 + 4);
        S[a][0] = f32x2{x0.x, x0.y}; S[a][1] = f32x2{x0.z, x0.w}; S[a][2] = f32x2{x1.x, x1.y}; S[a][3] = f32x2{x1.z, x1.w};
      }
    }
#pragma unroll
    for (int c = 0; c < 4; ++c) ka[c] = f32x2{p.in[I_RKA][head * 64 + jg * 8 + 2 * c], p.in[I_RKA][head * 64 + jg * 8 + 2 * c + 1]};
    RwVec nx;
    rw_load(nx, SV, rw_row(chunk * LCH, dir), head, dir, i, jg, true);
#pragma unroll 1
    for (int t = 0; t < LCH; ++t) {
      RwVec cu = nx;
      const int row = rw_row(chunk * LCH + t, dir);
      if (t + 1 < LCH) rw_load(nx, SV, rw_row(chunk * LCH + t + 1, dir), head, dir, i, jg, true);
      f32x2 kv[4], kk[4], w[4], av[4], rr[4], kka[4], keff[4]; float vv[8];
      unpack8p(cu.k, kv); unpack8p(cu.kk, kk); unpack8p(cu.w, w); unpack8p(cu.a, av); unpack8p(cu.r, rr); unpack8(cu.v, vv);
#pragma unroll
      for (int c = 0; c < 4; ++c) {
        w[c] = f32x2{__expf(-w[c][0]), __expf(-w[c][1])};
        kka[c] = -kk[c] * av[c];
        keff[c] = kv[c] * (bc2(1.f) + (av[c] - bc2(1.f)) * ka[c]);
      }
      float ov = 0.f;
#pragma unroll
      for (int a = 0; a < 8; ++a) {
        f32x2 sa = S[a][0] * kk[0];
#pragma unroll
        for (int c = 1; c < 4; ++c) sa += S[a][c] * kk[c];
        const float s1 = allred8(sa[0] + sa[1]);
        const f32x2 s2 = bc2(s1), v2 = bc2(vv[a]);
        f32x2 oa = f32x2{0.f, 0.f};
#pragma unroll
        for (int c = 0; c < 4; ++c) {
          S[a][c] = S[a][c] * w[c] + s2 * kka[c] + v2 * keff[c];
          oa += S[a][c] * rr[c];
        }
        const float o = allred8(oa[0] + oa[1]);
        if (jg == a) ov = o;
      }
      if (row >= T_CTX) odir[((size_t)dir * T_LAT + (row - T_CTX)) * 512 + head * 64 + i * 8 + jg] = f2bf(ov);
    }
  }
}

DEVI void phase10(const Params& p) {
  const int lane = threadIdx.x & 63, warp = threadIdx.x >> 6;
  const bf16_t* odir = (const bf16_t*)p.out;
  const bf16_t* SV = (const bf16_t*)(p.ws + R_SV);
  const float* bonus = (const float*)(p.ws + O_BONUS);
  bf16_t* ya = (bf16_t*)(p.ws + O_PO);
  const int head = lane >> 3, c8 = (lane & 7) * 8, C0 = lane * 8;
#pragma unroll 2
  for (int t = blockIdx.x * 4 + warp; t < T_LAT; t += gridDim.x * 4) {
    const int row = t + T_CTX;
    const bf16_t* b = SV + ((size_t)row * 8 + head) * SVH;
    float v[8], g[8], y[8];
    unpack8(*(const uint4*)(b + 2 * 64 + c8), v);
    unpack8(*(const uint4*)(b + 8 * 64 + c8), g);
    float bs = bonus[(size_t)row * 16 + head] + bonus[(size_t)row * 16 + 8 + head];
#pragma unroll
    for (int e = 0; e < 8; ++e) y[e] = bs * v[e];
#pragma unroll
    for (int dir = 0; dir < 2; ++dir) {
      float o[8];
      unpack8(*(const uint4*)(odir + ((size_t)dir * T_LAT + t) * 512 + C0), o);
      float s = 0.f;
#pragma unroll
      for (int e = 0; e < 8; ++e) s += o[e];
      s = allred8(s);
      float mu = s * (1.f / 64.f);
      float q = 0.f;
#pragma unroll
      for (int e = 0; e < 8; ++e) { o[e] -= mu; q += o[e] * o[e]; }
      q = allred8(q);
      float rsd = rsqrtf(q * (1.f / 64.f) + 64e-5f);
#pragma unroll
      for (int e = 0; e < 8; ++e) y[e] += o[e] * rsd * p.in[I_RLNW][C0 + e] + p.in[I_RLNB][C0 + e];
    }
#pragma unroll
    for (int e = 0; e < 8; ++e) y[e] *= g[e];
    *(uint4*)(ya + (size_t)t * 512 + C0) = pack8(y);
  }
}

DEVI void phase11(const Params& p, unsigned char* smem, const XcdMap& xm) {
  const int lane = threadIdx.x & 63, warp = threadIdx.x >> 6, wm = warp >> 1, wn = warp & 1;
  const bf16_t* ya = (const bf16_t*)(p.ws + O_PO);
  const bf16_t* yb = (const bf16_t*)(p.ws + R_YA);
  const bf16_t* pg = (const bf16_t*)(p.ws + O_PG);
  bf16_t* mg = (bf16_t*)(p.ws + R_MERGED);
  for_tiles_xcd(xm, 128, 8, 8, 8, [&](int mt, int nt) {
    f32x4 acc[4][4];
    zero_acc(acc);
    gemm_core(ya + (size_t)mt * 128 * 512, 512, (const bf16_t*)(p.ws + O_WBA) + (size_t)nt * 128 * 512, 512, 512, acc, smem);
#pragma unroll
    for (int i = 0; i < 4; ++i) {
      int row = mt * 128 + wm * 64 + i * 16 + (lane & 15);
#pragma unroll
      for (int j = 0; j < 4; ++j) {
        int n = nt * 128 + wn * 64 + j * 16 + (lane >> 4) * 4;
        uint2 s = *(const uint2*)(pg + (size_t)row * 2048 + n);
        *(uint2*)(mg + (size_t)row * 1024 + n) = make_uint2(pack2(acc[i][j][0] * bflo(s.x), acc[i][j][1] * bfhi(s.x)), pack2(acc[i][j][2] * bflo(s.y), acc[i][j][3] * bfhi(s.y)));
      }
    }
    zero_acc(acc);
    gemm_core(yb + (size_t)mt * 128 * 512, 512, (const bf16_t*)(p.ws + O_WBB) + (size_t)nt * 128 * 512, 512, 512, acc, smem);
#pragma unroll
    for (int i = 0; i < 4; ++i) {
      int row = mt * 128 + wm * 64 + i * 16 + (lane & 15);
#pragma unroll
      for (int j = 0; j < 4; ++j) {
        int n = nt * 128 + wn * 64 + j * 16 + (lane >> 4) * 4;
        uint2 s = *(const uint2*)(pg + (size_t)row * 2048 + 1024 + n);
        uint2 m0 = *(const uint2*)(mg + (size_t)row * 1024 + n);
        float v0 = bflo(m0.x) + acc[i][j][0] * bflo(s.x), v1 = bfhi(m0.x) + acc[i][j][1] * bfhi(s.x);
        float v2 = bflo(m0.y) + acc[i][j][2] * bflo(s.y), v3 = bfhi(m0.y) + acc[i][j][3] * bfhi(s.y);
        *(uint2*)(mg + (size_t)row * 1024 + n) = make_uint2(pack2(v0, v1), pack2(v2, v3));
      }
    }
  });
}

DEVI void phase12(const Params& p, unsigned char* smem, const XcdMap& xm) {
  float* gt = (float*)(smem + 45056);
  const int tid = threadIdx.x, lane = tid & 63, warp = tid >> 6, wm = warp >> 1, wn = warp & 1;
  for (int i = tid; i < 1024; i += 256) gt[i] = mod_val(p, 0, 2048 + i);
  __syncthreads();
  const bf16_t* mg = (const bf16_t*)(p.ws + R_MERGED);
  const float* x = p.in[I_X];
  float* x1 = p.out;
  for_tiles_xcd(xm, 128, 8, 8, 8, [&](int mt, int nt) {
    f32x4 acc[4][4];
    zero_acc(acc);
    gemm_core(mg + (size_t)mt * 128 * 1024, 1024, (const bf16_t*)(p.ws + O_WOUT) + (size_t)nt * 128 * 1024, 1024, 1024, acc, smem);
#pragma unroll
    for (int i = 0; i < 4; ++i) {
      int row = mt * 128 + wm * 64 + i * 16 + (lane & 15);
#pragma unroll
      for (int j = 0; j < 4; ++j) {
        int n = nt * 128 + wn * 64 + j * 16 + (lane >> 4) * 4;
        float4 xv = *(const float4*)(x + (size_t)row * 1024 + n);
        xv.x += gt[n] * acc[i][j][0]; xv.y += gt[n + 1] * acc[i][j][1]; xv.z += gt[n + 2] * acc[i][j][2]; xv.w += gt[n + 3] * acc[i][j][3];
        *(float4*)(x1 + (size_t)row * 1024 + n) = xv;
      }
    }
  });
}

DEVI void phase13(const Params& p, unsigned char* smem) {
  float* smod = (float*)smem;
  const int tid = threadIdx.x, lane = tid & 63, warp = tid >> 6;
  for (int i = tid; i < 2048; i += 256) smod[i] = mod_val(p, 0, 3072 + i);
  __syncthreads();
  const float* x1 = p.out;
  bf16_t* h2 = (bf16_t*)(p.ws + R_H2);
  for (int rp = blockIdx.x * 4 + warp; rp < T_LAT / 2; rp += gridDim.x * 4) {
    float h[2][16]; float ss[2] = {0.f, 0.f};
#pragma unroll
    for (int u = 0; u < 2; ++u)
#pragma unroll
      for (int i = 0; i < 4; ++i) {
        float4 v = *(const float4*)(x1 + (size_t)(rp * 2 + u) * 1024 + i * 256 + lane * 4);
        h[u][4 * i] = v.x; h[u][4 * i + 1] = v.y; h[u][4 * i + 2] = v.z; h[u][4 * i + 3] = v.w;
        ss[u] += v.x * v.x + v.y * v.y + v.z * v.z + v.w * v.w;
      }
#pragma unroll
    for (int u = 0; u < 2; ++u) {
      const int row = rp * 2 + u;
      const float rstd = rsqrtf(wave_sum_u(ss[u]) * (1.f / 1024.f) + 1e-6f);
#pragma unroll
      for (int i = 0; i < 4; ++i) {
#pragma unroll
        for (int e = 0; e < 4; ++e) {
          int k = i * 256 + lane * 4 + e;
          float y = h[u][4 * i + e] * rstd * p.in[I_N2G][k];
          h[u][4 * i + e] = y * (1.f + smod[1024 + k]) + smod[k];
        }
        *(uint2*)(h2 + (size_t)row * 1024 + i * 256 + lane * 4) = make_uint2(pack2(h[u][4 * i], h[u][4 * i + 1]), pack2(h[u][4 * i + 2], h[u][4 * i + 3]));
      }
    }
  }
}

DEVI void phase14(const Params& p, unsigned char* smem, const XcdMap& xm) {
  bf16_t(*Qt)[136] = (bf16_t(*)[136])smem;
  float* Sc = (float*)smem;
  const int tid = threadIdx.x, lane = tid & 63, warp = tid >> 6, wm = warp >> 1, wn = warp & 1;
  const bf16_t* h2 = (const bf16_t*)(p.ws + R_H2);
  const bf16_t* keys = (const bf16_t*)(p.ws + O_KEYS);
  float* tops = (float*)(p.ws + R_TOPS);
  int* topi = (int*)(p.ws + R_TOPI);
  for_tiles_xcd(xm, 128, 16, 8, 8, [&](int mt, int hp) {
    f32x4 acc[4][4];
    zero_acc(acc);
    gemm_core(h2 + (size_t)mt * 128 * 1024, 1024, (const bf16_t*)(p.ws + O_WQ) + (size_t)hp * 128 * 1024, 1024, 1024, acc, smem);
#pragma unroll
    for (int i = 0; i < 4; ++i)
#pragma unroll
      for (int j = 0; j < 4; ++j)
        *(uint2*)&Qt[wm * 64 + i * 16 + (lane & 15)][wn * 64 + j * 16 + (lane >> 4) * 4] =
            make_uint2(pack2(acc[i][j][0], acc[i][j][1]), pack2(acc[i][j][2], acc[i][j][3]));
    __syncthreads();
    zero_acc(acc);
#pragma unroll
    for (int ks = 0; ks < 4; ++ks) {
      bf16x8 qf[4], kf[4];
#pragma unroll
      for (int i = 0; i < 4; ++i) qf[i] = *(const bf16x8*)&Qt[wm * 64 + i * 16 + (lane & 15)][ks * 32 + (lane >> 4) * 8];
#pragma unroll
      for (int j = 0; j < 4; ++j) kf[j] = *(const bf16x8*)(keys + ((size_t)hp * 128 + wn * 64 + j * 16 + (lane & 15)) * 128 + ks * 32 + (lane >> 4) * 8);
#pragma unroll
      for (int i = 0; i < 4; ++i)
#pragma unroll
        for (int j = 0; j < 4; ++j) acc[i][j] = __builtin_amdgcn_mfma_f32_16x16x32_bf16(kf[j], qf[i], acc[i][j], 0, 0, 0);
    }
    __syncthreads();
#pragma unroll
    for (int i = 0; i < 4; ++i)
#pragma unroll
      for (int j = 0; j < 4; ++j) {
        float* d = Sc + (wm * 64 + i * 16 + (lane & 15)) * 129 + wn * 64 + j * 16 + (lane >> 4) * 4;
        d[0] = acc[i][j][0]; d[1] = acc[i][j][1]; d[2] = acc[i][j][2]; d[3] = acc[i][j][3];
      }
    __syncthreads();
    {
      const int row = tid & 127, half = tid >> 7;
      float* hp_ = Sc + row * 129 + half * 64;
      float bv[16]; int bi[16];
#pragma unroll
      for (int r = 0; r < 16; ++r) {
        float best = -INFINITY; int b2 = 0;
#pragma unroll 8
        for (int k = 0; k < 64; ++k) { float v = hp_[k]; if (v > best) { best = v; b2 = k; } }
        bv[r] = best; bi[r] = b2 + half * 64; hp_[b2] = -INFINITY;
      }
#pragma unroll
      for (int r = 0; r < 16; ++r) { hp_[r] = bv[r]; hp_[16 + r] = __int_as_float(bi[r]); }
    }
    __syncthreads();
    if (tid < 128) {
      const float* la = Sc + tid * 129; const float* lb = la + 64;
      size_t ob = ((size_t)(mt * 128 + tid) * 16 + hp) * 16;
      int ia = 0, ib = 0;
      for (int r = 0; r < 16; ++r) {
        float va = la[ia], vb = lb[ib];
        bool ta = va >= vb;
        tops[ob + r] = ta ? va : vb;
        topi[ob + r] = __float_as_int(ta ? la[16 + ia] : lb[16 + ib]);
        ia += ta ? 1 : 0; ib += ta ? 0 : 1;
      }
    }
    __syncthreads();
  });
}

template <bool DRY> DEVI void phase15(const Params& p, unsigned char* smem) {
  const bool wr = !DRY || (p.in[I_FG][0] == 1234.5f);
  float* gt = (float*)smem;
  const int tid = threadIdx.x, lane = tid & 63, warp = tid >> 6;
  for (int i = tid; i < 1024; i += 256) gt[i] = mod_val(p, 0, 5120 + i);
  __syncthreads();
  const bf16_t* __restrict__ h2 = (const bf16_t*)(p.ws + R_H2);
  const float* __restrict__ tops = (const float*)(p.ws + R_TOPS);
  const int* __restrict__ topi = (const int*)(p.ws + R_TOPI);
  const unsigned char* __restrict__ uf8 = p.ws + R_UBF;
  const unsigned char* __restrict__ vf8 = p.ws + R_VBF;
  float* xo = p.out;
  int ca, cb;
  {
    int l = lane;
    if (l < 16) { ca = 0; cb = l; } else if (l < 24) { ca = 1; cb = l - 16; } else if (l < 29) { ca = 2; cb = l - 24; }
    else if (l < 33) { ca = 3; cb = l - 29; } else if (l < 36) { ca = 4; cb = l - 33; } else if (l < 38) { ca = 5; cb = l - 36; }
    else if (l < 40) { ca = 6; cb = l - 38; } else if (l < 42) { ca = 7; cb = l - 40; } else if (l < 50) { ca = l - 34; cb = 0; }
    else { ca = 0; cb = 0; }
  }
  const int flat = ca * 16 + cb;
  for (int t = blockIdx.x * 4 + warp; t < T_LAT; t += gridDim.x * 4) {
    float hv[16], out[16];
    {
      const u32x4 hp0 = *(const u32x4*)(h2 + (size_t)t * 1024 + lane * 16);
      const u32x4 hp1 = *(const u32x4*)(h2 + (size_t)t * 1024 + lane * 16 + 8);
#pragma unroll
      for (int e = 0; e < 4; ++e) { hv[2 * e] = bflo(hp0[e]); hv[2 * e + 1] = bfhi(hp0[e]); hv[8 + 2 * e] = bflo(hp1[e]); hv[8 + 2 * e + 1] = bfhi(hp1[e]); }
    }
#pragma unroll
    for (int e = 0; e < 16; ++e) out[e] = 0.f;
#pragma unroll 1
    for (int hd = 0; hd < 8; ++hd) {
      const size_t b1 = ((size_t)t * 16 + hd * 2) * 16, b2 = b1 + 16;
      float val = lane < 50 ? tops[b1 + ca] + tops[b2 + cb] : -INFINITY;
      int idx = topi[b1 + ca] * 128 + topi[b2 + cb];
      int cnt = 0;
#pragma unroll
      for (int i = 0; i < 50; ++i) {
        float vi = rlf(val, i);
        int fi = __builtin_amdgcn_readlane(flat, i);
        cnt += ((vi > val) || (vi == val && fi < flat)) ? 1 : 0;
      }
      bool sel = lane < 50 && cnt < 16;
      float vmax = rlf(val, 0);
      float ex = sel ? __expf(val - vmax) : 0.f;
      float gsum = wave_sum_u(ex);
      float g = ex / gsum;
      unsigned long long m1 = __ballot(sel);
      int es[16];
      float gq = 0.f;
#pragma unroll
      for (int q = 0; q < 16; ++q) {
        int src = __ffsll((long long)m1) - 1; m1 &= m1 - 1;
        es[q] = __builtin_amdgcn_readlane(idx, src);
        float gg = rlf(g, src);
        if (lane == q) gq = gg;
      }
      float dm = 0.f;
      {
        u32x4 ub[16];
#pragma unroll
        for (int q = 0; q < 16; ++q) ub[q] = *(const u32x4*)(uf8 + (size_t)es[q] * 1024 + lane * 16);
#pragma unroll
        for (int q = 0; q < 16; ++q) {
          float f[16]; unpack_fp8x16(ub[q], f);
          float d0 = 0.f, d1 = 0.f;
#pragma unroll
          for (int e = 0; e < 8; ++e) { d0 += f[2 * e] * hv[2 * e]; d1 += f[2 * e + 1] * hv[2 * e + 1]; }
          float d = wave_sum_u(d0 + d1);
          if (lane == q) dm = d;
        }
      }
      dm *= (1.f / 64.f);
      float coef = gq * 0.5f * dm * (1.f + erff(dm * 0.70710678118f)) * 0.25f;
      {
        u32x4 vb[16];
#pragma unroll
        for (int q = 0; q < 16; ++q) vb[q] = *(const u32x4*)(vf8 + (size_t)es[q] * 1024 + lane * 16);
#pragma unroll
        for (int q = 0; q < 16; ++q) {
          float cf = rlf(coef, q);
          float f[16]; unpack_fp8x16(vb[q], f);
#pragma unroll
          for (int e = 0; e < 16; ++e) out[e] += cf * f[e];
        }
      }
    }
    float xs[16]; float ss = 0.f;
#pragma unroll
    for (int i = 0; i < 4; ++i) {
      int k = lane * 16 + i * 4;
      float4 v = *(const float4*)(xo + (size_t)t * 1024 + k);
      xs[4 * i] = v.x + gt[k] * out[4 * i]; xs[4 * i + 1] = v.y + gt[k + 1] * out[4 * i + 1];
      xs[4 * i + 2] = v.z + gt[k + 2] * out[4 * i + 2]; xs[4 * i + 3] = v.w + gt[k + 3] * out[4 * i + 3];
      ss += xs[4 * i] * xs[4 * i] + xs[4 * i + 1] * xs[4 * i + 1] + xs[4 * i + 2] * xs[4 * i + 2] + xs[4 * i + 3] * xs[4 * i + 3];
    }
    ss = wave_sum_u(ss);
    float rstd = rsqrtf(ss * (1.f / 1024.f) + 1e-6f);
#pragma unroll
    for (int i = 0; i < 4; ++i) {
      int k = lane * 16 + i * 4;
      float4 g4 = *(const float4*)(p.in[I_FG] + k);
      if (wr) *(float4*)(xo + (size_t)t * 1024 + k) = make_float4(xs[4 * i] * rstd * g4.x, xs[4 * i + 1] * rstd * g4.y, xs[4 * i + 2] * rstd * g4.z, xs[4 * i + 3] * rstd * g4.w);
    }
  }
}

#define XB_TMO      128
#define XB_XCNT(j)  (256  + 64 * (j))
#define XB_XSUB(j)  (1280 + 64 * (j))
#define XB_XGEN(j)  (2304 + 64 * (j))
#define XB_TOP      3328
#define XB_TOPGEN   3392
#define XCD_BAR_WORDS 3456
#define XB_SPIN_CAP (1u << 22)
#define LAS __attribute__((address_space(3)))
DEVI unsigned xb_ld(unsigned* p) { return __hip_atomic_load(p, __ATOMIC_RELAXED, __HIP_MEMORY_SCOPE_AGENT); }
DEVI unsigned xb_add(unsigned* p, unsigned v) { return __hip_atomic_fetch_add(p, v, __ATOMIC_RELAXED, __HIP_MEMORY_SCOPE_AGENT); }
DEVI unsigned xb_xcc_id() { return (unsigned)__builtin_amdgcn_s_getreg((3 << 11) | 20) & 0xFu; }
#define XB_SPIN(cond, bar) do { unsigned _sp = 0; while (cond) { __builtin_amdgcn_s_sleep(1); \
    if ((++_sp & 255u) == 0u) { if (xb_ld(&(bar)[XB_TMO])) break; if (_sp > XB_SPIN_CAP) { atomicAdd(&(bar)[XB_TMO], 1u); break; } } } } while (0)
struct XcdBarrier { unsigned* bar; unsigned x; volatile LAS unsigned* st; };
DEVI XcdBarrier xcd_barrier_post(unsigned* bar, volatile LAS unsigned* st) {
  XcdBarrier b; b.bar = bar; b.x = xb_xcc_id(); b.st = st;
  if (threadIdx.x == 0) st[2] = xb_add(&bar[XB_XCNT(b.x)], 1u);
  return b;
}
DEVI void xcd_barrier_complete(unsigned* bar, unsigned x, unsigned& nloc, unsigned& nx, unsigned& vidx) {
  const unsigned G = gridDim.x * gridDim.y * gridDim.z;
  unsigned sum, cnt, mine, below, sp = 0u;
  for (;;) {
    sum = 0u; cnt = 0u; mine = 0u; below = 0u;
#pragma unroll
    for (unsigned j = 0; j < 16; ++j) { const unsigned c = xb_ld(&bar[XB_XCNT(j)]); sum += c; cnt += (c > 0u) ? 1u : 0u; mine = (j == x) ? c : mine; below += (c > 0u && j < x) ? 1u : 0u; }
    if (sum == G) break;
    __builtin_amdgcn_s_sleep(1);
    if ((++sp & 255u) == 0u) { if (xb_ld(&bar[XB_TMO])) break; if (sp > XB_SPIN_CAP) { atomicAdd(&bar[XB_TMO], 1u); break; } }
  }
  nloc = mine > 0u ? mine : 1u; nx = cnt > 0u ? cnt : 1u; vidx = below;
}
DEVI void xcd_barrier(const XcdBarrier& b) {
  asm volatile("s_waitcnt vmcnt(0)" ::: "memory");
  __syncthreads();
  if (threadIdx.x == 0) {
    unsigned* bar = b.bar;
    __builtin_amdgcn_s_waitcnt(0);
    unsigned nloc = b.st[0], nx = b.st[1];
    if (nloc == 0u) { unsigned vidx; xcd_barrier_complete(bar, b.x, nloc, nx, vidx); b.st[0] = nloc; b.st[1] = nx; b.st[3] = vidx; }
    const unsigned old = xb_add(&bar[XB_XSUB(b.x)], 1u);
    const unsigned gen = old / nloc;
    if (old + 1u == (gen + 1u) * nloc) {
      __builtin_amdgcn_fence(__ATOMIC_RELEASE, "agent");
      asm volatile("s_waitcnt vmcnt(0)" ::: "memory");
      const unsigned og = xb_add(&bar[XB_TOP], 1u);
      const unsigned tg = og / nx;
      if (og + 1u == (tg + 1u) * nx) xb_add(&bar[XB_TOPGEN], 1u);
      else XB_SPIN(xb_ld(&bar[XB_TOPGEN]) == tg, bar);
      __builtin_amdgcn_fence(__ATOMIC_ACQUIRE, "agent");
      xb_add(&bar[XB_XGEN(b.x)], 1u);
      asm volatile("s_waitcnt vmcnt(0)" ::: "memory");
    } else {
      XB_SPIN(xb_ld(&bar[XB_XGEN(b.x)]) == gen, bar);
      __builtin_amdgcn_fence(__ATOMIC_ACQUIRE, "agent");
      asm volatile("s_waitcnt vmcnt(0)" ::: "memory");
    }
  }
  __syncthreads();
}

constexpr int NPHASE = 16;
DEVI XcdMap get_xm(int coop, const uint4& w) {
  XcdMap m;
  if (coop) { m.v = (int)w.w; m.nx = (int)w.y; m.slot = (int)w.z; m.slots = (int)w.x; }
  else { m.v = blockIdx.x & 7; m.nx = 8; m.slot = blockIdx.x >> 3; m.slots = gridDim.x >> 3; if (m.slots < 1) { m.slots = 1; } }
  return m;
}
__global__ void __launch_bounds__(256, 2) mk(Params p, int ph0, int ph1, int coop) {
  __shared__ __attribute__((aligned(16))) unsigned char smem[SMEM_BYTES];
  __shared__ uint4 xb_words;
  if (threadIdx.x == 0) xb_words = make_uint4(0u, 0u, 0u, 0u);
  __syncthreads();
  XcdBarrier xb;
  if (coop) xb = xcd_barrier_post((unsigned*)(p.ws + O_BAR), (volatile LAS unsigned*)&xb_words);
#ifdef XCC_PROBE
  if (coop && xb_xcc_id() != (blockIdx.x & 7u)) { unsigned long long t0 = wall_clock64(); while (wall_clock64() - t0 < 100000ull) __builtin_amdgcn_s_sleep(8); }
#endif
  if (ph0 < 0) cg::this_grid().sync();
#ifdef PROBE_A
#define STAMP(n) if (blockIdx.x == 0 && threadIdx.x == 0) ((unsigned long long*)(p.ws + O_STAMP))[n] = wall_clock64();
#else
#define STAMP(n)
#endif
#define RUN_PHASE(n, call)                                   \
  if (ph0 <= n && n < ph1) {                                 \
    STAMP(n)                                                 \
        if (DRY_PH == n) { if (n == 4) phase4<true>(p); if (n == 5) phase5<true>(p, smem); if (n == 8) phase8<true>(p, smem); if (n == 15) phase15<true>(p, smem); } \
    if (ONLY < 0 || ONLY == n) { call; }                     \
    if (REPEAT_PH == n) { call; }                            \
    if (coop && n + 1 < ph1) xcd_barrier(xb);                \
  }
  RUN_PHASE(0, phase0(p, smem))
  RUN_PHASE(1, phase1(p, smem))
  RUN_PHASE(2, phase2(p, smem, get_xm(coop, xb_words)))
  RUN_PHASE(3, phase3(p, smem))
  RUN_PHASE(4, (phase4<false>(p), phase6(p, smem, 0, 32, gridDim.x > 290 ? 258 : 0, gridDim.x > 290 ? (int)gridDim.x - 258 : (int)gridDim.x)))
  RUN_PHASE(5, phase5<false>(p, smem))
  RUN_PHASE(6, phase6(p, smem, 32, 260 * 8, 0, (int)gridDim.x))
  RUN_PHASE(7, phase7(p))
  RUN_PHASE(8, phase8<false>(p, smem))
  RUN_PHASE(9, phase9(p))
  RUN_PHASE(10, phase10(p))
  RUN_PHASE(11, phase11(p, smem, get_xm(coop, xb_words)))
  RUN_PHASE(12, (phase12(p, smem, get_xm(coop, xb_words)), convert_fp8(p.in[I_PU], p.ws + R_UBF, (size_t)16384 * 64, 64.f)))
  RUN_PHASE(13, phase13(p, smem))
  RUN_PHASE(14, (phase14(p, smem, get_xm(coop, xb_words)), convert_fp8(p.in[I_PV], p.ws + R_VBF, (size_t)16384 * 64, 4.f)))
  RUN_PHASE(15, phase15<false>(p, smem))
#ifdef SYNC_EXTRA
  for (int i = 0; i < SYNC_EXTRA; ++i) xcd_barrier(xb);
#endif
#ifdef PROBE_A
  cg::this_grid().sync();
  STAMP(16)
  __syncthreads();
  if (blockIdx.x == 0) {
    const unsigned long long* st = (const unsigned long long*)(p.ws + O_STAMP);
    float ta = (float)(st[PROBE_A + 1] - st[PROBE_A]) * 0.01f, tb = (float)(st[PROBE_B + 1] - st[PROBE_B]) * 0.01f;
    for (int i = threadIdx.x; i < 1000000; i += 256) p.out[1 + i] = tb;
    if (threadIdx.x == 0) p.out[0] = 100.f * ta;
  }
#endif
}

extern "C" void kernel_launch(void* const* d_in, const int* in_sizes, int n_in, void* d_out, int out_size, void* d_ws,
                              size_t ws_size, hipStream_t stream) {
  static int grid_blocks = 0;
  if (!grid_blocks) {
    int dev = 0, cus = 0, per_cu = 0;
    hipGetDevice(&dev);
    hipDeviceGetAttribute(&cus, hipDeviceAttributeMultiprocessorCount, dev);
    hipOccupancyMaxActiveBlocksPerMultiprocessor(&per_cu, mk, 256, 0);
    if (per_cu < 1) per_cu = 1;
    if (per_cu > 2) per_cu = 2;
    grid_blocks = cus * per_cu;
  }
  if (ws_size < WS_NEED) { fprintf(stderr, "workspace too small: %zu < %zu\n", ws_size, (size_t)WS_NEED); return; }
  Params p{};
  for (int i = 0; i < 32; ++i) p.in[i] = (const float*)d_in[i];
  p.out = (float*)d_out;
  p.ws = (unsigned char*)d_ws;
#if MEGA
  (void)hipMemsetAsync((unsigned char*)d_ws + O_BAR, 0, XCD_BAR_WORDS * 4, stream);
  int ph0 = 0, ph1 = NPHASE, coop = 1;
  void* args[] = {&p, &ph0, &ph1, &coop};
  hipError_t e = hipLaunchCooperativeKernel((void*)mk, dim3(grid_blocks), dim3(256), args, 0, stream);
  if (e != hipSuccess) fprintf(stderr, "cooperative launch failed: %s (grid %d)\n", hipGetErrorString(e), grid_blocks);
#else
  for (int ph = 0; ph < NPHASE; ++ph) mk<<<grid_blocks, 256, 0, stream>>>(p, ph, ph + 1, 0);
#endif
}
```

```cpp
#include <hip/hip_runtime.h>
#include <hip/hip_cooperative_groups.h>
#include <cstdio>
#include <cstdint>
namespace cg = cooperative_groups;

#ifndef MEGA
#define MEGA 1
#endif
#ifndef ONLY
#define ONLY -1
#endif
#ifndef REPEAT_PH
#define REPEAT_PH -1
#endif
#ifndef DRY_PH
#define DRY_PH -1
#endif

typedef unsigned short bf16_t;
using bf16x8 = __attribute__((ext_vector_type(8))) short;
using f32x4 = __attribute__((ext_vector_type(4))) float;
using u32x4 = __attribute__((ext_vector_type(4))) unsigned;
#define DEVI __device__ __forceinline__

constexpr int T_CTX = 256, T_LAT = 16384, T_ALL = 16640;
constexpr int NIN = 5392, NP = 5376;
constexpr int NCH = 128, LCH = 130;
constexpr int SVH = 576;
constexpr int SMEM_BYTES = 71680;

enum { I_X = 0, I_C, I_CTX, I_CCTX, I_ADAW, I_ADAB, I_N1G, I_WIN, I_RCONV, I_RW0, I_RWUP, I_RA0, I_RAUP, I_RGUP,
       I_RKK, I_RKA, I_RRK, I_RLNW, I_RLNB, I_MCONV, I_MIB, I_MFB, I_MNG, I_WBA, I_WBB, I_WOUT, I_N2G, I_WQ,
       I_KEYS, I_PU, I_PV, I_FG };

struct Params { const float* in[32]; float* out; unsigned char* ws; };

constexpr size_t A256(size_t x) { return (x + 255) & ~(size_t)255; }
constexpr size_t O_MODP = 0;
constexpr size_t O_WBA = A256(O_MODP + (size_t)16 * 2 * 6144 * 4);
constexpr size_t O_WBB = A256(O_WBA + (size_t)1024 * 512 * 2);
constexpr size_t O_WOUT = A256(O_WBB + (size_t)1024 * 512 * 2);
constexpr size_t O_WQ = A256(O_WOUT + (size_t)1024 * 1024 * 2);
constexpr size_t O_KEYS = A256(O_WQ + (size_t)2048 * 1024 * 2);
constexpr size_t O_WUP = A256(O_KEYS + (size_t)16 * 128 * 128 * 2);
constexpr size_t O_AUP = A256(O_WUP + (size_t)1024 * 64 * 2);
constexpr size_t O_GUP = A256(O_AUP + (size_t)1024 * 64 * 2);
constexpr size_t O_BEND = A256(O_GUP + (size_t)512 * 128 * 2);
constexpr size_t O_MLOC = A256(O_BEND + (size_t)260 * 8 * 4);
constexpr size_t O_MST = A256(O_MLOC + (size_t)260 * 8 * 4);
constexpr size_t O_NT = A256(O_MST + (size_t)260 * 8 * 4);
constexpr size_t O_BONUS = A256(O_NT + (size_t)260 * 8 * 64 * 4);
constexpr size_t O_STAMP = A256(O_BONUS + (size_t)T_ALL * 16 * 4);
constexpr size_t O_BAR = A256(O_STAMP + 1024);
constexpr size_t O_PG = A256(O_BAR + 3456 * 4);
constexpr size_t O_PO = A256(O_PG + (size_t)T_LAT * 2048 * 2);
constexpr size_t O_R = A256(O_PO + (size_t)T_LAT * 512 * 2);
constexpr size_t R_HX = O_R;
constexpr size_t R_WIN = A256(R_HX + (size_t)T_ALL * 1024 * 2);
constexpr size_t R_PQK = A256(R_WIN + (size_t)NP * 1024 * 2);
constexpr size_t R_PV = A256(R_PQK + (size_t)T_ALL * 512 * 2);
constexpr size_t R_GIF = A256(R_PV + (size_t)T_ALL * 512 * 2);
constexpr size_t R_U = A256(R_GIF + (size_t)T_ALL * 16 * 4);
constexpr size_t R_END1 = A256(R_U + (size_t)260 * 8 * 8192 * 4);
constexpr size_t R_SV = O_R;
constexpr size_t R_YA = A256(R_SV + (size_t)T_ALL * 8 * SVH * 2);
constexpr size_t R_END2 = A256(R_YA + (size_t)T_LAT * 512 * 2);
constexpr size_t R_MERGED = O_R;
constexpr size_t R_H2 = A256(R_MERGED + (size_t)T_LAT * 1024 * 2);
constexpr size_t R_TOPS = A256(R_H2 + (size_t)T_LAT * 1024 * 2);
constexpr size_t R_TOPI = A256(R_TOPS + (size_t)T_LAT * 256 * 4);
constexpr size_t R_UBF = A256(R_TOPI + (size_t)T_LAT * 256 * 4);
constexpr size_t R_VBF = A256(R_UBF + (size_t)16384 * 1024 * 2);
constexpr size_t R_END3 = A256(R_VBF + (size_t)16384 * 1024 * 2);
constexpr size_t WS_NEED = (R_END1 > R_END2 ? (R_END1 > R_END3 ? R_END1 : R_END3) : (R_END2 > R_END3 ? R_END2 : R_END3));
constexpr size_t OUT_BC = (size_t)NCH * 16 * 4096 * 4;

DEVI bf16_t f2bf(float f) { unsigned u = __float_as_uint(f); u += 0x7fffu + ((u >> 16) & 1u); return (bf16_t)(u >> 16); }
DEVI float bf2f(bf16_t h) { return __uint_as_float(((unsigned)h) << 16); }
DEVI float bflo(unsigned u) { return __uint_as_float(u << 16); }
DEVI float bfhi(unsigned u) { return __uint_as_float(u & 0xffff0000u); }
DEVI unsigned pack2(float a, float b) { return (unsigned)f2bf(a) | ((unsigned)f2bf(b) << 16); }
DEVI void unpack8(const uint4& u, float* f) {
  f[0] = bflo(u.x); f[1] = bfhi(u.x); f[2] = bflo(u.y); f[3] = bfhi(u.y);
  f[4] = bflo(u.z); f[5] = bfhi(u.z); f[6] = bflo(u.w); f[7] = bfhi(u.w);
}
DEVI uint4 pack8(const float* f) { return make_uint4(pack2(f[0], f[1]), pack2(f[2], f[3]), pack2(f[4], f[5]), pack2(f[6], f[7])); }
DEVI float wave_sum(float v) {
#pragma unroll
  for (int o = 32; o; o >>= 1) v += __shfl_xor(v, o);
  return v;
}
DEVI float wave_max(float v) {
#pragma unroll
  for (int o = 32; o; o >>= 1) v = fmaxf(v, __shfl_xor(v, o));
  return v;
}
DEVI float sigm(float x) { return 1.f / (1.f + __expf(-x)); }
DEVI float siluf(float x) { return x / (1.f + __expf(-x)); }
DEVI float logsig(float x) { return fminf(x, 0.f) - log1pf(expf(-fabsf(x))); }
template <int CTRL> DEVI float dppf(float v) { return __int_as_float(__builtin_amdgcn_update_dpp(0, __float_as_int(v), CTRL, 0xf, 0xf, true)); }
DEVI float rlf(float v, int l) { return __int_as_float(__builtin_amdgcn_readlane(__float_as_int(v), l)); }
DEVI float wave_sum_u(float v) {
  v += dppf<0xB1>(v); v += dppf<0x4E>(v); v += dppf<0x141>(v); v += dppf<0x140>(v);
  return (rlf(v, 0) + rlf(v, 16)) + (rlf(v, 32) + rlf(v, 48));
}
typedef __attribute__((ext_vector_type(2))) short s16x2;
DEVI float dot2bf(unsigned a, unsigned b, float c) { return __builtin_amdgcn_fdot2_f32_bf16(__builtin_bit_cast(s16x2, a), __builtin_bit_cast(s16x2, b), c, false); }
typedef __attribute__((ext_vector_type(2))) float f32x2;
DEVI void convert_fp8(const float* __restrict__ src, unsigned char* __restrict__ dst, size_t n16, float scale) {
  for (size_t g = (size_t)blockIdx.x * 256 + threadIdx.x; g < n16; g += (size_t)gridDim.x * 256) {
    u32x4 o;
#pragma unroll
    for (int q = 0; q < 4; ++q) {
      float4 a = *(const float4*)(src + g * 16 + q * 4);
      int pk = __builtin_amdgcn_cvt_pk_fp8_f32(a.x * scale, a.y * scale, 0, false);
      pk = __builtin_amdgcn_cvt_pk_fp8_f32(a.z * scale, a.w * scale, pk, true);
      o[q] = (unsigned)pk;
    }
    *(u32x4*)(dst + g * 16) = o;
  }
}
DEVI void unpack_fp8x16(const u32x4& u, float* f) {
#pragma unroll
  for (int q = 0; q < 4; ++q) {
    f32x2 lo = __builtin_amdgcn_cvt_pk_f32_fp8((int)u[q], false), hi = __builtin_amdgcn_cvt_pk_f32_fp8((int)u[q], true);
    f[4 * q] = lo[0]; f[4 * q + 1] = lo[1]; f[4 * q + 2] = hi[0]; f[4 * q + 3] = hi[1];
  }
}
DEVI void convert_bf16(const float* __restrict__ src, bf16_t* __restrict__ dst, size_t n8) {
  for (size_t g = (size_t)blockIdx.x * 256 + threadIdx.x; g < n8; g += (size_t)gridDim.x * 256) {
    float4 a = *(const float4*)(src + g * 8), b = *(const float4*)(src + g * 8 + 4);
    *(uint4*)(dst + g * 8) = make_uint4(pack2(a.x, a.y), pack2(a.z, a.w), pack2(b.x, b.y), pack2(b.z, b.w));
  }
}
DEVI float allred8(float v) { v += dppf<0xB1>(v); v += dppf<0x4E>(v); v += dppf<0x141>(v); return v; }

DEVI int ml_row(int c, int j) {
  if (c < 4) return c * 64 + j;
  int cc = c - 4; int col = cc >> 2; int gr = (cc & 3) * 64 + j;
  return T_CTX + gr * 64 + col;
}
DEVI int ml_sc(int c, int dir) { return dir == 0 ? c : (c < 4 ? 3 - c : 263 - c); }
DEVI int rw_row(int p, int dir) { return dir == 0 ? p : (p < T_CTX ? (T_CTX - 1 - p) : (T_ALL + T_CTX - 1 - p)); }

DEVI float mod_val(const Params& p, int which, int col) {
  const float* modp = (const float*)(p.ws + O_MODP);
  float s = p.in[I_ADAB][col];
#pragma unroll
  for (int rs = 0; rs < 16; ++rs) s += modp[(rs * 2 + which) * 6144 + col];
  return s;
}

DEVI void gemm_core(const bf16_t* __restrict__ A, int lda, const bf16_t* __restrict__ Bt, int ldb, int K,
                    f32x4 (&acc)[4][4], unsigned char* smem) {
  bf16_t(*sa)[80] = (bf16_t(*)[80])smem;
  bf16_t(*sb)[80] = (bf16_t(*)[80])(smem + 128 * 80 * 2);
  const int tid = threadIdx.x, lane = tid & 63, warp = tid >> 6, wm = warp >> 1, wn = warp & 1;
  const int lr = tid >> 3, lk = (tid & 7) * 8;
  const bf16_t* Ap = A + (size_t)lr * lda + lk;
  const bf16_t* Bp = Bt + (size_t)lr * ldb + lk;
  u32x4 ra0[4], rb0[4], ra1[4], rb1[4];
#pragma unroll
  for (int i = 0; i < 4; ++i) {
    ra0[i] = *(const u32x4*)(Ap + (size_t)(32 * i) * lda); rb0[i] = *(const u32x4*)(Bp + (size_t)(32 * i) * ldb);
    ra1[i] = *(const u32x4*)(Ap + (size_t)(32 * i) * lda + 64); rb1[i] = *(const u32x4*)(Bp + (size_t)(32 * i) * ldb + 64);
  }
#define GEMM_STEP(k0, ra, rb)                                                                                 \
  {                                                                                                           \
    __syncthreads();                                                                                          \
    _Pragma("unroll") for (int i = 0; i < 4; ++i) { *(u32x4*)&sa[lr + 32 * i][lk] = ra[i]; *(u32x4*)&sb[lr + 32 * i][lk] = rb[i]; } \
    __syncthreads();                                                                                          \
    if ((k0) + 128 < K) {                                                                                     \
      _Pragma("unroll") for (int i = 0; i < 4; ++i) {                                                         \
        ra[i] = *(const u32x4*)(Ap + (size_t)(32 * i) * lda + (k0) + 128);                                    \
        rb[i] = *(const u32x4*)(Bp + (size_t)(32 * i) * ldb + (k0) + 128);                                    \
      }                                                                                                       \
    }                                                                                                         \
    __builtin_amdgcn_s_setprio(1);                                                                            \
    _Pragma("unroll") for (int ks = 0; ks < 2; ++ks) {                                                        \
      bf16x8 af[4], bq[4];                                                                                    \
      _Pragma("unroll") for (int i = 0; i < 4; ++i) af[i] = *(const bf16x8*)&sa[wm * 64 + i * 16 + (lane & 15)][ks * 32 + (lane >> 4) * 8]; \
      _Pragma("unroll") for (int j = 0; j < 4; ++j) bq[j] = *(const bf16x8*)&sb[wn * 64 + j * 16 + (lane & 15)][ks * 32 + (lane >> 4) * 8]; \
      _Pragma("unroll") for (int i = 0; i < 4; ++i)                                                           \
        _Pragma("unroll") for (int j = 0; j < 4; ++j) acc[i][j] = __builtin_amdgcn_mfma_f32_16x16x32_bf16(bq[j], af[i], acc[i][j], 0, 0, 0); \
    }                                                                                                         \
    __builtin_amdgcn_s_setprio(0);                                                                            \
  }
  for (int k0 = 0; k0 < K; k0 += 128) {
    GEMM_STEP(k0, ra0, rb0)
    GEMM_STEP(k0 + 64, ra1, rb1)
  }
#undef GEMM_STEP
  __syncthreads();
}
DEVI void zero_acc(f32x4 (&acc)[4][4]) {
#pragma unroll
  for (int i = 0; i < 4; ++i)
#pragma unroll
    for (int j = 0; j < 4; ++j) acc[i][j] = f32x4{0.f, 0.f, 0.f, 0.f};
}

struct XcdMap { int v, nx, slot, slots; };
template <typename F> DEVI void for_tiles_xcd(const XcdMap& xm, int MT, int NT, int SM, int SN, F&& f) {
  const int nsn = (NT + SN - 1) / SN, nst = ((MT + SM - 1) / SM) * nsn, per = SM * SN;
  const int n_my = (nst - xm.v + xm.nx - 1) / xm.nx;
  for (int g = xm.slot; g < n_my * per; g += xm.slots) {
    const int s = xm.v + (g / per) * xm.nx, idx = g % per;
    const int sm = s / nsn, sn = s % nsn;
    const int mt = sm * SM + idx / SN, nt = sn * SN + idx % SN;
    if (mt < MT && nt < NT) f(mt, nt);
  }
}

DEVI void tr_tile(const float* __restrict__ src, int lds, int k0, int n0src, bf16_t* __restrict__ dst, int ldd, int n0dst,
                  unsigned char* smem) {
  float(*tile)[65] = (float(*)[65])smem;
  const int tid = threadIdx.x, j = tid & 63, i0 = tid >> 6;
#pragma unroll 4
  for (int ii = 0; ii < 16; ++ii) { int i = i0 + 4 * ii; tile[i][j] = src[(size_t)(k0 + i) * lds + n0src + j]; }
  __syncthreads();
#pragma unroll 4
  for (int jj = 0; jj < 16; ++jj) { int jn = i0 + 4 * jj; dst[(size_t)(n0dst + jn) * ldd + k0 + j] = f2bf(tile[j][jn]); }
  __syncthreads();
}

DEVI void phase0(const Params& p, unsigned char* smem) {
  const int tid = threadIdx.x;
  constexpr int N_MOD = 384, N_WIN = 16 * 84, N_WB = 128, N_WOUT = 256, N_WQ = 512, N_LORA = 16, N_GUP = 16, N_KEYS = 128;
  constexpr int E0 = N_MOD, E1 = E0 + N_WIN, E2 = E1 + N_WB, E3 = E2 + N_WB, E4 = E3 + N_WOUT, E5 = E4 + N_WQ,
                E6 = E5 + N_LORA, E7 = E6 + N_LORA, E8 = E7 + N_GUP, E9 = E8 + N_KEYS;
  for (int it = blockIdx.x; it < E9; it += gridDim.x) {
    if (it < E0) {
      int cb = it % 24, rs = it / 24; int col = cb * 256 + tid;
      const float* aw = p.in[I_ADAW];
      float ax = 0.f, ac = 0.f;
#pragma unroll 8
      for (int r = rs * 64; r < rs * 64 + 64; ++r) {
        float w = aw[(size_t)r * 6144 + col];
        ax += siluf(p.in[I_C][r]) * w;
        ac += siluf(p.in[I_CCTX][r]) * w;
      }
      float* modp = (float*)(p.ws + O_MODP);
      modp[(rs * 2 + 0) * 6144 + col] = ax;
      modp[(rs * 2 + 1) * 6144 + col] = ac;
    } else if (it < E1) {
      int t = it - E0; int kt = t / 84, nt = t % 84; int n0 = nt * 64;
      tr_tile(p.in[I_WIN], NIN, kt * 64, n0 < 2816 ? n0 : n0 + 16, (bf16_t*)(p.ws + R_WIN), 1024, n0, smem);
    } else if (it < E2) {
      int t = it - E1; tr_tile(p.in[I_WBA], 1024, (t / 16) * 64, (t % 16) * 64, (bf16_t*)(p.ws + O_WBA), 512, (t % 16) * 64, smem);
    } else if (it < E3) {
      int t = it - E2; tr_tile(p.in[I_WBB], 1024, (t / 16) * 64, (t % 16) * 64, (bf16_t*)(p.ws + O_WBB), 512, (t % 16) * 64, smem);
    } else if (it < E4) {
      int t = it - E3; tr_tile(p.in[I_WOUT], 1024, (t / 16) * 64, (t % 16) * 64, (bf16_t*)(p.ws + O_WOUT), 1024, (t % 16) * 64, smem);
    } else if (it < E5) {
      int t = it - E4; tr_tile(p.in[I_WQ], 2048, (t / 32) * 64, (t % 32) * 64, (bf16_t*)(p.ws + O_WQ), 1024, (t % 32) * 64, smem);
    } else if (it < E6) {
      int t = it - E5; int dir = t / 8, nt = t % 8;
      tr_tile(p.in[I_RWUP] + (size_t)dir * 64 * 512, 512, 0, nt * 64, (bf16_t*)(p.ws + O_WUP) + (size_t)dir * 512 * 64, 64, nt * 64, smem);
    } else if (it < E7) {
      int t = it - E6; int dir = t / 8, nt = t % 8;
      tr_tile(p.in[I_RAUP] + (size_t)dir * 64 * 512, 512, 0, nt * 64, (bf16_t*)(p.ws + O_AUP) + (size_t)dir * 512 * 64, 64, nt * 64, smem);
    } else if (it < E8) {
      int t = it - E7; tr_tile(p.in[I_RGUP], 512, (t / 8) * 64, (t % 8) * 64, (bf16_t*)(p.ws + O_GUP), 128, (t % 8) * 64, smem);
    } else {
      int t = it - E8; size_t base = (size_t)t * 2048 + tid * 8;
      const float* s = p.in[I_KEYS] + base;
      float f[8];
      float4 a = *(const float4*)s, b = *(const float4*)(s + 4);
      f[0] = a.x; f[1] = a.y; f[2] = a.z; f[3] = a.w; f[4] = b.x; f[5] = b.y; f[6] = b.z; f[7] = b.w;
      *(uint4*)((bf16_t*)(p.ws + O_KEYS) + base) = pack8(f);
    }
  }
}

DEVI void phase1(const Params& p, unsigned char* smem) {
  float* smod = (float*)smem;
  const int tid = threadIdx.x, lane = tid & 63, warp = tid >> 6;
  for (int i = tid; i < 4096; i += 256) { int which = i >> 10; smod[i] = mod_val(p, which >> 1, (which & 1) * 1024 + (i & 1023)); }
  __syncthreads();
  bf16_t* hx = (bf16_t*)(p.ws + R_HX);
  float* gif = (float*)(p.ws + R_GIF);
  const float* win = p.in[I_WIN];
  constexpr int RPW = 4;
  for (int rg = blockIdx.x * 4 + warp; rg < T_ALL / RPW; rg += gridDim.x * 4) {
    const int row0 = rg * RPW;
    const float* sh = smod + (row0 < T_CTX ? 2048 : 0);
    const float* sc = sh + 1024;
    const float* src0 = row0 < T_CTX ? p.in[I_CTX] + (size_t)row0 * 1024 : p.in[I_X] + (size_t)(row0 - T_CTX) * 1024;
    float rstd[RPW];
#pragma unroll
    for (int r = 0; r < RPW; ++r) {
      float ss = 0.f;
#pragma unroll
      for (int i = 0; i < 4; ++i) {
        float4 v = *(const float4*)(src0 + (size_t)r * 1024 + i * 256 + lane * 4);
        ss += v.x * v.x + v.y * v.y + v.z * v.z + v.w * v.w;
      }
      ss = wave_sum_u(ss);
      rstd[r] = rsqrtf(ss * (1.f / 1024.f) + 1e-6f);
    }
    float g[RPW][16];
#pragma unroll
    for (int r = 0; r < RPW; ++r)
#pragma unroll
      for (int j = 0; j < 16; ++j) g[r][j] = 0.f;
#pragma unroll 2
    for (int i = 0; i < 4; ++i) {
      const int k0 = i * 256 + lane * 4;
      float y[RPW][4];
      {
        const float4 gk = *(const float4*)(p.in[I_N1G] + k0);
        const float4 s4 = *(const float4*)(sc + k0), h4 = *(const float4*)(sh + k0);
#pragma unroll
        for (int r = 0; r < RPW; ++r) {
          float4 v = *(const float4*)(src0 + (size_t)r * 1024 + k0);
          y[r][0] = v.x * rstd[r] * gk.x * (1.f + s4.x) + h4.x; y[r][1] = v.y * rstd[r] * gk.y * (1.f + s4.y) + h4.y;
          y[r][2] = v.z * rstd[r] * gk.z * (1.f + s4.z) + h4.z; y[r][3] = v.w * rstd[r] * gk.w * (1.f + s4.w) + h4.w;
          *(uint2*)(hx + (size_t)(row0 + r) * 1024 + k0) = make_uint2(pack2(y[r][0], y[r][1]), pack2(y[r][2], y[r][3]));
        }
      }
#pragma unroll
      for (int e = 0; e < 4; ++e) {
        const float* wr = win + (size_t)(k0 + e) * NIN + 2816;
        float w[16];
#pragma unroll
        for (int q = 0; q < 4; ++q) { float4 t4 = *(const float4*)(wr + 4 * q); w[4 * q] = t4.x; w[4 * q + 1] = t4.y; w[4 * q + 2] = t4.z; w[4 * q + 3] = t4.w; }
#pragma unroll
        for (int r = 0; r < RPW; ++r)
#pragma unroll
          for (int q = 0; q < 16; ++q) g[r][q] += y[r][e] * w[q];
      }
    }
#pragma unroll
    for (int r = 0; r < RPW; ++r) {
      float mine = 0.f;
#pragma unroll
      for (int j = 0; j < 16; ++j) { float s2 = wave_sum_u(g[r][j]); if (lane == j) mine = s2; }
      if (lane < 16) gif[(size_t)(row0 + r) * 16 + lane] = mine;
    }
  }
}

DEVI void phase2(const Params& p, unsigned char* smem, const XcdMap& xm) {
  const int lane = threadIdx.x & 63, warp = threadIdx.x >> 6, wm = warp >> 1, wn = warp & 1;
  const bf16_t* hx = (const bf16_t*)(p.ws + R_HX);
  const bf16_t* wt = (const bf16_t*)(p.ws + R_WIN);
  bf16_t* prw = (bf16_t*)p.out;
  bf16_t* pqk = (bf16_t*)(p.ws + R_PQK);
  bf16_t* pv = (bf16_t*)(p.ws + R_PV);
  bf16_t* po = (bf16_t*)(p.ws + O_PO);
  bf16_t* pg = (bf16_t*)(p.ws + O_PG);
  for_tiles_xcd(xm, 130, 42, 5, 6, [&](int mt, int nt) {
    if (mt < 2 && nt >= 22) return;
    f32x4 acc[4][4];
    zero_acc(acc);
    gemm_core(hx + (size_t)mt * 128 * 1024, 1024, wt + (size_t)nt * 128 * 1024, 1024, 1024, acc, smem);
    bf16_t* dst; int ld, nb; int rofs = 0; bool sg = false;
    if (nt < 14) { dst = prw; ld = 1792; nb = nt * 128; }
    else if (nt < 18) { dst = pqk; ld = 512; nb = (nt - 14) * 128; }
    else if (nt < 22) { dst = pv; ld = 512; nb = (nt - 18) * 128; }
    else if (nt < 26) { dst = po; ld = 512; nb = (nt - 22) * 128; rofs = T_CTX; }
    else { dst = pg; ld = 2048; nb = (nt - 26) * 128; rofs = T_CTX; sg = true; }
    bf16_t(*Ct)[136] = (bf16_t(*)[136])smem;
#pragma unroll
    for (int i = 0; i < 4; ++i) {
#pragma unroll
      for (int j = 0; j < 4; ++j) {
        f32x4 v = acc[i][j];
        if (sg) { v[0] = sigm(v[0]); v[1] = sigm(v[1]); v[2] = sigm(v[2]); v[3] = sigm(v[3]); }
        *(uint2*)&Ct[wm * 64 + i * 16 + (lane & 15)][wn * 64 + j * 16 + (lane >> 4) * 4] = make_uint2(pack2(v[0], v[1]), pack2(v[2], v[3]));
      }
    }
    __syncthreads();
#pragma unroll
    for (int q = 0; q < 8; ++q) {
      const int pc = threadIdx.x + 256 * q; const int r = pc >> 4, c8 = (pc & 15) * 8;
      const int row = mt * 128 + r - rofs;
      *(u32x4*)(dst + (size_t)row * ld + nb + c8) = *(const u32x4*)&Ct[r][c8];
    }
    __syncthreads();
  });
}

DEVI void ml_qk8(const Params& p, int c, int j, int chan, float* o) {
  const bf16_t* pqk = (const bf16_t*)(p.ws + R_PQK);
  int row = ml_row(c, j);
  bool hp, hn; int rp, rn;
  if (c < 4) { hp = row > 0; hn = row < T_CTX - 1; rp = row - 1; rn = row + 1; }
  else { int gr = ((c - 4) & 3) * 64 + j; hp = gr > 0; hn = gr < 255; rp = row - 64; rn = row + 64; }
  const float* cw = p.in[I_MCONV];
  float cur[8], pr[8], nx[8];
  unpack8(*(const uint4*)(pqk + (size_t)row * 512 + chan), cur);
  if (hp) unpack8(*(const uint4*)(pqk + (size_t)rp * 512 + chan), pr);
  if (hn) unpack8(*(const uint4*)(pqk + (size_t)rn * 512 + chan), nx);
#pragma unroll
  for (int e = 0; e < 8; ++e) {
    float v = cw[512 + chan + e] * cur[e];
    if (hp) v += cw[chan + e] * pr[e];
    if (hn) v += cw[1024 + chan + e] * nx[e];
    o[e] = siluf(v);
  }
}

DEVI void phase3(const Params& p, unsigned char* smem) {
  bf16_t(*KT)[72] = (bf16_t(*)[72])smem;
  bf16_t(*VwT)[72] = (bf16_t(*)[72])(smem + 64 * 72 * 2);
  float* wgt = (float*)(smem + 64 * 72 * 2 + 256 * 72 * 2);
  const int tid = threadIdx.x, lane = tid & 63, warp = tid >> 6;
  const float* gif = (const float*)(p.ws + R_GIF);
  const bf16_t* pv = (const bf16_t*)(p.ws + R_PV);
  float* U = (float*)(p.ws + R_U);
  float* NT = (float*)(p.ws + O_NT);
  float* bend = (float*)(p.ws + O_BEND);
  float* mloc = (float*)(p.ws + O_MLOC);
  for (int it = blockIdx.x; it < 260 * 4; it += gridDim.x) {
    int c = it >> 2, h = it & 3;
    if (warp < 2) {
      int dir = warp; int j = dir ? 63 - lane : lane;
      int row = ml_row(c, j);
      float ig = gif[(size_t)row * 16 + dir * 4 + h] + p.in[I_MIB][dir * 4 + h];
      float lf = logsig(gif[(size_t)row * 16 + 8 + dir * 4 + h] + p.in[I_MFB][dir * 4 + h]);
      float b = lf;
#pragma unroll
      for (int o = 1; o < 64; o <<= 1) { float t = __shfl_up(b, o); if (lane >= o) b += t; }
      float be = __shfl(b, 63);
      float ge = be - b + ig;
      float ml = wave_max(ge);
      wgt[dir * 64 + j] = expf(ge - ml);
      if (lane == 0) { int sc = ml_sc(c, dir); bend[sc * 8 + dir * 4 + h] = be; mloc[sc * 8 + dir * 4 + h] = ml; }
    }
    __syncthreads();
    {
      int j = tid >> 2, part = tid & 3;
      float f[8];
#pragma unroll
      for (int q = 0; q < 2; ++q) {
        int d0 = part * 16 + q * 8;
        ml_qk8(p, c, j, 256 + h * 64 + d0, f);
#pragma unroll
        for (int e = 0; e < 8; ++e) KT[d0 + e][j] = f2bf(f[e] * 0.125f);
      }
      int row = ml_row(c, j);
      float w0 = wgt[j], w1 = wgt[64 + j];
#pragma unroll
      for (int q = 0; q < 4; ++q) {
        int v0 = part * 32 + q * 8;
        unpack8(*(const uint4*)(pv + (size_t)row * 512 + h * 128 + v0), f);
#pragma unroll
        for (int e = 0; e < 8; ++e) { VwT[v0 + e][j] = f2bf(f[e] * w0); VwT[128 + v0 + e][j] = f2bf(f[e] * w1); }
      }
    }
    __syncthreads();
#pragma unroll
    for (int dir = 0; dir < 2; ++dir) {
      int sc = ml_sc(c, dir);
      float* Ud = U + ((size_t)sc * 8 + dir * 4 + h) * 8192;
#pragma unroll
      for (int vi = 0; vi < 2; ++vi) {
        int vt = warp * 2 + vi;
        bf16x8 bv[2];
#pragma unroll
        for (int ks = 0; ks < 2; ++ks) bv[ks] = *(const bf16x8*)&VwT[dir * 128 + vt * 16 + (lane & 15)][ks * 32 + (lane >> 4) * 8];
#pragma unroll
        for (int dt = 0; dt < 4; ++dt) {
          f32x4 a = {0.f, 0.f, 0.f, 0.f};
#pragma unroll
          for (int ks = 0; ks < 2; ++ks) {
            bf16x8 ak = *(const bf16x8*)&KT[dt * 16 + (lane & 15)][ks * 32 + (lane >> 4) * 8];
            a = __builtin_amdgcn_mfma_f32_16x16x32_bf16(ak, bv[ks], a, 0, 0, 0);
          }
          *(float4*)(Ud + (size_t)(vt * 16 + (lane & 15)) * 64 + dt * 16 + (lane >> 4) * 4) = make_float4(a[0], a[1], a[2], a[3]);
        }
      }
    }
    if (tid < 128) {
      int dir = tid >> 6, d = tid & 63; float s = 0.f;
      for (int j = 0; j < 64; ++j) s += wgt[dir * 64 + j] * bf2f(KT[d][j]);
      NT[((size_t)ml_sc(c, dir) * 8 + dir * 4 + h) * 64 + d] = s;
    }
    __syncthreads();
  }
}

template <bool DRY> DEVI void phase4(const Params& p) {
  const bool wr = !DRY || (p.in[I_FG][0] == 1234.5f);
  float* U = (float*)(p.ws + R_U);
  float* NT = (float*)(p.ws + O_NT);
  const float* bend = (const float*)(p.ws + O_BEND);
  const float* mloc = (const float*)(p.ws + O_MLOC);
  float* mst = (float*)(p.ws + O_MST);
  for (int g = blockIdx.x * 256 + threadIdx.x; g < 8 * 8256; g += gridDim.x * 256) {
    int pr = g / 8256, e = g % 8256;
    float* base; size_t stride;
    if (e < 8192) { base = U + (size_t)pr * 8192 + e; stride = 8 * 8192; }
    else { base = NT + (size_t)pr * 64 + (e - 8192); stride = 8 * 64; }
    float m = 0.f, C = 0.f;
    for (int sc = 0; sc < 260; sc += 20) {
      float u[20];
#pragma unroll
      for (int q = 0; q < 20; ++q) u[q] = base[(size_t)(sc + q) * stride];
#pragma unroll
      for (int q = 0; q < 20; ++q) {
        float be = bend[(sc + q) * 8 + pr], ml = mloc[(sc + q) * 8 + pr];
        float mn = fmaxf(be + m, ml);
        float keep = expf(be + m - mn), s = expf(ml - mn);
        if (wr) base[(size_t)(sc + q) * stride] = C;
        if (wr && e == 0) mst[(sc + q) * 8 + pr] = m;
        C = keep * C + s * u[q];
        m = mn;
      }
    }
  }
}

template <bool DRY> DEVI void phase5(const Params& p, unsigned char* smem) {
  const bool wr = !DRY || (p.in[I_FG][0] == 1234.5f);
  bf16_t(*Qs)[72] = (bf16_t(*)[72])smem;
  bf16_t(*Ks)[72] = (bf16_t(*)[72])(smem + 9216);
  bf16_t(*Pm)[72] = (bf16_t(*)[72])(smem + 2 * 9216);
  bf16_t(*VT)[72] = (bf16_t(*)[72])(smem + 3 * 9216);
  float* evec = (float*)(smem + 3 * 9216 + 144 * 72 * 2);
  float* Mvec = evec + 128;
  float* bvec = Mvec + 128;
  const int tid = threadIdx.x, lane = tid & 63, warp = tid >> 6;
  const float* gif = (const float*)(p.ws + R_GIF);
  const bf16_t* pv = (const bf16_t*)(p.ws + R_PV);
  const bf16_t* po = (const bf16_t*)(p.ws + O_PO);
  bf16_t* yb = (bf16_t*)(p.ws + R_YA);
  const float* U = (const float*)(p.ws + R_U);
  const float* NT = (const float*)(p.ws + O_NT);
  const float* mst = (const float*)(p.ws + O_MST);
  for (int it = blockIdx.x; it < 256 * 4; it += gridDim.x) {
    int c = 4 + (it >> 2), h = it & 3;
    if (warp < 2) {
      int dir = warp; int j = dir ? 63 - lane : lane;
      int row = ml_row(c, j);
      float ig = gif[(size_t)row * 16 + dir * 4 + h] + p.in[I_MIB][dir * 4 + h];
      float lf = logsig(gif[(size_t)row * 16 + 8 + dir * 4 + h] + p.in[I_MFB][dir * 4 + h]);
      float b = lf;
#pragma unroll
      for (int o = 1; o < 64; o <<= 1) { float t = __shfl_up(b, o); if (lane >= o) b += t; }
      float e = ig - b;
      float pm = e;
#pragma unroll
      for (int o = 1; o < 64; o <<= 1) { float t = __shfl_up(pm, o); if (lane >= o) pm = fmaxf(pm, t); }
      float m0 = mst[ml_sc(c, dir) * 8 + dir * 4 + h];
      evec[dir * 64 + j] = e; Mvec[dir * 64 + j] = fmaxf(m0, pm); bvec[dir * 64 + j] = b;
    }
    {
      int j = tid >> 2, part = tid & 3;
      float f[8];
#pragma unroll
      for (int q = 0; q < 2; ++q) {
        int d0 = part * 16 + q * 8;
        ml_qk8(p, c, j, h * 64 + d0, f);
        *(uint4*)&Qs[j][d0] = pack8(f);
        ml_qk8(p, c, j, 256 + h * 64 + d0, f);
#pragma unroll
        for (int e = 0; e < 8; ++e) f[e] *= 0.125f;
        *(uint4*)&Ks[j][d0] = pack8(f);
      }
      int row = ml_row(c, j);
#pragma unroll
      for (int q = 0; q < 4; ++q) {
        int v0 = part * 32 + q * 8;
        unpack8(*(const uint4*)(pv + (size_t)row * 512 + h * 128 + v0), f);
#pragma unroll
        for (int e = 0; e < 8; ++e) VT[v0 + e][j] = f2bf(f[e]);
      }
      for (int i = tid; i < 16 * 64; i += 256) VT[128 + (i >> 6)][i & 63] = (i < 64) ? (bf16_t)0x3f80 : (bf16_t)0;
    }
    __syncthreads();
    const int jl = warp * 16 + (lane & 15);
    f32x4 s0[4];
    bf16x8 qf[2];
#pragma unroll
    for (int ks = 0; ks < 2; ++ks) qf[ks] = *(const bf16x8*)&Qs[jl][ks * 32 + (lane >> 4) * 8];
#pragma unroll
    for (int st = 0; st < 4; ++st) {
      f32x4 a = {0.f, 0.f, 0.f, 0.f};
#pragma unroll
      for (int ks = 0; ks < 2; ++ks) {
        bf16x8 kf = *(const bf16x8*)&Ks[st * 16 + (lane & 15)][ks * 32 + (lane >> 4) * 8];
        a = __builtin_amdgcn_mfma_f32_16x16x32_bf16(kf, qf[ks], a, 0, 0, 0);
      }
      s0[st] = a;
    }
    f32x4 ysum[8];
#pragma unroll
    for (int vt = 0; vt < 8; ++vt) ysum[vt] = f32x4{0.f, 0.f, 0.f, 0.f};
#pragma unroll 1
    for (int dir = 0; dir < 2; ++dir) {
      float Mj = Mvec[dir * 64 + jl], bj = bvec[dir * 64 + jl];
      float m0 = mst[ml_sc(c, dir) * 8 + dir * 4 + h];
#pragma unroll
      for (int st = 0; st < 4; ++st) {
        float pvv[4];
#pragma unroll
        for (int r = 0; r < 4; ++r) {
          int s = st * 16 + (lane >> 4) * 4 + r;
          bool ok = dir == 0 ? (s <= jl) : (s >= jl);
          pvv[r] = ok ? s0[st][r] * expf(evec[dir * 64 + s] - Mj) : 0.f;
        }
        *(uint2*)&Pm[jl][st * 16 + (lane >> 4) * 4] = make_uint2(pack2(pvv[0], pvv[1]), pack2(pvv[2], pvv[3]));
      }
      __syncthreads();
      bf16x8 pf[2];
#pragma unroll
      for (int ks = 0; ks < 2; ++ks) pf[ks] = *(const bf16x8*)&Pm[jl][ks * 32 + (lane >> 4) * 8];
      const float* Cst = U + ((size_t)ml_sc(c, dir) * 8 + dir * 4 + h) * 8192;
      const float* nst = NT + ((size_t)ml_sc(c, dir) * 8 + dir * 4 + h) * 64;
      float ai = expf(m0 - Mj);
      f32x4 hh[9];
#pragma unroll
      for (int vt = 0; vt < 9; ++vt) {
        f32x4 a1 = {0.f, 0.f, 0.f, 0.f}, a2 = {0.f, 0.f, 0.f, 0.f};
#pragma unroll
        for (int ks = 0; ks < 2; ++ks) {
          bf16x8 vf = *(const bf16x8*)&VT[vt * 16 + (lane & 15)][ks * 32 + (lane >> 4) * 8];
          a1 = __builtin_amdgcn_mfma_f32_16x16x32_bf16(vf, pf[ks], a1, 0, 0, 0);
          int v = vt * 16 + (lane & 15);
          const float* cp = v < 128 ? Cst + (size_t)v * 64 + ks * 32 + (lane >> 4) * 8 : nst + ks * 32 + (lane >> 4) * 8;
          float cf[8];
          if (v <= 128) {
            float4 x0 = *(const float4*)cp, x1 = *(const float4*)(cp + 4);
            cf[0] = x0.x; cf[1] = x0.y; cf[2] = x0.z; cf[3] = x0.w; cf[4] = x1.x; cf[5] = x1.y; cf[6] = x1.z; cf[7] = x1.w;
          } else {
#pragma unroll
            for (int e = 0; e < 8; ++e) cf[e] = 0.f;
          }
          uint4 pk = pack8(cf);
          bf16x8 cfr;
          cfr[0] = (short)(pk.x & 0xffff); cfr[1] = (short)(pk.x >> 16); cfr[2] = (short)(pk.y & 0xffff); cfr[3] = (short)(pk.y >> 16);
          cfr[4] = (short)(pk.z & 0xffff); cfr[5] = (short)(pk.z >> 16); cfr[6] = (short)(pk.w & 0xffff); cfr[7] = (short)(pk.w >> 16);
          a2 = __builtin_amdgcn_mfma_f32_16x16x32_bf16(cfr, qf[ks], a2, 0, 0, 0);
        }
#pragma unroll
        for (int r = 0; r < 4; ++r) hh[vt][r] = a1[r] + ai * a2[r];
      }
      float den = __shfl(hh[8][0], lane & 15);
      float dn = fmaxf(fabsf(den), expf(-(bj + Mj)));
      float inv = 1.f / dn;
      float ss = 0.f;
#pragma unroll
      for (int vt = 0; vt < 8; ++vt)
#pragma unroll
        for (int r = 0; r < 4; ++r) { float x = hh[vt][r] * inv; hh[vt][r] = x; ss += x * x; }
      ss += __shfl_xor(ss, 16); ss += __shfl_xor(ss, 32);
      float rs = rsqrtf(ss * (1.f / 128.f) + 1e-6f);
#pragma unroll
      for (int vt = 0; vt < 8; ++vt)
#pragma unroll
        for (int r = 0; r < 4; ++r) ysum[vt][r] += hh[vt][r] * rs * p.in[I_MNG][h * 128 + vt * 16 + (lane >> 4) * 4 + r];
      __syncthreads();
    }
    {
      int row = ml_row(c, jl) - T_CTX;
#pragma unroll
      for (int vt = 0; vt < 8; ++vt) {
        const bf16_t* op = po + (size_t)row * 512 + h * 128 + vt * 16 + (lane >> 4) * 4;
        uint2 o = *(const uint2*)op;
        float y0 = ysum[vt][0] * sigm(bflo(o.x)), y1 = ysum[vt][1] * sigm(bfhi(o.x)), y2 = ysum[vt][2] * sigm(bflo(o.y)), y3 = ysum[vt][3] * sigm(bfhi(o.y));
        if (wr) *(uint2*)(yb + (size_t)row * 512 + h * 128 + vt * 16 + (lane >> 4) * 4) = make_uint2(pack2(y0, y1), pack2(y2, y3));
      }
    }
    __syncthreads();
  }
}

DEVI void phase6(const Params& p, unsigned char* smem, int item_lo, int item_hi, int blk0, int nblk) {
  float(*rs)[65] = (float(*)[65])smem;
  float(*ks)[65] = (float(*)[65])(smem + 64 * 65 * 4);
  bf16_t(*TW)[72] = (bf16_t(*)[72])(smem + 2 * 64 * 65 * 4);
  bf16_t(*TA)[72] = (bf16_t(*)[72])(smem + 2 * 64 * 65 * 4 + 9216);
  bf16_t(*TG)[136] = (bf16_t(*)[136])(smem + 2 * 64 * 65 * 4 + 2 * 9216);
  float* rn = (float*)(smem + 2 * 64 * 65 * 4 + 2 * 9216 + 64 * 136 * 2);
  const int tid = threadIdx.x, lane = tid & 63, warp = tid >> 6;
  const bf16_t* prw = (const bf16_t*)p.out;
  bf16_t* SV = (bf16_t*)(p.ws + R_SV);
  float* bonus = (float*)(p.ws + O_BONUS);
  const float* cw = p.in[I_RCONV];
  const bf16_t* WUP = (const bf16_t*)(p.ws + O_WUP);
  const bf16_t* AUP = (const bf16_t*)(p.ws + O_AUP);
  const bf16_t* GUP = (const bf16_t*)(p.ws + O_GUP);
  if ((int)blockIdx.x < blk0) return;
  for (int it = item_lo + ((int)blockIdx.x - blk0); it < item_hi; it += nblk) {
    int tile = it >> 3, head = it & 7;
    int row0 = tile * 64;
    int seg0 = tile < 4 ? 0 : row0, seg1 = tile < 4 ? T_CTX : row0 + 64;
#pragma unroll 1
    for (int ub = 0; ub < 2; ++ub) {
      u32x4 lc[7], lp[7], ln[7];
#pragma unroll
      for (int it7 = 0; it7 < 7; ++it7) {
        const int u = warp + 4 * (ub * 7 + it7);
        const int grp = u >> 3;
        const int j = (u & 7) * 8 + (lane >> 3), q = grp * 8 + (lane & 7);
        const int row = row0 + j;
        const int col = q < 24 ? (q >> 3) * 512 + head * 64 + (q & 7) * 8 : 1536 + (q - 24) * 8;
        const bool hp = row > seg0, hn = row < seg1 - 1;
        lc[it7] = *(const u32x4*)(prw + (size_t)row * 1792 + col);
        lp[it7] = hp ? *(const u32x4*)(prw + (size_t)(row - 1) * 1792 + col) : u32x4{0u, 0u, 0u, 0u};
        ln[it7] = hn ? *(const u32x4*)(prw + (size_t)(row + 1) * 1792 + col) : u32x4{0u, 0u, 0u, 0u};
      }
#pragma unroll
      for (int it7 = 0; it7 < 7; ++it7) {
        const int u = warp + 4 * (ub * 7 + it7);
        const int grp = u >> 3;
        const int j = (u & 7) * 8 + (lane >> 3), q = grp * 8 + (lane & 7);
        const int row = row0 + j;
        const int col = q < 24 ? (q >> 3) * 512 + head * 64 + (q & 7) * 8 : 1536 + (q - 24) * 8;
        float cur[8], pr[8], nx[8], o[8];
        unpack8(make_uint4(lc[it7][0], lc[it7][1], lc[it7][2], lc[it7][3]), cur);
        unpack8(make_uint4(lp[it7][0], lp[it7][1], lp[it7][2], lp[it7][3]), pr);
        unpack8(make_uint4(ln[it7][0], ln[it7][1], ln[it7][2], ln[it7][3]), nx);
        {
          float4 c0 = *(const float4*)(cw + col), c1 = *(const float4*)(cw + col + 4);
          float4 d0 = *(const float4*)(cw + 1792 + col), d1 = *(const float4*)(cw + 1792 + col + 4);
          float4 e0 = *(const float4*)(cw + 3584 + col), e1 = *(const float4*)(cw + 3584 + col + 4);
          float wp[8] = {c0.x, c0.y, c0.z, c0.w, c1.x, c1.y, c1.z, c1.w};
          float wc[8] = {d0.x, d0.y, d0.z, d0.w, d1.x, d1.y, d1.z, d1.w};
          float wn_[8] = {e0.x, e0.y, e0.z, e0.w, e1.x, e1.y, e1.z, e1.w};
#pragma unroll
          for (int e = 0; e < 8; ++e) o[e] = wc[e] * cur[e] + wp[e] * pr[e] + wn_[e] * nx[e];
        }
        if (grp == 0) {
#pragma unroll
          for (int e = 0; e < 8; ++e) rs[j][(q & 7) * 8 + e] = o[e];
        } else if (grp == 1) {
#pragma unroll
          for (int e = 0; e < 8; ++e) ks[j][(q & 7) * 8 + e] = o[e];
        } else if (grp == 2) {
          *(uint4*)(SV + ((size_t)row * 8 + head) * SVH + 2 * 64 + (q & 7) * 8) = pack8(o);
        } else if (grp == 3) {
#pragma unroll
          for (int e = 0; e < 8; ++e) o[e] = 1.f - 2.f / (1.f + __expf(2.f * o[e]));
          *(uint4*)&TW[j][(q - 24) * 8] = pack8(o);
        } else if (grp == 4) {
          *(uint4*)&TA[j][(q - 32) * 8] = pack8(o);
        } else {
#pragma unroll
          for (int e = 0; e < 8; ++e) o[e] = sigm(o[e]);
          *(uint4*)&TG[j][(q - 40) * 8] = pack8(o);
        }
      }
    }
    __syncthreads();
    {
      int j = tid >> 2, part = tid & 3; float ss = 0.f;
#pragma unroll
      for (int e = 0; e < 16; ++e) { float v = ks[j][part * 16 + e] * p.in[I_RKK][head * 64 + part * 16 + e]; ss += v * v; }
      ss += __shfl_xor(ss, 1); ss += __shfl_xor(ss, 2);
      if (part == 0) rn[j] = 1.f / fmaxf(sqrtf(ss), 1e-12f);
    }
    __syncthreads();
    for (int pc = tid; pc < 64 * 8; pc += 256) {
      int j = pc >> 3, c8 = (pc & 7) * 8; int row = row0 + j;
      float fr[8], fk[8], fkk[8];
#pragma unroll
      for (int e = 0; e < 8; ++e) { fr[e] = rs[j][c8 + e]; fk[e] = ks[j][c8 + e]; fkk[e] = fk[e] * p.in[I_RKK][head * 64 + c8 + e] * rn[j]; }
      bf16_t* b = SV + ((size_t)row * 8 + head) * SVH;
      *(uint4*)(b + 0 * 64 + c8) = pack8(fr);
      *(uint4*)(b + 1 * 64 + c8) = pack8(fk);
      *(uint4*)(b + 3 * 64 + c8) = pack8(fkk);
    }
    {
      const int jl = warp * 16 + (lane & 15); const int row = row0 + jl;
      bf16x8 tw[2], ta[2], tg[4];
#pragma unroll
      for (int s2 = 0; s2 < 2; ++s2) { tw[s2] = *(const bf16x8*)&TW[jl][s2 * 32 + (lane >> 4) * 8]; ta[s2] = *(const bf16x8*)&TA[jl][s2 * 32 + (lane >> 4) * 8]; }
#pragma unroll
      for (int s2 = 0; s2 < 4; ++s2) tg[s2] = *(const bf16x8*)&TG[jl][s2 * 32 + (lane >> 4) * 8];
      __syncthreads();
      bf16_t(*OB)[64][72] = (bf16_t(*)[64][72])(smem + 2 * 64 * 65 * 4);
      float bon[2] = {0.f, 0.f};
#pragma unroll
      for (int dir = 0; dir < 2; ++dir) {
#pragma unroll
        for (int ct = 0; ct < 4; ++ct) {
          const int ch0 = ct * 16 + (lane >> 4) * 4;
          const int C0 = head * 64 + ch0;
          if (dir == 0) {
            f32x4 a = {0.f, 0.f, 0.f, 0.f};
#pragma unroll
            for (int s2 = 0; s2 < 4; ++s2) {
              bf16x8 wf = *(const bf16x8*)(GUP + (size_t)(head * 64 + ct * 16 + (lane & 15)) * 128 + s2 * 32 + (lane >> 4) * 8);
              a = __builtin_amdgcn_mfma_f32_16x16x32_bf16(wf, tg[s2], a, 0, 0, 0);
            }
            *(uint2*)&OB[2][jl][ch0] = make_uint2(pack2(a[0], a[1]), pack2(a[2], a[3]));
          }
          f32x4 aw = {0.f, 0.f, 0.f, 0.f}, aa = {0.f, 0.f, 0.f, 0.f};
#pragma unroll
          for (int s2 = 0; s2 < 2; ++s2) {
            size_t wo = (size_t)(dir * 512 + head * 64 + ct * 16 + (lane & 15)) * 64 + s2 * 32 + (lane >> 4) * 8;
            bf16x8 wf = *(const bf16x8*)(WUP + wo);
            bf16x8 af = *(const bf16x8*)(AUP + wo);
            aw = __builtin_amdgcn_mfma_f32_16x16x32_bf16(wf, tw[s2], aw, 0, 0, 0);
            aa = __builtin_amdgcn_mfma_f32_16x16x32_bf16(af, ta[s2], aa, 0, 0, 0);
          }
          const float4 w04 = *(const float4*)(p.in[I_RW0] + dir * 512 + C0), a04 = *(const float4*)(p.in[I_RA0] + dir * 512 + C0);
          const float4 ka4 = *(const float4*)(p.in[I_RKA] + C0), rk4 = *(const float4*)(p.in[I_RRK] + C0);
          const float w0v[4] = {w04.x, w04.y, w04.z, w04.w}, a0v[4] = {a04.x, a04.y, a04.z, a04.w};
          const float kav[4] = {ka4.x, ka4.y, ka4.z, ka4.w}, rkv[4] = {rk4.x, rk4.y, rk4.z, rk4.w};
          float we[4], av[4];
#pragma unroll
          for (int r = 0; r < 4; ++r) {
            we[r] = (0.60653066f * 1.44269504f) * sigm(w0v[r] + aw[r]);
            av[r] = sigm(a0v[r] + aa[r]);
            float kv = ks[jl][ch0 + r];
            float keff = kv * (1.f + (av[r] - 1.f) * kav[r]);
            bon[dir] += rs[jl][ch0 + r] * keff * rkv[r];
          }
          *(uint2*)&OB[0][jl][ch0] = make_uint2(pack2(we[0], we[1]), pack2(we[2], we[3]));
          *(uint2*)&OB[1][jl][ch0] = make_uint2(pack2(av[0], av[1]), pack2(av[2], av[3]));
        }
        __syncthreads();
        for (int pc = tid; pc < (dir == 0 ? 3 : 2) * 64 * 8; pc += 256) {
          const int vsel = pc >> 9, j = (pc >> 3) & 63, c8 = (pc & 7) * 8;
          const int vec = vsel == 2 ? 8 : (4 + 2 * dir + vsel);
          *(u32x4*)(SV + ((size_t)(row0 + j) * 8 + head) * SVH + vec * 64 + c8) = *(const u32x4*)&OB[vsel][j][c8];
        }
        __syncthreads();
      }
#pragma unroll
      for (int dir = 0; dir < 2; ++dir) {
        float sb = bon[dir]; sb += __shfl_xor(sb, 16); sb += __shfl_xor(sb, 32);
        if (lane < 16) bonus[(size_t)row * 16 + dir * 8 + head] = sb;
      }
    }
    __syncthreads();
  }
}

struct RwVec { uint4 k, kk, w, a, v, r; };
DEVI void unpack8p(const uint4& u, f32x2* f) {
  f[0] = f32x2{bflo(u.x), bfhi(u.x)}; f[1] = f32x2{bflo(u.y), bfhi(u.y)}; f[2] = f32x2{bflo(u.z), bfhi(u.z)}; f[3] = f32x2{bflo(u.w), bfhi(u.w)};
}
DEVI f32x2 bc2(float x) { return f32x2{x, x}; }
DEVI void rw_load(RwVec& x, const bf16_t* SV, int row, int head, int dir, int i, int jg, bool need_r) {
  const bf16_t* b = SV + ((size_t)row * 8 + head) * SVH;
  x.k = *(const uint4*)(b + 1 * 64 + jg * 8);
  x.kk = *(const uint4*)(b + 3 * 64 + jg * 8);
  x.w = *(const uint4*)(b + (4 + 2 * dir) * 64 + jg * 8);
  x.a = *(const uint4*)(b + (5 + 2 * dir) * 64 + jg * 8);
  x.v = *(const uint4*)(b + 2 * 64 + i * 8);
  if (need_r) x.r = *(const uint4*)(b + 0 * 64 + jg * 8);
}

DEVI void phase7(const Params& p) {
  const int lane = threadIdx.x & 63, warp = threadIdx.x >> 6, i = lane >> 3, jg = lane & 7;
  const bf16_t* SV = (const bf16_t*)(p.ws + R_SV);
  float* Pc = (float*)p.out;
  float* Bc = (float*)((unsigned char*)p.out + OUT_BC);
  for (int it = blockIdx.x * 4 + warp; it < (NCH - 1) * 16; it += gridDim.x * 4) {
    const int chunk = it >> 4, pair = it & 15, dir = pair >> 3, head = pair & 7;
    f32x2 S[8][4], P[8][4], ka[4];
#pragma unroll
    for (int a = 0; a < 8; ++a)
#pragma unroll
      for (int c = 0; c < 4; ++c) {
        S[a][c] = f32x2{0.f, 0.f};
        P[a][c] = f32x2{(i * 8 + a == jg * 8 + 2 * c) ? 1.f : 0.f, (i * 8 + a == jg * 8 + 2 * c + 1) ? 1.f : 0.f};
      }
#pragma unroll
    for (int c = 0; c < 4; ++c) ka[c] = f32x2{p.in[I_RKA][head * 64 + jg * 8 + 2 * c], p.in[I_RKA][head * 64 + jg * 8 + 2 * c + 1]};
    RwVec nx;
    rw_load(nx, SV, rw_row(chunk * LCH, dir), head, dir, i, jg, false);
#pragma unroll 1
    for (int t = 0; t < LCH; ++t) {
      RwVec cu = nx;
      if (t + 1 < LCH) rw_load(nx, SV, rw_row(chunk * LCH + t + 1, dir), head, dir, i, jg, false);
      f32x2 kv[4], kk[4], w[4], av[4], kka[4], keff[4]; float vv[8];
      unpack8p(cu.k, kv); unpack8p(cu.kk, kk); unpack8p(cu.w, w); unpack8p(cu.a, av); unpack8(cu.v, vv);
#pragma unroll
      for (int c = 0; c < 4; ++c) {
        w[c] = f32x2{__builtin_amdgcn_exp2f(-w[c][0]), __builtin_amdgcn_exp2f(-w[c][1])};
        kka[c] = -kk[c] * av[c];
        keff[c] = kv[c] * (bc2(1.f) + (av[c] - bc2(1.f)) * ka[c]);
      }
#pragma unroll
      for (int a = 0; a < 8; ++a) {
        f32x2 sa = S[a][0] * kk[0], qa = P[a][0] * kk[0];
#pragma unroll
        for (int c = 1; c < 4; ++c) { sa += S[a][c] * kk[c]; qa += P[a][c] * kk[c]; }
        float s1 = allred8(sa[0] + sa[1]), q1 = allred8(qa[0] + qa[1]);
        const f32x2 s2 = bc2(s1), q2 = bc2(q1), v2 = bc2(vv[a]);
#pragma unroll
        for (int c = 0; c < 4; ++c) {
          S[a][c] = S[a][c] * w[c] + s2 * kka[c] + v2 * keff[c];
          P[a][c] = P[a][c] * w[c] + q2 * kka[c];
        }
      }
    }
    float* po = Pc + ((size_t)chunk * 16 + pair) * 4096;
    float* bo = Bc + ((size_t)chunk * 16 + pair) * 4096;
#pragma unroll
    for (int a = 0; a < 8; ++a) {
      *(float4*)(po + (i * 8 + a) * 64 + jg * 8) = make_float4(P[a][0][0], P[a][0][1], P[a][1][0], P[a][1][1]);
      *(float4*)(po + (i * 8 + a) * 64 + jg * 8 + 4) = make_float4(P[a][2][0], P[a][2][1], P[a][3][0], P[a][3][1]);
      *(float4*)(bo + (i * 8 + a) * 64 + jg * 8) = make_float4(S[a][0][0], S[a][0][1], S[a][1][0], S[a][1][1]);
      *(float4*)(bo + (i * 8 + a) * 64 + jg * 8 + 4) = make_float4(S[a][2][0], S[a][2][1], S[a][3][0], S[a][3][1]);
    }
  }
}

template <bool DRY> DEVI void phase8(const Params& p, unsigned char* smem) {
  const bool wr = !DRY || (p.in[I_FG][0] == 1234.5f);
  float(*Sb)[16][68] = (float(*)[16][68])smem;
  const int tid = threadIdx.x, lane = tid & 63, warp = tid >> 6, q = lane >> 4, c16 = lane & 15;
  const float* Pc = (const float*)p.out;
  float* Bc = (float*)((unsigned char*)p.out + OUT_BC);
  constexpr int NS = NCH - 1;
  const size_t CS = (size_t)16 * 4096;
  for (int it = blockIdx.x; it < 64; it += gridDim.x) {
    const int pair = it >> 2, rg = it & 3;
    const float* Pp = Pc + (size_t)pair * 4096 + q * 64 + warp * 16 + c16;
    float* Bp = Bc + (size_t)pair * 4096 + (size_t)(rg * 16 + q * 4) * 64 + warp * 16 + c16;
    __syncthreads();
    {
      const int row = tid >> 4, c4 = (tid & 15) * 4;
      float4 v = *(const float4*)(Bc + (size_t)pair * 4096 + (size_t)(rg * 16 + row) * 64 + c4);
      Sb[0][row][c4] = v.x; Sb[0][row][c4 + 1] = v.y; Sb[0][row][c4 + 2] = v.z; Sb[0][row][c4 + 3] = v.w;
    }
    float pa[16], pb[16]; f32x4 ba, bb;
#pragma unroll
    for (int s2 = 0; s2 < 16; ++s2) { pa[s2] = Pp[CS + s2 * 256]; pb[s2] = Pp[2 * CS + s2 * 256]; }
#pragma unroll
    for (int r = 0; r < 4; ++r) { ba[r] = Bp[CS + r * 64]; bb[r] = Bp[2 * CS + r * 64]; }
    __syncthreads();
#define P8_STEP(c, pp, bv)                                                                                  \
    {                                                                                                        \
      const int rb = ((c) - 1) & 1;                                                                          \
      f32x4 acc0 = bv, acc1 = f32x4{0.f, 0.f, 0.f, 0.f};                                                     \
      _Pragma("unroll") for (int s2 = 0; s2 < 16; s2 += 2) {                                                 \
        acc0 = __builtin_amdgcn_mfma_f32_16x16x4f32(Sb[rb][c16][4 * s2 + q], pp[s2], acc0, 0, 0, 0);         \
        acc1 = __builtin_amdgcn_mfma_f32_16x16x4f32(Sb[rb][c16][4 * s2 + 4 + q], pp[s2 + 1], acc1, 0, 0, 0); \
      }                                                                                                      \
      acc0 += acc1;                                                                                          \
      if ((c) + 2 < NS) {                                                                                    \
        _Pragma("unroll") for (int s2 = 0; s2 < 16; ++s2) pp[s2] = Pp[(size_t)((c) + 2) * CS + s2 * 256];    \
        _Pragma("unroll") for (int r = 0; r < 4; ++r) bv[r] = Bp[(size_t)((c) + 2) * CS + r * 64];           \
      }                                                                                                      \
      _Pragma("unroll") for (int r = 0; r < 4; ++r) {                                                        \
        Sb[rb ^ 1][q * 4 + r][warp * 16 + c16] = acc0[r];                                                    \
        if (wr) Bp[(size_t)(c) * CS + r * 64] = acc0[r];                                                     \
      }                                                                                                      \
      __syncthreads();                                                                                       \
    }
    for (int c = 1; c < NS; c += 2) {
      P8_STEP(c, pa, ba)
      if (c + 1 < NS) P8_STEP(c + 1, pb, bb)
    }
#undef P8_STEP
  }
}

DEVI void phase9(const Params& p) {
  const int lane = threadIdx.x & 63, warp = threadIdx.x >> 6, i = lane >> 3, jg = lane & 7;
  const bf16_t* SV = (const bf16_t*)(p.ws + R_SV);
  const float* Bc = (const float*)((unsigned char*)p.out + OUT_BC);
  bf16_t* odir = (bf16_t*)p.out;
  for (int it = blockIdx.x * 4 + warp; it < NCH * 16; it += gridDim.x * 4) {
    const int chunk = it >> 4, pair = it & 15, dir = pair >> 3, head = pair & 7;
    f32x2 S[8][4], ka[4];
    if (chunk == 0) {
#pragma unroll
      for (int a = 0; a < 8; ++a)
#pragma unroll
        for (int c = 0; c < 4; ++c) S[a][c] = f32x2{0.f, 0.f};
    } else {
      const float* bs = Bc + ((size_t)(chunk - 1) * 16 + pair) * 4096;
#pragma unroll
      for (int a = 0; a < 8; ++a) {
        float4 x0 = *(const float4*)(bs + (i * 8 + a) * 64 + jg * 8), x1 = *(const float4*)(bs + (i * 8 + a) * 64 + jg * 8 + 4);
        S[a][0] = f32x2{x0.x, x0.y}; S[a][1] = f32x2{x0.z, x0.w}; S[a][2] = f32x2{x1.x, x1.y}; S[a][3] = f32x2{x1.z, x1.w};
      }
    }
#pragma unroll
    for (int c = 0; c < 4; ++c) ka[c] = f32x2{p.in[I_RKA][head * 64 + jg * 8 + 2 * c], p.in[I_RKA][head * 64 + jg * 8 + 2 * c + 1]};
    RwVec nx;
    rw_load(nx, SV, rw_row(chunk * LCH, dir), head, dir, i, jg, true);
#pragma unroll 1
    for (int t = 0; t < LCH; ++t) {
      RwVec cu = nx;
      const int row = rw_row(chunk * LCH + t, dir);
      if (t + 1 < LCH) rw_load(nx, SV, rw_row(chunk * LCH + t + 1, dir), head, dir, i, jg, true);
      f32x2 kv[4], kk[4], w[4], av[4], rr[4], kka[4], keff[4]; float vv[8];
      unpack8p(cu.k, kv); unpack8p(cu.kk, kk); unpack8p(cu.w, w); unpack8p(cu.a, av); unpack8p(cu.r, rr); unpack8(cu.v, vv);
#pragma unroll
      for (int c = 0; c < 4; ++c) {
        w[c] = f32x2{__builtin_amdgcn_exp2f(-w[c][0]), __builtin_amdgcn_exp2f(-w[c][1])};
        kka[c] = -kk[c] * av[c];
        keff[c] = kv[c] * (bc2(1.f) + (av[c] - bc2(1.f)) * ka[c]);
      }
      float ov = 0.f;
#pragma unroll
      for (int a = 0; a < 8; ++a) {
        f32x2 sa = S[a][0] * kk[0];
#pragma unroll
        for (int c = 1; c < 4; ++c) sa += S[a][c] * kk[c];
        const float s1 = allred8(sa[0] + sa[1]);
        const f32x2 s2 = bc2(s1), v2 = bc2(vv[a]);
        f32x2 oa = f32x2{0.f, 0.f};
#pragma unroll
        for (int c = 0; c < 4; ++c) {
          S[a][c] = S[a][c] * w[c] + s2 * kka[c] + v2 * keff[c];
          oa += S[a][c] * rr[c];
        }
        const float o = allred8(oa[0] + oa[1]);
        if (jg == a) ov = o;
      }
      if (row >= T_CTX) odir[((size_t)dir * T_LAT + (row - T_CTX)) * 512 + head * 64 + i * 8 + jg] = f2bf(ov);
    }
  }
}

DEVI void phase10(const Params& p) {
  const int lane = threadIdx.x & 63, warp = threadIdx.x >> 6;
  const bf16_t* odir = (const bf16_t*)p.out;
  const bf16_t* SV = (const bf16_t*)(p.ws + R_SV);
  const float* bonus = (const float*)(p.ws + O_BONUS);
  bf16_t* ya = (bf16_t*)(p.ws + O_PO);
  const int head = lane >> 3, c8 = (lane & 7) * 8, C0 = lane * 8;
#pragma unroll 2
  for (int t = blockIdx.x * 4 + warp; t < T_LAT; t += gridDim.x * 4) {
    const int row = t + T_CTX;
    const bf16_t* b = SV + ((size_t)row * 8 + head) * SVH;
    float v[8], g[8], y[8];
    unpack8(*(const uint4*)(b + 2 * 64 + c8), v);
    unpack8(*(const uint4*)(b + 8 * 64 + c8), g);
    float bs = bonus[(size_t)row * 16 + head] + bonus[(size_t)row * 16 + 8 + head];
#pragma unroll
    for (int e = 0; e < 8; ++e) y[e] = bs * v[e];
#pragma unroll
    for (int dir = 0; dir < 2; ++dir) {
      float o[8];
      unpack8(*(const uint4*)(odir + ((size_t)dir * T_LAT + t) * 512 + C0), o);
      float s = 0.f;
#pragma unroll
      for (int e = 0; e < 8; ++e) s += o[e];
      s = allred8(s);
      float mu = s * (1.f / 64.f);
      float q = 0.f;
#pragma unroll
      for (int e = 0; e < 8; ++e) { o[e] -= mu; q += o[e] * o[e]; }
      q = allred8(q);
      float rsd = rsqrtf(q * (1.f / 64.f) + 64e-5f);
#pragma unroll
      for (int e = 0; e < 8; ++e) y[e] += o[e] * rsd * p.in[I_RLNW][C0 + e] + p.in[I_RLNB][C0 + e];
    }
#pragma unroll
    for (int e = 0; e < 8; ++e) y[e] *= g[e];
    *(uint4*)(ya + (size_t)t * 512 + C0) = pack8(y);
  }
}

DEVI void phase11(const Params& p, unsigned char* smem, const XcdMap& xm) {
  const int lane = threadIdx.x & 63, warp = threadIdx.x >> 6, wm = warp >> 1, wn = warp & 1;
  const bf16_t* ya = (const bf16_t*)(p.ws + O_PO);
  const bf16_t* yb = (const bf16_t*)(p.ws + R_YA);
  const bf16_t* pg = (const bf16_t*)(p.ws + O_PG);
  bf16_t* mg = (bf16_t*)(p.ws + R_MERGED);
  for_tiles_xcd(xm, 128, 8, 8, 8, [&](int mt, int nt) {
    f32x4 acc[4][4];
    zero_acc(acc);
    gemm_core(ya + (size_t)mt * 128 * 512, 512, (const bf16_t*)(p.ws + O_WBA) + (size_t)nt * 128 * 512, 512, 512, acc, smem);
#pragma unroll
    for (int i = 0; i < 4; ++i) {
      int row = mt * 128 + wm * 64 + i * 16 + (lane & 15);
#pragma unroll
      for (int j = 0; j < 4; ++j) {
        int n = nt * 128 + wn * 64 + j * 16 + (lane >> 4) * 4;
        uint2 s = *(const uint2*)(pg + (size_t)row * 2048 + n);
        *(uint2*)(mg + (size_t)row * 1024 + n) = make_uint2(pack2(acc[i][j][0] * bflo(s.x), acc[i][j][1] * bfhi(s.x)), pack2(acc[i][j][2] * bflo(s.y), acc[i][j][3] * bfhi(s.y)));
      }
    }
    zero_acc(acc);
    gemm_core(yb + (size_t)mt * 128 * 512, 512, (const bf16_t*)(p.ws + O_WBB) + (size_t)nt * 128 * 512, 512, 512, acc, smem);
#pragma unroll
    for (int i = 0; i < 4; ++i) {
      int row = mt * 128 + wm * 64 + i * 16 + (lane & 15);
#pragma unroll
      for (int j = 0; j < 4; ++j) {
        int n = nt * 128 + wn * 64 + j * 16 + (lane >> 4) * 4;
        uint2 s = *(const uint2*)(pg + (size_t)row * 2048 + 1024 + n);
        uint2 m0 = *(const uint2*)(mg + (size_t)row * 1024 + n);
        float v0 = bflo(m0.x) + acc[i][j][0] * bflo(s.x), v1 = bfhi(m0.x) + acc[i][j][1] * bfhi(s.x);
        float v2 = bflo(m0.y) + acc[i][j][2] * bflo(s.y), v3 = bfhi(m0.y) + acc[i][j][3] * bfhi(s.y);
        *(uint2*)(mg + (size_t)row * 1024 + n) = make_uint2(pack2(v0, v1), pack2(v2, v3));
      }
    }
  });
}

DEVI void phase12(const Params& p, unsigned char* smem, const XcdMap& xm) {
  float* gt = (float*)(smem + 45056);
  const int tid = threadIdx.x, lane = tid & 63, warp = tid >> 6, wm = warp >> 1, wn = warp & 1;
  for (int i = tid; i < 1024; i += 256) gt[i] = mod_val(p, 0, 2048 + i);
  __syncthreads();
  const bf16_t* mg = (const bf16_t*)(p.ws + R_MERGED);
  const float* x = p.in[I_X];
  float* x1 = p.out;
  for_tiles_xcd(xm, 128, 8, 8, 8, [&](int mt, int nt) {
    f32x4 acc[4][4];
    zero_acc(acc);
    gemm_core(mg + (size_t)mt * 128 * 1024, 1024, (const bf16_t*)(p.ws + O_WOUT) + (size_t)nt * 128 * 1024, 1024, 1024, acc, smem);
#pragma unroll
    for (int i = 0; i < 4; ++i) {
      int row = mt * 128 + wm * 64 + i * 16 + (lane & 15);
#pragma unroll
      for (int j = 0; j < 4; ++j) {
        int n = nt * 128 + wn * 64 + j * 16 + (lane >> 4) * 4;
        float4 xv = *(const float4*)(x + (size_t)row * 1024 + n);
        xv.x += gt[n] * acc[i][j][0]; xv.y += gt[n + 1] * acc[i][j][1]; xv.z += gt[n + 2] * acc[i][j][2]; xv.w += gt[n + 3] * acc[i][j][3];
        *(float4*)(x1 + (size_t)row * 1024 + n) = xv;
      }
    }
  });
}

DEVI void phase13(const Params& p, unsigned char* smem) {
  float* smod = (float*)smem;
  const int tid = threadIdx.x, lane = tid & 63, warp = tid >> 6;
  for (int i = tid; i < 2048; i += 256) smod[i] = mod_val(p, 0, 3072 + i);
  __syncthreads();
  const float* x1 = p.out;
  bf16_t* h2 = (bf16_t*)(p.ws + R_H2);
  for (int rp = blockIdx.x * 4 + warp; rp < T_LAT / 2; rp += gridDim.x * 4) {
    float h[2][16]; float ss[2] = {0.f, 0.f};
#pragma unroll
    for (int u = 0; u < 2; ++u)
#pragma unroll
      for (int i = 0; i < 4; ++i) {
        float4 v = *(const float4*)(x1 + (size_t)(rp * 2 + u) * 1024 + i * 256 + lane * 4);
        h[u][4 * i] = v.x; h[u][4 * i + 1] = v.y; h[u][4 * i + 2] = v.z; h[u][4 * i + 3] = v.w;
        ss[u] += v.x * v.x + v.y * v.y + v.z * v.z + v.w * v.w;
      }
#pragma unroll
    for (int u = 0; u < 2; ++u) {
      const int row = rp * 2 + u;
      const float rstd = rsqrtf(wave_sum_u(ss[u]) * (1.f / 1024.f) + 1e-6f);
#pragma unroll
      for (int i = 0; i < 4; ++i) {
#pragma unroll
        for (int e = 0; e < 4; ++e) {
          int k = i * 256 + lane * 4 + e;
          float y = h[u][4 * i + e] * rstd * p.in[I_N2G][k];
          h[u][4 * i + e] = y * (1.f + smod[1024 + k]) + smod[k];
        }
        *(uint2*)(h2 + (size_t)row * 1024 + i * 256 + lane * 4) = make_uint2(pack2(h[u][4 * i], h[u][4 * i + 1]), pack2(h[u][4 * i + 2], h[u][4 * i + 3]));
      }
    }
  }
}

DEVI void phase14(const Params& p, unsigned char* smem, const XcdMap& xm) {
  bf16_t(*Qt)[136] = (bf16_t(*)[136])smem;
  float* Sc = (float*)smem;
  const int tid = threadIdx.x, lane = tid & 63, warp = tid >> 6, wm = warp >> 1, wn = warp & 1;
  const bf16_t* h2 = (const bf16_t*)(p.ws + R_H2);
  const bf16_t* keys = (const bf16_t*)(p.ws + O_KEYS);
  float* tops = (float*)(p.ws + R_TOPS);
  int* topi = (int*)(p.ws + R_TOPI);
  for_tiles_xcd(xm, 128, 16, 8, 8, [&](int mt, int hp) {
    f32x4 acc[4][4];
    zero_acc(acc);
    gemm_core(h2 + (size_t)mt * 128 * 1024, 1024, (const bf16_t*)(p.ws + O_WQ) + (size_t)hp * 128 * 1024, 1024, 1024, acc, smem);
#pragma unroll
    for (int i = 0; i < 4; ++i)
#pragma unroll
      for (int j = 0; j < 4; ++j)
        *(uint2*)&Qt[wm * 64 + i * 16 + (lane & 15)][wn * 64 + j * 16 + (lane >> 4) * 4] =
            make_uint2(pack2(acc[i][j][0], acc[i][j][1]), pack2(acc[i][j][2], acc[i][j][3]));
    __syncthreads();
    zero_acc(acc);
#pragma unroll
    for (int ks = 0; ks < 4; ++ks) {
      bf16x8 qf[4], kf[4];
#pragma unroll
      for (int i = 0; i < 4; ++i) qf[i] = *(const bf16x8*)&Qt[wm * 64 + i * 16 + (lane & 15)][ks * 32 + (lane >> 4) * 8];
#pragma unroll
      for (int j = 0; j < 4; ++j) kf[j] = *(const bf16x8*)(keys + ((size_t)hp * 128 + wn * 64 + j * 16 + (lane & 15)) * 128 + ks * 32 + (lane >> 4) * 8);
#pragma unroll
      for (int i = 0; i < 4; ++i)
#pragma unroll
        for (int j = 0; j < 4; ++j) acc[i][j] = __builtin_amdgcn_mfma_f32_16x16x32_bf16(kf[j], qf[i], acc[i][j], 0, 0, 0);
    }
    __syncthreads();
#pragma unroll
    for (int i = 0; i < 4; ++i)
#pragma unroll
      for (int j = 0; j < 4; ++j) {
        float* d = Sc + (wm * 64 + i * 16 + (lane & 15)) * 129 + wn * 64 + j * 16 + (lane >> 4) * 4;
        d[0] = acc[i][j][0]; d[1] = acc[i][j][1]; d[2] = acc[i][j][2]; d[3] = acc[i][j][3];
      }
    __syncthreads();
    {
      const int row = tid & 127, half = tid >> 7;
      float* hp_ = Sc + row * 129 + half * 64;
      float bv[16]; int bi[16];
#pragma unroll
      for (int r = 0; r < 16; ++r) {
        float best = -INFINITY; int b2 = 0;
#pragma unroll 8
        for (int k = 0; k < 64; ++k) { float v = hp_[k]; if (v > best) { best = v; b2 = k; } }
        bv[r] = best; bi[r] = b2 + half * 64; hp_[b2] = -INFINITY;
      }
#pragma unroll
      for (int r = 0; r < 16; ++r) { hp_[r] = bv[r]; hp_[16 + r] = __int_as_float(bi[r]); }
    }
    __syncthreads();
    if (tid < 128) {
      const float* la = Sc + tid * 129; const float* lb = la + 64;
      size_t ob = ((size_t)(mt * 128 + tid) * 16 + hp) * 16;
      int ia = 0, ib = 0;
      for (int r = 0; r < 16; ++r) {
        float va = la[ia], vb = lb[ib];
        bool ta = va >= vb;
        tops[ob + r] = ta ? va : vb;
        topi[ob + r] = __float_as_int(ta ? la[16 + ia] : lb[16 + ib]);
        ia += ta ? 1 : 0; ib += ta ? 0 : 1;
      }
    }
    __syncthreads();
  });
}

template <bool DRY> DEVI void phase15(const Params& p, unsigned char* smem) {
  const bool wr = !DRY || (p.in[I_FG][0] == 1234.5f);
  float* gt = (float*)smem;
  const int tid = threadIdx.x, lane = tid & 63, warp = tid >> 6;
  for (int i = tid; i < 1024; i += 256) gt[i] = mod_val(p, 0, 5120 + i);
  __syncthreads();
  const bf16_t* __restrict__ h2 = (const bf16_t*)(p.ws + R_H2);
  const float* __restrict__ tops = (const float*)(p.ws + R_TOPS);
  const int* __restrict__ topi = (const int*)(p.ws + R_TOPI);
  const unsigned char* __restrict__ uf8 = p.ws + R_UBF;
  const unsigned char* __restrict__ vf8 = p.ws + R_VBF;
  float* xo = p.out;
  int ca, cb;
  {
    int l = lane;
    if (l < 16) { ca = 0; cb = l; } else if (l < 24) { ca = 1; cb = l - 16; } else if (l < 29) { ca = 2; cb = l - 24; }
    else if (l < 33) { ca = 3; cb = l - 29; } else if (l < 36) { ca = 4; cb = l - 33; } else if (l < 38) { ca = 5; cb = l - 36; }
    else if (l < 40) { ca = 6; cb = l - 38; } else if (l < 42) { ca = 7; cb = l - 40; } else if (l < 50) { ca = l - 34; cb = 0; }
    else { ca = 0; cb = 0; }
  }
  const int flat = ca * 16 + cb;
  for (int t = blockIdx.x * 4 + warp; t < T_LAT; t += gridDim.x * 4) {
    float hv[16], out[16];
    {
      const u32x4 hp0 = *(const u32x4*)(h2 + (size_t)t * 1024 + lane * 16);
      const u32x4 hp1 = *(const u32x4*)(h2 + (size_t)t * 1024 + lane * 16 + 8);
#pragma unroll
      for (int e = 0; e < 4; ++e) { hv[2 * e] = bflo(hp0[e]); hv[2 * e + 1] = bfhi(hp0[e]); hv[8 + 2 * e] = bflo(hp1[e]); hv[8 + 2 * e + 1] = bfhi(hp1[e]); }
    }
#pragma unroll
    for (int e = 0; e < 16; ++e) out[e] = 0.f;
#pragma unroll 1
    for (int hd = 0; hd < 8; ++hd) {
      const size_t b1 = ((size_t)t * 16 + hd * 2) * 16, b2 = b1 + 16;
      float val = lane < 50 ? tops[b1 + ca] + tops[b2 + cb] : -INFINITY;
      int idx = topi[b1 + ca] * 128 + topi[b2 + cb];
      int cnt = 0;
#pragma unroll
      for (int i = 0; i < 50; ++i) {
        float vi = rlf(val, i);
        int fi = __builtin_amdgcn_readlane(flat, i);
        cnt += ((vi > val) || (vi == val && fi < flat)) ? 1 : 0;
      }
      bool sel = lane < 50 && cnt < 16;
      float vmax = rlf(val, 0);
      float ex = sel ? __expf(val - vmax) : 0.f;
      float gsum = wave_sum_u(ex);
      float g = ex / gsum;
      unsigned long long m1 = __ballot(sel);
      int es[16];
      float gq = 0.f;
#pragma unroll
      for (int q = 0; q < 16; ++q) {
        int src = __ffsll((long long)m1) - 1; m1 &= m1 - 1;
        es[q] = __builtin_amdgcn_readlane(idx, src);
        float gg = rlf(g, src);
        if (lane == q) gq = gg;
      }
      float dm = 0.f;
      {
        u32x4 ub[16];
#pragma unroll
        for (int q = 0; q < 16; ++q) ub[q] = *(const u32x4*)(uf8 + (size_t)es[q] * 1024 + lane * 16);
#pragma unroll
        for (int q = 0; q < 16; ++q) {
          float f[16]; unpack_fp8x16(ub[q], f);
          float d0 = 0.f, d1 = 0.f;
#pragma unroll
          for (int e = 0; e < 8; ++e) { d0 += f[2 * e] * hv[2 * e]; d1 += f[2 * e + 1] * hv[2 * e + 1]; }
          float d = wave_sum_u(d0 + d1);
          if (lane == q) dm = d;
        }
      }
      dm *= (1.f / 64.f);
      float coef = gq * 0.5f * dm * (1.f + erff(dm * 0.70710678118f)) * 0.25f;
      {
        u32x4 vb[16];
#pragma unroll
        for (int q = 0; q < 16; ++q) vb[q] = *(const u32x4*)(vf8 + (size_t)es[q] * 1024 + lane * 16);
#pragma unroll
        for (int q = 0; q < 16; ++q) {
          float cf = rlf(coef, q);
          float f[16]; unpack_fp8x16(vb[q], f);
#pragma unroll
          for (int e = 0; e < 16; ++e) out[e] += cf * f[e];
        }
      }
    }
    float xs[16]; float ss = 0.f;
#pragma unroll
    for (int i = 0; i < 4; ++i) {
      int k = lane * 16 + i * 4;
      float4 v = *(const float4*)(xo + (size_t)t * 1024 + k);
      xs[4 * i] = v.x + gt[k] * out[4 * i]; xs[4 * i + 1] = v.y + gt[k + 1] * out[4 * i + 1];
      xs[4 * i + 2] = v.z + gt[k + 2] * out[4 * i + 2]; xs[4 * i + 3] = v.w + gt[k + 3] * out[4 * i + 3];
      ss += xs[4 * i] * xs[4 * i] + xs[4 * i + 1] * xs[4 * i + 1] + xs[4 * i + 2] * xs[4 * i + 2] + xs[4 * i + 3] * xs[4 * i + 3];
    }
    ss = wave_sum_u(ss);
    float rstd = rsqrtf(ss * (1.f / 1024.f) + 1e-6f);
#pragma unroll
    for (int i = 0; i < 4; ++i) {
      int k = lane * 16 + i * 4;
      float4 g4 = *(const float4*)(p.in[I_FG] + k);
      if (wr) *(float4*)(xo + (size_t)t * 1024 + k) = make_float4(xs[4 * i] * rstd * g4.x, xs[4 * i + 1] * rstd * g4.y, xs[4 * i + 2] * rstd * g4.z, xs[4 * i + 3] * rstd * g4.w);
    }
  }
}

#define XB_TMO      128
#define XB_XCNT(j)  (256  + 64 * (j))
#define XB_XSUB(j)  (1280 + 64 * (j))
#define XB_XGEN(j)  (2304 + 64 * (j))
#define XB_TOP      3328
#define XB_TOPGEN   3392
#define XCD_BAR_WORDS 3456
#define XB_SPIN_CAP (1u << 22)
#define LAS __attribute__((address_space(3)))
DEVI unsigned xb_ld(unsigned* p) { return __hip_atomic_load(p, __ATOMIC_RELAXED, __HIP_MEMORY_SCOPE_AGENT); }
DEVI unsigned xb_add(unsigned* p, unsigned v) { return __hip_atomic_fetch_add(p, v, __ATOMIC_RELAXED, __HIP_MEMORY_SCOPE_AGENT); }
DEVI unsigned xb_xcc_id() { return (unsigned)__builtin_amdgcn_s_getreg((3 << 11) | 20) & 0xFu; }
#define XB_SPIN(cond, bar) do { unsigned _sp = 0; while (cond) { __builtin_amdgcn_s_sleep(1); \
    if ((++_sp & 255u) == 0u) { if (xb_ld(&(bar)[XB_TMO])) break; if (_sp > XB_SPIN_CAP) { atomicAdd(&(bar)[XB_TMO], 1u); break; } } } } while (0)
struct XcdBarrier { unsigned* bar; unsigned x; volatile LAS unsigned* st; };
DEVI XcdBarrier xcd_barrier_post(unsigned* bar, volatile LAS unsigned* st) {
  XcdBarrier b; b.bar = bar; b.x = xb_xcc_id(); b.st = st;
  if (threadIdx.x == 0) st[2] = xb_add(&bar[XB_XCNT(b.x)], 1u);
  return b;
}
DEVI void xcd_barrier_complete(unsigned* bar, unsigned x, unsigned& nloc, unsigned& nx, unsigned& vidx) {
  const unsigned G = gridDim.x * gridDim.y * gridDim.z;
  unsigned sum, cnt, mine, below, sp = 0u;
  for (;;) {
    sum = 0u; cnt = 0u; mine = 0u; below = 0u;
#pragma unroll
    for (unsigned j = 0; j < 16; ++j) { const unsigned c = xb_ld(&bar[XB_XCNT(j)]); sum += c; cnt += (c > 0u) ? 1u : 0u; mine = (j == x) ? c : mine; below += (c > 0u && j < x) ? 1u : 0u; }
    if (sum == G) break;
    __builtin_amdgcn_s_sleep(1);
    if ((++sp & 255u) == 0u) { if (xb_ld(&bar[XB_TMO])) break; if (sp > XB_SPIN_CAP) { atomicAdd(&bar[XB_TMO], 1u); break; } }
  }
  nloc = mine > 0u ? mine : 1u; nx = cnt > 0u ? cnt : 1u; vidx = below;
}
DEVI void xcd_barrier(const XcdBarrier& b) {
  asm volatile("s_waitcnt vmcnt(0)" ::: "memory");
  __syncthreads();
  if (threadIdx.x == 0) {
    unsigned* bar = b.bar;
    __builtin_amdgcn_s_waitcnt(0);
    unsigned nloc = b.st[0], nx = b.st[1];
    if (nloc == 0u) { unsigned vidx; xcd_barrier_complete(bar, b.x, nloc, nx, vidx); b.st[0] = nloc; b.st[1] = nx; b.st[3] = vidx; }
    const unsigned old = xb_add(&bar[XB_XSUB(b.x)], 1u);
    const unsigned gen = old / nloc;
    if (old + 1u == (gen + 1u) * nloc) {
      __builtin_amdgcn_fence(__ATOMIC_RELEASE, "agent");
      asm volatile("s_waitcnt vmcnt(0)" ::: "memory");
      const unsigned og = xb_add(&bar[XB_TOP], 1u);
      const unsigned tg = og / nx;
      if (og + 1u == (tg + 1u) * nx) xb_add(&bar[XB_TOPGEN], 1u);
      else XB_SPIN(xb_ld(&bar[XB_TOPGEN]) == tg, bar);
      __builtin_amdgcn_fence(__ATOMIC_ACQUIRE, "agent");
      xb_add(&bar[XB_XGEN(b.x)], 1u);
      asm volatile("s_waitcnt vmcnt(0)" ::: "memory");
    } else {
      XB_SPIN(xb_ld(&bar[XB_XGEN(b.x)]) == gen, bar);
      __builtin_amdgcn_fence(__ATOMIC_ACQUIRE, "agent");
      asm volatile("s_waitcnt vmcnt(0)" ::: "memory");
    }
  }
  __syncthreads();
}

constexpr int NPHASE = 16;
DEVI XcdMap get_xm(int coop, const uint4& w) {
  XcdMap m;
  if (coop) { m.v = (int)w.w; m.nx = (int)w.y; m.slot = (int)w.z; m.slots = (int)w.x; }
  else { m.v = blockIdx.x & 7; m.nx = 8; m.slot = blockIdx.x >> 3; m.slots = gridDim.x >> 3; if (m.slots < 1) { m.slots = 1; } }
  return m;
}
__global__ void __launch_bounds__(256, 2) mk(Params p, int ph0, int ph1, int coop) {
  __shared__ __attribute__((aligned(16))) unsigned char smem[SMEM_BYTES];
  __shared__ uint4 xb_words;
  if (threadIdx.x == 0) xb_words = make_uint4(0u, 0u, 0u, 0u);
  __syncthreads();
  XcdBarrier xb;
  if (coop) xb = xcd_barrier_post((unsigned*)(p.ws + O_BAR), (volatile LAS unsigned*)&xb_words);
#ifdef XCC_PROBE
  if (coop && xb_xcc_id() != (blockIdx.x & 7u)) { unsigned long long t0 = wall_clock64(); while (wall_clock64() - t0 < 100000ull) __builtin_amdgcn_s_sleep(8); }
#endif
  if (ph0 < 0) cg::this_grid().sync();
#ifdef PROBE_A
#define STAMP(n) if (blockIdx.x == 0 && threadIdx.x == 0) ((unsigned long long*)(p.ws + O_STAMP))[n] = wall_clock64();
#else
#define STAMP(n)
#endif
#define RUN_PHASE(n, call)                                   \
  if (ph0 <= n && n < ph1) {                                 \
    STAMP(n)                                                 \
        if (DRY_PH == n) { if (n == 4) phase4<true>(p); if (n == 5) phase5<true>(p, smem); if (n == 8) phase8<true>(p, smem); if (n == 15) phase15<true>(p, smem); } \
    if (ONLY < 0 || ONLY == n) { call; }                     \
    if (REPEAT_PH == n) { call; }                            \
    if (coop && n + 1 < ph1) xcd_barrier(xb);                \
  }
  RUN_PHASE(0, phase0(p, smem))
  RUN_PHASE(1, phase1(p, smem))
  RUN_PHASE(2, phase2(p, smem, get_xm(coop, xb_words)))
  RUN_PHASE(3, phase3(p, smem))
  RUN_PHASE(4, (phase4<false>(p), phase6(p, smem, 0, 32, gridDim.x > 290 ? 258 : 0, gridDim.x > 290 ? (int)gridDim.x - 258 : (int)gridDim.x)))
  RUN_PHASE(5, phase5<false>(p, smem))
  RUN_PHASE(6, phase6(p, smem, 32, 260 * 8, 0, (int)gridDim.x))
  RUN_PHASE(7, phase7(p))
  RUN_PHASE(8, phase8<false>(p, smem))
  RUN_PHASE(9, phase9(p))
  RUN_PHASE(10, phase10(p))
  RUN_PHASE(11, phase11(p, smem, get_xm(coop, xb_words)))
  RUN_PHASE(12, (phase12(p, smem, get_xm(coop, xb_words)), convert_fp8(p.in[I_PU], p.ws + R_UBF, (size_t)16384 * 64, 64.f)))
  RUN_PHASE(13, phase13(p, smem))
  RUN_PHASE(14, (phase14(p, smem, get_xm(coop, xb_words)), convert_fp8(p.in[I_PV], p.ws + R_VBF, (size_t)16384 * 64, 4.f)))
  RUN_PHASE(15, phase15<false>(p, smem))
#ifdef SYNC_EXTRA
  for (int i = 0; i < SYNC_EXTRA; ++i) xcd_barrier(xb);
#endif
#ifdef PROBE_A
  cg::this_grid().sync();
  STAMP(16)
  __syncthreads();
  if (blockIdx.x == 0) {
    const unsigned long long* st = (const unsigned long long*)(p.ws + O_STAMP);
    float ta = (float)(st[PROBE_A + 1] - st[PROBE_A]) * 0.01f, tb = (float)(st[PROBE_B + 1] - st[PROBE_B]) * 0.01f;
    for (int i = threadIdx.x; i < 1000000; i += 256) p.out[1 + i] = tb;
    if (threadIdx.x == 0) p.out[0] = 100.f * ta;
  }
#endif
}

extern "C" void kernel_launch(void* const* d_in, const int* in_sizes, int n_in, void* d_out, int out_size, void* d_ws,
                              size_t ws_size, hipStream_t stream) {
  static int grid_blocks = 0;
  if (!grid_blocks) {
    int dev = 0, cus = 0, per_cu = 0;
    hipGetDevice(&dev);
    hipDeviceGetAttribute(&cus, hipDeviceAttributeMultiprocessorCount, dev);
    hipOccupancyMaxActiveBlocksPerMultiprocessor(&per_cu, mk, 256, 0);
    if (per_cu < 1) per_cu = 1;
    if (per_cu > 2) per_cu = 2;
    grid_blocks = cus * per_cu;
  }
  if (ws_size < WS_NEED) { fprintf(stderr, "workspace too small: %zu < %zu\n", ws_size, (size_t)WS_NEED); return; }
  Params p{};
  for (int i = 0; i < 32; ++i) p.in[i] = (const float*)d_in[i];
  p.out = (float*)d_out;
  p.ws = (unsigned char*)d_ws;
#if MEGA
  (void)hipMemsetAsync((unsigned char*)d_ws + O_BAR, 0, XCD_BAR_WORDS * 4, stream);
  int ph0 = 0, ph1 = NPHASE, coop = 1;
  void* args[] = {&p, &ph0, &ph1, &coop};
  hipError_t e = hipLaunchCooperativeKernel((void*)mk, dim3(grid_blocks), dim3(256), args, 0, stream);
  if (e != hipSuccess) fprintf(stderr, "cooperative launch failed: %s (grid %d)\n", hipGetErrorString(e), grid_blocks);
#else
  for (int ph = 0; ph < NPHASE; ++ph) mk<<<grid_blocks, 256, 0, stream>>>(p, ph, ph + 1, 0);
#endif
}
```

```cpp
#include <hip/hip_runtime.h>
#include <hip/hip_cooperative_groups.h>
#include <cstdio>
#include <cstdint>
namespace cg = cooperative_groups;

#ifndef MEGA
#define MEGA 1
#endif
#ifndef ONLY
#define ONLY -1
#endif
#ifndef REPEAT_PH
#define REPEAT_PH -1
#endif
#ifndef DRY_PH
#define DRY_PH -1
#endif

typedef unsigned short bf16_t;
using bf16x8 = __attribute__((ext_vector_type(8))) short;
using f32x4 = __attribute__((ext_vector_type(4))) float;
using u32x4 = __attribute__((ext_vector_type(4))) unsigned;
#define DEVI __device__ __forceinline__

constexpr int T_CTX = 256, T_LAT = 16384, T_ALL = 16640;
constexpr int NIN = 5392, NP = 5376;
constexpr int NCH = 128, LCH = 130;
constexpr int SVH = 576;
constexpr int SMEM_BYTES = 71680;

enum { I_X = 0, I_C, I_CTX, I_CCTX, I_ADAW, I_ADAB, I_N1G, I_WIN, I_RCONV, I_RW0, I_RWUP, I_RA0, I_RAUP, I_RGUP,
       I_RKK, I_RKA, I_RRK, I_RLNW, I_RLNB, I_MCONV, I_MIB, I_MFB, I_MNG, I_WBA, I_WBB, I_WOUT, I_N2G, I_WQ,
       I_KEYS, I_PU, I_PV, I_FG };

struct Params { const float* in[32]; float* out; unsigned char* ws; };

constexpr size_t A256(size_t x) { return (x + 255) & ~(size_t)255; }
constexpr size_t O_MODP = 0;
constexpr size_t O_WBA = A256(O_MODP + (size_t)16 * 2 * 6144 * 4);
constexpr size_t O_WBB = A256(O_WBA + (size_t)1024 * 512 * 2);
constexpr size_t O_WOUT = A256(O_WBB + (size_t)1024 * 512 * 2);
constexpr size_t O_WQ = A256(O_WOUT + (size_t)1024 * 1024 * 2);
constexpr size_t O_KEYS = A256(O_WQ + (size_t)2048 * 1024 * 2);
constexpr size_t O_WUP = A256(O_KEYS + (size_t)16 * 128 * 128 * 2);
constexpr size_t O_AUP = A256(O_WUP + (size_t)1024 * 64 * 2);
constexpr size_t O_GUP = A256(O_AUP + (size_t)1024 * 64 * 2);
constexpr size_t O_BEND = A256(O_GUP + (size_t)512 * 128 * 2);
constexpr size_t O_MLOC = A256(O_BEND + (size_t)260 * 8 * 4);
constexpr size_t O_MST = A256(O_MLOC + (size_t)260 * 8 * 4);
constexpr size_t O_NT = A256(O_MST + (size_t)260 * 8 * 4);
constexpr size_t O_BONUS = A256(O_NT + (size_t)260 * 8 * 64 * 4);
constexpr size_t O_STAMP = A256(O_BONUS + (size_t)T_ALL * 16 * 4);
constexpr size_t O_BAR = A256(O_STAMP + 1024);
constexpr size_t O_PG = A256(O_BAR + 3456 * 4);
constexpr size_t O_PO = A256(O_PG + (size_t)T_LAT * 2048 * 2);
constexpr size_t O_R = A256(O_PO + (size_t)T_LAT * 512 * 2);
constexpr size_t R_HX = O_R;
constexpr size_t R_WIN = A256(R_HX + (size_t)T_ALL * 1024 * 2);
constexpr size_t R_PQK = A256(R_WIN + (size_t)(NP + 128) * 1024 * 2);
constexpr size_t R_PV = A256(R_PQK + (size_t)T_ALL * 512 * 2);
constexpr size_t R_GIF = A256(R_PV + (size_t)T_ALL * 512 * 2);
constexpr size_t R_U = A256(R_GIF + (size_t)T_ALL * 16 * 4);
constexpr size_t R_END1 = A256(R_U + (size_t)260 * 8 * 8192 * 4);
constexpr size_t R_SV = O_R;
constexpr size_t R_YA = A256(R_SV + (size_t)T_ALL * 8 * SVH * 2);
constexpr size_t R_END2 = A256(R_YA + (size_t)T_LAT * 512 * 2);
constexpr size_t R_MERGED = O_R;
constexpr size_t R_H2 = A256(R_MERGED + (size_t)T_LAT * 1024 * 2);
constexpr size_t R_TOPS = A256(R_H2 + (size_t)T_LAT * 1024 * 2);
constexpr size_t R_TOPI = A256(R_TOPS + (size_t)T_LAT * 256 * 4);
constexpr size_t R_UBF = A256(R_TOPI + (size_t)T_LAT * 256 * 4);
constexpr size_t R_VBF = A256(R_UBF + (size_t)16384 * 1024 * 2);
constexpr size_t R_END3 = A256(R_VBF + (size_t)16384 * 1024 * 2);
constexpr size_t WS_NEED = (R_END1 > R_END2 ? (R_END1 > R_END3 ? R_END1 : R_END3) : (R_END2 > R_END3 ? R_END2 : R_END3));
constexpr size_t OUT_BC = (size_t)NCH * 16 * 4096 * 4;

DEVI bf16_t f2bf(float f) { unsigned u = __float_as_uint(f); u += 0x7fffu + ((u >> 16) & 1u); return (bf16_t)(u >> 16); }
DEVI float bf2f(bf16_t h) { return __uint_as_float(((unsigned)h) << 16); }
DEVI float bflo(unsigned u) { return __uint_as_float(u << 16); }
DEVI float bfhi(unsigned u) { return __uint_as_float(u & 0xffff0000u); }
DEVI unsigned pack2(float a, float b) { return (unsigned)f2bf(a) | ((unsigned)f2bf(b) << 16); }
DEVI void unpack8(const uint4& u, float* f) {
  f[0] = bflo(u.x); f[1] = bfhi(u.x); f[2] = bflo(u.y); f[3] = bfhi(u.y);
  f[4] = bflo(u.z); f[5] = bfhi(u.z); f[6] = bflo(u.w); f[7] = bfhi(u.w);
}
DEVI uint4 pack8(const float* f) { return make_uint4(pack2(f[0], f[1]), pack2(f[2], f[3]), pack2(f[4], f[5]), pack2(f[6], f[7])); }
DEVI float wave_sum(float v) {
#pragma unroll
  for (int o = 32; o; o >>= 1) v += __shfl_xor(v, o);
  return v;
}
DEVI float wave_max(float v) {
#pragma unroll
  for (int o = 32; o; o >>= 1) v = fmaxf(v, __shfl_xor(v, o));
  return v;
}
DEVI float sigm(float x) { return 1.f / (1.f + __expf(-x)); }
DEVI float siluf(float x) { return x / (1.f + __expf(-x)); }
DEVI float logsig(float x) { return fminf(x, 0.f) - log1pf(expf(-fabsf(x))); }
template <int CTRL> DEVI float dppf(float v) { return __int_as_float(__builtin_amdgcn_update_dpp(0, __float_as_int(v), CTRL, 0xf, 0xf, true)); }
DEVI float rlf(float v, int l) { return __int_as_float(__builtin_amdgcn_readlane(__float_as_int(v), l)); }
DEVI float wave_sum_u(float v) {
  v += dppf<0xB1>(v); v += dppf<0x4E>(v); v += dppf<0x141>(v); v += dppf<0x140>(v);
  return (rlf(v, 0) + rlf(v, 16)) + (rlf(v, 32) + rlf(v, 48));
}
typedef __attribute__((ext_vector_type(2))) short s16x2;
DEVI float dot2bf(unsigned a, unsigned b, float c) { return __builtin_amdgcn_fdot2_f32_bf16(__builtin_bit_cast(s16x2, a), __builtin_bit_cast(s16x2, b), c, false); }
typedef __attribute__((ext_vector_type(2))) float f32x2;
DEVI void convert_fp8(const float* __restrict__ src, unsigned char* __restrict__ dst, size_t n16, float scale) {
  for (size_t g = (size_t)blockIdx.x * 256 + threadIdx.x; g < n16; g += (size_t)gridDim.x * 256) {
    u32x4 o;
#pragma unroll
    for (int q = 0; q < 4; ++q) {
      float4 a = *(const float4*)(src + g * 16 + q * 4);
      int pk = __builtin_amdgcn_cvt_pk_fp8_f32(a.x * scale, a.y * scale, 0, false);
      pk = __builtin_amdgcn_cvt_pk_fp8_f32(a.z * scale, a.w * scale, pk, true);
      o[q] = (unsigned)pk;
    }
    *(u32x4*)(dst + g * 16) = o;
  }
}
DEVI void unpack_fp8x16(const u32x4& u, float* f) {
#pragma unroll
  for (int q = 0; q < 4; ++q) {
    f32x2 lo = __builtin_amdgcn_cvt_pk_f32_fp8((int)u[q], false), hi = __builtin_amdgcn_cvt_pk_f32_fp8((int)u[q], true);
    f[4 * q] = lo[0]; f[4 * q + 1] = lo[1]; f[4 * q + 2] = hi[0]; f[4 * q + 3] = hi[1];
  }
}
DEVI void convert_bf16(const float* __restrict__ src, bf16_t* __restrict__ dst, size_t n8) {
  for (size_t g = (size_t)blockIdx.x * 256 + threadIdx.x; g < n8; g += (size_t)gridDim.x * 256) {
    float4 a = *(const float4*)(src + g * 8), b = *(const float4*)(src + g * 8 + 4);
    *(uint4*)(dst + g * 8) = make_uint4(pack2(a.x, a.y), pack2(a.z, a.w), pack2(b.x, b.y), pack2(b.z, b.w));
  }
}
DEVI float allred8(float v) { v += dppf<0xB1>(v); v += dppf<0x4E>(v); v += dppf<0x141>(v); return v; }

DEVI int ml_row(int c, int j) {
  if (c < 4) return c * 64 + j;
  int cc = c - 4; int col = cc >> 2; int gr = (cc & 3) * 64 + j;
  return T_CTX + gr * 64 + col;
}
DEVI int ml_sc(int c, int dir) { return dir == 0 ? c : (c < 4 ? 3 - c : 263 - c); }
DEVI int rw_row(int p, int dir) { return dir == 0 ? p : (p < T_CTX ? (T_CTX - 1 - p) : (T_ALL + T_CTX - 1 - p)); }

DEVI float mod_val(const Params& p, int which, int col) {
  const float* modp = (const float*)(p.ws + O_MODP);
  float s = p.in[I_ADAB][col];
#pragma unroll
  for (int rs = 0; rs < 16; ++rs) s += modp[(rs * 2 + which) * 6144 + col];
  return s;
}

DEVI void gemm_core(const bf16_t* __restrict__ A, int lda, const bf16_t* __restrict__ Bt, int ldb, int K,
                    f32x4 (&acc)[4][4], unsigned char* smem) {
  bf16_t(*sa)[80] = (bf16_t(*)[80])smem;
  bf16_t(*sb)[80] = (bf16_t(*)[80])(smem + 128 * 80 * 2);
  const int tid = threadIdx.x, lane = tid & 63, warp = tid >> 6, wm = warp >> 1, wn = warp & 1;
  const int lr = tid >> 3, lk = (tid & 7) * 8;
  const bf16_t* Ap = A + (size_t)lr * lda + lk;
  const bf16_t* Bp = Bt + (size_t)lr * ldb + lk;
  u32x4 ra0[4], rb0[4], ra1[4], rb1[4];
#pragma unroll
  for (int i = 0; i < 4; ++i) {
    ra0[i] = *(const u32x4*)(Ap + (size_t)(32 * i) * lda); rb0[i] = *(const u32x4*)(Bp + (size_t)(32 * i) * ldb);
    ra1[i] = *(const u32x4*)(Ap + (size_t)(32 * i) * lda + 64); rb1[i] = *(const u32x4*)(Bp + (size_t)(32 * i) * ldb + 64);
  }
#define GEMM_STEP(k0, ra, rb)                                                                                 \
  {                                                                                                           \
    __syncthreads();                                                                                          \
    _Pragma("unroll") for (int i = 0; i < 4; ++i) { *(u32x4*)&sa[lr + 32 * i][lk] = ra[i]; *(u32x4*)&sb[lr + 32 * i][lk] = rb[i]; } \
    __syncthreads();                                                                                          \
    if ((k0) + 128 < K) {                                                                                     \
      _Pragma("unroll") for (int i = 0; i < 4; ++i) {                                                         \
        ra[i] = *(const u32x4*)(Ap + (size_t)(32 * i) * lda + (k0) + 128);                                    \
        rb[i] = *(const u32x4*)(Bp + (size_t)(32 * i) * ldb + (k0) + 128);                                    \
      }                                                                                                       \
    }                                                                                                         \
    __builtin_amdgcn_s_setprio(1);                                                                            \
    _Pragma("unroll") for (int ks = 0; ks < 2; ++ks) {                                                        \
      bf16x8 af[4], bq[4];                                                                                    \
      _Pragma("unroll") for (int i = 0; i < 4; ++i) af[i] = *(const bf16x8*)&sa[wm * 64 + i * 16 + (lane & 15)][ks * 32 + (lane >> 4) * 8]; \
      _Pragma("unroll") for (int j = 0; j < 4; ++j) bq[j] = *(const bf16x8*)&sb[wn * 64 + j * 16 + (lane & 15)][ks * 32 + (lane >> 4) * 8]; \
      _Pragma("unroll") for (int i = 0; i < 4; ++i)                                                           \
        _Pragma("unroll") for (int j = 0; j < 4; ++j) acc[i][j] = __builtin_amdgcn_mfma_f32_16x16x32_bf16(bq[j], af[i], acc[i][j], 0, 0, 0); \
    }                                                                                                         \
    __builtin_amdgcn_s_setprio(0);                                                                            \
  }
  for (int k0 = 0; k0 < K; k0 += 128) {
    GEMM_STEP(k0, ra0, rb0)
    GEMM_STEP(k0 + 64, ra1, rb1)
  }
#undef GEMM_STEP
  __syncthreads();
}
DEVI void zero_acc(f32x4 (&acc)[4][4]) {
#pragma unroll
  for (int i = 0; i < 4; ++i)
#pragma unroll
    for (int j = 0; j < 4; ++j) acc[i][j] = f32x4{0.f, 0.f, 0.f, 0.f};
}

struct XcdMap { int v, nx, slot, slots; };
template <typename F> DEVI void for_tiles_xcd(const XcdMap& xm, int MT, int NT, int SM, int SN, F&& f) {
  const int nsn = (NT + SN - 1) / SN, nst = ((MT + SM - 1) / SM) * nsn, per = SM * SN;
  const int n_my = (nst - xm.v + xm.nx - 1) / xm.nx;
  for (int g = xm.slot; g < n_my * per; g += xm.slots) {
    const int s = xm.v + (g / per) * xm.nx, idx = g % per;
    const int sm = s / nsn, sn = s % nsn;
    const int mt = sm * SM + idx / SN, nt = sn * SN + idx % SN;
    if (mt < MT && nt < NT) f(mt, nt);
  }
}

DEVI void tr_tile(const float* __restrict__ src, int lds, int k0, int n0src, bf16_t* __restrict__ dst, int ldd, int n0dst,
                  unsigned char* smem) {
  float(*tile)[65] = (float(*)[65])smem;
  const int tid = threadIdx.x, j = tid & 63, i0 = tid >> 6;
#pragma unroll 4
  for (int ii = 0; ii < 16; ++ii) { int i = i0 + 4 * ii; tile[i][j] = src[(size_t)(k0 + i) * lds + n0src + j]; }
  __syncthreads();
#pragma unroll 4
  for (int jj = 0; jj < 16; ++jj) { int jn = i0 + 4 * jj; dst[(size_t)(n0dst + jn) * ldd + k0 + j] = f2bf(tile[j][jn]); }
  __syncthreads();
}

DEVI void phase0(const Params& p, unsigned char* smem) {
  const int tid = threadIdx.x;
  constexpr int N_MOD = 384, N_WIN = 16 * 85, N_WB = 128, N_WOUT = 256, N_WQ = 512, N_LORA = 16, N_GUP = 16, N_KEYS = 128;
  constexpr int E0 = N_MOD, E1 = E0 + N_WIN, E2 = E1 + N_WB, E3 = E2 + N_WB, E4 = E3 + N_WOUT, E5 = E4 + N_WQ,
                E6 = E5 + N_LORA, E7 = E6 + N_LORA, E8 = E7 + N_GUP, E9 = E8 + N_KEYS;
  for (int it = blockIdx.x; it < E9; it += gridDim.x) {
    if (it < E0) {
      int cb = it % 24, rs = it / 24; int col = cb * 256 + tid;
      const float* aw = p.in[I_ADAW];
      float ax = 0.f, ac = 0.f;
#pragma unroll 8
      for (int r = rs * 64; r < rs * 64 + 64; ++r) {
        float w = aw[(size_t)r * 6144 + col];
        ax += siluf(p.in[I_C][r]) * w;
        ac += siluf(p.in[I_CCTX][r]) * w;
      }
      float* modp = (float*)(p.ws + O_MODP);
      modp[(rs * 2 + 0) * 6144 + col] = ax;
      modp[(rs * 2 + 1) * 6144 + col] = ac;
    } else if (it < E1) {
      int t = it - E0; int kt = t / 85, nt = t % 85; int n0 = nt * 64;
      tr_tile(p.in[I_WIN], NIN, kt * 64, nt == 84 ? 2816 : (n0 < 2816 ? n0 : n0 + 16), (bf16_t*)(p.ws + R_WIN), 1024, n0, smem);
    } else if (it < E2) {
      int t = it - E1; tr_tile(p.in[I_WBA], 1024, (t / 16) * 64, (t % 16) * 64, (bf16_t*)(p.ws + O_WBA), 512, (t % 16) * 64, smem);
    } else if (it < E3) {
      int t = it - E2; tr_tile(p.in[I_WBB], 1024, (t / 16) * 64, (t % 16) * 64, (bf16_t*)(p.ws + O_WBB), 512, (t % 16) * 64, smem);
    } else if (it < E4) {
      int t = it - E3; tr_tile(p.in[I_WOUT], 1024, (t / 16) * 64, (t % 16) * 64, (bf16_t*)(p.ws + O_WOUT), 1024, (t % 16) * 64, smem);
    } else if (it < E5) {
      int t = it - E4; tr_tile(p.in[I_WQ], 2048, (t / 32) * 64, (t % 32) * 64, (bf16_t*)(p.ws + O_WQ), 1024, (t % 32) * 64, smem);
    } else if (it < E6) {
      int t = it - E5; int dir = t / 8, nt = t % 8;
      tr_tile(p.in[I_RWUP] + (size_t)dir * 64 * 512, 512, 0, nt * 64, (bf16_t*)(p.ws + O_WUP) + (size_t)dir * 512 * 64, 64, nt * 64, smem);
    } else if (it < E7) {
      int t = it - E6; int dir = t / 8, nt = t % 8;
      tr_tile(p.in[I_RAUP] + (size_t)dir * 64 * 512, 512, 0, nt * 64, (bf16_t*)(p.ws + O_AUP) + (size_t)dir * 512 * 64, 64, nt * 64, smem);
    } else if (it < E8) {
      int t = it - E7; tr_tile(p.in[I_RGUP], 512, (t / 8) * 64, (t % 8) * 64, (bf16_t*)(p.ws + O_GUP), 128, (t % 8) * 64, smem);
    } else {
      int t = it - E8; size_t base = (size_t)t * 2048 + tid * 8;
      const float* s = p.in[I_KEYS] + base;
      float f[8];
      float4 a = *(const float4*)s, b = *(const float4*)(s + 4);
      f[0] = a.x; f[1] = a.y; f[2] = a.z; f[3] = a.w; f[4] = b.x; f[5] = b.y; f[6] = b.z; f[7] = b.w;
      *(uint4*)((bf16_t*)(p.ws + O_KEYS) + base) = pack8(f);
    }
  }
}

DEVI void phase1(const Params& p, unsigned char* smem) {
  float* smod = (float*)smem;
  const int tid = threadIdx.x, lane = tid & 63, warp = tid >> 6;
  for (int i = tid; i < 4096; i += 256) { int which = i >> 10; smod[i] = mod_val(p, which >> 1, (which & 1) * 1024 + (i & 1023)); }
  __syncthreads();
  bf16_t* hx = (bf16_t*)(p.ws + R_HX);
  float* gif = (float*)(p.ws + R_GIF);
  const float* win = p.in[I_WIN];
  constexpr int RPW = 4;
  for (int rg = blockIdx.x * 4 + warp; rg < T_ALL / RPW; rg += gridDim.x * 4) {
    const int row0 = rg * RPW;
    const float* sh = smod + (row0 < T_CTX ? 2048 : 0);
    const float* sc = sh + 1024;
    const float* src0 = row0 < T_CTX ? p.in[I_CTX] + (size_t)row0 * 1024 : p.in[I_X] + (size_t)(row0 - T_CTX) * 1024;
    float rstd[RPW];
#pragma unroll
    for (int r = 0; r < RPW; ++r) {
      float ss = 0.f;
#pragma unroll
      for (int i = 0; i < 4; ++i) {
        float4 v = *(const float4*)(src0 + (size_t)r * 1024 + i * 256 + lane * 4);
        ss += v.x * v.x + v.y * v.y + v.z * v.z + v.w * v.w;
      }
      ss = wave_sum_u(ss);
      rstd[r] = rsqrtf(ss * (1.f / 1024.f) + 1e-6f);
    }
#pragma unroll
    for (int i = 0; i < 4; ++i) {
      const int k0 = i * 256 + lane * 4;
      const float4 gk = *(const float4*)(p.in[I_N1G] + k0);
      const float4 s4 = *(const float4*)(sc + k0), h4 = *(const float4*)(sh + k0);
#pragma unroll
      for (int r = 0; r < RPW; ++r) {
        float4 v = *(const float4*)(src0 + (size_t)r * 1024 + k0);
        const float y0 = v.x * rstd[r] * gk.x * (1.f + s4.x) + h4.x, y1 = v.y * rstd[r] * gk.y * (1.f + s4.y) + h4.y;
        const float y2 = v.z * rstd[r] * gk.z * (1.f + s4.z) + h4.z, y3 = v.w * rstd[r] * gk.w * (1.f + s4.w) + h4.w;
        *(uint2*)(hx + (size_t)(row0 + r) * 1024 + k0) = make_uint2(pack2(y0, y1), pack2(y2, y3));
      }
    }
  }
}

DEVI void phase2(const Params& p, unsigned char* smem, const XcdMap& xm) {
  const int lane = threadIdx.x & 63, warp = threadIdx.x >> 6, wm = warp >> 1, wn = warp & 1;
  const bf16_t* hx = (const bf16_t*)(p.ws + R_HX);
  const bf16_t* wt = (const bf16_t*)(p.ws + R_WIN);
  bf16_t* prw = (bf16_t*)p.out;
  bf16_t* pqk = (bf16_t*)(p.ws + R_PQK);
  bf16_t* pv = (bf16_t*)(p.ws + R_PV);
  bf16_t* po = (bf16_t*)(p.ws + O_PO);
  bf16_t* pg = (bf16_t*)(p.ws + O_PG);
  for_tiles_xcd(xm, 130, 43, 5, 6, [&](int mt, int nt) {
    if (mt < 2 && nt >= 22 && nt < 42) return;
    f32x4 acc[4][4];
    zero_acc(acc);
    gemm_core(hx + (size_t)mt * 128 * 1024, 1024, wt + (size_t)nt * 128 * 1024, 1024, 1024, acc, smem);
    if (nt == 42) {
      float* gif = (float*)(p.ws + R_GIF);
      if (wn == 0) {
#pragma unroll
        for (int i = 0; i < 4; ++i) {
          const int row = mt * 128 + wm * 64 + i * 16 + (lane & 15);
          *(float4*)(gif + (size_t)row * 16 + (lane >> 4) * 4) = make_float4(acc[i][0][0], acc[i][0][1], acc[i][0][2], acc[i][0][3]);
        }
      }
      return;
    }
    bf16_t* dst; int ld, nb; int rofs = 0; bool sg = false;
    if (nt < 14) { dst = prw; ld = 1792; nb = nt * 128; }
    else if (nt < 18) { dst = pqk; ld = 512; nb = (nt - 14) * 128; }
    else if (nt < 22) { dst = pv; ld = 512; nb = (nt - 18) * 128; }
    else if (nt < 26) { dst = po; ld = 512; nb = (nt - 22) * 128; rofs = T_CTX; }
    else { dst = pg; ld = 2048; nb = (nt - 26) * 128; rofs = T_CTX; sg = true; }
    bf16_t(*Ct)[136] = (bf16_t(*)[136])smem;
#pragma unroll
    for (int i = 0; i < 4; ++i) {
#pragma unroll
      for (int j = 0; j < 4; ++j) {
        f32x4 v = acc[i][j];
        if (sg) { v[0] = sigm(v[0]); v[1] = sigm(v[1]); v[2] = sigm(v[2]); v[3] = sigm(v[3]); }
        *(uint2*)&Ct[wm * 64 + i * 16 + (lane & 15)][wn * 64 + j * 16 + (lane >> 4) * 4] = make_uint2(pack2(v[0], v[1]), pack2(v[2], v[3]));
      }
    }
    __syncthreads();
#pragma unroll
    for (int q = 0; q < 8; ++q) {
      const int pc = threadIdx.x + 256 * q; const int r = pc >> 4, c8 = (pc & 15) * 8;
      const int row = mt * 128 + r - rofs;
      *(u32x4*)(dst + (size_t)row * ld + nb + c8) = *(const u32x4*)&Ct[r][c8];
    }
    __syncthreads();
  });
}

DEVI void ml_qk8(const Params& p, int c, int j, int chan, float* o) {
  const bf16_t* pqk = (const bf16_t*)(p.ws + R_PQK);
  int row = ml_row(c, j);
  bool hp, hn; int rp, rn;
  if (c < 4) { hp = row > 0; hn = row < T_CTX - 1; rp = row - 1; rn = row + 1; }
  else { int gr = ((c - 4) & 3) * 64 + j; hp = gr > 0; hn = gr < 255; rp = row - 64; rn = row + 64; }
  const float* cw = p.in[I_MCONV];
  float cur[8], pr[8], nx[8];
  unpack8(*(const uint4*)(pqk + (size_t)row * 512 + chan), cur);
  if (hp) unpack8(*(const uint4*)(pqk + (size_t)rp * 512 + chan), pr);
  if (hn) unpack8(*(const uint4*)(pqk + (size_t)rn * 512 + chan), nx);
#pragma unroll
  for (int e = 0; e < 8; ++e) {
    float v = cw[512 + chan + e] * cur[e];
    if (hp) v += cw[chan + e] * pr[e];
    if (hn) v += cw[1024 + chan + e] * nx[e];
    o[e] = siluf(v);
  }
}

DEVI void phase3(const Params& p, unsigned char* smem) {
  bf16_t(*KT)[72] = (bf16_t(*)[72])smem;
  bf16_t(*VwT)[72] = (bf16_t(*)[72])(smem + 64 * 72 * 2);
  float* wgt = (float*)(smem + 64 * 72 * 2 + 256 * 72 * 2);
  const int tid = threadIdx.x, lane = tid & 63, warp = tid >> 6;
  const float* gif = (const float*)(p.ws + R_GIF);
  const bf16_t* pv = (const bf16_t*)(p.ws + R_PV);
  float* U = (float*)(p.ws + R_U);
  float* NT = (float*)(p.ws + O_NT);
  float* bend = (float*)(p.ws + O_BEND);
  float* mloc = (float*)(p.ws + O_MLOC);
  for (int it = blockIdx.x; it < 260 * 4; it += gridDim.x) {
    int c = it >> 2, h = it & 3;
    if (warp < 2) {
      int dir = warp; int j = dir ? 63 - lane : lane;
      int row = ml_row(c, j);
      float ig = gif[(size_t)row * 16 + dir * 4 + h] + p.in[I_MIB][dir * 4 + h];
      float lf = logsig(gif[(size_t)row * 16 + 8 + dir * 4 + h] + p.in[I_MFB][dir * 4 + h]);
      float b = lf;
#pragma unroll
      for (int o = 1; o < 64; o <<= 1) { float t = __shfl_up(b, o); if (lane >= o) b += t; }
      float be = __shfl(b, 63);
      float ge = be - b + ig;
      float ml = wave_max(ge);
      wgt[dir * 64 + j] = expf(ge - ml);
      if (lane == 0) { int sc = ml_sc(c, dir); bend[sc * 8 + dir * 4 + h] = be; mloc[sc * 8 + dir * 4 + h] = ml; }
    }
    __syncthreads();
    {
      int j = tid >> 2, part = tid & 3;
      float f[8];
#pragma unroll
      for (int q = 0; q < 2; ++q) {
        int d0 = part * 16 + q * 8;
        ml_qk8(p, c, j, 256 + h * 64 + d0, f);
#pragma unroll
        for (int e = 0; e < 8; ++e) KT[d0 + e][j] = f2bf(f[e] * 0.125f);
      }
      int row = ml_row(c, j);
      float w0 = wgt[j], w1 = wgt[64 + j];
#pragma unroll
      for (int q = 0; q < 4; ++q) {
        int v0 = part * 32 + q * 8;
        unpack8(*(const uint4*)(pv + (size_t)row * 512 + h * 128 + v0), f);
#pragma unroll
        for (int e = 0; e < 8; ++e) { VwT[v0 + e][j] = f2bf(f[e] * w0); VwT[128 + v0 + e][j] = f2bf(f[e] * w1); }
      }
    }
    __syncthreads();
#pragma unroll
    for (int dir = 0; dir < 2; ++dir) {
      int sc = ml_sc(c, dir);
      float* Ud = U + ((size_t)sc * 8 + dir * 4 + h) * 8192;
#pragma unroll
      for (int vi = 0; vi < 2; ++vi) {
        int vt = warp * 2 + vi;
        bf16x8 bv[2];
#pragma unroll
        for (int ks = 0; ks < 2; ++ks) bv[ks] = *(const bf16x8*)&VwT[dir * 128 + vt * 16 + (lane & 15)][ks * 32 + (lane >> 4) * 8];
#pragma unroll
        for (int dt = 0; dt < 4; ++dt) {
          f32x4 a = {0.f, 0.f, 0.f, 0.f};
#pragma unroll
          for (int ks = 0; ks < 2; ++ks) {
            bf16x8 ak = *(const bf16x8*)&KT[dt * 16 + (lane & 15)][ks * 32 + (lane >> 4) * 8];
            a = __builtin_amdgcn_mfma_f32_16x16x32_bf16(ak, bv[ks], a, 0, 0, 0);
          }
          *(float4*)(Ud + (size_t)(vt * 16 + (lane & 15)) * 64 + dt * 16 + (lane >> 4) * 4) = make_float4(a[0], a[1], a[2], a[3]);
        }
      }
    }
    if (tid < 128) {
      int dir = tid >> 6, d = tid & 63; float s = 0.f;
      for (int j = 0; j < 64; ++j) s += wgt[dir * 64 + j] * bf2f(KT[d][j]);
      NT[((size_t)ml_sc(c, dir) * 8 + dir * 4 + h) * 64 + d] = s;
    }
    __syncthreads();
  }
}

template <bool DRY> DEVI void phase4(const Params& p) {
  const bool wr = !DRY || (p.in[I_FG][0] == 1234.5f);
  float* U = (float*)(p.ws + R_U);
  float* NT = (float*)(p.ws + O_NT);
  const float* bend = (const float*)(p.ws + O_BEND);
  const float* mloc = (const float*)(p.ws + O_MLOC);
  float* mst = (float*)(p.ws + O_MST);
  for (int g = blockIdx.x * 256 + threadIdx.x; g < 8 * 8256; g += gridDim.x * 256) {
    int pr = g / 8256, e = g % 8256;
    float* base; size_t stride;
    if (e < 8192) { base = U + (size_t)pr * 8192 + e; stride = 8 * 8192; }
    else { base = NT + (size_t)pr * 64 + (e - 8192); stride = 8 * 64; }
    float m = 0.f, C = 0.f;
    for (int sc = 0; sc < 260; sc += 20) {
      float u[20];
#pragma unroll
      for (int q = 0; q < 20; ++q) u[q] = base[(size_t)(sc + q) * stride];
#pragma unroll
      for (int q = 0; q < 20; ++q) {
        float be = bend[(sc + q) * 8 + pr], ml = mloc[(sc + q) * 8 + pr];
        float mn = fmaxf(be + m, ml);
        float keep = expf(be + m - mn), s = expf(ml - mn);
        if (wr) base[(size_t)(sc + q) * stride] = C;
        if (wr && e == 0) mst[(sc + q) * 8 + pr] = m;
        C = keep * C + s * u[q];
        m = mn;
      }
    }
  }
}

template <bool DRY> DEVI void phase5(const Params& p, unsigned char* smem) {
  const bool wr = !DRY || (p.in[I_FG][0] == 1234.5f);
  bf16_t(*Qs)[72] = (bf16_t(*)[72])smem;
  bf16_t(*Ks)[72] = (bf16_t(*)[72])(smem + 9216);
  bf16_t(*Pm)[72] = (bf16_t(*)[72])(smem + 2 * 9216);
  bf16_t(*VT)[72] = (bf16_t(*)[72])(smem + 3 * 9216);
  float* evec = (float*)(smem + 3 * 9216 + 144 * 72 * 2);
  float* Mvec = evec + 128;
  float* bvec = Mvec + 128;
  const int tid = threadIdx.x, lane = tid & 63, warp = tid >> 6;
  const float* gif = (const float*)(p.ws + R_GIF);
  const bf16_t* pv = (const bf16_t*)(p.ws + R_PV);
  const bf16_t* po = (const bf16_t*)(p.ws + O_PO);
  bf16_t* yb = (bf16_t*)(p.ws + R_YA);
  const float* U = (const float*)(p.ws + R_U);
  const float* NT = (const float*)(p.ws + O_NT);
  const float* mst = (const float*)(p.ws + O_MST);
  for (int it = blockIdx.x; it < 256 * 4; it += gridDim.x) {
    int c = 4 + (it >> 2), h = it & 3;
    if (warp < 2) {
      int dir = warp; int j = dir ? 63 - lane : lane;
      int row = ml_row(c, j);
      float ig = gif[(size_t)row * 16 + dir * 4 + h] + p.in[I_MIB][dir * 4 + h];
      float lf = logsig(gif[(size_t)row * 16 + 8 + dir * 4 + h] + p.in[I_MFB][dir * 4 + h]);
      float b = lf;
#pragma unroll
      for (int o = 1; o < 64; o <<= 1) { float t = __shfl_up(b, o); if (lane >= o) b += t; }
      float e = ig - b;
      float pm = e;
#pragma unroll
      for (int o = 1; o < 64; o <<= 1) { float t = __shfl_up(pm, o); if (lane >= o) pm = fmaxf(pm, t); }
      float m0 = mst[ml_sc(c, dir) * 8 + dir * 4 + h];
      evec[dir * 64 + j] = e; Mvec[dir * 64 + j] = fmaxf(m0, pm); bvec[dir * 64 + j] = b;
    }
    {
      int j = tid >> 2, part = tid & 3;
      float f[8];
#pragma unroll
      for (int q = 0; q < 2; ++q) {
        int d0 = part * 16 + q * 8;
        ml_qk8(p, c, j, h * 64 + d0, f);
        *(uint4*)&Qs[j][d0] = pack8(f);
        ml_qk8(p, c, j, 256 + h * 64 + d0, f);
#pragma unroll
        for (int e = 0; e < 8; ++e) f[e] *= 0.125f;
        *(uint4*)&Ks[j][d0] = pack8(f);
      }
      int row = ml_row(c, j);
#pragma unroll
      for (int q = 0; q < 4; ++q) {
        int v0 = part * 32 + q * 8;
        unpack8(*(const uint4*)(pv + (size_t)row * 512 + h * 128 + v0), f);
#pragma unroll
        for (int e = 0; e < 8; ++e) VT[v0 + e][j] = f2bf(f[e]);
      }
      for (int i = tid; i < 16 * 64; i += 256) VT[128 + (i >> 6)][i & 63] = (i < 64) ? (bf16_t)0x3f80 : (bf16_t)0;
    }
    __syncthreads();
    const int jl = warp * 16 + (lane & 15);
    f32x4 s0[4];
    bf16x8 qf[2];
#pragma unroll
    for (int ks = 0; ks < 2; ++ks) qf[ks] = *(const bf16x8*)&Qs[jl][ks * 32 + (lane >> 4) * 8];
#pragma unroll
    for (int st = 0; st < 4; ++st) {
      f32x4 a = {0.f, 0.f, 0.f, 0.f};
#pragma unroll
      for (int ks = 0; ks < 2; ++ks) {
        bf16x8 kf = *(const bf16x8*)&Ks[st * 16 + (lane & 15)][ks * 32 + (lane >> 4) * 8];
        a = __builtin_amdgcn_mfma_f32_16x16x32_bf16(kf, qf[ks], a, 0, 0, 0);
      }
      s0[st] = a;
    }
    f32x4 ysum[8];
#pragma unroll
    for (int vt = 0; vt < 8; ++vt) ysum[vt] = f32x4{0.f, 0.f, 0.f, 0.f};
#pragma unroll 1
    for (int dir = 0; dir < 2; ++dir) {
      float Mj = Mvec[dir * 64 + jl], bj = bvec[dir * 64 + jl];
      float m0 = mst[ml_sc(c, dir) * 8 + dir * 4 + h];
#pragma unroll
      for (int st = 0; st < 4; ++st) {
        float pvv[4];
#pragma unroll
        for (int r = 0; r < 4; ++r) {
          int s = st * 16 + (lane >> 4) * 4 + r;
          bool ok = dir == 0 ? (s <= jl) : (s >= jl);
          pvv[r] = ok ? s0[st][r] * expf(evec[dir * 64 + s] - Mj) : 0.f;
        }
        *(uint2*)&Pm[jl][st * 16 + (lane >> 4) * 4] = make_uint2(pack2(pvv[0], pvv[1]), pack2(pvv[2], pvv[3]));
      }
      __syncthreads();
      bf16x8 pf[2];
#pragma unroll
      for (int ks = 0; ks < 2; ++ks) pf[ks] = *(const bf16x8*)&Pm[jl][ks * 32 + (lane >> 4) * 8];
      const float* Cst = U + ((size_t)ml_sc(c, dir) * 8 + dir * 4 + h) * 8192;
      const float* nst = NT + ((size_t)ml_sc(c, dir) * 8 + dir * 4 + h) * 64;
      float ai = expf(m0 - Mj);
      f32x4 hh[9];
#pragma unroll
      for (int vt = 0; vt < 9; ++vt) {
        f32x4 a1 = {0.f, 0.f, 0.f, 0.f}, a2 = {0.f, 0.f, 0.f, 0.f};
#pragma unroll
        for (int ks = 0; ks < 2; ++ks) {
          bf16x8 vf = *(const bf16x8*)&VT[vt * 16 + (lane & 15)][ks * 32 + (lane >> 4) * 8];
          a1 = __builtin_amdgcn_mfma_f32_16x16x32_bf16(vf, pf[ks], a1, 0, 0, 0);
          int v = vt * 16 + (lane & 15);
          const float* cp = v < 128 ? Cst + (size_t)v * 64 + ks * 32 + (lane >> 4) * 8 : nst + ks * 32 + (lane >> 4) * 8;
          float cf[8];
          if (v <= 128) {
            float4 x0 = *(const float4*)cp, x1 = *(const float4*)(cp + 4);
            cf[0] = x0.x; cf[1] = x0.y; cf[2] = x0.z; cf[3] = x0.w; cf[4] = x1.x; cf[5] = x1.y; cf[6] = x1.z; cf[7] = x1.w;
          } else {
#pragma unroll
            for (int e = 0; e < 8; ++e) cf[e] = 0.f;
          }
          uint4 pk = pack8(cf);
          bf16x8 cfr;
          cfr[0] = (short)(pk.x & 0xffff); cfr[1] = (short)(pk.x >> 16); cfr[2] = (short)(pk.y & 0xffff); cfr[3] = (short)(pk.y >> 16);
          cfr[4] = (short)(pk.z & 0xffff); cfr[5] = (short)(pk.z >> 16); cfr[6] = (short)(pk.w & 0xffff); cfr[7] = (short)(pk.w >> 16);
          a2 = __builtin_amdgcn_mfma_f32_16x16x32_bf16(cfr, qf[ks], a2, 0, 0, 0);
        }
#pragma unroll
        for (int r = 0; r < 4; ++r) hh[vt][r] = a1[r] + ai * a2[r];
      }
      float den = __shfl(hh[8][0], lane & 15);
      float dn = fmaxf(fabsf(den), expf(-(bj + Mj)));
      float inv = 1.f / dn;
      float ss = 0.f;
#pragma unroll
      for (int vt = 0; vt < 8; ++vt)
#pragma unroll
        for (int r = 0; r < 4; ++r) { float x = hh[vt][r] * inv; hh[vt][r] = x; ss += x * x; }
      ss += __shfl_xor(ss, 16); ss += __shfl_xor(ss, 32);
      float rs = rsqrtf(ss * (1.f / 128.f) + 1e-6f);
#pragma unroll
      for (int vt = 0; vt < 8; ++vt)
#pragma unroll
        for (int r = 0; r < 4; ++r) ysum[vt][r] += hh[vt][r] * rs * p.in[I_MNG][h * 128 + vt * 16 + (lane >> 4) * 4 + r];
      __syncthreads();
    }
    {
      int row = ml_row(c, jl) - T_CTX;
#pragma unroll
      for (int vt = 0; vt < 8; ++vt) {
        const bf16_t* op = po + (size_t)row * 512 + h * 128 + vt * 16 + (lane >> 4) * 4;
        uint2 o = *(const uint2*)op;
        float y0 = ysum[vt][0] * sigm(bflo(o.x)), y1 = ysum[vt][1] * sigm(bfhi(o.x)), y2 = ysum[vt][2] * sigm(bflo(o.y)), y3 = ysum[vt][3] * sigm(bfhi(o.y));
        if (wr) *(uint2*)(yb + (size_t)row * 512 + h * 128 + vt * 16 + (lane >> 4) * 4) = make_uint2(pack2(y0, y1), pack2(y2, y3));
      }
    }
    __syncthreads();
  }
}

DEVI void phase6(const Params& p, unsigned char* smem, int item_lo, int item_hi, int blk0, int nblk) {
  float(*rs)[65] = (float(*)[65])smem;
  float(*ks)[65] = (float(*)[65])(smem + 64 * 65 * 4);
  bf16_t(*TW)[72] = (bf16_t(*)[72])(smem + 2 * 64 * 65 * 4);
  bf16_t(*TA)[72] = (bf16_t(*)[72])(smem + 2 * 64 * 65 * 4 + 9216);
  bf16_t(*TG)[136] = (bf16_t(*)[136])(smem + 2 * 64 * 65 * 4 + 2 * 9216);
  float* rn = (float*)(smem + 2 * 64 * 65 * 4 + 2 * 9216 + 64 * 136 * 2);
  const int tid = threadIdx.x, lane = tid & 63, warp = tid >> 6;
  const bf16_t* prw = (const bf16_t*)p.out;
  bf16_t* SV = (bf16_t*)(p.ws + R_SV);
  float* bonus = (float*)(p.ws + O_BONUS);
  const float* cw = p.in[I_RCONV];
  const bf16_t* WUP = (const bf16_t*)(p.ws + O_WUP);
  const bf16_t* AUP = (const bf16_t*)(p.ws + O_AUP);
  const bf16_t* GUP = (const bf16_t*)(p.ws + O_GUP);
  if ((int)blockIdx.x < blk0) return;
  for (int it = item_lo + ((int)blockIdx.x - blk0); it < item_hi; it += nblk) {
    int tile = it >> 3, head = it & 7;
    int row0 = tile * 64;
    int seg0 = tile < 4 ? 0 : row0, seg1 = tile < 4 ? T_CTX : row0 + 64;
#pragma unroll 1
    for (int ub = 0; ub < 2; ++ub) {
      u32x4 lc[7], lp[7], ln[7];
#pragma unroll
      for (int it7 = 0; it7 < 7; ++it7) {
        const int u = warp + 4 * (ub * 7 + it7);
        const int grp = u >> 3;
        const int j = (u & 7) * 8 + (lane >> 3), q = grp * 8 + (lane & 7);
        const int row = row0 + j;
        const int col = q < 24 ? (q >> 3) * 512 + head * 64 + (q & 7) * 8 : 1536 + (q - 24) * 8;
        const bool hp = row > seg0, hn = row < seg1 - 1;
        lc[it7] = *(const u32x4*)(prw + (size_t)row * 1792 + col);
        lp[it7] = hp ? *(const u32x4*)(prw + (size_t)(row - 1) * 1792 + col) : u32x4{0u, 0u, 0u, 0u};
        ln[it7] = hn ? *(const u32x4*)(prw + (size_t)(row + 1) * 1792 + col) : u32x4{0u, 0u, 0u, 0u};
      }
#pragma unroll
      for (int it7 = 0; it7 < 7; ++it7) {
        const int u = warp + 4 * (ub * 7 + it7);
        const int grp = u >> 3;
        const int j = (u & 7) * 8 + (lane >> 3), q = grp * 8 + (lane & 7);
        const int row = row0 + j;
        const int col = q < 24 ? (q >> 3) * 512 + head * 64 + (q & 7) * 8 : 1536 + (q - 24) * 8;
        float cur[8], pr[8], nx[8], o[8];
        unpack8(make_uint4(lc[it7][0], lc[it7][1], lc[it7][2], lc[it7][3]), cur);
        unpack8(make_uint4(lp[it7][0], lp[it7][1], lp[it7][2], lp[it7][3]), pr);
        unpack8(make_uint4(ln[it7][0], ln[it7][1], ln[it7][2], ln[it7][3]), nx);
        {
          float4 c0 = *(const float4*)(cw + col), c1 = *(const float4*)(cw + col + 4);
          float4 d0 = *(const float4*)(cw + 1792 + col), d1 = *(const float4*)(cw + 1792 + col + 4);
          float4 e0 = *(const float4*)(cw + 3584 + col), e1 = *(const float4*)(cw + 3584 + col + 4);
          float wp[8] = {c0.x, c0.y, c0.z, c0.w, c1.x, c1.y, c1.z, c1.w};
          float wc[8] = {d0.x, d0.y, d0.z, d0.w, d1.x, d1.y, d1.z, d1.w};
          float wn_[8] = {e0.x, e0.y, e0.z, e0.w, e1.x, e1.y, e1.z, e1.w};
#pragma unroll
          for (int e = 0; e < 8; ++e) o[e] = wc[e] * cur[e] + wp[e] * pr[e] + wn_[e] * nx[e];
        }
        if (grp == 0) {
#pragma unroll
          for (int e = 0; e < 8; ++e) rs[j][(q & 7) * 8 + e] = o[e];
        } else if (grp == 1) {
#pragma unroll
          for (int e = 0; e < 8; ++e) ks[j][(q & 7) * 8 + e] = o[e];
        } else if (grp == 2) {
          *(uint4*)(SV + ((size_t)row * 8 + head) * SVH + 2 * 64 + (q & 7) * 8) = pack8(o);
        } else if (grp == 3) {
#pragma unroll
          for (int e = 0; e < 8; ++e) o[e] = 1.f - 2.f / (1.f + __expf(2.f * o[e]));
          *(uint4*)&TW[j][(q - 24) * 8] = pack8(o);
        } else if (grp == 4) {
          *(uint4*)&TA[j][(q - 32) * 8] = pack8(o);
        } else {
#pragma unroll
          for (int e = 0; e < 8; ++e) o[e] = sigm(o[e]);
          *(uint4*)&TG[j][(q - 40) * 8] = pack8(o);
        }
      }
    }
    __syncthreads();
    {
      int j = tid >> 2, part = tid & 3; float ss = 0.f;
#pragma unroll
      for (int e = 0; e < 16; ++e) { float v = ks[j][part * 16 + e] * p.in[I_RKK][head * 64 + part * 16 + e]; ss += v * v; }
      ss += __shfl_xor(ss, 1); ss += __shfl_xor(ss, 2);
      if (part == 0) rn[j] = 1.f / fmaxf(sqrtf(ss), 1e-12f);
    }
    __syncthreads();
    for (int pc = tid; pc < 64 * 8; pc += 256) {
      int j = pc >> 3, c8 = (pc & 7) * 8; int row = row0 + j;
      float fr[8], fk[8], fkk[8];
#pragma unroll
      for (int e = 0; e < 8; ++e) { fr[e] = rs[j][c8 + e]; fk[e] = ks[j][c8 + e]; fkk[e] = fk[e] * p.in[I_RKK][head * 64 + c8 + e] * rn[j]; }
      bf16_t* b = SV + ((size_t)row * 8 + head) * SVH;
      *(uint4*)(b + 0 * 64 + c8) = pack8(fr);
      *(uint4*)(b + 1 * 64 + c8) = pack8(fk);
      *(uint4*)(b + 3 * 64 + c8) = pack8(fkk);
    }
    {
      const int jl = warp * 16 + (lane & 15); const int row = row0 + jl;
      bf16x8 tw[2], ta[2], tg[4];
#pragma unroll
      for (int s2 = 0; s2 < 2; ++s2) { tw[s2] = *(const bf16x8*)&TW[jl][s2 * 32 + (lane >> 4) * 8]; ta[s2] = *(const bf16x8*)&TA[jl][s2 * 32 + (lane >> 4) * 8]; }
#pragma unroll
      for (int s2 = 0; s2 < 4; ++s2) tg[s2] = *(const bf16x8*)&TG[jl][s2 * 32 + (lane >> 4) * 8];
      __syncthreads();
      bf16_t(*OB)[64][72] = (bf16_t(*)[64][72])(smem + 2 * 64 * 65 * 4);
      float bon[2] = {0.f, 0.f};
#pragma unroll
      for (int dir = 0; dir < 2; ++dir) {
#pragma unroll
        for (int ct = 0; ct < 4; ++ct) {
          const int ch0 = ct * 16 + (lane >> 4) * 4;
          const int C0 = head * 64 + ch0;
          if (dir == 0) {
            f32x4 a = {0.f, 0.f, 0.f, 0.f};
#pragma unroll
            for (int s2 = 0; s2 < 4; ++s2) {
              bf16x8 wf = *(const bf16x8*)(GUP + (size_t)(head * 64 + ct * 16 + (lane & 15)) * 128 + s2 * 32 + (lane >> 4) * 8);
              a = __builtin_amdgcn_mfma_f32_16x16x32_bf16(wf, tg[s2], a, 0, 0, 0);
            }
            *(uint2*)&OB[2][jl][ch0] = make_uint2(pack2(a[0], a[1]), pack2(a[2], a[3]));
          }
          f32x4 aw = {0.f, 0.f, 0.f, 0.f}, aa = {0.f, 0.f, 0.f, 0.f};
#pragma unroll
          for (int s2 = 0; s2 < 2; ++s2) {
            size_t wo = (size_t)(dir * 512 + head * 64 + ct * 16 + (lane & 15)) * 64 + s2 * 32 + (lane >> 4) * 8;
            bf16x8 wf = *(const bf16x8*)(WUP + wo);
            bf16x8 af = *(const bf16x8*)(AUP + wo);
            aw = __builtin_amdgcn_mfma_f32_16x16x32_bf16(wf, tw[s2], aw, 0, 0, 0);
            aa = __builtin_amdgcn_mfma_f32_16x16x32_bf16(af, ta[s2], aa, 0, 0, 0);
          }
          const float4 w04 = *(const float4*)(p.in[I_RW0] + dir * 512 + C0), a04 = *(const float4*)(p.in[I_RA0] + dir * 512 + C0);
          const float4 ka4 = *(const float4*)(p.in[I_RKA] + C0), rk4 = *(const float4*)(p.in[I_RRK] + C0);
          const float w0v[4] = {w04.x, w04.y, w04.z, w04.w}, a0v[4] = {a04.x, a04.y, a04.z, a04.w};
          const float kav[4] = {ka4.x, ka4.y, ka4.z, ka4.w}, rkv[4] = {rk4.x, rk4.y, rk4.z, rk4.w};
          float we[4], av[4];
#pragma unroll
          for (int r = 0; r < 4; ++r) {
            we[r] = (0.60653066f * 1.44269504f) * sigm(w0v[r] + aw[r]);
            av[r] = sigm(a0v[r] + aa[r]);
            float kv = ks[jl][ch0 + r];
            float keff = kv * (1.f + (av[r] - 1.f) * kav[r]);
            bon[dir] += rs[jl][ch0 + r] * keff * rkv[r];
          }
          *(uint2*)&OB[0][jl][ch0] = make_uint2(pack2(we[0], we[1]), pack2(we[2], we[3]));
          *(uint2*)&OB[1][jl][ch0] = make_uint2(pack2(av[0], av[1]), pack2(av[2], av[3]));
        }
        __syncthreads();
        for (int pc = tid; pc < (dir == 0 ? 3 : 2) * 64 * 8; pc += 256) {
          const int vsel = pc >> 9, j = (pc >> 3) & 63, c8 = (pc & 7) * 8;
          const int vec = vsel == 2 ? 8 : (4 + 2 * dir + vsel);
          *(u32x4*)(SV + ((size_t)(row0 + j) * 8 + head) * SVH + vec * 64 + c8) = *(const u32x4*)&OB[vsel][j][c8];
        }
        __syncthreads();
      }
#pragma unroll
      for (int dir = 0; dir < 2; ++dir) {
        float sb = bon[dir]; sb += __shfl_xor(sb, 16); sb += __shfl_xor(sb, 32);
        if (lane < 16) bonus[(size_t)row * 16 + dir * 8 + head] = sb;
      }
    }
    __syncthreads();
  }
}

struct RwVec { uint4 k, kk, w, a, v, r; };
DEVI void unpack8p(const uint4& u, f32x2* f) {
  f[0] = f32x2{bflo(u.x), bfhi(u.x)}; f[1] = f32x2{bflo(u.y), bfhi(u.y)}; f[2] = f32x2{bflo(u.z), bfhi(u.z)}; f[3] = f32x2{bflo(u.w), bfhi(u.w)};
}
DEVI f32x2 bc2(float x) { return f32x2{x, x}; }
DEVI void rw_load(RwVec& x, const bf16_t* SV, int row, int head, int dir, int i, int jg, bool need_r) {
  const bf16_t* b = SV + ((size_t)row * 8 + head) * SVH;
  x.k = *(const uint4*)(b + 1 * 64 + jg * 8);
  x.kk = *(const uint4*)(b + 3 * 64 + jg * 8);
  x.w = *(const uint4*)(b + (4 + 2 * dir) * 64 + jg * 8);
  x.a = *(const uint4*)(b + (5 + 2 * dir) * 64 + jg * 8);
  x.v = *(const uint4*)(b + 2 * 64 + i * 8);
  if (need_r) x.r = *(const uint4*)(b + 0 * 64 + jg * 8);
}

DEVI void phase7(const Params& p) {
  const int lane = threadIdx.x & 63, warp = threadIdx.x >> 6, i = lane >> 3, jg = lane & 7;
  const bf16_t* SV = (const bf16_t*)(p.ws + R_SV);
  float* Pc = (float*)p.out;
  float* Bc = (float*)((unsigned char*)p.out + OUT_BC);
  for (int it = blockIdx.x * 4 + warp; it < (NCH - 1) * 16; it += gridDim.x * 4) {
    const int chunk = it >> 4, pair = it & 15, dir = pair >> 3, head = pair & 7;
    f32x2 S[8][4], P[8][4], ka[4];
#pragma unroll
    for (int a = 0; a < 8; ++a)
#pragma unroll
      for (int c = 0; c < 4; ++c) {
        S[a][c] = f32x2{0.f, 0.f};
        P[a][c] = f32x2{(i * 8 + a == jg * 8 + 2 * c) ? 1.f : 0.f, (i * 8 + a == jg * 8 + 2 * c + 1) ? 1.f : 0.f};
      }
#pragma unroll
    for (int c = 0; c < 4; ++c) ka[c] = f32x2{p.in[I_RKA][head * 64 + jg * 8 + 2 * c], p.in[I_RKA][head * 64 + jg * 8 + 2 * c + 1]};
    RwVec nx;
    rw_load(nx, SV, rw_row(chunk * LCH, dir), head, dir, i, jg, false);
#pragma unroll 1
    for (int t = 0; t < LCH; ++t) {
      RwVec cu = nx;
      if (t + 1 < LCH) rw_load(nx, SV, rw_row(chunk * LCH + t + 1, dir), head, dir, i, jg, false);
      f32x2 kv[4], kk[4], w[4], av[4], kka[4], keff[4]; float vv[8];
      unpack8p(cu.k, kv); unpack8p(cu.kk, kk); unpack8p(cu.w, w); unpack8p(cu.a, av); unpack8(cu.v, vv);
#pragma unroll
      for (int c = 0; c < 4; ++c) {
        w[c] = f32x2{__builtin_amdgcn_exp2f(-w[c][0]), __builtin_amdgcn_exp2f(-w[c][1])};
        kka[c] = -kk[c] * av[c];
        keff[c] = kv[c] * (bc2(1.f) + (av[c] - bc2(1.f)) * ka[c]);
      }
#pragma unroll
      for (int a = 0; a < 8; ++a) {
        f32x2 sa = S[a][0] * kk[0], qa = P[a][0] * kk[0];
#pragma unroll
        for (int c = 1; c < 4; ++c) { sa += S[a][c] * kk[c]; qa += P[a][c] * kk[c]; }
        float s1 = allred8(sa[0] + sa[1]), q1 = allred8(qa[0] + qa[1]);
        const f32x2 s2 = bc2(s1), q2 = bc2(q1), v2 = bc2(vv[a]);
#pragma unroll
        for (int c = 0; c < 4; ++c) {
          S[a][c] = S[a][c] * w[c] + s2 * kka[c] + v2 * keff[c];
          P[a][c] = P[a][c] * w[c] + q2 * kka[c];
        }
      }
    }
    float* po = Pc + ((size_t)chunk * 16 + pair) * 4096;
    float* bo = Bc + ((size_t)chunk * 16 + pair) * 4096;
#pragma unroll
    for (int a = 0; a < 8; ++a) {
      *(float4*)(po + (i * 8 + a) * 64 + jg * 8) = make_float4(P[a][0][0], P[a][0][1], P[a][1][0], P[a][1][1]);
      *(float4*)(po + (i * 8 + a) * 64 + jg * 8 + 4) = make_float4(P[a][2][0], P[a][2][1], P[a][3][0], P[a][3][1]);
      *(float4*)(bo + (i * 8 + a) * 64 + jg * 8) = make_float4(S[a][0][0], S[a][0][1], S[a][1][0], S[a][1][1]);
      *(float4*)(bo + (i * 8 + a) * 64 + jg * 8 + 4) = make_float4(S[a][2][0], S[a][2][1], S[a][3][0], S[a][3][1]);
    }
  }
}

template <bool DRY> DEVI void phase8(const Params& p, unsigned char* smem) {
  const bool wr = !DRY || (p.in[I_FG][0] == 1234.5f);
  float(*Sb)[16][68] = (float(*)[16][68])smem;
  const int tid = threadIdx.x, lane = tid & 63, warp = tid >> 6, q = lane >> 4, c16 = lane & 15;
  const float* Pc = (const float*)p.out;
  float* Bc = (float*)((unsigned char*)p.out + OUT_BC);
  constexpr int NS = NCH - 1;
  const size_t CS = (size_t)16 * 4096;
  for (int it = blockIdx.x; it < 64; it += gridDim.x) {
    const int pair = it >> 2, rg = it & 3;
    const float* Pp = Pc + (size_t)pair * 4096 + q * 64 + warp * 16 + c16;
    float* Bp = Bc + (size_t)pair * 4096 + (size_t)(rg * 16 + q * 4) * 64 + warp * 16 + c16;
    __syncthreads();
    {
      const int row = tid >> 4, c4 = (tid & 15) * 4;
      float4 v = *(const float4*)(Bc + (size_t)pair * 4096 + (size_t)(rg * 16 + row) * 64 + c4);
      Sb[0][row][c4] = v.x; Sb[0][row][c4 + 1] = v.y; Sb[0][row][c4 + 2] = v.z; Sb[0][row][c4 + 3] = v.w;
    }
    float pa[16], pb[16]; f32x4 ba, bb;
#pragma unroll
    for (int s2 = 0; s2 < 16; ++s2) { pa[s2] = Pp[CS + s2 * 256]; pb[s2] = Pp[2 * CS + s2 * 256]; }
#pragma unroll
    for (int r = 0; r < 4; ++r) { ba[r] = Bp[CS + r * 64]; bb[r] = Bp[2 * CS + r * 64]; }
    __syncthreads();
#define P8_STEP(c, pp, bv)                                                                                  \
    {                                                                                                        \
      const int rb = ((c) - 1) & 1;                                                                          \
      f32x4 acc0 = bv, acc1 = f32x4{0.f, 0.f, 0.f, 0.f};                                                     \
      _Pragma("unroll") for (int s2 = 0; s2 < 16; s2 += 2) {                                                 \
        acc0 = __builtin_amdgcn_mfma_f32_16x16x4f32(Sb[rb][c16][4 * s2 + q], pp[s2], acc0, 0, 0, 0);         \
        acc1 = __builtin_amdgcn_mfma_f32_16x16x4f32(Sb[rb][c16][4 * s2 + 4 + q], pp[s2 + 1], acc1, 0, 0, 0); \
      }                                                                                                      \
      acc0 += acc1;                                                                                          \
      if ((c) + 2 < NS) {                                                                                    \
        _Pragma("unroll") for (int s2 = 0; s2 < 16; ++s2) pp[s2] = Pp[(size_t)((c) + 2) * CS + s2 * 256];    \
        _Pragma("unroll") for (int r = 0; r < 4; ++r) bv[r] = Bp[(size_t)((c) + 2) * CS + r * 64];           \
      }                                                                                                      \
      _Pragma("unroll") for (int r = 0; r < 4; ++r) {                                                        \
        Sb[rb ^ 1][q * 4 + r][warp * 16 + c16] = acc0[r];                                                    \
        if (wr) Bp[(size_t)(c) * CS + r * 64] = acc0[r];                                                     \
      }                                                                                                      \
      __syncthreads();                                                                                       \
    }
    for (int c = 1; c < NS; c += 2) {
      P8_STEP(c, pa, ba)
      if (c + 1 < NS) P8_STEP(c + 1, pb, bb)
    }
#undef P8_STEP
  }
}

DEVI void phase9(const Params& p) {
  const int lane = threadIdx.x & 63, warp = threadIdx.x >> 6, i = lane >> 3, jg = lane & 7;
  const bf16_t* SV = (const bf16_t*)(p.ws + R_SV);
  const float* Bc = (const float*)((unsigned char*)p.out + OUT_BC);
  bf16_t* odir = (bf16_t*)p.out;
  for (int it = blockIdx.x * 4 + warp; it < NCH * 16; it += gridDim.x * 4) {
    const int chunk = it >> 4, pair = it & 15, dir = pair >> 3, head = pair & 7;
    f32x2 S[8][4], ka[4];
    if (chunk == 0) {
#pragma unroll
      for (int a = 0; a < 8; ++a)
#pragma unroll
        for (int c = 0; c < 4; ++c) S[a][c] = f32x2{0.f, 0.f};
    } else {
      const float* bs = Bc + ((size_t)(chunk - 1) * 16 + pair) * 4096;
#pragma unroll
      for (int a = 0; a < 8; ++a) {
        float4 x0 = *(const float4*)(bs + (i * 8 + a) * 64 + jg * 8), x1 = *(const float4*)(bs + (i * 8 + a) * 64 + jg * 8 + 4);
        S[a][0] = f32x2{x0.x, x0.y}; S[a][1] = f32x2{x0.z, x0.w}; S[a][2] = f32x2{x1.x, x1.y}; S[a][3] = f32x2{x1.z, x1.w};
      }
    }
#pragma unroll
    for (int c = 0; c < 4; ++c) ka[c] = f32x2{p.in[I_RKA][head * 64 + jg * 8 + 2 * c], p.in[I_RKA][head * 64 + jg * 8 + 2 * c + 1]};
    RwVec nx;
    rw_load(nx, SV, rw_row(chunk * LCH, dir), head, dir, i, jg, true);
#pragma unroll 1
    for (int t = 0; t < LCH; ++t) {
      RwVec cu = nx;
      const int row = rw_row(chunk * LCH + t, dir);
      if (t + 1 < LCH) rw_load(nx, SV, rw_row(chunk * LCH + t + 1, dir), head, dir, i, jg, true);
      f32x2 kv[4], kk[4], w[4], av[4], rr[4], kka[4], keff[4]; float vv[8];
      unpack8p(cu.k, kv); unpack8p(cu.kk, kk); unpack8p(cu.w, w); unpack8p(cu.a, av); unpack8p(cu.r, rr); unpack8(cu.v, vv);
#pragma unroll
      for (int c = 0; c < 4; ++c) {
        w[c] = f32x2{__builtin_amdgcn_exp2f(-w[c][0]), __builtin_amdgcn_exp2f(-w[c][1])};
        kka[c] = -kk[c] * av[c];
        keff[c] = kv[c] * (bc2(1.f) + (av[c] - bc2(1.f)) * ka[c]);
      }
      float ov = 0.f;
#pragma unroll
      for (int a = 0; a < 8; ++a) {
        f32x2 sa = S[a][0] * kk[0];
#pragma unroll
        for (int c = 1; c < 4; ++c) sa += S[a][c] * kk[c];
        const float s1 = allred8(sa[0] + sa[1]);
        const f32x2 s2 = bc2(s1), v2 = bc2(vv[a]);
        f32x2 oa = f32x2{0.f, 0.f};
#pragma unroll
        for (int c = 0; c < 4; ++c) {
          S[a][c] = S[a][c] * w[c] + s2 * kka[c] + v2 * keff[c];
          oa += S[a][c] * rr[c];
        }
        const float o = allred8(oa[0] + oa[1]);
        if (jg == a) ov = o;
      }
      if (row >= T_CTX) odir[((size_t)dir * T_LAT + (row - T_CTX)) * 512 + head * 64 + i * 8 + jg] = f2bf(ov);
    }
  }
}

DEVI void phase10(const Params& p) {
  const int lane = threadIdx.x & 63, warp = threadIdx.x >> 6;
  const bf16_t* odir = (const bf16_t*)p.out;
  const bf16_t* SV = (const bf16_t*)(p.ws + R_SV);
  const float* bonus = (const float*)(p.ws + O_BONUS);
  bf16_t* ya = (bf16_t*)(p.ws + O_PO);
  const int head = lane >> 3, c8 = (lane & 7) * 8, C0 = lane * 8;
#pragma unroll 2
  for (int t = blockIdx.x * 4 + warp; t < T_LAT; t += gridDim.x * 4) {
    const int row = t + T_CTX;
    const bf16_t* b = SV + ((size_t)row * 8 + head) * SVH;
    float v[8], g[8], y[8];
    unpack8(*(const uint4*)(b + 2 * 64 + c8), v);
    unpack8(*(const uint4*)(b + 8 * 64 + c8), g);
    float bs = bonus[(size_t)row * 16 + head] + bonus[(size_t)row * 16 + 8 + head];
#pragma unroll
    for (int e = 0; e < 8; ++e) y[e] = bs * v[e];
#pragma unroll
    for (int dir = 0; dir < 2; ++dir) {
      float o[8];
      unpack8(*(const uint4*)(odir + ((size_t)dir * T_LAT + t) * 512 + C0), o);
      float s = 0.f;
#pragma unroll
      for (int e = 0; e < 8; ++e) s += o[e];
      s = allred8(s);
      float mu = s * (1.f / 64.f);
      float q = 0.f;
#pragma unroll
      for (int e = 0; e < 8; ++e) { o[e] -= mu; q += o[e] * o[e]; }
      q = allred8(q);
      float rsd = rsqrtf(q * (1.f / 64.f) + 64e-5f);
#pragma unroll
      for (int e = 0; e < 8; ++e) y[e] += o[e] * rsd * p.in[I_RLNW][C0 + e] + p.in[I_RLNB][C0 + e];
    }
#pragma unroll
    for (int e = 0; e < 8; ++e) y[e] *= g[e];
    *(uint4*)(ya + (size_t)t * 512 + C0) = pack8(y);
  }
}

DEVI void phase11(const Params& p, unsigned char* smem, const XcdMap& xm) {
  const int lane = threadIdx.x & 63, warp = threadIdx.x >> 6, wm = warp >> 1, wn = warp & 1;
  const bf16_t* ya = (const bf16_t*)(p.ws + O_PO);
  const bf16_t* yb = (const bf16_t*)(p.ws + R_YA);
  const bf16_t* pg = (const bf16_t*)(p.ws + O_PG);
  bf16_t* mg = (bf16_t*)(p.ws + R_MERGED);
  for_tiles_xcd(xm, 128, 8, 8, 8, [&](int mt, int nt) {
    f32x4 acc[4][4];
    zero_acc(acc);
    gemm_core(ya + (size_t)mt * 128 * 512, 512, (const bf16_t*)(p.ws + O_WBA) + (size_t)nt * 128 * 512, 512, 512, acc, smem);
#pragma unroll
    for (int i = 0; i < 4; ++i) {
      int row = mt * 128 + wm * 64 + i * 16 + (lane & 15);
#pragma unroll
      for (int j = 0; j < 4; ++j) {
        int n = nt * 128 + wn * 64 + j * 16 + (lane >> 4) * 4;
        uint2 s = *(const uint2*)(pg + (size_t)row * 2048 + n);
        *(uint2*)(mg + (size_t)row * 1024 + n) = make_uint2(pack2(acc[i][j][0] * bflo(s.x), acc[i][j][1] * bfhi(s.x)), pack2(acc[i][j][2] * bflo(s.y), acc[i][j][3] * bfhi(s.y)));
      }
    }
    zero_acc(acc);
    gemm_core(yb + (size_t)mt * 128 * 512, 512, (const bf16_t*)(p.ws + O_WBB) + (size_t)nt * 128 * 512, 512, 512, acc, smem);
#pragma unroll
    for (int i = 0; i < 4; ++i) {
      int row = mt * 128 + wm * 64 + i * 16 + (lane & 15);
#pragma unroll
      for (int j = 0; j < 4; ++j) {
        int n = nt * 128 + wn * 64 + j * 16 + (lane >> 4) * 4;
        uint2 s = *(const uint2*)(pg + (size_t)row * 2048 + 1024 + n);
        uint2 m0 = *(const uint2*)(mg + (size_t)row * 1024 + n);
        float v0 = bflo(m0.x) + acc[i][j][0] * bflo(s.x), v1 = bfhi(m0.x) + acc[i][j][1] * bfhi(s.x);
        float v2 = bflo(m0.y) + acc[i][j][2] * bflo(s.y), v3 = bfhi(m0.y) + acc[i][j][3] * bfhi(s.y);
        *(uint2*)(mg + (size_t)row * 1024 + n) = make_uint2(pack2(v0, v1), pack2(v2, v3));
      }
    }
  });
}

DEVI void phase12(const Params& p, unsigned char* smem, const XcdMap& xm) {
  float* gt = (float*)(smem + 45056);
  const int tid = threadIdx.x, lane = tid & 63, warp = tid >> 6, wm = warp >> 1, wn = warp & 1;
  for (int i = tid; i < 1024; i += 256) gt[i] = mod_val(p, 0, 2048 + i);
  __syncthreads();
  const bf16_t* mg = (const bf16_t*)(p.ws + R_MERGED);
  const float* x = p.in[I_X];
  float* x1 = p.out;
  for_tiles_xcd(xm, 128, 8, 8, 8, [&](int mt, int nt) {
    f32x4 acc[4][4];
    zero_acc(acc);
    gemm_core(mg + (size_t)mt * 128 * 1024, 1024, (const bf16_t*)(p.ws + O_WOUT) + (size_t)nt * 128 * 1024, 1024, 1024, acc, smem);
#pragma unroll
    for (int i = 0; i < 4; ++i) {
      int row = mt * 128 + wm * 64 + i * 16 + (lane & 15);
#pragma unroll
      for (int j = 0; j < 4; ++j) {
        int n = nt * 128 + wn * 64 + j * 16 + (lane >> 4) * 4;
        float4 xv = *(const float4*)(x + (size_t)row * 1024 + n);
        xv.x += gt[n] * acc[i][j][0]; xv.y += gt[n + 1] * acc[i][j][1]; xv.z += gt[n + 2] * acc[i][j][2]; xv.w += gt[n + 3] * acc[i][j][3];
        *(float4*)(x1 + (size_t)row * 1024 + n) = xv;
      }
    }
  });
}

DEVI void phase13(const Params& p, unsigned char* smem) {
  float* smod = (float*)smem;
  const int tid = threadIdx.x, lane = tid & 63, warp = tid >> 6;
  for (int i = tid; i < 2048; i += 256) smod[i] = mod_val(p, 0, 3072 + i);
  __syncthreads();
  const float* x1 = p.out;
  bf16_t* h2 = (bf16_t*)(p.ws + R_H2);
  for (int rp = blockIdx.x * 4 + warp; rp < T_LAT / 2; rp += gridDim.x * 4) {
    float h[2][16]; float ss[2] = {0.f, 0.f};
#pragma unroll
    for (int u = 0; u < 2; ++u)
#pragma unroll
      for (int i = 0; i < 4; ++i) {
        float4 v = *(const float4*)(x1 + (size_t)(rp * 2 + u) * 1024 + i * 256 + lane * 4);
        h[u][4 * i] = v.x; h[u][4 * i + 1] = v.y; h[u][4 * i + 2] = v.z; h[u][4 * i + 3] = v.w;
        ss[u] += v.x * v.x + v.y * v.y + v.z * v.z + v.w * v.w;
      }
#pragma unroll
    for (int u = 0; u < 2; ++u) {
      const int row = rp * 2 + u;
      const float rstd = rsqrtf(wave_sum_u(ss[u]) * (1.f / 1024.f) + 1e-6f);
#pragma unroll
      for (int i = 0; i < 4; ++i) {
#pragma unroll
        for (int e = 0; e < 4; ++e) {
          int k = i * 256 + lane * 4 + e;
          float y = h[u][4 * i + e] * rstd * p.in[I_N2G][k];
          h[u][4 * i + e] = y * (1.f + smod[1024 + k]) + smod[k];
        }
        *(uint2*)(h2 + (size_t)row * 1024 + i * 256 + lane * 4) = make_uint2(pack2(h[u][4 * i], h[u][4 * i + 1]), pack2(h[u][4 * i + 2], h[u][4 * i + 3]));
      }
    }
  }
}

DEVI void phase14(const Params& p, unsigned char* smem, const XcdMap& xm) {
  bf16_t(*Qt)[136] = (bf16_t(*)[136])smem;
  float* Sc = (float*)smem;
  const int tid = threadIdx.x, lane = tid & 63, warp = tid >> 6, wm = warp >> 1, wn = warp & 1;
  const bf16_t* h2 = (const bf16_t*)(p.ws + R_H2);
  const bf16_t* keys = (const bf16_t*)(p.ws + O_KEYS);
  float* tops = (float*)(p.ws + R_TOPS);
  int* topi = (int*)(p.ws + R_TOPI);
  for_tiles_xcd(xm, 128, 16, 8, 8, [&](int mt, int hp) {
    f32x4 acc[4][4];
    zero_acc(acc);
    gemm_core(h2 + (size_t)mt * 128 * 1024, 1024, (const bf16_t*)(p.ws + O_WQ) + (size_t)hp * 128 * 1024, 1024, 1024, acc, smem);
#pragma unroll
    for (int i = 0; i < 4; ++i)
#pragma unroll
      for (int j = 0; j < 4; ++j)
        *(uint2*)&Qt[wm * 64 + i * 16 + (lane & 15)][wn * 64 + j * 16 + (lane >> 4) * 4] =
            make_uint2(pack2(acc[i][j][0], acc[i][j][1]), pack2(acc[i][j][2], acc[i][j][3]));
    __syncthreads();
    zero_acc(acc);
#pragma unroll
    for (int ks = 0; ks < 4; ++ks) {
      bf16x8 qf[4], kf[4];
#pragma unroll
      for (int i = 0; i < 4; ++i) qf[i] = *(const bf16x8*)&Qt[wm * 64 + i * 16 + (lane & 15)][ks * 32 + (lane >> 4) * 8];
#pragma unroll
      for (int j = 0; j < 4; ++j) kf[j] = *(const bf16x8*)(keys + ((size_t)hp * 128 + wn * 64 + j * 16 + (lane & 15)) * 128 + ks * 32 + (lane >> 4) * 8);
#pragma unroll
      for (int i = 0; i < 4; ++i)
#pragma unroll
        for (int j = 0; j < 4; ++j) acc[i][j] = __builtin_amdgcn_mfma_f32_16x16x32_bf16(kf[j], qf[i], acc[i][j], 0, 0, 0);
    }
    __syncthreads();
#pragma unroll
    for (int i = 0; i < 4; ++i)
#pragma unroll
      for (int j = 0; j < 4; ++j) {
        float* d = Sc + (wm * 64 + i * 16 + (lane & 15)) * 129 + wn * 64 + j * 16 + (lane >> 4) * 4;
        d[0] = acc[i][j][0]; d[1] = acc[i][j][1]; d[2] = acc[i][j][2]; d[3] = acc[i][j][3];
      }
    __syncthreads();
    {
      const int row = tid & 127, half = tid >> 7;
      float* hp_ = Sc + row * 129 + half * 64;
      float bv[16]; int bi[16];
#pragma unroll
      for (int r = 0; r < 16; ++r) {
        float best = -INFINITY; int b2 = 0;
#pragma unroll 8
        for (int k = 0; k < 64; ++k) { float v = hp_[k]; if (v > best) { best = v; b2 = k; } }
        bv[r] = best; bi[r] = b2 + half * 64; hp_[b2] = -INFINITY;
      }
#pragma unroll
      for (int r = 0; r < 16; ++r) { hp_[r] = bv[r]; hp_[16 + r] = __int_as_float(bi[r]); }
    }
    __syncthreads();
    if (tid < 128) {
      const float* la = Sc + tid * 129; const float* lb = la + 64;
      size_t ob = ((size_t)(mt * 128 + tid) * 16 + hp) * 16;
      int ia = 0, ib = 0;
      for (int r = 0; r < 16; ++r) {
        float va = la[ia], vb = lb[ib];
        bool ta = va >= vb;
        tops[ob + r] = ta ? va : vb;
        topi[ob + r] = __float_as_int(ta ? la[16 + ia] : lb[16 + ib]);
        ia += ta ? 1 : 0; ib += ta ? 0 : 1;
      }
    }
    __syncthreads();
  });
}

template <bool DRY> DEVI void phase15(const Params& p, unsigned char* smem) {
  const bool wr = !DRY || (p.in[I_FG][0] == 1234.5f);
  float* gt = (float*)smem;
  const int tid = threadIdx.x, lane = tid & 63, warp = tid >> 6;
  for (int i = tid; i < 1024; i += 256) gt[i] = mod_val(p, 0, 5120 + i);
  __syncthreads();
  const bf16_t* __restrict__ h2 = (const bf16_t*)(p.ws + R_H2);
  const float* __restrict__ tops = (const float*)(p.ws + R_TOPS);
  const int* __restrict__ topi = (const int*)(p.ws + R_TOPI);
  const unsigned char* __restrict__ uf8 = p.ws + R_UBF;
  const unsigned char* __restrict__ vf8 = p.ws + R_VBF;
  float* xo = p.out;
  int ca, cb;
  {
    int l = lane;
    if (l < 16) { ca = 0; cb = l; } else if (l < 24) { ca = 1; cb = l - 16; } else if (l < 29) { ca = 2; cb = l - 24; }
    else if (l < 33) { ca = 3; cb = l - 29; } else if (l < 36) { ca = 4; cb = l - 33; } else if (l < 38) { ca = 5; cb = l - 36; }
    else if (l < 40) { ca = 6; cb = l - 38; } else if (l < 42) { ca = 7; cb = l - 40; } else if (l < 50) { ca = l - 34; cb = 0; }
    else { ca = 0; cb = 0; }
  }
  const int flat = ca * 16 + cb;
  for (int t = blockIdx.x * 4 + warp; t < T_LAT; t += gridDim.x * 4) {
    float hv[16], out[16];
    {
      const u32x4 hp0 = *(const u32x4*)(h2 + (size_t)t * 1024 + lane * 16);
      const u32x4 hp1 = *(const u32x4*)(h2 + (size_t)t * 1024 + lane * 16 + 8);
#pragma unroll
      for (int e = 0; e < 4; ++e) { hv[2 * e] = bflo(hp0[e]); hv[2 * e + 1] = bfhi(hp0[e]); hv[8 + 2 * e] = bflo(hp1[e]); hv[8 + 2 * e + 1] = bfhi(hp1[e]); }
    }
#pragma unroll
    for (int e = 0; e < 16; ++e) out[e] = 0.f;
#pragma unroll 1
    for (int hd = 0; hd < 8; ++hd) {
      const size_t b1 = ((size_t)t * 16 + hd * 2) * 16, b2 = b1 + 16;
      float val = lane < 50 ? tops[b1 + ca] + tops[b2 + cb] : -INFINITY;
      int idx = topi[b1 + ca] * 128 + topi[b2 + cb];
      int cnt = 0;
#pragma unroll
      for (int i = 0; i < 50; ++i) {
        float vi = rlf(val, i);
        int fi = __builtin_amdgcn_readlane(flat, i);
        cnt += ((vi > val) || (vi == val && fi < flat)) ? 1 : 0;
      }
      bool sel = lane < 50 && cnt < 16;
      float vmax = rlf(val, 0);
      float ex = sel ? __expf(val - vmax) : 0.f;
      float gsum = wave_sum_u(ex);
      float g = ex / gsum;
      unsigned long long m1 = __ballot(sel);
      int es[16];
      float gq = 0.f;
#pragma unroll
      for (int q = 0; q < 16; ++q) {
        int src = __ffsll((long long)m1) - 1; m1 &= m1 - 1;
        es[q] = __builtin_amdgcn_readlane(idx, src);
        float gg = rlf(g, src);
        if (lane == q) gq = gg;
      }
      float dm = 0.f;
      {
        u32x4 ub[16];
#pragma unroll
        for (int q = 0; q < 16; ++q) ub[q] = *(const u32x4*)(uf8 + (size_t)es[q] * 1024 + lane * 16);
#pragma unroll
        for (int q = 0; q < 16; ++q) {
          float f[16]; unpack_fp8x16(ub[q], f);
          float d0 = 0.f, d1 = 0.f;
#pragma unroll
          for (int e = 0; e < 8; ++e) { d0 += f[2 * e] * hv[2 * e]; d1 += f[2 * e + 1] * hv[2 * e + 1]; }
          float d = wave_sum_u(d0 + d1);
          if (lane == q) dm = d;
        }
      }
      dm *= (1.f / 64.f);
      float coef = gq * 0.5f * dm * (1.f + erff(dm * 0.70710678118f)) * 0.25f;
      {
        u32x4 vb[16];
#pragma unroll
        for (int q = 0; q < 16; ++q) vb[q] = *(const u32x4*)(vf8 + (size_t)es[q] * 1024 + lane * 16);
#pragma unroll
        for (int q = 0; q < 16; ++q) {
          float cf = rlf(coef, q);
          float f[16]; unpack_fp8x16(vb[q], f);
#pragma unroll
          for (int e = 0; e < 16; ++e) out[e] += cf * f[e];
        }
      }
    }
    float xs[16]; float ss = 0.f;
#pragma unroll
    for (int i = 0; i < 4; ++i) {
      int k = lane * 16 + i * 4;
      float4 v = *(const float4*)(xo + (size_t)t * 1024 + k);
      xs[4 * i] = v.x + gt[k] * out[4 * i]; xs[4 * i + 1] = v.y + gt[k + 1] * out[4 * i + 1];
      xs[4 * i + 2] = v.z + gt[k + 2] * out[4 * i + 2]; xs[4 * i + 3] = v.w + gt[k + 3] * out[4 * i + 3];
      ss += xs[4 * i] * xs[4 * i] + xs[4 * i + 1] * xs[4 * i + 1] + xs[4 * i + 2] * xs[4 * i + 2] + xs[4 * i + 3] * xs[4 * i + 3];
    }
    ss = wave_sum_u(ss);
    float rstd = rsqrtf(ss * (1.f / 1024.f) + 1e-6f);
#pragma unroll
    for (int i = 0; i < 4; ++i) {
      int k = lane * 16 + i * 4;
      float4 g4 = *(const float4*)(p.in[I_FG] + k);
      if (wr) *(float4*)(xo + (size_t)t * 1024 + k) = make_float4(xs[4 * i] * rstd * g4.x, xs[4 * i + 1] * rstd * g4.y, xs[4 * i + 2] * rstd * g4.z, xs[4 * i + 3] * rstd * g4.w);
    }
  }
}

#define XB_TMO      128
#define XB_XCNT(j)  (256  + 64 * (j))
#define XB_XSUB(j)  (1280 + 64 * (j))
#define XB_XGEN(j)  (2304 + 64 * (j))
#define XB_TOP      3328
#define XB_TOPGEN   3392
#define XCD_BAR_WORDS 3456
#define XB_SPIN_CAP (1u << 22)
#define LAS __attribute__((address_space(3)))
DEVI unsigned xb_ld(unsigned* p) { return __hip_atomic_load(p, __ATOMIC_RELAXED, __HIP_MEMORY_SCOPE_AGENT); }
DEVI unsigned xb_add(unsigned* p, unsigned v) { return __hip_atomic_fetch_add(p, v, __ATOMIC_RELAXED, __HIP_MEMORY_SCOPE_AGENT); }
DEVI unsigned xb_xcc_id() { return (unsigned)__builtin_amdgcn_s_getreg((3 << 11) | 20) & 0xFu; }
#define XB_SPIN(cond, bar) do { unsigned _sp = 0; while (cond) { __builtin_amdgcn_s_sleep(1); \
    if ((++_sp & 255u) == 0u) { if (xb_ld(&(bar)[XB_TMO])) break; if (_sp > XB_SPIN_CAP) { atomicAdd(&(bar)[XB_TMO], 1u); break; } } } } while (0)
struct XcdBarrier { unsigned* bar; unsigned x; volatile LAS unsigned* st; };
DEVI XcdBarrier xcd_barrier_post(unsigned* bar, volatile LAS unsigned* st) {
  XcdBarrier b; b.bar = bar; b.x = xb_xcc_id(); b.st = st;
  if (threadIdx.x == 0) st[2] = xb_add(&bar[XB_XCNT(b.x)], 1u);
  return b;
}
DEVI void xcd_barrier_complete(unsigned* bar, unsigned x, unsigned& nloc, unsigned& nx, unsigned& vidx) {
  const unsigned G = gridDim.x * gridDim.y * gridDim.z;
  unsigned sum, cnt, mine, below, sp = 0u;
  for (;;) {
    sum = 0u; cnt = 0u; mine = 0u; below = 0u;
#pragma unroll
    for (unsigned j = 0; j < 16; ++j) { const unsigned c = xb_ld(&bar[XB_XCNT(j)]); sum += c; cnt += (c > 0u) ? 1u : 0u; mine = (j == x) ? c : mine; below += (c > 0u && j < x) ? 1u : 0u; }
    if (sum == G) break;
    __builtin_amdgcn_s_sleep(1);
    if ((++sp & 255u) == 0u) { if (xb_ld(&bar[XB_TMO])) break; if (sp > XB_SPIN_CAP) { atomicAdd(&bar[XB_TMO], 1u); break; } }
  }
  nloc = mine > 0u ? mine : 1u; nx = cnt > 0u ? cnt : 1u; vidx = below;
}
DEVI void xcd_barrier(const XcdBarrier& b) {
  asm volatile("s_waitcnt vmcnt(0)" ::: "memory");
  __syncthreads();
  if (threadIdx.x == 0) {
    unsigned* bar = b.bar;
    __builtin_amdgcn_s_waitcnt(0);
    unsigned nloc = b.st[0], nx = b.st[1];
    if (nloc == 0u) { unsigned vidx; xcd_barrier_complete(bar, b.x, nloc, nx, vidx); b.st[0] = nloc; b.st[1] = nx; b.st[3] = vidx; }
    const unsigned old = xb_add(&bar[XB_XSUB(b.x)], 1u);
    const unsigned gen = old / nloc;
    if (old + 1u == (gen + 1u) * nloc) {
      __builtin_amdgcn_fence(__ATOMIC_RELEASE, "agent");
      asm volatile("s_waitcnt vmcnt(0)" ::: "memory");
      const unsigned og = xb_add(&bar[XB_TOP], 1u);
      const unsigned tg = og / nx;
      if (og + 1u == (tg + 1u) * nx) xb_add(&bar[XB_TOPGEN], 1u);
      else XB_SPIN(xb_ld(&bar[XB_TOPGEN]) == tg, bar);
      __builtin_amdgcn_fence(__ATOMIC_ACQUIRE, "agent");
      xb_add(&bar[XB_XGEN(b.x)], 1u);
      asm volatile("s_waitcnt vmcnt(0)" ::: "memory");
    } else {
      XB_SPIN(xb_ld(&bar[XB_XGEN(b.x)]) == gen, bar);
      __builtin_amdgcn_fence(__ATOMIC_ACQUIRE, "agent");
      asm volatile("s_waitcnt vmcnt(0)" ::: "memory");
    }
  }
  __syncthreads();
}

constexpr int NPHASE = 16;
DEVI XcdMap get_xm(int coop, const uint4& w) {
  XcdMap m;
  if (coop) { m.v = (int)w.w; m.nx = (int)w.y; m.slot = (int)w.z; m.slots = (int)w.x; }
  else { m.v = blockIdx.x & 7; m.nx = 8; m.slot = blockIdx.x >> 3; m.slots = gridDim.x >> 3; if (m.slots < 1) { m.slots = 1; } }
  return m;
}
__global__ void __launch_bounds__(256, 2) mk(Params p, int ph0, int ph1, int coop) {
  __shared__ __attribute__((aligned(16))) unsigned char smem[SMEM_BYTES];
  __shared__ uint4 xb_words;
  if (threadIdx.x == 0) xb_words = make_uint4(0u, 0u, 0u, 0u);
  __syncthreads();
  XcdBarrier xb;
  if (coop) xb = xcd_barrier_post((unsigned*)(p.ws + O_BAR), (volatile LAS unsigned*)&xb_words);
#ifdef XCC_PROBE
  if (coop && xb_xcc_id() != (blockIdx.x & 7u)) { unsigned long long t0 = wall_clock64(); while (wall_clock64() - t0 < 100000ull) __builtin_amdgcn_s_sleep(8); }
#endif
  if (ph0 < 0) cg::this_grid().sync();
#ifdef PROBE_A
#define STAMP(n) if (blockIdx.x == 0 && threadIdx.x == 0) ((unsigned long long*)(p.ws + O_STAMP))[n] = wall_clock64();
#else
#define STAMP(n)
#endif
#define RUN_PHASE(n, call)                                   \
  if (ph0 <= n && n < ph1) {                                 \
    STAMP(n)                                                 \
        if (DRY_PH == n) { if (n == 4) phase4<true>(p); if (n == 5) phase5<true>(p, smem); if (n == 8) phase8<true>(p, smem); if (n == 15) phase15<true>(p, smem); } \
    if (ONLY < 0 || ONLY == n) { call; }                     \
    if (REPEAT_PH == n) { call; }                            \
    if (coop && n + 1 < ph1) xcd_barrier(xb);                \
  }
  RUN_PHASE(0, phase0(p, smem))
  RUN_PHASE(1, phase1(p, smem))
  RUN_PHASE(2, phase2(p, smem, get_xm(coop, xb_words)))
  RUN_PHASE(3, phase3(p, smem))
  RUN_PHASE(4, (phase4<false>(p), phase6(p, smem, 0, 32, gridDim.x > 290 ? 258 : 0, gridDim.x > 290 ? (int)gridDim.x - 258 : (int)gridDim.x)))
  RUN_PHASE(5, phase5<false>(p, smem))
  RUN_PHASE(6, phase6(p, smem, 32, 260 * 8, 0, (int)gridDim.x))
  RUN_PHASE(7, phase7(p))
  RUN_PHASE(8, phase8<false>(p, smem))
  RUN_PHASE(9, phase9(p))
  RUN_PHASE(10, phase10(p))
  RUN_PHASE(11, phase11(p, smem, get_xm(coop, xb_words)))
  RUN_PHASE(12, (phase12(p, smem, get_xm(coop, xb_words)), convert_fp8(p.in[I_PU], p.ws + R_UBF, (size_t)16384 * 64, 64.f)))
  RUN_PHASE(13, phase13(p, smem))
  RUN_PHASE(14, (phase14(p, smem, get_xm(coop, xb_words)), convert_fp8(p.in[I_PV], p.ws + R_VBF, (size_t)16384 * 64, 4.f)))
  RUN_PHASE(15, phase15<false>(p, smem))
#ifdef SYNC_EXTRA
  for (int i = 0; i < SYNC_EXTRA; ++i) xcd_barrier(xb);
#endif
#ifdef PROBE_A
  cg::this_grid().sync();
  STAMP(16)
  __syncthreads();
  if (blockIdx.x == 0) {
    const unsigned long long* st = (const unsigned long long*)(p.ws + O_STAMP);
    float ta = (float)(st[PROBE_A + 1] - st[PROBE_A]) * 0.01f, tb = (float)(st[PROBE_B + 1] - st[PROBE_B]) * 0.01f;
    for (int i = threadIdx.x; i < 1000000; i += 256) p.out[1 + i] = tb;
    if (threadIdx.x == 0) p.out[0] = 100.f * ta;
  }
#endif
}

extern "C" void kernel_launch(void* const* d_in, const int* in_sizes, int n_in, void* d_out, int out_size, void* d_ws,
                              size_t ws_size, hipStream_t stream) {
  static int grid_blocks = 0;
  if (!grid_blocks) {
    int dev = 0, cus = 0, per_cu = 0;
    hipGetDevice(&dev);
    hipDeviceGetAttribute(&cus, hipDeviceAttributeMultiprocessorCount, dev);
    hipOccupancyMaxActiveBlocksPerMultiprocessor(&per_cu, mk, 256, 0);
    if (per_cu < 1) per_cu = 1;
    if (per_cu > 2) per_cu = 2;
    grid_blocks = cus * per_cu;
  }
  if (ws_size < WS_NEED) { fprintf(stderr, "workspace too small: %zu < %zu\n", ws_size, (size_t)WS_NEED); return; }
  Params p{};
  for (int i = 0; i < 32; ++i) p.in[i] = (const float*)d_in[i];
  p.out = (float*)d_out;
  p.ws = (unsigned char*)d_ws;
#if MEGA
  (void)hipMemsetAsync((unsigned char*)d_ws + O_BAR, 0, XCD_BAR_WORDS * 4, stream);
  int ph0 = 0, ph1 = NPHASE, coop = 1;
  void* args[] = {&p, &ph0, &ph1, &coop};
  hipError_t e = hipLaunchCooperativeKernel((void*)mk, dim3(grid_blocks), dim3(256), args, 0, stream);
  if (e != hipSuccess) fprintf(stderr, "cooperative launch failed: %s (grid %d)\n", hipGetErrorString(e), grid_blocks);
#else
  for (int ph = 0; ph < NPHASE; ++ph) mk<<<grid_blocks, 256, 0, stream>>>(p, ph, ph + 1, 0);
#endif
}
```

```cpp
#include <hip/hip_runtime.h>
#include <hip/hip_cooperative_groups.h>
#include <cstdio>
#include <cstdint>
namespace cg = cooperative_groups;

#ifndef MEGA
#define MEGA 1
#endif
#ifndef ONLY
#define ONLY -1
#endif
#ifndef REPEAT_PH
#define REPEAT_PH -1
#endif
#ifndef DRY_PH
#define DRY_PH -1
#endif

typedef unsigned short bf16_t;
using bf16x8 = __attribute__((ext_vector_type(8))) short;
using f32x4 = __attribute__((ext_vector_type(4))) float;
using u32x4 = __attribute__((ext_vector_type(4))) unsigned;
#define DEVI __device__ __forceinline__

constexpr int T_CTX = 256, T_LAT = 16384, T_ALL = 16640;
constexpr int NIN = 5392, NP = 5376;
constexpr int NCH = 128, LCH = 130;
constexpr int SVH = 576;
constexpr int SMEM_BYTES = 71680;

enum { I_X = 0, I_C, I_CTX, I_CCTX, I_ADAW, I_ADAB, I_N1G, I_WIN, I_RCONV, I_RW0, I_RWUP, I_RA0, I_RAUP, I_RGUP,
       I_RKK, I_RKA, I_RRK, I_RLNW, I_RLNB, I_MCONV, I_MIB, I_MFB, I_MNG, I_WBA, I_WBB, I_WOUT, I_N2G, I_WQ,
       I_KEYS, I_PU, I_PV, I_FG };

struct Params { const float* in[32]; float* out; unsigned char* ws; };

constexpr size_t A256(size_t x) { return (x + 255) & ~(size_t)255; }
constexpr size_t O_MODP = 0;
constexpr size_t O_WBA = A256(O_MODP + (size_t)16 * 2 * 6144 * 4);
constexpr size_t O_WBB = A256(O_WBA + (size_t)1024 * 512 * 2);
constexpr size_t O_WOUT = A256(O_WBB + (size_t)1024 * 512 * 2);
constexpr size_t O_WQ = A256(O_WOUT + (size_t)1024 * 1024 * 2);
constexpr size_t O_KEYS = A256(O_WQ + (size_t)2048 * 1024 * 2);
constexpr size_t O_WUP = A256(O_KEYS + (size_t)16 * 128 * 128 * 2);
constexpr size_t O_AUP = A256(O_WUP + (size_t)1024 * 64 * 2);
constexpr size_t O_GUP = A256(O_AUP + (size_t)1024 * 64 * 2);
constexpr size_t O_BEND = A256(O_GUP + (size_t)512 * 128 * 2);
constexpr size_t O_MLOC = A256(O_BEND + (size_t)260 * 8 * 4);
constexpr size_t O_MST = A256(O_MLOC + (size_t)260 * 8 * 4);
constexpr size_t O_NT = A256(O_MST + (size_t)260 * 8 * 4);
constexpr size_t O_BONUS = A256(O_NT + (size_t)260 * 8 * 64 * 4);
constexpr size_t O_STAMP = A256(O_BONUS + (size_t)T_ALL * 16 * 4);
constexpr size_t O_BAR = A256(O_STAMP + 1024);
constexpr size_t O_PG = A256(O_BAR + 3456 * 4);
constexpr size_t O_PO = A256(O_PG + (size_t)T_LAT * 2048 * 2);
constexpr size_t O_R = A256(O_PO + (size_t)T_LAT * 512 * 2);
constexpr size_t R_HX = O_R;
constexpr size_t R_WIN = A256(R_HX + (size_t)T_ALL * 1024 * 2);
constexpr size_t R_PQK = A256(R_WIN + (size_t)(NP + 128) * 1024 * 2);
constexpr size_t R_PV = A256(R_PQK + (size_t)T_ALL * 512 * 2);
constexpr size_t R_GIF = A256(R_PV + (size_t)T_ALL * 512 * 2);
constexpr size_t R_U = A256(R_GIF + (size_t)T_ALL * 16 * 4);
constexpr size_t R_END1 = A256(R_U + (size_t)260 * 8 * 8192 * 4);
constexpr size_t R_SV = O_R;
constexpr size_t R_YA = A256(R_SV + (size_t)T_ALL * 8 * SVH * 2);
constexpr size_t R_END2 = A256(R_YA + (size_t)T_LAT * 512 * 2);
constexpr size_t R_MERGED = O_R;
constexpr size_t R_H2 = A256(R_MERGED + (size_t)T_LAT * 1024 * 2);
constexpr size_t R_TOPS = A256(R_H2 + (size_t)T_LAT * 1024 * 2);
constexpr size_t R_TOPI = A256(R_TOPS + (size_t)T_LAT * 256 * 4);
constexpr size_t R_UBF = A256(R_TOPI + (size_t)T_LAT * 256 * 4);
constexpr size_t R_VBF = A256(R_UBF + (size_t)16384 * 1024 * 2);
constexpr size_t R_END3 = A256(R_VBF + (size_t)16384 * 1024 * 2);
constexpr size_t WS_NEED = (R_END1 > R_END2 ? (R_END1 > R_END3 ? R_END1 : R_END3) : (R_END2 > R_END3 ? R_END2 : R_END3));
constexpr size_t OUT_BC = (size_t)NCH * 16 * 4096 * 4;

DEVI bf16_t f2bf(float f) { unsigned u = __float_as_uint(f); u += 0x7fffu + ((u >> 16) & 1u); return (bf16_t)(u >> 16); }
DEVI float bf2f(bf16_t h) { return __uint_as_float(((unsigned)h) << 16); }
DEVI float bflo(unsigned u) { return __uint_as_float(u << 16); }
DEVI float bfhi(unsigned u) { return __uint_as_float(u & 0xffff0000u); }
DEVI unsigned pack2(float a, float b) { return (unsigned)f2bf(a) | ((unsigned)f2bf(b) << 16); }
DEVI void unpack8(const uint4& u, float* f) {
  f[0] = bflo(u.x); f[1] = bfhi(u.x); f[2] = bflo(u.y); f[3] = bfhi(u.y);
  f[4] = bflo(u.z); f[5] = bfhi(u.z); f[6] = bflo(u.w); f[7] = bfhi(u.w);
}
DEVI uint4 pack8(const float* f) { return make_uint4(pack2(f[0], f[1]), pack2(f[2], f[3]), pack2(f[4], f[5]), pack2(f[6], f[7])); }
DEVI float wave_sum(float v) {
#pragma unroll
  for (int o = 32; o; o >>= 1) v += __shfl_xor(v, o);
  return v;
}
DEVI float wave_max(float v) {
#pragma unroll
  for (int o = 32; o; o >>= 1) v = fmaxf(v, __shfl_xor(v, o));
  return v;
}
DEVI float sigm(float x) { return 1.f / (1.f + __expf(-x)); }
DEVI float siluf(float x) { return x / (1.f + __expf(-x)); }
DEVI float logsig(float x) { return fminf(x, 0.f) - log1pf(expf(-fabsf(x))); }
template <int CTRL> DEVI float dppf(float v) { return __int_as_float(__builtin_amdgcn_update_dpp(0, __float_as_int(v), CTRL, 0xf, 0xf, true)); }
DEVI float rlf(float v, int l) { return __int_as_float(__builtin_amdgcn_readlane(__float_as_int(v), l)); }
DEVI float wave_sum_u(float v) {
  v += dppf<0xB1>(v); v += dppf<0x4E>(v); v += dppf<0x141>(v); v += dppf<0x140>(v);
  return (rlf(v, 0) + rlf(v, 16)) + (rlf(v, 32) + rlf(v, 48));
}
typedef __attribute__((ext_vector_type(2))) short s16x2;
DEVI float dot2bf(unsigned a, unsigned b, float c) { return __builtin_amdgcn_fdot2_f32_bf16(__builtin_bit_cast(s16x2, a), __builtin_bit_cast(s16x2, b), c, false); }
typedef __attribute__((ext_vector_type(2))) float f32x2;
DEVI void convert_fp8(const float* __restrict__ src, unsigned char* __restrict__ dst, size_t n16, float scale) {
  for (size_t g = (size_t)blockIdx.x * 256 + threadIdx.x; g < n16; g += (size_t)gridDim.x * 256) {
    u32x4 o;
#pragma unroll
    for (int q = 0; q < 4; ++q) {
      float4 a = *(const float4*)(src + g * 16 + q * 4);
      int pk = __builtin_amdgcn_cvt_pk_fp8_f32(a.x * scale, a.y * scale, 0, false);
      pk = __builtin_amdgcn_cvt_pk_fp8_f32(a.z * scale, a.w * scale, pk, true);
      o[q] = (unsigned)pk;
    }
    *(u32x4*)(dst + g * 16) = o;
  }
}
DEVI void unpack_fp8x16(const u32x4& u, float* f) {
#pragma unroll
  for (int q = 0; q < 4; ++q) {
    f32x2 lo = __builtin_amdgcn_cvt_pk_f32_fp8((int)u[q], false), hi = __builtin_amdgcn_cvt_pk_f32_fp8((int)u[q], true);
    f[4 * q] = lo[0]; f[4 * q + 1] = lo[1]; f[4 * q + 2] = hi[0]; f[4 * q + 3] = hi[1];
  }
}
DEVI void convert_bf16(const float* __restrict__ src, bf16_t* __restrict__ dst, size_t n8) {
  for (size_t g = (size_t)blockIdx.x * 256 + threadIdx.x; g < n8; g += (size_t)gridDim.x * 256) {
    float4 a = *(const float4*)(src + g * 8), b = *(const float4*)(src + g * 8 + 4);
    *(uint4*)(dst + g * 8) = make_uint4(pack2(a.x, a.y), pack2(a.z, a.w), pack2(b.x, b.y), pack2(b.z, b.w));
  }
}
DEVI float allred8(float v) { v += dppf<0xB1>(v); v += dppf<0x4E>(v); v += dppf<0x141>(v); return v; }

DEVI int ml_row(int c, int j) {
  if (c < 4) return c * 64 + j;
  int cc = c - 4; int col = cc >> 2; int gr = (cc & 3) * 64 + j;
  return T_CTX + gr * 64 + col;
}
DEVI int ml_sc(int c, int dir) { return dir == 0 ? c : (c < 4 ? 3 - c : 263 - c); }
DEVI int rw_row(int p, int dir) { return dir == 0 ? p : (p < T_CTX ? (T_CTX - 1 - p) : (T_ALL + T_CTX - 1 - p)); }

DEVI float mod_val(const Params& p, int which, int col) {
  const float* modp = (const float*)(p.ws + O_MODP);
  float s = p.in[I_ADAB][col];
#pragma unroll
  for (int rs = 0; rs < 16; ++rs) s += modp[(rs * 2 + which) * 6144 + col];
  return s;
}

DEVI void gemm_core(const bf16_t* __restrict__ A, int lda, const bf16_t* __restrict__ Bt, int ldb, int K,
                    f32x4 (&acc)[4][4], unsigned char* smem) {
  bf16_t(*sa)[80] = (bf16_t(*)[80])smem;
  bf16_t(*sb)[80] = (bf16_t(*)[80])(smem + 128 * 80 * 2);
  const int tid = threadIdx.x, lane = tid & 63, warp = tid >> 6, wm = warp >> 1, wn = warp & 1;
  const int lr = tid >> 3, lk = (tid & 7) * 8;
  const bf16_t* Ap = A + (size_t)lr * lda + lk;
  const bf16_t* Bp = Bt + (size_t)lr * ldb + lk;
  u32x4 ra0[4], rb0[4], ra1[4], rb1[4];
#pragma unroll
  for (int i = 0; i < 4; ++i) {
    ra0[i] = *(const u32x4*)(Ap + (size_t)(32 * i) * lda); rb0[i] = *(const u32x4*)(Bp + (size_t)(32 * i) * ldb);
    ra1[i] = *(const u32x4*)(Ap + (size_t)(32 * i) * lda + 64); rb1[i] = *(const u32x4*)(Bp + (size_t)(32 * i) * ldb + 64);
  }
#define GEMM_STEP(k0, ra, rb)                                                                                 \
  {                                                                                                           \
    __syncthreads();                                                                                          \
    _Pragma("unroll") for (int i = 0; i < 4; ++i) { *(u32x4*)&sa[lr + 32 * i][lk] = ra[i]; *(u32x4*)&sb[lr + 32 * i][lk] = rb[i]; } \
    __syncthreads();                                                                                          \
    if ((k0) + 128 < K) {                                                                                     \
      _Pragma("unroll") for (int i = 0; i < 4; ++i) {                                                         \
        ra[i] = *(const u32x4*)(Ap + (size_t)(32 * i) * lda + (k0) + 128);                                    \
        rb[i] = *(const u32x4*)(Bp + (size_t)(32 * i) * ldb + (k0) + 128);                                    \
      }                                                                                                       \
    }                                                                                                         \
    __builtin_amdgcn_s_setprio(1);                                                                            \
    _Pragma("unroll") for (int ks = 0; ks < 2; ++ks) {                                                        \
      bf16x8 af[4], bq[4];                                                                                    \
      _Pragma("unroll") for (int i = 0; i < 4; ++i) af[i] = *(const bf16x8*)&sa[wm * 64 + i * 16 + (lane & 15)][ks * 32 + (lane >> 4) * 8]; \
      _Pragma("unroll") for (int j = 0; j < 4; ++j) bq[j] = *(const bf16x8*)&sb[wn * 64 + j * 16 + (lane & 15)][ks * 32 + (lane >> 4) * 8]; \
      _Pragma("unroll") for (int i = 0; i < 4; ++i)                                                           \
        _Pragma("unroll") for (int j = 0; j < 4; ++j) acc[i][j] = __builtin_amdgcn_mfma_f32_16x16x32_bf16(bq[j], af[i], acc[i][j], 0, 0, 0); \
    }                                                                                                         \
    __builtin_amdgcn_s_setprio(0);                                                                            \
  }
  for (int k0 = 0; k0 < K; k0 += 128) {
    GEMM_STEP(k0, ra0, rb0)
    GEMM_STEP(k0 + 64, ra1, rb1)
  }
#undef GEMM_STEP
  __syncthreads();
}
DEVI void zero_acc(f32x4 (&acc)[4][4]) {
#pragma unroll
  for (int i = 0; i < 4; ++i)
#pragma unroll
    for (int j = 0; j < 4; ++j) acc[i][j] = f32x4{0.f, 0.f, 0.f, 0.f};
}

struct XcdMap { int v, nx, slot, slots; };
template <typename F> DEVI void for_tiles_xcd(const XcdMap& xm, int MT, int NT, int SM, int SN, F&& f) {
  const int nsn = (NT + SN - 1) / SN, nst = ((MT + SM - 1) / SM) * nsn, per = SM * SN;
  const int n_my = (nst - xm.v + xm.nx - 1) / xm.nx;
  for (int g = xm.slot; g < n_my * per; g += xm.slots) {
    const int s = xm.v + (g / per) * xm.nx, idx = g % per;
    const int sm = s / nsn, sn = s % nsn;
    const int mt = sm * SM + idx / SN, nt = sn * SN + idx % SN;
    if (mt < MT && nt < NT) f(mt, nt);
  }
}

DEVI void tr_tile(const float* __restrict__ src, int lds, int k0, int n0src, bf16_t* __restrict__ dst, int ldd, int n0dst,
                  unsigned char* smem) {
  float(*tile)[65] = (float(*)[65])smem;
  const int tid = threadIdx.x, j = tid & 63, i0 = tid >> 6;
#pragma unroll 4
  for (int ii = 0; ii < 16; ++ii) { int i = i0 + 4 * ii; tile[i][j] = src[(size_t)(k0 + i) * lds + n0src + j]; }
  __syncthreads();
#pragma unroll 4
  for (int jj = 0; jj < 16; ++jj) { int jn = i0 + 4 * jj; dst[(size_t)(n0dst + jn) * ldd + k0 + j] = f2bf(tile[j][jn]); }
  __syncthreads();
}

DEVI void phase0(const Params& p, unsigned char* smem, int it_lo, int it_hi) {
  const int tid = threadIdx.x;
  constexpr int N_MOD = 384, N_WIN = 16 * 85, N_WB = 128, N_WOUT = 256, N_WQ = 512, N_LORA = 16, N_GUP = 16, N_KEYS = 128;
  constexpr int E0 = N_MOD, E1 = E0 + N_WIN, E2 = E1 + N_WB, E3 = E2 + N_WB, E4 = E3 + N_WOUT, E5 = E4 + N_WQ,
                E6 = E5 + N_LORA, E7 = E6 + N_LORA, E8 = E7 + N_GUP, E9 = E8 + N_KEYS;
  if (it_hi > E9) it_hi = E9;
  for (int it = it_lo + blockIdx.x; it < it_hi; it += gridDim.x) {
    if (it < E0) {
      int cb = it % 24, rs = it / 24; int col = cb * 256 + tid;
      const float* aw = p.in[I_ADAW];
      float ax = 0.f, ac = 0.f;
#pragma unroll 8
      for (int r = rs * 64; r < rs * 64 + 64; ++r) {
        float w = aw[(size_t)r * 6144 + col];
        ax += siluf(p.in[I_C][r]) * w;
        ac += siluf(p.in[I_CCTX][r]) * w;
      }
      float* modp = (float*)(p.ws + O_MODP);
      modp[(rs * 2 + 0) * 6144 + col] = ax;
      modp[(rs * 2 + 1) * 6144 + col] = ac;
    } else if (it < E1) {
      int t = it - E0; int kt = t / 85, nt = t % 85; int n0 = nt * 64;
      tr_tile(p.in[I_WIN], NIN, kt * 64, nt == 84 ? 2816 : (n0 < 2816 ? n0 : n0 + 16), (bf16_t*)(p.ws + R_WIN), 1024, n0, smem);
    } else if (it < E2) {
      int t = it - E1; tr_tile(p.in[I_WBA], 1024, (t / 16) * 64, (t % 16) * 64, (bf16_t*)(p.ws + O_WBA), 512, (t % 16) * 64, smem);
    } else if (it < E3) {
      int t = it - E2; tr_tile(p.in[I_WBB], 1024, (t / 16) * 64, (t % 16) * 64, (bf16_t*)(p.ws + O_WBB), 512, (t % 16) * 64, smem);
    } else if (it < E4) {
      int t = it - E3; tr_tile(p.in[I_WOUT], 1024, (t / 16) * 64, (t % 16) * 64, (bf16_t*)(p.ws + O_WOUT), 1024, (t % 16) * 64, smem);
    } else if (it < E5) {
      int t = it - E4; tr_tile(p.in[I_WQ], 2048, (t / 32) * 64, (t % 32) * 64, (bf16_t*)(p.ws + O_WQ), 1024, (t % 32) * 64, smem);
    } else if (it < E6) {
      int t = it - E5; int dir = t / 8, nt = t % 8;
      tr_tile(p.in[I_RWUP] + (size_t)dir * 64 * 512, 512, 0, nt * 64, (bf16_t*)(p.ws + O_WUP) + (size_t)dir * 512 * 64, 64, nt * 64, smem);
    } else if (it < E7) {
      int t = it - E6; int dir = t / 8, nt = t % 8;
      tr_tile(p.in[I_RAUP] + (size_t)dir * 64 * 512, 512, 0, nt * 64, (bf16_t*)(p.ws + O_AUP) + (size_t)dir * 512 * 64, 64, nt * 64, smem);
    } else if (it < E8) {
      int t = it - E7; tr_tile(p.in[I_RGUP], 512, (t / 8) * 64, (t % 8) * 64, (bf16_t*)(p.ws + O_GUP), 128, (t % 8) * 64, smem);
    } else {
      int t = it - E8; size_t base = (size_t)t * 2048 + tid * 8;
      const float* s = p.in[I_KEYS] + base;
      float f[8];
      float4 a = *(const float4*)s, b = *(const float4*)(s + 4);
      f[0] = a.x; f[1] = a.y; f[2] = a.z; f[3] = a.w; f[4] = b.x; f[5] = b.y; f[6] = b.z; f[7] = b.w;
      *(uint4*)((bf16_t*)(p.ws + O_KEYS) + base) = pack8(f);
    }
  }
}

DEVI void phase1(const Params& p, unsigned char* smem) {
  float* smod = (float*)smem;
  const int tid = threadIdx.x, lane = tid & 63, warp = tid >> 6;
  for (int i = tid; i < 4096; i += 256) { int which = i >> 10; smod[i] = mod_val(p, which >> 1, (which & 1) * 1024 + (i & 1023)); }
  __syncthreads();
  bf16_t* hx = (bf16_t*)(p.ws + R_HX);
  float* gif = (float*)(p.ws + R_GIF);
  const float* win = p.in[I_WIN];
  constexpr int RPW = 4;
  for (int rg = blockIdx.x * 4 + warp; rg < T_ALL / RPW; rg += gridDim.x * 4) {
    const int row0 = rg * RPW;
    const float* sh = smod + (row0 < T_CTX ? 2048 : 0);
    const float* sc = sh + 1024;
    const float* src0 = row0 < T_CTX ? p.in[I_CTX] + (size_t)row0 * 1024 : p.in[I_X] + (size_t)(row0 - T_CTX) * 1024;
    float rstd[RPW];
#pragma unroll
    for (int r = 0; r < RPW; ++r) {
      float ss = 0.f;
#pragma unroll
      for (int i = 0; i < 4; ++i) {
        float4 v = *(const float4*)(src0 + (size_t)r * 1024 + i * 256 + lane * 4);
        ss += v.x * v.x + v.y * v.y + v.z * v.z + v.w * v.w;
      }
      ss = wave_sum_u(ss);
      rstd[r] = rsqrtf(ss * (1.f / 1024.f) + 1e-6f);
    }
#pragma unroll
    for (int i = 0; i < 4; ++i) {
      const int k0 = i * 256 + lane * 4;
      const float4 gk = *(const float4*)(p.in[I_N1G] + k0);
      const float4 s4 = *(const float4*)(sc + k0), h4 = *(const float4*)(sh + k0);
#pragma unroll
      for (int r = 0; r < RPW; ++r) {
        float4 v = *(const float4*)(src0 + (size_t)r * 1024 + k0);
        const float y0 = v.x * rstd[r] * gk.x * (1.f + s4.x) + h4.x, y1 = v.y * rstd[r] * gk.y * (1.f + s4.y) + h4.y;
        const float y2 = v.z * rstd[r] * gk.z * (1.f + s4.z) + h4.z, y3 = v.w * rstd[r] * gk.w * (1.f + s4.w) + h4.w;
        *(uint2*)(hx + (size_t)(row0 + r) * 1024 + k0) = make_uint2(pack2(y0, y1), pack2(y2, y3));
      }
    }
  }
}

DEVI void phase2(const Params& p, unsigned char* smem, const XcdMap& xm) {
  const int lane = threadIdx.x & 63, warp = threadIdx.x >> 6, wm = warp >> 1, wn = warp & 1;
  const bf16_t* hx = (const bf16_t*)(p.ws + R_HX);
  const bf16_t* wt = (const bf16_t*)(p.ws + R_WIN);
  bf16_t* prw = (bf16_t*)p.out;
  bf16_t* pqk = (bf16_t*)(p.ws + R_PQK);
  bf16_t* pv = (bf16_t*)(p.ws + R_PV);
  bf16_t* po = (bf16_t*)(p.ws + O_PO);
  bf16_t* pg = (bf16_t*)(p.ws + O_PG);
  for_tiles_xcd(xm, 130, 43, 5, 6, [&](int mt, int nt) {
    if (mt < 2 && nt >= 22 && nt < 42) return;
    f32x4 acc[4][4];
    zero_acc(acc);
    gemm_core(hx + (size_t)mt * 128 * 1024, 1024, wt + (size_t)nt * 128 * 1024, 1024, 1024, acc, smem);
    if (nt == 42) {
      float* gif = (float*)(p.ws + R_GIF);
      if (wn == 0) {
#pragma unroll
        for (int i = 0; i < 4; ++i) {
          const int row = mt * 128 + wm * 64 + i * 16 + (lane & 15);
          *(float4*)(gif + (size_t)row * 16 + (lane >> 4) * 4) = make_float4(acc[i][0][0], acc[i][0][1], acc[i][0][2], acc[i][0][3]);
        }
      }
      return;
    }
    bf16_t* dst; int ld, nb; int rofs = 0; bool sg = false;
    if (nt < 14) { dst = prw; ld = 1792; nb = nt * 128; }
    else if (nt < 18) { dst = pqk; ld = 512; nb = (nt - 14) * 128; }
    else if (nt < 22) { dst = pv; ld = 512; nb = (nt - 18) * 128; }
    else if (nt < 26) { dst = po; ld = 512; nb = (nt - 22) * 128; rofs = T_CTX; }
    else { dst = pg; ld = 2048; nb = (nt - 26) * 128; rofs = T_CTX; sg = true; }
    bf16_t(*Ct)[136] = (bf16_t(*)[136])smem;
#pragma unroll
    for (int i = 0; i < 4; ++i) {
#pragma unroll
      for (int j = 0; j < 4; ++j) {
        f32x4 v = acc[i][j];
        if (sg) { v[0] = sigm(v[0]); v[1] = sigm(v[1]); v[2] = sigm(v[2]); v[3] = sigm(v[3]); }
        *(uint2*)&Ct[wm * 64 + i * 16 + (lane & 15)][wn * 64 + j * 16 + (lane >> 4) * 4] = make_uint2(pack2(v[0], v[1]), pack2(v[2], v[3]));
      }
    }
    __syncthreads();
#pragma unroll
    for (int q = 0; q < 8; ++q) {
      const int pc = threadIdx.x + 256 * q; const int r = pc >> 4, c8 = (pc & 15) * 8;
      const int row = mt * 128 + r - rofs;
      *(u32x4*)(dst + (size_t)row * ld + nb + c8) = *(const u32x4*)&Ct[r][c8];
    }
    __syncthreads();
  });
}

DEVI void ml_qk8(const Params& p, int c, int j, int chan, float* o) {
  const bf16_t* pqk = (const bf16_t*)(p.ws + R_PQK);
  int row = ml_row(c, j);
  bool hp, hn; int rp, rn;
  if (c < 4) { hp = row > 0; hn = row < T_CTX - 1; rp = row - 1; rn = row + 1; }
  else { int gr = ((c - 4) & 3) * 64 + j; hp = gr > 0; hn = gr < 255; rp = row - 64; rn = row + 64; }
  const float* cw = p.in[I_MCONV];
  float cur[8], pr[8], nx[8];
  unpack8(*(const uint4*)(pqk + (size_t)row * 512 + chan), cur);
  if (hp) unpack8(*(const uint4*)(pqk + (size_t)rp * 512 + chan), pr);
  if (hn) unpack8(*(const uint4*)(pqk + (size_t)rn * 512 + chan), nx);
#pragma unroll
  for (int e = 0; e < 8; ++e) {
    float v = cw[512 + chan + e] * cur[e];
    if (hp) v += cw[chan + e] * pr[e];
    if (hn) v += cw[1024 + chan + e] * nx[e];
    o[e] = siluf(v);
  }
}

DEVI void phase3(const Params& p, unsigned char* smem) {
  bf16_t(*KT)[72] = (bf16_t(*)[72])smem;
  bf16_t(*VwT)[72] = (bf16_t(*)[72])(smem + 64 * 72 * 2);
  float* wgt = (float*)(smem + 64 * 72 * 2 + 256 * 72 * 2);
  const int tid = threadIdx.x, lane = tid & 63, warp = tid >> 6;
  const float* gif = (const float*)(p.ws + R_GIF);
  const bf16_t* pv = (const bf16_t*)(p.ws + R_PV);
  float* U = (float*)(p.ws + R_U);
  float* NT = (float*)(p.ws + O_NT);
  float* bend = (float*)(p.ws + O_BEND);
  float* mloc = (float*)(p.ws + O_MLOC);
  for (int it = blockIdx.x; it < 260 * 4; it += gridDim.x) {
    int c = it >> 2, h = it & 3;
    if (warp < 2) {
      int dir = warp; int j = dir ? 63 - lane : lane;
      int row = ml_row(c, j);
      float ig = gif[(size_t)row * 16 + dir * 4 + h] + p.in[I_MIB][dir * 4 + h];
      float lf = logsig(gif[(size_t)row * 16 + 8 + dir * 4 + h] + p.in[I_MFB][dir * 4 + h]);
      float b = lf;
#pragma unroll
      for (int o = 1; o < 64; o <<= 1) { float t = __shfl_up(b, o); if (lane >= o) b += t; }
      float be = __shfl(b, 63);
      float ge = be - b + ig;
      float ml = wave_max(ge);
      wgt[dir * 64 + j] = expf(ge - ml);
      if (lane == 0) { int sc = ml_sc(c, dir); bend[sc * 8 + dir * 4 + h] = be; mloc[sc * 8 + dir * 4 + h] = ml; }
    }
    __syncthreads();
    {
      int j = tid >> 2, part = tid & 3;
      float f[8];
#pragma unroll
      for (int q = 0; q < 2; ++q) {
        int d0 = part * 16 + q * 8;
        ml_qk8(p, c, j, 256 + h * 64 + d0, f);
#pragma unroll
        for (int e = 0; e < 8; ++e) KT[d0 + e][j] = f2bf(f[e] * 0.125f);
      }
      int row = ml_row(c, j);
      float w0 = wgt[j], w1 = wgt[64 + j];
#pragma unroll
      for (int q = 0; q < 4; ++q) {
        int v0 = part * 32 + q * 8;
        unpack8(*(const uint4*)(pv + (size_t)row * 512 + h * 128 + v0), f);
#pragma unroll
        for (int e = 0; e < 8; ++e) { VwT[v0 + e][j] = f2bf(f[e] * w0); VwT[128 + v0 + e][j] = f2bf(f[e] * w1); }
      }
    }
    __syncthreads();
#pragma unroll
    for (int dir = 0; dir < 2; ++dir) {
      int sc = ml_sc(c, dir);
      float* Ud = U + ((size_t)sc * 8 + dir * 4 + h) * 8192;
#pragma unroll
      for (int vi = 0; vi < 2; ++vi) {
        int vt = warp * 2 + vi;
        bf16x8 bv[2];
#pragma unroll
        for (int ks = 0; ks < 2; ++ks) bv[ks] = *(const bf16x8*)&VwT[dir * 128 + vt * 16 + (lane & 15)][ks * 32 + (lane >> 4) * 8];
#pragma unroll
        for (int dt = 0; dt < 4; ++dt) {
          f32x4 a = {0.f, 0.f, 0.f, 0.f};
#pragma unroll
          for (int ks = 0; ks < 2; ++ks) {
            bf16x8 ak = *(const bf16x8*)&KT[dt * 16 + (lane & 15)][ks * 32 + (lane >> 4) * 8];
            a = __builtin_amdgcn_mfma_f32_16x16x32_bf16(ak, bv[ks], a, 0, 0, 0);
          }
          *(float4*)(Ud + (size_t)(vt * 16 + (lane & 15)) * 64 + dt * 16 + (lane >> 4) * 4) = make_float4(a[0], a[1], a[2], a[3]);
        }
      }
    }
    if (tid < 128) {
      int dir = tid >> 6, d = tid & 63; float s = 0.f;
      for (int j = 0; j < 64; ++j) s += wgt[dir * 64 + j] * bf2f(KT[d][j]);
      NT[((size_t)ml_sc(c, dir) * 8 + dir * 4 + h) * 64 + d] = s;
    }
    __syncthreads();
  }
}

template <bool DRY> DEVI void phase4(const Params& p) {
  const bool wr = !DRY || (p.in[I_FG][0] == 1234.5f);
  float* U = (float*)(p.ws + R_U);
  float* NT = (float*)(p.ws + O_NT);
  const float* bend = (const float*)(p.ws + O_BEND);
  const float* mloc = (const float*)(p.ws + O_MLOC);
  float* mst = (float*)(p.ws + O_MST);
  for (int g = blockIdx.x * 256 + threadIdx.x; g < 8 * 8256; g += gridDim.x * 256) {
    int pr = g / 8256, e = g % 8256;
    float* base; size_t stride;
    if (e < 8192) { base = U + (size_t)pr * 8192 + e; stride = 8 * 8192; }
    else { base = NT + (size_t)pr * 64 + (e - 8192); stride = 8 * 64; }
    float m = 0.f, C = 0.f;
    for (int sc = 0; sc < 260; sc += 20) {
      float u[20];
#pragma unroll
      for (int q = 0; q < 20; ++q) u[q] = base[(size_t)(sc + q) * stride];
#pragma unroll
      for (int q = 0; q < 20; ++q) {
        float be = bend[(sc + q) * 8 + pr], ml = mloc[(sc + q) * 8 + pr];
        float mn = fmaxf(be + m, ml);
        float keep = expf(be + m - mn), s = expf(ml - mn);
        if (wr) base[(size_t)(sc + q) * stride] = C;
        if (wr && e == 0) mst[(sc + q) * 8 + pr] = m;
        C = keep * C + s * u[q];
        m = mn;
      }
    }
  }
}

template <bool DRY> DEVI void phase5(const Params& p, unsigned char* smem) {
  const bool wr = !DRY || (p.in[I_FG][0] == 1234.5f);
  bf16_t(*Qs)[72] = (bf16_t(*)[72])smem;
  bf16_t(*Ks)[72] = (bf16_t(*)[72])(smem + 9216);
  bf16_t(*Pm)[72] = (bf16_t(*)[72])(smem + 2 * 9216);
  bf16_t(*VT)[72] = (bf16_t(*)[72])(smem + 3 * 9216);
  float* evec = (float*)(smem + 3 * 9216 + 144 * 72 * 2);
  float* Mvec = evec + 128;
  float* bvec = Mvec + 128;
  const int tid = threadIdx.x, lane = tid & 63, warp = tid >> 6;
  const float* gif = (const float*)(p.ws + R_GIF);
  const bf16_t* pv = (const bf16_t*)(p.ws + R_PV);
  const bf16_t* po = (const bf16_t*)(p.ws + O_PO);
  bf16_t* yb = (bf16_t*)(p.ws + R_YA);
  const float* U = (const float*)(p.ws + R_U);
  const float* NT = (const float*)(p.ws + O_NT);
  const float* mst = (const float*)(p.ws + O_MST);
  for (int it = blockIdx.x; it < 256 * 4; it += gridDim.x) {
    int c = 4 + (it >> 2), h = it & 3;
    if (warp < 2) {
      int dir = warp; int j = dir ? 63 - lane : lane;
      int row = ml_row(c, j);
      float ig = gif[(size_t)row * 16 + dir * 4 + h] + p.in[I_MIB][dir * 4 + h];
      float lf = logsig(gif[(size_t)row * 16 + 8 + dir * 4 + h] + p.in[I_MFB][dir * 4 + h]);
      float b = lf;
#pragma unroll
      for (int o = 1; o < 64; o <<= 1) { float t = __shfl_up(b, o); if (lane >= o) b += t; }
      float e = ig - b;
      float pm = e;
#pragma unroll
      for (int o = 1; o < 64; o <<= 1) { float t = __shfl_up(pm, o); if (lane >= o) pm = fmaxf(pm, t); }
      float m0 = mst[ml_sc(c, dir) * 8 + dir * 4 + h];
      evec[dir * 64 + j] = e; Mvec[dir * 64 + j] = fmaxf(m0, pm); bvec[dir * 64 + j] = b;
    }
    {
      int j = tid >> 2, part = tid & 3;
      float f[8];
#pragma unroll
      for (int q = 0; q < 2; ++q) {
        int d0 = part * 16 + q * 8;
        ml_qk8(p, c, j, h * 64 + d0, f);
        *(uint4*)&Qs[j][d0] = pack8(f);
        ml_qk8(p, c, j, 256 + h * 64 + d0, f);
#pragma unroll
        for (int e = 0; e < 8; ++e) f[e] *= 0.125f;
        *(uint4*)&Ks[j][d0] = pack8(f);
      }
      int row = ml_row(c, j);
#pragma unroll
      for (int q = 0; q < 4; ++q) {
        int v0 = part * 32 + q * 8;
        unpack8(*(const uint4*)(pv + (size_t)row * 512 + h * 128 + v0), f);
#pragma unroll
        for (int e = 0; e < 8; ++e) VT[v0 + e][j] = f2bf(f[e]);
      }
      for (int i = tid; i < 16 * 64; i += 256) VT[128 + (i >> 6)][i & 63] = (i < 64) ? (bf16_t)0x3f80 : (bf16_t)0;
    }
    __syncthreads();
    const int jl = warp * 16 + (lane & 15);
    f32x4 s0[4];
    bf16x8 qf[2];
#pragma unroll
    for (int ks = 0; ks < 2; ++ks) qf[ks] = *(const bf16x8*)&Qs[jl][ks * 32 + (lane >> 4) * 8];
#pragma unroll
    for (int st = 0; st < 4; ++st) {
      f32x4 a = {0.f, 0.f, 0.f, 0.f};
#pragma unroll
      for (int ks = 0; ks < 2; ++ks) {
        bf16x8 kf = *(const bf16x8*)&Ks[st * 16 + (lane & 15)][ks * 32 + (lane >> 4) * 8];
        a = __builtin_amdgcn_mfma_f32_16x16x32_bf16(kf, qf[ks], a, 0, 0, 0);
      }
      s0[st] = a;
    }
    f32x4 ysum[8];
#pragma unroll
    for (int vt = 0; vt < 8; ++vt) ysum[vt] = f32x4{0.f, 0.f, 0.f, 0.f};
#pragma unroll 1
    for (int dir = 0; dir < 2; ++dir) {
      float Mj = Mvec[dir * 64 + jl], bj = bvec[dir * 64 + jl];
      float m0 = mst[ml_sc(c, dir) * 8 + dir * 4 + h];
#pragma unroll
      for (int st = 0; st < 4; ++st) {
        float pvv[4];
#pragma unroll
        for (int r = 0; r < 4; ++r) {
          int s = st * 16 + (lane >> 4) * 4 + r;
          bool ok = dir == 0 ? (s <= jl) : (s >= jl);
          pvv[r] = ok ? s0[st][r] * expf(evec[dir * 64 + s] - Mj) : 0.f;
        }
        *(uint2*)&Pm[jl][st * 16 + (lane >> 4) * 4] = make_uint2(pack2(pvv[0], pvv[1]), pack2(pvv[2], pvv[3]));
      }
      __syncthreads();
      bf16x8 pf[2];
#pragma unroll
      for (int ks = 0; ks < 2; ++ks) pf[ks] = *(const bf16x8*)&Pm[jl][ks * 32 + (lane >> 4) * 8];
      const float* Cst = U + ((size_t)ml_sc(c, dir) * 8 + dir * 4 + h) * 8192;
      const float* nst = NT + ((size_t)ml_sc(c, dir) * 8 + dir * 4 + h) * 64;
      float ai = expf(m0 - Mj);
      f32x4 hh[9];
#pragma unroll
      for (int vt = 0; vt < 9; ++vt) {
        f32x4 a1 = {0.f, 0.f, 0.f, 0.f}, a2 = {0.f, 0.f, 0.f, 0.f};
#pragma unroll
        for (int ks = 0; ks < 2; ++ks) {
          bf16x8 vf = *(const bf16x8*)&VT[vt * 16 + (lane & 15)][ks * 32 + (lane >> 4) * 8];
          a1 = __builtin_amdgcn_mfma_f32_16x16x32_bf16(vf, pf[ks], a1, 0, 0, 0);
          int v = vt * 16 + (lane & 15);
          const float* cp = v < 128 ? Cst + (size_t)v * 64 + ks * 32 + (lane >> 4) * 8 : nst + ks * 32 + (lane >> 4) * 8;
          float cf[8];
          if (v <= 128) {
            float4 x0 = *(const float4*)cp, x1 = *(const float4*)(cp + 4);
            cf[0] = x0.x; cf[1] = x0.y; cf[2] = x0.z; cf[3] = x0.w; cf[4] = x1.x; cf[5] = x1.y; cf[6] = x1.z; cf[7] = x1.w;
          } else {
#pragma unroll
            for (int e = 0; e < 8; ++e) cf[e] = 0.f;
          }
          uint4 pk = pack8(cf);
          bf16x8 cfr;
          cfr[0] = (short)(pk.x & 0xffff); cfr[1] = (short)(pk.x >> 16); cfr[2] = (short)(pk.y & 0xffff); cfr[3] = (short)(pk.y >> 16);
          cfr[4] = (short)(pk.z & 0xffff); cfr[5] = (short)(pk.z >> 16); cfr[6] = (short)(pk.w & 0xffff); cfr[7] = (short)(pk.w >> 16);
          a2 = __builtin_amdgcn_mfma_f32_16x16x32_bf16(cfr, qf[ks], a2, 0, 0, 0);
        }
#pragma unroll
        for (int r = 0; r < 4; ++r) hh[vt][r] = a1[r] + ai * a2[r];
      }
      float den = __shfl(hh[8][0], lane & 15);
      float dn = fmaxf(fabsf(den), expf(-(bj + Mj)));
      float inv = 1.f / dn;
      float ss = 0.f;
#pragma unroll
      for (int vt = 0; vt < 8; ++vt)
#pragma unroll
        for (int r = 0; r < 4; ++r) { float x = hh[vt][r] * inv; hh[vt][r] = x; ss += x * x; }
      ss += __shfl_xor(ss, 16); ss += __shfl_xor(ss, 32);
      float rs = rsqrtf(ss * (1.f / 128.f) + 1e-6f);
#pragma unroll
      for (int vt = 0; vt < 8; ++vt)
#pragma unroll
        for (int r = 0; r < 4; ++r) ysum[vt][r] += hh[vt][r] * rs * p.in[I_MNG][h * 128 + vt * 16 + (lane >> 4) * 4 + r];
      __syncthreads();
    }
    {
      int row = ml_row(c, jl) - T_CTX;
#pragma unroll
      for (int vt = 0; vt < 8; ++vt) {
        const bf16_t* op = po + (size_t)row * 512 + h * 128 + vt * 16 + (lane >> 4) * 4;
        uint2 o = *(const uint2*)op;
        float y0 = ysum[vt][0] * sigm(bflo(o.x)), y1 = ysum[vt][1] * sigm(bfhi(o.x)), y2 = ysum[vt][2] * sigm(bflo(o.y)), y3 = ysum[vt][3] * sigm(bfhi(o.y));
        if (wr) *(uint2*)(yb + (size_t)row * 512 + h * 128 + vt * 16 + (lane >> 4) * 4) = make_uint2(pack2(y0, y1), pack2(y2, y3));
      }
    }
    __syncthreads();
  }
}

DEVI void phase6(const Params& p, unsigned char* smem, int item_lo, int item_hi, int blk0, int nblk) {
  float(*rs)[65] = (float(*)[65])smem;
  float(*ks)[65] = (float(*)[65])(smem + 64 * 65 * 4);
  bf16_t(*TW)[72] = (bf16_t(*)[72])(smem + 2 * 64 * 65 * 4);
  bf16_t(*TA)[72] = (bf16_t(*)[72])(smem + 2 * 64 * 65 * 4 + 9216);
  bf16_t(*TG)[136] = (bf16_t(*)[136])(smem + 2 * 64 * 65 * 4 + 2 * 9216);
  float* rn = (float*)(smem + 2 * 64 * 65 * 4 + 2 * 9216 + 64 * 136 * 2);
  const int tid = threadIdx.x, lane = tid & 63, warp = tid >> 6;
  const bf16_t* prw = (const bf16_t*)p.out;
  bf16_t* SV = (bf16_t*)(p.ws + R_SV);
  float* bonus = (float*)(p.ws + O_BONUS);
  const float* cw = p.in[I_RCONV];
  const bf16_t* WUP = (const bf16_t*)(p.ws + O_WUP);
  const bf16_t* AUP = (const bf16_t*)(p.ws + O_AUP);
  const bf16_t* GUP = (const bf16_t*)(p.ws + O_GUP);
  if ((int)blockIdx.x < blk0) return;
  for (int it = item_lo + ((int)blockIdx.x - blk0); it < item_hi; it += nblk) {
    int tile = it >> 3, head = it & 7;
    int row0 = tile * 64;
    int seg0 = tile < 4 ? 0 : row0, seg1 = tile < 4 ? T_CTX : row0 + 64;
#pragma unroll 1
    for (int ub = 0; ub < 2; ++ub) {
      u32x4 lc[7], lp[7], ln[7];
#pragma unroll
      for (int it7 = 0; it7 < 7; ++it7) {
        const int u = warp + 4 * (ub * 7 + it7);
        const int grp = u >> 3;
        const int j = (u & 7) * 8 + (lane >> 3), q = grp * 8 + (lane & 7);
        const int row = row0 + j;
        const int col = q < 24 ? (q >> 3) * 512 + head * 64 + (q & 7) * 8 : 1536 + (q - 24) * 8;
        const bool hp = row > seg0, hn = row < seg1 - 1;
        lc[it7] = *(const u32x4*)(prw + (size_t)row * 1792 + col);
        lp[it7] = hp ? *(const u32x4*)(prw + (size_t)(row - 1) * 1792 + col) : u32x4{0u, 0u, 0u, 0u};
        ln[it7] = hn ? *(const u32x4*)(prw + (size_t)(row + 1) * 1792 + col) : u32x4{0u, 0u, 0u, 0u};
      }
#pragma unroll
      for (int it7 = 0; it7 < 7; ++it7) {
        const int u = warp + 4 * (ub * 7 + it7);
        const int grp = u >> 3;
        const int j = (u & 7) * 8 + (lane >> 3), q = grp * 8 + (lane & 7);
        const int row = row0 + j;
        const int col = q < 24 ? (q >> 3) * 512 + head * 64 + (q & 7) * 8 : 1536 + (q - 24) * 8;
        float cur[8], pr[8], nx[8], o[8];
        unpack8(make_uint4(lc[it7][0], lc[it7][1], lc[it7][2], lc[it7][3]), cur);
        unpack8(make_uint4(lp[it7][0], lp[it7][1], lp[it7][2], lp[it7][3]), pr);
        unpack8(make_uint4(ln[it7][0], ln[it7][1], ln[it7][2], ln[it7][3]), nx);
        {
          float4 c0 = *(const float4*)(cw + col), c1 = *(const float4*)(cw + col + 4);
          float4 d0 = *(const float4*)(cw + 1792 + col), d1 = *(const float4*)(cw + 1792 + col + 4);
          float4 e0 = *(const float4*)(cw + 3584 + col), e1 = *(const float4*)(cw + 3584 + col + 4);
          float wp[8] = {c0.x, c0.y, c0.z, c0.w, c1.x, c1.y, c1.z, c1.w};
          float wc[8] = {d0.x, d0.y, d0.z, d0.w, d1.x, d1.y, d1.z, d1.w};
          float wn_[8] = {e0.x, e0.y, e0.z, e0.w, e1.x, e1.y, e1.z, e1.w};
#pragma unroll
          for (int e = 0; e < 8; ++e) o[e] = wc[e] * cur[e] + wp[e] * pr[e] + wn_[e] * nx[e];
        }
        if (grp == 0) {
#pragma unroll
          for (int e = 0; e < 8; ++e) rs[j][(q & 7) * 8 + e] = o[e];
        } else if (grp == 1) {
#pragma unroll
          for (int e = 0; e < 8; ++e) ks[j][(q & 7) * 8 + e] = o[e];
        } else if (grp == 2) {
          *(uint4*)(SV + ((size_t)row * 8 + head) * SVH + 2 * 64 + (q & 7) * 8) = pack8(o);
        } else if (grp == 3) {
#pragma unroll
          for (int e = 0; e < 8; ++e) o[e] = 1.f - 2.f / (1.f + __expf(2.f * o[e]));
          *(uint4*)&TW[j][(q - 24) * 8] = pack8(o);
        } else if (grp == 4) {
          *(uint4*)&TA[j][(q - 32) * 8] = pack8(o);
        } else {
#pragma unroll
          for (int e = 0; e < 8; ++e) o[e] = sigm(o[e]);
          *(uint4*)&TG[j][(q - 40) * 8] = pack8(o);
        }
      }
    }
    __syncthreads();
    {
      int j = tid >> 2, part = tid & 3; float ss = 0.f;
#pragma unroll
      for (int e = 0; e < 16; ++e) { float v = ks[j][part * 16 + e] * p.in[I_RKK][head * 64 + part * 16 + e]; ss += v * v; }
      ss += __shfl_xor(ss, 1); ss += __shfl_xor(ss, 2);
      if (part == 0) rn[j] = 1.f / fmaxf(sqrtf(ss), 1e-12f);
    }
    __syncthreads();
    for (int pc = tid; pc < 64 * 8; pc += 256) {
      int j = pc >> 3, c8 = (pc & 7) * 8; int row = row0 + j;
      float fr[8], fk[8], fkk[8];
#pragma unroll
      for (int e = 0; e < 8; ++e) { fr[e] = rs[j][c8 + e]; fk[e] = ks[j][c8 + e]; fkk[e] = fk[e] * p.in[I_RKK][head * 64 + c8 + e] * rn[j]; }
      bf16_t* b = SV + ((size_t)row * 8 + head) * SVH;
      *(uint4*)(b + 0 * 64 + c8) = pack8(fr);
      *(uint4*)(b + 1 * 64 + c8) = pack8(fk);
      *(uint4*)(b + 3 * 64 + c8) = pack8(fkk);
    }
    {
      const int jl = warp * 16 + (lane & 15); const int row = row0 + jl;
      bf16x8 tw[2], ta[2], tg[4];
#pragma unroll
      for (int s2 = 0; s2 < 2; ++s2) { tw[s2] = *(const bf16x8*)&TW[jl][s2 * 32 + (lane >> 4) * 8]; ta[s2] = *(const bf16x8*)&TA[jl][s2 * 32 + (lane >> 4) * 8]; }
#pragma unroll
      for (int s2 = 0; s2 < 4; ++s2) tg[s2] = *(const bf16x8*)&TG[jl][s2 * 32 + (lane >> 4) * 8];
      __syncthreads();
      bf16_t(*OB)[64][72] = (bf16_t(*)[64][72])(smem + 2 * 64 * 65 * 4);
      float bon[2] = {0.f, 0.f};
#pragma unroll
      for (int dir = 0; dir < 2; ++dir) {
#pragma unroll
        for (int ct = 0; ct < 4; ++ct) {
          const int ch0 = ct * 16 + (lane >> 4) * 4;
          const int C0 = head * 64 + ch0;
          if (dir == 0) {
            f32x4 a = {0.f, 0.f, 0.f, 0.f};
#pragma unroll
            for (int s2 = 0; s2 < 4; ++s2) {
              bf16x8 wf = *(const bf16x8*)(GUP + (size_t)(head * 64 + ct * 16 + (lane & 15)) * 128 + s2 * 32 + (lane >> 4) * 8);
              a = __builtin_amdgcn_mfma_f32_16x16x32_bf16(wf, tg[s2], a, 0, 0, 0);
            }
            *(uint2*)&OB[2][jl][ch0] = make_uint2(pack2(a[0], a[1]), pack2(a[2], a[3]));
          }
          f32x4 aw = {0.f, 0.f, 0.f, 0.f}, aa = {0.f, 0.f, 0.f, 0.f};
#pragma unroll
          for (int s2 = 0; s2 < 2; ++s2) {
            size_t wo = (size_t)(dir * 512 + head * 64 + ct * 16 + (lane & 15)) * 64 + s2 * 32 + (lane >> 4) * 8;
            bf16x8 wf = *(const bf16x8*)(WUP + wo);
            bf16x8 af = *(const bf16x8*)(AUP + wo);
            aw = __builtin_amdgcn_mfma_f32_16x16x32_bf16(wf, tw[s2], aw, 0, 0, 0);
            aa = __builtin_amdgcn_mfma_f32_16x16x32_bf16(af, ta[s2], aa, 0, 0, 0);
          }
          const float4 w04 = *(const float4*)(p.in[I_RW0] + dir * 512 + C0), a04 = *(const float4*)(p.in[I_RA0] + dir * 512 + C0);
          const float4 ka4 = *(const float4*)(p.in[I_RKA] + C0), rk4 = *(const float4*)(p.in[I_RRK] + C0);
          const float w0v[4] = {w04.x, w04.y, w04.z, w04.w}, a0v[4] = {a04.x, a04.y, a04.z, a04.w};
          const float kav[4] = {ka4.x, ka4.y, ka4.z, ka4.w}, rkv[4] = {rk4.x, rk4.y, rk4.z, rk4.w};
          float we[4], av[4];
#pragma unroll
          for (int r = 0; r < 4; ++r) {
            we[r] = (0.60653066f * 1.44269504f) * sigm(w0v[r] + aw[r]);
            av[r] = sigm(a0v[r] + aa[r]);
            float kv = ks[jl][ch0 + r];
            float keff = kv * (1.f + (av[r] - 1.f) * kav[r]);
            bon[dir] += rs[jl][ch0 + r] * keff * rkv[r];
          }
          *(uint2*)&OB[0][jl][ch0] = make_uint2(pack2(we[0], we[1]), pack2(we[2], we[3]));
          *(uint2*)&OB[1][jl][ch0] = make_uint2(pack2(av[0], av[1]), pack2(av[2], av[3]));
        }
        __syncthreads();
        for (int pc = tid; pc < (dir == 0 ? 3 : 2) * 64 * 8; pc += 256) {
          const int vsel = pc >> 9, j = (pc >> 3) & 63, c8 = (pc & 7) * 8;
          const int vec = vsel == 2 ? 8 : (4 + 2 * dir + vsel);
          *(u32x4*)(SV + ((size_t)(row0 + j) * 8 + head) * SVH + vec * 64 + c8) = *(const u32x4*)&OB[vsel][j][c8];
        }
        __syncthreads();
      }
#pragma unroll
      for (int dir = 0; dir < 2; ++dir) {
        float sb = bon[dir]; sb += __shfl_xor(sb, 16); sb += __shfl_xor(sb, 32);
        if (lane < 16) bonus[(size_t)row * 16 + dir * 8 + head] = sb;
      }
    }
    __syncthreads();
  }
}

struct RwVec { uint4 k, kk, w, a, v, r; };
DEVI void unpack8p(const uint4& u, f32x2* f) {
  f[0] = f32x2{bflo(u.x), bfhi(u.x)}; f[1] = f32x2{bflo(u.y), bfhi(u.y)}; f[2] = f32x2{bflo(u.z), bfhi(u.z)}; f[3] = f32x2{bflo(u.w), bfhi(u.w)};
}
DEVI f32x2 bc2(float x) { return f32x2{x, x}; }
DEVI void rw_load(RwVec& x, const bf16_t* SV, int row, int head, int dir, int i, int jg, bool need_r) {
  const bf16_t* b = SV + ((size_t)row * 8 + head) * SVH;
  x.k = *(const uint4*)(b + 1 * 64 + jg * 8);
  x.kk = *(const uint4*)(b + 3 * 64 + jg * 8);
  x.w = *(const uint4*)(b + (4 + 2 * dir) * 64 + jg * 8);
  x.a = *(const uint4*)(b + (5 + 2 * dir) * 64 + jg * 8);
  x.v = *(const uint4*)(b + 2 * 64 + i * 8);
  if (need_r) x.r = *(const uint4*)(b + 0 * 64 + jg * 8);
}

DEVI void phase7(const Params& p) {
  const int lane = threadIdx.x & 63, warp = threadIdx.x >> 6, i = lane >> 3, jg = lane & 7;
  const bf16_t* SV = (const bf16_t*)(p.ws + R_SV);
  float* Pc = (float*)p.out;
  float* Bc = (float*)((unsigned char*)p.out + OUT_BC);
  for (int it = blockIdx.x * 4 + warp; it < (NCH - 1) * 16; it += gridDim.x * 4) {
    const int chunk = it >> 4, pair = it & 15, dir = pair >> 3, head = pair & 7;
    f32x2 S[8][4], P[8][4], ka[4];
#pragma unroll
    for (int a = 0; a < 8; ++a)
#pragma unroll
      for (int c = 0; c < 4; ++c) {
        S[a][c] = f32x2{0.f, 0.f};
        P[a][c] = f32x2{(i * 8 + a == jg * 8 + 2 * c) ? 1.f : 0.f, (i * 8 + a == jg * 8 + 2 * c + 1) ? 1.f : 0.f};
      }
#pragma unroll
    for (int c = 0; c < 4; ++c) ka[c] = f32x2{p.in[I_RKA][head * 64 + jg * 8 + 2 * c], p.in[I_RKA][head * 64 + jg * 8 + 2 * c + 1]};
    RwVec nx;
    rw_load(nx, SV, rw_row(chunk * LCH, dir), head, dir, i, jg, false);
#pragma unroll 1
    for (int t = 0; t < LCH; ++t) {
      RwVec cu = nx;
      if (t + 1 < LCH) rw_load(nx, SV, rw_row(chunk * LCH + t + 1, dir), head, dir, i, jg, false);
      f32x2 kv[4], kk[4], w[4], av[4], kka[4], keff[4]; float vv[8];
      unpack8p(cu.k, kv); unpack8p(cu.kk, kk); unpack8p(cu.w, w); unpack8p(cu.a, av); unpack8(cu.v, vv);
#pragma unroll
      for (int c = 0; c < 4; ++c) {
        w[c] = f32x2{__builtin_amdgcn_exp2f(-w[c][0]), __builtin_amdgcn_exp2f(-w[c][1])};
        kka[c] = -kk[c] * av[c];
        keff[c] = kv[c] * (bc2(1.f) + (av[c] - bc2(1.f)) * ka[c]);
      }
#pragma unroll
      for (int a = 0; a < 8; ++a) {
        f32x2 sa = S[a][0] * kk[0], qa = P[a][0] * kk[0];
#pragma unroll
        for (int c = 1; c < 4; ++c) { sa += S[a][c] * kk[c]; qa += P[a][c] * kk[c]; }
        float s1 = allred8(sa[0] + sa[1]), q1 = allred8(qa[0] + qa[1]);
        const f32x2 s2 = bc2(s1), q2 = bc2(q1), v2 = bc2(vv[a]);
#pragma unroll
        for (int c = 0; c < 4; ++c) {
          S[a][c] = S[a][c] * w[c] + s2 * kka[c] + v2 * keff[c];
          P[a][c] = P[a][c] * w[c] + q2 * kka[c];
        }
      }
    }
    float* po = Pc + ((size_t)chunk * 16 + pair) * 4096;
    float* bo = Bc + ((size_t)chunk * 16 + pair) * 4096;
#pragma unroll
    for (int a = 0; a < 8; ++a) {
      *(float4*)(po + (i * 8 + a) * 64 + jg * 8) = make_float4(P[a][0][0], P[a][0][1], P[a][1][0], P[a][1][1]);
      *(float4*)(po + (i * 8 + a) * 64 + jg * 8 + 4) = make_float4(P[a][2][0], P[a][2][1], P[a][3][0], P[a][3][1]);
      *(float4*)(bo + (i * 8 + a) * 64 + jg * 8) = make_float4(S[a][0][0], S[a][0][1], S[a][1][0], S[a][1][1]);
      *(float4*)(bo + (i * 8 + a) * 64 + jg * 8 + 4) = make_float4(S[a][2][0], S[a][2][1], S[a][3][0], S[a][3][1]);
    }
  }
}

template <bool DRY> DEVI void phase8(const Params& p, unsigned char* smem) {
  const bool wr = !DRY || (p.in[I_FG][0] == 1234.5f);
  float(*Sb)[16][68] = (float(*)[16][68])smem;
  const int tid = threadIdx.x, lane = tid & 63, warp = tid >> 6, q = lane >> 4, c16 = lane & 15;
  const float* Pc = (const float*)p.out;
  float* Bc = (float*)((unsigned char*)p.out + OUT_BC);
  constexpr int NS = NCH - 1;
  const size_t CS = (size_t)16 * 4096;
  for (int it = blockIdx.x; it < 64; it += gridDim.x) {
    const int pair = it >> 2, rg = it & 3;
    const float* Pp = Pc + (size_t)pair * 4096 + q * 64 + warp * 16 + c16;
    float* Bp = Bc + (size_t)pair * 4096 + (size_t)(rg * 16 + q * 4) * 64 + warp * 16 + c16;
    __syncthreads();
    {
      const int row = tid >> 4, c4 = (tid & 15) * 4;
      float4 v = *(const float4*)(Bc + (size_t)pair * 4096 + (size_t)(rg * 16 + row) * 64 + c4);
      Sb[0][row][c4] = v.x; Sb[0][row][c4 + 1] = v.y; Sb[0][row][c4 + 2] = v.z; Sb[0][row][c4 + 3] = v.w;
    }
    float pa[16], pb[16]; f32x4 ba, bb;
#pragma unroll
    for (int s2 = 0; s2 < 16; ++s2) { pa[s2] = Pp[CS + s2 * 256]; pb[s2] = Pp[2 * CS + s2 * 256]; }
#pragma unroll
    for (int r = 0; r < 4; ++r) { ba[r] = Bp[CS + r * 64]; bb[r] = Bp[2 * CS + r * 64]; }
    __syncthreads();
#define P8_STEP(c, pp, bv)                                                                                  \
    {                                                                                                        \
      const int rb = ((c) - 1) & 1;                                                                          \
      f32x4 acc0 = bv, acc1 = f32x4{0.f, 0.f, 0.f, 0.f};                                                     \
      _Pragma("unroll") for (int s2 = 0; s2 < 16; s2 += 2) {                                                 \
        acc0 = __builtin_amdgcn_mfma_f32_16x16x4f32(Sb[rb][c16][4 * s2 + q], pp[s2], acc0, 0, 0, 0);         \
        acc1 = __builtin_amdgcn_mfma_f32_16x16x4f32(Sb[rb][c16][4 * s2 + 4 + q], pp[s2 + 1], acc1, 0, 0, 0); \
      }                                                                                                      \
      acc0 += acc1;                                                                                          \
      if ((c) + 2 < NS) {                                                                                    \
        _Pragma("unroll") for (int s2 = 0; s2 < 16; ++s2) pp[s2] = Pp[(size_t)((c) + 2) * CS + s2 * 256];    \
        _Pragma("unroll") for (int r = 0; r < 4; ++r) bv[r] = Bp[(size_t)((c) + 2) * CS + r * 64];           \
      }                                                                                                      \
      _Pragma("unroll") for (int r = 0; r < 4; ++r) {                                                        \
        Sb[rb ^ 1][q * 4 + r][warp * 16 + c16] = acc0[r];                                                    \
        if (wr) Bp[(size_t)(c) * CS + r * 64] = acc0[r];                                                     \
      }                                                                                                      \
      __syncthreads();                                                                                       \
    }
    for (int c = 1; c < NS; c += 2) {
      P8_STEP(c, pa, ba)
      if (c + 1 < NS) P8_STEP(c + 1, pb, bb)
    }
#undef P8_STEP
  }
}

DEVI void phase9(const Params& p) {
  const int lane = threadIdx.x & 63, warp = threadIdx.x >> 6, i = lane >> 3, jg = lane & 7;
  const bf16_t* SV = (const bf16_t*)(p.ws + R_SV);
  const float* Bc = (const float*)((unsigned char*)p.out + OUT_BC);
  bf16_t* odir = (bf16_t*)p.out;
  for (int it = blockIdx.x * 4 + warp; it < NCH * 16; it += gridDim.x * 4) {
    const int chunk = it >> 4, pair = it & 15, dir = pair >> 3, head = pair & 7;
    f32x2 S[8][4], ka[4];
    if (chunk == 0) {
#pragma unroll
      for (int a = 0; a < 8; ++a)
#pragma unroll
        for (int c = 0; c < 4; ++c) S[a][c] = f32x2{0.f, 0.f};
    } else {
      const float* bs = Bc + ((size_t)(chunk - 1) * 16 + pair) * 4096;
#pragma unroll
      for (int a = 0; a < 8; ++a) {
        float4 x0 = *(const float4*)(bs + (i * 8 + a) * 64 + jg * 8), x1 = *(const float4*)(bs + (i * 8 + a) * 64 + jg * 8 + 4);
        S[a][0] = f32x2{x0.x, x0.y}; S[a][1] = f32x2{x0.z, x0.w}; S[a][2] = f32x2{x1.x, x1.y}; S[a][3] = f32x2{x1.z, x1.w};
      }
    }
#pragma unroll
    for (int c = 0; c < 4; ++c) ka[c] = f32x2{p.in[I_RKA][head * 64 + jg * 8 + 2 * c], p.in[I_RKA][head * 64 + jg * 8 + 2 * c + 1]};
    RwVec nx;
    rw_load(nx, SV, rw_row(chunk * LCH, dir), head, dir, i, jg, true);
#pragma unroll 1
    for (int t = 0; t < LCH; ++t) {
      RwVec cu = nx;
      const int row = rw_row(chunk * LCH + t, dir);
      if (t + 1 < LCH) rw_load(nx, SV, rw_row(chunk * LCH + t + 1, dir), head, dir, i, jg, true);
      f32x2 kv[4], kk[4], w[4], av[4], rr[4], kka[4], keff[4]; float vv[8];
      unpack8p(cu.k, kv); unpack8p(cu.kk, kk); unpack8p(cu.w, w); unpack8p(cu.a, av); unpack8p(cu.r, rr); unpack8(cu.v, vv);
#pragma unroll
      for (int c = 0; c < 4; ++c) {
        w[c] = f32x2{__builtin_amdgcn_exp2f(-w[c][0]), __builtin_amdgcn_exp2f(-w[c][1])};
        kka[c] = -kk[c] * av[c];
        keff[c] = kv[c] * (bc2(1.f) + (av[c] - bc2(1.f)) * ka[c]);
      }
      float ov = 0.f;
#pragma unroll
      for (int a = 0; a < 8; ++a) {
        f32x2 sa = S[a][0] * kk[0];
#pragma unroll
        for (int c = 1; c < 4; ++c) sa += S[a][c] * kk[c];
        const float s1 = allred8(sa[0] + sa[1]);
        const f32x2 s2 = bc2(s1), v2 = bc2(vv[a]);
        f32x2 oa = f32x2{0.f, 0.f};
#pragma unroll
        for (int c = 0; c < 4; ++c) {
          S[a][c] = S[a][c] * w[c] + s2 * kka[c] + v2 * keff[c];
          oa += S[a][c] * rr[c];
        }
        const float o = allred8(oa[0] + oa[1]);
        if (jg == a) ov = o;
      }
      if (row >= T_CTX) odir[((size_t)dir * T_LAT + (row - T_CTX)) * 512 + head * 64 + i * 8 + jg] = f2bf(ov);
    }
  }
}

DEVI void phase10(const Params& p) {
  const int lane = threadIdx.x & 63, warp = threadIdx.x >> 6;
  const bf16_t* odir = (const bf16_t*)p.out;
  const bf16_t* SV = (const bf16_t*)(p.ws + R_SV);
  const float* bonus = (const float*)(p.ws + O_BONUS);
  bf16_t* ya = (bf16_t*)(p.ws + O_PO);
  const int head = lane >> 3, c8 = (lane & 7) * 8, C0 = lane * 8;
#pragma unroll 2
  for (int t = blockIdx.x * 4 + warp; t < T_LAT; t += gridDim.x * 4) {
    const int row = t + T_CTX;
    const bf16_t* b = SV + ((size_t)row * 8 + head) * SVH;
    float v[8], g[8], y[8];
    unpack8(*(const uint4*)(b + 2 * 64 + c8), v);
    unpack8(*(const uint4*)(b + 8 * 64 + c8), g);
    float bs = bonus[(size_t)row * 16 + head] + bonus[(size_t)row * 16 + 8 + head];
#pragma unroll
    for (int e = 0; e < 8; ++e) y[e] = bs * v[e];
#pragma unroll
    for (int dir = 0; dir < 2; ++dir) {
      float o[8];
      unpack8(*(const uint4*)(odir + ((size_t)dir * T_LAT + t) * 512 + C0), o);
      float s = 0.f;
#pragma unroll
      for (int e = 0; e < 8; ++e) s += o[e];
      s = allred8(s);
      float mu = s * (1.f / 64.f);
      float q = 0.f;
#pragma unroll
      for (int e = 0; e < 8; ++e) { o[e] -= mu; q += o[e] * o[e]; }
      q = allred8(q);
      float rsd = rsqrtf(q * (1.f / 64.f) + 64e-5f);
#pragma unroll
      for (int e = 0; e < 8; ++e) y[e] += o[e] * rsd * p.in[I_RLNW][C0 + e] + p.in[I_RLNB][C0 + e];
    }
#pragma unroll
    for (int e = 0; e < 8; ++e) y[e] *= g[e];
    *(uint4*)(ya + (size_t)t * 512 + C0) = pack8(y);
  }
}

DEVI void phase11(const Params& p, unsigned char* smem, const XcdMap& xm) {
  const int lane = threadIdx.x & 63, warp = threadIdx.x >> 6, wm = warp >> 1, wn = warp & 1;
  const bf16_t* ya = (const bf16_t*)(p.ws + O_PO);
  const bf16_t* yb = (const bf16_t*)(p.ws + R_YA);
  const bf16_t* pg = (const bf16_t*)(p.ws + O_PG);
  bf16_t* mg = (bf16_t*)(p.ws + R_MERGED);
  for_tiles_xcd(xm, 128, 8, 8, 8, [&](int mt, int nt) {
    f32x4 acc[4][4];
    zero_acc(acc);
    gemm_core(ya + (size_t)mt * 128 * 512, 512, (const bf16_t*)(p.ws + O_WBA) + (size_t)nt * 128 * 512, 512, 512, acc, smem);
#pragma unroll
    for (int i = 0; i < 4; ++i) {
      int row = mt * 128 + wm * 64 + i * 16 + (lane & 15);
#pragma unroll
      for (int j = 0; j < 4; ++j) {
        int n = nt * 128 + wn * 64 + j * 16 + (lane >> 4) * 4;
        uint2 s = *(const uint2*)(pg + (size_t)row * 2048 + n);
        *(uint2*)(mg + (size_t)row * 1024 + n) = make_uint2(pack2(acc[i][j][0] * bflo(s.x), acc[i][j][1] * bfhi(s.x)), pack2(acc[i][j][2] * bflo(s.y), acc[i][j][3] * bfhi(s.y)));
      }
    }
    zero_acc(acc);
    gemm_core(yb + (size_t)mt * 128 * 512, 512, (const bf16_t*)(p.ws + O_WBB) + (size_t)nt * 128 * 512, 512, 512, acc, smem);
#pragma unroll
    for (int i = 0; i < 4; ++i) {
      int row = mt * 128 + wm * 64 + i * 16 + (lane & 15);
#pragma unroll
      for (int j = 0; j < 4; ++j) {
        int n = nt * 128 + wn * 64 + j * 16 + (lane >> 4) * 4;
        uint2 s = *(const uint2*)(pg + (size_t)row * 2048 + 1024 + n);
        uint2 m0 = *(const uint2*)(mg + (size_t)row * 1024 + n);
        float v0 = bflo(m0.x) + acc[i][j][0] * bflo(s.x), v1 = bfhi(m0.x) + acc[i][j][1] * bfhi(s.x);
        float v2 = bflo(m0.y) + acc[i][j][2] * bflo(s.y), v3 = bfhi(m0.y) + acc[i][j][3] * bfhi(s.y);
        *(uint2*)(mg + (size_t)row * 1024 + n) = make_uint2(pack2(v0, v1), pack2(v2, v3));
      }
    }
  });
}

DEVI void phase12(const Params& p, unsigned char* smem, const XcdMap& xm) {
  float* gt = (float*)(smem + 45056);
  const int tid = threadIdx.x, lane = tid & 63, warp = tid >> 6, wm = warp >> 1, wn = warp & 1;
  for (int i = tid; i < 1024; i += 256) gt[i] = mod_val(p, 0, 2048 + i);
  __syncthreads();
  const bf16_t* mg = (const bf16_t*)(p.ws + R_MERGED);
  const float* x = p.in[I_X];
  float* x1 = p.out;
  for_tiles_xcd(xm, 128, 8, 8, 8, [&](int mt, int nt) {
    f32x4 acc[4][4];
    zero_acc(acc);
    gemm_core(mg + (size_t)mt * 128 * 1024, 1024, (const bf16_t*)(p.ws + O_WOUT) + (size_t)nt * 128 * 1024, 1024, 1024, acc, smem);
#pragma unroll
    for (int i = 0; i < 4; ++i) {
      int row = mt * 128 + wm * 64 + i * 16 + (lane & 15);
#pragma unroll
      for (int j = 0; j < 4; ++j) {
        int n = nt * 128 + wn * 64 + j * 16 + (lane >> 4) * 4;
        float4 xv = *(const float4*)(x + (size_t)row * 1024 + n);
        xv.x += gt[n] * acc[i][j][0]; xv.y += gt[n + 1] * acc[i][j][1]; xv.z += gt[n + 2] * acc[i][j][2]; xv.w += gt[n + 3] * acc[i][j][3];
        *(float4*)(x1 + (size_t)row * 1024 + n) = xv;
      }
    }
  });
}

DEVI void phase13(const Params& p, unsigned char* smem) {
  float* smod = (float*)smem;
  const int tid = threadIdx.x, lane = tid & 63, warp = tid >> 6;
  for (int i = tid; i < 2048; i += 256) smod[i] = mod_val(p, 0, 3072 + i);
  __syncthreads();
  const float* x1 = p.out;
  bf16_t* h2 = (bf16_t*)(p.ws + R_H2);
  for (int rp = blockIdx.x * 4 + warp; rp < T_LAT / 2; rp += gridDim.x * 4) {
    float h[2][16]; float ss[2] = {0.f, 0.f};
#pragma unroll
    for (int u = 0; u < 2; ++u)
#pragma unroll
      for (int i = 0; i < 4; ++i) {
        float4 v = *(const float4*)(x1 + (size_t)(rp * 2 + u) * 1024 + i * 256 + lane * 4);
        h[u][4 * i] = v.x; h[u][4 * i + 1] = v.y; h[u][4 * i + 2] = v.z; h[u][4 * i + 3] = v.w;
        ss[u] += v.x * v.x + v.y * v.y + v.z * v.z + v.w * v.w;
      }
#pragma unroll
    for (int u = 0; u < 2; ++u) {
      const int row = rp * 2 + u;
      const float rstd = rsqrtf(wave_sum_u(ss[u]) * (1.f / 1024.f) + 1e-6f);
#pragma unroll
      for (int i = 0; i < 4; ++i) {
#pragma unroll
        for (int e = 0; e < 4; ++e) {
          int k = i * 256 + lane * 4 + e;
          float y = h[u][4 * i + e] * rstd * p.in[I_N2G][k];
          h[u][4 * i + e] = y * (1.f + smod[1024 + k]) + smod[k];
        }
        *(uint2*)(h2 + (size_t)row * 1024 + i * 256 + lane * 4) = make_uint2(pack2(h[u][4 * i], h[u][4 * i + 1]), pack2(h[u][4 * i + 2], h[u][4 * i + 3]));
      }
    }
  }
}

DEVI void phase14(const Params& p, unsigned char* smem, const XcdMap& xm) {
  bf16_t(*Qt)[136] = (bf16_t(*)[136])smem;
  float* Sc = (float*)smem;
  const int tid = threadIdx.x, lane = tid & 63, warp = tid >> 6, wm = warp >> 1, wn = warp & 1;
  const bf16_t* h2 = (const bf16_t*)(p.ws + R_H2);
  const bf16_t* keys = (const bf16_t*)(p.ws + O_KEYS);
  float* tops = (float*)(p.ws + R_TOPS);
  int* topi = (int*)(p.ws + R_TOPI);
  for_tiles_xcd(xm, 128, 16, 8, 8, [&](int mt, int hp) {
    f32x4 acc[4][4];
    zero_acc(acc);
    gemm_core(h2 + (size_t)mt * 128 * 1024, 1024, (const bf16_t*)(p.ws + O_WQ) + (size_t)hp * 128 * 1024, 1024, 1024, acc, smem);
#pragma unroll
    for (int i = 0; i < 4; ++i)
#pragma unroll
      for (int j = 0; j < 4; ++j)
        *(uint2*)&Qt[wm * 64 + i * 16 + (lane & 15)][wn * 64 + j * 16 + (lane >> 4) * 4] =
            make_uint2(pack2(acc[i][j][0], acc[i][j][1]), pack2(acc[i][j][2], acc[i][j][3]));
    __syncthreads();
    zero_acc(acc);
#pragma unroll
    for (int ks = 0; ks < 4; ++ks) {
      bf16x8 qf[4], kf[4];
#pragma unroll
      for (int i = 0; i < 4; ++i) qf[i] = *(const bf16x8*)&Qt[wm * 64 + i * 16 + (lane & 15)][ks * 32 + (lane >> 4) * 8];
#pragma unroll
      for (int j = 0; j < 4; ++j) kf[j] = *(const bf16x8*)(keys + ((size_t)hp * 128 + wn * 64 + j * 16 + (lane & 15)) * 128 + ks * 32 + (lane >> 4) * 8);
#pragma unroll
      for (int i = 0; i < 4; ++i)
#pragma unroll
        for (int j = 0; j < 4; ++j) acc[i][j] = __builtin_amdgcn_mfma_f32_16x16x32_bf16(kf[j], qf[i], acc[i][j], 0, 0, 0);
    }
    __syncthreads();
#pragma unroll
    for (int i = 0; i < 4; ++i)
#pragma unroll
      for (int j = 0; j < 4; ++j) {
        float* d = Sc + (wm * 64 + i * 16 + (lane & 15)) * 129 + wn * 64 + j * 16 + (lane >> 4) * 4;
        d[0] = acc[i][j][0]; d[1] = acc[i][j][1]; d[2] = acc[i][j][2]; d[3] = acc[i][j][3];
      }
    __syncthreads();
    {
      const int row = tid & 127, half = tid >> 7;
      float* hp_ = Sc + row * 129 + half * 64;
      float bv[16]; int bi[16];
#pragma unroll
      for (int r = 0; r < 16; ++r) {
        float best = -INFINITY; int b2 = 0;
#pragma unroll 8
        for (int k = 0; k < 64; ++k) { float v = hp_[k]; if (v > best) { best = v; b2 = k; } }
        bv[r] = best; bi[r] = b2 + half * 64; hp_[b2] = -INFINITY;
      }
#pragma unroll
      for (int r = 0; r < 16; ++r) { hp_[r] = bv[r]; hp_[16 + r] = __int_as_float(bi[r]); }
    }
    __syncthreads();
    if (tid < 128) {
      const float* la = Sc + tid * 129; const float* lb = la + 64;
      size_t ob = ((size_t)(mt * 128 + tid) * 16 + hp) * 16;
      int ia = 0, ib = 0;
      for (int r = 0; r < 16; ++r) {
        float va = la[ia], vb = lb[ib];
        bool ta = va >= vb;
        tops[ob + r] = ta ? va : vb;
        topi[ob + r] = __float_as_int(ta ? la[16 + ia] : lb[16 + ib]);
        ia += ta ? 1 : 0; ib += ta ? 0 : 1;
      }
    }
    __syncthreads();
  });
}

template <bool DRY> DEVI void phase15(const Params& p, unsigned char* smem) {
  const bool wr = !DRY || (p.in[I_FG][0] == 1234.5f);
  float* gt = (float*)smem;
  const int tid = threadIdx.x, lane = tid & 63, warp = tid >> 6;
  for (int i = tid; i < 1024; i += 256) gt[i] = mod_val(p, 0, 5120 + i);
  __syncthreads();
  const bf16_t* __restrict__ h2 = (const bf16_t*)(p.ws + R_H2);
  const float* __restrict__ tops = (const float*)(p.ws + R_TOPS);
  const int* __restrict__ topi = (const int*)(p.ws + R_TOPI);
  const unsigned char* __restrict__ uf8 = p.ws + R_UBF;
  const unsigned char* __restrict__ vf8 = p.ws + R_VBF;
  float* xo = p.out;
  int ca, cb;
  {
    int l = lane;
    if (l < 16) { ca = 0; cb = l; } else if (l < 24) { ca = 1; cb = l - 16; } else if (l < 29) { ca = 2; cb = l - 24; }
    else if (l < 33) { ca = 3; cb = l - 29; } else if (l < 36) { ca = 4; cb = l - 33; } else if (l < 38) { ca = 5; cb = l - 36; }
    else if (l < 40) { ca = 6; cb = l - 38; } else if (l < 42) { ca = 7; cb = l - 40; } else if (l < 50) { ca = l - 34; cb = 0; }
    else { ca = 0; cb = 0; }
  }
  const int flat = ca * 16 + cb;
  for (int t = blockIdx.x * 4 + warp; t < T_LAT; t += gridDim.x * 4) {
    float hv[16], out[16];
    {
      const u32x4 hp0 = *(const u32x4*)(h2 + (size_t)t * 1024 + lane * 16);
      const u32x4 hp1 = *(const u32x4*)(h2 + (size_t)t * 1024 + lane * 16 + 8);
#pragma unroll
      for (int e = 0; e < 4; ++e) { hv[2 * e] = bflo(hp0[e]); hv[2 * e + 1] = bfhi(hp0[e]); hv[8 + 2 * e] = bflo(hp1[e]); hv[8 + 2 * e + 1] = bfhi(hp1[e]); }
    }
#pragma unroll
    for (int e = 0; e < 16; ++e) out[e] = 0.f;
#pragma unroll 1
    for (int hd = 0; hd < 8; ++hd) {
      const size_t b1 = ((size_t)t * 16 + hd * 2) * 16, b2 = b1 + 16;
      float val = lane < 50 ? tops[b1 + ca] + tops[b2 + cb] : -INFINITY;
      int idx = topi[b1 + ca] * 128 + topi[b2 + cb];
      int cnt = 0;
#pragma unroll
      for (int i = 0; i < 50; ++i) {
        float vi = rlf(val, i);
        int fi = __builtin_amdgcn_readlane(flat, i);
        cnt += ((vi > val) || (vi == val && fi < flat)) ? 1 : 0;
      }
      bool sel = lane < 50 && cnt < 16;
      float vmax = rlf(val, 0);
      float ex = sel ? __expf(val - vmax) : 0.f;
      float gsum = wave_sum_u(ex);
      float g = ex / gsum;
      unsigned long long m1 = __ballot(sel);
      int es[16];
      float gq = 0.f;
#pragma unroll
      for (int q = 0; q < 16; ++q) {
        int src = __ffsll((long long)m1) - 1; m1 &= m1 - 1;
        es[q] = __builtin_amdgcn_readlane(idx, src);
        float gg = rlf(g, src);
        if (lane == q) gq = gg;
      }
      float dm = 0.f;
      {
        u32x4 ub[16];
#pragma unroll
        for (int q = 0; q < 16; ++q) ub[q] = *(const u32x4*)(uf8 + (size_t)es[q] * 1024 + lane * 16);
#pragma unroll
        for (int q = 0; q < 16; ++q) {
          float f[16]; unpack_fp8x16(ub[q], f);
          float d0 = 0.f, d1 = 0.f;
#pragma unroll
          for (int e = 0; e < 8; ++e) { d0 += f[2 * e] * hv[2 * e]; d1 += f[2 * e + 1] * hv[2 * e + 1]; }
          float d = wave_sum_u(d0 + d1);
          if (lane == q) dm = d;
        }
      }
      dm *= (1.f / 64.f);
      float coef = gq * 0.5f * dm * (1.f + erff(dm * 0.70710678118f)) * 0.25f;
      {
        u32x4 vb[16];
#pragma unroll
        for (int q = 0; q < 16; ++q) vb[q] = *(const u32x4*)(vf8 + (size_t)es[q] * 1024 + lane * 16);
#pragma unroll
        for (int q = 0; q < 16; ++q) {
          float cf = rlf(coef, q);
          float f[16]; unpack_fp8x16(vb[q], f);
#pragma unroll
          for (int e = 0; e < 16; ++e) out[e] += cf * f[e];
        }
      }
    }
    float xs[16]; float ss = 0.f;
#pragma unroll
    for (int i = 0; i < 4; ++i) {
      int k = lane * 16 + i * 4;
      float4 v = *(const float4*)(xo + (size_t)t * 1024 + k);
      xs[4 * i] = v.x + gt[k] * out[4 * i]; xs[4 * i + 1] = v.y + gt[k + 1] * out[4 * i + 1];
      xs[4 * i + 2] = v.z + gt[k + 2] * out[4 * i + 2]; xs[4 * i + 3] = v.w + gt[k + 3] * out[4 * i + 3];
      ss += xs[4 * i] * xs[4 * i] + xs[4 * i + 1] * xs[4 * i + 1] + xs[4 * i + 2] * xs[4 * i + 2] + xs[4 * i + 3] * xs[4 * i + 3];
    }
    ss = wave_sum_u(ss);
    float rstd = rsqrtf(ss * (1.f / 1024.f) + 1e-6f);
#pragma unroll
    for (int i = 0; i < 4; ++i) {
      int k = lane * 16 + i * 4;
      float4 g4 = *(const float4*)(p.in[I_FG] + k);
      if (wr) *(float4*)(xo + (size_t)t * 1024 + k) = make_float4(xs[4 * i] * rstd * g4.x, xs[4 * i + 1] * rstd * g4.y, xs[4 * i + 2] * rstd * g4.z, xs[4 * i + 3] * rstd * g4.w);
    }
  }
}

#define XB_TMO      128
#define XB_XCNT(j)  (256  + 64 * (j))
#define XB_XSUB(j)  (1280 + 64 * (j))
#define XB_XGEN(j)  (2304 + 64 * (j))
#define XB_TOP      3328
#define XB_TOPGEN   3392
#define XCD_BAR_WORDS 3456
#define XB_SPIN_CAP (1u << 22)
#define LAS __attribute__((address_space(3)))
DEVI unsigned xb_ld(unsigned* p) { return __hip_atomic_load(p, __ATOMIC_RELAXED, __HIP_MEMORY_SCOPE_AGENT); }
DEVI unsigned xb_add(unsigned* p, unsigned v) { return __hip_atomic_fetch_add(p, v, __ATOMIC_RELAXED, __HIP_MEMORY_SCOPE_AGENT); }
DEVI unsigned xb_xcc_id() { return (unsigned)__builtin_amdgcn_s_getreg((3 << 11) | 20) & 0xFu; }
#define XB_SPIN(cond, bar) do { unsigned _sp = 0; while (cond) { __builtin_amdgcn_s_sleep(1); \
    if ((++_sp & 255u) == 0u) { if (xb_ld(&(bar)[XB_TMO])) break; if (_sp > XB_SPIN_CAP) { atomicAdd(&(bar)[XB_TMO], 1u); break; } } } } while (0)
struct XcdBarrier { unsigned* bar; unsigned x; volatile LAS unsigned* st; };
DEVI XcdBarrier xcd_barrier_post(unsigned* bar, volatile LAS unsigned* st) {
  XcdBarrier b; b.bar = bar; b.x = xb_xcc_id(); b.st = st;
  if (threadIdx.x == 0) st[2] = xb_add(&bar[XB_XCNT(b.x)], 1u);
  return b;
}
DEVI void xcd_barrier_complete(unsigned* bar, unsigned x, unsigned& nloc, unsigned& nx, unsigned& vidx) {
  const unsigned G = gridDim.x * gridDim.y * gridDim.z;
  unsigned sum, cnt, mine, below, sp = 0u;
  for (;;) {
    sum = 0u; cnt = 0u; mine = 0u; below = 0u;
#pragma unroll
    for (unsigned j = 0; j < 16; ++j) { const unsigned c = xb_ld(&bar[XB_XCNT(j)]); sum += c; cnt += (c > 0u) ? 1u : 0u; mine = (j == x) ? c : mine; below += (c > 0u && j < x) ? 1u : 0u; }
    if (sum == G) break;
    __builtin_amdgcn_s_sleep(1);
    if ((++sp & 255u) == 0u) { if (xb_ld(&bar[XB_TMO])) break; if (sp > XB_SPIN_CAP) { atomicAdd(&bar[XB_TMO], 1u); break; } }
  }
  nloc = mine > 0u ? mine : 1u; nx = cnt > 0u ? cnt : 1u; vidx = below;
}
DEVI void xcd_barrier(const XcdBarrier& b) {
  asm volatile("s_waitcnt vmcnt(0)" ::: "memory");
  __syncthreads();
  if (threadIdx.x == 0) {
    unsigned* bar = b.bar;
    __builtin_amdgcn_s_waitcnt(0);
    unsigned nloc = b.st[0], nx = b.st[1];
    if (nloc == 0u) { unsigned vidx; xcd_barrier_complete(bar, b.x, nloc, nx, vidx); b.st[0] = nloc; b.st[1] = nx; b.st[3] = vidx; }
    const unsigned old = xb_add(&bar[XB_XSUB(b.x)], 1u);
    const unsigned gen = old / nloc;
    if (old + 1u == (gen + 1u) * nloc) {
      __builtin_amdgcn_fence(__ATOMIC_RELEASE, "agent");
      asm volatile("s_waitcnt vmcnt(0)" ::: "memory");
      const unsigned og = xb_add(&bar[XB_TOP], 1u);
      const unsigned tg = og / nx;
      if (og + 1u == (tg + 1u) * nx) xb_add(&bar[XB_TOPGEN], 1u);
      else XB_SPIN(xb_ld(&bar[XB_TOPGEN]) == tg, bar);
      __builtin_amdgcn_fence(__ATOMIC_ACQUIRE, "agent");
      xb_add(&bar[XB_XGEN(b.x)], 1u);
      asm volatile("s_waitcnt vmcnt(0)" ::: "memory");
    } else {
      XB_SPIN(xb_ld(&bar[XB_XGEN(b.x)]) == gen, bar);
      __builtin_amdgcn_fence(__ATOMIC_ACQUIRE, "agent");
      asm volatile("s_waitcnt vmcnt(0)" ::: "memory");
    }
  }
  __syncthreads();
}

constexpr int NPHASE = 16;
DEVI XcdMap get_xm(int coop, const uint4& w) {
  XcdMap m;
  if (coop) { m.v = (int)w.w; m.nx = (int)w.y; m.slot = (int)w.z; m.slots = (int)w.x; }
  else { m.v = blockIdx.x & 7; m.nx = 8; m.slot = blockIdx.x >> 3; m.slots = gridDim.x >> 3; if (m.slots < 1) { m.slots = 1; } }
  return m;
}
__global__ void __launch_bounds__(256, 2) mk(Params p, int ph0, int ph1, int coop) {
  __shared__ __attribute__((aligned(16))) unsigned char smem[SMEM_BYTES];
  __shared__ uint4 xb_words;
  if (threadIdx.x == 0) xb_words = make_uint4(0u, 0u, 0u, 0u);
  __syncthreads();
  XcdBarrier xb;
  if (coop) xb = xcd_barrier_post((unsigned*)(p.ws + O_BAR), (volatile LAS unsigned*)&xb_words);
#ifdef XCC_PROBE
  if (coop && xb_xcc_id() != (blockIdx.x & 7u)) { unsigned long long t0 = wall_clock64(); while (wall_clock64() - t0 < 100000ull) __builtin_amdgcn_s_sleep(8); }
#endif
  if (ph0 < 0) cg::this_grid().sync();
#ifdef PROBE_A
#define STAMP(n) if (blockIdx.x == 0 && threadIdx.x == 0) ((unsigned long long*)(p.ws + O_STAMP))[n] = wall_clock64();
#else
#define STAMP(n)
#endif
#define RUN_PHASE(n, call)                                   \
  if (ph0 <= n && n < ph1) {                                 \
    STAMP(n)                                                 \
        if (DRY_PH == n) { if (n == 4) phase4<true>(p); if (n == 5) phase5<true>(p, smem); if (n == 8) phase8<true>(p, smem); if (n == 15) phase15<true>(p, smem); } \
    if (ONLY < 0 || ONLY == n) { call; }                     \
    if (REPEAT_PH == n) { call; }                            \
    if (coop && n + 1 < ph1) xcd_barrier(xb);                \
  }
  RUN_PHASE(0, phase0(p, smem, 0, 384))
  RUN_PHASE(1, (phase1(p, smem), __syncthreads(), phase0(p, smem, 384, 1 << 30)))
  RUN_PHASE(2, phase2(p, smem, get_xm(coop, xb_words)))
  RUN_PHASE(3, phase3(p, smem))
  RUN_PHASE(4, (phase4<false>(p), phase6(p, smem, 0, 32, gridDim.x > 290 ? 258 : 0, gridDim.x > 290 ? (int)gridDim.x - 258 : (int)gridDim.x)))
  RUN_PHASE(5, phase5<false>(p, smem))
  RUN_PHASE(6, phase6(p, smem, 32, 260 * 8, 0, (int)gridDim.x))
  RUN_PHASE(7, phase7(p))
  RUN_PHASE(8, phase8<false>(p, smem))
  RUN_PHASE(9, phase9(p))
  RUN_PHASE(10, phase10(p))
  RUN_PHASE(11, phase11(p, smem, get_xm(coop, xb_words)))
  RUN_PHASE(12, (phase12(p, smem, get_xm(coop, xb_words)), convert_fp8(p.in[I_PU], p.ws + R_UBF, (size_t)16384 * 64, 64.f)))
  RUN_PHASE(13, phase13(p, smem))
  RUN_PHASE(14, (phase14(p, smem, get_xm(coop, xb_words)), convert_fp8(p.in[I_PV], p.ws + R_VBF, (size_t)16384 * 64, 4.f)))
  RUN_PHASE(15, phase15<false>(p, smem))
#ifdef SYNC_EXTRA
  for (int i = 0; i < SYNC_EXTRA; ++i) xcd_barrier(xb);
#endif
#ifdef PROBE_A
  cg::this_grid().sync();
  STAMP(16)
  __syncthreads();
  if (blockIdx.x == 0) {
    const unsigned long long* st = (const unsigned long long*)(p.ws + O_STAMP);
    float ta = (float)(st[PROBE_A + 1] - st[PROBE_A]) * 0.01f, tb = (float)(st[PROBE_B + 1] - st[PROBE_B]) * 0.01f;
    for (int i = threadIdx.x; i < 1000000; i += 256) p.out[1 + i] = tb;
    if (threadIdx.x == 0) p.out[0] = 100.f * ta;
  }
#endif
}

extern "C" void kernel_launch(void* const* d_in, const int* in_sizes, int n_in, void* d_out, int out_size, void* d_ws,
                              size_t ws_size, hipStream_t stream) {
  static int grid_blocks = 0;
  if (!grid_blocks) {
    int dev = 0, cus = 0, per_cu = 0;
    hipGetDevice(&dev);
    hipDeviceGetAttribute(&cus, hipDeviceAttributeMultiprocessorCount, dev);
    hipOccupancyMaxActiveBlocksPerMultiprocessor(&per_cu, mk, 256, 0);
    if (per_cu < 1) per_cu = 1;
    if (per_cu > 2) per_cu = 2;
    grid_blocks = cus * per_cu;
  }
  if (ws_size < WS_NEED) { fprintf(stderr, "workspace too small: %zu < %zu\n", ws_size, (size_t)WS_NEED); return; }
  Params p{};
  for (int i = 0; i < 32; ++i) p.in[i] = (const float*)d_in[i];
  p.out = (float*)d_out;
  p.ws = (unsigned char*)d_ws;
#if MEGA
  (void)hipMemsetAsync((unsigned char*)d_ws + O_BAR, 0, XCD_BAR_WORDS * 4, stream);
  int ph0 = 0, ph1 = NPHASE, coop = 1;
  void* args[] = {&p, &ph0, &ph1, &coop};
  hipError_t e = hipLaunchCooperativeKernel((void*)mk, dim3(grid_blocks), dim3(256), args, 0, stream);
  if (e != hipSuccess) fprintf(stderr, "cooperative launch failed: %s (grid %d)\n", hipGetErrorString(e), grid_blocks);
#else
  for (int ph = 0; ph < NPHASE; ++ph) mk<<<grid_blocks, 256, 0, stream>>>(p, ph, ph + 1, 0);
#endif
}
```

```cpp
#include <hip/hip_runtime.h>
#include <hip/hip_cooperative_groups.h>
#include <cstdio>
#include <cstdint>
namespace cg = cooperative_groups;

#ifndef MEGA
#define MEGA 1
#endif
#ifndef ONLY
#define ONLY -1
#endif
#ifndef REPEAT_PH
#define REPEAT_PH -1
#endif
#ifndef DRY_PH
#define DRY_PH -1
#endif

typedef unsigned short bf16_t;
using bf16x8 = __attribute__((ext_vector_type(8))) short;
using f32x4 = __attribute__((ext_vector_type(4))) float;
using u32x4 = __attribute__((ext_vector_type(4))) unsigned;
#define DEVI __device__ __forceinline__

constexpr int T_CTX = 256, T_LAT = 16384, T_ALL = 16640;
constexpr int NIN = 5392, NP = 5376;
constexpr int NCH = 128, LCH = 130;
constexpr int SVH = 576;
constexpr int SMEM_BYTES = 71680;

enum { I_X = 0, I_C, I_CTX, I_CCTX, I_ADAW, I_ADAB, I_N1G, I_WIN, I_RCONV, I_RW0, I_RWUP, I_RA0, I_RAUP, I_RGUP,
       I_RKK, I_RKA, I_RRK, I_RLNW, I_RLNB, I_MCONV, I_MIB, I_MFB, I_MNG, I_WBA, I_WBB, I_WOUT, I_N2G, I_WQ,
       I_KEYS, I_PU, I_PV, I_FG };

struct Params { const float* in[32]; float* out; unsigned char* ws; };

constexpr size_t A256(size_t x) { return (x + 255) & ~(size_t)255; }
constexpr size_t O_MODP = 0;
constexpr size_t O_WBA = A256(O_MODP + (size_t)16 * 2 * 6144 * 4);
constexpr size_t O_WBB = A256(O_WBA + (size_t)1024 * 512 * 2);
constexpr size_t O_WOUT = A256(O_WBB + (size_t)1024 * 512 * 2);
constexpr size_t O_WQ = A256(O_WOUT + (size_t)1024 * 1024 * 2);
constexpr size_t O_KEYS = A256(O_WQ + (size_t)2048 * 1024 * 2);
constexpr size_t O_WUP = A256(O_KEYS + (size_t)16 * 128 * 128 * 2);
constexpr size_t O_AUP = A256(O_WUP + (size_t)1024 * 64 * 2);
constexpr size_t O_GUP = A256(O_AUP + (size_t)1024 * 64 * 2);
constexpr size_t O_BEND = A256(O_GUP + (size_t)512 * 128 * 2);
constexpr size_t O_MLOC = A256(O_BEND + (size_t)260 * 8 * 4);
constexpr size_t O_MST = A256(O_MLOC + (size_t)260 * 8 * 4);
constexpr size_t O_NT = A256(O_MST + (size_t)260 * 8 * 4);
constexpr size_t O_BONUS = A256(O_NT + (size_t)260 * 8 * 64 * 4);
constexpr size_t O_STAMP = A256(O_BONUS + (size_t)T_ALL * 16 * 4);
constexpr size_t O_BAR = A256(O_STAMP + 1024);
constexpr size_t O_PG = A256(O_BAR + 3456 * 4);
constexpr size_t O_PO = A256(O_PG + (size_t)T_LAT * 2048 * 2);
constexpr size_t O_R = A256(O_PO + (size_t)T_LAT * 512 * 2);
constexpr size_t R_HX = O_R;
constexpr size_t R_WIN = A256(R_HX + (size_t)T_ALL * 1024 * 2);
constexpr size_t R_PQK = A256(R_WIN + (size_t)(NP + 128) * 1024 * 2);
constexpr size_t R_PV = A256(R_PQK + (size_t)T_ALL * 512 * 2);
constexpr size_t R_GIF = A256(R_PV + (size_t)T_ALL * 512 * 2);
constexpr size_t R_U = A256(R_GIF + (size_t)T_ALL * 16 * 4);
constexpr size_t R_END1 = A256(R_U + (size_t)260 * 8 * 8192 * 4);
constexpr size_t R_SV = O_R;
constexpr size_t R_YA = A256(R_SV + (size_t)T_ALL * 8 * SVH * 2);
constexpr size_t R_END2 = A256(R_YA + (size_t)T_LAT * 512 * 2);
constexpr size_t R_MERGED = O_R;
constexpr size_t R_H2 = A256(R_MERGED + (size_t)T_LAT * 1024 * 2);
constexpr size_t R_TOPS = A256(R_H2 + (size_t)T_LAT * 1024 * 2);
constexpr size_t R_TOPI = A256(R_TOPS + (size_t)T_LAT * 256 * 4);
constexpr size_t R_UBF = A256(R_TOPI + (size_t)T_LAT * 256 * 4);
constexpr size_t R_VBF = A256(R_UBF + (size_t)16384 * 1024 * 2);
constexpr size_t R_END3 = A256(R_VBF + (size_t)16384 * 1024 * 2);
constexpr size_t WS_NEED = (R_END1 > R_END2 ? (R_END1 > R_END3 ? R_END1 : R_END3) : (R_END2 > R_END3 ? R_END2 : R_END3));
constexpr size_t OUT_BC = (size_t)NCH * 16 * 4096 * 4;

DEVI bf16_t f2bf(float f) { unsigned u = __float_as_uint(f); u += 0x7fffu + ((u >> 16) & 1u); return (bf16_t)(u >> 16); }
DEVI float bf2f(bf16_t h) { return __uint_as_float(((unsigned)h) << 16); }
DEVI float bflo(unsigned u) { return __uint_as_float(u << 16); }
DEVI float bfhi(unsigned u) { return __uint_as_float(u & 0xffff0000u); }
DEVI unsigned pack2(float a, float b) { return (unsigned)f2bf(a) | ((unsigned)f2bf(b) << 16); }
DEVI void unpack8(const uint4& u, float* f) {
  f[0] = bflo(u.x); f[1] = bfhi(u.x); f[2] = bflo(u.y); f[3] = bfhi(u.y);
  f[4] = bflo(u.z); f[5] = bfhi(u.z); f[6] = bflo(u.w); f[7] = bfhi(u.w);
}
DEVI uint4 pack8(const float* f) { return make_uint4(pack2(f[0], f[1]), pack2(f[2], f[3]), pack2(f[4], f[5]), pack2(f[6], f[7])); }
DEVI float wave_sum(float v) {
#pragma unroll
  for (int o = 32; o; o >>= 1) v += __shfl_xor(v, o);
  return v;
}
DEVI float wave_max(float v) {
#pragma unroll
  for (int o = 32; o; o >>= 1) v = fmaxf(v, __shfl_xor(v, o));
  return v;
}
DEVI float sigm(float x) { return 1.f / (1.f + __expf(-x)); }
DEVI float siluf(float x) { return x / (1.f + __expf(-x)); }
DEVI float logsig(float x) { return fminf(x, 0.f) - log1pf(expf(-fabsf(x))); }
template <int CTRL> DEVI float dppf(float v) { return __int_as_float(__builtin_amdgcn_update_dpp(0, __float_as_int(v), CTRL, 0xf, 0xf, true)); }
DEVI float rlf(float v, int l) { return __int_as_float(__builtin_amdgcn_readlane(__float_as_int(v), l)); }
DEVI float wave_sum_u(float v) {
  v += dppf<0xB1>(v); v += dppf<0x4E>(v); v += dppf<0x141>(v); v += dppf<0x140>(v);
  return (rlf(v, 0) + rlf(v, 16)) + (rlf(v, 32) + rlf(v, 48));
}
typedef __attribute__((ext_vector_type(2))) short s16x2;
DEVI float dot2bf(unsigned a, unsigned b, float c) { return __builtin_amdgcn_fdot2_f32_bf16(__builtin_bit_cast(s16x2, a), __builtin_bit_cast(s16x2, b), c, false); }
typedef __attribute__((ext_vector_type(2))) float f32x2;
DEVI void convert_fp8(const float* __restrict__ src, unsigned char* __restrict__ dst, size_t n16, float scale) {
  for (size_t g = (size_t)blockIdx.x * 256 + threadIdx.x; g < n16; g += (size_t)gridDim.x * 256) {
    u32x4 o;
#pragma unroll
    for (int q = 0; q < 4; ++q) {
      float4 a = *(const float4*)(src + g * 16 + q * 4);
      int pk = __builtin_amdgcn_cvt_pk_fp8_f32(a.x * scale, a.y * scale, 0, false);
      pk = __builtin_amdgcn_cvt_pk_fp8_f32(a.z * scale, a.w * scale, pk, true);
      o[q] = (unsigned)pk;
    }
    *(u32x4*)(dst + g * 16) = o;
  }
}
DEVI void unpack_fp8x16(const u32x4& u, float* f) {
#pragma unroll
  for (int q = 0; q < 4; ++q) {
    f32x2 lo = __builtin_amdgcn_cvt_pk_f32_fp8((int)u[q], false), hi = __builtin_amdgcn_cvt_pk_f32_fp8((int)u[q], true);
    f[4 * q] = lo[0]; f[4 * q + 1] = lo[1]; f[4 * q + 2] = hi[0]; f[4 * q + 3] = hi[1];
  }
}
DEVI void convert_bf16(const float* __restrict__ src, bf16_t* __restrict__ dst, size_t n8) {
  for (size_t g = (size_t)blockIdx.x * 256 + threadIdx.x; g < n8; g += (size_t)gridDim.x * 256) {
    float4 a = *(const float4*)(src + g * 8), b = *(const float4*)(src + g * 8 + 4);
    *(uint4*)(dst + g * 8) = make_uint4(pack2(a.x, a.y), pack2(a.z, a.w), pack2(b.x, b.y), pack2(b.z, b.w));
  }
}
DEVI float allred8(float v) { v += dppf<0xB1>(v); v += dppf<0x4E>(v); v += dppf<0x141>(v); return v; }

DEVI int ml_row(int c, int j) {
  if (c < 4) return c * 64 + j;
  int cc = c - 4; int col = cc >> 2; int gr = (cc & 3) * 64 + j;
  return T_CTX + gr * 64 + col;
}
DEVI int ml_sc(int c, int dir) { return dir == 0 ? c : (c < 4 ? 3 - c : 263 - c); }
DEVI int rw_row(int p, int dir) { return dir == 0 ? p : (p < T_CTX ? (T_CTX - 1 - p) : (T_ALL + T_CTX - 1 - p)); }

DEVI float mod_val(const Params& p, int which, int col) {
  const float* modp = (const float*)(p.ws + O_MODP);
  float s = p.in[I_ADAB][col];
#pragma unroll
  for (int rs = 0; rs < 16; ++rs) s += modp[(rs * 2 + which) * 6144 + col];
  return s;
}

DEVI void gemm_core(const bf16_t* __restrict__ A, int lda, const bf16_t* __restrict__ Bt, int ldb, int K,
                    f32x4 (&acc)[4][4], unsigned char* smem) {
  bf16_t(*sa)[80] = (bf16_t(*)[80])smem;
  bf16_t(*sb)[80] = (bf16_t(*)[80])(smem + 128 * 80 * 2);
  const int tid = threadIdx.x, lane = tid & 63, warp = tid >> 6, wm = warp >> 1, wn = warp & 1;
  const int lr = tid >> 3, lk = (tid & 7) * 8;
  const bf16_t* Ap = A + (size_t)lr * lda + lk;
  const bf16_t* Bp = Bt + (size_t)lr * ldb + lk;
  u32x4 ra0[4], rb0[4], ra1[4], rb1[4];
#pragma unroll
  for (int i = 0; i < 4; ++i) {
    ra0[i] = *(const u32x4*)(Ap + (size_t)(32 * i) * lda); rb0[i] = *(const u32x4*)(Bp + (size_t)(32 * i) * ldb);
    ra1[i] = *(const u32x4*)(Ap + (size_t)(32 * i) * lda + 64); rb1[i] = *(const u32x4*)(Bp + (size_t)(32 * i) * ldb + 64);
  }
#define GEMM_STEP(k0, ra, rb)                                                                                 \
  {                                                                                                           \
    __syncthreads();                                                                                          \
    _Pragma("unroll") for (int i = 0; i < 4; ++i) { *(u32x4*)&sa[lr + 32 * i][lk] = ra[i]; *(u32x4*)&sb[lr + 32 * i][lk] = rb[i]; } \
    __syncthreads();                                                                                          \
    if ((k0) + 128 < K) {                                                                                     \
      _Pragma("unroll") for (int i = 0; i < 4; ++i) {                                                         \
        ra[i] = *(const u32x4*)(Ap + (size_t)(32 * i) * lda + (k0) + 128);                                    \
        rb[i] = *(const u32x4*)(Bp + (size_t)(32 * i) * ldb + (k0) + 128);                                    \
      }                                                                                                       \
    }                                                                                                         \
    __builtin_amdgcn_s_setprio(1);                                                                            \
    _Pragma("unroll") for (int ks = 0; ks < 2; ++ks) {                                                        \
      bf16x8 af[4], bq[4];                                                                                    \
      _Pragma("unroll") for (int i = 0; i < 4; ++i) af[i] = *(const bf16x8*)&sa[wm * 64 + i * 16 + (lane & 15)][ks * 32 + (lane >> 4) * 8]; \
      _Pragma("unroll") for (int j = 0; j < 4; ++j) bq[j] = *(const bf16x8*)&sb[wn * 64 + j * 16 + (lane & 15)][ks * 32 + (lane >> 4) * 8]; \
      _Pragma("unroll") for (int i = 0; i < 4; ++i)                                                           \
        _Pragma("unroll") for (int j = 0; j < 4; ++j) acc[i][j] = __builtin_amdgcn_mfma_f32_16x16x32_bf16(bq[j], af[i], acc[i][j], 0, 0, 0); \
    }                                                                                                         \
    __builtin_amdgcn_s_setprio(0);                                                                            \
  }
  for (int k0 = 0; k0 < K; k0 += 128) {
    GEMM_STEP(k0, ra0, rb0)
    GEMM_STEP(k0 + 64, ra1, rb1)
  }
#undef GEMM_STEP
  __syncthreads();
}
DEVI void zero_acc(f32x4 (&acc)[4][4]) {
#pragma unroll
  for (int i = 0; i < 4; ++i)
#pragma unroll
    for (int j = 0; j < 4; ++j) acc[i][j] = f32x4{0.f, 0.f, 0.f, 0.f};
}

struct XcdMap { int v, nx, slot, slots; };
template <typename F> DEVI void for_tiles_xcd(const XcdMap& xm, int MT, int NT, int SM, int SN, F&& f) {
  const int nsn = (NT + SN - 1) / SN, nst = ((MT + SM - 1) / SM) * nsn, per = SM * SN;
  const int n_my = (nst - xm.v + xm.nx - 1) / xm.nx;
  for (int g = xm.slot; g < n_my * per; g += xm.slots) {
    const int s = xm.v + (g / per) * xm.nx, idx = g % per;
    const int sm = s / nsn, sn = s % nsn;
    const int mt = sm * SM + idx / SN, nt = sn * SN + idx % SN;
    if (mt < MT && nt < NT) f(mt, nt);
  }
}

DEVI void tr_tile(const float* __restrict__ src, int lds, int k0, int n0src, bf16_t* __restrict__ dst, int ldd, int n0dst,
                  unsigned char* smem) {
  float(*tile)[65] = (float(*)[65])smem;
  const int tid = threadIdx.x, j = tid & 63, i0 = tid >> 6;
#pragma unroll 4
  for (int ii = 0; ii < 16; ++ii) { int i = i0 + 4 * ii; tile[i][j] = src[(size_t)(k0 + i) * lds + n0src + j]; }
  __syncthreads();
#pragma unroll 4
  for (int jj = 0; jj < 16; ++jj) { int jn = i0 + 4 * jj; dst[(size_t)(n0dst + jn) * ldd + k0 + j] = f2bf(tile[j][jn]); }
  __syncthreads();
}

DEVI void phase0(const Params& p, unsigned char* smem, int it_lo, int it_hi) {
  const int tid = threadIdx.x;
  constexpr int N_MOD = 384, N_WIN = 16 * 85, N_WB = 128, N_WOUT = 256, N_WQ = 512, N_LORA = 16, N_GUP = 16, N_KEYS = 128;
  constexpr int E0 = N_MOD, E1 = E0 + N_WIN, E2 = E1 + N_WB, E3 = E2 + N_WB, E4 = E3 + N_WOUT, E5 = E4 + N_WQ,
                E6 = E5 + N_LORA, E7 = E6 + N_LORA, E8 = E7 + N_GUP, E9 = E8 + N_KEYS;
  if (it_hi > E9) it_hi = E9;
  for (int it = it_lo + blockIdx.x; it < it_hi; it += gridDim.x) {
    if (it < E0) {
      int cb = it % 24, rs = it / 24; int col = cb * 256 + tid;
      const float* aw = p.in[I_ADAW];
      float ax = 0.f, ac = 0.f;
#pragma unroll 8
      for (int r = rs * 64; r < rs * 64 + 64; ++r) {
        float w = aw[(size_t)r * 6144 + col];
        ax += siluf(p.in[I_C][r]) * w;
        ac += siluf(p.in[I_CCTX][r]) * w;
      }
      float* modp = (float*)(p.ws + O_MODP);
      modp[(rs * 2 + 0) * 6144 + col] = ax;
      modp[(rs * 2 + 1) * 6144 + col] = ac;
    } else if (it < E1) {
      int t = it - E0; int kt = t / 85, nt = t % 85; int n0 = nt * 64;
      tr_tile(p.in[I_WIN], NIN, kt * 64, nt == 84 ? 2816 : (n0 < 2816 ? n0 : n0 + 16), (bf16_t*)(p.ws + R_WIN), 1024, n0, smem);
    } else if (it < E2) {
      int t = it - E1; tr_tile(p.in[I_WBA], 1024, (t / 16) * 64, (t % 16) * 64, (bf16_t*)(p.ws + O_WBA), 512, (t % 16) * 64, smem);
    } else if (it < E3) {
      int t = it - E2; tr_tile(p.in[I_WBB], 1024, (t / 16) * 64, (t % 16) * 64, (bf16_t*)(p.ws + O_WBB), 512, (t % 16) * 64, smem);
    } else if (it < E4) {
      int t = it - E3; tr_tile(p.in[I_WOUT], 1024, (t / 16) * 64, (t % 16) * 64, (bf16_t*)(p.ws + O_WOUT), 1024, (t % 16) * 64, smem);
    } else if (it < E5) {
      int t = it - E4; tr_tile(p.in[I_WQ], 2048, (t / 32) * 64, (t % 32) * 64, (bf16_t*)(p.ws + O_WQ), 1024, (t % 32) * 64, smem);
    } else if (it < E6) {
      int t = it - E5; int dir = t / 8, nt = t % 8;
      tr_tile(p.in[I_RWUP] + (size_t)dir * 64 * 512, 512, 0, nt * 64, (bf16_t*)(p.ws + O_WUP) + (size_t)dir * 512 * 64, 64, nt * 64, smem);
    } else if (it < E7) {
      int t = it - E6; int dir = t / 8, nt = t % 8;
      tr_tile(p.in[I_RAUP] + (size_t)dir * 64 * 512, 512, 0, nt * 64, (bf16_t*)(p.ws + O_AUP) + (size_t)dir * 512 * 64, 64, nt * 64, smem);
    } else if (it < E8) {
      int t = it - E7; tr_tile(p.in[I_RGUP], 512, (t / 8) * 64, (t % 8) * 64, (bf16_t*)(p.ws + O_GUP), 128, (t % 8) * 64, smem);
    } else {
      int t = it - E8; size_t base = (size_t)t * 2048 + tid * 8;
      const float* s = p.in[I_KEYS] + base;
      float f[8];
      float4 a = *(const float4*)s, b = *(const float4*)(s + 4);
      f[0] = a.x; f[1] = a.y; f[2] = a.z; f[3] = a.w; f[4] = b.x; f[5] = b.y; f[6] = b.z; f[7] = b.w;
      *(uint4*)((bf16_t*)(p.ws + O_KEYS) + base) = pack8(f);
    }
  }
}

DEVI void phase1(const Params& p, unsigned char* smem) {
  float* smod = (float*)smem;
  const int tid = threadIdx.x, lane = tid & 63, warp = tid >> 6;
  for (int i = tid; i < 4096; i += 256) { int which = i >> 10; smod[i] = mod_val(p, which >> 1, (which & 1) * 1024 + (i & 1023)); }
  __syncthreads();
  bf16_t* hx = (bf16_t*)(p.ws + R_HX);
  float* gif = (float*)(p.ws + R_GIF);
  const float* win = p.in[I_WIN];
  constexpr int RPW = 4;
  for (int rg = blockIdx.x * 4 + warp; rg < T_ALL / RPW; rg += gridDim.x * 4) {
    const int row0 = rg * RPW;
    const float* sh = smod + (row0 < T_CTX ? 2048 : 0);
    const float* sc = sh + 1024;
    const float* src0 = row0 < T_CTX ? p.in[I_CTX] + (size_t)row0 * 1024 : p.in[I_X] + (size_t)(row0 - T_CTX) * 1024;
    float rstd[RPW];
#pragma unroll
    for (int r = 0; r < RPW; ++r) {
      float ss = 0.f;
#pragma unroll
      for (int i = 0; i < 4; ++i) {
        float4 v = *(const float4*)(src0 + (size_t)r * 1024 + i * 256 + lane * 4);
        ss += v.x * v.x + v.y * v.y + v.z * v.z + v.w * v.w;
      }
      ss = wave_sum_u(ss);
      rstd[r] = rsqrtf(ss * (1.f / 1024.f) + 1e-6f);
    }
#pragma unroll
    for (int i = 0; i < 4; ++i) {
      const int k0 = i * 256 + lane * 4;
      const float4 gk = *(const float4*)(p.in[I_N1G] + k0);
      const float4 s4 = *(const float4*)(sc + k0), h4 = *(const float4*)(sh + k0);
#pragma unroll
      for (int r = 0; r < RPW; ++r) {
        float4 v = *(const float4*)(src0 + (size_t)r * 1024 + k0);
        const float y0 = v.x * rstd[r] * gk.x * (1.f + s4.x) + h4.x, y1 = v.y * rstd[r] * gk.y * (1.f + s4.y) + h4.y;
        const float y2 = v.z * rstd[r] * gk.z * (1.f + s4.z) + h4.z, y3 = v.w * rstd[r] * gk.w * (1.f + s4.w) + h4.w;
        *(uint2*)(hx + (size_t)(row0 + r) * 1024 + k0) = make_uint2(pack2(y0, y1), pack2(y2, y3));
      }
    }
  }
}

DEVI void phase2(const Params& p, unsigned char* smem, const XcdMap& xm) {
  const int lane = threadIdx.x & 63, warp = threadIdx.x >> 6, wm = warp >> 1, wn = warp & 1;
  const bf16_t* hx = (const bf16_t*)(p.ws + R_HX);
  const bf16_t* wt = (const bf16_t*)(p.ws + R_WIN);
  bf16_t* prw = (bf16_t*)p.out;
  bf16_t* pqk = (bf16_t*)(p.ws + R_PQK);
  bf16_t* pv = (bf16_t*)(p.ws + R_PV);
  bf16_t* po = (bf16_t*)(p.ws + O_PO);
  bf16_t* pg = (bf16_t*)(p.ws + O_PG);
  for_tiles_xcd(xm, 130, 43, 5, 6, [&](int mt, int nt) {
    if (mt < 2 && nt >= 22 && nt < 42) return;
    f32x4 acc[4][4];
    zero_acc(acc);
    gemm_core(hx + (size_t)mt * 128 * 1024, 1024, wt + (size_t)nt * 128 * 1024, 1024, 1024, acc, smem);
    if (nt == 42) {
      float* gif = (float*)(p.ws + R_GIF);
      if (wn == 0) {
#pragma unroll
        for (int i = 0; i < 4; ++i) {
          const int row = mt * 128 + wm * 64 + i * 16 + (lane & 15);
          *(float4*)(gif + (size_t)row * 16 + (lane >> 4) * 4) = make_float4(acc[i][0][0], acc[i][0][1], acc[i][0][2], acc[i][0][3]);
        }
      }
      return;
    }
    bf16_t* dst; int ld, nb; int rofs = 0; bool sg = false;
    if (nt < 14) { dst = prw; ld = 1792; nb = nt * 128; }
    else if (nt < 18) { dst = pqk; ld = 512; nb = (nt - 14) * 128; }
    else if (nt < 22) { dst = pv; ld = 512; nb = (nt - 18) * 128; }
    else if (nt < 26) { dst = po; ld = 512; nb = (nt - 22) * 128; rofs = T_CTX; }
    else { dst = pg; ld = 2048; nb = (nt - 26) * 128; rofs = T_CTX; sg = true; }
    bf16_t(*Ct)[136] = (bf16_t(*)[136])smem;
#pragma unroll
    for (int i = 0; i < 4; ++i) {
#pragma unroll
      for (int j = 0; j < 4; ++j) {
        f32x4 v = acc[i][j];
        if (sg) { v[0] = sigm(v[0]); v[1] = sigm(v[1]); v[2] = sigm(v[2]); v[3] = sigm(v[3]); }
        *(uint2*)&Ct[wm * 64 + i * 16 + (lane & 15)][wn * 64 + j * 16 + (lane >> 4) * 4] = make_uint2(pack2(v[0], v[1]), pack2(v[2], v[3]));
      }
    }
    __syncthreads();
#pragma unroll
    for (int q = 0; q < 8; ++q) {
      const int pc = threadIdx.x + 256 * q; const int r = pc >> 4, c8 = (pc & 15) * 8;
      const int row = mt * 128 + r - rofs;
      *(u32x4*)(dst + (size_t)row * ld + nb + c8) = *(const u32x4*)&Ct[r][c8];
    }
    __syncthreads();
  });
}

DEVI void ml_qk8(const Params& p, int c, int j, int chan, float* o) {
  const bf16_t* pqk = (const bf16_t*)(p.ws + R_PQK);
  int row = ml_row(c, j);
  bool hp, hn; int rp, rn;
  if (c < 4) { hp = row > 0; hn = row < T_CTX - 1; rp = row - 1; rn = row + 1; }
  else { int gr = ((c - 4) & 3) * 64 + j; hp = gr > 0; hn = gr < 255; rp = row - 64; rn = row + 64; }
  const float* cw = p.in[I_MCONV];
  float cur[8], pr[8], nx[8];
  unpack8(*(const uint4*)(pqk + (size_t)row * 512 + chan), cur);
  if (hp) unpack8(*(const uint4*)(pqk + (size_t)rp * 512 + chan), pr);
  if (hn) unpack8(*(const uint4*)(pqk + (size_t)rn * 512 + chan), nx);
#pragma unroll
  for (int e = 0; e < 8; ++e) {
    float v = cw[512 + chan + e] * cur[e];
    if (hp) v += cw[chan + e] * pr[e];
    if (hn) v += cw[1024 + chan + e] * nx[e];
    o[e] = siluf(v);
  }
}

DEVI void phase3(const Params& p, unsigned char* smem) {
  bf16_t(*KT)[72] = (bf16_t(*)[72])smem;
  bf16_t(*VwT)[72] = (bf16_t(*)[72])(smem + 64 * 72 * 2);
  float* wgt = (float*)(smem + 64 * 72 * 2 + 256 * 72 * 2);
  const int tid = threadIdx.x, lane = tid & 63, warp = tid >> 6;
  const float* gif = (const float*)(p.ws + R_GIF);
  const bf16_t* pv = (const bf16_t*)(p.ws + R_PV);
  float* U = (float*)(p.ws + R_U);
  float* NT = (float*)(p.ws + O_NT);
  float* bend = (float*)(p.ws + O_BEND);
  float* mloc = (float*)(p.ws + O_MLOC);
  for (int it = blockIdx.x; it < 260 * 4; it += gridDim.x) {
    int c = it >> 2, h = it & 3;
    if (warp < 2) {
      int dir = warp; int j = dir ? 63 - lane : lane;
      int row = ml_row(c, j);
      float ig = gif[(size_t)row * 16 + dir * 4 + h] + p.in[I_MIB][dir * 4 + h];
      float lf = logsig(gif[(size_t)row * 16 + 8 + dir * 4 + h] + p.in[I_MFB][dir * 4 + h]);
      float b = lf;
#pragma unroll
      for (int o = 1; o < 64; o <<= 1) { float t = __shfl_up(b, o); if (lane >= o) b += t; }
      float be = __shfl(b, 63);
      float ge = be - b + ig;
      float ml = wave_max(ge);
      wgt[dir * 64 + j] = expf(ge - ml);
      if (lane == 0) { int sc = ml_sc(c, dir); bend[sc * 8 + dir * 4 + h] = be; mloc[sc * 8 + dir * 4 + h] = ml; }
    }
    __syncthreads();
    {
      int j = tid >> 2, part = tid & 3;
      float f[8];
#pragma unroll
      for (int q = 0; q < 2; ++q) {
        int d0 = part * 16 + q * 8;
        ml_qk8(p, c, j, 256 + h * 64 + d0, f);
#pragma unroll
        for (int e = 0; e < 8; ++e) KT[d0 + e][j] = f2bf(f[e] * 0.125f);
      }
      int row = ml_row(c, j);
      float w0 = wgt[j], w1 = wgt[64 + j];
#pragma unroll
      for (int q = 0; q < 4; ++q) {
        int v0 = part * 32 + q * 8;
        unpack8(*(const uint4*)(pv + (size_t)row * 512 + h * 128 + v0), f);
#pragma unroll
        for (int e = 0; e < 8; ++e) { VwT[v0 + e][j] = f2bf(f[e] * w0); VwT[128 + v0 + e][j] = f2bf(f[e] * w1); }
      }
    }
    __syncthreads();
#pragma unroll
    for (int dir = 0; dir < 2; ++dir) {
      int sc = ml_sc(c, dir);
      float* Ud = U + ((size_t)sc * 8 + dir * 4 + h) * 8192;
#pragma unroll
      for (int vi = 0; vi < 2; ++vi) {
        int vt = warp * 2 + vi;
        bf16x8 bv[2];
#pragma unroll
        for (int ks = 0; ks < 2; ++ks) bv[ks] = *(const bf16x8*)&VwT[dir * 128 + vt * 16 + (lane & 15)][ks * 32 + (lane >> 4) * 8];
#pragma unroll
        for (int dt = 0; dt < 4; ++dt) {
          f32x4 a = {0.f, 0.f, 0.f, 0.f};
#pragma unroll
          for (int ks = 0; ks < 2; ++ks) {
            bf16x8 ak = *(const bf16x8*)&KT[dt * 16 + (lane & 15)][ks * 32 + (lane >> 4) * 8];
            a = __builtin_amdgcn_mfma_f32_16x16x32_bf16(ak, bv[ks], a, 0, 0, 0);
          }
          *(float4*)(Ud + (size_t)(vt * 16 + (lane & 15)) * 64 + dt * 16 + (lane >> 4) * 4) = make_float4(a[0], a[1], a[2], a[3]);
        }
      }
    }
    if (tid < 128) {
      int dir = tid >> 6, d = tid & 63; float s = 0.f;
      for (int j = 0; j < 64; ++j) s += wgt[dir * 64 + j] * bf2f(KT[d][j]);
      NT[((size_t)ml_sc(c, dir) * 8 + dir * 4 + h) * 64 + d] = s;
    }
    __syncthreads();
  }
}

template <bool DRY> DEVI void phase4(const Params& p) {
  const bool wr = !DRY || (p.in[I_FG][0] == 1234.5f);
  float* U = (float*)(p.ws + R_U);
  float* NT = (float*)(p.ws + O_NT);
  const float* bend = (const float*)(p.ws + O_BEND);
  const float* mloc = (const float*)(p.ws + O_MLOC);
  float* mst = (float*)(p.ws + O_MST);
  for (int g = blockIdx.x * 256 + threadIdx.x; g < 8 * 8256; g += gridDim.x * 256) {
    int pr = g / 8256, e = g % 8256;
    float* base; size_t stride;
    if (e < 8192) { base = U + (size_t)pr * 8192 + e; stride = 8 * 8192; }
    else { base = NT + (size_t)pr * 64 + (e - 8192); stride = 8 * 64; }
    float m = 0.f, C = 0.f;
    for (int sc = 0; sc < 260; sc += 20) {
      float u[20];
#pragma unroll
      for (int q = 0; q < 20; ++q) u[q] = base[(size_t)(sc + q) * stride];
#pragma unroll
      for (int q = 0; q < 20; ++q) {
        float be = bend[(sc + q) * 8 + pr], ml = mloc[(sc + q) * 8 + pr];
        float mn = fmaxf(be + m, ml);
        float keep = expf(be + m - mn), s = expf(ml - mn);
        if (wr) base[(size_t)(sc + q) * stride] = C;
        if (wr && e == 0) mst[(sc + q) * 8 + pr] = m;
        C = keep * C + s * u[q];
        m = mn;
      }
    }
  }
}

template <bool DRY> DEVI void phase5(const Params& p, unsigned char* smem) {
  const bool wr = !DRY || (p.in[I_FG][0] == 1234.5f);
  bf16_t(*Qs)[72] = (bf16_t(*)[72])smem;
  bf16_t(*Ks)[72] = (bf16_t(*)[72])(smem + 9216);
  bf16_t(*Pm)[72] = (bf16_t(*)[72])(smem + 2 * 9216);
  bf16_t(*VT)[72] = (bf16_t(*)[72])(smem + 3 * 9216);
  float* evec = (float*)(smem + 3 * 9216 + 144 * 72 * 2);
  float* Mvec = evec + 128;
  float* bvec = Mvec + 128;
  const int tid = threadIdx.x, lane = tid & 63, warp = tid >> 6;
  const float* gif = (const float*)(p.ws + R_GIF);
  const bf16_t* pv = (const bf16_t*)(p.ws + R_PV);
  const bf16_t* po = (const bf16_t*)(p.ws + O_PO);
  bf16_t* yb = (bf16_t*)(p.ws + R_YA);
  const float* U = (const float*)(p.ws + R_U);
  const float* NT = (const float*)(p.ws + O_NT);
  const float* mst = (const float*)(p.ws + O_MST);
  for (int it = blockIdx.x; it < 256 * 4; it += gridDim.x) {
    int c = 4 + (it >> 2), h = it & 3;
    if (warp < 2) {
      int dir = warp; int j = dir ? 63 - lane : lane;
      int row = ml_row(c, j);
      float ig = gif[(size_t)row * 16 + dir * 4 + h] + p.in[I_MIB][dir * 4 + h];
      float lf = logsig(gif[(size_t)row * 16 + 8 + dir * 4 + h] + p.in[I_MFB][dir * 4 + h]);
      float b = lf;
#pragma unroll
      for (int o = 1; o < 64; o <<= 1) { float t = __shfl_up(b, o); if (lane >= o) b += t; }
      float e = ig - b;
      float pm = e;
#pragma unroll
      for (int o = 1; o < 64; o <<= 1) { float t = __shfl_up(pm, o); if (lane >= o) pm = fmaxf(pm, t); }
      float m0 = mst[ml_sc(c, dir) * 8 + dir * 4 + h];
      evec[dir * 64 + j] = e; Mvec[dir * 64 + j] = fmaxf(m0, pm); bvec[dir * 64 + j] = b;
    }
    {
      int j = tid >> 2, part = tid & 3;
      float f[8];
#pragma unroll
      for (int q = 0; q < 2; ++q) {
        int d0 = part * 16 + q * 8;
        ml_qk8(p, c, j, h * 64 + d0, f);
        *(uint4*)&Qs[j][d0] = pack8(f);
        ml_qk8(p, c, j, 256 + h * 64 + d0, f);
#pragma unroll
        for (int e = 0; e < 8; ++e) f[e] *= 0.125f;
        *(uint4*)&Ks[j][d0] = pack8(f);
      }
      int row = ml_row(c, j);
#pragma unroll
      for (int q = 0; q < 4; ++q) {
        int v0 = part * 32 + q * 8;
        unpack8(*(const uint4*)(pv + (size_t)row * 512 + h * 128 + v0), f);
#pragma unroll
        for (int e = 0; e < 8; ++e) VT[v0 + e][j] = f2bf(f[e]);
      }
      for (int i = tid; i < 16 * 64; i += 256) VT[128 + (i >> 6)][i & 63] = (i < 64) ? (bf16_t)0x3f80 : (bf16_t)0;
    }
    __syncthreads();
    const int jl = warp * 16 + (lane & 15);
    f32x4 s0[4];
    bf16x8 qf[2];
#pragma unroll
    for (int ks = 0; ks < 2; ++ks) qf[ks] = *(const bf16x8*)&Qs[jl][ks * 32 + (lane >> 4) * 8];
#pragma unroll
    for (int st = 0; st < 4; ++st) {
      f32x4 a = {0.f, 0.f, 0.f, 0.f};
#pragma unroll
      for (int ks = 0; ks < 2; ++ks) {
        bf16x8 kf = *(const bf16x8*)&Ks[st * 16 + (lane & 15)][ks * 32 + (lane >> 4) * 8];
        a = __builtin_amdgcn_mfma_f32_16x16x32_bf16(kf, qf[ks], a, 0, 0, 0);
      }
      s0[st] = a;
    }
    f32x4 ysum[8];
#pragma unroll
    for (int vt = 0; vt < 8; ++vt) ysum[vt] = f32x4{0.f, 0.f, 0.f, 0.f};
#pragma unroll 1
    for (int dir = 0; dir < 2; ++dir) {
      float Mj = Mvec[dir * 64 + jl], bj = bvec[dir * 64 + jl];
      float m0 = mst[ml_sc(c, dir) * 8 + dir * 4 + h];
#pragma unroll
      for (int st = 0; st < 4; ++st) {
        float pvv[4];
#pragma unroll
        for (int r = 0; r < 4; ++r) {
          int s = st * 16 + (lane >> 4) * 4 + r;
          bool ok = dir == 0 ? (s <= jl) : (s >= jl);
          pvv[r] = ok ? s0[st][r] * expf(evec[dir * 64 + s] - Mj) : 0.f;
        }
        *(uint2*)&Pm[jl][st * 16 + (lane >> 4) * 4] = make_uint2(pack2(pvv[0], pvv[1]), pack2(pvv[2], pvv[3]));
      }
      __syncthreads();
      bf16x8 pf[2];
#pragma unroll
      for (int ks = 0; ks < 2; ++ks) pf[ks] = *(const bf16x8*)&Pm[jl][ks * 32 + (lane >> 4) * 8];
      const float* Cst = U + ((size_t)ml_sc(c, dir) * 8 + dir * 4 + h) * 8192;
      const float* nst = NT + ((size_t)ml_sc(c, dir) * 8 + dir * 4 + h) * 64;
      float ai = expf(m0 - Mj);
      f32x4 hh[9];
#pragma unroll
      for (int vt = 0; vt < 9; ++vt) {
        f32x4 a1 = {0.f, 0.f, 0.f, 0.f}, a2 = {0.f, 0.f, 0.f, 0.f};
#pragma unroll
        for (int ks = 0; ks < 2; ++ks) {
          bf16x8 vf = *(const bf16x8*)&VT[vt * 16 + (lane & 15)][ks * 32 + (lane >> 4) * 8];
          a1 = __builtin_amdgcn_mfma_f32_16x16x32_bf16(vf, pf[ks], a1, 0, 0, 0);
          int v = vt * 16 + (lane & 15);
          const float* cp = v < 128 ? Cst + (size_t)v * 64 + ks * 32 + (lane >> 4) * 8 : nst + ks * 32 + (lane >> 4) * 8;
          float cf[8];
          if (v <= 128) {
            float4 x0 = *(const float4*)cp, x1 = *(const float4*)(cp + 4);
            cf[0] = x0.x; cf[1] = x0.y; cf[2] = x0.z; cf[3] = x0.w; cf[4] = x1.x; cf[5] = x1.y; cf[6] = x1.z; cf[7] = x1.w;
          } else {
#pragma unroll
            for (int e = 0; e < 8; ++e) cf[e] = 0.f;
          }
          uint4 pk = pack8(cf);
          bf16x8 cfr;
          cfr[0] = (short)(pk.x & 0xffff); cfr[1] = (short)(pk.x >> 16); cfr[2] = (short)(pk.y & 0xffff); cfr[3] = (short)(pk.y >> 16);
          cfr[4] = (short)(pk.z & 0xffff); cfr[5] = (short)(pk.z >> 16); cfr[6] = (short)(pk.w & 0xffff); cfr[7] = (short)(pk.w >> 16);
          a2 = __builtin_amdgcn_mfma_f32_16x16x32_bf16(cfr, qf[ks], a2, 0, 0, 0);
        }
#pragma unroll
        for (int r = 0; r < 4; ++r) hh[vt][r] = a1[r] + ai * a2[r];
      }
      float den = __shfl(hh[8][0], lane & 15);
      float dn = fmaxf(fabsf(den), expf(-(bj + Mj)));
      float inv = 1.f / dn;
      float ss = 0.f;
#pragma unroll
      for (int vt = 0; vt < 8; ++vt)
#pragma unroll
        for (int r = 0; r < 4; ++r) { float x = hh[vt][r] * inv; hh[vt][r] = x; ss += x * x; }
      ss += __shfl_xor(ss, 16); ss += __shfl_xor(ss, 32);
      float rs = rsqrtf(ss * (1.f / 128.f) + 1e-6f);
#pragma unroll
      for (int vt = 0; vt < 8; ++vt)
#pragma unroll
        for (int r = 0; r < 4; ++r) ysum[vt][r] += hh[vt][r] * rs * p.in[I_MNG][h * 128 + vt * 16 + (lane >> 4) * 4 + r];
      __syncthreads();
    }
    {
      int row = ml_row(c, jl) - T_CTX;
#pragma unroll
      for (int vt = 0; vt < 8; ++vt) {
        const bf16_t* op = po + (size_t)row * 512 + h * 128 + vt * 16 + (lane >> 4) * 4;
        uint2 o = *(const uint2*)op;
        float y0 = ysum[vt][0] * sigm(bflo(o.x)), y1 = ysum[vt][1] * sigm(bfhi(o.x)), y2 = ysum[vt][2] * sigm(bflo(o.y)), y3 = ysum[vt][3] * sigm(bfhi(o.y));
        if (wr) *(uint2*)(yb + (size_t)row * 512 + h * 128 + vt * 16 + (lane >> 4) * 4) = make_uint2(pack2(y0, y1), pack2(y2, y3));
      }
    }
    __syncthreads();
  }
}

DEVI void phase6(const Params& p, unsigned char* smem, int item_lo, int item_hi, int blk0, int nblk) {
  float(*rs)[65] = (float(*)[65])smem;
  float(*ks)[65] = (float(*)[65])(smem + 64 * 65 * 4);
  bf16_t(*TW)[72] = (bf16_t(*)[72])(smem + 2 * 64 * 65 * 4);
  bf16_t(*TA)[72] = (bf16_t(*)[72])(smem + 2 * 64 * 65 * 4 + 9216);
  bf16_t(*TG)[136] = (bf16_t(*)[136])(smem + 2 * 64 * 65 * 4 + 2 * 9216);
  float* rn = (float*)(smem + 2 * 64 * 65 * 4 + 2 * 9216 + 64 * 136 * 2);
  const int tid = threadIdx.x, lane = tid & 63, warp = tid >> 6;
  const bf16_t* prw = (const bf16_t*)p.out;
  bf16_t* SV = (bf16_t*)(p.ws + R_SV);
  float* bonus = (float*)(p.ws + O_BONUS);
  const float* cw = p.in[I_RCONV];
  const bf16_t* WUP = (const bf16_t*)(p.ws + O_WUP);
  const bf16_t* AUP = (const bf16_t*)(p.ws + O_AUP);
  const bf16_t* GUP = (const bf16_t*)(p.ws + O_GUP);
  if ((int)blockIdx.x < blk0) return;
  for (int it = item_lo + ((int)blockIdx.x - blk0); it < item_hi; it += nblk) {
    int tile = it >> 3, head = it & 7;
    int row0 = tile * 64;
    int seg0 = tile < 4 ? 0 : row0, seg1 = tile < 4 ? T_CTX : row0 + 64;
#pragma unroll 1
    for (int ub = 0; ub < 2; ++ub) {
      u32x4 lc[7], lp[7], ln[7];
#pragma unroll
      for (int it7 = 0; it7 < 7; ++it7) {
        const int u = warp + 4 * (ub * 7 + it7);
        const int grp = u >> 3;
        const int j = (u & 7) * 8 + (lane >> 3), q = grp * 8 + (lane & 7);
        const int row = row0 + j;
        const int col = q < 24 ? (q >> 3) * 512 + head * 64 + (q & 7) * 8 : 1536 + (q - 24) * 8;
        const bool hp = row > seg0, hn = row < seg1 - 1;
        lc[it7] = *(const u32x4*)(prw + (size_t)row * 1792 + col);
        lp[it7] = hp ? *(const u32x4*)(prw + (size_t)(row - 1) * 1792 + col) : u32x4{0u, 0u, 0u, 0u};
        ln[it7] = hn ? *(const u32x4*)(prw + (size_t)(row + 1) * 1792 + col) : u32x4{0u, 0u, 0u, 0u};
      }
#pragma unroll
      for (int it7 = 0; it7 < 7; ++it7) {
        const int u = warp + 4 * (ub * 7 + it7);
        const int grp = u >> 3;
        const int j = (u & 7) * 8 + (lane >> 3), q = grp * 8 + (lane & 7);
        const int row = row0 + j;
        const int col = q < 24 ? (q >> 3) * 512 + head * 64 + (q & 7) * 8 : 1536 + (q - 24) * 8;
        float cur[8], pr[8], nx[8], o[8];
        unpack8(make_uint4(lc[it7][0], lc[it7][1], lc[it7][2], lc[it7][3]), cur);
        unpack8(make_uint4(lp[it7][0], lp[it7][1], lp[it7][2], lp[it7][3]), pr);
        unpack8(make_uint4(ln[it7][0], ln[it7][1], ln[it7][2], ln[it7][3]), nx);
        {
          float4 c0 = *(const float4*)(cw + col), c1 = *(const float4*)(cw + col + 4);
          float4 d0 = *(const float4*)(cw + 1792 + col), d1 = *(const float4*)(cw + 1792 + col + 4);
          float4 e0 = *(const float4*)(cw + 3584 + col), e1 = *(const float4*)(cw + 3584 + col + 4);
          float wp[8] = {c0.x, c0.y, c0.z, c0.w, c1.x, c1.y, c1.z, c1.w};
          float wc[8] = {d0.x, d0.y, d0.z, d0.w, d1.x, d1.y, d1.z, d1.w};
          float wn_[8] = {e0.x, e0.y, e0.z, e0.w, e1.x, e1.y, e1.z, e1.w};
#pragma unroll
          for (int e = 0; e < 8; ++e) o[e] = wc[e] * cur[e] + wp[e] * pr[e] + wn_[e] * nx[e];
        }
        if (grp == 0) {
#pragma unroll
          for (int e = 0; e < 8; ++e) rs[j][(q & 7) * 8 + e] = o[e];
        } else if (grp == 1) {
#pragma unroll
          for (int e = 0; e < 8; ++e) ks[j][(q & 7) * 8 + e] = o[e];
        } else if (grp == 2) {
          *(uint4*)(SV + ((size_t)row * 8 + head) * SVH + 2 * 64 + (q & 7) * 8) = pack8(o);
        } else if (grp == 3) {
#pragma unroll
          for (int e = 0; e < 8; ++e) o[e] = 1.f - 2.f / (1.f + __expf(2.f * o[e]));
          *(uint4*)&TW[j][(q - 24) * 8] = pack8(o);
        } else if (grp == 4) {
          *(uint4*)&TA[j][(q - 32) * 8] = pack8(o);
        } else {
#pragma unroll
          for (int e = 0; e < 8; ++e) o[e] = sigm(o[e]);
          *(uint4*)&TG[j][(q - 40) * 8] = pack8(o);
        }
      }
    }
    __syncthreads();
    {
      int j = tid >> 2, part = tid & 3; float ss = 0.f;
#pragma unroll
      for (int e = 0; e < 16; ++e) { float v = ks[j][part * 16 + e] * p.in[I_RKK][head * 64 + part * 16 + e]; ss += v * v; }
      ss += __shfl_xor(ss, 1); ss += __shfl_xor(ss, 2);
      if (part == 0) rn[j] = 1.f / fmaxf(sqrtf(ss), 1e-12f);
    }
    __syncthreads();
    for (int pc = tid; pc < 64 * 8; pc += 256) {
      int j = pc >> 3, c8 = (pc & 7) * 8; int row = row0 + j;
      float fr[8], fk[8], fkk[8];
#pragma unroll
      for (int e = 0; e < 8; ++e) { fr[e] = rs[j][c8 + e]; fk[e] = ks[j][c8 + e]; fkk[e] = fk[e] * p.in[I_RKK][head * 64 + c8 + e] * rn[j]; }
      bf16_t* b = SV + ((size_t)row * 8 + head) * SVH;
      *(uint4*)(b + 0 * 64 + c8) = pack8(fr);
      *(uint4*)(b + 1 * 64 + c8) = pack8(fk);
      *(uint4*)(b + 3 * 64 + c8) = pack8(fkk);
    }
    {
      const int jl = warp * 16 + (lane & 15); const int row = row0 + jl;
      bf16x8 tw[2], ta[2], tg[4];
#pragma unroll
      for (int s2 = 0; s2 < 2; ++s2) { tw[s2] = *(const bf16x8*)&TW[jl][s2 * 32 + (lane >> 4) * 8]; ta[s2] = *(const bf16x8*)&TA[jl][s2 * 32 + (lane >> 4) * 8]; }
#pragma unroll
      for (int s2 = 0; s2 < 4; ++s2) tg[s2] = *(const bf16x8*)&TG[jl][s2 * 32 + (lane >> 4) * 8];
      __syncthreads();
      bf16_t(*OB)[64][72] = (bf16_t(*)[64][72])(smem + 2 * 64 * 65 * 4);
      float bon[2] = {0.f, 0.f};
#pragma unroll
      for (int dir = 0; dir < 2; ++dir) {
#pragma unroll
        for (int ct = 0; ct < 4; ++ct) {
          const int ch0 = ct * 16 + (lane >> 4) * 4;
          const int C0 = head * 64 + ch0;
          if (dir == 0) {
            f32x4 a = {0.f, 0.f, 0.f, 0.f};
#pragma unroll
            for (int s2 = 0; s2 < 4; ++s2) {
              bf16x8 wf = *(const bf16x8*)(GUP + (size_t)(head * 64 + ct * 16 + (lane & 15)) * 128 + s2 * 32 + (lane >> 4) * 8);
              a = __builtin_amdgcn_mfma_f32_16x16x32_bf16(wf, tg[s2], a, 0, 0, 0);
            }
            *(uint2*)&OB[2][jl][ch0] = make_uint2(pack2(a[0], a[1]), pack2(a[2], a[3]));
          }
          f32x4 aw = {0.f, 0.f, 0.f, 0.f}, aa = {0.f, 0.f, 0.f, 0.f};
#pragma unroll
          for (int s2 = 0; s2 < 2; ++s2) {
            size_t wo = (size_t)(dir * 512 + head * 64 + ct * 16 + (lane & 15)) * 64 + s2 * 32 + (lane >> 4) * 8;
            bf16x8 wf = *(const bf16x8*)(WUP + wo);
            bf16x8 af = *(const bf16x8*)(AUP + wo);
            aw = __builtin_amdgcn_mfma_f32_16x16x32_bf16(wf, tw[s2], aw, 0, 0, 0);
            aa = __builtin_amdgcn_mfma_f32_16x16x32_bf16(af, ta[s2], aa, 0, 0, 0);
          }
          const float4 w04 = *(const float4*)(p.in[I_RW0] + dir * 512 + C0), a04 = *(const float4*)(p.in[I_RA0] + dir * 512 + C0);
          const float4 ka4 = *(const float4*)(p.in[I_RKA] + C0), rk4 = *(const float4*)(p.in[I_RRK] + C0);
          const float w0v[4] = {w04.x, w04.y, w04.z, w04.w}, a0v[4] = {a04.x, a04.y, a04.z, a04.w};
          const float kav[4] = {ka4.x, ka4.y, ka4.z, ka4.w}, rkv[4] = {rk4.x, rk4.y, rk4.z, rk4.w};
          float we[4], av[4];
#pragma unroll
          for (int r = 0; r < 4; ++r) {
            we[r] = (0.60653066f * 1.44269504f) * sigm(w0v[r] + aw[r]);
            av[r] = sigm(a0v[r] + aa[r]);
            float kv = ks[jl][ch0 + r];
            float keff = kv * (1.f + (av[r] - 1.f) * kav[r]);
            bon[dir] += rs[jl][ch0 + r] * keff * rkv[r];
          }
          *(uint2*)&OB[0][jl][ch0] = make_uint2(pack2(we[0], we[1]), pack2(we[2], we[3]));
          *(uint2*)&OB[1][jl][ch0] = make_uint2(pack2(av[0], av[1]), pack2(av[2], av[3]));
        }
        __syncthreads();
        for (int pc = tid; pc < (dir == 0 ? 3 : 2) * 64 * 8; pc += 256) {
          const int vsel = pc >> 9, j = (pc >> 3) & 63, c8 = (pc & 7) * 8;
          const int vec = vsel == 2 ? 8 : (4 + 2 * dir + vsel);
          *(u32x4*)(SV + ((size_t)(row0 + j) * 8 + head) * SVH + vec * 64 + c8) = *(const u32x4*)&OB[vsel][j][c8];
        }
        __syncthreads();
      }
#pragma unroll
      for (int dir = 0; dir < 2; ++dir) {
        float sb = bon[dir]; sb += __shfl_xor(sb, 16); sb += __shfl_xor(sb, 32);
        if (lane < 16) bonus[(size_t)row * 16 + dir * 8 + head] = sb;
      }
    }
    __syncthreads();
  }
}

struct RwVec { uint4 k, kk, w, a, v, r; };
DEVI void unpack8p(const uint4& u, f32x2* f) {
  f[0] = f32x2{bflo(u.x), bfhi(u.x)}; f[1] = f32x2{bflo(u.y), bfhi(u.y)}; f[2] = f32x2{bflo(u.z), bfhi(u.z)}; f[3] = f32x2{bflo(u.w), bfhi(u.w)};
}
DEVI f32x2 bc2(float x) { return f32x2{x, x}; }
DEVI void rw_load(RwVec& x, const bf16_t* SV, int row, int head, int dir, int i, int jg, bool need_r) {
  const bf16_t* b = SV + ((size_t)row * 8 + head) * SVH;
  x.k = *(const uint4*)(b + 1 * 64 + jg * 8);
  x.kk = *(const uint4*)(b + 3 * 64 + jg * 8);
  x.w = *(const uint4*)(b + (4 + 2 * dir) * 64 + jg * 8);
  x.a = *(const uint4*)(b + (5 + 2 * dir) * 64 + jg * 8);
  x.v = *(const uint4*)(b + 2 * 64 + i * 8);
  if (need_r) x.r = *(const uint4*)(b + 0 * 64 + jg * 8);
}

DEVI void phase7(const Params& p) {
  const int lane = threadIdx.x & 63, warp = threadIdx.x >> 6, i = lane >> 3, jg = lane & 7;
  const bf16_t* SV = (const bf16_t*)(p.ws + R_SV);
  float* Pc = (float*)p.out;
  float* Bc = (float*)((unsigned char*)p.out + OUT_BC);
  for (int it = blockIdx.x * 4 + warp; it < (NCH - 1) * 16; it += gridDim.x * 4) {
    const int chunk = it >> 4, pair = it & 15, dir = pair >> 3, head = pair & 7;
    f32x2 S[8][4], P[8][4], ka[4];
#pragma unroll
    for (int a = 0; a < 8; ++a)
#pragma unroll
      for (int c = 0; c < 4; ++c) {
        S[a][c] = f32x2{0.f, 0.f};
        P[a][c] = f32x2{(i * 8 + a == jg * 8 + 2 * c) ? 1.f : 0.f, (i * 8 + a == jg * 8 + 2 * c + 1) ? 1.f : 0.f};
      }
#pragma unroll
    for (int c = 0; c < 4; ++c) ka[c] = f32x2{p.in[I_RKA][head * 64 + jg * 8 + 2 * c], p.in[I_RKA][head * 64 + jg * 8 + 2 * c + 1]};
    RwVec nx;
    rw_load(nx, SV, rw_row(chunk * LCH, dir), head, dir, i, jg, false);
#pragma unroll 1
    for (int t = 0; t < LCH; ++t) {
      RwVec cu = nx;
      if (t + 1 < LCH) rw_load(nx, SV, rw_row(chunk * LCH + t + 1, dir), head, dir, i, jg, false);
      f32x2 kv[4], kk[4], w[4], av[4], kka[4], keff[4]; float vv[8];
      unpack8p(cu.k, kv); unpack8p(cu.kk, kk); unpack8p(cu.w, w); unpack8p(cu.a, av); unpack8(cu.v, vv);
#pragma unroll
      for (int c = 0; c < 4; ++c) {
        w[c] = f32x2{__builtin_amdgcn_exp2f(-w[c][0]), __builtin_amdgcn_exp2f(-w[c][1])};
        kka[c] = -kk[c] * av[c];
        keff[c] = kv[c] * (bc2(1.f) + (av[c] - bc2(1.f)) * ka[c]);
      }
#pragma unroll
      for (int a = 0; a < 8; ++a) {
        f32x2 sa = S[a][0] * kk[0], qa = P[a][0] * kk[0];
#pragma unroll
        for (int c = 1; c < 4; ++c) { sa += S[a][c] * kk[c]; qa += P[a][c] * kk[c]; }
        float s1 = allred8(sa[0] + sa[1]), q1 = allred8(qa[0] + qa[1]);
        const f32x2 s2 = bc2(s1), q2 = bc2(q1), v2 = bc2(vv[a]);
#pragma unroll
        for (int c = 0; c < 4; ++c) {
          S[a][c] = S[a][c] * w[c] + s2 * kka[c] + v2 * keff[c];
          P[a][c] = P[a][c] * w[c] + q2 * kka[c];
        }
      }
    }
    float* po = Pc + ((size_t)chunk * 16 + pair) * 4096;
    float* bo = Bc + ((size_t)chunk * 16 + pair) * 4096;
#pragma unroll
    for (int a = 0; a < 8; ++a) {
      *(float4*)(po + (i * 8 + a) * 64 + jg * 8) = make_float4(P[a][0][0], P[a][0][1], P[a][1][0], P[a][1][1]);
      *(float4*)(po + (i * 8 + a) * 64 + jg * 8 + 4) = make_float4(P[a][2][0], P[a][2][1], P[a][3][0], P[a][3][1]);
      *(float4*)(bo + (i * 8 + a) * 64 + jg * 8) = make_float4(S[a][0][0], S[a][0][1], S[a][1][0], S[a][1][1]);
      *(float4*)(bo + (i * 8 + a) * 64 + jg * 8 + 4) = make_float4(S[a][2][0], S[a][2][1], S[a][3][0], S[a][3][1]);
    }
  }
}

template <bool DRY> DEVI void phase8(const Params& p, unsigned char* smem) {
  const bool wr = !DRY || (p.in[I_FG][0] == 1234.5f);
  float(*Sb)[16][68] = (float(*)[16][68])smem;
  const int tid = threadIdx.x, lane = tid & 63, warp = tid >> 6, q = lane >> 4, c16 = lane & 15;
  const float* Pc = (const float*)p.out;
  float* Bc = (float*)((unsigned char*)p.out + OUT_BC);
  constexpr int NS = NCH - 1;
  const size_t CS = (size_t)16 * 4096;
  for (int it = blockIdx.x; it < 64; it += gridDim.x) {
    const int pair = it >> 2, rg = it & 3;
    const float* Pp = Pc + (size_t)pair * 4096 + q * 64 + warp * 16 + c16;
    float* Bp = Bc + (size_t)pair * 4096 + (size_t)(rg * 16 + q * 4) * 64 + warp * 16 + c16;
    __syncthreads();
    {
      const int row = tid >> 4, c4 = (tid & 15) * 4;
      float4 v = *(const float4*)(Bc + (size_t)pair * 4096 + (size_t)(rg * 16 + row) * 64 + c4);
      Sb[0][row][c4] = v.x; Sb[0][row][c4 + 1] = v.y; Sb[0][row][c4 + 2] = v.z; Sb[0][row][c4 + 3] = v.w;
    }
    float pa[16], pb[16]; f32x4 ba, bb;
#pragma unroll
    for (int s2 = 0; s2 < 16; ++s2) { pa[s2] = Pp[CS + s2 * 256]; pb[s2] = Pp[2 * CS + s2 * 256]; }
#pragma unroll
    for (int r = 0; r < 4; ++r) { ba[r] = Bp[CS + r * 64]; bb[r] = Bp[2 * CS + r * 64]; }
    __syncthreads();
#define P8_STEP(c, pp, bv)                                                                                  \
    {                                                                                                        \
      const int rb = ((c) - 1) & 1;                                                                          \
      f32x4 acc0 = bv, acc1 = f32x4{0.f, 0.f, 0.f, 0.f};                                                     \
      _Pragma("unroll") for (int s2 = 0; s2 < 16; s2 += 2) {                                                 \
        acc0 = __builtin_amdgcn_mfma_f32_16x16x4f32(Sb[rb][c16][4 * s2 + q], pp[s2], acc0, 0, 0, 0);         \
        acc1 = __builtin_amdgcn_mfma_f32_16x16x4f32(Sb[rb][c16][4 * s2 + 4 + q], pp[s2 + 1], acc1, 0, 0, 0); \
      }                                                                                                      \
      acc0 += acc1;                                                                                          \
      if ((c) + 2 < NS) {                                                                                    \
        _Pragma("unroll") for (int s2 = 0; s2 < 16; ++s2) pp[s2] = Pp[(size_t)((c) + 2) * CS + s2 * 256];    \
        _Pragma("unroll") for (int r = 0; r < 4; ++r) bv[r] = Bp[(size_t)((c) + 2) * CS + r * 64];           \
      }                                                                                                      \
      _Pragma("unroll") for (int r = 0; r < 4; ++r) {                                                        \
        Sb[rb ^ 1][q * 4 + r][warp * 16 + c16] = acc0[r];                                                    \
        if (wr) Bp[(size_t)(c) * CS + r * 64] = acc0[r];                                                     \
      }                                                                                                      \
      __syncthreads();                                                                                       \
    }
    for (int c = 1; c < NS; c += 2) {
      P8_STEP(c, pa, ba)
      if (c + 1 < NS) P8_STEP(c + 1, pb, bb)
    }
#undef P8_STEP
  }
}

DEVI void phase9(const Params& p) {
  const int lane = threadIdx.x & 63, warp = threadIdx.x >> 6, i = lane >> 3, jg = lane & 7;
  const bf16_t* SV = (const bf16_t*)(p.ws + R_SV);
  const float* Bc = (const float*)((unsigned char*)p.out + OUT_BC);
  bf16_t* odir = (bf16_t*)p.out;
  for (int it = blockIdx.x * 4 + warp; it < NCH * 16; it += gridDim.x * 4) {
    const int chunk = it >> 4, pair = it & 15, dir = pair >> 3, head = pair & 7;
    f32x2 S[8][4], ka[4];
    if (chunk == 0) {
#pragma unroll
      for (int a = 0; a < 8; ++a)
#pragma unroll
        for (int c = 0; c < 4; ++c) S[a][c] = f32x2{0.f, 0.f};
    } else {
      const float* bs = Bc + ((size_t)(chunk - 1) * 16 + pair) * 4096;
#pragma unroll
      for (int a = 0; a < 8; ++a) {
        float4 x0 = *(const float4*)(bs + (i * 8 + a) * 64 + jg * 8), x1 = *(const float4*)(bs + (i * 8 + a) * 64 + jg * 8 + 4);
        S[a][0] = f32x2{x0.x, x0.y}; S[a][1] = f32x2{x0.z, x0.w}; S[a][2] = f32x2{x1.x, x1.y}; S[a][3] = f32x2{x1.z, x1.w};
      }
    }
#pragma unroll
    for (int c = 0; c < 4; ++c) ka[c] = f32x2{p.in[I_RKA][head * 64 + jg * 8 + 2 * c], p.in[I_RKA][head * 64 + jg * 8 + 2 * c + 1]};
    RwVec nx;
    rw_load(nx, SV, rw_row(chunk * LCH, dir), head, dir, i, jg, true);
#pragma unroll 1
    for (int t = 0; t < LCH; ++t) {
      RwVec cu = nx;
      const int row = rw_row(chunk * LCH + t, dir);
      if (t + 1 < LCH) rw_load(nx, SV, rw_row(chunk * LCH + t + 1, dir), head, dir, i, jg, true);
      f32x2 kv[4], kk[4], w[4], av[4], rr[4], kka[4], keff[4]; float vv[8];
      unpack8p(cu.k, kv); unpack8p(cu.kk, kk); unpack8p(cu.w, w); unpack8p(cu.a, av); unpack8p(cu.r, rr); unpack8(cu.v, vv);
#pragma unroll
      for (int c = 0; c < 4; ++c) {
        w[c] = f32x2{__builtin_amdgcn_exp2f(-w[c][0]), __builtin_amdgcn_exp2f(-w[c][1])};
        kka[c] = -kk[c] * av[c];
        keff[c] = kv[c] * (bc2(1.f) + (av[c] - bc2(1.f)) * ka[c]);
      }
      float ov = 0.f;
#pragma unroll
      for (int a = 0; a < 8; ++a) {
        f32x2 sa = S[a][0] * kk[0];
#pragma unroll
        for (int c = 1; c < 4; ++c) sa += S[a][c] * kk[c];
        const float s1 = allred8(sa[0] + sa[1]);
        const f32x2 s2 = bc2(s1), v2 = bc2(vv[a]);
        f32x2 oa = f32x2{0.f, 0.f};
#pragma unroll
        for (int c = 0; c < 4; ++c) {
          S[a][c] = S[a][c] * w[c] + s2 * kka[c] + v2 * keff[c];
          oa += S[a][c] * rr[c];
        }
        const float o = allred8(oa[0] + oa[1]);
        if (jg == a) ov = o;
      }
      if (row >= T_CTX) odir[((size_t)dir * T_LAT + (row - T_CTX)) * 512 + head * 64 + i * 8 + jg] = f2bf(ov);
    }
  }
}

DEVI void phase10(const Params& p) {
  const int lane = threadIdx.x & 63, warp = threadIdx.x >> 6;
  const bf16_t* odir = (const bf16_t*)p.out;
  const bf16_t* SV = (const bf16_t*)(p.ws + R_SV);
  const float* bonus = (const float*)(p.ws + O_BONUS);
  bf16_t* ya = (bf16_t*)(p.ws + O_PO);
  const int head = lane >> 3, c8 = (lane & 7) * 8, C0 = lane * 8;
#pragma unroll 2
  for (int t = blockIdx.x * 4 + warp; t < T_LAT; t += gridDim.x * 4) {
    const int row = t + T_CTX;
    const bf16_t* b = SV + ((size_t)row * 8 + head) * SVH;
    float v[8], g[8], y[8];
    unpack8(*(const uint4*)(b + 2 * 64 + c8), v);
    unpack8(*(const uint4*)(b + 8 * 64 + c8), g);
    float bs = bonus[(size_t)row * 16 + head] + bonus[(size_t)row * 16 + 8 + head];
#pragma unroll
    for (int e = 0; e < 8; ++e) y[e] = bs * v[e];
#pragma unroll
    for (int dir = 0; dir < 2; ++dir) {
      float o[8];
      unpack8(*(const uint4*)(odir + ((size_t)dir * T_LAT + t) * 512 + C0), o);
      float s = 0.f;
#pragma unroll
      for (int e = 0; e < 8; ++e) s += o[e];
      s = allred8(s);
      float mu = s * (1.f / 64.f);
      float q = 0.f;
#pragma unroll
      for (int e = 0; e < 8; ++e) { o[e] -= mu; q += o[e] * o[e]; }
      q = allred8(q);
      float rsd = rsqrtf(q * (1.f / 64.f) + 64e-5f);
#pragma unroll
      for (int e = 0; e < 8; ++e) y[e] += o[e] * rsd * p.in[I_RLNW][C0 + e] + p.in[I_RLNB][C0 + e];
    }
#pragma unroll
    for (int e = 0; e < 8; ++e) y[e] *= g[e];
    *(uint4*)(ya + (size_t)t * 512 + C0) = pack8(y);
  }
}

DEVI void phase11(const Params& p, unsigned char* smem, const XcdMap& xm) {
  const int lane = threadIdx.x & 63, warp = threadIdx.x >> 6, wm = warp >> 1, wn = warp & 1;
  const bf16_t* ya = (const bf16_t*)(p.ws + O_PO);
  const bf16_t* yb = (const bf16_t*)(p.ws + R_YA);
  const bf16_t* pg = (const bf16_t*)(p.ws + O_PG);
  bf16_t* mg = (bf16_t*)(p.ws + R_MERGED);
  for_tiles_xcd(xm, 128, 8, 8, 8, [&](int mt, int nt) {
    f32x4 acc[4][4];
    zero_acc(acc);
    gemm_core(ya + (size_t)mt * 128 * 512, 512, (const bf16_t*)(p.ws + O_WBA) + (size_t)nt * 128 * 512, 512, 512, acc, smem);
#pragma unroll
    for (int i = 0; i < 4; ++i) {
      int row = mt * 128 + wm * 64 + i * 16 + (lane & 15);
#pragma unroll
      for (int j = 0; j < 4; ++j) {
        int n = nt * 128 + wn * 64 + j * 16 + (lane >> 4) * 4;
        uint2 s = *(const uint2*)(pg + (size_t)row * 2048 + n);
        *(uint2*)(mg + (size_t)row * 1024 + n) = make_uint2(pack2(acc[i][j][0] * bflo(s.x), acc[i][j][1] * bfhi(s.x)), pack2(acc[i][j][2] * bflo(s.y), acc[i][j][3] * bfhi(s.y)));
      }
    }
    zero_acc(acc);
    gemm_core(yb + (size_t)mt * 128 * 512, 512, (const bf16_t*)(p.ws + O_WBB) + (size_t)nt * 128 * 512, 512, 512, acc, smem);
#pragma unroll
    for (int i = 0; i < 4; ++i) {
      int row = mt * 128 + wm * 64 + i * 16 + (lane & 15);
#pragma unroll
      for (int j = 0; j < 4; ++j) {
        int n = nt * 128 + wn * 64 + j * 16 + (lane >> 4) * 4;
        uint2 s = *(const uint2*)(pg + (size_t)row * 2048 + 1024 + n);
        uint2 m0 = *(const uint2*)(mg + (size_t)row * 1024 + n);
        float v0 = bflo(m0.x) + acc[i][j][0] * bflo(s.x), v1 = bfhi(m0.x) + acc[i][j][1] * bfhi(s.x);
        float v2 = bflo(m0.y) + acc[i][j][2] * bflo(s.y), v3 = bfhi(m0.y) + acc[i][j][3] * bfhi(s.y);
        *(uint2*)(mg + (size_t)row * 1024 + n) = make_uint2(pack2(v0, v1), pack2(v2, v3));
      }
    }
  });
}

DEVI void phase12(const Params& p, unsigned char* smem, const XcdMap& xm) {
  float* gt = (float*)(smem + 45056);
  const int tid = threadIdx.x, lane = tid & 63, warp = tid >> 6, wm = warp >> 1, wn = warp & 1;
  for (int i = tid; i < 1024; i += 256) gt[i] = mod_val(p, 0, 2048 + i);
  __syncthreads();
  const bf16_t* mg = (const bf16_t*)(p.ws + R_MERGED);
  const float* x = p.in[I_X];
  float* x1 = p.out;
  for_tiles_xcd(xm, 128, 8, 8, 8, [&](int mt, int nt) {
    f32x4 acc[4][4];
    zero_acc(acc);
    gemm_core(mg + (size_t)mt * 128 * 1024, 1024, (const bf16_t*)(p.ws + O_WOUT) + (size_t)nt * 128 * 1024, 1024, 1024, acc, smem);
#pragma unroll
    for (int i = 0; i < 4; ++i) {
      int row = mt * 128 + wm * 64 + i * 16 + (lane & 15);
#pragma unroll
      for (int j = 0; j < 4; ++j) {
        int n = nt * 128 + wn * 64 + j * 16 + (lane >> 4) * 4;
        float4 xv = *(const float4*)(x + (size_t)row * 1024 + n);
        xv.x += gt[n] * acc[i][j][0]; xv.y += gt[n + 1] * acc[i][j][1]; xv.z += gt[n + 2] * acc[i][j][2]; xv.w += gt[n + 3] * acc[i][j][3];
        *(float4*)(x1 + (size_t)row * 1024 + n) = xv;
      }
    }
  });
}

DEVI void phase13(const Params& p, unsigned char* smem) {
  float* smod = (float*)smem;
  const int tid = threadIdx.x, lane = tid & 63, warp = tid >> 6;
  for (int i = tid; i < 2048; i += 256) smod[i] = mod_val(p, 0, 3072 + i);
  __syncthreads();
  const float* x1 = p.out;
  bf16_t* h2 = (bf16_t*)(p.ws + R_H2);
  for (int rp = blockIdx.x * 4 + warp; rp < T_LAT / 2; rp += gridDim.x * 4) {
    float h[2][16]; float ss[2] = {0.f, 0.f};
#pragma unroll
    for (int u = 0; u < 2; ++u)
#pragma unroll
      for (int i = 0; i < 4; ++i) {
        float4 v = *(const float4*)(x1 + (size_t)(rp * 2 + u) * 1024 + i * 256 + lane * 4);
        h[u][4 * i] = v.x; h[u][4 * i + 1] = v.y; h[u][4 * i + 2] = v.z; h[u][4 * i + 3] = v.w;
        ss[u] += v.x * v.x + v.y * v.y + v.z * v.z + v.w * v.w;
      }
#pragma unroll
    for (int u = 0; u < 2; ++u) {
      const int row = rp * 2 + u;
      const float rstd = rsqrtf(wave_sum_u(ss[u]) * (1.f / 1024.f) + 1e-6f);
#pragma unroll
      for (int i = 0; i < 4; ++i) {
#pragma unroll
        for (int e = 0; e < 4; ++e) {
          int k = i * 256 + lane * 4 + e;
          float y = h[u][4 * i + e] * rstd * p.in[I_N2G][k];
          h[u][4 * i + e] = y * (1.f + smod[1024 + k]) + smod[k];
        }
        *(uint2*)(h2 + (size_t)row * 1024 + i * 256 + lane * 4) = make_uint2(pack2(h[u][4 * i], h[u][4 * i + 1]), pack2(h[u][4 * i + 2], h[u][4 * i + 3]));
      }
    }
  }
}

DEVI void phase14(const Params& p, unsigned char* smem, const XcdMap& xm) {
  bf16_t(*Qt)[136] = (bf16_t(*)[136])smem;
  float* Sc = (float*)smem;
  const int tid = threadIdx.x, lane = tid & 63, warp = tid >> 6, wm = warp >> 1, wn = warp & 1;
  const bf16_t* h2 = (const bf16_t*)(p.ws + R_H2);
  const bf16_t* keys = (const bf16_t*)(p.ws + O_KEYS);
  float* tops = (float*)(p.ws + R_TOPS);
  int* topi = (int*)(p.ws + R_TOPI);
  for_tiles_xcd(xm, 128, 16, 8, 8, [&](int mt, int hp) {
    f32x4 acc[4][4];
    zero_acc(acc);
    gemm_core(h2 + (size_t)mt * 128 * 1024, 1024, (const bf16_t*)(p.ws + O_WQ) + (size_t)hp * 128 * 1024, 1024, 1024, acc, smem);
#pragma unroll
    for (int i = 0; i < 4; ++i)
#pragma unroll
      for (int j = 0; j < 4; ++j)
        *(uint2*)&Qt[wm * 64 + i * 16 + (lane & 15)][wn * 64 + j * 16 + (lane >> 4) * 4] =
            make_uint2(pack2(acc[i][j][0], acc[i][j][1]), pack2(acc[i][j][2], acc[i][j][3]));
    __syncthreads();
    zero_acc(acc);
#pragma unroll
    for (int ks = 0; ks < 4; ++ks) {
      bf16x8 qf[4], kf[4];
#pragma unroll
      for (int i = 0; i < 4; ++i) qf[i] = *(const bf16x8*)&Qt[wm * 64 + i * 16 + (lane & 15)][ks * 32 + (lane >> 4) * 8];
#pragma unroll
      for (int j = 0; j < 4; ++j) kf[j] = *(const bf16x8*)(keys + ((size_t)hp * 128 + wn * 64 + j * 16 + (lane & 15)) * 128 + ks * 32 + (lane >> 4) * 8);
#pragma unroll
      for (int i = 0; i < 4; ++i)
#pragma unroll
        for (int j = 0; j < 4; ++j) acc[i][j] = __builtin_amdgcn_mfma_f32_16x16x32_bf16(kf[j], qf[i], acc[i][j], 0, 0, 0);
    }
    __syncthreads();
#pragma unroll
    for (int i = 0; i < 4; ++i)
#pragma unroll
      for (int j = 0; j < 4; ++j) {
        *(f32x4*)(Sc + (wm * 64 + i * 16 + (lane & 15)) * 132 + wn * 64 + j * 16 + (lane >> 4) * 4) = acc[i][j];
      }
    __syncthreads();
    {
      const int row = tid & 127, half = tid >> 7;
      float* hp_ = Sc + row * 132 + half * 64;
      float bv[16]; int bi[16];
#pragma unroll
      for (int r = 0; r < 16; ++r) {
        float best = -INFINITY; int b2 = 0;
#pragma unroll 4
        for (int k = 0; k < 64; k += 4) {
          const f32x4 v4 = *(const f32x4*)(hp_ + k);
          if (v4[0] > best) { best = v4[0]; b2 = k; }
          if (v4[1] > best) { best = v4[1]; b2 = k + 1; }
          if (v4[2] > best) { best = v4[2]; b2 = k + 2; }
          if (v4[3] > best) { best = v4[3]; b2 = k + 3; }
        }
        bv[r] = best; bi[r] = b2 + half * 64; hp_[b2] = -INFINITY;
      }
#pragma unroll
      for (int r = 0; r < 16; ++r) { hp_[r] = bv[r]; hp_[16 + r] = __int_as_float(bi[r]); }
    }
    __syncthreads();
    if (tid < 128) {
      const float* la = Sc + tid * 132; const float* lb = la + 64;
      size_t ob = ((size_t)(mt * 128 + tid) * 16 + hp) * 16;
      int ia = 0, ib = 0;
      for (int r = 0; r < 16; ++r) {
        float va = la[ia], vb = lb[ib];
        bool ta = va >= vb;
        tops[ob + r] = ta ? va : vb;
        topi[ob + r] = __float_as_int(ta ? la[16 + ia] : lb[16 + ib]);
        ia += ta ? 1 : 0; ib += ta ? 0 : 1;
      }
    }
    __syncthreads();
  });
}

template <bool DRY> DEVI void phase15(const Params& p, unsigned char* smem) {
  const bool wr = !DRY || (p.in[I_FG][0] == 1234.5f);
  float* gt = (float*)smem;
  const int tid = threadIdx.x, lane = tid & 63, warp = tid >> 6;
  for (int i = tid; i < 1024; i += 256) gt[i] = mod_val(p, 0, 5120 + i);
  __syncthreads();
  const bf16_t* __restrict__ h2 = (const bf16_t*)(p.ws + R_H2);
  const float* __restrict__ tops = (const float*)(p.ws + R_TOPS);
  const int* __restrict__ topi = (const int*)(p.ws + R_TOPI);
  const unsigned char* __restrict__ uf8 = p.ws + R_UBF;
  const unsigned char* __restrict__ vf8 = p.ws + R_VBF;
  float* xo = p.out;
  int ca, cb;
  {
    int l = lane;
    if (l < 16) { ca = 0; cb = l; } else if (l < 24) { ca = 1; cb = l - 16; } else if (l < 29) { ca = 2; cb = l - 24; }
    else if (l < 33) { ca = 3; cb = l - 29; } else if (l < 36) { ca = 4; cb = l - 33; } else if (l < 38) { ca = 5; cb = l - 36; }
    else if (l < 40) { ca = 6; cb = l - 38; } else if (l < 42) { ca = 7; cb = l - 40; } else if (l < 50) { ca = l - 34; cb = 0; }
    else { ca = 0; cb = 0; }
  }
  const int flat = ca * 16 + cb;
  for (int t = blockIdx.x * 4 + warp; t < T_LAT; t += gridDim.x * 4) {
    float hv[16], out[16];
    {
      const u32x4 hp0 = *(const u32x4*)(h2 + (size_t)t * 1024 + lane * 16);
      const u32x4 hp1 = *(const u32x4*)(h2 + (size_t)t * 1024 + lane * 16 + 8);
#pragma unroll
      for (int e = 0; e < 4; ++e) { hv[2 * e] = bflo(hp0[e]); hv[2 * e + 1] = bfhi(hp0[e]); hv[8 + 2 * e] = bflo(hp1[e]); hv[8 + 2 * e + 1] = bfhi(hp1[e]); }
    }
#pragma unroll
    for (int e = 0; e < 16; ++e) out[e] = 0.f;
#pragma unroll 1
    for (int hd = 0; hd < 8; ++hd) {
      const size_t b1 = ((size_t)t * 16 + hd * 2) * 16, b2 = b1 + 16;
      float val = lane < 50 ? tops[b1 + ca] + tops[b2 + cb] : -INFINITY;
      int idx = topi[b1 + ca] * 128 + topi[b2 + cb];
      int cnt = 0;
#pragma unroll
      for (int i = 0; i < 50; ++i) {
        float vi = rlf(val, i);
        int fi = __builtin_amdgcn_readlane(flat, i);
        cnt += ((vi > val) || (vi == val && fi < flat)) ? 1 : 0;
      }
      bool sel = lane < 50 && cnt < 16;
      float vmax = rlf(val, 0);
      float ex = sel ? __expf(val - vmax) : 0.f;
      float gsum = wave_sum_u(ex);
      float g = ex / gsum;
      unsigned long long m1 = __ballot(sel);
      int es[16];
      float gq = 0.f;
#pragma unroll
      for (int q = 0; q < 16; ++q) {
        int src = __ffsll((long long)m1) - 1; m1 &= m1 - 1;
        es[q] = __builtin_amdgcn_readlane(idx, src);
        float gg = rlf(g, src);
        if (lane == q) gq = gg;
      }
      float dm = 0.f;
      {
        u32x4 ub[16];
#pragma unroll
        for (int q = 0; q < 16; ++q) ub[q] = *(const u32x4*)(uf8 + (size_t)es[q] * 1024 + lane * 16);
#pragma unroll
        for (int q = 0; q < 16; ++q) {
          float f[16]; unpack_fp8x16(ub[q], f);
          float d0 = 0.f, d1 = 0.f;
#pragma unroll
          for (int e = 0; e < 8; ++e) { d0 += f[2 * e] * hv[2 * e]; d1 += f[2 * e + 1] * hv[2 * e + 1]; }
          float d = wave_sum_u(d0 + d1);
          if (lane == q) dm = d;
        }
      }
      dm *= (1.f / 64.f);
      float coef = gq * 0.5f * dm * (1.f + erff(dm * 0.70710678118f)) * 0.25f;
      {
        u32x4 vb[16];
#pragma unroll
        for (int q = 0; q < 16; ++q) vb[q] = *(const u32x4*)(vf8 + (size_t)es[q] * 1024 + lane * 16);
#pragma unroll
        for (int q = 0; q < 16; ++q) {
          float cf = rlf(coef, q);
          float f[16]; unpack_fp8x16(vb[q], f);
#pragma unroll
          for (int e = 0; e < 16; ++e) out[e] += cf * f[e];
        }
      }
    }
    float xs[16]; float ss = 0.f;
#pragma unroll
    for (int i = 0; i < 4; ++i) {
      int k = lane * 16 + i * 4;
      float4 v = *(const float4*)(xo + (size_t)t * 1024 + k);
      xs[4 * i] = v.x + gt[k] * out[4 * i]; xs[4 * i + 1] = v.y + gt[k + 1] * out[4 * i + 1];
      xs[4 * i + 2] = v.z + gt[k + 2] * out[4 * i + 2]; xs[4 * i + 3] = v.w + gt[k + 3] * out[4 * i + 3];
      ss += xs[4 * i] * xs[4 * i] + xs[4 * i + 1] * xs[4 * i + 1] + xs[4 * i + 2] * xs[4 * i + 2] + xs[4 * i + 3] * xs[4 * i + 3];
    }
    ss = wave_sum_u(ss);
    float rstd = rsqrtf(ss * (1.f / 1024.f) + 1e-6f);
#pragma unroll
    for (int i = 0; i < 4; ++i) {
      int k = lane * 16 + i * 4;
      float4 g4 = *(const float4*)(p.in[I_FG] + k);
      if (wr) *(float4*)(xo + (size_t)t * 1024 + k) = make_float4(xs[4 * i] * rstd * g4.x, xs[4 * i + 1] * rstd * g4.y, xs[4 * i + 2] * rstd * g4.z, xs[4 * i + 3] * rstd * g4.w);
    }
  }
}

#define XB_TMO      128
#define XB_XCNT(j)  (256  + 64 * (j))
#define XB_XSUB(j)  (1280 + 64 * (j))
#define XB_XGEN(j)  (2304 + 64 * (j))
#define XB_TOP      3328
#define XB_TOPGEN   3392
#define XCD_BAR_WORDS 3456
#define XB_SPIN_CAP (1u << 22)
#define LAS __attribute__((address_space(3)))
DEVI unsigned xb_ld(unsigned* p) { return __hip_atomic_load(p, __ATOMIC_RELAXED, __HIP_MEMORY_SCOPE_AGENT); }
DEVI unsigned xb_add(unsigned* p, unsigned v) { return __hip_atomic_fetch_add(p, v, __ATOMIC_RELAXED, __HIP_MEMORY_SCOPE_AGENT); }
DEVI unsigned xb_xcc_id() { return (unsigned)__builtin_amdgcn_s_getreg((3 << 11) | 20) & 0xFu; }
#define XB_SPIN(cond, bar) do { unsigned _sp = 0; while (cond) { __builtin_amdgcn_s_sleep(1); \
    if ((++_sp & 255u) == 0u) { if (xb_ld(&(bar)[XB_TMO])) break; if (_sp > XB_SPIN_CAP) { atomicAdd(&(bar)[XB_TMO], 1u); break; } } } } while (0)
struct XcdBarrier { unsigned* bar; unsigned x; volatile LAS unsigned* st; };
DEVI XcdBarrier xcd_barrier_post(unsigned* bar, volatile LAS unsigned* st) {
  XcdBarrier b; b.bar = bar; b.x = xb_xcc_id(); b.st = st;
  if (threadIdx.x == 0) st[2] = xb_add(&bar[XB_XCNT(b.x)], 1u);
  return b;
}
DEVI void xcd_barrier_complete(unsigned* bar, unsigned x, unsigned& nloc, unsigned& nx, unsigned& vidx) {
  const unsigned G = gridDim.x * gridDim.y * gridDim.z;
  unsigned sum, cnt, mine, below, sp = 0u;
  for (;;) {
    sum = 0u; cnt = 0u; mine = 0u; below = 0u;
#pragma unroll
    for (unsigned j = 0; j < 16; ++j) { const unsigned c = xb_ld(&bar[XB_XCNT(j)]); sum += c; cnt += (c > 0u) ? 1u : 0u; mine = (j == x) ? c : mine; below += (c > 0u && j < x) ? 1u : 0u; }
    if (sum == G) break;
    __builtin_amdgcn_s_sleep(1);
    if ((++sp & 255u) == 0u) { if (xb_ld(&bar[XB_TMO])) break; if (sp > XB_SPIN_CAP) { atomicAdd(&bar[XB_TMO], 1u); break; } }
  }
  nloc = mine > 0u ? mine : 1u; nx = cnt > 0u ? cnt : 1u; vidx = below;
}
DEVI void xcd_barrier(const XcdBarrier& b) {
  asm volatile("s_waitcnt vmcnt(0)" ::: "memory");
  __syncthreads();
  if (threadIdx.x == 0) {
    unsigned* bar = b.bar;
    __builtin_amdgcn_s_waitcnt(0);
    unsigned nloc = b.st[0], nx = b.st[1];
    if (nloc == 0u) { unsigned vidx; xcd_barrier_complete(bar, b.x, nloc, nx, vidx); b.st[0] = nloc; b.st[1] = nx; b.st[3] = vidx; }
    const unsigned old = xb_add(&bar[XB_XSUB(b.x)], 1u);
    const unsigned gen = old / nloc;
    if (old + 1u == (gen + 1u) * nloc) {
      __builtin_amdgcn_fence(__ATOMIC_RELEASE, "agent");
      asm volatile("s_waitcnt vmcnt(0)" ::: "memory");
      const unsigned og = xb_add(&bar[XB_TOP], 1u);
      const unsigned tg = og / nx;
      if (og + 1u == (tg + 1u) * nx) xb_add(&bar[XB_TOPGEN], 1u);
      else XB_SPIN(xb_ld(&bar[XB_TOPGEN]) == tg, bar);
      __builtin_amdgcn_fence(__ATOMIC_ACQUIRE, "agent");
      xb_add(&bar[XB_XGEN(b.x)], 1u);
      asm volatile("s_waitcnt vmcnt(0)" ::: "memory");
    } else {
      XB_SPIN(xb_ld(&bar[XB_XGEN(b.x)]) == gen, bar);
      __builtin_amdgcn_fence(__ATOMIC_ACQUIRE, "agent");
      asm volatile("s_waitcnt vmcnt(0)" ::: "memory");
    }
  }
  __syncthreads();
}

constexpr int NPHASE = 16;
DEVI XcdMap get_xm(int coop, const uint4& w) {
  XcdMap m;
  if (coop) { m.v = (int)w.w; m.nx = (int)w.y; m.slot = (int)w.z; m.slots = (int)w.x; }
  else { m.v = blockIdx.x & 7; m.nx = 8; m.slot = blockIdx.x >> 3; m.slots = gridDim.x >> 3; if (m.slots < 1) { m.slots = 1; } }
  return m;
}
__global__ void __launch_bounds__(256, 2) mk(Params p, int ph0, int ph1, int coop) {
  __shared__ __attribute__((aligned(16))) unsigned char smem[SMEM_BYTES];
  __shared__ uint4 xb_words;
  if (threadIdx.x == 0) xb_words = make_uint4(0u, 0u, 0u, 0u);
  __syncthreads();
  XcdBarrier xb;
  if (coop) xb = xcd_barrier_post((unsigned*)(p.ws + O_BAR), (volatile LAS unsigned*)&xb_words);
#ifdef XCC_PROBE
  if (coop && xb_xcc_id() != (blockIdx.x & 7u)) { unsigned long long t0 = wall_clock64(); while (wall_clock64() - t0 < 100000ull) __builtin_amdgcn_s_sleep(8); }
#endif
  if (ph0 < 0) cg::this_grid().sync();
#ifdef PROBE_A
#define STAMP(n) if (blockIdx.x == 0 && threadIdx.x == 0) ((unsigned long long*)(p.ws + O_STAMP))[n] = wall_clock64();
#else
#define STAMP(n)
#endif
#define RUN_PHASE(n, call)                                   \
  if (ph0 <= n && n < ph1) {                                 \
    STAMP(n)                                                 \
        if (DRY_PH == n) { if (n == 4) phase4<true>(p); if (n == 5) phase5<true>(p, smem); if (n == 8) phase8<true>(p, smem); if (n == 15) phase15<true>(p, smem); } \
    if (ONLY < 0 || ONLY == n) { call; }                     \
    if (REPEAT_PH == n) { call; }                            \
    if (coop && n + 1 < ph1) xcd_barrier(xb);                \
  }
  RUN_PHASE(0, phase0(p, smem, 0, 384))
  RUN_PHASE(1, (phase1(p, smem), __syncthreads(), phase0(p, smem, 384, 1 << 30)))
  RUN_PHASE(2, phase2(p, smem, get_xm(coop, xb_words)))
  RUN_PHASE(3, phase3(p, smem))
  RUN_PHASE(4, (phase4<false>(p), phase6(p, smem, 0, 32, gridDim.x > 290 ? 258 : 0, gridDim.x > 290 ? (int)gridDim.x - 258 : (int)gridDim.x)))
  RUN_PHASE(5, phase5<false>(p, smem))
  RUN_PHASE(6, phase6(p, smem, 32, 260 * 8, 0, (int)gridDim.x))
  RUN_PHASE(7, phase7(p))
  RUN_PHASE(8, phase8<false>(p, smem))
  RUN_PHASE(9, phase9(p))
  RUN_PHASE(10, phase10(p))
  RUN_PHASE(11, phase11(p, smem, get_xm(coop, xb_words)))
  RUN_PHASE(12, (phase12(p, smem, get_xm(coop, xb_words)), convert_fp8(p.in[I_PU], p.ws + R_UBF, (size_t)16384 * 64, 64.f)))
  RUN_PHASE(13, phase13(p, smem))
  RUN_PHASE(14, (phase14(p, smem, get_xm(coop, xb_words)), convert_fp8(p.in[I_PV], p.ws + R_VBF, (size_t)16384 * 64, 4.f)))
  RUN_PHASE(15, phase15<false>(p, smem))
#ifdef SYNC_EXTRA
  for (int i = 0; i < SYNC_EXTRA; ++i) xcd_barrier(xb);
#endif
#ifdef PROBE_A
  cg::this_grid().sync();
  STAMP(16)
  __syncthreads();
  if (blockIdx.x == 0) {
    const unsigned long long* st = (const unsigned long long*)(p.ws + O_STAMP);
    float ta = (float)(st[PROBE_A + 1] - st[PROBE_A]) * 0.01f, tb = (float)(st[PROBE_B + 1] - st[PROBE_B]) * 0.01f;
    for (int i = threadIdx.x; i < 1000000; i += 256) p.out[1 + i] = tb;
    if (threadIdx.x == 0) p.out[0] = 100.f * ta;
  }
#endif
}

extern "C" void kernel_launch(void* const* d_in, const int* in_sizes, int n_in, void* d_out, int out_size, void* d_ws,
                              size_t ws_size, hipStream_t stream) {
  static int grid_blocks = 0;
  if (!grid_blocks) {
    int dev = 0, cus = 0, per_cu = 0;
    hipGetDevice(&dev);
    hipDeviceGetAttribute(&cus, hipDeviceAttributeMultiprocessorCount, dev);
    hipOccupancyMaxActiveBlocksPerMultiprocessor(&per_cu, mk, 256, 0);
    if (per_cu < 1) per_cu = 1;
    if (per_cu > 2) per_cu = 2;
    grid_blocks = cus * per_cu;
  }
  if (ws_size < WS_NEED) { fprintf(stderr, "workspace too small: %zu < %zu\n", ws_size, (size_t)WS_NEED); return; }
  Params p{};
  for (int i = 0; i < 32; ++i) p.in[i] = (const float*)d_in[i];
  p.out = (float*)d_out;
  p.ws = (unsigned char*)d_ws;
#if MEGA
  (void)hipMemsetAsync((unsigned char*)d_ws + O_BAR, 0, XCD_BAR_WORDS * 4, stream);
  int ph0 = 0, ph1 = NPHASE, coop = 1;
  void* args[] = {&p, &ph0, &ph1, &coop};
  hipError_t e = hipLaunchCooperativeKernel((void*)mk, dim3(grid_blocks), dim3(256), args, 0, stream);
  if (e != hipSuccess) fprintf(stderr, "cooperative launch failed: %s (grid %d)\n", hipGetErrorString(e), grid_blocks);
#else
  for (int ph = 0; ph < NPHASE; ++ph) mk<<<grid_blocks, 256, 0, stream>>>(p, ph, ph + 1, 0);
#endif
}
```

```cpp
#include <hip/hip_runtime.h>
#include <hip/hip_cooperative_groups.h>
#include <cstdio>
#include <cstdint>
namespace cg = cooperative_groups;

#ifndef MEGA
#define MEGA 1
#endif
#ifndef ONLY
#define ONLY -1
#endif
#ifndef REPEAT_PH
#define REPEAT_PH -1
#endif
#ifndef DRY_PH
#define DRY_PH -1
#endif

typedef unsigned short bf16_t;
using bf16x8 = __attribute__((ext_vector_type(8))) short;
using f32x4 = __attribute__((ext_vector_type(4))) float;
using u32x4 = __attribute__((ext_vector_type(4))) unsigned;
#define DEVI __device__ __forceinline__

constexpr int T_CTX = 256, T_LAT = 16384, T_ALL = 16640;
constexpr int NIN = 5392, NP = 5376;
constexpr int NCH = 128, LCH = 130;
constexpr int SVH = 576;
constexpr int SMEM_BYTES = 71680;

enum { I_X = 0, I_C, I_CTX, I_CCTX, I_ADAW, I_ADAB, I_N1G, I_WIN, I_RCONV, I_RW0, I_RWUP, I_RA0, I_RAUP, I_RGUP,
       I_RKK, I_RKA, I_RRK, I_RLNW, I_RLNB, I_MCONV, I_MIB, I_MFB, I_MNG, I_WBA, I_WBB, I_WOUT, I_N2G, I_WQ,
       I_KEYS, I_PU, I_PV, I_FG };

struct Params { const float* in[32]; float* out; unsigned char* ws; };

constexpr size_t A256(size_t x) { return (x + 255) & ~(size_t)255; }
constexpr size_t O_MODP = 0;
constexpr size_t O_WBA = A256(O_MODP + (size_t)16 * 2 * 6144 * 4);
constexpr size_t O_WBB = A256(O_WBA + (size_t)1024 * 512 * 2);
constexpr size_t O_WOUT = A256(O_WBB + (size_t)1024 * 512 * 2);
constexpr size_t O_WQ = A256(O_WOUT + (size_t)1024 * 1024 * 2);
constexpr size_t O_KEYS = A256(O_WQ + (size_t)2048 * 1024 * 2);
constexpr size_t O_WUP = A256(O_KEYS + (size_t)16 * 128 * 128 * 2);
constexpr size_t O_AUP = A256(O_WUP + (size_t)1024 * 64 * 2);
constexpr size_t O_GUP = A256(O_AUP + (size_t)1024 * 64 * 2);
constexpr size_t O_BEND = A256(O_GUP + (size_t)512 * 128 * 2);
constexpr size_t O_MLOC = A256(O_BEND + (size_t)260 * 8 * 4);
constexpr size_t O_MST = A256(O_MLOC + (size_t)260 * 8 * 4);
constexpr size_t O_NT = A256(O_MST + (size_t)260 * 8 * 4);
constexpr size_t O_BONUS = A256(O_NT + (size_t)260 * 8 * 64 * 4);
constexpr size_t O_STAMP = A256(O_BONUS + (size_t)T_ALL * 16 * 4);
constexpr size_t O_BAR = A256(O_STAMP + 1024);
constexpr size_t O_PG = A256(O_BAR + 3456 * 4);
constexpr size_t O_PO = A256(O_PG + (size_t)T_LAT * 2048 * 2);
constexpr size_t O_R = A256(O_PO + (size_t)T_LAT * 512 * 2);
constexpr size_t R_HX = O_R;
constexpr size_t R_WIN = A256(R_HX + (size_t)T_ALL * 1024 * 2);
constexpr size_t R_PQK = A256(R_WIN + (size_t)(NP + 128) * 1024 * 2);
constexpr size_t R_PV = A256(R_PQK + (size_t)T_ALL * 512 * 2);
constexpr size_t R_GIF = A256(R_PV + (size_t)T_ALL * 512 * 2);
constexpr size_t R_U = A256(R_GIF + (size_t)T_ALL * 16 * 4);
constexpr size_t R_END1 = A256(R_U + (size_t)260 * 8 * 8192 * 4);
constexpr size_t R_SV = O_R;
constexpr size_t R_YA = A256(R_SV + (size_t)T_ALL * 8 * SVH * 2);
constexpr size_t R_END2 = A256(R_YA + (size_t)T_LAT * 512 * 2);
constexpr size_t R_MERGED = O_R;
constexpr size_t R_H2 = A256(R_MERGED + (size_t)T_LAT * 1024 * 2);
constexpr size_t R_TOPS = A256(R_H2 + (size_t)T_LAT * 1024 * 2);
constexpr size_t R_TOPI = A256(R_TOPS + (size_t)T_LAT * 256 * 4);
constexpr size_t R_UBF = A256(R_TOPI + (size_t)T_LAT * 256 * 4);
constexpr size_t R_VBF = A256(R_UBF + (size_t)16384 * 1024 * 2);
constexpr size_t R_END3 = A256(R_VBF + (size_t)16384 * 1024 * 2);
constexpr size_t WS_NEED = (R_END1 > R_END2 ? (R_END1 > R_END3 ? R_END1 : R_END3) : (R_END2 > R_END3 ? R_END2 : R_END3));
constexpr size_t OUT_BC = (size_t)NCH * 16 * 4096 * 4;

DEVI bf16_t f2bf(float f) { unsigned u = __float_as_uint(f); u += 0x7fffu + ((u >> 16) & 1u); return (bf16_t)(u >> 16); }
DEVI float bf2f(bf16_t h) { return __uint_as_float(((unsigned)h) << 16); }
DEVI float bflo(unsigned u) { return __uint_as_float(u << 16); }
DEVI float bfhi(unsigned u) { return __uint_as_float(u & 0xffff0000u); }
DEVI unsigned pack2(float a, float b) { return (unsigned)f2bf(a) | ((unsigned)f2bf(b) << 16); }
DEVI void unpack8(const uint4& u, float* f) {
  f[0] = bflo(u.x); f[1] = bfhi(u.x); f[2] = bflo(u.y); f[3] = bfhi(u.y);
  f[4] = bflo(u.z); f[5] = bfhi(u.z); f[6] = bflo(u.w); f[7] = bfhi(u.w);
}
DEVI uint4 pack8(const float* f) { return make_uint4(pack2(f[0], f[1]), pack2(f[2], f[3]), pack2(f[4], f[5]), pack2(f[6], f[7])); }
DEVI float wave_sum(float v) {
#pragma unroll
  for (int o = 32; o; o >>= 1) v += __shfl_xor(v, o);
  return v;
}
DEVI float wave_max(float v) {
#pragma unroll
  for (int o = 32; o; o >>= 1) v = fmaxf(v, __shfl_xor(v, o));
  return v;
}
DEVI float sigm(float x) { return 1.f / (1.f + __expf(-x)); }
DEVI float siluf(float x) { return x / (1.f + __expf(-x)); }
DEVI float logsig(float x) { return fminf(x, 0.f) - log1pf(expf(-fabsf(x))); }
template <int CTRL> DEVI float dppf(float v) { return __int_as_float(__builtin_amdgcn_update_dpp(0, __float_as_int(v), CTRL, 0xf, 0xf, true)); }
DEVI float rlf(float v, int l) { return __int_as_float(__builtin_amdgcn_readlane(__float_as_int(v), l)); }
DEVI float wave_sum_u(float v) {
  v += dppf<0xB1>(v); v += dppf<0x4E>(v); v += dppf<0x141>(v); v += dppf<0x140>(v);
  return (rlf(v, 0) + rlf(v, 16)) + (rlf(v, 32) + rlf(v, 48));
}
typedef __attribute__((ext_vector_type(2))) short s16x2;
DEVI float dot2bf(unsigned a, unsigned b, float c) { return __builtin_amdgcn_fdot2_f32_bf16(__builtin_bit_cast(s16x2, a), __builtin_bit_cast(s16x2, b), c, false); }
typedef __attribute__((ext_vector_type(2))) float f32x2;
DEVI void convert_fp8(const float* __restrict__ src, unsigned char* __restrict__ dst, size_t n16, float scale) {
  for (size_t g = (size_t)blockIdx.x * 256 + threadIdx.x; g < n16; g += (size_t)gridDim.x * 256) {
    u32x4 o;
#pragma unroll
    for (int q = 0; q < 4; ++q) {
      float4 a = *(const float4*)(src + g * 16 + q * 4);
      int pk = __builtin_amdgcn_cvt_pk_fp8_f32(a.x * scale, a.y * scale, 0, false);
      pk = __builtin_amdgcn_cvt_pk_fp8_f32(a.z * scale, a.w * scale, pk, true);
      o[q] = (unsigned)pk;
    }
    *(u32x4*)(dst + g * 16) = o;
  }
}
DEVI void unpack_fp8x16(const u32x4& u, float* f) {
#pragma unroll
  for (int q = 0; q < 4; ++q) {
    f32x2 lo = __builtin_amdgcn_cvt_pk_f32_fp8((int)u[q], false), hi = __builtin_amdgcn_cvt_pk_f32_fp8((int)u[q], true);
    f[4 * q] = lo[0]; f[4 * q + 1] = lo[1]; f[4 * q + 2] = hi[0]; f[4 * q + 3] = hi[1];
  }
}
DEVI void convert_bf16(const float* __restrict__ src, bf16_t* __restrict__ dst, size_t n8) {
  for (size_t g = (size_t)blockIdx.x * 256 + threadIdx.x; g < n8; g += (size_t)gridDim.x * 256) {
    float4 a = *(const float4*)(src + g * 8), b = *(const float4*)(src + g * 8 + 4);
    *(uint4*)(dst + g * 8) = make_uint4(pack2(a.x, a.y), pack2(a.z, a.w), pack2(b.x, b.y), pack2(b.z, b.w));
  }
}
DEVI float allred8(float v) { v += dppf<0xB1>(v); v += dppf<0x4E>(v); v += dppf<0x141>(v); return v; }

DEVI int ml_row(int c, int j) {
  if (c < 4) return c * 64 + j;
  int cc = c - 4; int col = cc >> 2; int gr = (cc & 3) * 64 + j;
  return T_CTX + gr * 64 + col;
}
DEVI int ml_sc(int c, int dir) { return dir == 0 ? c : (c < 4 ? 3 - c : 263 - c); }
DEVI int rw_row(int p, int dir) { return dir == 0 ? p : (p < T_CTX ? (T_CTX - 1 - p) : (T_ALL + T_CTX - 1 - p)); }

DEVI float mod_val(const Params& p, int which, int col) {
  const float* modp = (const float*)(p.ws + O_MODP);
  float s = p.in[I_ADAB][col];
#pragma unroll
  for (int rs = 0; rs < 16; ++rs) s += modp[(rs * 2 + which) * 6144 + col];
  return s;
}

DEVI void gemm_core(const bf16_t* __restrict__ A, int lda, const bf16_t* __restrict__ Bt, int ldb, int K,
                    f32x4 (&acc)[4][4], unsigned char* smem) {
  bf16_t(*sa)[80] = (bf16_t(*)[80])smem;
  bf16_t(*sb)[80] = (bf16_t(*)[80])(smem + 128 * 80 * 2);
  const int tid = threadIdx.x, lane = tid & 63, warp = tid >> 6, wm = warp >> 1, wn = warp & 1;
  const int lr = tid >> 3, lk = (tid & 7) * 8;
  const bf16_t* Ap = A + (size_t)lr * lda + lk;
  const bf16_t* Bp = Bt + (size_t)lr * ldb + lk;
  u32x4 ra0[4], rb0[4], ra1[4], rb1[4];
#pragma unroll
  for (int i = 0; i < 4; ++i) {
    ra0[i] = *(const u32x4*)(Ap + (size_t)(32 * i) * lda); rb0[i] = *(const u32x4*)(Bp + (size_t)(32 * i) * ldb);
    ra1[i] = *(const u32x4*)(Ap + (size_t)(32 * i) * lda + 64); rb1[i] = *(const u32x4*)(Bp + (size_t)(32 * i) * ldb + 64);
  }
#define GEMM_STEP(k0, ra, rb)                                                                                 \
  {                                                                                                           \
    __syncthreads();                                                                                          \
    _Pragma("unroll") for (int i = 0; i < 4; ++i) { *(u32x4*)&sa[lr + 32 * i][lk] = ra[i]; *(u32x4*)&sb[lr + 32 * i][lk] = rb[i]; } \
    __syncthreads();                                                                                          \
    if ((k0) + 128 < K) {                                                                                     \
      _Pragma("unroll") for (int i = 0; i < 4; ++i) {                                                         \
        ra[i] = *(const u32x4*)(Ap + (size_t)(32 * i) * lda + (k0) + 128);                                    \
        rb[i] = *(const u32x4*)(Bp + (size_t)(32 * i) * ldb + (k0) + 128);                                    \
      }                                                                                                       \
    }                                                                                                         \
    __builtin_amdgcn_s_setprio(1);                                                                            \
    _Pragma("unroll") for (int ks = 0; ks < 2; ++ks) {                                                        \
      bf16x8 af[4], bq[4];                                                                                    \
      _Pragma("unroll") for (int i = 0; i < 4; ++i) af[i] = *(const bf16x8*)&sa[wm * 64 + i * 16 + (lane & 15)][ks * 32 + (lane >> 4) * 8]; \
      _Pragma("unroll") for (int j = 0; j < 4; ++j) bq[j] = *(const bf16x8*)&sb[wn * 64 + j * 16 + (lane & 15)][ks * 32 + (lane >> 4) * 8]; \
      _Pragma("unroll") for (int i = 0; i < 4; ++i)                                                           \
        _Pragma("unroll") for (int j = 0; j < 4; ++j) acc[i][j] = __builtin_amdgcn_mfma_f32_16x16x32_bf16(bq[j], af[i], acc[i][j], 0, 0, 0); \
    }                                                                                                         \
    __builtin_amdgcn_s_setprio(0);                                                                            \
  }
  for (int k0 = 0; k0 < K; k0 += 128) {
    GEMM_STEP(k0, ra0, rb0)
    GEMM_STEP(k0 + 64, ra1, rb1)
  }
#undef GEMM_STEP
  __syncthreads();
}
DEVI void zero_acc(f32x4 (&acc)[4][4]) {
#pragma unroll
  for (int i = 0; i < 4; ++i)
#pragma unroll
    for (int j = 0; j < 4; ++j) acc[i][j] = f32x4{0.f, 0.f, 0.f, 0.f};
}

struct XcdMap { int v, nx, slot, slots; };
template <typename F> DEVI void for_tiles_xcd(const XcdMap& xm, int MT, int NT, int SM, int SN, F&& f) {
  const int nsn = (NT + SN - 1) / SN, nst = ((MT + SM - 1) / SM) * nsn, per = SM * SN;
  const int n_my = (nst - xm.v + xm.nx - 1) / xm.nx;
  for (int g = xm.slot; g < n_my * per; g += xm.slots) {
    const int s = xm.v + (g / per) * xm.nx, idx = g % per;
    const int sm = s / nsn, sn = s % nsn;
    const int mt = sm * SM + idx / SN, nt = sn * SN + idx % SN;
    if (mt < MT && nt < NT) f(mt, nt);
  }
}

DEVI void tr_tile(const float* __restrict__ src, int lds, int k0, int n0src, bf16_t* __restrict__ dst, int ldd, int n0dst,
                  unsigned char* smem) {
  float(*tile)[65] = (float(*)[65])smem;
  const int tid = threadIdx.x, j = tid & 63, i0 = tid >> 6;
#pragma unroll 4
  for (int ii = 0; ii < 16; ++ii) { int i = i0 + 4 * ii; tile[i][j] = src[(size_t)(k0 + i) * lds + n0src + j]; }
  __syncthreads();
#pragma unroll 4
  for (int jj = 0; jj < 16; ++jj) { int jn = i0 + 4 * jj; dst[(size_t)(n0dst + jn) * ldd + k0 + j] = f2bf(tile[j][jn]); }
  __syncthreads();
}

DEVI void phase0(const Params& p, unsigned char* smem, int it_lo, int it_hi) {
  const int tid = threadIdx.x;
  constexpr int N_MOD = 384, N_WIN = 16 * 85, N_WB = 128, N_WOUT = 256, N_WQ = 512, N_LORA = 16, N_GUP = 16, N_KEYS = 128;
  constexpr int E0 = N_MOD, E1 = E0 + N_WIN, E2 = E1 + N_WB, E3 = E2 + N_WB, E4 = E3 + N_WOUT, E5 = E4 + N_WQ,
                E6 = E5 + N_LORA, E7 = E6 + N_LORA, E8 = E7 + N_GUP, E9 = E8 + N_KEYS;
  if (it_hi > E9) it_hi = E9;
  for (int it = it_lo + blockIdx.x; it < it_hi; it += gridDim.x) {
    if (it < E0) {
      int cb = it % 24, rs = it / 24; int col = cb * 256 + tid;
      const float* aw = p.in[I_ADAW];
      float ax = 0.f, ac = 0.f;
#pragma unroll 8
      for (int r = rs * 64; r < rs * 64 + 64; ++r) {
        float w = aw[(size_t)r * 6144 + col];
        ax += siluf(p.in[I_C][r]) * w;
        ac += siluf(p.in[I_CCTX][r]) * w;
      }
      float* modp = (float*)(p.ws + O_MODP);
      modp[(rs * 2 + 0) * 6144 + col] = ax;
      modp[(rs * 2 + 1) * 6144 + col] = ac;
    } else if (it < E1) {
      int t = it - E0; int kt = t / 85, nt = t % 85; int n0 = nt * 64;
      tr_tile(p.in[I_WIN], NIN, kt * 64, nt == 84 ? 2816 : (n0 < 2816 ? n0 : n0 + 16), (bf16_t*)(p.ws + R_WIN), 1024, n0, smem);
    } else if (it < E2) {
      int t = it - E1; tr_tile(p.in[I_WBA], 1024, (t / 16) * 64, (t % 16) * 64, (bf16_t*)(p.ws + O_WBA), 512, (t % 16) * 64, smem);
    } else if (it < E3) {
      int t = it - E2; tr_tile(p.in[I_WBB], 1024, (t / 16) * 64, (t % 16) * 64, (bf16_t*)(p.ws + O_WBB), 512, (t % 16) * 64, smem);
    } else if (it < E4) {
      int t = it - E3; tr_tile(p.in[I_WOUT], 1024, (t / 16) * 64, (t % 16) * 64, (bf16_t*)(p.ws + O_WOUT), 1024, (t % 16) * 64, smem);
    } else if (it < E5) {
      int t = it - E4; tr_tile(p.in[I_WQ], 2048, (t / 32) * 64, (t % 32) * 64, (bf16_t*)(p.ws + O_WQ), 1024, (t % 32) * 64, smem);
    } else if (it < E6) {
      int t = it - E5; int dir = t / 8, nt = t % 8;
      tr_tile(p.in[I_RWUP] + (size_t)dir * 64 * 512, 512, 0, nt * 64, (bf16_t*)(p.ws + O_WUP) + (size_t)dir * 512 * 64, 64, nt * 64, smem);
    } else if (it < E7) {
      int t = it - E6; int dir = t / 8, nt = t % 8;
      tr_tile(p.in[I_RAUP] + (size_t)dir * 64 * 512, 512, 0, nt * 64, (bf16_t*)(p.ws + O_AUP) + (size_t)dir * 512 * 64, 64, nt * 64, smem);
    } else if (it < E8) {
      int t = it - E7; tr_tile(p.in[I_RGUP], 512, (t / 8) * 64, (t % 8) * 64, (bf16_t*)(p.ws + O_GUP), 128, (t % 8) * 64, smem);
    } else {
      int t = it - E8; size_t base = (size_t)t * 2048 + tid * 8;
      const float* s = p.in[I_KEYS] + base;
      float f[8];
      float4 a = *(const float4*)s, b = *(const float4*)(s + 4);
      f[0] = a.x; f[1] = a.y; f[2] = a.z; f[3] = a.w; f[4] = b.x; f[5] = b.y; f[6] = b.z; f[7] = b.w;
      *(uint4*)((bf16_t*)(p.ws + O_KEYS) + base) = pack8(f);
    }
  }
}

DEVI void phase1(const Params& p, unsigned char* smem) {
  float* smod = (float*)smem;
  const int tid = threadIdx.x, lane = tid & 63, warp = tid >> 6;
  for (int i = tid; i < 4096; i += 256) { int which = i >> 10; smod[i] = mod_val(p, which >> 1, (which & 1) * 1024 + (i & 1023)); }
  __syncthreads();
  bf16_t* hx = (bf16_t*)(p.ws + R_HX);
  float* gif = (float*)(p.ws + R_GIF);
  const float* win = p.in[I_WIN];
  constexpr int RPW = 4;
  for (int rg = blockIdx.x * 4 + warp; rg < T_ALL / RPW; rg += gridDim.x * 4) {
    const int row0 = rg * RPW;
    const float* sh = smod + (row0 < T_CTX ? 2048 : 0);
    const float* sc = sh + 1024;
    const float* src0 = row0 < T_CTX ? p.in[I_CTX] + (size_t)row0 * 1024 : p.in[I_X] + (size_t)(row0 - T_CTX) * 1024;
    float rstd[RPW];
#pragma unroll
    for (int r = 0; r < RPW; ++r) {
      float ss = 0.f;
#pragma unroll
      for (int i = 0; i < 4; ++i) {
        float4 v = *(const float4*)(src0 + (size_t)r * 1024 + i * 256 + lane * 4);
        ss += v.x * v.x + v.y * v.y + v.z * v.z + v.w * v.w;
      }
      ss = wave_sum_u(ss);
      rstd[r] = rsqrtf(ss * (1.f / 1024.f) + 1e-6f);
    }
#pragma unroll
    for (int i = 0; i < 4; ++i) {
      const int k0 = i * 256 + lane * 4;
      const float4 gk = *(const float4*)(p.in[I_N1G] + k0);
      const float4 s4 = *(const float4*)(sc + k0), h4 = *(const float4*)(sh + k0);
#pragma unroll
      for (int r = 0; r < RPW; ++r) {
        float4 v = *(const float4*)(src0 + (size_t)r * 1024 + k0);
        const float y0 = v.x * rstd[r] * gk.x * (1.f + s4.x) + h4.x, y1 = v.y * rstd[r] * gk.y * (1.f + s4.y) + h4.y;
        const float y2 = v.z * rstd[r] * gk.z * (1.f + s4.z) + h4.z, y3 = v.w * rstd[r] * gk.w * (1.f + s4.w) + h4.w;
        *(uint2*)(hx + (size_t)(row0 + r) * 1024 + k0) = make_uint2(pack2(y0, y1), pack2(y2, y3));
      }
    }
  }
}

DEVI void phase2(const Params& p, unsigned char* smem, const XcdMap& xm) {
  const int lane = threadIdx.x & 63, warp = threadIdx.x >> 6, wm = warp >> 1, wn = warp & 1;
  const bf16_t* hx = (const bf16_t*)(p.ws + R_HX);
  const bf16_t* wt = (const bf16_t*)(p.ws + R_WIN);
  bf16_t* prw = (bf16_t*)p.out;
  bf16_t* pqk = (bf16_t*)(p.ws + R_PQK);
  bf16_t* pv = (bf16_t*)(p.ws + R_PV);
  bf16_t* po = (bf16_t*)(p.ws + O_PO);
  bf16_t* pg = (bf16_t*)(p.ws + O_PG);
  for_tiles_xcd(xm, 130, 43, 5, 6, [&](int mt, int nt) {
    if (mt < 2 && nt >= 22 && nt < 42) return;
    f32x4 acc[4][4];
    zero_acc(acc);
    gemm_core(hx + (size_t)mt * 128 * 1024, 1024, wt + (size_t)nt * 128 * 1024, 1024, 1024, acc, smem);
    if (nt == 42) {
      float* gif = (float*)(p.ws + R_GIF);
      if (wn == 0) {
#pragma unroll
        for (int i = 0; i < 4; ++i) {
          const int row = mt * 128 + wm * 64 + i * 16 + (lane & 15);
          *(float4*)(gif + (size_t)row * 16 + (lane >> 4) * 4) = make_float4(acc[i][0][0], acc[i][0][1], acc[i][0][2], acc[i][0][3]);
        }
      }
      return;
    }
    bf16_t* dst; int ld, nb; int rofs = 0; bool sg = false;
    if (nt < 14) { dst = prw; ld = 1792; nb = nt * 128; }
    else if (nt < 18) { dst = pqk; ld = 512; nb = (nt - 14) * 128; }
    else if (nt < 22) { dst = pv; ld = 512; nb = (nt - 18) * 128; }
    else if (nt < 26) { dst = po; ld = 512; nb = (nt - 22) * 128; rofs = T_CTX; }
    else { dst = pg; ld = 2048; nb = (nt - 26) * 128; rofs = T_CTX; sg = true; }
    bf16_t(*Ct)[136] = (bf16_t(*)[136])smem;
#pragma unroll
    for (int i = 0; i < 4; ++i) {
#pragma unroll
      for (int j = 0; j < 4; ++j) {
        f32x4 v = acc[i][j];
        if (sg) { v[0] = sigm(v[0]); v[1] = sigm(v[1]); v[2] = sigm(v[2]); v[3] = sigm(v[3]); }
        *(uint2*)&Ct[wm * 64 + i * 16 + (lane & 15)][wn * 64 + j * 16 + (lane >> 4) * 4] = make_uint2(pack2(v[0], v[1]), pack2(v[2], v[3]));
      }
    }
    __syncthreads();
#pragma unroll
    for (int q = 0; q < 8; ++q) {
      const int pc = threadIdx.x + 256 * q; const int r = pc >> 4, c8 = (pc & 15) * 8;
      const int row = mt * 128 + r - rofs;
      *(u32x4*)(dst + (size_t)row * ld + nb + c8) = *(const u32x4*)&Ct[r][c8];
    }
    __syncthreads();
  });
}

DEVI void ml_qk8(const Params& p, int c, int j, int chan, float* o) {
  const bf16_t* pqk = (const bf16_t*)(p.ws + R_PQK);
  int row = ml_row(c, j);
  bool hp, hn; int rp, rn;
  if (c < 4) { hp = row > 0; hn = row < T_CTX - 1; rp = row - 1; rn = row + 1; }
  else { int gr = ((c - 4) & 3) * 64 + j; hp = gr > 0; hn = gr < 255; rp = row - 64; rn = row + 64; }
  const float* cw = p.in[I_MCONV];
  float cur[8], pr[8], nx[8];
  unpack8(*(const uint4*)(pqk + (size_t)row * 512 + chan), cur);
  if (hp) unpack8(*(const uint4*)(pqk + (size_t)rp * 512 + chan), pr);
  if (hn) unpack8(*(const uint4*)(pqk + (size_t)rn * 512 + chan), nx);
#pragma unroll
  for (int e = 0; e < 8; ++e) {
    float v = cw[512 + chan + e] * cur[e];
    if (hp) v += cw[chan + e] * pr[e];
    if (hn) v += cw[1024 + chan + e] * nx[e];
    o[e] = siluf(v);
  }
}

DEVI void phase3(const Params& p, unsigned char* smem) {
  bf16_t(*KT)[72] = (bf16_t(*)[72])smem;
  bf16_t(*VwT)[72] = (bf16_t(*)[72])(smem + 64 * 72 * 2);
  float* wgt = (float*)(smem + 64 * 72 * 2 + 256 * 72 * 2);
  const int tid = threadIdx.x, lane = tid & 63, warp = tid >> 6;
  const float* gif = (const float*)(p.ws + R_GIF);
  const bf16_t* pv = (const bf16_t*)(p.ws + R_PV);
  float* U = (float*)(p.ws + R_U);
  float* NT = (float*)(p.ws + O_NT);
  float* bend = (float*)(p.ws + O_BEND);
  float* mloc = (float*)(p.ws + O_MLOC);
  for (int it = blockIdx.x; it < 260 * 4; it += gridDim.x) {
    int c = it >> 2, h = it & 3;
    if (warp < 2) {
      int dir = warp; int j = dir ? 63 - lane : lane;
      int row = ml_row(c, j);
      float ig = gif[(size_t)row * 16 + dir * 4 + h] + p.in[I_MIB][dir * 4 + h];
      float lf = logsig(gif[(size_t)row * 16 + 8 + dir * 4 + h] + p.in[I_MFB][dir * 4 + h]);
      float b = lf;
#pragma unroll
      for (int o = 1; o < 64; o <<= 1) { float t = __shfl_up(b, o); if (lane >= o) b += t; }
      float be = __shfl(b, 63);
      float ge = be - b + ig;
      float ml = wave_max(ge);
      wgt[dir * 64 + j] = expf(ge - ml);
      if (lane == 0) { int sc = ml_sc(c, dir); bend[sc * 8 + dir * 4 + h] = be; mloc[sc * 8 + dir * 4 + h] = ml; }
    }
    __syncthreads();
    {
      int j = tid >> 2, part = tid & 3;
      float f[8];
#pragma unroll
      for (int q = 0; q < 2; ++q) {
        int d0 = part * 16 + q * 8;
        ml_qk8(p, c, j, 256 + h * 64 + d0, f);
#pragma unroll
        for (int e = 0; e < 8; ++e) KT[d0 + e][j] = f2bf(f[e] * 0.125f);
      }
      int row = ml_row(c, j);
      float w0 = wgt[j], w1 = wgt[64 + j];
#pragma unroll
      for (int q = 0; q < 4; ++q) {
        int v0 = part * 32 + q * 8;
        unpack8(*(const uint4*)(pv + (size_t)row * 512 + h * 128 + v0), f);
#pragma unroll
        for (int e = 0; e < 8; ++e) { VwT[v0 + e][j] = f2bf(f[e] * w0); VwT[128 + v0 + e][j] = f2bf(f[e] * w1); }
      }
    }
    __syncthreads();
#pragma unroll
    for (int dir = 0; dir < 2; ++dir) {
      int sc = ml_sc(c, dir);
      float* Ud = U + ((size_t)sc * 8 + dir * 4 + h) * 8192;
#pragma unroll
      for (int vi = 0; vi < 2; ++vi) {
        int vt = warp * 2 + vi;
        bf16x8 bv[2];
#pragma unroll
        for (int ks = 0; ks < 2; ++ks) bv[ks] = *(const bf16x8*)&VwT[dir * 128 + vt * 16 + (lane & 15)][ks * 32 + (lane >> 4) * 8];
#pragma unroll
        for (int dt = 0; dt < 4; ++dt) {
          f32x4 a = {0.f, 0.f, 0.f, 0.f};
#pragma unroll
          for (int ks = 0; ks < 2; ++ks) {
            bf16x8 ak = *(const bf16x8*)&KT[dt * 16 + (lane & 15)][ks * 32 + (lane >> 4) * 8];
            a = __builtin_amdgcn_mfma_f32_16x16x32_bf16(ak, bv[ks], a, 0, 0, 0);
          }
          *(float4*)(Ud + (size_t)(vt * 16 + (lane & 15)) * 64 + dt * 16 + (lane >> 4) * 4) = make_float4(a[0], a[1], a[2], a[3]);
        }
      }
    }
    if (tid < 128) {
      int dir = tid >> 6, d = tid & 63; float s = 0.f;
      for (int j = 0; j < 64; ++j) s += wgt[dir * 64 + j] * bf2f(KT[d][j]);
      NT[((size_t)ml_sc(c, dir) * 8 + dir * 4 + h) * 64 + d] = s;
    }
    __syncthreads();
  }
}

template <bool DRY> DEVI void phase4(const Params& p) {
  const bool wr = !DRY || (p.in[I_FG][0] == 1234.5f);
  float* U = (float*)(p.ws + R_U);
  float* NT = (float*)(p.ws + O_NT);
  const float* bend = (const float*)(p.ws + O_BEND);
  const float* mloc = (const float*)(p.ws + O_MLOC);
  float* mst = (float*)(p.ws + O_MST);
  for (int g = blockIdx.x * 256 + threadIdx.x; g < 8 * 8256; g += gridDim.x * 256) {
    int pr = g / 8256, e = g % 8256;
    float* base; size_t stride;
    if (e < 8192) { base = U + (size_t)pr * 8192 + e; stride = 8 * 8192; }
    else { base = NT + (size_t)pr * 64 + (e - 8192); stride = 8 * 64; }
    float m = 0.f, C = 0.f;
    for (int sc = 0; sc < 260; sc += 20) {
      float u[20];
#pragma unroll
      for (int q = 0; q < 20; ++q) u[q] = base[(size_t)(sc + q) * stride];
#pragma unroll
      for (int q = 0; q < 20; ++q) {
        float be = bend[(sc + q) * 8 + pr], ml = mloc[(sc + q) * 8 + pr];
        float mn = fmaxf(be + m, ml);
        float keep = expf(be + m - mn), s = expf(ml - mn);
        if (wr) base[(size_t)(sc + q) * stride] = C;
        if (wr && e == 0) mst[(sc + q) * 8 + pr] = m;
        C = keep * C + s * u[q];
        m = mn;
      }
    }
  }
}

template <bool DRY> DEVI void phase5(const Params& p, unsigned char* smem) {
  const bool wr = !DRY || (p.in[I_FG][0] == 1234.5f);
  bf16_t(*Qs)[72] = (bf16_t(*)[72])smem;
  bf16_t(*Ks)[72] = (bf16_t(*)[72])(smem + 9216);
  bf16_t(*Pm)[72] = (bf16_t(*)[72])(smem + 2 * 9216);
  bf16_t(*VT)[72] = (bf16_t(*)[72])(smem + 3 * 9216);
  float* evec = (float*)(smem + 3 * 9216 + 144 * 72 * 2);
  float* Mvec = evec + 128;
  float* bvec = Mvec + 128;
  const int tid = threadIdx.x, lane = tid & 63, warp = tid >> 6;
  const float* gif = (const float*)(p.ws + R_GIF);
  const bf16_t* pv = (const bf16_t*)(p.ws + R_PV);
  const bf16_t* po = (const bf16_t*)(p.ws + O_PO);
  bf16_t* yb = (bf16_t*)(p.ws + R_YA);
  const float* U = (const float*)(p.ws + R_U);
  const float* NT = (const float*)(p.ws + O_NT);
  const float* mst = (const float*)(p.ws + O_MST);
  for (int it = blockIdx.x; it < 256 * 4; it += gridDim.x) {
    int c = 4 + (it >> 2), h = it & 3;
    if (warp < 2) {
      int dir = warp; int j = dir ? 63 - lane : lane;
      int row = ml_row(c, j);
      float ig = gif[(size_t)row * 16 + dir * 4 + h] + p.in[I_MIB][dir * 4 + h];
      float lf = logsig(gif[(size_t)row * 16 + 8 + dir * 4 + h] + p.in[I_MFB][dir * 4 + h]);
      float b = lf;
#pragma unroll
      for (int o = 1; o < 64; o <<= 1) { float t = __shfl_up(b, o); if (lane >= o) b += t; }
      float e = ig - b;
      float pm = e;
#pragma unroll
      for (int o = 1; o < 64; o <<= 1) { float t = __shfl_up(pm, o); if (lane >= o) pm = fmaxf(pm, t); }
      float m0 = mst[ml_sc(c, dir) * 8 + dir * 4 + h];
      evec[dir * 64 + j] = e; Mvec[dir * 64 + j] = fmaxf(m0, pm); bvec[dir * 64 + j] = b;
    }
    {
      int j = tid >> 2, part = tid & 3;
      float f[8];
#pragma unroll
      for (int q = 0; q < 2; ++q) {
        int d0 = part * 16 + q * 8;
        ml_qk8(p, c, j, h * 64 + d0, f);
        *(uint4*)&Qs[j][d0] = pack8(f);
        ml_qk8(p, c, j, 256 + h * 64 + d0, f);
#pragma unroll
        for (int e = 0; e < 8; ++e) f[e] *= 0.125f;
        *(uint4*)&Ks[j][d0] = pack8(f);
      }
      int row = ml_row(c, j);
#pragma unroll
      for (int q = 0; q < 4; ++q) {
        int v0 = part * 32 + q * 8;
        unpack8(*(const uint4*)(pv + (size_t)row * 512 + h * 128 + v0), f);
#pragma unroll
        for (int e = 0; e < 8; ++e) VT[v0 + e][j] = f2bf(f[e]);
      }
      for (int i = tid; i < 16 * 64; i += 256) VT[128 + (i >> 6)][i & 63] = (i < 64) ? (bf16_t)0x3f80 : (bf16_t)0;
    }
    __syncthreads();
    const int jl = warp * 16 + (lane & 15);
    f32x4 s0[4];
    bf16x8 qf[2];
#pragma unroll
    for (int ks = 0; ks < 2; ++ks) qf[ks] = *(const bf16x8*)&Qs[jl][ks * 32 + (lane >> 4) * 8];
#pragma unroll
    for (int st = 0; st < 4; ++st) {
      f32x4 a = {0.f, 0.f, 0.f, 0.f};
#pragma unroll
      for (int ks = 0; ks < 2; ++ks) {
        bf16x8 kf = *(const bf16x8*)&Ks[st * 16 + (lane & 15)][ks * 32 + (lane >> 4) * 8];
        a = __builtin_amdgcn_mfma_f32_16x16x32_bf16(kf, qf[ks], a, 0, 0, 0);
      }
      s0[st] = a;
    }
    f32x4 ysum[8];
#pragma unroll
    for (int vt = 0; vt < 8; ++vt) ysum[vt] = f32x4{0.f, 0.f, 0.f, 0.f};
#pragma unroll 1
    for (int dir = 0; dir < 2; ++dir) {
      float Mj = Mvec[dir * 64 + jl], bj = bvec[dir * 64 + jl];
      float m0 = mst[ml_sc(c, dir) * 8 + dir * 4 + h];
#pragma unroll
      for (int st = 0; st < 4; ++st) {
        float pvv[4];
#pragma unroll
        for (int r = 0; r < 4; ++r) {
          int s = st * 16 + (lane >> 4) * 4 + r;
          bool ok = dir == 0 ? (s <= jl) : (s >= jl);
          pvv[r] = ok ? s0[st][r] * expf(evec[dir * 64 + s] - Mj) : 0.f;
        }
        *(uint2*)&Pm[jl][st * 16 + (lane >> 4) * 4] = make_uint2(pack2(pvv[0], pvv[1]), pack2(pvv[2], pvv[3]));
      }
      __syncthreads();
      bf16x8 pf[2];
#pragma unroll
      for (int ks = 0; ks < 2; ++ks) pf[ks] = *(const bf16x8*)&Pm[jl][ks * 32 + (lane >> 4) * 8];
      const float* Cst = U + ((size_t)ml_sc(c, dir) * 8 + dir * 4 + h) * 8192;
      const float* nst = NT + ((size_t)ml_sc(c, dir) * 8 + dir * 4 + h) * 64;
      float ai = expf(m0 - Mj);
      f32x4 hh[9];
#pragma unroll
      for (int vt = 0; vt < 9; ++vt) {
        f32x4 a1 = {0.f, 0.f, 0.f, 0.f}, a2 = {0.f, 0.f, 0.f, 0.f};
#pragma unroll
        for (int ks = 0; ks < 2; ++ks) {
          bf16x8 vf = *(const bf16x8*)&VT[vt * 16 + (lane & 15)][ks * 32 + (lane >> 4) * 8];
          a1 = __builtin_amdgcn_mfma_f32_16x16x32_bf16(vf, pf[ks], a1, 0, 0, 0);
          int v = vt * 16 + (lane & 15);
          const float* cp = v < 128 ? Cst + (size_t)v * 64 + ks * 32 + (lane >> 4) * 8 : nst + ks * 32 + (lane >> 4) * 8;
          float cf[8];
          if (v <= 128) {
            float4 x0 = *(const float4*)cp, x1 = *(const float4*)(cp + 4);
            cf[0] = x0.x; cf[1] = x0.y; cf[2] = x0.z; cf[3] = x0.w; cf[4] = x1.x; cf[5] = x1.y; cf[6] = x1.z; cf[7] = x1.w;
          } else {
#pragma unroll
            for (int e = 0; e < 8; ++e) cf[e] = 0.f;
          }
          uint4 pk = pack8(cf);
          bf16x8 cfr;
          cfr[0] = (short)(pk.x & 0xffff); cfr[1] = (short)(pk.x >> 16); cfr[2] = (short)(pk.y & 0xffff); cfr[3] = (short)(pk.y >> 16);
          cfr[4] = (short)(pk.z & 0xffff); cfr[5] = (short)(pk.z >> 16); cfr[6] = (short)(pk.w & 0xffff); cfr[7] = (short)(pk.w >> 16);
          a2 = __builtin_amdgcn_mfma_f32_16x16x32_bf16(cfr, qf[ks], a2, 0, 0, 0);
        }
#pragma unroll
        for (int r = 0; r < 4; ++r) hh[vt][r] = a1[r] + ai * a2[r];
      }
      float den = __shfl(hh[8][0], lane & 15);
      float dn = fmaxf(fabsf(den), expf(-(bj + Mj)));
      float inv = 1.f / dn;
      float ss = 0.f;
#pragma unroll
      for (int vt = 0; vt < 8; ++vt)
#pragma unroll
        for (int r = 0; r < 4; ++r) { float x = hh[vt][r] * inv; hh[vt][r] = x; ss += x * x; }
      ss += __shfl_xor(ss, 16); ss += __shfl_xor(ss, 32);
      float rs = rsqrtf(ss * (1.f / 128.f) + 1e-6f);
#pragma unroll
      for (int vt = 0; vt < 8; ++vt)
#pragma unroll
        for (int r = 0; r < 4; ++r) ysum[vt][r] += hh[vt][r] * rs * p.in[I_MNG][h * 128 + vt * 16 + (lane >> 4) * 4 + r];
      __syncthreads();
    }
    {
      int row = ml_row(c, jl) - T_CTX;
#pragma unroll
      for (int vt = 0; vt < 8; ++vt) {
        const bf16_t* op = po + (size_t)row * 512 + h * 128 + vt * 16 + (lane >> 4) * 4;
        uint2 o = *(const uint2*)op;
        float y0 = ysum[vt][0] * sigm(bflo(o.x)), y1 = ysum[vt][1] * sigm(bfhi(o.x)), y2 = ysum[vt][2] * sigm(bflo(o.y)), y3 = ysum[vt][3] * sigm(bfhi(o.y));
        if (wr) *(uint2*)(yb + (size_t)row * 512 + h * 128 + vt * 16 + (lane >> 4) * 4) = make_uint2(pack2(y0, y1), pack2(y2, y3));
      }
    }
    __syncthreads();
  }
}

DEVI void phase6(const Params& p, unsigned char* smem, int item_lo, int item_hi, int blk0, int nblk) {
  float(*rs)[65] = (float(*)[65])smem;
  float(*ks)[65] = (float(*)[65])(smem + 64 * 65 * 4);
  bf16_t(*TW)[72] = (bf16_t(*)[72])(smem + 2 * 64 * 65 * 4);
  bf16_t(*TA)[72] = (bf16_t(*)[72])(smem + 2 * 64 * 65 * 4 + 9216);
  bf16_t(*TG)[136] = (bf16_t(*)[136])(smem + 2 * 64 * 65 * 4 + 2 * 9216);
  float* rn = (float*)(smem + 2 * 64 * 65 * 4 + 2 * 9216 + 64 * 136 * 2);
  const int tid = threadIdx.x, lane = tid & 63, warp = tid >> 6;
  const bf16_t* prw = (const bf16_t*)p.out;
  bf16_t* SV = (bf16_t*)(p.ws + R_SV);
  float* bonus = (float*)(p.ws + O_BONUS);
  const float* cw = p.in[I_RCONV];
  const bf16_t* WUP = (const bf16_t*)(p.ws + O_WUP);
  const bf16_t* AUP = (const bf16_t*)(p.ws + O_AUP);
  const bf16_t* GUP = (const bf16_t*)(p.ws + O_GUP);
  if ((int)blockIdx.x < blk0) return;
  for (int it = item_lo + ((int)blockIdx.x - blk0); it < item_hi; it += nblk) {
    int tile = it >> 3, head = it & 7;
    int row0 = tile * 64;
    int seg0 = tile < 4 ? 0 : row0, seg1 = tile < 4 ? T_CTX : row0 + 64;
#pragma unroll 1
    for (int ub = 0; ub < 2; ++ub) {
      u32x4 lc[7], lp[7], ln[7];
#pragma unroll
      for (int it7 = 0; it7 < 7; ++it7) {
        const int u = warp + 4 * (ub * 7 + it7);
        const int grp = u >> 3;
        const int j = (u & 7) * 8 + (lane >> 3), q = grp * 8 + (lane & 7);
        const int row = row0 + j;
        const int col = q < 24 ? (q >> 3) * 512 + head * 64 + (q & 7) * 8 : 1536 + (q - 24) * 8;
        const bool hp = row > seg0, hn = row < seg1 - 1;
        lc[it7] = *(const u32x4*)(prw + (size_t)row * 1792 + col);
        lp[it7] = hp ? *(const u32x4*)(prw + (size_t)(row - 1) * 1792 + col) : u32x4{0u, 0u, 0u, 0u};
        ln[it7] = hn ? *(const u32x4*)(prw + (size_t)(row + 1) * 1792 + col) : u32x4{0u, 0u, 0u, 0u};
      }
#pragma unroll
      for (int it7 = 0; it7 < 7; ++it7) {
        const int u = warp + 4 * (ub * 7 + it7);
        const int grp = u >> 3;
        const int j = (u & 7) * 8 + (lane >> 3), q = grp * 8 + (lane & 7);
        const int row = row0 + j;
        const int col = q < 24 ? (q >> 3) * 512 + head * 64 + (q & 7) * 8 : 1536 + (q - 24) * 8;
        float cur[8], pr[8], nx[8], o[8];
        unpack8(make_uint4(lc[it7][0], lc[it7][1], lc[it7][2], lc[it7][3]), cur);
        unpack8(make_uint4(lp[it7][0], lp[it7][1], lp[it7][2], lp[it7][3]), pr);
        unpack8(make_uint4(ln[it7][0], ln[it7][1], ln[it7][2], ln[it7][3]), nx);
        {
          float4 c0 = *(const float4*)(cw + col), c1 = *(const float4*)(cw + col + 4);
          float4 d0 = *(const float4*)(cw + 1792 + col), d1 = *(const float4*)(cw + 1792 + col + 4);
          float4 e0 = *(const float4*)(cw + 3584 + col), e1 = *(const float4*)(cw + 3584 + col + 4);
          float wp[8] = {c0.x, c0.y, c0.z, c0.w, c1.x, c1.y, c1.z, c1.w};
          float wc[8] = {d0.x, d0.y, d0.z, d0.w, d1.x, d1.y, d1.z, d1.w};
          float wn_[8] = {e0.x, e0.y, e0.z, e0.w, e1.x, e1.y, e1.z, e1.w};
#pragma unroll
          for (int e = 0; e < 8; ++e) o[e] = wc[e] * cur[e] + wp[e] * pr[e] + wn_[e] * nx[e];
        }
        if (grp == 0) {
#pragma unroll
          for (int e = 0; e < 8; ++e) rs[j][(q & 7) * 8 + e] = o[e];
        } else if (grp == 1) {
#pragma unroll
          for (int e = 0; e < 8; ++e) ks[j][(q & 7) * 8 + e] = o[e];
        } else if (grp == 2) {
          *(uint4*)(SV + ((size_t)row * 8 + head) * SVH + 2 * 64 + (q & 7) * 8) = pack8(o);
        } else if (grp == 3) {
#pragma unroll
          for (int e = 0; e < 8; ++e) o[e] = 1.f - 2.f / (1.f + __expf(2.f * o[e]));
          *(uint4*)&TW[j][(q - 24) * 8] = pack8(o);
        } else if (grp == 4) {
          *(uint4*)&TA[j][(q - 32) * 8] = pack8(o);
        } else {
#pragma unroll
          for (int e = 0; e < 8; ++e) o[e] = sigm(o[e]);
          *(uint4*)&TG[j][(q - 40) * 8] = pack8(o);
        }
      }
    }
    __syncthreads();
    {
      int j = tid >> 2, part = tid & 3; float ss = 0.f;
#pragma unroll
      for (int e = 0; e < 16; ++e) { float v = ks[j][part * 16 + e] * p.in[I_RKK][head * 64 + part * 16 + e]; ss += v * v; }
      ss += __shfl_xor(ss, 1); ss += __shfl_xor(ss, 2);
      if (part == 0) rn[j] = 1.f / fmaxf(sqrtf(ss), 1e-12f);
    }
    __syncthreads();
    for (int pc = tid; pc < 64 * 8; pc += 256) {
      int j = pc >> 3, c8 = (pc & 7) * 8; int row = row0 + j;
      float fr[8], fk[8], fkk[8];
#pragma unroll
      for (int e = 0; e < 8; ++e) { fr[e] = rs[j][c8 + e]; fk[e] = ks[j][c8 + e]; fkk[e] = fk[e] * p.in[I_RKK][head * 64 + c8 + e] * rn[j]; }
      bf16_t* b = SV + ((size_t)row * 8 + head) * SVH;
      *(uint4*)(b + 0 * 64 + c8) = pack8(fr);
      *(uint4*)(b + 1 * 64 + c8) = pack8(fk);
      *(uint4*)(b + 3 * 64 + c8) = pack8(fkk);
    }
    {
      const int jl = warp * 16 + (lane & 15); const int row = row0 + jl;
      bf16x8 tw[2], ta[2], tg[4];
#pragma unroll
      for (int s2 = 0; s2 < 2; ++s2) { tw[s2] = *(const bf16x8*)&TW[jl][s2 * 32 + (lane >> 4) * 8]; ta[s2] = *(const bf16x8*)&TA[jl][s2 * 32 + (lane >> 4) * 8]; }
#pragma unroll
      for (int s2 = 0; s2 < 4; ++s2) tg[s2] = *(const bf16x8*)&TG[jl][s2 * 32 + (lane >> 4) * 8];
      __syncthreads();
      bf16_t(*OB)[64][72] = (bf16_t(*)[64][72])(smem + 2 * 64 * 65 * 4);
      float bon[2] = {0.f, 0.f};
#pragma unroll
      for (int dir = 0; dir < 2; ++dir) {
#pragma unroll
        for (int ct = 0; ct < 4; ++ct) {
          const int ch0 = ct * 16 + (lane >> 4) * 4;
          const int C0 = head * 64 + ch0;
          if (dir == 0) {
            f32x4 a = {0.f, 0.f, 0.f, 0.f};
#pragma unroll
            for (int s2 = 0; s2 < 4; ++s2) {
              bf16x8 wf = *(const bf16x8*)(GUP + (size_t)(head * 64 + ct * 16 + (lane & 15)) * 128 + s2 * 32 + (lane >> 4) * 8);
              a = __builtin_amdgcn_mfma_f32_16x16x32_bf16(wf, tg[s2], a, 0, 0, 0);
            }
            *(uint2*)&OB[2][jl][ch0] = make_uint2(pack2(a[0], a[1]), pack2(a[2], a[3]));
          }
          f32x4 aw = {0.f, 0.f, 0.f, 0.f}, aa = {0.f, 0.f, 0.f, 0.f};
#pragma unroll
          for (int s2 = 0; s2 < 2; ++s2) {
            size_t wo = (size_t)(dir * 512 + head * 64 + ct * 16 + (lane & 15)) * 64 + s2 * 32 + (lane >> 4) * 8;
            bf16x8 wf = *(const bf16x8*)(WUP + wo);
            bf16x8 af = *(const bf16x8*)(AUP + wo);
            aw = __builtin_amdgcn_mfma_f32_16x16x32_bf16(wf, tw[s2], aw, 0, 0, 0);
            aa = __builtin_amdgcn_mfma_f32_16x16x32_bf16(af, ta[s2], aa, 0, 0, 0);
          }
          const float4 w04 = *(const float4*)(p.in[I_RW0] + dir * 512 + C0), a04 = *(const float4*)(p.in[I_RA0] + dir * 512 + C0);
          const float4 ka4 = *(const float4*)(p.in[I_RKA] + C0), rk4 = *(const float4*)(p.in[I_RRK] + C0);
          const float w0v[4] = {w04.x, w04.y, w04.z, w04.w}, a0v[4] = {a04.x, a04.y, a04.z, a04.w};
          const float kav[4] = {ka4.x, ka4.y, ka4.z, ka4.w}, rkv[4] = {rk4.x, rk4.y, rk4.z, rk4.w};
          float we[4], av[4];
#pragma unroll
          for (int r = 0; r < 4; ++r) {
            we[r] = (0.60653066f * 1.44269504f) * sigm(w0v[r] + aw[r]);
            av[r] = sigm(a0v[r] + aa[r]);
            float kv = ks[jl][ch0 + r];
            float keff = kv * (1.f + (av[r] - 1.f) * kav[r]);
            bon[dir] += rs[jl][ch0 + r] * keff * rkv[r];
          }
          *(uint2*)&OB[0][jl][ch0] = make_uint2(pack2(we[0], we[1]), pack2(we[2], we[3]));
          *(uint2*)&OB[1][jl][ch0] = make_uint2(pack2(av[0], av[1]), pack2(av[2], av[3]));
        }
        __syncthreads();
        for (int pc = tid; pc < (dir == 0 ? 3 : 2) * 64 * 8; pc += 256) {
          const int vsel = pc >> 9, j = (pc >> 3) & 63, c8 = (pc & 7) * 8;
          const int vec = vsel == 2 ? 8 : (4 + 2 * dir + vsel);
          *(u32x4*)(SV + ((size_t)(row0 + j) * 8 + head) * SVH + vec * 64 + c8) = *(const u32x4*)&OB[vsel][j][c8];
        }
        __syncthreads();
      }
#pragma unroll
      for (int dir = 0; dir < 2; ++dir) {
        float sb = bon[dir]; sb += __shfl_xor(sb, 16); sb += __shfl_xor(sb, 32);
        if (lane < 16) bonus[(size_t)row * 16 + dir * 8 + head] = sb;
      }
    }
    __syncthreads();
  }
}

struct RwVec { uint4 k, kk, w, a, v, r; };
DEVI void unpack8p(const uint4& u, f32x2* f) {
  f[0] = f32x2{bflo(u.x), bfhi(u.x)}; f[1] = f32x2{bflo(u.y), bfhi(u.y)}; f[2] = f32x2{bflo(u.z), bfhi(u.z)}; f[3] = f32x2{bflo(u.w), bfhi(u.w)};
}
DEVI f32x2 bc2(float x) { return f32x2{x, x}; }
DEVI void rw_load(RwVec& x, const bf16_t* SV, int row, int head, int dir, int i, int jg, bool need_r) {
  const bf16_t* b = SV + ((size_t)row * 8 + head) * SVH;
  x.k = *(const uint4*)(b + 1 * 64 + jg * 8);
  x.kk = *(const uint4*)(b + 3 * 64 + jg * 8);
  x.w = *(const uint4*)(b + (4 + 2 * dir) * 64 + jg * 8);
  x.a = *(const uint4*)(b + (5 + 2 * dir) * 64 + jg * 8);
  x.v = *(const uint4*)(b + 2 * 64 + i * 8);
  if (need_r) x.r = *(const uint4*)(b + 0 * 64 + jg * 8);
}

DEVI void phase7(const Params& p) {
  const int lane = threadIdx.x & 63, warp = threadIdx.x >> 6, i = lane >> 3, jg = lane & 7;
  const bf16_t* SV = (const bf16_t*)(p.ws + R_SV);
  float* Pc = (float*)p.out;
  float* Bc = (float*)((unsigned char*)p.out + OUT_BC);
  for (int it = blockIdx.x * 4 + warp; it < (NCH - 1) * 16; it += gridDim.x * 4) {
    const int chunk = it >> 4, pair = it & 15, dir = pair >> 3, head = pair & 7;
    f32x2 S[8][4], P[8][4], ka[4];
#pragma unroll
    for (int a = 0; a < 8; ++a)
#pragma unroll
      for (int c = 0; c < 4; ++c) {
        S[a][c] = f32x2{0.f, 0.f};
        P[a][c] = f32x2{(i * 8 + a == jg * 8 + 2 * c) ? 1.f : 0.f, (i * 8 + a == jg * 8 + 2 * c + 1) ? 1.f : 0.f};
      }
#pragma unroll
    for (int c = 0; c < 4; ++c) ka[c] = f32x2{p.in[I_RKA][head * 64 + jg * 8 + 2 * c], p.in[I_RKA][head * 64 + jg * 8 + 2 * c + 1]};
    RwVec nx;
    rw_load(nx, SV, rw_row(chunk * LCH, dir), head, dir, i, jg, false);
#pragma unroll 1
    for (int t = 0; t < LCH; ++t) {
      RwVec cu = nx;
      if (t + 1 < LCH) rw_load(nx, SV, rw_row(chunk * LCH + t + 1, dir), head, dir, i, jg, false);
      f32x2 kv[4], kk[4], w[4], av[4], kka[4], keff[4]; float vv[8];
      unpack8p(cu.k, kv); unpack8p(cu.kk, kk); unpack8p(cu.w, w); unpack8p(cu.a, av); unpack8(cu.v, vv);
#pragma unroll
      for (int c = 0; c < 4; ++c) {
        w[c] = f32x2{__builtin_amdgcn_exp2f(-w[c][0]), __builtin_amdgcn_exp2f(-w[c][1])};
        kka[c] = -kk[c] * av[c];
        keff[c] = kv[c] * (bc2(1.f) + (av[c] - bc2(1.f)) * ka[c]);
      }
#pragma unroll
      for (int a = 0; a < 8; ++a) {
        f32x2 sa = S[a][0] * kk[0], qa = P[a][0] * kk[0];
#pragma unroll
        for (int c = 1; c < 4; ++c) { sa += S[a][c] * kk[c]; qa += P[a][c] * kk[c]; }
        float s1 = allred8(sa[0] + sa[1]), q1 = allred8(qa[0] + qa[1]);
        const f32x2 s2 = bc2(s1), q2 = bc2(q1), v2 = bc2(vv[a]);
#pragma unroll
        for (int c = 0; c < 4; ++c) {
          S[a][c] = S[a][c] * w[c] + s2 * kka[c] + v2 * keff[c];
          P[a][c] = P[a][c] * w[c] + q2 * kka[c];
        }
      }
    }
    float* po = Pc + ((size_t)chunk * 16 + pair) * 4096;
    float* bo = Bc + ((size_t)chunk * 16 + pair) * 4096;
#pragma unroll
    for (int a = 0; a < 8; ++a) {
      *(float4*)(po + (i * 8 + a) * 64 + jg * 8) = make_float4(P[a][0][0], P[a][0][1], P[a][1][0], P[a][1][1]);
      *(float4*)(po + (i * 8 + a) * 64 + jg * 8 + 4) = make_float4(P[a][2][0], P[a][2][1], P[a][3][0], P[a][3][1]);
      *(float4*)(bo + (i * 8 + a) * 64 + jg * 8) = make_float4(S[a][0][0], S[a][0][1], S[a][1][0], S[a][1][1]);
      *(float4*)(bo + (i * 8 + a) * 64 + jg * 8 + 4) = make_float4(S[a][2][0], S[a][2][1], S[a][3][0], S[a][3][1]);
    }
  }
}

template <bool DRY> DEVI void phase8(const Params& p, unsigned char* smem) {
  const bool wr = !DRY || (p.in[I_FG][0] == 1234.5f);
  float(*Sb)[16][68] = (float(*)[16][68])smem;
  const int tid = threadIdx.x, lane = tid & 63, warp = tid >> 6, q = lane >> 4, c16 = lane & 15;
  const float* Pc = (const float*)p.out;
  float* Bc = (float*)((unsigned char*)p.out + OUT_BC);
  constexpr int NS = NCH - 1;
  const size_t CS = (size_t)16 * 4096;
  for (int it = blockIdx.x; it < 64; it += gridDim.x) {
    const int pair = it >> 2, rg = it & 3;
    const float* Pp = Pc + (size_t)pair * 4096 + q * 64 + warp * 16 + c16;
    float* Bp = Bc + (size_t)pair * 4096 + (size_t)(rg * 16 + q * 4) * 64 + warp * 16 + c16;
    __syncthreads();
    {
      const int row = tid >> 4, c4 = (tid & 15) * 4;
      float4 v = *(const float4*)(Bc + (size_t)pair * 4096 + (size_t)(rg * 16 + row) * 64 + c4);
      Sb[0][row][c4] = v.x; Sb[0][row][c4 + 1] = v.y; Sb[0][row][c4 + 2] = v.z; Sb[0][row][c4 + 3] = v.w;
    }
    float pa[16], pb[16]; f32x4 ba, bb;
#pragma unroll
    for (int s2 = 0; s2 < 16; ++s2) { pa[s2] = Pp[CS + s2 * 256]; pb[s2] = Pp[2 * CS + s2 * 256]; }
#pragma unroll
    for (int r = 0; r < 4; ++r) { ba[r] = Bp[CS + r * 64]; bb[r] = Bp[2 * CS + r * 64]; }
    __syncthreads();
#define P8_STEP(c, pp, bv)                                                                                  \
    {                                                                                                        \
      const int rb = ((c) - 1) & 1;                                                                          \
      f32x4 acc0 = bv, acc1 = f32x4{0.f, 0.f, 0.f, 0.f};                                                     \
      _Pragma("unroll") for (int s2 = 0; s2 < 16; s2 += 2) {                                                 \
        acc0 = __builtin_amdgcn_mfma_f32_16x16x4f32(Sb[rb][c16][4 * s2 + q], pp[s2], acc0, 0, 0, 0);         \
        acc1 = __builtin_amdgcn_mfma_f32_16x16x4f32(Sb[rb][c16][4 * s2 + 4 + q], pp[s2 + 1], acc1, 0, 0, 0); \
      }                                                                                                      \
      acc0 += acc1;                                                                                          \
      if ((c) + 2 < NS) {                                                                                    \
        _Pragma("unroll") for (int s2 = 0; s2 < 16; ++s2) pp[s2] = Pp[(size_t)((c) + 2) * CS + s2 * 256];    \
        _Pragma("unroll") for (int r = 0; r < 4; ++r) bv[r] = Bp[(size_t)((c) + 2) * CS + r * 64];           \
      }                                                                                                      \
      _Pragma("unroll") for (int r = 0; r < 4; ++r) {                                                        \
        Sb[rb ^ 1][q * 4 + r][warp * 16 + c16] = acc0[r];                                                    \
        if (wr) Bp[(size_t)(c) * CS + r * 64] = acc0[r];                                                     \
      }                                                                                                      \
      __syncthreads();                                                                                       \
    }
    for (int c = 1; c < NS; c += 2) {
      P8_STEP(c, pa, ba)
      if (c + 1 < NS) P8_STEP(c + 1, pb, bb)
    }
#undef P8_STEP
  }
}

DEVI void phase9(const Params& p) {
  const int lane = threadIdx.x & 63, warp = threadIdx.x >> 6, i = lane >> 3, jg = lane & 7;
  const bf16_t* SV = (const bf16_t*)(p.ws + R_SV);
  const float* Bc = (const float*)((unsigned char*)p.out + OUT_BC);
  bf16_t* odir = (bf16_t*)p.out;
  for (int it = blockIdx.x * 4 + warp; it < NCH * 16; it += gridDim.x * 4) {
    const int chunk = it >> 4, pair = it & 15, dir = pair >> 3, head = pair & 7;
    f32x2 S[8][4], ka[4];
    if (chunk == 0) {
#pragma unroll
      for (int a = 0; a < 8; ++a)
#pragma unroll
        for (int c = 0; c < 4; ++c) S[a][c] = f32x2{0.f, 0.f};
    } else {
      const float* bs = Bc + ((size_t)(chunk - 1) * 16 + pair) * 4096;
#pragma unroll
      for (int a = 0; a < 8; ++a) {
        float4 x0 = *(const float4*)(bs + (i * 8 + a) * 64 + jg * 8), x1 = *(const float4*)(bs + (i * 8 + a) * 64 + jg * 8 + 4);
        S[a][0] = f32x2{x0.x, x0.y}; S[a][1] = f32x2{x0.z, x0.w}; S[a][2] = f32x2{x1.x, x1.y}; S[a][3] = f32x2{x1.z, x1.w};
      }
    }
#pragma unroll
    for (int c = 0; c < 4; ++c) ka[c] = f32x2{p.in[I_RKA][head * 64 + jg * 8 + 2 * c], p.in[I_RKA][head * 64 + jg * 8 + 2 * c + 1]};
    RwVec nx;
    rw_load(nx, SV, rw_row(chunk * LCH, dir), head, dir, i, jg, true);
#pragma unroll 1
    for (int t = 0; t < LCH; ++t) {
      RwVec cu = nx;
      const int row = rw_row(chunk * LCH + t, dir);
      if (t + 1 < LCH) rw_load(nx, SV, rw_row(chunk * LCH + t + 1, dir), head, dir, i, jg, true);
      f32x2 kv[4], kk[4], w[4], av[4], rr[4], kka[4], keff[4]; float vv[8];
      unpack8p(cu.k, kv); unpack8p(cu.kk, kk); unpack8p(cu.w, w); unpack8p(cu.a, av); unpack8p(cu.r, rr); unpack8(cu.v, vv);
#pragma unroll
      for (int c = 0; c < 4; ++c) {
        w[c] = f32x2{__builtin_amdgcn_exp2f(-w[c][0]), __builtin_amdgcn_exp2f(-w[c][1])};
        kka[c] = -kk[c] * av[c];
        keff[c] = kv[c] * (bc2(1.f) + (av[c] - bc2(1.f)) * ka[c]);
      }
      float ov = 0.f;
#pragma unroll
      for (int a = 0; a < 8; ++a) {
        f32x2 sa = S[a][0] * kk[0];
#pragma unroll
        for (int c = 1; c < 4; ++c) sa += S[a][c] * kk[c];
        const float s1 = allred8(sa[0] + sa[1]);
        const f32x2 s2 = bc2(s1), v2 = bc2(vv[a]);
        f32x2 oa = f32x2{0.f, 0.f};
#pragma unroll
        for (int c = 0; c < 4; ++c) {
          S[a][c] = S[a][c] * w[c] + s2 * kka[c] + v2 * keff[c];
          oa += S[a][c] * rr[c];
        }
        const float o = allred8(oa[0] + oa[1]);
        if (jg == a) ov = o;
      }
      if (row >= T_CTX) odir[((size_t)dir * T_LAT + (row - T_CTX)) * 512 + head * 64 + i * 8 + jg] = f2bf(ov);
    }
  }
}

DEVI void phase10(const Params& p) {
  const int lane = threadIdx.x & 63, warp = threadIdx.x >> 6;
  const bf16_t* odir = (const bf16_t*)p.out;
  const bf16_t* SV = (const bf16_t*)(p.ws + R_SV);
  const float* bonus = (const float*)(p.ws + O_BONUS);
  bf16_t* ya = (bf16_t*)(p.ws + O_PO);
  const int head = lane >> 3, c8 = (lane & 7) * 8, C0 = lane * 8;
#pragma unroll 2
  for (int t = blockIdx.x * 4 + warp; t < T_LAT; t += gridDim.x * 4) {
    const int row = t + T_CTX;
    const bf16_t* b = SV + ((size_t)row * 8 + head) * SVH;
    float v[8], g[8], y[8];
    unpack8(*(const uint4*)(b + 2 * 64 + c8), v);
    unpack8(*(const uint4*)(b + 8 * 64 + c8), g);
    float bs = bonus[(size_t)row * 16 + head] + bonus[(size_t)row * 16 + 8 + head];
#pragma unroll
    for (int e = 0; e < 8; ++e) y[e] = bs * v[e];
#pragma unroll
    for (int dir = 0; dir < 2; ++dir) {
      float o[8];
      unpack8(*(const uint4*)(odir + ((size_t)dir * T_LAT + t) * 512 + C0), o);
      float s = 0.f;
#pragma unroll
      for (int e = 0; e < 8; ++e) s += o[e];
      s = allred8(s);
      float mu = s * (1.f / 64.f);
      float q = 0.f;
#pragma unroll
      for (int e = 0; e < 8; ++e) { o[e] -= mu; q += o[e] * o[e]; }
      q = allred8(q);
      float rsd = rsqrtf(q * (1.f / 64.f) + 64e-5f);
#pragma unroll
      for (int e = 0; e < 8; ++e) y[e] += o[e] * rsd * p.in[I_RLNW][C0 + e] + p.in[I_RLNB][C0 + e];
    }
#pragma unroll
    for (int e = 0; e < 8; ++e) y[e] *= g[e];
    *(uint4*)(ya + (size_t)t * 512 + C0) = pack8(y);
  }
}

DEVI void phase11(const Params& p, unsigned char* smem, const XcdMap& xm) {
  const int lane = threadIdx.x & 63, warp = threadIdx.x >> 6, wm = warp >> 1, wn = warp & 1;
  const bf16_t* ya = (const bf16_t*)(p.ws + O_PO);
  const bf16_t* yb = (const bf16_t*)(p.ws + R_YA);
  const bf16_t* pg = (const bf16_t*)(p.ws + O_PG);
  bf16_t* mg = (bf16_t*)(p.ws + R_MERGED);
  for_tiles_xcd(xm, 128, 8, 8, 8, [&](int mt, int nt) {
    f32x4 acc[4][4];
    zero_acc(acc);
    gemm_core(ya + (size_t)mt * 128 * 512, 512, (const bf16_t*)(p.ws + O_WBA) + (size_t)nt * 128 * 512, 512, 512, acc, smem);
#pragma unroll
    for (int i = 0; i < 4; ++i) {
      int row = mt * 128 + wm * 64 + i * 16 + (lane & 15);
#pragma unroll
      for (int j = 0; j < 4; ++j) {
        int n = nt * 128 + wn * 64 + j * 16 + (lane >> 4) * 4;
        uint2 s = *(const uint2*)(pg + (size_t)row * 2048 + n);
        *(uint2*)(mg + (size_t)row * 1024 + n) = make_uint2(pack2(acc[i][j][0] * bflo(s.x), acc[i][j][1] * bfhi(s.x)), pack2(acc[i][j][2] * bflo(s.y), acc[i][j][3] * bfhi(s.y)));
      }
    }
    zero_acc(acc);
    gemm_core(yb + (size_t)mt * 128 * 512, 512, (const bf16_t*)(p.ws + O_WBB) + (size_t)nt * 128 * 512, 512, 512, acc, smem);
#pragma unroll
    for (int i = 0; i < 4; ++i) {
      int row = mt * 128 + wm * 64 + i * 16 + (lane & 15);
#pragma unroll
      for (int j = 0; j < 4; ++j) {
        int n = nt * 128 + wn * 64 + j * 16 + (lane >> 4) * 4;
        uint2 s = *(const uint2*)(pg + (size_t)row * 2048 + 1024 + n);
        uint2 m0 = *(const uint2*)(mg + (size_t)row * 1024 + n);
        float v0 = bflo(m0.x) + acc[i][j][0] * bflo(s.x), v1 = bfhi(m0.x) + acc[i][j][1] * bfhi(s.x);
        float v2 = bflo(m0.y) + acc[i][j][2] * bflo(s.y), v3 = bfhi(m0.y) + acc[i][j][3] * bfhi(s.y);
        *(uint2*)(mg + (size_t)row * 1024 + n) = make_uint2(pack2(v0, v1), pack2(v2, v3));
      }
    }
  });
}

DEVI void phase12(const Params& p, unsigned char* smem, const XcdMap& xm) {
  float* gt = (float*)(smem + 45056);
  const int tid = threadIdx.x, lane = tid & 63, warp = tid >> 6, wm = warp >> 1, wn = warp & 1;
  for (int i = tid; i < 1024; i += 256) gt[i] = mod_val(p, 0, 2048 + i);
  __syncthreads();
  const bf16_t* mg = (const bf16_t*)(p.ws + R_MERGED);
  const float* x = p.in[I_X];
  float* x1 = p.out;
  for_tiles_xcd(xm, 128, 8, 8, 8, [&](int mt, int nt) {
    f32x4 acc[4][4];
    zero_acc(acc);
    gemm_core(mg + (size_t)mt * 128 * 1024, 1024, (const bf16_t*)(p.ws + O_WOUT) + (size_t)nt * 128 * 1024, 1024, 1024, acc, smem);
#pragma unroll
    for (int i = 0; i < 4; ++i) {
      int row = mt * 128 + wm * 64 + i * 16 + (lane & 15);
#pragma unroll
      for (int j = 0; j < 4; ++j) {
        int n = nt * 128 + wn * 64 + j * 16 + (lane >> 4) * 4;
        float4 xv = *(const float4*)(x + (size_t)row * 1024 + n);
        xv.x += gt[n] * acc[i][j][0]; xv.y += gt[n + 1] * acc[i][j][1]; xv.z += gt[n + 2] * acc[i][j][2]; xv.w += gt[n + 3] * acc[i][j][3];
        *(float4*)(x1 + (size_t)row * 1024 + n) = xv;
      }
    }
  });
}

DEVI void phase13(const Params& p, unsigned char* smem) {
  float* smod = (float*)smem;
  const int tid = threadIdx.x, lane = tid & 63, warp = tid >> 6;
  for (int i = tid; i < 2048; i += 256) smod[i] = mod_val(p, 0, 3072 + i);
  __syncthreads();
  const float* x1 = p.out;
  bf16_t* h2 = (bf16_t*)(p.ws + R_H2);
  for (int rp = blockIdx.x * 4 + warp; rp < T_LAT / 2; rp += gridDim.x * 4) {
    float h[2][16]; float ss[2] = {0.f, 0.f};
#pragma unroll
    for (int u = 0; u < 2; ++u)
#pragma unroll
      for (int i = 0; i < 4; ++i) {
        float4 v = *(const float4*)(x1 + (size_t)(rp * 2 + u) * 1024 + i * 256 + lane * 4);
        h[u][4 * i] = v.x; h[u][4 * i + 1] = v.y; h[u][4 * i + 2] = v.z; h[u][4 * i + 3] = v.w;
        ss[u] += v.x * v.x + v.y * v.y + v.z * v.z + v.w * v.w;
      }
#pragma unroll
    for (int u = 0; u < 2; ++u) {
      const int row = rp * 2 + u;
      const float rstd = rsqrtf(wave_sum_u(ss[u]) * (1.f / 1024.f) + 1e-6f);
#pragma unroll
      for (int i = 0; i < 4; ++i) {
#pragma unroll
        for (int e = 0; e < 4; ++e) {
          int k = i * 256 + lane * 4 + e;
          float y = h[u][4 * i + e] * rstd * p.in[I_N2G][k];
          h[u][4 * i + e] = y * (1.f + smod[1024 + k]) + smod[k];
        }
        *(uint2*)(h2 + (size_t)row * 1024 + i * 256 + lane * 4) = make_uint2(pack2(h[u][4 * i], h[u][4 * i + 1]), pack2(h[u][4 * i + 2], h[u][4 * i + 3]));
      }
    }
  }
}

DEVI void phase14(const Params& p, unsigned char* smem, const XcdMap& xm) {
  bf16_t(*Qt)[136] = (bf16_t(*)[136])smem;
  float* Sc = (float*)smem;
  const int tid = threadIdx.x, lane = tid & 63, warp = tid >> 6, wm = warp >> 1, wn = warp & 1;
  const bf16_t* h2 = (const bf16_t*)(p.ws + R_H2);
  const bf16_t* keys = (const bf16_t*)(p.ws + O_KEYS);
  float* tops = (float*)(p.ws + R_TOPS);
  int* topi = (int*)(p.ws + R_TOPI);
  for_tiles_xcd(xm, 128, 16, 8, 8, [&](int mt, int hp) {
    f32x4 acc[4][4];
    zero_acc(acc);
    gemm_core(h2 + (size_t)mt * 128 * 1024, 1024, (const bf16_t*)(p.ws + O_WQ) + (size_t)hp * 128 * 1024, 1024, 1024, acc, smem);
#pragma unroll
    for (int i = 0; i < 4; ++i)
#pragma unroll
      for (int j = 0; j < 4; ++j)
        *(uint2*)&Qt[wm * 64 + i * 16 + (lane & 15)][wn * 64 + j * 16 + (lane >> 4) * 4] =
            make_uint2(pack2(acc[i][j][0], acc[i][j][1]), pack2(acc[i][j][2], acc[i][j][3]));
    __syncthreads();
    zero_acc(acc);
#pragma unroll
    for (int ks = 0; ks < 4; ++ks) {
      bf16x8 qf[4], kf[4];
#pragma unroll
      for (int i = 0; i < 4; ++i) qf[i] = *(const bf16x8*)&Qt[wm * 64 + i * 16 + (lane & 15)][ks * 32 + (lane >> 4) * 8];
#pragma unroll
      for (int j = 0; j < 4; ++j) kf[j] = *(const bf16x8*)(keys + ((size_t)hp * 128 + wn * 64 + j * 16 + (lane & 15)) * 128 + ks * 32 + (lane >> 4) * 8);
#pragma unroll
      for (int i = 0; i < 4; ++i)
#pragma unroll
        for (int j = 0; j < 4; ++j) acc[i][j] = __builtin_amdgcn_mfma_f32_16x16x32_bf16(kf[j], qf[i], acc[i][j], 0, 0, 0);
    }
    __syncthreads();
#pragma unroll
    for (int i = 0; i < 4; ++i)
#pragma unroll
      for (int j = 0; j < 4; ++j) {
        {
          const int c0 = j * 16 + (lane >> 4) * 4;
          u32x4 kq;
#pragma unroll
          for (int r = 0; r < 4; ++r) {
            unsigned u = __float_as_uint(acc[i][j][r]);
            u = (u & 0x80000000u) ? ~u : (u | 0x80000000u);
            kq[r] = (u & ~63u) | (unsigned)(63 - (c0 + r));
          }
          *(u32x4*)(Sc + (wm * 64 + i * 16 + (lane & 15)) * 132 + wn * 64 + c0) = kq;
        }
      }
    __syncthreads();
    {
      const int row = tid & 127, half = tid >> 7;
      float* hp_ = Sc + row * 132 + half * 64;
      float bv[16]; int bi[16];
      unsigned* hk = (unsigned*)hp_;
#pragma unroll
      for (int r = 0; r < 16; ++r) {
        unsigned best = 0u;
#pragma unroll 4
        for (int k = 0; k < 64; k += 4) {
          const u32x4 v4 = *(const u32x4*)(hk + k);
          const unsigned m01 = v4[0] > v4[1] ? v4[0] : v4[1], m23 = v4[2] > v4[3] ? v4[2] : v4[3];
          const unsigned m = m01 > m23 ? m01 : m23;
          best = best > m ? best : m;
        }
        const int b2 = 63 - (int)(best & 63u);
        unsigned u = best & ~63u;
        u = (u & 0x80000000u) ? (u & 0x7fffffffu) : ~u;
        bv[r] = __uint_as_float(u); bi[r] = b2 + half * 64; hk[b2] = 0u;
      }
#pragma unroll
      for (int r = 0; r < 16; ++r) { hp_[r] = bv[r]; hp_[16 + r] = __int_as_float(bi[r]); }
    }
    __syncthreads();
    if (tid < 128) {
      const float* la = Sc + tid * 132; const float* lb = la + 64;
      size_t ob = ((size_t)(mt * 128 + tid) * 16 + hp) * 16;
      int ia = 0, ib = 0;
      for (int r = 0; r < 16; ++r) {
        float va = la[ia], vb = lb[ib];
        bool ta = va >= vb;
        tops[ob + r] = ta ? va : vb;
        topi[ob + r] = __float_as_int(ta ? la[16 + ia] : lb[16 + ib]);
        ia += ta ? 1 : 0; ib += ta ? 0 : 1;
      }
    }
    __syncthreads();
  });
}

template <bool DRY> DEVI void phase15(const Params& p, unsigned char* smem) {
  const bool wr = !DRY || (p.in[I_FG][0] == 1234.5f);
  float* gt = (float*)smem;
  const int tid = threadIdx.x, lane = tid & 63, warp = tid >> 6;
  for (int i = tid; i < 1024; i += 256) gt[i] = mod_val(p, 0, 5120 + i);
  __syncthreads();
  const bf16_t* __restrict__ h2 = (const bf16_t*)(p.ws + R_H2);
  const float* __restrict__ tops = (const float*)(p.ws + R_TOPS);
  const int* __restrict__ topi = (const int*)(p.ws + R_TOPI);
  const unsigned char* __restrict__ uf8 = p.ws + R_UBF;
  const unsigned char* __restrict__ vf8 = p.ws + R_VBF;
  float* xo = p.out;
  int ca, cb;
  {
    int l = lane;
    if (l < 16) { ca = 0; cb = l; } else if (l < 24) { ca = 1; cb = l - 16; } else if (l < 29) { ca = 2; cb = l - 24; }
    else if (l < 33) { ca = 3; cb = l - 29; } else if (l < 36) { ca = 4; cb = l - 33; } else if (l < 38) { ca = 5; cb = l - 36; }
    else if (l < 40) { ca = 6; cb = l - 38; } else if (l < 42) { ca = 7; cb = l - 40; } else if (l < 50) { ca = l - 34; cb = 0; }
    else { ca = 0; cb = 0; }
  }
  const int flat = ca * 16 + cb;
  for (int t = blockIdx.x * 4 + warp; t < T_LAT; t += gridDim.x * 4) {
    float hv[16], out[16];
    {
      const u32x4 hp0 = *(const u32x4*)(h2 + (size_t)t * 1024 + lane * 16);
      const u32x4 hp1 = *(const u32x4*)(h2 + (size_t)t * 1024 + lane * 16 + 8);
#pragma unroll
      for (int e = 0; e < 4; ++e) { hv[2 * e] = bflo(hp0[e]); hv[2 * e + 1] = bfhi(hp0[e]); hv[8 + 2 * e] = bflo(hp1[e]); hv[8 + 2 * e + 1] = bfhi(hp1[e]); }
    }
#pragma unroll
    for (int e = 0; e < 16; ++e) out[e] = 0.f;
#pragma unroll 1
    for (int hd = 0; hd < 8; ++hd) {
      const size_t b1 = ((size_t)t * 16 + hd * 2) * 16, b2 = b1 + 16;
      float val = lane < 50 ? tops[b1 + ca] + tops[b2 + cb] : -INFINITY;
      int idx = topi[b1 + ca] * 128 + topi[b2 + cb];
      int cnt = 0;
#pragma unroll
      for (int i = 0; i < 50; ++i) {
        float vi = rlf(val, i);
        int fi = __builtin_amdgcn_readlane(flat, i);
        cnt += ((vi > val) || (vi == val && fi < flat)) ? 1 : 0;
      }
      bool sel = lane < 50 && cnt < 16;
      float vmax = rlf(val, 0);
      float ex = sel ? __expf(val - vmax) : 0.f;
      float gsum = wave_sum_u(ex);
      float g = ex / gsum;
      unsigned long long m1 = __ballot(sel);
      int es[16];
      float gq = 0.f;
#pragma unroll
      for (int q = 0; q < 16; ++q) {
        int src = __ffsll((long long)m1) - 1; m1 &= m1 - 1;
        es[q] = __builtin_amdgcn_readlane(idx, src);
        float gg = rlf(g, src);
        if (lane == q) gq = gg;
      }
      float dm = 0.f;
      {
        u32x4 ub[16];
#pragma unroll
        for (int q = 0; q < 16; ++q) ub[q] = *(const u32x4*)(uf8 + (size_t)es[q] * 1024 + lane * 16);
#pragma unroll
        for (int q = 0; q < 16; ++q) {
          float f[16]; unpack_fp8x16(ub[q], f);
          float d0 = 0.f, d1 = 0.f;
#pragma unroll
          for (int e = 0; e < 8; ++e) { d0 += f[2 * e] * hv[2 * e]; d1 += f[2 * e + 1] * hv[2 * e + 1]; }
          float d = wave_sum_u(d0 + d1);
          if (lane == q) dm = d;
        }
      }
      dm *= (1.f / 64.f);
      float coef = gq * 0.5f * dm * (1.f + erff(dm * 0.70710678118f)) * 0.25f;
      {
        u32x4 vb[16];
#pragma unroll
        for (int q = 0; q < 16; ++q) vb[q] = *(const u32x4*)(vf8 + (size_t)es[q] * 1024 + lane * 16);
#pragma unroll
        for (int q = 0; q < 16; ++q) {
          float cf = rlf(coef, q);
          float f[16]; unpack_fp8x16(vb[q], f);
#pragma unroll
          for (int e = 0; e < 16; ++e) out[e] += cf * f[e];
        }
      }
    }
    float xs[16]; float ss = 0.f;
#pragma unroll
    for (int i = 0; i < 4; ++i) {
      int k = lane * 16 + i * 4;
      float4 v = *(const float4*)(xo + (size_t)t * 1024 + k);
      xs[4 * i] = v.x + gt[k] * out[4 * i]; xs[4 * i + 1] = v.y + gt[k + 1] * out[4 * i + 1];
      xs[4 * i + 2] = v.z + gt[k + 2] * out[4 * i + 2]; xs[4 * i + 3] = v.w + gt[k + 3] * out[4 * i + 3];
      ss += xs[4 * i] * xs[4 * i] + xs[4 * i + 1] * xs[4 * i + 1] + xs[4 * i + 2] * xs[4 * i + 2] + xs[4 * i + 3] * xs[4 * i + 3];
    }
    ss = wave_sum_u(ss);
    float rstd = rsqrtf(ss * (1.f / 1024.f) + 1e-6f);
#pragma unroll
    for (int i = 0; i < 4; ++i) {
      int k = lane * 16 + i * 4;
      float4 g4 = *(const float4*)(p.in[I_FG] + k);
      if (wr) *(float4*)(xo + (size_t)t * 1024 + k) = make_float4(xs[4 * i] * rstd * g4.x, xs[4 * i + 1] * rstd * g4.y, xs[4 * i + 2] * rstd * g4.z, xs[4 * i + 3] * rstd * g4.w);
    }
  }
}

#define XB_TMO      128
#define XB_XCNT(j)  (256  + 64 * (j))
#define XB_XSUB(j)  (1280 + 64 * (j))
#define XB_XGEN(j)  (2304 + 64 * (j))
#define XB_TOP      3328
#define XB_TOPGEN   3392
#define XCD_BAR_WORDS 3456
#define XB_SPIN_CAP (1u << 22)
#define LAS __attribute__((address_space(3)))
DEVI unsigned xb_ld(unsigned* p) { return __hip_atomic_load(p, __ATOMIC_RELAXED, __HIP_MEMORY_SCOPE_AGENT); }
DEVI unsigned xb_add(unsigned* p, unsigned v) { return __hip_atomic_fetch_add(p, v, __ATOMIC_RELAXED, __HIP_MEMORY_SCOPE_AGENT); }
DEVI unsigned xb_xcc_id() { return (unsigned)__builtin_amdgcn_s_getreg((3 << 11) | 20) & 0xFu; }
#define XB_SPIN(cond, bar) do { unsigned _sp = 0; while (cond) { __builtin_amdgcn_s_sleep(1); \
    if ((++_sp & 255u) == 0u) { if (xb_ld(&(bar)[XB_TMO])) break; if (_sp > XB_SPIN_CAP) { atomicAdd(&(bar)[XB_TMO], 1u); break; } } } } while (0)
struct XcdBarrier { unsigned* bar; unsigned x; volatile LAS unsigned* st; };
DEVI XcdBarrier xcd_barrier_post(unsigned* bar, volatile LAS unsigned* st) {
  XcdBarrier b; b.bar = bar; b.x = xb_xcc_id(); b.st = st;
  if (threadIdx.x == 0) st[2] = xb_add(&bar[XB_XCNT(b.x)], 1u);
  return b;
}
DEVI void xcd_barrier_complete(unsigned* bar, unsigned x, unsigned& nloc, unsigned& nx, unsigned& vidx) {
  const unsigned G = gridDim.x * gridDim.y * gridDim.z;
  unsigned sum, cnt, mine, below, sp = 0u;
  for (;;) {
    sum = 0u; cnt = 0u; mine = 0u; below = 0u;
#pragma unroll
    for (unsigned j = 0; j < 16; ++j) { const unsigned c = xb_ld(&bar[XB_XCNT(j)]); sum += c; cnt += (c > 0u) ? 1u : 0u; mine = (j == x) ? c : mine; below += (c > 0u && j < x) ? 1u : 0u; }
    if (sum == G) break;
    __builtin_amdgcn_s_sleep(1);
    if ((++sp & 255u) == 0u) { if (xb_ld(&bar[XB_TMO])) break; if (sp > XB_SPIN_CAP) { atomicAdd(&bar[XB_TMO], 1u); break; } }
  }
  nloc = mine > 0u ? mine : 1u; nx = cnt > 0u ? cnt : 1u; vidx = below;
}
DEVI void xcd_barrier(const XcdBarrier& b) {
  asm volatile("s_waitcnt vmcnt(0)" ::: "memory");
  __syncthreads();
  if (threadIdx.x == 0) {
    unsigned* bar = b.bar;
    __builtin_amdgcn_s_waitcnt(0);
    unsigned nloc = b.st[0], nx = b.st[1];
    if (nloc == 0u) { unsigned vidx; xcd_barrier_complete(bar, b.x, nloc, nx, vidx); b.st[0] = nloc; b.st[1] = nx; b.st[3] = vidx; }
    const unsigned old = xb_add(&bar[XB_XSUB(b.x)], 1u);
    const unsigned gen = old / nloc;
    if (old + 1u == (gen + 1u) * nloc) {
      __builtin_amdgcn_fence(__ATOMIC_RELEASE, "agent");
      asm volatile("s_waitcnt vmcnt(0)" ::: "memory");
      const unsigned og = xb_add(&bar[XB_TOP], 1u);
      const unsigned tg = og / nx;
      if (og + 1u == (tg + 1u) * nx) xb_add(&bar[XB_TOPGEN], 1u);
      else XB_SPIN(xb_ld(&bar[XB_TOPGEN]) == tg, bar);
      __builtin_amdgcn_fence(__ATOMIC_ACQUIRE, "agent");
      xb_add(&bar[XB_XGEN(b.x)], 1u);
      asm volatile("s_waitcnt vmcnt(0)" ::: "memory");
    } else {
      XB_SPIN(xb_ld(&bar[XB_XGEN(b.x)]) == gen, bar);
      __builtin_amdgcn_fence(__ATOMIC_ACQUIRE, "agent");
      asm volatile("s_waitcnt vmcnt(0)" ::: "memory");
    }
  }
  __syncthreads();
}

constexpr int NPHASE = 16;
DEVI XcdMap get_xm(int coop, const uint4& w) {
  XcdMap m;
  if (coop) { m.v = (int)w.w; m.nx = (int)w.y; m.slot = (int)w.z; m.slots = (int)w.x; }
  else { m.v = blockIdx.x & 7; m.nx = 8; m.slot = blockIdx.x >> 3; m.slots = gridDim.x >> 3; if (m.slots < 1) { m.slots = 1; } }
  return m;
}
__global__ void __launch_bounds__(256, 2) mk(Params p, int ph0, int ph1, int coop) {
  __shared__ __attribute__((aligned(16))) unsigned char smem[SMEM_BYTES];
  __shared__ uint4 xb_words;
  if (threadIdx.x == 0) xb_words = make_uint4(0u, 0u, 0u, 0u);
  __syncthreads();
  XcdBarrier xb;
  if (coop) xb = xcd_barrier_post((unsigned*)(p.ws + O_BAR), (volatile LAS unsigned*)&xb_words);
#ifdef XCC_PROBE
  if (coop && xb_xcc_id() != (blockIdx.x & 7u)) { unsigned long long t0 = wall_clock64(); while (wall_clock64() - t0 < 100000ull) __builtin_amdgcn_s_sleep(8); }
#endif
  if (ph0 < 0) cg::this_grid().sync();
#ifdef PROBE_A
#define STAMP(n) if (blockIdx.x == 0 && threadIdx.x == 0) ((unsigned long long*)(p.ws + O_STAMP))[n] = wall_clock64();
#else
#define STAMP(n)
#endif
#define RUN_PHASE(n, call)                                   \
  if (ph0 <= n && n < ph1) {                                 \
    STAMP(n)                                                 \
        if (DRY_PH == n) { if (n == 4) phase4<true>(p); if (n == 5) phase5<true>(p, smem); if (n == 8) phase8<true>(p, smem); if (n == 15) phase15<true>(p, smem); } \
    if (ONLY < 0 || ONLY == n) { call; }                     \
    if (REPEAT_PH == n) { call; }                            \
    if (coop && n + 1 < ph1) xcd_barrier(xb);                \
  }
  RUN_PHASE(0, phase0(p, smem, 0, 384))
  RUN_PHASE(1, (phase1(p, smem), __syncthreads(), phase0(p, smem, 384, 1 << 30)))
  RUN_PHASE(2, phase2(p, smem, get_xm(coop, xb_words)))
  RUN_PHASE(3, phase3(p, smem))
  RUN_PHASE(4, (phase4<false>(p), phase6(p, smem, 0, 32, gridDim.x > 290 ? 258 : 0, gridDim.x > 290 ? (int)gridDim.x - 258 : (int)gridDim.x)))
  RUN_PHASE(5, phase5<false>(p, smem))
  RUN_PHASE(6, phase6(p, smem, 32, 260 * 8, 0, (int)gridDim.x))
  RUN_PHASE(7, phase7(p))
  RUN_PHASE(8, phase8<false>(p, smem))
  RUN_PHASE(9, phase9(p))
  RUN_PHASE(10, phase10(p))
  RUN_PHASE(11, phase11(p, smem, get_xm(coop, xb_words)))
  RUN_PHASE(12, (phase12(p, smem, get_xm(coop, xb_words)), convert_fp8(p.in[I_PU], p.ws + R_UBF, (size_t)16384 * 64, 64.f)))
  RUN_PHASE(13, phase13(p, smem))
  RUN_PHASE(14, (phase14(p, smem, get_xm(coop, xb_words)), convert_fp8(p.in[I_PV], p.ws + R_VBF, (size_t)16384 * 64, 4.f)))
  RUN_PHASE(15, phase15<false>(p, smem))
#ifdef SYNC_EXTRA
  for (int i = 0; i < SYNC_EXTRA; ++i) xcd_barrier(xb);
#endif
#ifdef PROBE_A
  cg::this_grid().sync();
  STAMP(16)
  __syncthreads();
  if (blockIdx.x == 0) {
    const unsigned long long* st = (const unsigned long long*)(p.ws + O_STAMP);
    float ta = (float)(st[PROBE_A + 1] - st[PROBE_A]) * 0.01f, tb = (float)(st[PROBE_B + 1] - st[PROBE_B]) * 0.01f;
    for (int i = threadIdx.x; i < 1000000; i += 256) p.out[1 + i] = tb;
    if (threadIdx.x == 0) p.out[0] = 100.f * ta;
  }
#endif
}

extern "C" void kernel_launch(void* const* d_in, const int* in_sizes, int n_in, void* d_out, int out_size, void* d_ws,
                              size_t ws_size, hipStream_t stream) {
  static int grid_blocks = 0;
  if (!grid_blocks) {
    int dev = 0, cus = 0, per_cu = 0;
    hipGetDevice(&dev);
    hipDeviceGetAttribute(&cus, hipDeviceAttributeMultiprocessorCount, dev);
    hipOccupancyMaxActiveBlocksPerMultiprocessor(&per_cu, mk, 256, 0);
    if (per_cu < 1) per_cu = 1;
    if (per_cu > 2) per_cu = 2;
    grid_blocks = cus * per_cu;
  }
  if (ws_size < WS_NEED) { fprintf(stderr, "workspace too small: %zu < %zu\n", ws_size, (size_t)WS_NEED); return; }
  Params p{};
  for (int i = 0; i < 32; ++i) p.in[i] = (const float*)d_in[i];
  p.out = (float*)d_out;
  p.ws = (unsigned char*)d_ws;
#if MEGA
  (void)hipMemsetAsync((unsigned char*)d_ws + O_BAR, 0, XCD_BAR_WORDS * 4, stream);
  int ph0 = 0, ph1 = NPHASE, coop = 1;
  void* args[] = {&p, &ph0, &ph1, &coop};
  hipError_t e = hipLaunchCooperativeKernel((void*)mk, dim3(grid_blocks), dim3(256), args, 0, stream);
  if (e != hipSuccess) fprintf(stderr, "cooperative launch failed: %s (grid %d)\n", hipGetErrorString(e), grid_blocks);
#else
  for (int ph = 0; ph < NPHASE; ++ph) mk<<<grid_blocks, 256, 0, stream>>>(p, ph, ph + 1, 0);
#endif
}
```

```cpp
#include <hip/hip_runtime.h>
#include <hip/hip_cooperative_groups.h>
#include <cstdio>
#include <cstdint>
namespace cg = cooperative_groups;

#ifndef MEGA
#define MEGA 1
#endif
#ifndef ONLY
#define ONLY -1
#endif
#ifndef REPEAT_PH
#define REPEAT_PH -1
#endif
#ifndef DRY_PH
#define DRY_PH -1
#endif

typedef unsigned short bf16_t;
using bf16x8 = __attribute__((ext_vector_type(8))) short;
using f32x4 = __attribute__((ext_vector_type(4))) float;
using u32x4 = __attribute__((ext_vector_type(4))) unsigned;
#define DEVI __device__ __forceinline__

constexpr int T_CTX = 256, T_LAT = 16384, T_ALL = 16640;
constexpr int NIN = 5392, NP = 5376;
constexpr int NCH = 128, LCH = 130;
constexpr int SVH = 576;
constexpr int SMEM_BYTES = 71680;

enum { I_X = 0, I_C, I_CTX, I_CCTX, I_ADAW, I_ADAB, I_N1G, I_WIN, I_RCONV, I_RW0, I_RWUP, I_RA0, I_RAUP, I_RGUP,
       I_RKK, I_RKA, I_RRK, I_RLNW, I_RLNB, I_MCONV, I_MIB, I_MFB, I_MNG, I_WBA, I_WBB, I_WOUT, I_N2G, I_WQ,
       I_KEYS, I_PU, I_PV, I_FG };

struct Params { const float* in[32]; float* out; unsigned char* ws; };

constexpr size_t A256(size_t x) { return (x + 255) & ~(size_t)255; }
constexpr size_t O_MODP = 0;
constexpr size_t O_WBA = A256(O_MODP + (size_t)16 * 2 * 6144 * 4);
constexpr size_t O_WBB = A256(O_WBA + (size_t)1024 * 512 * 2);
constexpr size_t O_WOUT = A256(O_WBB + (size_t)1024 * 512 * 2);
constexpr size_t O_WQ = A256(O_WOUT + (size_t)1024 * 1024 * 2);
constexpr size_t O_KEYS = A256(O_WQ + (size_t)2048 * 1024 * 2);
constexpr size_t O_WUP = A256(O_KEYS + (size_t)16 * 128 * 128 * 2);
constexpr size_t O_AUP = A256(O_WUP + (size_t)1024 * 64 * 2);
constexpr size_t O_GUP = A256(O_AUP + (size_t)1024 * 64 * 2);
constexpr size_t O_BEND = A256(O_GUP + (size_t)512 * 128 * 2);
constexpr size_t O_MLOC = A256(O_BEND + (size_t)260 * 8 * 4);
constexpr size_t O_MST = A256(O_MLOC + (size_t)260 * 8 * 4);
constexpr size_t O_NT = A256(O_MST + (size_t)260 * 8 * 4);
constexpr size_t O_BONUS = A256(O_NT + (size_t)260 * 8 * 64 * 4);
constexpr size_t O_STAMP = A256(O_BONUS + (size_t)T_ALL * 16 * 4);
constexpr size_t O_BAR = A256(O_STAMP + 1024);
constexpr size_t O_PG = A256(O_BAR + 3456 * 4);
constexpr size_t O_PO = A256(O_PG + (size_t)T_LAT * 2048 * 2);
constexpr size_t O_R = A256(O_PO + (size_t)T_LAT * 512 * 2);
constexpr size_t R_HX = O_R;
constexpr size_t R_WIN = A256(R_HX + (size_t)T_ALL * 1024 * 2);
constexpr size_t R_PQK = A256(R_WIN + (size_t)(NP + 128) * 1024 * 2);
constexpr size_t R_PV = A256(R_PQK + (size_t)T_ALL * 512 * 2);
constexpr size_t R_GIF = A256(R_PV + (size_t)T_ALL * 512 * 2);
constexpr size_t R_U = A256(R_GIF + (size_t)T_ALL * 16 * 4);
constexpr size_t R_END1 = A256(R_U + (size_t)260 * 8 * 8192 * 4);
constexpr size_t R_SV = O_R;
constexpr size_t R_YA = A256(R_SV + (size_t)T_ALL * 8 * SVH * 2);
constexpr size_t R_END2 = A256(R_YA + (size_t)T_LAT * 512 * 2);
constexpr size_t R_MERGED = O_R;
constexpr size_t R_H2 = A256(R_MERGED + (size_t)T_LAT * 1024 * 2);
constexpr size_t R_TOPS = A256(R_H2 + (size_t)T_LAT * 1024 * 2);
constexpr size_t R_TOPI = A256(R_TOPS + (size_t)T_LAT * 256 * 4);
constexpr size_t R_UBF = A256(R_TOPI + (size_t)T_LAT * 256 * 4);
constexpr size_t R_VBF = A256(R_UBF + (size_t)16384 * 1024 * 2);
constexpr size_t R_END3 = A256(R_VBF + (size_t)16384 * 1024 * 2);
constexpr size_t WS_NEED = (R_END1 > R_END2 ? (R_END1 > R_END3 ? R_END1 : R_END3) : (R_END2 > R_END3 ? R_END2 : R_END3));
constexpr size_t OUT_BC = (size_t)NCH * 16 * 4096 * 4;

DEVI bf16_t f2bf(float f) { unsigned u = __float_as_uint(f); u += 0x7fffu + ((u >> 16) & 1u); return (bf16_t)(u >> 16); }
DEVI float bf2f(bf16_t h) { return __uint_as_float(((unsigned)h) << 16); }
DEVI float bflo(unsigned u) { return __uint_as_float(u << 16); }
DEVI float bfhi(unsigned u) { return __uint_as_float(u & 0xffff0000u); }
DEVI unsigned pack2(float a, float b) { return (unsigned)f2bf(a) | ((unsigned)f2bf(b) << 16); }
DEVI void unpack8(const uint4& u, float* f) {
  f[0] = bflo(u.x); f[1] = bfhi(u.x); f[2] = bflo(u.y); f[3] = bfhi(u.y);
  f[4] = bflo(u.z); f[5] = bfhi(u.z); f[6] = bflo(u.w); f[7] = bfhi(u.w);
}
DEVI uint4 pack8(const float* f) { return make_uint4(pack2(f[0], f[1]), pack2(f[2], f[3]), pack2(f[4], f[5]), pack2(f[6], f[7])); }
DEVI float wave_sum(float v) {
#pragma unroll
  for (int o = 32; o; o >>= 1) v += __shfl_xor(v, o);
  return v;
}
DEVI float wave_max(float v) {
#pragma unroll
  for (int o = 32; o; o >>= 1) v = fmaxf(v, __shfl_xor(v, o));
  return v;
}
DEVI float sigm(float x) { return 1.f / (1.f + __expf(-x)); }
DEVI float siluf(float x) { return x / (1.f + __expf(-x)); }
DEVI float logsig(float x) { return fminf(x, 0.f) - log1pf(expf(-fabsf(x))); }
template <int CTRL> DEVI float dppf(float v) { return __int_as_float(__builtin_amdgcn_update_dpp(0, __float_as_int(v), CTRL, 0xf, 0xf, true)); }
DEVI float rlf(float v, int l) { return __int_as_float(__builtin_amdgcn_readlane(__float_as_int(v), l)); }
DEVI float wave_sum_u(float v) {
  v += dppf<0xB1>(v); v += dppf<0x4E>(v); v += dppf<0x141>(v); v += dppf<0x140>(v);
  return (rlf(v, 0) + rlf(v, 16)) + (rlf(v, 32) + rlf(v, 48));
}
typedef __attribute__((ext_vector_type(2))) short s16x2;
DEVI float dot2bf(unsigned a, unsigned b, float c) { return __builtin_amdgcn_fdot2_f32_bf16(__builtin_bit_cast(s16x2, a), __builtin_bit_cast(s16x2, b), c, false); }
typedef __attribute__((ext_vector_type(2))) float f32x2;
DEVI void convert_fp8(const float* __restrict__ src, unsigned char* __restrict__ dst, size_t n16, float scale) {
  for (size_t g = (size_t)blockIdx.x * 256 + threadIdx.x; g < n16; g += (size_t)gridDim.x * 256) {
    u32x4 o;
#pragma unroll
    for (int q = 0; q < 4; ++q) {
      float4 a = *(const float4*)(src + g * 16 + q * 4);
      int pk = __builtin_amdgcn_cvt_pk_fp8_f32(a.x * scale, a.y * scale, 0, false);
      pk = __builtin_amdgcn_cvt_pk_fp8_f32(a.z * scale, a.w * scale, pk, true);
      o[q] = (unsigned)pk;
    }
    *(u32x4*)(dst + g * 16) = o;
  }
}
DEVI void unpack_fp8x16(const u32x4& u, float* f) {
#pragma unroll
  for (int q = 0; q < 4; ++q) {
    f32x2 lo = __builtin_amdgcn_cvt_pk_f32_fp8((int)u[q], false), hi = __builtin_amdgcn_cvt_pk_f32_fp8((int)u[q], true);
    f[4 * q] = lo[0]; f[4 * q + 1] = lo[1]; f[4 * q + 2] = hi[0]; f[4 * q + 3] = hi[1];
  }
}
DEVI void convert_bf16(const float* __restrict__ src, bf16_t* __restrict__ dst, size_t n8) {
  for (size_t g = (size_t)blockIdx.x * 256 + threadIdx.x; g < n8; g += (size_t)gridDim.x * 256) {
    float4 a = *(const float4*)(src + g * 8), b = *(const float4*)(src + g * 8 + 4);
    *(uint4*)(dst + g * 8) = make_uint4(pack2(a.x, a.y), pack2(a.z, a.w), pack2(b.x, b.y), pack2(b.z, b.w));
  }
}
DEVI float allred8(float v) { v += dppf<0xB1>(v); v += dppf<0x4E>(v); v += dppf<0x141>(v); return v; }

DEVI int ml_row(int c, int j) {
  if (c < 4) return c * 64 + j;
  int cc = c - 4; int col = cc >> 2; int gr = (cc & 3) * 64 + j;
  return T_CTX + gr * 64 + col;
}
DEVI int ml_sc(int c, int dir) { return dir == 0 ? c : (c < 4 ? 3 - c : 263 - c); }
DEVI int rw_row(int p, int dir) { return dir == 0 ? p : (p < T_CTX ? (T_CTX - 1 - p) : (T_ALL + T_CTX - 1 - p)); }

DEVI float mod_val(const Params& p, int which, int col) {
  const float* modp = (const float*)(p.ws + O_MODP);
  float s = p.in[I_ADAB][col];
#pragma unroll
  for (int rs = 0; rs < 16; ++rs) s += modp[(rs * 2 + which) * 6144 + col];
  return s;
}

DEVI void gemm_core(const bf16_t* __restrict__ A, int lda, const bf16_t* __restrict__ Bt, int ldb, int K,
                    f32x4 (&acc)[4][4], unsigned char* smem) {
  bf16_t(*sa)[80] = (bf16_t(*)[80])smem;
  bf16_t(*sb)[80] = (bf16_t(*)[80])(smem + 128 * 80 * 2);
  const int tid = threadIdx.x, lane = tid & 63, warp = tid >> 6, wm = warp >> 1, wn = warp & 1;
  const int lr = tid >> 3, lk = (tid & 7) * 8;
  const bf16_t* Ap = A + (size_t)lr * lda + lk;
  const bf16_t* Bp = Bt + (size_t)lr * ldb + lk;
  u32x4 ra0[4], rb0[4], ra1[4], rb1[4];
#pragma unroll
  for (int i = 0; i < 4; ++i) {
    ra0[i] = *(const u32x4*)(Ap + (size_t)(32 * i) * lda); rb0[i] = *(const u32x4*)(Bp + (size_t)(32 * i) * ldb);
    ra1[i] = *(const u32x4*)(Ap + (size_t)(32 * i) * lda + 64); rb1[i] = *(const u32x4*)(Bp + (size_t)(32 * i) * ldb + 64);
  }
#define GEMM_STEP(k0, ra, rb)                                                                                 \
  {                                                                                                           \
    __syncthreads();                                                                                          \
    _Pragma("unroll") for (int i = 0; i < 4; ++i) { *(u32x4*)&sa[lr + 32 * i][lk] = ra[i]; *(u32x4*)&sb[lr + 32 * i][lk] = rb[i]; } \
    __syncthreads();                                                                                          \
    if ((k0) + 128 < K) {                                                                                     \
      _Pragma("unroll") for (int i = 0; i < 4; ++i) {                                                         \
        ra[i] = *(const u32x4*)(Ap + (size_t)(32 * i) * lda + (k0) + 128);                                    \
        rb[i] = *(const u32x4*)(Bp + (size_t)(32 * i) * ldb + (k0) + 128);                                    \
      }                                                                                                       \
    }                                                                                                         \
    __builtin_amdgcn_s_setprio(1);                                                                            \
    _Pragma("unroll") for (int ks = 0; ks < 2; ++ks) {                                                        \
      bf16x8 af[4], bq[4];                                                                                    \
      _Pragma("unroll") for (int i = 0; i < 4; ++i) af[i] = *(const bf16x8*)&sa[wm * 64 + i * 16 + (lane & 15)][ks * 32 + (lane >> 4) * 8]; \
      _Pragma("unroll") for (int j = 0; j < 4; ++j) bq[j] = *(const bf16x8*)&sb[wn * 64 + j * 16 + (lane & 15)][ks * 32 + (lane >> 4) * 8]; \
      _Pragma("unroll") for (int i = 0; i < 4; ++i)                                                           \
        _Pragma("unroll") for (int j = 0; j < 4; ++j) acc[i][j] = __builtin_amdgcn_mfma_f32_16x16x32_bf16(bq[j], af[i], acc[i][j], 0, 0, 0); \
    }                                                                                                         \
    __builtin_amdgcn_s_setprio(0);                                                                            \
  }
  for (int k0 = 0; k0 < K; k0 += 128) {
    GEMM_STEP(k0, ra0, rb0)
    GEMM_STEP(k0 + 64, ra1, rb1)
  }
#undef GEMM_STEP
  __syncthreads();
}
DEVI void zero_acc(f32x4 (&acc)[4][4]) {
#pragma unroll
  for (int i = 0; i < 4; ++i)
#pragma unroll
    for (int j = 0; j < 4; ++j) acc[i][j] = f32x4{0.f, 0.f, 0.f, 0.f};
}

struct XcdMap { int v, nx, slot, slots; };
template <typename F> DEVI void for_tiles_xcd(const XcdMap& xm, int MT, int NT, int SM, int SN, F&& f) {
  const int nsn = (NT + SN - 1) / SN, nst = ((MT + SM - 1) / SM) * nsn, per = SM * SN;
  const int n_my = (nst - xm.v + xm.nx - 1) / xm.nx;
  for (int g = xm.slot; g < n_my * per; g += xm.slots) {
    const int s = xm.v + (g / per) * xm.nx, idx = g % per;
    const int sm = s / nsn, sn = s % nsn;
    const int mt = sm * SM + idx / SN, nt = sn * SN + idx % SN;
    if (mt < MT && nt < NT) f(mt, nt);
  }
}

DEVI void tr_tile(const float* __restrict__ src, int lds, int k0, int n0src, bf16_t* __restrict__ dst, int ldd, int n0dst,
                  unsigned char* smem) {
  float(*tile)[65] = (float(*)[65])smem;
  const int tid = threadIdx.x, j = tid & 63, i0 = tid >> 6;
#pragma unroll 4
  for (int ii = 0; ii < 16; ++ii) { int i = i0 + 4 * ii; tile[i][j] = src[(size_t)(k0 + i) * lds + n0src + j]; }
  __syncthreads();
#pragma unroll 4
  for (int jj = 0; jj < 16; ++jj) { int jn = i0 + 4 * jj; dst[(size_t)(n0dst + jn) * ldd + k0 + j] = f2bf(tile[j][jn]); }
  __syncthreads();
}

DEVI void phase0(const Params& p, unsigned char* smem, int it_lo, int it_hi) {
  const int tid = threadIdx.x;
  constexpr int N_MOD = 384, N_WIN = 16 * 85, N_WB = 128, N_WOUT = 256, N_WQ = 512, N_LORA = 16, N_GUP = 16, N_KEYS = 128;
  constexpr int E0 = N_MOD, E1 = E0 + N_WIN, E2 = E1 + N_WB, E3 = E2 + N_WB, E4 = E3 + N_WOUT, E5 = E4 + N_WQ,
                E6 = E5 + N_LORA, E7 = E6 + N_LORA, E8 = E7 + N_GUP, E9 = E8 + N_KEYS;
  if (it_hi > E9) it_hi = E9;
  for (int it = it_lo + blockIdx.x; it < it_hi; it += gridDim.x) {
    if (it < E0) {
      int cb = it % 24, rs = it / 24; int col = cb * 256 + tid;
      const float* aw = p.in[I_ADAW];
      float ax = 0.f, ac = 0.f;
#pragma unroll 8
      for (int r = rs * 64; r < rs * 64 + 64; ++r) {
        float w = aw[(size_t)r * 6144 + col];
        ax += siluf(p.in[I_C][r]) * w;
        ac += siluf(p.in[I_CCTX][r]) * w;
      }
      float* modp = (float*)(p.ws + O_MODP);
      modp[(rs * 2 + 0) * 6144 + col] = ax;
      modp[(rs * 2 + 1) * 6144 + col] = ac;
    } else if (it < E1) {
      int t = it - E0; int kt = t / 85, nt = t % 85; int n0 = nt * 64;
      tr_tile(p.in[I_WIN], NIN, kt * 64, nt == 84 ? 2816 : (n0 < 2816 ? n0 : n0 + 16), (bf16_t*)(p.ws + R_WIN), 1024, n0, smem);
    } else if (it < E2) {
      int t = it - E1; tr_tile(p.in[I_WBA], 1024, (t / 16) * 64, (t % 16) * 64, (bf16_t*)(p.ws + O_WBA), 512, (t % 16) * 64, smem);
    } else if (it < E3) {
      int t = it - E2; tr_tile(p.in[I_WBB], 1024, (t / 16) * 64, (t % 16) * 64, (bf16_t*)(p.ws + O_WBB), 512, (t % 16) * 64, smem);
    } else if (it < E4) {
      int t = it - E3; tr_tile(p.in[I_WOUT], 1024, (t / 16) * 64, (t % 16) * 64, (bf16_t*)(p.ws + O_WOUT), 1024, (t % 16) * 64, smem);
    } else if (it < E5) {
      int t = it - E4; tr_tile(p.in[I_WQ], 2048, (t / 32) * 64, (t % 32) * 64, (bf16_t*)(p.ws + O_WQ), 1024, (t % 32) * 64, smem);
    } else if (it < E6) {
      int t = it - E5; int dir = t / 8, nt = t % 8;
      tr_tile(p.in[I_RWUP] + (size_t)dir * 64 * 512, 512, 0, nt * 64, (bf16_t*)(p.ws + O_WUP) + (size_t)dir * 512 * 64, 64, nt * 64, smem);
    } else if (it < E7) {
      int t = it - E6; int dir = t / 8, nt = t % 8;
      tr_tile(p.in[I_RAUP] + (size_t)dir * 64 * 512, 512, 0, nt * 64, (bf16_t*)(p.ws + O_AUP) + (size_t)dir * 512 * 64, 64, nt * 64, smem);
    } else if (it < E8) {
      int t = it - E7; tr_tile(p.in[I_RGUP], 512, (t / 8) * 64, (t % 8) * 64, (bf16_t*)(p.ws + O_GUP), 128, (t % 8) * 64, smem);
    } else {
      int t = it - E8; size_t base = (size_t)t * 2048 + tid * 8;
      const float* s = p.in[I_KEYS] + base;
      float f[8];
      float4 a = *(const float4*)s, b = *(const float4*)(s + 4);
      f[0] = a.x; f[1] = a.y; f[2] = a.z; f[3] = a.w; f[4] = b.x; f[5] = b.y; f[6] = b.z; f[7] = b.w;
      *(uint4*)((bf16_t*)(p.ws + O_KEYS) + base) = pack8(f);
    }
  }
}

DEVI void phase1(const Params& p, unsigned char* smem) {
  float* smod = (float*)smem;
  const int tid = threadIdx.x, lane = tid & 63, warp = tid >> 6;
  for (int i = tid; i < 4096; i += 256) { int which = i >> 10; smod[i] = mod_val(p, which >> 1, (which & 1) * 1024 + (i & 1023)); }
  __syncthreads();
  bf16_t* hx = (bf16_t*)(p.ws + R_HX);
  float* gif = (float*)(p.ws + R_GIF);
  const float* win = p.in[I_WIN];
  constexpr int RPW = 4;
  for (int rg = blockIdx.x * 4 + warp; rg < T_ALL / RPW; rg += gridDim.x * 4) {
    const int row0 = rg * RPW;
    const float* sh = smod + (row0 < T_CTX ? 2048 : 0);
    const float* sc = sh + 1024;
    const float* src0 = row0 < T_CTX ? p.in[I_CTX] + (size_t)row0 * 1024 : p.in[I_X] + (size_t)(row0 - T_CTX) * 1024;
    float rstd[RPW];
#pragma unroll
    for (int r = 0; r < RPW; ++r) {
      float ss = 0.f;
#pragma unroll
      for (int i = 0; i < 4; ++i) {
        float4 v = *(const float4*)(src0 + (size_t)r * 1024 + i * 256 + lane * 4);
        ss += v.x * v.x + v.y * v.y + v.z * v.z + v.w * v.w;
      }
      ss = wave_sum_u(ss);
      rstd[r] = rsqrtf(ss * (1.f / 1024.f) + 1e-6f);
    }
#pragma unroll
    for (int i = 0; i < 4; ++i) {
      const int k0 = i * 256 + lane * 4;
      const float4 gk = *(const float4*)(p.in[I_N1G] + k0);
      const float4 s4 = *(const float4*)(sc + k0), h4 = *(const float4*)(sh + k0);
#pragma unroll
      for (int r = 0; r < RPW; ++r) {
        float4 v = *(const float4*)(src0 + (size_t)r * 1024 + k0);
        const float y0 = v.x * rstd[r] * gk.x * (1.f + s4.x) + h4.x, y1 = v.y * rstd[r] * gk.y * (1.f + s4.y) + h4.y;
        const float y2 = v.z * rstd[r] * gk.z * (1.f + s4.z) + h4.z, y3 = v.w * rstd[r] * gk.w * (1.f + s4.w) + h4.w;
        *(uint2*)(hx + (size_t)(row0 + r) * 1024 + k0) = make_uint2(pack2(y0, y1), pack2(y2, y3));
      }
    }
  }
}

DEVI void phase2(const Params& p, unsigned char* smem, const XcdMap& xm) {
  const int lane = threadIdx.x & 63, warp = threadIdx.x >> 6, wm = warp >> 1, wn = warp & 1;
  const bf16_t* hx = (const bf16_t*)(p.ws + R_HX);
  const bf16_t* wt = (const bf16_t*)(p.ws + R_WIN);
  bf16_t* prw = (bf16_t*)p.out;
  bf16_t* pqk = (bf16_t*)(p.ws + R_PQK);
  bf16_t* pv = (bf16_t*)(p.ws + R_PV);
  bf16_t* po = (bf16_t*)(p.ws + O_PO);
  bf16_t* pg = (bf16_t*)(p.ws + O_PG);
  for_tiles_xcd(xm, 130, 43, 5, 6, [&](int mt, int nt) {
    if (mt < 2 && nt >= 22 && nt < 42) return;
    f32x4 acc[4][4];
    zero_acc(acc);
    gemm_core(hx + (size_t)mt * 128 * 1024, 1024, wt + (size_t)nt * 128 * 1024, 1024, 1024, acc, smem);
    if (nt == 42) {
      float* gif = (float*)(p.ws + R_GIF);
      if (wn == 0) {
#pragma unroll
        for (int i = 0; i < 4; ++i) {
          const int row = mt * 128 + wm * 64 + i * 16 + (lane & 15);
          *(float4*)(gif + (size_t)row * 16 + (lane >> 4) * 4) = make_float4(acc[i][0][0], acc[i][0][1], acc[i][0][2], acc[i][0][3]);
        }
      }
      return;
    }
    bf16_t* dst; int ld, nb; int rofs = 0; bool sg = false;
    if (nt < 14) { dst = prw; ld = 1792; nb = nt * 128; }
    else if (nt < 18) { dst = pqk; ld = 512; nb = (nt - 14) * 128; }
    else if (nt < 22) { dst = pv; ld = 512; nb = (nt - 18) * 128; }
    else if (nt < 26) { dst = po; ld = 512; nb = (nt - 22) * 128; rofs = T_CTX; }
    else { dst = pg; ld = 2048; nb = (nt - 26) * 128; rofs = T_CTX; sg = true; }
    bf16_t(*Ct)[136] = (bf16_t(*)[136])smem;
#pragma unroll
    for (int i = 0; i < 4; ++i) {
#pragma unroll
      for (int j = 0; j < 4; ++j) {
        f32x4 v = acc[i][j];
        if (sg) { v[0] = sigm(v[0]); v[1] = sigm(v[1]); v[2] = sigm(v[2]); v[3] = sigm(v[3]); }
        *(uint2*)&Ct[wm * 64 + i * 16 + (lane & 15)][wn * 64 + j * 16 + (lane >> 4) * 4] = make_uint2(pack2(v[0], v[1]), pack2(v[2], v[3]));
      }
    }
    __syncthreads();
#pragma unroll
    for (int q = 0; q < 8; ++q) {
      const int pc = threadIdx.x + 256 * q; const int r = pc >> 4, c8 = (pc & 15) * 8;
      const int row = mt * 128 + r - rofs;
      *(u32x4*)(dst + (size_t)row * ld + nb + c8) = *(const u32x4*)&Ct[r][c8];
    }
    __syncthreads();
  });
}

DEVI void ml_qk8(const Params& p, int c, int j, int chan, float* o) {
  const bf16_t* pqk = (const bf16_t*)(p.ws + R_PQK);
  int row = ml_row(c, j);
  bool hp, hn; int rp, rn;
  if (c < 4) { hp = row > 0; hn = row < T_CTX - 1; rp = row - 1; rn = row + 1; }
  else { int gr = ((c - 4) & 3) * 64 + j; hp = gr > 0; hn = gr < 255; rp = row - 64; rn = row + 64; }
  const float* cw = p.in[I_MCONV];
  float cur[8], pr[8], nx[8];
  unpack8(*(const uint4*)(pqk + (size_t)row * 512 + chan), cur);
  if (hp) unpack8(*(const uint4*)(pqk + (size_t)rp * 512 + chan), pr);
  if (hn) unpack8(*(const uint4*)(pqk + (size_t)rn * 512 + chan), nx);
#pragma unroll
  for (int e = 0; e < 8; ++e) {
    float v = cw[512 + chan + e] * cur[e];
    if (hp) v += cw[chan + e] * pr[e];
    if (hn) v += cw[1024 + chan + e] * nx[e];
    o[e] = siluf(v);
  }
}

DEVI void phase3(const Params& p, unsigned char* smem) {
  bf16_t(*KT)[72] = (bf16_t(*)[72])smem;
  bf16_t(*VwT)[72] = (bf16_t(*)[72])(smem + 64 * 72 * 2);
  float* wgt = (float*)(smem + 64 * 72 * 2 + 256 * 72 * 2);
  const int tid = threadIdx.x, lane = tid & 63, warp = tid >> 6;
  const float* gif = (const float*)(p.ws + R_GIF);
  const bf16_t* pv = (const bf16_t*)(p.ws + R_PV);
  float* U = (float*)(p.ws + R_U);
  float* NT = (float*)(p.ws + O_NT);
  float* bend = (float*)(p.ws + O_BEND);
  float* mloc = (float*)(p.ws + O_MLOC);
  for (int it = blockIdx.x; it < 260 * 4; it += gridDim.x) {
    int c = it >> 2, h = it & 3;
    if (warp < 2) {
      int dir = warp; int j = dir ? 63 - lane : lane;
      int row = ml_row(c, j);
      float ig = gif[(size_t)row * 16 + dir * 4 + h] + p.in[I_MIB][dir * 4 + h];
      float lf = logsig(gif[(size_t)row * 16 + 8 + dir * 4 + h] + p.in[I_MFB][dir * 4 + h]);
      float b = lf;
#pragma unroll
      for (int o = 1; o < 64; o <<= 1) { float t = __shfl_up(b, o); if (lane >= o) b += t; }
      float be = __shfl(b, 63);
      float ge = be - b + ig;
      float ml = wave_max(ge);
      wgt[dir * 64 + j] = expf(ge - ml);
      if (lane == 0) { int sc = ml_sc(c, dir); bend[sc * 8 + dir * 4 + h] = be; mloc[sc * 8 + dir * 4 + h] = ml; }
    }
    __syncthreads();
    {
      int j = tid >> 2, part = tid & 3;
      float f[8];
#pragma unroll
      for (int q = 0; q < 2; ++q) {
        int d0 = part * 16 + q * 8;
        ml_qk8(p, c, j, 256 + h * 64 + d0, f);
#pragma unroll
        for (int e = 0; e < 8; ++e) KT[d0 + e][j] = f2bf(f[e] * 0.125f);
      }
      int row = ml_row(c, j);
      float w0 = wgt[j], w1 = wgt[64 + j];
#pragma unroll
      for (int q = 0; q < 4; ++q) {
        int v0 = part * 32 + q * 8;
        unpack8(*(const uint4*)(pv + (size_t)row * 512 + h * 128 + v0), f);
#pragma unroll
        for (int e = 0; e < 8; ++e) { VwT[v0 + e][j] = f2bf(f[e] * w0); VwT[128 + v0 + e][j] = f2bf(f[e] * w1); }
      }
    }
    __syncthreads();
#pragma unroll
    for (int dir = 0; dir < 2; ++dir) {
      int sc = ml_sc(c, dir);
      float* Ud = U + ((size_t)sc * 8 + dir * 4 + h) * 8192;
#pragma unroll
      for (int vi = 0; vi < 2; ++vi) {
        int vt = warp * 2 + vi;
        bf16x8 bv[2];
#pragma unroll
        for (int ks = 0; ks < 2; ++ks) bv[ks] = *(const bf16x8*)&VwT[dir * 128 + vt * 16 + (lane & 15)][ks * 32 + (lane >> 4) * 8];
#pragma unroll
        for (int dt = 0; dt < 4; ++dt) {
          f32x4 a = {0.f, 0.f, 0.f, 0.f};
#pragma unroll
          for (int ks = 0; ks < 2; ++ks) {
            bf16x8 ak = *(const bf16x8*)&KT[dt * 16 + (lane & 15)][ks * 32 + (lane >> 4) * 8];
            a = __builtin_amdgcn_mfma_f32_16x16x32_bf16(ak, bv[ks], a, 0, 0, 0);
          }
          *(float4*)(Ud + (size_t)(vt * 16 + (lane & 15)) * 64 + dt * 16 + (lane >> 4) * 4) = make_float4(a[0], a[1], a[2], a[3]);
        }
      }
    }
    if (tid < 128) {
      int dir = tid >> 6, d = tid & 63; float s = 0.f;
      for (int j = 0; j < 64; ++j) s += wgt[dir * 64 + j] * bf2f(KT[d][j]);
      NT[((size_t)ml_sc(c, dir) * 8 + dir * 4 + h) * 64 + d] = s;
    }
    __syncthreads();
  }
}

template <bool DRY> DEVI void phase4(const Params& p) {
  const bool wr = !DRY || (p.in[I_FG][0] == 1234.5f);
  float* U = (float*)(p.ws + R_U);
  float* NT = (float*)(p.ws + O_NT);
  const float* bend = (const float*)(p.ws + O_BEND);
  const float* mloc = (const float*)(p.ws + O_MLOC);
  float* mst = (float*)(p.ws + O_MST);
  for (int g = blockIdx.x * 256 + threadIdx.x; g < 8 * 8256; g += gridDim.x * 256) {
    int pr = g / 8256, e = g % 8256;
    float* base; size_t stride;
    if (e < 8192) { base = U + (size_t)pr * 8192 + e; stride = 8 * 8192; }
    else { base = NT + (size_t)pr * 64 + (e - 8192); stride = 8 * 64; }
    float m = 0.f, C = 0.f;
    for (int sc = 0; sc < 260; sc += 20) {
      float u[20];
#pragma unroll
      for (int q = 0; q < 20; ++q) u[q] = base[(size_t)(sc + q) * stride];
#pragma unroll
      for (int q = 0; q < 20; ++q) {
        float be = bend[(sc + q) * 8 + pr], ml = mloc[(sc + q) * 8 + pr];
        float mn = fmaxf(be + m, ml);
        float keep = expf(be + m - mn), s = expf(ml - mn);
        if (wr) base[(size_t)(sc + q) * stride] = C;
        if (wr && e == 0) mst[(sc + q) * 8 + pr] = m;
        C = keep * C + s * u[q];
        m = mn;
      }
    }
  }
}

template <bool DRY> DEVI void phase5(const Params& p, unsigned char* smem) {
  const bool wr = !DRY || (p.in[I_FG][0] == 1234.5f);
  bf16_t(*Qs)[72] = (bf16_t(*)[72])smem;
  bf16_t(*Ks)[72] = (bf16_t(*)[72])(smem + 9216);
  bf16_t(*Pm)[72] = (bf16_t(*)[72])(smem + 2 * 9216);
  bf16_t(*VT)[72] = (bf16_t(*)[72])(smem + 3 * 9216);
  float* evec = (float*)(smem + 3 * 9216 + 144 * 72 * 2);
  float* Mvec = evec + 128;
  float* bvec = Mvec + 128;
  const int tid = threadIdx.x, lane = tid & 63, warp = tid >> 6;
  const float* gif = (const float*)(p.ws + R_GIF);
  const bf16_t* pv = (const bf16_t*)(p.ws + R_PV);
  const bf16_t* po = (const bf16_t*)(p.ws + O_PO);
  bf16_t* yb = (bf16_t*)(p.ws + R_YA);
  const float* U = (const float*)(p.ws + R_U);
  const float* NT = (const float*)(p.ws + O_NT);
  const float* mst = (const float*)(p.ws + O_MST);
  for (int it = blockIdx.x; it < 256 * 4; it += gridDim.x) {
    int c = 4 + (it >> 2), h = it & 3;
    if (warp < 2) {
      int dir = warp; int j = dir ? 63 - lane : lane;
      int row = ml_row(c, j);
      float ig = gif[(size_t)row * 16 + dir * 4 + h] + p.in[I_MIB][dir * 4 + h];
      float lf = logsig(gif[(size_t)row * 16 + 8 + dir * 4 + h] + p.in[I_MFB][dir * 4 + h]);
      float b = lf;
#pragma unroll
      for (int o = 1; o < 64; o <<= 1) { float t = __shfl_up(b, o); if (lane >= o) b += t; }
      float e = ig - b;
      float pm = e;
#pragma unroll
      for (int o = 1; o < 64; o <<= 1) { float t = __shfl_up(pm, o); if (lane >= o) pm = fmaxf(pm, t); }
      float m0 = mst[ml_sc(c, dir) * 8 + dir * 4 + h];
      evec[dir * 64 + j] = e; Mvec[dir * 64 + j] = fmaxf(m0, pm); bvec[dir * 64 + j] = b;
    }
    {
      int j = tid >> 2, part = tid & 3;
      float f[8];
#pragma unroll
      for (int q = 0; q < 2; ++q) {
        int d0 = part * 16 + q * 8;
        ml_qk8(p, c, j, h * 64 + d0, f);
        *(uint4*)&Qs[j][d0] = pack8(f);
        ml_qk8(p, c, j, 256 + h * 64 + d0, f);
#pragma unroll
        for (int e = 0; e < 8; ++e) f[e] *= 0.125f;
        *(uint4*)&Ks[j][d0] = pack8(f);
      }
      int row = ml_row(c, j);
#pragma unroll
      for (int q = 0; q < 4; ++q) {
        int v0 = part * 32 + q * 8;
        unpack8(*(const uint4*)(pv + (size_t)row * 512 + h * 128 + v0), f);
#pragma unroll
        for (int e = 0; e < 8; ++e) VT[v0 + e][j] = f2bf(f[e]);
      }
      for (int i = tid; i < 16 * 64; i += 256) VT[128 + (i >> 6)][i & 63] = (i < 64) ? (bf16_t)0x3f80 : (bf16_t)0;
    }
    __syncthreads();
    const int jl = warp * 16 + (lane & 15);
    f32x4 s0[4];
    bf16x8 qf[2];
#pragma unroll
    for (int ks = 0; ks < 2; ++ks) qf[ks] = *(const bf16x8*)&Qs[jl][ks * 32 + (lane >> 4) * 8];
#pragma unroll
    for (int st = 0; st < 4; ++st) {
      f32x4 a = {0.f, 0.f, 0.f, 0.f};
#pragma unroll
      for (int ks = 0; ks < 2; ++ks) {
        bf16x8 kf = *(const bf16x8*)&Ks[st * 16 + (lane & 15)][ks * 32 + (lane >> 4) * 8];
        a = __builtin_amdgcn_mfma_f32_16x16x32_bf16(kf, qf[ks], a, 0, 0, 0);
      }
      s0[st] = a;
    }
    f32x4 ysum[8];
#pragma unroll
    for (int vt = 0; vt < 8; ++vt) ysum[vt] = f32x4{0.f, 0.f, 0.f, 0.f};
#pragma unroll 1
    for (int dir = 0; dir < 2; ++dir) {
      float Mj = Mvec[dir * 64 + jl], bj = bvec[dir * 64 + jl];
      float m0 = mst[ml_sc(c, dir) * 8 + dir * 4 + h];
#pragma unroll
      for (int st = 0; st < 4; ++st) {
        float pvv[4];
#pragma unroll
        for (int r = 0; r < 4; ++r) {
          int s = st * 16 + (lane >> 4) * 4 + r;
          bool ok = dir == 0 ? (s <= jl) : (s >= jl);
          pvv[r] = ok ? s0[st][r] * expf(evec[dir * 64 + s] - Mj) : 0.f;
        }
        *(uint2*)&Pm[jl][st * 16 + (lane >> 4) * 4] = make_uint2(pack2(pvv[0], pvv[1]), pack2(pvv[2], pvv[3]));
      }
      __syncthreads();
      bf16x8 pf[2];
#pragma unroll
      for (int ks = 0; ks < 2; ++ks) pf[ks] = *(const bf16x8*)&Pm[jl][ks * 32 + (lane >> 4) * 8];
      const float* Cst = U + ((size_t)ml_sc(c, dir) * 8 + dir * 4 + h) * 8192;
      const float* nst = NT + ((size_t)ml_sc(c, dir) * 8 + dir * 4 + h) * 64;
      float ai = expf(m0 - Mj);
      f32x4 hh[9];
#pragma unroll
      for (int vt = 0; vt < 9; ++vt) {
        f32x4 a1 = {0.f, 0.f, 0.f, 0.f}, a2 = {0.f, 0.f, 0.f, 0.f};
#pragma unroll
        for (int ks = 0; ks < 2; ++ks) {
          bf16x8 vf = *(const bf16x8*)&VT[vt * 16 + (lane & 15)][ks * 32 + (lane >> 4) * 8];
          a1 = __builtin_amdgcn_mfma_f32_16x16x32_bf16(vf, pf[ks], a1, 0, 0, 0);
          int v = vt * 16 + (lane & 15);
          const float* cp = v < 128 ? Cst + (size_t)v * 64 + ks * 32 + (lane >> 4) * 8 : nst + ks * 32 + (lane >> 4) * 8;
          float cf[8];
          if (v <= 128) {
            float4 x0 = *(const float4*)cp, x1 = *(const float4*)(cp + 4);
            cf[0] = x0.x; cf[1] = x0.y; cf[2] = x0.z; cf[3] = x0.w; cf[4] = x1.x; cf[5] = x1.y; cf[6] = x1.z; cf[7] = x1.w;
          } else {
#pragma unroll
            for (int e = 0; e < 8; ++e) cf[e] = 0.f;
          }
          uint4 pk = pack8(cf);
          bf16x8 cfr;
          cfr[0] = (short)(pk.x & 0xffff); cfr[1] = (short)(pk.x >> 16); cfr[2] = (short)(pk.y & 0xffff); cfr[3] = (short)(pk.y >> 16);
          cfr[4] = (short)(pk.z & 0xffff); cfr[5] = (short)(pk.z >> 16); cfr[6] = (short)(pk.w & 0xffff); cfr[7] = (short)(pk.w >> 16);
          a2 = __builtin_amdgcn_mfma_f32_16x16x32_bf16(cfr, qf[ks], a2, 0, 0, 0);
        }
#pragma unroll
        for (int r = 0; r < 4; ++r) hh[vt][r] = a1[r] + ai * a2[r];
      }
      float den = __shfl(hh[8][0], lane & 15);
      float dn = fmaxf(fabsf(den), expf(-(bj + Mj)));
      float inv = 1.f / dn;
      float ss = 0.f;
#pragma unroll
      for (int vt = 0; vt < 8; ++vt)
#pragma unroll
        for (int r = 0; r < 4; ++r) { float x = hh[vt][r] * inv; hh[vt][r] = x; ss += x * x; }
      ss += __shfl_xor(ss, 16); ss += __shfl_xor(ss, 32);
      float rs = rsqrtf(ss * (1.f / 128.f) + 1e-6f);
#pragma unroll
      for (int vt = 0; vt < 8; ++vt)
#pragma unroll
        for (int r = 0; r < 4; ++r) ysum[vt][r] += hh[vt][r] * rs * p.in[I_MNG][h * 128 + vt * 16 + (lane >> 4) * 4 + r];
      __syncthreads();
    }
    {
      int row = ml_row(c, jl) - T_CTX;
#pragma unroll
      for (int vt = 0; vt < 8; ++vt) {
        const bf16_t* op = po + (size_t)row * 512 + h * 128 + vt * 16 + (lane >> 4) * 4;
        uint2 o = *(const uint2*)op;
        float y0 = ysum[vt][0] * sigm(bflo(o.x)), y1 = ysum[vt][1] * sigm(bfhi(o.x)), y2 = ysum[vt][2] * sigm(bflo(o.y)), y3 = ysum[vt][3] * sigm(bfhi(o.y));
        if (wr) *(uint2*)(yb + (size_t)row * 512 + h * 128 + vt * 16 + (lane >> 4) * 4) = make_uint2(pack2(y0, y1), pack2(y2, y3));
      }
    }
    __syncthreads();
  }
}

DEVI void phase6(const Params& p, unsigned char* smem, int item_lo, int item_hi, int blk0, int nblk) {
  float(*rs)[65] = (float(*)[65])smem;
  float(*ks)[65] = (float(*)[65])(smem + 64 * 65 * 4);
  bf16_t(*TW)[72] = (bf16_t(*)[72])(smem + 2 * 64 * 65 * 4);
  bf16_t(*TA)[72] = (bf16_t(*)[72])(smem + 2 * 64 * 65 * 4 + 9216);
  bf16_t(*TG)[136] = (bf16_t(*)[136])(smem + 2 * 64 * 65 * 4 + 2 * 9216);
  float* rn = (float*)(smem + 2 * 64 * 65 * 4 + 2 * 9216 + 64 * 136 * 2);
  const int tid = threadIdx.x, lane = tid & 63, warp = tid >> 6;
  const bf16_t* prw = (const bf16_t*)p.out;
  bf16_t* SV = (bf16_t*)(p.ws + R_SV);
  float* bonus = (float*)(p.ws + O_BONUS);
  const float* cw = p.in[I_RCONV];
  const bf16_t* WUP = (const bf16_t*)(p.ws + O_WUP);
  const bf16_t* AUP = (const bf16_t*)(p.ws + O_AUP);
  const bf16_t* GUP = (const bf16_t*)(p.ws + O_GUP);
  if ((int)blockIdx.x < blk0) return;
  for (int it = item_lo + ((int)blockIdx.x - blk0); it < item_hi; it += nblk) {
    int tile = it >> 3, head = it & 7;
    int row0 = tile * 64;
    int seg0 = tile < 4 ? 0 : row0, seg1 = tile < 4 ? T_CTX : row0 + 64;
#pragma unroll 1
    for (int ub = 0; ub < 2; ++ub) {
      u32x4 lc[7], lp[7], ln[7];
#pragma unroll
      for (int it7 = 0; it7 < 7; ++it7) {
        const int u = warp + 4 * (ub * 7 + it7);
        const int grp = u >> 3;
        const int j = (u & 7) * 8 + (lane >> 3), q = grp * 8 + (lane & 7);
        const int row = row0 + j;
        const int col = q < 24 ? (q >> 3) * 512 + head * 64 + (q & 7) * 8 : 1536 + (q - 24) * 8;
        const bool hp = row > seg0, hn = row < seg1 - 1;
        lc[it7] = *(const u32x4*)(prw + (size_t)row * 1792 + col);
        lp[it7] = hp ? *(const u32x4*)(prw + (size_t)(row - 1) * 1792 + col) : u32x4{0u, 0u, 0u, 0u};
        ln[it7] = hn ? *(const u32x4*)(prw + (size_t)(row + 1) * 1792 + col) : u32x4{0u, 0u, 0u, 0u};
      }
#pragma unroll
      for (int it7 = 0; it7 < 7; ++it7) {
        const int u = warp + 4 * (ub * 7 + it7);
        const int grp = u >> 3;
        const int j = (u & 7) * 8 + (lane >> 3), q = grp * 8 + (lane & 7);
        const int row = row0 + j;
        const int col = q < 24 ? (q >> 3) * 512 + head * 64 + (q & 7) * 8 : 1536 + (q - 24) * 8;
        float cur[8], pr[8], nx[8], o[8];
        unpack8(make_uint4(lc[it7][0], lc[it7][1], lc[it7][2], lc[it7][3]), cur);
        unpack8(make_uint4(lp[it7][0], lp[it7][1], lp[it7][2], lp[it7][3]), pr);
        unpack8(make_uint4(ln[it7][0], ln[it7][1], ln[it7][2], ln[it7][3]), nx);
        {
          float4 c0 = *(const float4*)(cw + col), c1 = *(const float4*)(cw + col + 4);
          float4 d0 = *(const float4*)(cw + 1792 + col), d1 = *(const float4*)(cw + 1792 + col + 4);
          float4 e0 = *(const float4*)(cw + 3584 + col), e1 = *(const float4*)(cw + 3584 + col + 4);
          float wp[8] = {c0.x, c0.y, c0.z, c0.w, c1.x, c1.y, c1.z, c1.w};
          float wc[8] = {d0.x, d0.y, d0.z, d0.w, d1.x, d1.y, d1.z, d1.w};
          float wn_[8] = {e0.x, e0.y, e0.z, e0.w, e1.x, e1.y, e1.z, e1.w};
#pragma unroll
          for (int e = 0; e < 8; ++e) o[e] = wc[e] * cur[e] + wp[e] * pr[e] + wn_[e] * nx[e];
        }
        if (grp == 0) {
#pragma unroll
          for (int e = 0; e < 8; ++e) rs[j][(q & 7) * 8 + e] = o[e];
        } else if (grp == 1) {
#pragma unroll
          for (int e = 0; e < 8; ++e) ks[j][(q & 7) * 8 + e] = o[e];
        } else if (grp == 2) {
          *(uint4*)(SV + ((size_t)row * 8 + head) * SVH + 2 * 64 + (q & 7) * 8) = pack8(o);
        } else if (grp == 3) {
#pragma unroll
          for (int e = 0; e < 8; ++e) o[e] = 1.f - 2.f / (1.f + __expf(2.f * o[e]));
          *(uint4*)&TW[j][(q - 24) * 8] = pack8(o);
        } else if (grp == 4) {
          *(uint4*)&TA[j][(q - 32) * 8] = pack8(o);
        } else {
#pragma unroll
          for (int e = 0; e < 8; ++e) o[e] = sigm(o[e]);
          *(uint4*)&TG[j][(q - 40) * 8] = pack8(o);
        }
      }
    }
    __syncthreads();
    {
      int j = tid >> 2, part = tid & 3; float ss = 0.f;
#pragma unroll
      for (int e = 0; e < 16; ++e) { float v = ks[j][part * 16 + e] * p.in[I_RKK][head * 64 + part * 16 + e]; ss += v * v; }
      ss += __shfl_xor(ss, 1); ss += __shfl_xor(ss, 2);
      if (part == 0) rn[j] = 1.f / fmaxf(sqrtf(ss), 1e-12f);
    }
    __syncthreads();
    for (int pc = tid; pc < 64 * 8; pc += 256) {
      int j = pc >> 3, c8 = (pc & 7) * 8; int row = row0 + j;
      float fr[8], fk[8], fkk[8];
#pragma unroll
      for (int e = 0; e < 8; ++e) { fr[e] = rs[j][c8 + e]; fk[e] = ks[j][c8 + e]; fkk[e] = fk[e] * p.in[I_RKK][head * 64 + c8 + e] * rn[j]; }
      bf16_t* b = SV + ((size_t)row * 8 + head) * SVH;
      *(uint4*)(b + 0 * 64 + c8) = pack8(fr);
      *(uint4*)(b + 1 * 64 + c8) = pack8(fk);
      *(uint4*)(b + 3 * 64 + c8) = pack8(fkk);
    }
    {
      const int jl = warp * 16 + (lane & 15); const int row = row0 + jl;
      bf16x8 tw[2], ta[2], tg[4];
#pragma unroll
      for (int s2 = 0; s2 < 2; ++s2) { tw[s2] = *(const bf16x8*)&TW[jl][s2 * 32 + (lane >> 4) * 8]; ta[s2] = *(const bf16x8*)&TA[jl][s2 * 32 + (lane >> 4) * 8]; }
#pragma unroll
      for (int s2 = 0; s2 < 4; ++s2) tg[s2] = *(const bf16x8*)&TG[jl][s2 * 32 + (lane >> 4) * 8];
      __syncthreads();
      bf16_t(*OB)[64][72] = (bf16_t(*)[64][72])(smem + 2 * 64 * 65 * 4);
      float bon[2] = {0.f, 0.f};
#pragma unroll
      for (int dir = 0; dir < 2; ++dir) {
#pragma unroll
        for (int ct = 0; ct < 4; ++ct) {
          const int ch0 = ct * 16 + (lane >> 4) * 4;
          const int C0 = head * 64 + ch0;
          if (dir == 0) {
            f32x4 a = {0.f, 0.f, 0.f, 0.f};
#pragma unroll
            for (int s2 = 0; s2 < 4; ++s2) {
              bf16x8 wf = *(const bf16x8*)(GUP + (size_t)(head * 64 + ct * 16 + (lane & 15)) * 128 + s2 * 32 + (lane >> 4) * 8);
              a = __builtin_amdgcn_mfma_f32_16x16x32_bf16(wf, tg[s2], a, 0, 0, 0);
            }
            *(uint2*)&OB[2][jl][ch0] = make_uint2(pack2(a[0], a[1]), pack2(a[2], a[3]));
          }
          f32x4 aw = {0.f, 0.f, 0.f, 0.f}, aa = {0.f, 0.f, 0.f, 0.f};
#pragma unroll
          for (int s2 = 0; s2 < 2; ++s2) {
            size_t wo = (size_t)(dir * 512 + head * 64 + ct * 16 + (lane & 15)) * 64 + s2 * 32 + (lane >> 4) * 8;
            bf16x8 wf = *(const bf16x8*)(WUP + wo);
            bf16x8 af = *(const bf16x8*)(AUP + wo);
            aw = __builtin_amdgcn_mfma_f32_16x16x32_bf16(wf, tw[s2], aw, 0, 0, 0);
            aa = __builtin_amdgcn_mfma_f32_16x16x32_bf16(af, ta[s2], aa, 0, 0, 0);
          }
          const float4 w04 = *(const float4*)(p.in[I_RW0] + dir * 512 + C0), a04 = *(const float4*)(p.in[I_RA0] + dir * 512 + C0);
          const float4 ka4 = *(const float4*)(p.in[I_RKA] + C0), rk4 = *(const float4*)(p.in[I_RRK] + C0);
          const float w0v[4] = {w04.x, w04.y, w04.z, w04.w}, a0v[4] = {a04.x, a04.y, a04.z, a04.w};
          const float kav[4] = {ka4.x, ka4.y, ka4.z, ka4.w}, rkv[4] = {rk4.x, rk4.y, rk4.z, rk4.w};
          float we[4], av[4];
#pragma unroll
          for (int r = 0; r < 4; ++r) {
            we[r] = (0.60653066f * 1.44269504f) * sigm(w0v[r] + aw[r]);
            av[r] = sigm(a0v[r] + aa[r]);
            float kv = ks[jl][ch0 + r];
            float keff = kv * (1.f + (av[r] - 1.f) * kav[r]);
            bon[dir] += rs[jl][ch0 + r] * keff * rkv[r];
          }
          *(uint2*)&OB[0][jl][ch0] = make_uint2(pack2(we[0], we[1]), pack2(we[2], we[3]));
          *(uint2*)&OB[1][jl][ch0] = make_uint2(pack2(av[0], av[1]), pack2(av[2], av[3]));
        }
        __syncthreads();
        for (int pc = tid; pc < (dir == 0 ? 3 : 2) * 64 * 8; pc += 256) {
          const int vsel = pc >> 9, j = (pc >> 3) & 63, c8 = (pc & 7) * 8;
          const int vec = vsel == 2 ? 8 : (4 + 2 * dir + vsel);
          *(u32x4*)(SV + ((size_t)(row0 + j) * 8 + head) * SVH + vec * 64 + c8) = *(const u32x4*)&OB[vsel][j][c8];
        }
        __syncthreads();
      }
#pragma unroll
      for (int dir = 0; dir < 2; ++dir) {
        float sb = bon[dir]; sb += __shfl_xor(sb, 16); sb += __shfl_xor(sb, 32);
        if (lane < 16) bonus[(size_t)row * 16 + dir * 8 + head] = sb;
      }
    }
    __syncthreads();
  }
}

struct RwVec { uint4 k, kk, w, a, v, r; };
DEVI void unpack8p(const uint4& u, f32x2* f) {
  f[0] = f32x2{bflo(u.x), bfhi(u.x)}; f[1] = f32x2{bflo(u.y), bfhi(u.y)}; f[2] = f32x2{bflo(u.z), bfhi(u.z)}; f[3] = f32x2{bflo(u.w), bfhi(u.w)};
}
DEVI f32x2 bc2(float x) { return f32x2{x, x}; }
DEVI void rw_load(RwVec& x, const bf16_t* SV, int row, int head, int dir, int i, int jg, bool need_r) {
  const bf16_t* b = SV + ((size_t)row * 8 + head) * SVH;
  x.k = *(const uint4*)(b + 1 * 64 + jg * 8);
  x.kk = *(const uint4*)(b + 3 * 64 + jg * 8);
  x.w = *(const uint4*)(b + (4 + 2 * dir) * 64 + jg * 8);
  x.a = *(const uint4*)(b + (5 + 2 * dir) * 64 + jg * 8);
  x.v = *(const uint4*)(b + 2 * 64 + i * 8);
  if (need_r) x.r = *(const uint4*)(b + 0 * 64 + jg * 8);
}

DEVI void phase7(const Params& p) {
  const int lane = threadIdx.x & 63, warp = threadIdx.x >> 6, i = lane >> 3, jg = lane & 7;
  const bf16_t* SV = (const bf16_t*)(p.ws + R_SV);
  float* Pc = (float*)p.out;
  float* Bc = (float*)((unsigned char*)p.out + OUT_BC);
  for (int it = blockIdx.x * 4 + warp; it < (NCH - 1) * 16; it += gridDim.x * 4) {
    const int chunk = it >> 4, pair = it & 15, dir = pair >> 3, head = pair & 7;
    f32x2 S[8][4], P[8][4], ka[4];
#pragma unroll
    for (int a = 0; a < 8; ++a)
#pragma unroll
      for (int c = 0; c < 4; ++c) {
        S[a][c] = f32x2{0.f, 0.f};
        P[a][c] = f32x2{(i * 8 + a == jg * 8 + 2 * c) ? 1.f : 0.f, (i * 8 + a == jg * 8 + 2 * c + 1) ? 1.f : 0.f};
      }
#pragma unroll
    for (int c = 0; c < 4; ++c) ka[c] = f32x2{p.in[I_RKA][head * 64 + jg * 8 + 2 * c], p.in[I_RKA][head * 64 + jg * 8 + 2 * c + 1]};
    RwVec nx;
    rw_load(nx, SV, rw_row(chunk * LCH, dir), head, dir, i, jg, false);
#pragma unroll 1
    for (int t = 0; t < LCH; ++t) {
      RwVec cu = nx;
      if (t + 1 < LCH) rw_load(nx, SV, rw_row(chunk * LCH + t + 1, dir), head, dir, i, jg, false);
      f32x2 kv[4], kk[4], w[4], av[4], kka[4], keff[4]; float vv[8];
      unpack8p(cu.k, kv); unpack8p(cu.kk, kk); unpack8p(cu.w, w); unpack8p(cu.a, av); unpack8(cu.v, vv);
#pragma unroll
      for (int c = 0; c < 4; ++c) {
        w[c] = f32x2{__builtin_amdgcn_exp2f(-w[c][0]), __builtin_amdgcn_exp2f(-w[c][1])};
        kka[c] = -kk[c] * av[c];
        keff[c] = kv[c] * (bc2(1.f) + (av[c] - bc2(1.f)) * ka[c]);
      }
#pragma unroll
      for (int a = 0; a < 8; ++a) {
        f32x2 sa = S[a][0] * kk[0], qa = P[a][0] * kk[0];
#pragma unroll
        for (int c = 1; c < 4; ++c) { sa += S[a][c] * kk[c]; qa += P[a][c] * kk[c]; }
        float s1 = allred8(sa[0] + sa[1]), q1 = allred8(qa[0] + qa[1]);
        const f32x2 s2 = bc2(s1), q2 = bc2(q1), v2 = bc2(vv[a]);
#pragma unroll
        for (int c = 0; c < 4; ++c) {
          S[a][c] = S[a][c] * w[c] + s2 * kka[c] + v2 * keff[c];
          P[a][c] = P[a][c] * w[c] + q2 * kka[c];
        }
      }
    }
    float* po = Pc + ((size_t)chunk * 16 + pair) * 4096;
    float* bo = Bc + ((size_t)chunk * 16 + pair) * 4096;
#pragma unroll
    for (int a = 0; a < 8; ++a) {
      *(float4*)(po + (i * 8 + a) * 64 + jg * 8) = make_float4(P[a][0][0], P[a][0][1], P[a][1][0], P[a][1][1]);
      *(float4*)(po + (i * 8 + a) * 64 + jg * 8 + 4) = make_float4(P[a][2][0], P[a][2][1], P[a][3][0], P[a][3][1]);
      *(float4*)(bo + (i * 8 + a) * 64 + jg * 8) = make_float4(S[a][0][0], S[a][0][1], S[a][1][0], S[a][1][1]);
      *(float4*)(bo + (i * 8 + a) * 64 + jg * 8 + 4) = make_float4(S[a][2][0], S[a][2][1], S[a][3][0], S[a][3][1]);
    }
  }
}

template <bool DRY> DEVI void phase8(const Params& p, unsigned char* smem) {
  const bool wr = !DRY || (p.in[I_FG][0] == 1234.5f);
  float(*Sb)[16][68] = (float(*)[16][68])smem;
  const int tid = threadIdx.x, lane = tid & 63, warp = tid >> 6, q = lane >> 4, c16 = lane & 15;
  const float* Pc = (const float*)p.out;
  float* Bc = (float*)((unsigned char*)p.out + OUT_BC);
  constexpr int NS = NCH - 1;
  const size_t CS = (size_t)16 * 4096;
  for (int it = blockIdx.x; it < 64; it += gridDim.x) {
    const int pair = it >> 2, rg = it & 3;
    const float* Pp = Pc + (size_t)pair * 4096 + q * 64 + warp * 16 + c16;
    float* Bp = Bc + (size_t)pair * 4096 + (size_t)(rg * 16 + q * 4) * 64 + warp * 16 + c16;
    __syncthreads();
    {
      const int row = tid >> 4, c4 = (tid & 15) * 4;
      float4 v = *(const float4*)(Bc + (size_t)pair * 4096 + (size_t)(rg * 16 + row) * 64 + c4);
      Sb[0][row][c4] = v.x; Sb[0][row][c4 + 1] = v.y; Sb[0][row][c4 + 2] = v.z; Sb[0][row][c4 + 3] = v.w;
    }
    float pa[16], pb[16]; f32x4 ba, bb;
#pragma unroll
    for (int s2 = 0; s2 < 16; ++s2) { pa[s2] = Pp[CS + s2 * 256]; pb[s2] = Pp[2 * CS + s2 * 256]; }
#pragma unroll
    for (int r = 0; r < 4; ++r) { ba[r] = Bp[CS + r * 64]; bb[r] = Bp[2 * CS + r * 64]; }
    __syncthreads();
#define P8_STEP(c, pp, bv)                                                                                  \
    {                                                                                                        \
      const int rb = ((c) - 1) & 1;                                                                          \
      f32x4 acc0 = bv, acc1 = f32x4{0.f, 0.f, 0.f, 0.f};                                                     \
      _Pragma("unroll") for (int s2 = 0; s2 < 16; s2 += 2) {                                                 \
        acc0 = __builtin_amdgcn_mfma_f32_16x16x4f32(Sb[rb][c16][4 * s2 + q], pp[s2], acc0, 0, 0, 0);         \
        acc1 = __builtin_amdgcn_mfma_f32_16x16x4f32(Sb[rb][c16][4 * s2 + 4 + q], pp[s2 + 1], acc1, 0, 0, 0); \
      }                                                                                                      \
      acc0 += acc1;                                                                                          \
      if ((c) + 2 < NS) {                                                                                    \
        _Pragma("unroll") for (int s2 = 0; s2 < 16; ++s2) pp[s2] = Pp[(size_t)((c) + 2) * CS + s2 * 256];    \
        _Pragma("unroll") for (int r = 0; r < 4; ++r) bv[r] = Bp[(size_t)((c) + 2) * CS + r * 64];           \
      }                                                                                                      \
      _Pragma("unroll") for (int r = 0; r < 4; ++r) {                                                        \
        Sb[rb ^ 1][q * 4 + r][warp * 16 + c16] = acc0[r];                                                    \
        if (wr) Bp[(size_t)(c) * CS + r * 64] = acc0[r];                                                     \
      }                                                                                                      \
      __syncthreads();                                                                                       \
    }
    for (int c = 1; c < NS; c += 2) {
      P8_STEP(c, pa, ba)
      if (c + 1 < NS) P8_STEP(c + 1, pb, bb)
    }
#undef P8_STEP
  }
}

DEVI void phase9(const Params& p) {
  const int lane = threadIdx.x & 63, warp = threadIdx.x >> 6, i = lane >> 3, jg = lane & 7;
  const bf16_t* SV = (const bf16_t*)(p.ws + R_SV);
  const float* Bc = (const float*)((unsigned char*)p.out + OUT_BC);
  bf16_t* odir = (bf16_t*)p.out;
  for (int it = blockIdx.x * 4 + warp; it < NCH * 16; it += gridDim.x * 4) {
    const int chunk = it >> 4, pair = it & 15, dir = pair >> 3, head = pair & 7;
    f32x2 S[8][4], ka[4];
    if (chunk == 0) {
#pragma unroll
      for (int a = 0; a < 8; ++a)
#pragma unroll
        for (int c = 0; c < 4; ++c) S[a][c] = f32x2{0.f, 0.f};
    } else {
      const float* bs = Bc + ((size_t)(chunk - 1) * 16 + pair) * 4096;
#pragma unroll
      for (int a = 0; a < 8; ++a) {
        float4 x0 = *(const float4*)(bs + (i * 8 + a) * 64 + jg * 8), x1 = *(const float4*)(bs + (i * 8 + a) * 64 + jg * 8 + 4);
        S[a][0] = f32x2{x0.x, x0.y}; S[a][1] = f32x2{x0.z, x0.w}; S[a][2] = f32x2{x1.x, x1.y}; S[a][3] = f32x2{x1.z, x1.w};
      }
    }
#pragma unroll
    for (int c = 0; c < 4; ++c) ka[c] = f32x2{p.in[I_RKA][head * 64 + jg * 8 + 2 * c], p.in[I_RKA][head * 64 + jg * 8 + 2 * c + 1]};
    RwVec nx;
    rw_load(nx, SV, rw_row(chunk * LCH, dir), head, dir, i, jg, true);
#pragma unroll 1
    for (int t = 0; t < LCH; ++t) {
      RwVec cu = nx;
      const int row = rw_row(chunk * LCH + t, dir);
      if (t + 1 < LCH) rw_load(nx, SV, rw_row(chunk * LCH + t + 1, dir), head, dir, i, jg, true);
      f32x2 kv[4], kk[4], w[4], av[4], rr[4], kka[4], keff[4]; float vv[8];
      unpack8p(cu.k, kv); unpack8p(cu.kk, kk); unpack8p(cu.w, w); unpack8p(cu.a, av); unpack8p(cu.r, rr); unpack8(cu.v, vv);
#pragma unroll
      for (int c = 0; c < 4; ++c) {
        w[c] = f32x2{__builtin_amdgcn_exp2f(-w[c][0]), __builtin_amdgcn_exp2f(-w[c][1])};
        kka[c] = -kk[c] * av[c];
        keff[c] = kv[c] * (bc2(1.f) + (av[c] - bc2(1.f)) * ka[c]);
      }
      float ov = 0.f;
#pragma unroll
      for (int a = 0; a < 8; ++a) {
        f32x2 sa = S[a][0] * kk[0];
#pragma unroll
        for (int c = 1; c < 4; ++c) sa += S[a][c] * kk[c];
        const float s1 = allred8(sa[0] + sa[1]);
        const f32x2 s2 = bc2(s1), v2 = bc2(vv[a]);
        f32x2 oa = f32x2{0.f, 0.f};
#pragma unroll
        for (int c = 0; c < 4; ++c) {
          S[a][c] = S[a][c] * w[c] + s2 * kka[c] + v2 * keff[c];
          oa += S[a][c] * rr[c];
        }
        const float o = allred8(oa[0] + oa[1]);
        if (jg == a) ov = o;
      }
      if (row >= T_CTX) odir[((size_t)dir * T_LAT + (row - T_CTX)) * 512 + head * 64 + i * 8 + jg] = f2bf(ov);
    }
  }
}

DEVI void phase10(const Params& p) {
  const int lane = threadIdx.x & 63, warp = threadIdx.x >> 6;
  const bf16_t* odir = (const bf16_t*)p.out;
  const bf16_t* SV = (const bf16_t*)(p.ws + R_SV);
  const float* bonus = (const float*)(p.ws + O_BONUS);
  bf16_t* ya = (bf16_t*)(p.ws + O_PO);
  const int head = lane >> 3, c8 = (lane & 7) * 8, C0 = lane * 8;
#pragma unroll 2
  for (int t = blockIdx.x * 4 + warp; t < T_LAT; t += gridDim.x * 4) {
    const int row = t + T_CTX;
    const bf16_t* b = SV + ((size_t)row * 8 + head) * SVH;
    float v[8], g[8], y[8];
    unpack8(*(const uint4*)(b + 2 * 64 + c8), v);
    unpack8(*(const uint4*)(b + 8 * 64 + c8), g);
    float bs = bonus[(size_t)row * 16 + head] + bonus[(size_t)row * 16 + 8 + head];
#pragma unroll
    for (int e = 0; e < 8; ++e) y[e] = bs * v[e];
#pragma unroll
    for (int dir = 0; dir < 2; ++dir) {
      float o[8];
      unpack8(*(const uint4*)(odir + ((size_t)dir * T_LAT + t) * 512 + C0), o);
      float s = 0.f;
#pragma unroll
      for (int e = 0; e < 8; ++e) s += o[e];
      s = allred8(s);
      float mu = s * (1.f / 64.f);
      float q = 0.f;
#pragma unroll
      for (int e = 0; e < 8; ++e) { o[e] -= mu; q += o[e] * o[e]; }
      q = allred8(q);
      float rsd = rsqrtf(q * (1.f / 64.f) + 64e-5f);
#pragma unroll
      for (int e = 0; e < 8; ++e) y[e] += o[e] * rsd * p.in[I_RLNW][C0 + e] + p.in[I_RLNB][C0 + e];
    }
#pragma unroll
    for (int e = 0; e < 8; ++e) y[e] *= g[e];
    *(uint4*)(ya + (size_t)t * 512 + C0) = pack8(y);
  }
}

DEVI void phase11(const Params& p, unsigned char* smem, const XcdMap& xm) {
  const int lane = threadIdx.x & 63, warp = threadIdx.x >> 6, wm = warp >> 1, wn = warp & 1;
  const bf16_t* ya = (const bf16_t*)(p.ws + O_PO);
  const bf16_t* yb = (const bf16_t*)(p.ws + R_YA);
  const bf16_t* pg = (const bf16_t*)(p.ws + O_PG);
  bf16_t* mg = (bf16_t*)(p.ws + R_MERGED);
  for_tiles_xcd(xm, 128, 8, 8, 8, [&](int mt, int nt) {
    f32x4 acc[4][4];
    zero_acc(acc);
    gemm_core(ya + (size_t)mt * 128 * 512, 512, (const bf16_t*)(p.ws + O_WBA) + (size_t)nt * 128 * 512, 512, 512, acc, smem);
#pragma unroll
    for (int i = 0; i < 4; ++i) {
      int row = mt * 128 + wm * 64 + i * 16 + (lane & 15);
#pragma unroll
      for (int j = 0; j < 4; ++j) {
        int n = nt * 128 + wn * 64 + j * 16 + (lane >> 4) * 4;
        uint2 s = *(const uint2*)(pg + (size_t)row * 2048 + n);
        *(uint2*)(mg + (size_t)row * 1024 + n) = make_uint2(pack2(acc[i][j][0] * bflo(s.x), acc[i][j][1] * bfhi(s.x)), pack2(acc[i][j][2] * bflo(s.y), acc[i][j][3] * bfhi(s.y)));
      }
    }
    zero_acc(acc);
    gemm_core(yb + (size_t)mt * 128 * 512, 512, (const bf16_t*)(p.ws + O_WBB) + (size_t)nt * 128 * 512, 512, 512, acc, smem);
#pragma unroll
    for (int i = 0; i < 4; ++i) {
      int row = mt * 128 + wm * 64 + i * 16 + (lane & 15);
#pragma unroll
      for (int j = 0; j < 4; ++j) {
        int n = nt * 128 + wn * 64 + j * 16 + (lane >> 4) * 4;
        uint2 s = *(const uint2*)(pg + (size_t)row * 2048 + 1024 + n);
        uint2 m0 = *(const uint2*)(mg + (size_t)row * 1024 + n);
        float v0 = bflo(m0.x) + acc[i][j][0] * bflo(s.x), v1 = bfhi(m0.x) + acc[i][j][1] * bfhi(s.x);
        float v2 = bflo(m0.y) + acc[i][j][2] * bflo(s.y), v3 = bfhi(m0.y) + acc[i][j][3] * bfhi(s.y);
        *(uint2*)(mg + (size_t)row * 1024 + n) = make_uint2(pack2(v0, v1), pack2(v2, v3));
      }
    }
  });
}

DEVI void phase12(const Params& p, unsigned char* smem, const XcdMap& xm) {
  float* gt = (float*)(smem + 45056);
  const int tid = threadIdx.x, lane = tid & 63, warp = tid >> 6, wm = warp >> 1, wn = warp & 1;
  for (int i = tid; i < 1024; i += 256) gt[i] = mod_val(p, 0, 2048 + i);
  __syncthreads();
  const bf16_t* mg = (const bf16_t*)(p.ws + R_MERGED);
  const float* x = p.in[I_X];
  float* x1 = p.out;
  for_tiles_xcd(xm, 128, 8, 8, 8, [&](int mt, int nt) {
    f32x4 acc[4][4];
    zero_acc(acc);
    gemm_core(mg + (size_t)mt * 128 * 1024, 1024, (const bf16_t*)(p.ws + O_WOUT) + (size_t)nt * 128 * 1024, 1024, 1024, acc, smem);
#pragma unroll
    for (int i = 0; i < 4; ++i) {
      int row = mt * 128 + wm * 64 + i * 16 + (lane & 15);
#pragma unroll
      for (int j = 0; j < 4; ++j) {
        int n = nt * 128 + wn * 64 + j * 16 + (lane >> 4) * 4;
        float4 xv = *(const float4*)(x + (size_t)row * 1024 + n);
        xv.x += gt[n] * acc[i][j][0]; xv.y += gt[n + 1] * acc[i][j][1]; xv.z += gt[n + 2] * acc[i][j][2]; xv.w += gt[n + 3] * acc[i][j][3];
        *(float4*)(x1 + (size_t)row * 1024 + n) = xv;
      }
    }
  });
}

DEVI void phase13(const Params& p, unsigned char* smem) {
  float* smod = (float*)smem;
  const int tid = threadIdx.x, lane = tid & 63, warp = tid >> 6;
  for (int i = tid; i < 2048; i += 256) smod[i] = mod_val(p, 0, 3072 + i);
  __syncthreads();
  const float* x1 = p.out;
  bf16_t* h2 = (bf16_t*)(p.ws + R_H2);
  for (int rp = blockIdx.x * 4 + warp; rp < T_LAT / 2; rp += gridDim.x * 4) {
    float h[2][16]; float ss[2] = {0.f, 0.f};
#pragma unroll
    for (int u = 0; u < 2; ++u)
#pragma unroll
      for (int i = 0; i < 4; ++i) {
        float4 v = *(const float4*)(x1 + (size_t)(rp * 2 + u) * 1024 + i * 256 + lane * 4);
        h[u][4 * i] = v.x; h[u][4 * i + 1] = v.y; h[u][4 * i + 2] = v.z; h[u][4 * i + 3] = v.w;
        ss[u] += v.x * v.x + v.y * v.y + v.z * v.z + v.w * v.w;
      }
#pragma unroll
    for (int u = 0; u < 2; ++u) {
      const int row = rp * 2 + u;
      const float rstd = rsqrtf(wave_sum_u(ss[u]) * (1.f / 1024.f) + 1e-6f);
#pragma unroll
      for (int i = 0; i < 4; ++i) {
#pragma unroll
        for (int e = 0; e < 4; ++e) {
          int k = i * 256 + lane * 4 + e;
          float y = h[u][4 * i + e] * rstd * p.in[I_N2G][k];
          h[u][4 * i + e] = y * (1.f + smod[1024 + k]) + smod[k];
        }
        *(uint2*)(h2 + (size_t)row * 1024 + i * 256 + lane * 4) = make_uint2(pack2(h[u][4 * i], h[u][4 * i + 1]), pack2(h[u][4 * i + 2], h[u][4 * i + 3]));
      }
    }
  }
}

DEVI void phase14(const Params& p, unsigned char* smem, const XcdMap& xm) {
  bf16_t(*Qt)[136] = (bf16_t(*)[136])smem;
  float* Sc = (float*)smem;
  const int tid = threadIdx.x, lane = tid & 63, warp = tid >> 6, wm = warp >> 1, wn = warp & 1;
  const bf16_t* h2 = (const bf16_t*)(p.ws + R_H2);
  const bf16_t* keys = (const bf16_t*)(p.ws + O_KEYS);
  float* tops = (float*)(p.ws + R_TOPS);
  int* topi = (int*)(p.ws + R_TOPI);
  for_tiles_xcd(xm, 128, 16, 8, 8, [&](int mt, int hp) {
    f32x4 acc[4][4];
    zero_acc(acc);
    gemm_core(h2 + (size_t)mt * 128 * 1024, 1024, (const bf16_t*)(p.ws + O_WQ) + (size_t)hp * 128 * 1024, 1024, 1024, acc, smem);
#pragma unroll
    for (int i = 0; i < 4; ++i)
#pragma unroll
      for (int j = 0; j < 4; ++j)
        *(uint2*)&Qt[wm * 64 + i * 16 + (lane & 15)][wn * 64 + j * 16 + (lane >> 4) * 4] =
            make_uint2(pack2(acc[i][j][0], acc[i][j][1]), pack2(acc[i][j][2], acc[i][j][3]));
    __syncthreads();
    zero_acc(acc);
#pragma unroll
    for (int ks = 0; ks < 4; ++ks) {
      bf16x8 qf[4], kf[4];
#pragma unroll
      for (int i = 0; i < 4; ++i) qf[i] = *(const bf16x8*)&Qt[wm * 64 + i * 16 + (lane & 15)][ks * 32 + (lane >> 4) * 8];
#pragma unroll
      for (int j = 0; j < 4; ++j) kf[j] = *(const bf16x8*)(keys + ((size_t)hp * 128 + wn * 64 + j * 16 + (lane & 15)) * 128 + ks * 32 + (lane >> 4) * 8);
#pragma unroll
      for (int i = 0; i < 4; ++i)
#pragma unroll
        for (int j = 0; j < 4; ++j) acc[i][j] = __builtin_amdgcn_mfma_f32_16x16x32_bf16(kf[j], qf[i], acc[i][j], 0, 0, 0);
    }
    __syncthreads();
#pragma unroll
    for (int i = 0; i < 4; ++i)
#pragma unroll
      for (int j = 0; j < 4; ++j) {
        {
          const int c0 = j * 16 + (lane >> 4) * 4;
          u32x4 kq;
#pragma unroll
          for (int r = 0; r < 4; ++r) {
            unsigned u = __float_as_uint(acc[i][j][r]);
            u = (u & 0x80000000u) ? ~u : (u | 0x80000000u);
            kq[r] = (u & ~63u) | (unsigned)(63 - (c0 + r));
          }
          *(u32x4*)(Sc + (wm * 64 + i * 16 + (lane & 15)) * 132 + wn * 64 + c0) = kq;
        }
      }
    __syncthreads();
    {
      const int row = tid & 127, half = tid >> 7;
      float* hp_ = Sc + row * 132 + half * 64;
      float bv[16]; int bi[16];
      unsigned* hk = (unsigned*)hp_;
#pragma unroll
      for (int r = 0; r < 16; ++r) {
        unsigned best = 0u;
#pragma unroll 4
        for (int k = 0; k < 64; k += 4) {
          const u32x4 v4 = *(const u32x4*)(hk + k);
          const unsigned m01 = v4[0] > v4[1] ? v4[0] : v4[1], m23 = v4[2] > v4[3] ? v4[2] : v4[3];
          const unsigned m = m01 > m23 ? m01 : m23;
          best = best > m ? best : m;
        }
        const int b2 = 63 - (int)(best & 63u);
        unsigned u = best & ~63u;
        u = (u & 0x80000000u) ? (u & 0x7fffffffu) : ~u;
        bv[r] = __uint_as_float(u); bi[r] = b2 + half * 64; hk[b2] = 0u;
      }
#pragma unroll
      for (int r = 0; r < 16; ++r) { hp_[r] = bv[r]; hp_[16 + r] = __int_as_float(bi[r]); }
    }
    __syncthreads();
    if (tid < 128) {
      const float* la = Sc + tid * 132; const float* lb = la + 64;
      size_t ob = ((size_t)(mt * 128 + tid) * 16 + hp) * 16;
      int ia = 0, ib = 0;
      for (int r = 0; r < 16; ++r) {
        float va = la[ia], vb = lb[ib];
        bool ta = va >= vb;
        tops[ob + r] = ta ? va : vb;
        topi[ob + r] = __float_as_int(ta ? la[16 + ia] : lb[16 + ib]);
        ia += ta ? 1 : 0; ib += ta ? 0 : 1;
      }
    }
    __syncthreads();
  });
}

template <bool DRY> DEVI void phase15(const Params& p, unsigned char* smem) {
  const bool wr = !DRY || (p.in[I_FG][0] == 1234.5f);
  float* gt = (float*)smem;
  const int tid = threadIdx.x, lane = tid & 63, warp = tid >> 6;
  for (int i = tid; i < 1024; i += 256) gt[i] = mod_val(p, 0, 5120 + i);
  __syncthreads();
  const bf16_t* __restrict__ h2 = (const bf16_t*)(p.ws + R_H2);
  const float* __restrict__ tops = (const float*)(p.ws + R_TOPS);
  const int* __restrict__ topi = (const int*)(p.ws + R_TOPI);
  const unsigned char* __restrict__ uf8 = p.ws + R_UBF;
  const unsigned char* __restrict__ vf8 = p.ws + R_VBF;
  float* xo = p.out;
  int ca, cb;
  {
    int l = lane;
    if (l < 16) { ca = 0; cb = l; } else if (l < 24) { ca = 1; cb = l - 16; } else if (l < 29) { ca = 2; cb = l - 24; }
    else if (l < 33) { ca = 3; cb = l - 29; } else if (l < 36) { ca = 4; cb = l - 33; } else if (l < 38) { ca = 5; cb = l - 36; }
    else if (l < 40) { ca = 6; cb = l - 38; } else if (l < 42) { ca = 7; cb = l - 40; } else if (l < 50) { ca = l - 34; cb = 0; }
    else { ca = 0; cb = 0; }
  }
  const int flat = ca * 16 + cb;
  for (int t = blockIdx.x * 4 + warp; t < T_LAT; t += gridDim.x * 4) {
    float hv[16], out[16];
    {
      const u32x4 hp0 = *(const u32x4*)(h2 + (size_t)t * 1024 + lane * 16);
      const u32x4 hp1 = *(const u32x4*)(h2 + (size_t)t * 1024 + lane * 16 + 8);
#pragma unroll
      for (int e = 0; e < 4; ++e) { hv[2 * e] = bflo(hp0[e]); hv[2 * e + 1] = bfhi(hp0[e]); hv[8 + 2 * e] = bflo(hp1[e]); hv[8 + 2 * e + 1] = bfhi(hp1[e]); }
    }
#pragma unroll
    for (int e = 0; e < 16; ++e) out[e] = 0.f;
#pragma unroll 1
    for (int hd = 0; hd < 8; ++hd) {
      const size_t b1 = ((size_t)t * 16 + hd * 2) * 16, b2 = b1 + 16;
      float val = lane < 50 ? tops[b1 + ca] + tops[b2 + cb] : -INFINITY;
      int idx = topi[b1 + ca] * 128 + topi[b2 + cb];
      unsigned key = __float_as_uint(val);
      key = (key & 0x80000000u) ? ~key : (key | 0x80000000u);
      key = lane < 50 ? ((key & ~63u) | (unsigned)(63 - lane)) : 0u;
      int cnt = 0;
#pragma unroll
      for (int i = 0; i < 50; ++i) cnt += ((unsigned)__builtin_amdgcn_readlane((int)key, i) > key) ? 1 : 0;
      bool sel = lane < 50 && cnt < 16;
      float vmax = rlf(val, 0);
      float ex = sel ? __expf(val - vmax) : 0.f;
      float gsum = wave_sum_u(ex);
      float g = ex / gsum;
      unsigned long long m1 = __ballot(sel);
      int es[16];
      float gq = 0.f;
#pragma unroll
      for (int q = 0; q < 16; ++q) {
        int src = __ffsll((long long)m1) - 1; m1 &= m1 - 1;
        es[q] = __builtin_amdgcn_readlane(idx, src);
        float gg = rlf(g, src);
        if (lane == q) gq = gg;
      }
      float dm = 0.f;
      {
        u32x4 ub[16];
#pragma unroll
        for (int q = 0; q < 16; ++q) ub[q] = *(const u32x4*)(uf8 + (size_t)es[q] * 1024 + lane * 16);
#pragma unroll
        for (int q = 0; q < 16; ++q) {
          float f[16]; unpack_fp8x16(ub[q], f);
          float d0 = 0.f, d1 = 0.f;
#pragma unroll
          for (int e = 0; e < 8; ++e) { d0 += f[2 * e] * hv[2 * e]; d1 += f[2 * e + 1] * hv[2 * e + 1]; }
          float d = wave_sum_u(d0 + d1);
          if (lane == q) dm = d;
        }
      }
      dm *= (1.f / 64.f);
      float coef = gq * 0.5f * dm * (1.f + erff(dm * 0.70710678118f)) * 0.25f;
      {
        u32x4 vb[16];
#pragma unroll
        for (int q = 0; q < 16; ++q) vb[q] = *(const u32x4*)(vf8 + (size_t)es[q] * 1024 + lane * 16);
#pragma unroll
        for (int q = 0; q < 16; ++q) {
          float cf = rlf(coef, q);
          float f[16]; unpack_fp8x16(vb[q], f);
#pragma unroll
          for (int e = 0; e < 16; ++e) out[e] += cf * f[e];
        }
      }
    }
    float xs[16]; float ss = 0.f;
#pragma unroll
    for (int i = 0; i < 4; ++i) {
      int k = lane * 16 + i * 4;
      float4 v = *(const float4*)(xo + (size_t)t * 1024 + k);
      xs[4 * i] = v.x + gt[k] * out[4 * i]; xs[4 * i + 1] = v.y + gt[k + 1] * out[4 * i + 1];
      xs[4 * i + 2] = v.z + gt[k + 2] * out[4 * i + 2]; xs[4 * i + 3] = v.w + gt[k + 3] * out[4 * i + 3];
      ss += xs[4 * i] * xs[4 * i] + xs[4 * i + 1] * xs[4 * i + 1] + xs[4 * i + 2] * xs[4 * i + 2] + xs[4 * i + 3] * xs[4 * i + 3];
    }
    ss = wave_sum_u(ss);
    float rstd = rsqrtf(ss * (1.f / 1024.f) + 1e-6f);
#pragma unroll
    for (int i = 0; i < 4; ++i) {
      int k = lane * 16 + i * 4;
      float4 g4 = *(const float4*)(p.in[I_FG] + k);
      if (wr) *(float4*)(xo + (size_t)t * 1024 + k) = make_float4(xs[4 * i] * rstd * g4.x, xs[4 * i + 1] * rstd * g4.y, xs[4 * i + 2] * rstd * g4.z, xs[4 * i + 3] * rstd * g4.w);
    }
  }
}

#define XB_TMO      128
#define XB_XCNT(j)  (256  + 64 * (j))
#define XB_XSUB(j)  (1280 + 64 * (j))
#define XB_XGEN(j)  (2304 + 64 * (j))
#define XB_TOP      3328
#define XB_TOPGEN   3392
#define XCD_BAR_WORDS 3456
#define XB_SPIN_CAP (1u << 22)
#define LAS __attribute__((address_space(3)))
DEVI unsigned xb_ld(unsigned* p) { return __hip_atomic_load(p, __ATOMIC_RELAXED, __HIP_MEMORY_SCOPE_AGENT); }
DEVI unsigned xb_add(unsigned* p, unsigned v) { return __hip_atomic_fetch_add(p, v, __ATOMIC_RELAXED, __HIP_MEMORY_SCOPE_AGENT); }
DEVI unsigned xb_xcc_id() { return (unsigned)__builtin_amdgcn_s_getreg((3 << 11) | 20) & 0xFu; }
#define XB_SPIN(cond, bar) do { unsigned _sp = 0; while (cond) { __builtin_amdgcn_s_sleep(1); \
    if ((++_sp & 255u) == 0u) { if (xb_ld(&(bar)[XB_TMO])) break; if (_sp > XB_SPIN_CAP) { atomicAdd(&(bar)[XB_TMO], 1u); break; } } } } while (0)
struct XcdBarrier { unsigned* bar; unsigned x; volatile LAS unsigned* st; };
DEVI XcdBarrier xcd_barrier_post(unsigned* bar, volatile LAS unsigned* st) {
  XcdBarrier b; b.bar = bar; b.x = xb_xcc_id(); b.st = st;
  if (threadIdx.x == 0) st[2] = xb_add(&bar[XB_XCNT(b.x)], 1u);
  return b;
}
DEVI void xcd_barrier_complete(unsigned* bar, unsigned x, unsigned& nloc, unsigned& nx, unsigned& vidx) {
  const unsigned G = gridDim.x * gridDim.y * gridDim.z;
  unsigned sum, cnt, mine, below, sp = 0u;
  for (;;) {
    sum = 0u; cnt = 0u; mine = 0u; below = 0u;
#pragma unroll
    for (unsigned j = 0; j < 16; ++j) { const unsigned c = xb_ld(&bar[XB_XCNT(j)]); sum += c; cnt += (c > 0u) ? 1u : 0u; mine = (j == x) ? c : mine; below += (c > 0u && j < x) ? 1u : 0u; }
    if (sum == G) break;
    __builtin_amdgcn_s_sleep(1);
    if ((++sp & 255u) == 0u) { if (xb_ld(&bar[XB_TMO])) break; if (sp > XB_SPIN_CAP) { atomicAdd(&bar[XB_TMO], 1u); break; } }
  }
  nloc = mine > 0u ? mine : 1u; nx = cnt > 0u ? cnt : 1u; vidx = below;
}
DEVI void xcd_barrier(const XcdBarrier& b) {
  asm volatile("s_waitcnt vmcnt(0)" ::: "memory");
  __syncthreads();
  if (threadIdx.x == 0) {
    unsigned* bar = b.bar;
    __builtin_amdgcn_s_waitcnt(0);
    unsigned nloc = b.st[0], nx = b.st[1];
    if (nloc == 0u) { unsigned vidx; xcd_barrier_complete(bar, b.x, nloc, nx, vidx); b.st[0] = nloc; b.st[1] = nx; b.st[3] = vidx; }
    const unsigned old = xb_add(&bar[XB_XSUB(b.x)], 1u);
    const unsigned gen = old / nloc;
    if (old + 1u == (gen + 1u) * nloc) {
      __builtin_amdgcn_fence(__ATOMIC_RELEASE, "agent");
      asm volatile("s_waitcnt vmcnt(0)" ::: "memory");
      const unsigned og = xb_add(&bar[XB_TOP], 1u);
      const unsigned tg = og / nx;
      if (og + 1u == (tg + 1u) * nx) xb_add(&bar[XB_TOPGEN], 1u);
      else XB_SPIN(xb_ld(&bar[XB_TOPGEN]) == tg, bar);
      __builtin_amdgcn_fence(__ATOMIC_ACQUIRE, "agent");
      xb_add(&bar[XB_XGEN(b.x)], 1u);
      asm volatile("s_waitcnt vmcnt(0)" ::: "memory");
    } else {
      XB_SPIN(xb_ld(&bar[XB_XGEN(b.x)]) == gen, bar);
      __builtin_amdgcn_fence(__ATOMIC_ACQUIRE, "agent");
      asm volatile("s_waitcnt vmcnt(0)" ::: "memory");
    }
  }
  __syncthreads();
}

constexpr int NPHASE = 16;
DEVI XcdMap get_xm(int coop, const uint4& w) {
  XcdMap m;
  if (coop) { m.v = (int)w.w; m.nx = (int)w.y; m.slot = (int)w.z; m.slots = (int)w.x; }
  else { m.v = blockIdx.x & 7; m.nx = 8; m.slot = blockIdx.x >> 3; m.slots = gridDim.x >> 3; if (m.slots < 1) { m.slots = 1; } }
  return m;
}
__global__ void __launch_bounds__(256, 2) mk(Params p, int ph0, int ph1, int coop) {
  __shared__ __attribute__((aligned(16))) unsigned char smem[SMEM_BYTES];
  __shared__ uint4 xb_words;
  if (threadIdx.x == 0) xb_words = make_uint4(0u, 0u, 0u, 0u);
  __syncthreads();
  XcdBarrier xb;
  if (coop) xb = xcd_barrier_post((unsigned*)(p.ws + O_BAR), (volatile LAS unsigned*)&xb_words);
#ifdef XCC_PROBE
  if (coop && xb_xcc_id() != (blockIdx.x & 7u)) { unsigned long long t0 = wall_clock64(); while (wall_clock64() - t0 < 100000ull) __builtin_amdgcn_s_sleep(8); }
#endif
  if (ph0 < 0) cg::this_grid().sync();
#ifdef PROBE_A
#define STAMP(n) if (blockIdx.x == 0 && threadIdx.x == 0) ((unsigned long long*)(p.ws + O_STAMP))[n] = wall_clock64();
#else
#define STAMP(n)
#endif
#define RUN_PHASE(n, call)                                   \
  if (ph0 <= n && n < ph1) {                                 \
    STAMP(n)                                                 \
        if (DRY_PH == n) { if (n == 4) phase4<true>(p); if (n == 5) phase5<true>(p, smem); if (n == 8) phase8<true>(p, smem); if (n == 15) phase15<true>(p, smem); } \
    if (ONLY < 0 || ONLY == n) { call; }                     \
    if (REPEAT_PH == n) { call; }                            \
    if (coop && n + 1 < ph1) xcd_barrier(xb);                \
  }
  RUN_PHASE(0, phase0(p, smem, 0, 384))
  RUN_PHASE(1, (phase1(p, smem), __syncthreads(), phase0(p, smem, 384, 1 << 30)))
  RUN_PHASE(2, phase2(p, smem, get_xm(coop, xb_words)))
  RUN_PHASE(3, phase3(p, smem))
  RUN_PHASE(4, (phase4<false>(p), phase6(p, smem, 0, 32, gridDim.x > 290 ? 258 : 0, gridDim.x > 290 ? (int)gridDim.x - 258 : (int)gridDim.x)))
  RUN_PHASE(5, phase5<false>(p, smem))
  RUN_PHASE(6, phase6(p, smem, 32, 260 * 8, 0, (int)gridDim.x))
  RUN_PHASE(7, phase7(p))
  RUN_PHASE(8, phase8<false>(p, smem))
  RUN_PHASE(9, phase9(p))
  RUN_PHASE(10, phase10(p))
  RUN_PHASE(11, phase11(p, smem, get_xm(coop, xb_words)))
  RUN_PHASE(12, (phase12(p, smem, get_xm(coop, xb_words)), convert_fp8(p.in[I_PU], p.ws + R_UBF, (size_t)16384 * 64, 64.f)))
  RUN_PHASE(13, phase13(p, smem))
  RUN_PHASE(14, (phase14(p, smem, get_xm(coop, xb_words)), convert_fp8(p.in[I_PV], p.ws + R_VBF, (size_t)16384 * 64, 4.f)))
  RUN_PHASE(15, phase15<false>(p, smem))
#ifdef SYNC_EXTRA
  for (int i = 0; i < SYNC_EXTRA; ++i) xcd_barrier(xb);
#endif
#ifdef PROBE_A
  cg::this_grid().sync();
  STAMP(16)
  __syncthreads();
  if (blockIdx.x == 0) {
    const unsigned long long* st = (const unsigned long long*)(p.ws + O_STAMP);
    float ta = (float)(st[PROBE_A + 1] - st[PROBE_A]) * 0.01f, tb = (float)(st[PROBE_B + 1] - st[PROBE_B]) * 0.01f;
    for (int i = threadIdx.x; i < 1000000; i += 256) p.out[1 + i] = tb;
    if (threadIdx.x == 0) p.out[0] = 100.f * ta;
  }
#endif
}

extern "C" void kernel_launch(void* const* d_in, const int* in_sizes, int n_in, void* d_out, int out_size, void* d_ws,
                              size_t ws_size, hipStream_t stream) {
  static int grid_blocks = 0;
  if (!grid_blocks) {
    int dev = 0, cus = 0, per_cu = 0;
    hipGetDevice(&dev);
    hipDeviceGetAttribute(&cus, hipDeviceAttributeMultiprocessorCount, dev);
    hipOccupancyMaxActiveBlocksPerMultiprocessor(&per_cu, mk, 256, 0);
    if (per_cu < 1) per_cu = 1;
    if (per_cu > 2) per_cu = 2;
    grid_blocks = cus * per_cu;
  }
  if (ws_size < WS_NEED) { fprintf(stderr, "workspace too small: %zu < %zu\n", ws_size, (size_t)WS_NEED); return; }
  Params p{};
  for (int i = 0; i < 32; ++i) p.in[i] = (const float*)d_in[i];
  p.out = (float*)d_out;
  p.ws = (unsigned char*)d_ws;
#if MEGA
  (void)hipMemsetAsync((unsigned char*)d_ws + O_BAR, 0, XCD_BAR_WORDS * 4, stream);
  int ph0 = 0, ph1 = NPHASE, coop = 1;
  void* args[] = {&p, &ph0, &ph1, &coop};
  hipError_t e = hipLaunchCooperativeKernel((void*)mk, dim3(grid_blocks), dim3(256), args, 0, stream);
  if (e != hipSuccess) fprintf(stderr, "cooperative launch failed: %s (grid %d)\n", hipGetErrorString(e), grid_blocks);
#else
  for (int ph = 0; ph < NPHASE; ++ph) mk<<<grid_blocks, 256, 0, stream>>>(p, ph, ph + 1, 0);
#endif
}
```

```cpp
#include <hip/hip_runtime.h>
#include <hip/hip_cooperative_groups.h>
#include <cstdio>
#include <cstdint>
namespace cg = cooperative_groups;

#ifndef MEGA
#define MEGA 1
#endif
#ifndef ONLY
#define ONLY -1
#endif
#ifndef REPEAT_PH
#define REPEAT_PH -1
#endif
#ifndef DRY_PH
#define DRY_PH -1
#endif

typedef unsigned short bf16_t;
using bf16x8 = __attribute__((ext_vector_type(8))) short;
using f32x4 = __attribute__((ext_vector_type(4))) float;
using u32x4 = __attribute__((ext_vector_type(4))) unsigned;
#define DEVI __device__ __forceinline__

constexpr int T_CTX = 256, T_LAT = 16384, T_ALL = 16640;
constexpr int NIN = 5392, NP = 5376;
constexpr int NCH = 128, LCH = 130;
constexpr int SVH = 576;
constexpr int SMEM_BYTES = 71680;

enum { I_X = 0, I_C, I_CTX, I_CCTX, I_ADAW, I_ADAB, I_N1G, I_WIN, I_RCONV, I_RW0, I_RWUP, I_RA0, I_RAUP, I_RGUP,
       I_RKK, I_RKA, I_RRK, I_RLNW, I_RLNB, I_MCONV, I_MIB, I_MFB, I_MNG, I_WBA, I_WBB, I_WOUT, I_N2G, I_WQ,
       I_KEYS, I_PU, I_PV, I_FG };

struct Params { const float* in[32]; float* out; unsigned char* ws; };

constexpr size_t A256(size_t x) { return (x + 255) & ~(size_t)255; }
constexpr size_t O_MODP = 0;
constexpr size_t O_WBA = A256(O_MODP + (size_t)16 * 2 * 6144 * 4);
constexpr size_t O_WBB = A256(O_WBA + (size_t)1024 * 512 * 2);
constexpr size_t O_WOUT = A256(O_WBB + (size_t)1024 * 512 * 2);
constexpr size_t O_WQ = A256(O_WOUT + (size_t)1024 * 1024 * 2);
constexpr size_t O_KEYS = A256(O_WQ + (size_t)2048 * 1024 * 2);
constexpr size_t O_WUP = A256(O_KEYS + (size_t)16 * 128 * 128 * 2);
constexpr size_t O_AUP = A256(O_WUP + (size_t)1024 * 64 * 2);
constexpr size_t O_GUP = A256(O_AUP + (size_t)1024 * 64 * 2);
constexpr size_t O_BEND = A256(O_GUP + (size_t)512 * 128 * 2);
constexpr size_t O_MLOC = A256(O_BEND + (size_t)260 * 8 * 4);
constexpr size_t O_MST = A256(O_MLOC + (size_t)260 * 8 * 4);
constexpr size_t O_NT = A256(O_MST + (size_t)260 * 8 * 4);
constexpr size_t O_BONUS = A256(O_NT + (size_t)260 * 8 * 64 * 4);
constexpr size_t O_STAMP = A256(O_BONUS + (size_t)T_ALL * 16 * 4);
constexpr size_t O_BAR = A256(O_STAMP + 1024);
constexpr size_t O_PG = A256(O_BAR + 3456 * 4);
constexpr size_t O_PO = A256(O_PG + (size_t)T_LAT * 2048 * 2);
constexpr size_t O_R = A256(O_PO + (size_t)T_LAT * 512 * 2);
constexpr size_t R_HX = O_R;
constexpr size_t R_WIN = A256(R_HX + (size_t)T_ALL * 1024 * 2);
constexpr size_t R_PQK = A256(R_WIN + (size_t)(NP + 128) * 1024 * 2);
constexpr size_t R_PV = A256(R_PQK + (size_t)T_ALL * 512 * 2);
constexpr size_t R_GIF = A256(R_PV + (size_t)T_ALL * 512 * 2);
constexpr size_t R_U = A256(R_GIF + (size_t)T_ALL * 16 * 4);
constexpr size_t R_END1 = A256(R_U + (size_t)260 * 8 * 8192 * 4);
constexpr size_t R_SV = O_R;
constexpr size_t R_YA = A256(R_SV + (size_t)T_ALL * 8 * SVH * 2);
constexpr size_t R_END2 = A256(R_YA + (size_t)T_LAT * 512 * 2);
constexpr size_t R_MERGED = O_R;
constexpr size_t R_H2 = A256(R_MERGED + (size_t)T_LAT * 1024 * 2);
constexpr size_t R_TOPS = A256(R_H2 + (size_t)T_LAT * 1024 * 2);
constexpr size_t R_TOPI = A256(R_TOPS + (size_t)T_LAT * 256 * 4);
constexpr size_t R_UBF = A256(R_TOPI + (size_t)T_LAT * 256 * 4);
constexpr size_t R_VBF = A256(R_UBF + (size_t)16384 * 1024 * 2);
constexpr size_t R_END3 = A256(R_VBF + (size_t)16384 * 1024 * 2);
constexpr size_t WS_NEED = (R_END1 > R_END2 ? (R_END1 > R_END3 ? R_END1 : R_END3) : (R_END2 > R_END3 ? R_END2 : R_END3));
constexpr size_t OUT_BC = (size_t)NCH * 16 * 4096 * 4;

DEVI bf16_t f2bf(float f) { unsigned u = __float_as_uint(f); u += 0x7fffu + ((u >> 16) & 1u); return (bf16_t)(u >> 16); }
DEVI float bf2f(bf16_t h) { return __uint_as_float(((unsigned)h) << 16); }
DEVI float bflo(unsigned u) { return __uint_as_float(u << 16); }
DEVI float bfhi(unsigned u) { return __uint_as_float(u & 0xffff0000u); }
DEVI unsigned pack2(float a, float b) { return (unsigned)f2bf(a) | ((unsigned)f2bf(b) << 16); }
DEVI void unpack8(const uint4& u, float* f) {
  f[0] = bflo(u.x); f[1] = bfhi(u.x); f[2] = bflo(u.y); f[3] = bfhi(u.y);
  f[4] = bflo(u.z); f[5] = bfhi(u.z); f[6] = bflo(u.w); f[7] = bfhi(u.w);
}
DEVI uint4 pack8(const float* f) { return make_uint4(pack2(f[0], f[1]), pack2(f[2], f[3]), pack2(f[4], f[5]), pack2(f[6], f[7])); }
DEVI float wave_sum(float v) {
#pragma unroll
  for (int o = 32; o; o >>= 1) v += __shfl_xor(v, o);
  return v;
}
DEVI float wave_max(float v) {
#pragma unroll
  for (int o = 32; o; o >>= 1) v = fmaxf(v, __shfl_xor(v, o));
  return v;
}
DEVI float sigm(float x) { return 1.f / (1.f + __expf(-x)); }
DEVI float siluf(float x) { return x / (1.f + __expf(-x)); }
DEVI float logsig(float x) { return fminf(x, 0.f) - log1pf(expf(-fabsf(x))); }
template <int CTRL> DEVI float dppf(float v) { return __int_as_float(__builtin_amdgcn_update_dpp(0, __float_as_int(v), CTRL, 0xf, 0xf, true)); }
DEVI float rlf(float v, int l) { return __int_as_float(__builtin_amdgcn_readlane(__float_as_int(v), l)); }
DEVI float wave_sum_u(float v) {
  v += dppf<0xB1>(v); v += dppf<0x4E>(v); v += dppf<0x141>(v); v += dppf<0x140>(v);
  return (rlf(v, 0) + rlf(v, 16)) + (rlf(v, 32) + rlf(v, 48));
}
typedef __attribute__((ext_vector_type(2))) short s16x2;
DEVI float dot2bf(unsigned a, unsigned b, float c) { return __builtin_amdgcn_fdot2_f32_bf16(__builtin_bit_cast(s16x2, a), __builtin_bit_cast(s16x2, b), c, false); }
typedef __attribute__((ext_vector_type(2))) float f32x2;
DEVI void convert_fp8(const float* __restrict__ src, unsigned char* __restrict__ dst, size_t n16, float scale) {
  for (size_t g = (size_t)blockIdx.x * 256 + threadIdx.x; g < n16; g += (size_t)gridDim.x * 256) {
    u32x4 o;
#pragma unroll
    for (int q = 0; q < 4; ++q) {
      float4 a = *(const float4*)(src + g * 16 + q * 4);
      int pk = __builtin_amdgcn_cvt_pk_fp8_f32(a.x * scale, a.y * scale, 0, false);
      pk = __builtin_amdgcn_cvt_pk_fp8_f32(a.z * scale, a.w * scale, pk, true);
      o[q] = (unsigned)pk;
    }
    *(u32x4*)(dst + g * 16) = o;
  }
}
DEVI void unpack_fp8x16(const u32x4& u, float* f) {
#pragma unroll
  for (int q = 0; q < 4; ++q) {
    f32x2 lo = __builtin_amdgcn_cvt_pk_f32_fp8((int)u[q], false), hi = __builtin_amdgcn_cvt_pk_f32_fp8((int)u[q], true);
    f[4 * q] = lo[0]; f[4 * q + 1] = lo[1]; f[4 * q + 2] = hi[0]; f[4 * q + 3] = hi[1];
  }
}
DEVI void convert_bf16(const float* __restrict__ src, bf16_t* __restrict__ dst, size_t n8) {
  for (size_t g = (size_t)blockIdx.x * 256 + threadIdx.x; g < n8; g += (size_t)gridDim.x * 256) {
    float4 a = *(const float4*)(src + g * 8), b = *(const float4*)(src + g * 8 + 4);
    *(uint4*)(dst + g * 8) = make_uint4(pack2(a.x, a.y), pack2(a.z, a.w), pack2(b.x, b.y), pack2(b.z, b.w));
  }
}
DEVI float allred8(float v) { v += dppf<0xB1>(v); v += dppf<0x4E>(v); v += dppf<0x141>(v); return v; }

DEVI int ml_row(int c, int j) {
  if (c < 4) return c * 64 + j;
  int cc = c - 4; int col = cc >> 2; int gr = (cc & 3) * 64 + j;
  return T_CTX + gr * 64 + col;
}
DEVI int ml_sc(int c, int dir) { return dir == 0 ? c : (c < 4 ? 3 - c : 263 - c); }
DEVI int rw_row(int p, int dir) { return dir == 0 ? p : (p < T_CTX ? (T_CTX - 1 - p) : (T_ALL + T_CTX - 1 - p)); }

DEVI float mod_val(const Params& p, int which, int col) {
  const float* modp = (const float*)(p.ws + O_MODP);
  float s = p.in[I_ADAB][col];
#pragma unroll
  for (int rs = 0; rs < 16; ++rs) s += modp[(rs * 2 + which) * 6144 + col];
  return s;
}

DEVI void gemm_core(const bf16_t* __restrict__ A, int lda, const bf16_t* __restrict__ Bt, int ldb, int K,
                    f32x4 (&acc)[4][4], unsigned char* smem) {
  bf16_t(*sa)[80] = (bf16_t(*)[80])smem;
  bf16_t(*sb)[80] = (bf16_t(*)[80])(smem + 128 * 80 * 2);
  const int tid = threadIdx.x, lane = tid & 63, warp = tid >> 6, wm = warp >> 1, wn = warp & 1;
  const int lr = tid >> 3, lk = (tid & 7) * 8;
  const bf16_t* Ap = A + (size_t)lr * lda + lk;
  const bf16_t* Bp = Bt + (size_t)lr * ldb + lk;
  u32x4 ra0[4], rb0[4], ra1[4], rb1[4];
#pragma unroll
  for (int i = 0; i < 4; ++i) {
    ra0[i] = *(const u32x4*)(Ap + (size_t)(32 * i) * lda); rb0[i] = *(const u32x4*)(Bp + (size_t)(32 * i) * ldb);
    ra1[i] = *(const u32x4*)(Ap + (size_t)(32 * i) * lda + 64); rb1[i] = *(const u32x4*)(Bp + (size_t)(32 * i) * ldb + 64);
  }
#define GEMM_STEP(k0, ra, rb)                                                                                 \
  {                                                                                                           \
    __syncthreads();                                                                                          \
    _Pragma("unroll") for (int i = 0; i < 4; ++i) { *(u32x4*)&sa[lr + 32 * i][lk] = ra[i]; *(u32x4*)&sb[lr + 32 * i][lk] = rb[i]; } \
    __syncthreads();                                                                                          \
    if ((k0) + 128 < K) {                                                                                     \
      _Pragma("unroll") for (int i = 0; i < 4; ++i) {                                                         \
        ra[i] = *(const u32x4*)(Ap + (size_t)(32 * i) * lda + (k0) + 128);                                    \
        rb[i] = *(const u32x4*)(Bp + (size_t)(32 * i) * ldb + (k0) + 128);                                    \
      }                                                                                                       \
    }                                                                                                         \
    __builtin_amdgcn_s_setprio(1);                                                                            \
    _Pragma("unroll") for (int ks = 0; ks < 2; ++ks) {                                                        \
      bf16x8 af[4], bq[4];                                                                                    \
      _Pragma("unroll") for (int i = 0; i < 4; ++i) af[i] = *(const bf16x8*)&sa[wm * 64 + i * 16 + (lane & 15)][ks * 32 + (lane >> 4) * 8]; \
      _Pragma("unroll") for (int j = 0; j < 4; ++j) bq[j] = *(const bf16x8*)&sb[wn * 64 + j * 16 + (lane & 15)][ks * 32 + (lane >> 4) * 8]; \
      _Pragma("unroll") for (int i = 0; i < 4; ++i)                                                           \
        _Pragma("unroll") for (int j = 0; j < 4; ++j) acc[i][j] = __builtin_amdgcn_mfma_f32_16x16x32_bf16(bq[j], af[i], acc[i][j], 0, 0, 0); \
    }                                                                                                         \
    __builtin_amdgcn_s_setprio(0);                                                                            \
  }
  for (int k0 = 0; k0 < K; k0 += 128) {
    GEMM_STEP(k0, ra0, rb0)
    GEMM_STEP(k0 + 64, ra1, rb1)
  }
#undef GEMM_STEP
  __syncthreads();
}
DEVI void zero_acc(f32x4 (&acc)[4][4]) {
#pragma unroll
  for (int i = 0; i < 4; ++i)
#pragma unroll
    for (int j = 0; j < 4; ++j) acc[i][j] = f32x4{0.f, 0.f, 0.f, 0.f};
}

struct XcdMap { int v, nx, slot, slots; };
template <typename F> DEVI void for_tiles_xcd(const XcdMap& xm, int MT, int NT, int SM, int SN, F&& f) {
  const int nsn = (NT + SN - 1) / SN, nst = ((MT + SM - 1) / SM) * nsn, per = SM * SN;
  const int n_my = (nst - xm.v + xm.nx - 1) / xm.nx;
  for (int g = xm.slot; g < n_my * per; g += xm.slots) {
    const int s = xm.v + (g / per) * xm.nx, idx = g % per;
    const int sm = s / nsn, sn = s % nsn;
    const int mt = sm * SM + idx / SN, nt = sn * SN + idx % SN;
    if (mt < MT && nt < NT) f(mt, nt);
  }
}

DEVI void tr_tile(const float* __restrict__ src, int lds, int k0, int n0src, bf16_t* __restrict__ dst, int ldd, int n0dst,
                  unsigned char* smem) {
  float(*tile)[65] = (float(*)[65])smem;
  const int tid = threadIdx.x, j = tid & 63, i0 = tid >> 6;
#pragma unroll 4
  for (int ii = 0; ii < 16; ++ii) { int i = i0 + 4 * ii; tile[i][j] = src[(size_t)(k0 + i) * lds + n0src + j]; }
  __syncthreads();
#pragma unroll 4
  for (int jj = 0; jj < 16; ++jj) { int jn = i0 + 4 * jj; dst[(size_t)(n0dst + jn) * ldd + k0 + j] = f2bf(tile[j][jn]); }
  __syncthreads();
}

DEVI void phase0(const Params& p, unsigned char* smem, int it_lo, int it_hi) {
  const int tid = threadIdx.x;
  constexpr int N_MOD = 384, N_WIN = 16 * 85, N_WB = 128, N_WOUT = 256, N_WQ = 512, N_LORA = 16, N_GUP = 16, N_KEYS = 128;
  constexpr int E0 = N_MOD, E1 = E0 + N_WIN, E2 = E1 + N_WB, E3 = E2 + N_WB, E4 = E3 + N_WOUT, E5 = E4 + N_WQ,
                E6 = E5 + N_LORA, E7 = E6 + N_LORA, E8 = E7 + N_GUP, E9 = E8 + N_KEYS;
  if (it_hi > E9) it_hi = E9;
  for (int it = it_lo + blockIdx.x; it < it_hi; it += gridDim.x) {
    if (it < E0) {
      int cb = it % 24, rs = it / 24; int col = cb * 256 + tid;
      const float* aw = p.in[I_ADAW];
      float ax = 0.f, ac = 0.f;
#pragma unroll 8
      for (int r = rs * 64; r < rs * 64 + 64; ++r) {
        float w = aw[(size_t)r * 6144 + col];
        ax += siluf(p.in[I_C][r]) * w;
        ac += siluf(p.in[I_CCTX][r]) * w;
      }
      float* modp = (float*)(p.ws + O_MODP);
      modp[(rs * 2 + 0) * 6144 + col] = ax;
      modp[(rs * 2 + 1) * 6144 + col] = ac;
    } else if (it < E1) {
      int t = it - E0; int kt = t / 85, nt = t % 85; int n0 = nt * 64;
      tr_tile(p.in[I_WIN], NIN, kt * 64, nt == 84 ? 2816 : (n0 < 2816 ? n0 : n0 + 16), (bf16_t*)(p.ws + R_WIN), 1024, n0, smem);
    } else if (it < E2) {
      int t = it - E1; tr_tile(p.in[I_WBA], 1024, (t / 16) * 64, (t % 16) * 64, (bf16_t*)(p.ws + O_WBA), 512, (t % 16) * 64, smem);
    } else if (it < E3) {
      int t = it - E2; tr_tile(p.in[I_WBB], 1024, (t / 16) * 64, (t % 16) * 64, (bf16_t*)(p.ws + O_WBB), 512, (t % 16) * 64, smem);
    } else if (it < E4) {
      int t = it - E3; tr_tile(p.in[I_WOUT], 1024, (t / 16) * 64, (t % 16) * 64, (bf16_t*)(p.ws + O_WOUT), 1024, (t % 16) * 64, smem);
    } else if (it < E5) {
      int t = it - E4; tr_tile(p.in[I_WQ], 2048, (t / 32) * 64, (t % 32) * 64, (bf16_t*)(p.ws + O_WQ), 1024, (t % 32) * 64, smem);
    } else if (it < E6) {
      int t = it - E5; int dir = t / 8, nt = t % 8;
      tr_tile(p.in[I_RWUP] + (size_t)dir * 64 * 512, 512, 0, nt * 64, (bf16_t*)(p.ws + O_WUP) + (size_t)dir * 512 * 64, 64, nt * 64, smem);
    } else if (it < E7) {
      int t = it - E6; int dir = t / 8, nt = t % 8;
      tr_tile(p.in[I_RAUP] + (size_t)dir * 64 * 512, 512, 0, nt * 64, (bf16_t*)(p.ws + O_AUP) + (size_t)dir * 512 * 64, 64, nt * 64, smem);
    } else if (it < E8) {
      int t = it - E7; tr_tile(p.in[I_RGUP], 512, (t / 8) * 64, (t % 8) * 64, (bf16_t*)(p.ws + O_GUP), 128, (t % 8) * 64, smem);
    } else {
      int t = it - E8; size_t base = (size_t)t * 2048 + tid * 8;
      const float* s = p.in[I_KEYS] + base;
      float f[8];
      float4 a = *(const float4*)s, b = *(const float4*)(s + 4);
      f[0] = a.x; f[1] = a.y; f[2] = a.z; f[3] = a.w; f[4] = b.x; f[5] = b.y; f[6] = b.z; f[7] = b.w;
      *(uint4*)((bf16_t*)(p.ws + O_KEYS) + base) = pack8(f);
    }
  }
}

DEVI void phase1(const Params& p, unsigned char* smem) {
  float* smod = (float*)smem;
  const int tid = threadIdx.x, lane = tid & 63, warp = tid >> 6;
  for (int i = tid; i < 4096; i += 256) { int which = i >> 10; smod[i] = mod_val(p, which >> 1, (which & 1) * 1024 + (i & 1023)); }
  __syncthreads();
  bf16_t* hx = (bf16_t*)(p.ws + R_HX);
  float* gif = (float*)(p.ws + R_GIF);
  const float* win = p.in[I_WIN];
  constexpr int RPW = 4;
  for (int rg = blockIdx.x * 4 + warp; rg < T_ALL / RPW; rg += gridDim.x * 4) {
    const int row0 = rg * RPW;
    const float* sh = smod + (row0 < T_CTX ? 2048 : 0);
    const float* sc = sh + 1024;
    const float* src0 = row0 < T_CTX ? p.in[I_CTX] + (size_t)row0 * 1024 : p.in[I_X] + (size_t)(row0 - T_CTX) * 1024;
    float rstd[RPW];
#pragma unroll
    for (int r = 0; r < RPW; ++r) {
      float ss = 0.f;
#pragma unroll
      for (int i = 0; i < 4; ++i) {
        float4 v = *(const float4*)(src0 + (size_t)r * 1024 + i * 256 + lane * 4);
        ss += v.x * v.x + v.y * v.y + v.z * v.z + v.w * v.w;
      }
      ss = wave_sum_u(ss);
      rstd[r] = rsqrtf(ss * (1.f / 1024.f) + 1e-6f);
    }
#pragma unroll
    for (int i = 0; i < 4; ++i) {
      const int k0 = i * 256 + lane * 4;
      const float4 gk = *(const float4*)(p.in[I_N1G] + k0);
      const float4 s4 = *(const float4*)(sc + k0), h4 = *(const float4*)(sh + k0);
#pragma unroll
      for (int r = 0; r < RPW; ++r) {
        float4 v = *(const float4*)(src0 + (size_t)r * 1024 + k0);
        const float y0 = v.x * rstd[r] * gk.x * (1.f + s4.x) + h4.x, y1 = v.y * rstd[r] * gk.y * (1.f + s4.y) + h4.y;
        const float y2 = v.z * rstd[r] * gk.z * (1.f + s4.z) + h4.z, y3 = v.w * rstd[r] * gk.w * (1.f + s4.w) + h4.w;
        *(uint2*)(hx + (size_t)(row0 + r) * 1024 + k0) = make_uint2(pack2(y0, y1), pack2(y2, y3));
      }
    }
  }
}

DEVI void phase2(const Params& p, unsigned char* smem, const XcdMap& xm) {
  const int lane = threadIdx.x & 63, warp = threadIdx.x >> 6, wm = warp >> 1, wn = warp & 1;
  const bf16_t* hx = (const bf16_t*)(p.ws + R_HX);
  const bf16_t* wt = (const bf16_t*)(p.ws + R_WIN);
  bf16_t* prw = (bf16_t*)p.out;
  bf16_t* pqk = (bf16_t*)(p.ws + R_PQK);
  bf16_t* pv = (bf16_t*)(p.ws + R_PV);
  bf16_t* po = (bf16_t*)(p.ws + O_PO);
  bf16_t* pg = (bf16_t*)(p.ws + O_PG);
  for_tiles_xcd(xm, 130, 43, 5, 6, [&](int mt, int nt) {
    if (mt < 2 && nt >= 22 && nt < 42) return;
    f32x4 acc[4][4];
    zero_acc(acc);
    gemm_core(hx + (size_t)mt * 128 * 1024, 1024, wt + (size_t)nt * 128 * 1024, 1024, 1024, acc, smem);
    if (nt == 42) {
      float* gif = (float*)(p.ws + R_GIF);
      if (wn == 0) {
#pragma unroll
        for (int i = 0; i < 4; ++i) {
          const int row = mt * 128 + wm * 64 + i * 16 + (lane & 15);
          *(float4*)(gif + (size_t)row * 16 + (lane >> 4) * 4) = make_float4(acc[i][0][0], acc[i][0][1], acc[i][0][2], acc[i][0][3]);
        }
      }
      return;
    }
    bf16_t* dst; int ld, nb; int rofs = 0; bool sg = false;
    if (nt < 14) { dst = prw; ld = 1792; nb = nt * 128; }
    else if (nt < 18) { dst = pqk; ld = 512; nb = (nt - 14) * 128; }
    else if (nt < 22) { dst = pv; ld = 512; nb = (nt - 18) * 128; }
    else if (nt < 26) { dst = po; ld = 512; nb = (nt - 22) * 128; rofs = T_CTX; }
    else { dst = pg; ld = 2048; nb = (nt - 26) * 128; rofs = T_CTX; sg = true; }
    bf16_t(*Ct)[136] = (bf16_t(*)[136])smem;
#pragma unroll
    for (int i = 0; i < 4; ++i) {
#pragma unroll
      for (int j = 0; j < 4; ++j) {
        f32x4 v = acc[i][j];
        if (sg) { v[0] = sigm(v[0]); v[1] = sigm(v[1]); v[2] = sigm(v[2]); v[3] = sigm(v[3]); }
        *(uint2*)&Ct[wm * 64 + i * 16 + (lane & 15)][wn * 64 + j * 16 + (lane >> 4) * 4] = make_uint2(pack2(v[0], v[1]), pack2(v[2], v[3]));
      }
    }
    __syncthreads();
#pragma unroll
    for (int q = 0; q < 8; ++q) {
      const int pc = threadIdx.x + 256 * q; const int r = pc >> 4, c8 = (pc & 15) * 8;
      const int row = mt * 128 + r - rofs;
      *(u32x4*)(dst + (size_t)row * ld + nb + c8) = *(const u32x4*)&Ct[r][c8];
    }
    __syncthreads();
  });
}

DEVI void ml_qk8(const Params& p, int c, int j, int chan, float* o) {
  const bf16_t* pqk = (const bf16_t*)(p.ws + R_PQK);
  int row = ml_row(c, j);
  bool hp, hn; int rp, rn;
  if (c < 4) { hp = row > 0; hn = row < T_CTX - 1; rp = row - 1; rn = row + 1; }
  else { int gr = ((c - 4) & 3) * 64 + j; hp = gr > 0; hn = gr < 255; rp = row - 64; rn = row + 64; }
  const float* cw = p.in[I_MCONV];
  float cur[8], pr[8], nx[8];
  unpack8(*(const uint4*)(pqk + (size_t)row * 512 + chan), cur);
  if (hp) unpack8(*(const uint4*)(pqk + (size_t)rp * 512 + chan), pr);
  if (hn) unpack8(*(const uint4*)(pqk + (size_t)rn * 512 + chan), nx);
#pragma unroll
  for (int e = 0; e < 8; ++e) {
    float v = cw[512 + chan + e] * cur[e];
    if (hp) v += cw[chan + e] * pr[e];
    if (hn) v += cw[1024 + chan + e] * nx[e];
    o[e] = siluf(v);
  }
}

DEVI void phase3(const Params& p, unsigned char* smem) {
  bf16_t(*KT)[72] = (bf16_t(*)[72])smem;
  bf16_t(*VwT)[72] = (bf16_t(*)[72])(smem + 64 * 72 * 2);
  float* wgt = (float*)(smem + 64 * 72 * 2 + 256 * 72 * 2);
  const int tid = threadIdx.x, lane = tid & 63, warp = tid >> 6;
  const float* gif = (const float*)(p.ws + R_GIF);
  const bf16_t* pv = (const bf16_t*)(p.ws + R_PV);
  float* U = (float*)(p.ws + R_U);
  float* NT = (float*)(p.ws + O_NT);
  float* bend = (float*)(p.ws + O_BEND);
  float* mloc = (float*)(p.ws + O_MLOC);
  for (int it = blockIdx.x; it < 260 * 4; it += gridDim.x) {
    int c = it >> 2, h = it & 3;
    if (warp < 2) {
      int dir = warp; int j = dir ? 63 - lane : lane;
      int row = ml_row(c, j);
      float ig = gif[(size_t)row * 16 + dir * 4 + h] + p.in[I_MIB][dir * 4 + h];
      float lf = logsig(gif[(size_t)row * 16 + 8 + dir * 4 + h] + p.in[I_MFB][dir * 4 + h]);
      float b = lf;
#pragma unroll
      for (int o = 1; o < 64; o <<= 1) { float t = __shfl_up(b, o); if (lane >= o) b += t; }
      float be = __shfl(b, 63);
      float ge = be - b + ig;
      float ml = wave_max(ge);
      wgt[dir * 64 + j] = expf(ge - ml);
      if (lane == 0) { int sc = ml_sc(c, dir); bend[sc * 8 + dir * 4 + h] = be; mloc[sc * 8 + dir * 4 + h] = ml; }
    }
    __syncthreads();
    {
      int j = tid >> 2, part = tid & 3;
      float f[8];
#pragma unroll
      for (int q = 0; q < 2; ++q) {
        int d0 = part * 16 + q * 8;
        ml_qk8(p, c, j, 256 + h * 64 + d0, f);
#pragma unroll
        for (int e = 0; e < 8; ++e) KT[d0 + e][j] = f2bf(f[e] * 0.125f);
      }
      int row = ml_row(c, j);
      float w0 = wgt[j], w1 = wgt[64 + j];
#pragma unroll
      for (int q = 0; q < 4; ++q) {
        int v0 = part * 32 + q * 8;
        unpack8(*(const uint4*)(pv + (size_t)row * 512 + h * 128 + v0), f);
#pragma unroll
        for (int e = 0; e < 8; ++e) { VwT[v0 + e][j] = f2bf(f[e] * w0); VwT[128 + v0 + e][j] = f2bf(f[e] * w1); }
      }
    }
    __syncthreads();
#pragma unroll
    for (int dir = 0; dir < 2; ++dir) {
      int sc = ml_sc(c, dir);
      float* Ud = U + ((size_t)sc * 8 + dir * 4 + h) * 8192;
#pragma unroll
      for (int vi = 0; vi < 2; ++vi) {
        int vt = warp * 2 + vi;
        bf16x8 bv[2];
#pragma unroll
        for (int ks = 0; ks < 2; ++ks) bv[ks] = *(const bf16x8*)&VwT[dir * 128 + vt * 16 + (lane & 15)][ks * 32 + (lane >> 4) * 8];
#pragma unroll
        for (int dt = 0; dt < 4; ++dt) {
          f32x4 a = {0.f, 0.f, 0.f, 0.f};
#pragma unroll
          for (int ks = 0; ks < 2; ++ks) {
            bf16x8 ak = *(const bf16x8*)&KT[dt * 16 + (lane & 15)][ks * 32 + (lane >> 4) * 8];
            a = __builtin_amdgcn_mfma_f32_16x16x32_bf16(ak, bv[ks], a, 0, 0, 0);
          }
          *(float4*)(Ud + (size_t)(vt * 16 + (lane & 15)) * 64 + dt * 16 + (lane >> 4) * 4) = make_float4(a[0], a[1], a[2], a[3]);
        }
      }
    }
    if (tid < 128) {
      int dir = tid >> 6, d = tid & 63; float s = 0.f;
      for (int j = 0; j < 64; ++j) s += wgt[dir * 64 + j] * bf2f(KT[d][j]);
      NT[((size_t)ml_sc(c, dir) * 8 + dir * 4 + h) * 64 + d] = s;
    }
    __syncthreads();
  }
}

template <bool DRY> DEVI void phase4(const Params& p, unsigned char* smem) {
  const bool wr = !DRY || (p.in[I_FG][0] == 1234.5f);
  float* U = (float*)(p.ws + R_U);
  float* NT = (float*)(p.ws + O_NT);
  const float* bend = (const float*)(p.ws + O_BEND);
  const float* mloc = (const float*)(p.ws + O_MLOC);
  float* mst = (float*)(p.ws + O_MST);
  float(*kp)[264] = (float(*)[264])smem;
  float(*sp)[264] = (float(*)[264])(smem + 2 * 264 * 4);
  const int tid = threadIdx.x, lane = tid & 63, warp = tid >> 6;
  for (int gb = blockIdx.x * 256; gb < 8 * 8256; gb += gridDim.x * 256) {
    const int pA = gb / 8256;
    if (warp < 2) {
      const int pw = pA + warp;
      if (pw < 8) {
        float be[5], ml[5], B[5], m[5];
        float run = 0.f;
#pragma unroll
        for (int k = 0; k < 5; ++k) {
          const int c = lane * 5 + k;
          be[k] = c < 260 ? bend[c * 8 + pw] : 0.f;
          ml[k] = c < 260 ? mloc[c * 8 + pw] : -INFINITY;
          run += be[k]; B[k] = run;
        }
        float incl = run;
#pragma unroll
        for (int o = 1; o < 64; o <<= 1) { float t = __shfl_up(incl, o); if (lane >= o) incl += t; }
        const float off = incl - run;
        float pm = -INFINITY, pml[5];
#pragma unroll
        for (int k = 0; k < 5; ++k) { B[k] += off; pm = fmaxf(pm, ml[k] - B[k]); pml[k] = pm; }
        float inclm = pm;
#pragma unroll
        for (int o = 1; o < 64; o <<= 1) { float t = __shfl_up(inclm, o); if (lane >= o) inclm = fmaxf(inclm, t); }
        float offm = __shfl_up(inclm, 1); if (lane == 0) offm = -INFINITY;
#pragma unroll
        for (int k = 0; k < 5; ++k) m[k] = B[k] + fmaxf(0.f, fmaxf(offm, pml[k]));
        float mprev = __shfl_up(m[4], 1); if (lane == 0) mprev = 0.f;
        const bool owner = gb <= pw * 8256 && pw * 8256 < gb + 256;
#pragma unroll
        for (int k = 0; k < 5; ++k) {
          const int c = lane * 5 + k;
          if (c < 260) {
            kp[warp][c] = expf(be[k] + mprev - m[k]);
            sp[warp][c] = expf(ml[k] - m[k]);
            if (wr && owner) mst[c * 8 + pw] = mprev;
          }
          mprev = m[k];
        }
      }
    }
    __syncthreads();
    const int g = gb + tid;
    if (g < 8 * 8256) {
      const int pr = g / 8256, e = g % 8256, slot = pr - pA;
      float* base; size_t stride;
      if (e < 8192) { base = U + (size_t)pr * 8192 + e; stride = 8 * 8192; }
      else { base = NT + (size_t)pr * 64 + (e - 8192); stride = 8 * 64; }
      float C = 0.f;
      for (int sc = 0; sc < 260; sc += 20) {
        float u[20];
#pragma unroll
        for (int q = 0; q < 20; ++q) u[q] = base[(size_t)(sc + q) * stride];
#pragma unroll
        for (int q = 0; q < 20; ++q) {
          if (wr) base[(size_t)(sc + q) * stride] = C;
          C = kp[slot][sc + q] * C + sp[slot][sc + q] * u[q];
        }
      }
    }
    __syncthreads();
  }
}

template <bool DRY> DEVI void phase5(const Params& p, unsigned char* smem) {
  const bool wr = !DRY || (p.in[I_FG][0] == 1234.5f);
  bf16_t(*Qs)[72] = (bf16_t(*)[72])smem;
  bf16_t(*Ks)[72] = (bf16_t(*)[72])(smem + 9216);
  bf16_t(*Pm)[72] = (bf16_t(*)[72])(smem + 2 * 9216);
  bf16_t(*VT)[72] = (bf16_t(*)[72])(smem + 3 * 9216);
  float* evec = (float*)(smem + 3 * 9216 + 144 * 72 * 2);
  float* Mvec = evec + 128;
  float* bvec = Mvec + 128;
  const int tid = threadIdx.x, lane = tid & 63, warp = tid >> 6;
  const float* gif = (const float*)(p.ws + R_GIF);
  const bf16_t* pv = (const bf16_t*)(p.ws + R_PV);
  const bf16_t* po = (const bf16_t*)(p.ws + O_PO);
  bf16_t* yb = (bf16_t*)(p.ws + R_YA);
  const float* U = (const float*)(p.ws + R_U);
  const float* NT = (const float*)(p.ws + O_NT);
  const float* mst = (const float*)(p.ws + O_MST);
  for (int it = blockIdx.x; it < 256 * 4; it += gridDim.x) {
    int c = 4 + (it >> 2), h = it & 3;
    if (warp < 2) {
      int dir = warp; int j = dir ? 63 - lane : lane;
      int row = ml_row(c, j);
      float ig = gif[(size_t)row * 16 + dir * 4 + h] + p.in[I_MIB][dir * 4 + h];
      float lf = logsig(gif[(size_t)row * 16 + 8 + dir * 4 + h] + p.in[I_MFB][dir * 4 + h]);
      float b = lf;
#pragma unroll
      for (int o = 1; o < 64; o <<= 1) { float t = __shfl_up(b, o); if (lane >= o) b += t; }
      float e = ig - b;
      float pm = e;
#pragma unroll
      for (int o = 1; o < 64; o <<= 1) { float t = __shfl_up(pm, o); if (lane >= o) pm = fmaxf(pm, t); }
      float m0 = mst[ml_sc(c, dir) * 8 + dir * 4 + h];
      evec[dir * 64 + j] = e; Mvec[dir * 64 + j] = fmaxf(m0, pm); bvec[dir * 64 + j] = b;
    }
    {
      int j = tid >> 2, part = tid & 3;
      float f[8];
#pragma unroll
      for (int q = 0; q < 2; ++q) {
        int d0 = part * 16 + q * 8;
        ml_qk8(p, c, j, h * 64 + d0, f);
        *(uint4*)&Qs[j][d0] = pack8(f);
        ml_qk8(p, c, j, 256 + h * 64 + d0, f);
#pragma unroll
        for (int e = 0; e < 8; ++e) f[e] *= 0.125f;
        *(uint4*)&Ks[j][d0] = pack8(f);
      }
      int row = ml_row(c, j);
#pragma unroll
      for (int q = 0; q < 4; ++q) {
        int v0 = part * 32 + q * 8;
        unpack8(*(const uint4*)(pv + (size_t)row * 512 + h * 128 + v0), f);
#pragma unroll
        for (int e = 0; e < 8; ++e) VT[v0 + e][j] = f2bf(f[e]);
      }
      for (int i = tid; i < 16 * 64; i += 256) VT[128 + (i >> 6)][i & 63] = (i < 64) ? (bf16_t)0x3f80 : (bf16_t)0;
    }
    __syncthreads();
    const int jl = warp * 16 + (lane & 15);
    f32x4 s0[4];
    bf16x8 qf[2];
#pragma unroll
    for (int ks = 0; ks < 2; ++ks) qf[ks] = *(const bf16x8*)&Qs[jl][ks * 32 + (lane >> 4) * 8];
#pragma unroll
    for (int st = 0; st < 4; ++st) {
      f32x4 a = {0.f, 0.f, 0.f, 0.f};
#pragma unroll
      for (int ks = 0; ks < 2; ++ks) {
        bf16x8 kf = *(const bf16x8*)&Ks[st * 16 + (lane & 15)][ks * 32 + (lane >> 4) * 8];
        a = __builtin_amdgcn_mfma_f32_16x16x32_bf16(kf, qf[ks], a, 0, 0, 0);
      }
      s0[st] = a;
    }
    f32x4 ysum[8];
#pragma unroll
    for (int vt = 0; vt < 8; ++vt) ysum[vt] = f32x4{0.f, 0.f, 0.f, 0.f};
#pragma unroll 1
    for (int dir = 0; dir < 2; ++dir) {
      float Mj = Mvec[dir * 64 + jl], bj = bvec[dir * 64 + jl];
      float m0 = mst[ml_sc(c, dir) * 8 + dir * 4 + h];
#pragma unroll
      for (int st = 0; st < 4; ++st) {
        float pvv[4];
#pragma unroll
        for (int r = 0; r < 4; ++r) {
          int s = st * 16 + (lane >> 4) * 4 + r;
          bool ok = dir == 0 ? (s <= jl) : (s >= jl);
          pvv[r] = ok ? s0[st][r] * expf(evec[dir * 64 + s] - Mj) : 0.f;
        }
        *(uint2*)&Pm[jl][st * 16 + (lane >> 4) * 4] = make_uint2(pack2(pvv[0], pvv[1]), pack2(pvv[2], pvv[3]));
      }
      __syncthreads();
      bf16x8 pf[2];
#pragma unroll
      for (int ks = 0; ks < 2; ++ks) pf[ks] = *(const bf16x8*)&Pm[jl][ks * 32 + (lane >> 4) * 8];
      const float* Cst = U + ((size_t)ml_sc(c, dir) * 8 + dir * 4 + h) * 8192;
      const float* nst = NT + ((size_t)ml_sc(c, dir) * 8 + dir * 4 + h) * 64;
      float ai = expf(m0 - Mj);
      f32x4 hh[9];
#pragma unroll
      for (int vt = 0; vt < 9; ++vt) {
        f32x4 a1 = {0.f, 0.f, 0.f, 0.f}, a2 = {0.f, 0.f, 0.f, 0.f};
#pragma unroll
        for (int ks = 0; ks < 2; ++ks) {
          bf16x8 vf = *(const bf16x8*)&VT[vt * 16 + (lane & 15)][ks * 32 + (lane >> 4) * 8];
          a1 = __builtin_amdgcn_mfma_f32_16x16x32_bf16(vf, pf[ks], a1, 0, 0, 0);
          int v = vt * 16 + (lane & 15);
          const float* cp = v < 128 ? Cst + (size_t)v * 64 + ks * 32 + (lane >> 4) * 8 : nst + ks * 32 + (lane >> 4) * 8;
          float cf[8];
          if (v <= 128) {
            float4 x0 = *(const float4*)cp, x1 = *(const float4*)(cp + 4);
            cf[0] = x0.x; cf[1] = x0.y; cf[2] = x0.z; cf[3] = x0.w; cf[4] = x1.x; cf[5] = x1.y; cf[6] = x1.z; cf[7] = x1.w;
          } else {
#pragma unroll
            for (int e = 0; e < 8; ++e) cf[e] = 0.f;
          }
          uint4 pk = pack8(cf);
          bf16x8 cfr;
          cfr[0] = (short)(pk.x & 0xffff); cfr[1] = (short)(pk.x >> 16); cfr[2] = (short)(pk.y & 0xffff); cfr[3] = (short)(pk.y >> 16);
          cfr[4] = (short)(pk.z & 0xffff); cfr[5] = (short)(pk.z >> 16); cfr[6] = (short)(pk.w & 0xffff); cfr[7] = (short)(pk.w >> 16);
          a2 = __builtin_amdgcn_mfma_f32_16x16x32_bf16(cfr, qf[ks], a2, 0, 0, 0);
        }
#pragma unroll
        for (int r = 0; r < 4; ++r) hh[vt][r] = a1[r] + ai * a2[r];
      }
      float den = __shfl(hh[8][0], lane & 15);
      float dn = fmaxf(fabsf(den), expf(-(bj + Mj)));
      float inv = 1.f / dn;
      float ss = 0.f;
#pragma unroll
      for (int vt = 0; vt < 8; ++vt)
#pragma unroll
        for (int r = 0; r < 4; ++r) { float x = hh[vt][r] * inv; hh[vt][r] = x; ss += x * x; }
      ss += __shfl_xor(ss, 16); ss += __shfl_xor(ss, 32);
      float rs = rsqrtf(ss * (1.f / 128.f) + 1e-6f);
#pragma unroll
      for (int vt = 0; vt < 8; ++vt)
#pragma unroll
        for (int r = 0; r < 4; ++r) ysum[vt][r] += hh[vt][r] * rs * p.in[I_MNG][h * 128 + vt * 16 + (lane >> 4) * 4 + r];
      __syncthreads();
    }
    {
      int row = ml_row(c, jl) - T_CTX;
#pragma unroll
      for (int vt = 0; vt < 8; ++vt) {
        const bf16_t* op = po + (size_t)row * 512 + h * 128 + vt * 16 + (lane >> 4) * 4;
        uint2 o = *(const uint2*)op;
        float y0 = ysum[vt][0] * sigm(bflo(o.x)), y1 = ysum[vt][1] * sigm(bfhi(o.x)), y2 = ysum[vt][2] * sigm(bflo(o.y)), y3 = ysum[vt][3] * sigm(bfhi(o.y));
        if (wr) *(uint2*)(yb + (size_t)row * 512 + h * 128 + vt * 16 + (lane >> 4) * 4) = make_uint2(pack2(y0, y1), pack2(y2, y3));
      }
    }
    __syncthreads();
  }
}

DEVI void phase6(const Params& p, unsigned char* smem, int item_lo, int item_hi, int blk0, int nblk) {
  float(*rs)[65] = (float(*)[65])smem;
  float(*ks)[65] = (float(*)[65])(smem + 64 * 65 * 4);
  bf16_t(*TW)[72] = (bf16_t(*)[72])(smem + 2 * 64 * 65 * 4);
  bf16_t(*TA)[72] = (bf16_t(*)[72])(smem + 2 * 64 * 65 * 4 + 9216);
  bf16_t(*TG)[136] = (bf16_t(*)[136])(smem + 2 * 64 * 65 * 4 + 2 * 9216);
  float* rn = (float*)(smem + 2 * 64 * 65 * 4 + 2 * 9216 + 64 * 136 * 2);
  const int tid = threadIdx.x, lane = tid & 63, warp = tid >> 6;
  const bf16_t* prw = (const bf16_t*)p.out;
  bf16_t* SV = (bf16_t*)(p.ws + R_SV);
  float* bonus = (float*)(p.ws + O_BONUS);
  const float* cw = p.in[I_RCONV];
  const bf16_t* WUP = (const bf16_t*)(p.ws + O_WUP);
  const bf16_t* AUP = (const bf16_t*)(p.ws + O_AUP);
  const bf16_t* GUP = (const bf16_t*)(p.ws + O_GUP);
  if ((int)blockIdx.x < blk0) return;
  for (int it = item_lo + ((int)blockIdx.x - blk0); it < item_hi; it += nblk) {
    int tile = it >> 3, head = it & 7;
    int row0 = tile * 64;
    int seg0 = tile < 4 ? 0 : row0, seg1 = tile < 4 ? T_CTX : row0 + 64;
#pragma unroll 1
    for (int ub = 0; ub < 2; ++ub) {
      u32x4 lc[7], lp[7], ln[7];
#pragma unroll
      for (int it7 = 0; it7 < 7; ++it7) {
        const int u = warp + 4 * (ub * 7 + it7);
        const int grp = u >> 3;
        const int j = (u & 7) * 8 + (lane >> 3), q = grp * 8 + (lane & 7);
        const int row = row0 + j;
        const int col = q < 24 ? (q >> 3) * 512 + head * 64 + (q & 7) * 8 : 1536 + (q - 24) * 8;
        const bool hp = row > seg0, hn = row < seg1 - 1;
        lc[it7] = *(const u32x4*)(prw + (size_t)row * 1792 + col);
        lp[it7] = hp ? *(const u32x4*)(prw + (size_t)(row - 1) * 1792 + col) : u32x4{0u, 0u, 0u, 0u};
        ln[it7] = hn ? *(const u32x4*)(prw + (size_t)(row + 1) * 1792 + col) : u32x4{0u, 0u, 0u, 0u};
      }
#pragma unroll
      for (int it7 = 0; it7 < 7; ++it7) {
        const int u = warp + 4 * (ub * 7 + it7);
        const int grp = u >> 3;
        const int j = (u & 7) * 8 + (lane >> 3), q = grp * 8 + (lane & 7);
        const int row = row0 + j;
        const int col = q < 24 ? (q >> 3) * 512 + head * 64 + (q & 7) * 8 : 1536 + (q - 24) * 8;
        float cur[8], pr[8], nx[8], o[8];
        unpack8(make_uint4(lc[it7][0], lc[it7][1], lc[it7][2], lc[it7][3]), cur);
        unpack8(make_uint4(lp[it7][0], lp[it7][1], lp[it7][2], lp[it7][3]), pr);
        unpack8(make_uint4(ln[it7][0], ln[it7][1], ln[it7][2], ln[it7][3]), nx);
        {
          float4 c0 = *(const float4*)(cw + col), c1 = *(const float4*)(cw + col + 4);
          float4 d0 = *(const float4*)(cw + 1792 + col), d1 = *(const float4*)(cw + 1792 + col + 4);
          float4 e0 = *(const float4*)(cw + 3584 + col), e1 = *(const float4*)(cw + 3584 + col + 4);
          float wp[8] = {c0.x, c0.y, c0.z, c0.w, c1.x, c1.y, c1.z, c1.w};
          float wc[8] = {d0.x, d0.y, d0.z, d0.w, d1.x, d1.y, d1.z, d1.w};
          float wn_[8] = {e0.x, e0.y, e0.z, e0.w, e1.x, e1.y, e1.z, e1.w};
#pragma unroll
          for (int e = 0; e < 8; ++e) o[e] = wc[e] * cur[e] + wp[e] * pr[e] + wn_[e] * nx[e];
        }
        if (grp == 0) {
#pragma unroll
          for (int e = 0; e < 8; ++e) rs[j][(q & 7) * 8 + e] = o[e];
        } else if (grp == 1) {
#pragma unroll
          for (int e = 0; e < 8; ++e) ks[j][(q & 7) * 8 + e] = o[e];
        } else if (grp == 2) {
          *(uint4*)(SV + ((size_t)row * 8 + head) * SVH + 2 * 64 + (q & 7) * 8) = pack8(o);
        } else if (grp == 3) {
#pragma unroll
          for (int e = 0; e < 8; ++e) o[e] = 1.f - 2.f / (1.f + __expf(2.f * o[e]));
          *(uint4*)&TW[j][(q - 24) * 8] = pack8(o);
        } else if (grp == 4) {
          *(uint4*)&TA[j][(q - 32) * 8] = pack8(o);
        } else {
#pragma unroll
          for (int e = 0; e < 8; ++e) o[e] = sigm(o[e]);
          *(uint4*)&TG[j][(q - 40) * 8] = pack8(o);
        }
      }
    }
    __syncthreads();
    {
      int j = tid >> 2, part = tid & 3; float ss = 0.f;
#pragma unroll
      for (int e = 0; e < 16; ++e) { float v = ks[j][part * 16 + e] * p.in[I_RKK][head * 64 + part * 16 + e]; ss += v * v; }
      ss += __shfl_xor(ss, 1); ss += __shfl_xor(ss, 2);
      if (part == 0) rn[j] = 1.f / fmaxf(sqrtf(ss), 1e-12f);
    }
    __syncthreads();
    for (int pc = tid; pc < 64 * 8; pc += 256) {
      int j = pc >> 3, c8 = (pc & 7) * 8; int row = row0 + j;
      float fr[8], fk[8], fkk[8];
#pragma unroll
      for (int e = 0; e < 8; ++e) { fr[e] = rs[j][c8 + e]; fk[e] = ks[j][c8 + e]; fkk[e] = fk[e] * p.in[I_RKK][head * 64 + c8 + e] * rn[j]; }
      bf16_t* b = SV + ((size_t)row * 8 + head) * SVH;
      *(uint4*)(b + 0 * 64 + c8) = pack8(fr);
      *(uint4*)(b + 1 * 64 + c8) = pack8(fk);
      *(uint4*)(b + 3 * 64 + c8) = pack8(fkk);
    }
    {
      const int jl = warp * 16 + (lane & 15); const int row = row0 + jl;
      bf16x8 tw[2], ta[2], tg[4];
#pragma unroll
      for (int s2 = 0; s2 < 2; ++s2) { tw[s2] = *(const bf16x8*)&TW[jl][s2 * 32 + (lane >> 4) * 8]; ta[s2] = *(const bf16x8*)&TA[jl][s2 * 32 + (lane >> 4) * 8]; }
#pragma unroll
      for (int s2 = 0; s2 < 4; ++s2) tg[s2] = *(const bf16x8*)&TG[jl][s2 * 32 + (lane >> 4) * 8];
      __syncthreads();
      bf16_t(*OB)[64][72] = (bf16_t(*)[64][72])(smem + 2 * 64 * 65 * 4);
      float bon[2] = {0.f, 0.f};
#pragma unroll
      for (int dir = 0; dir < 2; ++dir) {
#pragma unroll
        for (int ct = 0; ct < 4; ++ct) {
          const int ch0 = ct * 16 + (lane >> 4) * 4;
          const int C0 = head * 64 + ch0;
          if (dir == 0) {
            f32x4 a = {0.f, 0.f, 0.f, 0.f};
#pragma unroll
            for (int s2 = 0; s2 < 4; ++s2) {
              bf16x8 wf = *(const bf16x8*)(GUP + (size_t)(head * 64 + ct * 16 + (lane & 15)) * 128 + s2 * 32 + (lane >> 4) * 8);
              a = __builtin_amdgcn_mfma_f32_16x16x32_bf16(wf, tg[s2], a, 0, 0, 0);
            }
            *(uint2*)&OB[2][jl][ch0] = make_uint2(pack2(a[0], a[1]), pack2(a[2], a[3]));
          }
          f32x4 aw = {0.f, 0.f, 0.f, 0.f}, aa = {0.f, 0.f, 0.f, 0.f};
#pragma unroll
          for (int s2 = 0; s2 < 2; ++s2) {
            size_t wo = (size_t)(dir * 512 + head * 64 + ct * 16 + (lane & 15)) * 64 + s2 * 32 + (lane >> 4) * 8;
            bf16x8 wf = *(const bf16x8*)(WUP + wo);
            bf16x8 af = *(const bf16x8*)(AUP + wo);
            aw = __builtin_amdgcn_mfma_f32_16x16x32_bf16(wf, tw[s2], aw, 0, 0, 0);
            aa = __builtin_amdgcn_mfma_f32_16x16x32_bf16(af, ta[s2], aa, 0, 0, 0);
          }
          const float4 w04 = *(const float4*)(p.in[I_RW0] + dir * 512 + C0), a04 = *(const float4*)(p.in[I_RA0] + dir * 512 + C0);
          const float4 ka4 = *(const float4*)(p.in[I_RKA] + C0), rk4 = *(const float4*)(p.in[I_RRK] + C0);
          const float w0v[4] = {w04.x, w04.y, w04.z, w04.w}, a0v[4] = {a04.x, a04.y, a04.z, a04.w};
          const float kav[4] = {ka4.x, ka4.y, ka4.z, ka4.w}, rkv[4] = {rk4.x, rk4.y, rk4.z, rk4.w};
          float we[4], av[4];
#pragma unroll
          for (int r = 0; r < 4; ++r) {
            we[r] = (0.60653066f * 1.44269504f) * sigm(w0v[r] + aw[r]);
            av[r] = sigm(a0v[r] + aa[r]);
            float kv = ks[jl][ch0 + r];
            float keff = kv * (1.f + (av[r] - 1.f) * kav[r]);
            bon[dir] += rs[jl][ch0 + r] * keff * rkv[r];
          }
          *(uint2*)&OB[0][jl][ch0] = make_uint2(pack2(we[0], we[1]), pack2(we[2], we[3]));
          *(uint2*)&OB[1][jl][ch0] = make_uint2(pack2(av[0], av[1]), pack2(av[2], av[3]));
        }
        __syncthreads();
        for (int pc = tid; pc < (dir == 0 ? 3 : 2) * 64 * 8; pc += 256) {
          const int vsel = pc >> 9, j = (pc >> 3) & 63, c8 = (pc & 7) * 8;
          const int vec = vsel == 2 ? 8 : (4 + 2 * dir + vsel);
          *(u32x4*)(SV + ((size_t)(row0 + j) * 8 + head) * SVH + vec * 64 + c8) = *(const u32x4*)&OB[vsel][j][c8];
        }
        __syncthreads();
      }
#pragma unroll
      for (int dir = 0; dir < 2; ++dir) {
        float sb = bon[dir]; sb += __shfl_xor(sb, 16); sb += __shfl_xor(sb, 32);
        if (lane < 16) bonus[(size_t)row * 16 + dir * 8 + head] = sb;
      }
    }
    __syncthreads();
  }
}

struct RwVec { uint4 k, kk, w, a, v, r; };
DEVI void unpack8p(const uint4& u, f32x2* f) {
  f[0] = f32x2{bflo(u.x), bfhi(u.x)}; f[1] = f32x2{bflo(u.y), bfhi(u.y)}; f[2] = f32x2{bflo(u.z), bfhi(u.z)}; f[3] = f32x2{bflo(u.w), bfhi(u.w)};
}
DEVI f32x2 bc2(float x) { return f32x2{x, x}; }
DEVI void rw_load(RwVec& x, const bf16_t* SV, int row, int head, int dir, int i, int jg, bool need_r) {
  const bf16_t* b = SV + ((size_t)row * 8 + head) * SVH;
  x.k = *(const uint4*)(b + 1 * 64 + jg * 8);
  x.kk = *(const uint4*)(b + 3 * 64 + jg * 8);
  x.w = *(const uint4*)(b + (4 + 2 * dir) * 64 + jg * 8);
  x.a = *(const uint4*)(b + (5 + 2 * dir) * 64 + jg * 8);
  x.v = *(const uint4*)(b + 2 * 64 + i * 8);
  if (need_r) x.r = *(const uint4*)(b + 0 * 64 + jg * 8);
}

DEVI void phase7(const Params& p) {
  const int lane = threadIdx.x & 63, warp = threadIdx.x >> 6, i = lane >> 3, jg = lane & 7;
  const bf16_t* SV = (const bf16_t*)(p.ws + R_SV);
  float* Pc = (float*)p.out;
  float* Bc = (float*)((unsigned char*)p.out + OUT_BC);
  for (int it = blockIdx.x * 4 + warp; it < (NCH - 1) * 16; it += gridDim.x * 4) {
    const int chunk = it >> 4, pair = it & 15, dir = pair >> 3, head = pair & 7;
    f32x2 S[8][4], P[8][4], ka[4];
#pragma unroll
    for (int a = 0; a < 8; ++a)
#pragma unroll
      for (int c = 0; c < 4; ++c) {
        S[a][c] = f32x2{0.f, 0.f};
        P[a][c] = f32x2{(i * 8 + a == jg * 8 + 2 * c) ? 1.f : 0.f, (i * 8 + a == jg * 8 + 2 * c + 1) ? 1.f : 0.f};
      }
#pragma unroll
    for (int c = 0; c < 4; ++c) ka[c] = f32x2{p.in[I_RKA][head * 64 + jg * 8 + 2 * c], p.in[I_RKA][head * 64 + jg * 8 + 2 * c + 1]};
    RwVec nx;
    rw_load(nx, SV, rw_row(chunk * LCH, dir), head, dir, i, jg, false);
#pragma unroll 1
    for (int t = 0; t < LCH; ++t) {
      RwVec cu = nx;
      if (t + 1 < LCH) rw_load(nx, SV, rw_row(chunk * LCH + t + 1, dir), head, dir, i, jg, false);
      f32x2 kv[4], kk[4], w[4], av[4], kka[4], keff[4]; float vv[8];
      unpack8p(cu.k, kv); unpack8p(cu.kk, kk); unpack8p(cu.w, w); unpack8p(cu.a, av); unpack8(cu.v, vv);
#pragma unroll
      for (int c = 0; c < 4; ++c) {
        w[c] = f32x2{__builtin_amdgcn_exp2f(-w[c][0]), __builtin_amdgcn_exp2f(-w[c][1])};
        kka[c] = -kk[c] * av[c];
        keff[c] = kv[c] * (bc2(1.f) + (av[c] - bc2(1.f)) * ka[c]);
      }
#pragma unroll
      for (int a = 0; a < 8; ++a) {
        f32x2 sa = S[a][0] * kk[0], qa = P[a][0] * kk[0];
#pragma unroll
        for (int c = 1; c < 4; ++c) { sa += S[a][c] * kk[c]; qa += P[a][c] * kk[c]; }
        float s1 = allred8(sa[0] + sa[1]), q1 = allred8(qa[0] + qa[1]);
        const f32x2 s2 = bc2(s1), q2 = bc2(q1), v2 = bc2(vv[a]);
#pragma unroll
        for (int c = 0; c < 4; ++c) {
          S[a][c] = S[a][c] * w[c] + s2 * kka[c] + v2 * keff[c];
          P[a][c] = P[a][c] * w[c] + q2 * kka[c];
        }
      }
    }
    float* po = Pc + ((size_t)chunk * 16 + pair) * 4096;
    float* bo = Bc + ((size_t)chunk * 16 + pair) * 4096;
#pragma unroll
    for (int a = 0; a < 8; ++a) {
      *(float4*)(po + (i * 8 + a) * 64 + jg * 8) = make_float4(P[a][0][0], P[a][0][1], P[a][1][0], P[a][1][1]);
      *(float4*)(po + (i * 8 + a) * 64 + jg * 8 + 4) = make_float4(P[a][2][0], P[a][2][1], P[a][3][0], P[a][3][1]);
      *(float4*)(bo + (i * 8 + a) * 64 + jg * 8) = make_float4(S[a][0][0], S[a][0][1], S[a][1][0], S[a][1][1]);
      *(float4*)(bo + (i * 8 + a) * 64 + jg * 8 + 4) = make_float4(S[a][2][0], S[a][2][1], S[a][3][0], S[a][3][1]);
    }
  }
}

template <bool DRY> DEVI void phase8(const Params& p, unsigned char* smem) {
  const bool wr = !DRY || (p.in[I_FG][0] == 1234.5f);
  float(*Sb)[16][68] = (float(*)[16][68])smem;
  const int tid = threadIdx.x, lane = tid & 63, warp = tid >> 6, q = lane >> 4, c16 = lane & 15;
  const float* Pc = (const float*)p.out;
  float* Bc = (float*)((unsigned char*)p.out + OUT_BC);
  constexpr int NS = NCH - 1;
  const size_t CS = (size_t)16 * 4096;
  for (int it = blockIdx.x; it < 64; it += gridDim.x) {
    const int pair = it >> 2, rg = it & 3;
    const float* Pp = Pc + (size_t)pair * 4096 + q * 64 + warp * 16 + c16;
    float* Bp = Bc + (size_t)pair * 4096 + (size_t)(rg * 16 + q * 4) * 64 + warp * 16 + c16;
    __syncthreads();
    {
      const int row = tid >> 4, c4 = (tid & 15) * 4;
      float4 v = *(const float4*)(Bc + (size_t)pair * 4096 + (size_t)(rg * 16 + row) * 64 + c4);
      Sb[0][row][c4] = v.x; Sb[0][row][c4 + 1] = v.y; Sb[0][row][c4 + 2] = v.z; Sb[0][row][c4 + 3] = v.w;
    }
    float pa[16], pb[16]; f32x4 ba, bb;
#pragma unroll
    for (int s2 = 0; s2 < 16; ++s2) { pa[s2] = Pp[CS + s2 * 256]; pb[s2] = Pp[2 * CS + s2 * 256]; }
#pragma unroll
    for (int r = 0; r < 4; ++r) { ba[r] = Bp[CS + r * 64]; bb[r] = Bp[2 * CS + r * 64]; }
    __syncthreads();
#define P8_STEP(c, pp, bv)                                                                                  \
    {                                                                                                        \
      const int rb = ((c) - 1) & 1;                                                                          \
      f32x4 acc0 = bv, acc1 = f32x4{0.f, 0.f, 0.f, 0.f};                                                     \
      _Pragma("unroll") for (int s2 = 0; s2 < 16; s2 += 2) {                                                 \
        acc0 = __builtin_amdgcn_mfma_f32_16x16x4f32(Sb[rb][c16][4 * s2 + q], pp[s2], acc0, 0, 0, 0);         \
        acc1 = __builtin_amdgcn_mfma_f32_16x16x4f32(Sb[rb][c16][4 * s2 + 4 + q], pp[s2 + 1], acc1, 0, 0, 0); \
      }                                                                                                      \
      acc0 += acc1;                                                                                          \
      if ((c) + 2 < NS) {                                                                                    \
        _Pragma("unroll") for (int s2 = 0; s2 < 16; ++s2) pp[s2] = Pp[(size_t)((c) + 2) * CS + s2 * 256];    \
        _Pragma("unroll") for (int r = 0; r < 4; ++r) bv[r] = Bp[(size_t)((c) + 2) * CS + r * 64];           \
      }                                                                                                      \
      _Pragma("unroll") for (int r = 0; r < 4; ++r) {                                                        \
        Sb[rb ^ 1][q * 4 + r][warp * 16 + c16] = acc0[r];                                                    \
        if (wr) Bp[(size_t)(c) * CS + r * 64] = acc0[r];                                                     \
      }                                                                                                      \
      __syncthreads();                                                                                       \
    }
    for (int c = 1; c < NS; c += 2) {
      P8_STEP(c, pa, ba)
      if (c + 1 < NS) P8_STEP(c + 1, pb, bb)
    }
#undef P8_STEP
  }
}

DEVI void phase9(const Params& p) {
  const int lane = threadIdx.x & 63, warp = threadIdx.x >> 6, i = lane >> 3, jg = lane & 7;
  const bf16_t* SV = (const bf16_t*)(p.ws + R_SV);
  const float* Bc = (const float*)((unsigned char*)p.out + OUT_BC);
  bf16_t* odir = (bf16_t*)p.out;
  for (int it = blockIdx.x * 4 + warp; it < NCH * 16; it += gridDim.x * 4) {
    const int chunk = it >> 4, pair = it & 15, dir = pair >> 3, head = pair & 7;
    f32x2 S[8][4], ka[4];
    if (chunk == 0) {
#pragma unroll
      for (int a = 0; a < 8; ++a)
#pragma unroll
        for (int c = 0; c < 4; ++c) S[a][c] = f32x2{0.f, 0.f};
    } else {
      const float* bs = Bc + ((size_t)(chunk - 1) * 16 + pair) * 4096;
#pragma unroll
      for (int a = 0; a < 8; ++a) {
        float4 x0 = *(const float4*)(bs + (i * 8 + a) * 64 + jg * 8), x1 = *(const float4*)(bs + (i * 8 + a) * 64 + jg * 8 + 4);
        S[a][0] = f32x2{x0.x, x0.y}; S[a][1] = f32x2{x0.z, x0.w}; S[a][2] = f32x2{x1.x, x1.y}; S[a][3] = f32x2{x1.z, x1.w};
      }
    }
#pragma unroll
    for (int c = 0; c < 4; ++c) ka[c] = f32x2{p.in[I_RKA][head * 64 + jg * 8 + 2 * c], p.in[I_RKA][head * 64 + jg * 8 + 2 * c + 1]};
    RwVec nx;
    rw_load(nx, SV, rw_row(chunk * LCH, dir), head, dir, i, jg, true);
#pragma unroll 1
    for (int t = 0; t < LCH; ++t) {
      RwVec cu = nx;
      const int row = rw_row(chunk * LCH + t, dir);
      if (t + 1 < LCH) rw_load(nx, SV, rw_row(chunk * LCH + t + 1, dir), head, dir, i, jg, true);
      f32x2 kv[4], kk[4], w[4], av[4], rr[4], kka[4], keff[4]; float vv[8];
      unpack8p(cu.k, kv); unpack8p(cu.kk, kk); unpack8p(cu.w, w); unpack8p(cu.a, av); unpack8p(cu.r, rr); unpack8(cu.v, vv);
#pragma unroll
      for (int c = 0; c < 4; ++c) {
        w[c] = f32x2{__builtin_amdgcn_exp2f(-w[c][0]), __builtin_amdgcn_exp2f(-w[c][1])};
        kka[c] = -kk[c] * av[c];
        keff[c] = kv[c] * (bc2(1.f) + (av[c] - bc2(1.f)) * ka[c]);
      }
      float ov = 0.f;
#pragma unroll
      for (int a = 0; a < 8; ++a) {
        f32x2 sa = S[a][0] * kk[0];
#pragma unroll
        for (int c = 1; c < 4; ++c) sa += S[a][c] * kk[c];
        const float s1 = allred8(sa[0] + sa[1]);
        const f32x2 s2 = bc2(s1), v2 = bc2(vv[a]);
        f32x2 oa = f32x2{0.f, 0.f};
#pragma unroll
        for (int c = 0; c < 4; ++c) {
          S[a][c] = S[a][c] * w[c] + s2 * kka[c] + v2 * keff[c];
          oa += S[a][c] * rr[c];
        }
        const float o = allred8(oa[0] + oa[1]);
        if (jg == a) ov = o;
      }
      if (row >= T_CTX) odir[((size_t)dir * T_LAT + (row - T_CTX)) * 512 + head * 64 + i * 8 + jg] = f2bf(ov);
    }
  }
}

DEVI void phase10(const Params& p) {
  const int lane = threadIdx.x & 63, warp = threadIdx.x >> 6;
  const bf16_t* odir = (const bf16_t*)p.out;
  const bf16_t* SV = (const bf16_t*)(p.ws + R_SV);
  const float* bonus = (const float*)(p.ws + O_BONUS);
  bf16_t* ya = (bf16_t*)(p.ws + O_PO);
  const int head = lane >> 3, c8 = (lane & 7) * 8, C0 = lane * 8;
#pragma unroll 2
  for (int t = blockIdx.x * 4 + warp; t < T_LAT; t += gridDim.x * 4) {
    const int row = t + T_CTX;
    const bf16_t* b = SV + ((size_t)row * 8 + head) * SVH;
    float v[8], g[8], y[8];
    unpack8(*(const uint4*)(b + 2 * 64 + c8), v);
    unpack8(*(const uint4*)(b + 8 * 64 + c8), g);
    float bs = bonus[(size_t)row * 16 + head] + bonus[(size_t)row * 16 + 8 + head];
#pragma unroll
    for (int e = 0; e < 8; ++e) y[e] = bs * v[e];
#pragma unroll
    for (int dir = 0; dir < 2; ++dir) {
      float o[8];
      unpack8(*(const uint4*)(odir + ((size_t)dir * T_LAT + t) * 512 + C0), o);
      float s = 0.f;
#pragma unroll
      for (int e = 0; e < 8; ++e) s += o[e];
      s = allred8(s);
      float mu = s * (1.f / 64.f);
      float q = 0.f;
#pragma unroll
      for (int e = 0; e < 8; ++e) { o[e] -= mu; q += o[e] * o[e]; }
      q = allred8(q);
      float rsd = rsqrtf(q * (1.f / 64.f) + 64e-5f);
#pragma unroll
      for (int e = 0; e < 8; ++e) y[e] += o[e] * rsd * p.in[I_RLNW][C0 + e] + p.in[I_RLNB][C0 + e];
    }
#pragma unroll
    for (int e = 0; e < 8; ++e) y[e] *= g[e];
    *(uint4*)(ya + (size_t)t * 512 + C0) = pack8(y);
  }
}

DEVI void phase11(const Params& p, unsigned char* smem, const XcdMap& xm) {
  const int lane = threadIdx.x & 63, warp = threadIdx.x >> 6, wm = warp >> 1, wn = warp & 1;
  const bf16_t* ya = (const bf16_t*)(p.ws + O_PO);
  const bf16_t* yb = (const bf16_t*)(p.ws + R_YA);
  const bf16_t* pg = (const bf16_t*)(p.ws + O_PG);
  bf16_t* mg = (bf16_t*)(p.ws + R_MERGED);
  for_tiles_xcd(xm, 128, 8, 8, 8, [&](int mt, int nt) {
    f32x4 acc[4][4];
    zero_acc(acc);
    gemm_core(ya + (size_t)mt * 128 * 512, 512, (const bf16_t*)(p.ws + O_WBA) + (size_t)nt * 128 * 512, 512, 512, acc, smem);
#pragma unroll
    for (int i = 0; i < 4; ++i) {
      int row = mt * 128 + wm * 64 + i * 16 + (lane & 15);
#pragma unroll
      for (int j = 0; j < 4; ++j) {
        int n = nt * 128 + wn * 64 + j * 16 + (lane >> 4) * 4;
        uint2 s = *(const uint2*)(pg + (size_t)row * 2048 + n);
        *(uint2*)(mg + (size_t)row * 1024 + n) = make_uint2(pack2(acc[i][j][0] * bflo(s.x), acc[i][j][1] * bfhi(s.x)), pack2(acc[i][j][2] * bflo(s.y), acc[i][j][3] * bfhi(s.y)));
      }
    }
    zero_acc(acc);
    gemm_core(yb + (size_t)mt * 128 * 512, 512, (const bf16_t*)(p.ws + O_WBB) + (size_t)nt * 128 * 512, 512, 512, acc, smem);
#pragma unroll
    for (int i = 0; i < 4; ++i) {
      int row = mt * 128 + wm * 64 + i * 16 + (lane & 15);
#pragma unroll
      for (int j = 0; j < 4; ++j) {
        int n = nt * 128 + wn * 64 + j * 16 + (lane >> 4) * 4;
        uint2 s = *(const uint2*)(pg + (size_t)row * 2048 + 1024 + n);
        uint2 m0 = *(const uint2*)(mg + (size_t)row * 1024 + n);
        float v0 = bflo(m0.x) + acc[i][j][0] * bflo(s.x), v1 = bfhi(m0.x) + acc[i][j][1] * bfhi(s.x);
        float v2 = bflo(m0.y) + acc[i][j][2] * bflo(s.y), v3 = bfhi(m0.y) + acc[i][j][3] * bfhi(s.y);
        *(uint2*)(mg + (size_t)row * 1024 + n) = make_uint2(pack2(v0, v1), pack2(v2, v3));
      }
    }
  });
}

DEVI void phase12(const Params& p, unsigned char* smem, const XcdMap& xm) {
  float* gt = (float*)(smem + 45056);
  const int tid = threadIdx.x, lane = tid & 63, warp = tid >> 6, wm = warp >> 1, wn = warp & 1;
  for (int i = tid; i < 1024; i += 256) gt[i] = mod_val(p, 0, 2048 + i);
  __syncthreads();
  const bf16_t* mg = (const bf16_t*)(p.ws + R_MERGED);
  const float* x = p.in[I_X];
  float* x1 = p.out;
  for_tiles_xcd(xm, 128, 8, 8, 8, [&](int mt, int nt) {
    f32x4 acc[4][4];
    zero_acc(acc);
    gemm_core(mg + (size_t)mt * 128 * 1024, 1024, (const bf16_t*)(p.ws + O_WOUT) + (size_t)nt * 128 * 1024, 1024, 1024, acc, smem);
#pragma unroll
    for (int i = 0; i < 4; ++i) {
      int row = mt * 128 + wm * 64 + i * 16 + (lane & 15);
#pragma unroll
      for (int j = 0; j < 4; ++j) {
        int n = nt * 128 + wn * 64 + j * 16 + (lane >> 4) * 4;
        float4 xv = *(const float4*)(x + (size_t)row * 1024 + n);
        xv.x += gt[n] * acc[i][j][0]; xv.y += gt[n + 1] * acc[i][j][1]; xv.z += gt[n + 2] * acc[i][j][2]; xv.w += gt[n + 3] * acc[i][j][3];
        *(float4*)(x1 + (size_t)row * 1024 + n) = xv;
      }
    }
  });
}

DEVI void phase13(const Params& p, unsigned char* smem) {
  float* smod = (float*)smem;
  const int tid = threadIdx.x, lane = tid & 63, warp = tid >> 6;
  for (int i = tid; i < 2048; i += 256) smod[i] = mod_val(p, 0, 3072 + i);
  __syncthreads();
  const float* x1 = p.out;
  bf16_t* h2 = (bf16_t*)(p.ws + R_H2);
  for (int rp = blockIdx.x * 4 + warp; rp < T_LAT / 2; rp += gridDim.x * 4) {
    float h[2][16]; float ss[2] = {0.f, 0.f};
#pragma unroll
    for (int u = 0; u < 2; ++u)
#pragma unroll
      for (int i = 0; i < 4; ++i) {
        float4 v = *(const float4*)(x1 + (size_t)(rp * 2 + u) * 1024 + i * 256 + lane * 4);
        h[u][4 * i] = v.x; h[u][4 * i + 1] = v.y; h[u][4 * i + 2] = v.z; h[u][4 * i + 3] = v.w;
        ss[u] += v.x * v.x + v.y * v.y + v.z * v.z + v.w * v.w;
      }
#pragma unroll
    for (int u = 0; u < 2; ++u) {
      const int row = rp * 2 + u;
      const float rstd = rsqrtf(wave_sum_u(ss[u]) * (1.f / 1024.f) + 1e-6f);
#pragma unroll
      for (int i = 0; i < 4; ++i) {
#pragma unroll
        for (int e = 0; e < 4; ++e) {
          int k = i * 256 + lane * 4 + e;
          float y = h[u][4 * i + e] * rstd * p.in[I_N2G][k];
          h[u][4 * i + e] = y * (1.f + smod[1024 + k]) + smod[k];
        }
        *(uint2*)(h2 + (size_t)row * 1024 + i * 256 + lane * 4) = make_uint2(pack2(h[u][4 * i], h[u][4 * i + 1]), pack2(h[u][4 * i + 2], h[u][4 * i + 3]));
      }
    }
  }
}

DEVI void phase14(const Params& p, unsigned char* smem, const XcdMap& xm) {
  bf16_t(*Qt)[136] = (bf16_t(*)[136])smem;
  float* Sc = (float*)smem;
  const int tid = threadIdx.x, lane = tid & 63, warp = tid >> 6, wm = warp >> 1, wn = warp & 1;
  const bf16_t* h2 = (const bf16_t*)(p.ws + R_H2);
  const bf16_t* keys = (const bf16_t*)(p.ws + O_KEYS);
  float* tops = (float*)(p.ws + R_TOPS);
  int* topi = (int*)(p.ws + R_TOPI);
  for_tiles_xcd(xm, 128, 16, 8, 8, [&](int mt, int hp) {
    f32x4 acc[4][4];
    zero_acc(acc);
    gemm_core(h2 + (size_t)mt * 128 * 1024, 1024, (const bf16_t*)(p.ws + O_WQ) + (size_t)hp * 128 * 1024, 1024, 1024, acc, smem);
#pragma unroll
    for (int i = 0; i < 4; ++i)
#pragma unroll
      for (int j = 0; j < 4; ++j)
        *(uint2*)&Qt[wm * 64 + i * 16 + (lane & 15)][wn * 64 + j * 16 + (lane >> 4) * 4] =
            make_uint2(pack2(acc[i][j][0], acc[i][j][1]), pack2(acc[i][j][2], acc[i][j][3]));
    __syncthreads();
    zero_acc(acc);
#pragma unroll
    for (int ks = 0; ks < 4; ++ks) {
      bf16x8 qf[4], kf[4];
#pragma unroll
      for (int i = 0; i < 4; ++i) qf[i] = *(const bf16x8*)&Qt[wm * 64 + i * 16 + (lane & 15)][ks * 32 + (lane >> 4) * 8];
#pragma unroll
      for (int j = 0; j < 4; ++j) kf[j] = *(const bf16x8*)(keys + ((size_t)hp * 128 + wn * 64 + j * 16 + (lane & 15)) * 128 + ks * 32 + (lane >> 4) * 8);
#pragma unroll
      for (int i = 0; i < 4; ++i)
#pragma unroll
        for (int j = 0; j < 4; ++j) acc[i][j] = __builtin_amdgcn_mfma_f32_16x16x32_bf16(kf[j], qf[i], acc[i][j], 0, 0, 0);
    }
    __syncthreads();
#pragma unroll
    for (int i = 0; i < 4; ++i)
#pragma unroll
      for (int j = 0; j < 4; ++j) {
        {
          const int c0 = j * 16 + (lane >> 4) * 4;
          u32x4 kq;
#pragma unroll
          for (int r = 0; r < 4; ++r) {
            unsigned u = __float_as_uint(acc[i][j][r]);
            u = (u & 0x80000000u) ? ~u : (u | 0x80000000u);
            kq[r] = (u & ~63u) | (unsigned)(63 - (c0 + r));
          }
          *(u32x4*)(Sc + (wm * 64 + i * 16 + (lane & 15)) * 132 + wn * 64 + c0) = kq;
        }
      }
    __syncthreads();
    {
      const int row = tid & 127, half = tid >> 7;
      float* hp_ = Sc + row * 132 + half * 64;
      float bv[16]; int bi[16];
      unsigned* hk = (unsigned*)hp_;
#pragma unroll
      for (int r = 0; r < 16; ++r) {
        unsigned best = 0u;
#pragma unroll 4
        for (int k = 0; k < 64; k += 4) {
          const u32x4 v4 = *(const u32x4*)(hk + k);
          const unsigned m01 = v4[0] > v4[1] ? v4[0] : v4[1], m23 = v4[2] > v4[3] ? v4[2] : v4[3];
          const unsigned m = m01 > m23 ? m01 : m23;
          best = best > m ? best : m;
        }
        const int b2 = 63 - (int)(best & 63u);
        unsigned u = best & ~63u;
        u = (u & 0x80000000u) ? (u & 0x7fffffffu) : ~u;
        bv[r] = __uint_as_float(u); bi[r] = b2 + half * 64; hk[b2] = 0u;
      }
#pragma unroll
      for (int r = 0; r < 16; ++r) { hp_[r] = bv[r]; hp_[16 + r] = __int_as_float(bi[r]); }
    }
    __syncthreads();
    if (tid < 128) {
      const float* la = Sc + tid * 132; const float* lb = la + 64;
      size_t ob = ((size_t)(mt * 128 + tid) * 16 + hp) * 16;
      int ia = 0, ib = 0;
      for (int r = 0; r < 16; ++r) {
        float va = la[ia], vb = lb[ib];
        bool ta = va >= vb;
        tops[ob + r] = ta ? va : vb;
        topi[ob + r] = __float_as_int(ta ? la[16 + ia] : lb[16 + ib]);
        ia += ta ? 1 : 0; ib += ta ? 0 : 1;
      }
    }
    __syncthreads();
  });
}

template <bool DRY> DEVI void phase15(const Params& p, unsigned char* smem) {
  const bool wr = !DRY || (p.in[I_FG][0] == 1234.5f);
  float* gt = (float*)smem;
  const int tid = threadIdx.x, lane = tid & 63, warp = tid >> 6;
  for (int i = tid; i < 1024; i += 256) gt[i] = mod_val(p, 0, 5120 + i);
  __syncthreads();
  const bf16_t* __restrict__ h2 = (const bf16_t*)(p.ws + R_H2);
  const float* __restrict__ tops = (const float*)(p.ws + R_TOPS);
  const int* __restrict__ topi = (const int*)(p.ws + R_TOPI);
  const unsigned char* __restrict__ uf8 = p.ws + R_UBF;
  const unsigned char* __restrict__ vf8 = p.ws + R_VBF;
  float* xo = p.out;
  int ca, cb;
  {
    int l = lane;
    if (l < 16) { ca = 0; cb = l; } else if (l < 24) { ca = 1; cb = l - 16; } else if (l < 29) { ca = 2; cb = l - 24; }
    else if (l < 33) { ca = 3; cb = l - 29; } else if (l < 36) { ca = 4; cb = l - 33; } else if (l < 38) { ca = 5; cb = l - 36; }
    else if (l < 40) { ca = 6; cb = l - 38; } else if (l < 42) { ca = 7; cb = l - 40; } else if (l < 50) { ca = l - 34; cb = 0; }
    else { ca = 0; cb = 0; }
  }
  const int flat = ca * 16 + cb;
  for (int t = blockIdx.x * 4 + warp; t < T_LAT; t += gridDim.x * 4) {
    float hv[16], out[16];
    {
      const u32x4 hp0 = *(const u32x4*)(h2 + (size_t)t * 1024 + lane * 16);
      const u32x4 hp1 = *(const u32x4*)(h2 + (size_t)t * 1024 + lane * 16 + 8);
#pragma unroll
      for (int e = 0; e < 4; ++e) { hv[2 * e] = bflo(hp0[e]); hv[2 * e + 1] = bfhi(hp0[e]); hv[8 + 2 * e] = bflo(hp1[e]); hv[8 + 2 * e + 1] = bfhi(hp1[e]); }
    }
#pragma unroll
    for (int e = 0; e < 16; ++e) out[e] = 0.f;
#pragma unroll 1
    for (int hd = 0; hd < 8; ++hd) {
      const size_t b1 = ((size_t)t * 16 + hd * 2) * 16, b2 = b1 + 16;
      float val = lane < 50 ? tops[b1 + ca] + tops[b2 + cb] : -INFINITY;
      int idx = topi[b1 + ca] * 128 + topi[b2 + cb];
      unsigned key = __float_as_uint(val);
      key = (key & 0x80000000u) ? ~key : (key | 0x80000000u);
      key = lane < 50 ? ((key & ~63u) | (unsigned)(63 - lane)) : 0u;
      int cnt = 0;
#pragma unroll
      for (int i = 0; i < 50; ++i) cnt += ((unsigned)__builtin_amdgcn_readlane((int)key, i) > key) ? 1 : 0;
      bool sel = lane < 50 && cnt < 16;
      float vmax = rlf(val, 0);
      float ex = sel ? __expf(val - vmax) : 0.f;
      float gsum = wave_sum_u(ex);
      float g = ex / gsum;
      unsigned long long m1 = __ballot(sel);
      int es[16];
      float gq = 0.f;
#pragma unroll
      for (int q = 0; q < 16; ++q) {
        int src = __ffsll((long long)m1) - 1; m1 &= m1 - 1;
        es[q] = __builtin_amdgcn_readlane(idx, src);
        float gg = rlf(g, src);
        if (lane == q) gq = gg;
      }
      float dm = 0.f;
      {
        u32x4 ub[16];
#pragma unroll
        for (int q = 0; q < 16; ++q) ub[q] = *(const u32x4*)(uf8 + (size_t)es[q] * 1024 + lane * 16);
#pragma unroll
        for (int q = 0; q < 16; ++q) {
          float f[16]; unpack_fp8x16(ub[q], f);
          float d0 = 0.f, d1 = 0.f;
#pragma unroll
          for (int e = 0; e < 8; ++e) { d0 += f[2 * e] * hv[2 * e]; d1 += f[2 * e + 1] * hv[2 * e + 1]; }
          float d = wave_sum_u(d0 + d1);
          if (lane == q) dm = d;
        }
      }
      dm *= (1.f / 64.f);
      float coef = gq * 0.5f * dm * (1.f + erff(dm * 0.70710678118f)) * 0.25f;
      {
        u32x4 vb[16];
#pragma unroll
        for (int q = 0; q < 16; ++q) vb[q] = *(const u32x4*)(vf8 + (size_t)es[q] * 1024 + lane * 16);
#pragma unroll
        for (int q = 0; q < 16; ++q) {
          float cf = rlf(coef, q);
          float f[16]; unpack_fp8x16(vb[q], f);
#pragma unroll
          for (int e = 0; e < 16; ++e) out[e] += cf * f[e];
        }
      }
    }
    float xs[16]; float ss = 0.f;
#pragma unroll
    for (int i = 0; i < 4; ++i) {
      int k = lane * 16 + i * 4;
      float4 v = *(const float4*)(xo + (size_t)t * 1024 + k);
      xs[4 * i] = v.x + gt[k] * out[4 * i]; xs[4 * i + 1] = v.y + gt[k + 1] * out[4 * i + 1];
      xs[4 * i + 2] = v.z + gt[k + 2] * out[4 * i + 2]; xs[4 * i + 3] = v.w + gt[k + 3] * out[4 * i + 3];
      ss += xs[4 * i] * xs[4 * i] + xs[4 * i + 1] * xs[4 * i + 1] + xs[4 * i + 2] * xs[4 * i + 2] + xs[4 * i + 3] * xs[4 * i + 3];
    }
    ss = wave_sum_u(ss);
    float rstd = rsqrtf(ss * (1.f / 1024.f) + 1e-6f);
#pragma unroll
    for (int i = 0; i < 4; ++i) {
      int k = lane * 16 + i * 4;
      float4 g4 = *(const float4*)(p.in[I_FG] + k);
      if (wr) *(float4*)(xo + (size_t)t * 1024 + k) = make_float4(xs[4 * i] * rstd * g4.x, xs[4 * i + 1] * rstd * g4.y, xs[4 * i + 2] * rstd * g4.z, xs[4 * i + 3] * rstd * g4.w);
    }
  }
}

#define XB_TMO      128
#define XB_XCNT(j)  (256  + 64 * (j))
#define XB_XSUB(j)  (1280 + 64 * (j))
#define XB_XGEN(j)  (2304 + 64 * (j))
#define XB_TOP      3328
#define XB_TOPGEN   3392
#define XCD_BAR_WORDS 3456
#define XB_SPIN_CAP (1u << 22)
#define LAS __attribute__((address_space(3)))
DEVI unsigned xb_ld(unsigned* p) { return __hip_atomic_load(p, __ATOMIC_RELAXED, __HIP_MEMORY_SCOPE_AGENT); }
DEVI unsigned xb_add(unsigned* p, unsigned v) { return __hip_atomic_fetch_add(p, v, __ATOMIC_RELAXED, __HIP_MEMORY_SCOPE_AGENT); }
DEVI unsigned xb_xcc_id() { return (unsigned)__builtin_amdgcn_s_getreg((3 << 11) | 20) & 0xFu; }
#define XB_SPIN(cond, bar) do { unsigned _sp = 0; while (cond) { __builtin_amdgcn_s_sleep(1); \
    if ((++_sp & 255u) == 0u) { if (xb_ld(&(bar)[XB_TMO])) break; if (_sp > XB_SPIN_CAP) { atomicAdd(&(bar)[XB_TMO], 1u); break; } } } } while (0)
struct XcdBarrier { unsigned* bar; unsigned x; volatile LAS unsigned* st; };
DEVI XcdBarrier xcd_barrier_post(unsigned* bar, volatile LAS unsigned* st) {
  XcdBarrier b; b.bar = bar; b.x = xb_xcc_id(); b.st = st;
  if (threadIdx.x == 0) st[2] = xb_add(&bar[XB_XCNT(b.x)], 1u);
  return b;
}
DEVI void xcd_barrier_complete(unsigned* bar, unsigned x, unsigned& nloc, unsigned& nx, unsigned& vidx) {
  const unsigned G = gridDim.x * gridDim.y * gridDim.z;
  unsigned sum, cnt, mine, below, sp = 0u;
  for (;;) {
    sum = 0u; cnt = 0u; mine = 0u; below = 0u;
#pragma unroll
    for (unsigned j = 0; j < 16; ++j) { const unsigned c = xb_ld(&bar[XB_XCNT(j)]); sum += c; cnt += (c > 0u) ? 1u : 0u; mine = (j == x) ? c : mine; below += (c > 0u && j < x) ? 1u : 0u; }
    if (sum == G) break;
    __builtin_amdgcn_s_sleep(1);
    if ((++sp & 255u) == 0u) { if (xb_ld(&bar[XB_TMO])) break; if (sp > XB_SPIN_CAP) { atomicAdd(&bar[XB_TMO], 1u); break; } }
  }
  nloc = mine > 0u ? mine : 1u; nx = cnt > 0u ? cnt : 1u; vidx = below;
}
DEVI void xcd_barrier(const XcdBarrier& b) {
  asm volatile("s_waitcnt vmcnt(0)" ::: "memory");
  __syncthreads();
  if (threadIdx.x == 0) {
    unsigned* bar = b.bar;
    __builtin_amdgcn_s_waitcnt(0);
    unsigned nloc = b.st[0], nx = b.st[1];
    if (nloc == 0u) { unsigned vidx; xcd_barrier_complete(bar, b.x, nloc, nx, vidx); b.st[0] = nloc; b.st[1] = nx; b.st[3] = vidx; }
    const unsigned old = xb_add(&bar[XB_XSUB(b.x)], 1u);
    const unsigned gen = old / nloc;
    if (old + 1u == (gen + 1u) * nloc) {
      __builtin_amdgcn_fence(__ATOMIC_RELEASE, "agent");
      asm volatile("s_waitcnt vmcnt(0)" ::: "memory");
      const unsigned og = xb_add(&bar[XB_TOP], 1u);
      const unsigned tg = og / nx;
      if (og + 1u == (tg + 1u) * nx) xb_add(&bar[XB_TOPGEN], 1u);
      else XB_SPIN(xb_ld(&bar[XB_TOPGEN]) == tg, bar);
      __builtin_amdgcn_fence(__ATOMIC_ACQUIRE, "agent");
      xb_add(&bar[XB_XGEN(b.x)], 1u);
      asm volatile("s_waitcnt vmcnt(0)" ::: "memory");
    } else {
      XB_SPIN(xb_ld(&bar[XB_XGEN(b.x)]) == gen, bar);
      __builtin_amdgcn_fence(__ATOMIC_ACQUIRE, "agent");
      asm volatile("s_waitcnt vmcnt(0)" ::: "memory");
    }
  }
  __syncthreads();
}

constexpr int NPHASE = 16;
DEVI XcdMap get_xm(int coop, const uint4& w) {
  XcdMap m;
  if (coop) { m.v = (int)w.w; m.nx = (int)w.y; m.slot = (int)w.z; m.slots = (int)w.x; }
  else { m.v = blockIdx.x & 7; m.nx = 8; m.slot = blockIdx.x >> 3; m.slots = gridDim.x >> 3; if (m.slots < 1) { m.slots = 1; } }
  return m;
}
__global__ void __launch_bounds__(256, 2) mk(Params p, int ph0, int ph1, int coop) {
  __shared__ __attribute__((aligned(16))) unsigned char smem[SMEM_BYTES];
  __shared__ uint4 xb_words;
  if (threadIdx.x == 0) xb_words = make_uint4(0u, 0u, 0u, 0u);
  __syncthreads();
  XcdBarrier xb;
  if (coop) xb = xcd_barrier_post((unsigned*)(p.ws + O_BAR), (volatile LAS unsigned*)&xb_words);
#ifdef XCC_PROBE
  if (coop && xb_xcc_id() != (blockIdx.x & 7u)) { unsigned long long t0 = wall_clock64(); while (wall_clock64() - t0 < 100000ull) __builtin_amdgcn_s_sleep(8); }
#endif
  if (ph0 < 0) cg::this_grid().sync();
#ifdef PROBE_A
#define STAMP(n) if (blockIdx.x == 0 && threadIdx.x == 0) ((unsigned long long*)(p.ws + O_STAMP))[n] = wall_clock64();
#else
#define STAMP(n)
#endif
#define RUN_PHASE(n, call)                                   \
  if (ph0 <= n && n < ph1) {                                 \
    STAMP(n)                                                 \
        if (DRY_PH == n) { if (n == 4) phase4<true>(p, smem); if (n == 5) phase5<true>(p, smem); if (n == 8) phase8<true>(p, smem); if (n == 15) phase15<true>(p, smem); } \
    if (ONLY < 0 || ONLY == n) { call; }                     \
    if (REPEAT_PH == n) { call; }                            \
    if (coop && n + 1 < ph1) xcd_barrier(xb);                \
  }
  RUN_PHASE(0, phase0(p, smem, 0, 384))
  RUN_PHASE(1, (phase1(p, smem), __syncthreads(), phase0(p, smem, 384, 1 << 30)))
  RUN_PHASE(2, phase2(p, smem, get_xm(coop, xb_words)))
  RUN_PHASE(3, phase3(p, smem))
  RUN_PHASE(4, (phase4<false>(p, smem), phase6(p, smem, 0, 32, gridDim.x > 290 ? 258 : 0, gridDim.x > 290 ? (int)gridDim.x - 258 : (int)gridDim.x)))
  RUN_PHASE(5, phase5<false>(p, smem))
  RUN_PHASE(6, phase6(p, smem, 32, 260 * 8, 0, (int)gridDim.x))
  RUN_PHASE(7, phase7(p))
  RUN_PHASE(8, phase8<false>(p, smem))
  RUN_PHASE(9, phase9(p))
  RUN_PHASE(10, phase10(p))
  RUN_PHASE(11, phase11(p, smem, get_xm(coop, xb_words)))
  RUN_PHASE(12, (phase12(p, smem, get_xm(coop, xb_words)), convert_fp8(p.in[I_PU], p.ws + R_UBF, (size_t)16384 * 64, 64.f)))
  RUN_PHASE(13, phase13(p, smem))
  RUN_PHASE(14, (phase14(p, smem, get_xm(coop, xb_words)), convert_fp8(p.in[I_PV], p.ws + R_VBF, (size_t)16384 * 64, 4.f)))
  RUN_PHASE(15, phase15<false>(p, smem))
#ifdef SYNC_EXTRA
  for (int i = 0; i < SYNC_EXTRA; ++i) xcd_barrier(xb);
#endif
#ifdef PROBE_A
  cg::this_grid().sync();
  STAMP(16)
  __syncthreads();
  if (blockIdx.x == 0) {
    const unsigned long long* st = (const unsigned long long*)(p.ws + O_STAMP);
    float ta = (float)(st[PROBE_A + 1] - st[PROBE_A]) * 0.01f, tb = (float)(st[PROBE_B + 1] - st[PROBE_B]) * 0.01f;
    for (int i = threadIdx.x; i < 1000000; i += 256) p.out[1 + i] = tb;
    if (threadIdx.x == 0) p.out[0] = 100.f * ta;
  }
#endif
}

extern "C" void kernel_launch(void* const* d_in, const int* in_sizes, int n_in, void* d_out, int out_size, void* d_ws,
                              size_t ws_size, hipStream_t stream) {
  static int grid_blocks = 0;
  if (!grid_blocks) {
    int dev = 0, cus = 0, per_cu = 0;
    hipGetDevice(&dev);
    hipDeviceGetAttribute(&cus, hipDeviceAttributeMultiprocessorCount, dev);
    hipOccupancyMaxActiveBlocksPerMultiprocessor(&per_cu, mk, 256, 0);
    if (per_cu < 1) per_cu = 1;
    if (per_cu > 2) per_cu = 2;
    grid_blocks = cus * per_cu;
  }
  if (ws_size < WS_NEED) { fprintf(stderr, "workspace too small: %zu < %zu\n", ws_size, (size_t)WS_NEED); return; }
  Params p{};
  for (int i = 0; i < 32; ++i) p.in[i] = (const float*)d_in[i];
  p.out = (float*)d_out;
  p.ws = (unsigned char*)d_ws;
#if MEGA
  (void)hipMemsetAsync((unsigned char*)d_ws + O_BAR, 0, XCD_BAR_WORDS * 4, stream);
  int ph0 = 0, ph1 = NPHASE, coop = 1;
  void* args[] = {&p, &ph0, &ph1, &coop};
  hipError_t e = hipLaunchCooperativeKernel((void*)mk, dim3(grid_blocks), dim3(256), args, 0, stream);
  if (e != hipSuccess) fprintf(stderr, "cooperative launch failed: %s (grid %d)\n", hipGetErrorString(e), grid_blocks);
#else
  for (int ph = 0; ph < NPHASE; ++ph) mk<<<grid_blocks, 256, 0, stream>>>(p, ph, ph + 1, 0);
#endif
}
```

```cpp
#include <hip/hip_runtime.h>
#include <hip/hip_cooperative_groups.h>
#include <cstdio>
#include <cstdint>
namespace cg = cooperative_groups;

#ifndef MEGA
#define MEGA 1
#endif
#ifndef ONLY
#define ONLY -1
#endif
#ifndef REPEAT_PH
#define REPEAT_PH -1
#endif
#ifndef DRY_PH
#define DRY_PH -1
#endif

typedef unsigned short bf16_t;
using bf16x8 = __attribute__((ext_vector_type(8))) short;
using f32x4 = __attribute__((ext_vector_type(4))) float;
using u32x4 = __attribute__((ext_vector_type(4))) unsigned;
#define DEVI __device__ __forceinline__

constexpr int T_CTX = 256, T_LAT = 16384, T_ALL = 16640;
constexpr int NIN = 5392, NP = 5376;
constexpr int NCH = 128, LCH = 130;
constexpr int SVH = 576;
constexpr int SMEM_BYTES = 71680;

enum { I_X = 0, I_C, I_CTX, I_CCTX, I_ADAW, I_ADAB, I_N1G, I_WIN, I_RCONV, I_RW0, I_RWUP, I_RA0, I_RAUP, I_RGUP,
       I_RKK, I_RKA, I_RRK, I_RLNW, I_RLNB, I_MCONV, I_MIB, I_MFB, I_MNG, I_WBA, I_WBB, I_WOUT, I_N2G, I_WQ,
       I_KEYS, I_PU, I_PV, I_FG };

struct Params { const float* in[32]; float* out; unsigned char* ws; };

constexpr size_t A256(size_t x) { return (x + 255) & ~(size_t)255; }
constexpr size_t O_MODP = 0;
constexpr size_t O_WBA = A256(O_MODP + (size_t)16 * 2 * 6144 * 4);
constexpr size_t O_WBB = A256(O_WBA + (size_t)1024 * 512 * 2);
constexpr size_t O_WOUT = A256(O_WBB + (size_t)1024 * 512 * 2);
constexpr size_t O_WQ = A256(O_WOUT + (size_t)1024 * 1024 * 2);
constexpr size_t O_KEYS = A256(O_WQ + (size_t)2048 * 1024 * 2);
constexpr size_t O_WUP = A256(O_KEYS + (size_t)16 * 128 * 128 * 2);
constexpr size_t O_AUP = A256(O_WUP + (size_t)1024 * 64 * 2);
constexpr size_t O_GUP = A256(O_AUP + (size_t)1024 * 64 * 2);
constexpr size_t O_BEND = A256(O_GUP + (size_t)512 * 128 * 2);
constexpr size_t O_MLOC = A256(O_BEND + (size_t)260 * 8 * 4);
constexpr size_t O_MST = A256(O_MLOC + (size_t)260 * 8 * 4);
constexpr size_t O_NT = A256(O_MST + (size_t)260 * 8 * 4);
constexpr size_t O_BONUS = A256(O_NT + (size_t)260 * 8 * 64 * 4);
constexpr size_t O_STAMP = A256(O_BONUS + (size_t)T_ALL * 16 * 4);
constexpr size_t O_BAR = A256(O_STAMP + 1024);
constexpr size_t O_PG = A256(O_BAR + 3456 * 4);
constexpr size_t O_PO = A256(O_PG + (size_t)T_LAT * 2048 * 2);
constexpr size_t O_R = A256(O_PO + (size_t)T_LAT * 512 * 2);
constexpr size_t R_HX = O_R;
constexpr size_t R_WIN = A256(R_HX + (size_t)T_ALL * 1024 * 2);
constexpr size_t R_PQK = A256(R_WIN + (size_t)(NP + 128) * 1024 * 2);
constexpr size_t R_PV = A256(R_PQK + (size_t)T_ALL * 512 * 2);
constexpr size_t R_GIF = A256(R_PV + (size_t)T_ALL * 512 * 2);
constexpr size_t R_U = A256(R_GIF + (size_t)T_ALL * 16 * 4);
constexpr size_t R_END1 = A256(R_U + (size_t)260 * 8 * 8192 * 4);
constexpr size_t R_SV = O_R;
constexpr size_t R_YA = A256(R_SV + (size_t)T_ALL * 8 * SVH * 2);
constexpr size_t R_END2 = A256(R_YA + (size_t)T_LAT * 512 * 2);
constexpr size_t R_MERGED = O_R;
constexpr size_t R_H2 = A256(R_MERGED + (size_t)T_LAT * 1024 * 2);
constexpr size_t R_TOPS = A256(R_H2 + (size_t)T_LAT * 1024 * 2);
constexpr size_t R_TOPI = A256(R_TOPS + (size_t)T_LAT * 256 * 4);
constexpr size_t R_UBF = A256(R_TOPI + (size_t)T_LAT * 256 * 4);
constexpr size_t R_VBF = A256(R_UBF + (size_t)16384 * 1024 * 2);
constexpr size_t R_END3 = A256(R_VBF + (size_t)16384 * 1024 * 2);
constexpr size_t WS_NEED = (R_END1 > R_END2 ? (R_END1 > R_END3 ? R_END1 : R_END3) : (R_END2 > R_END3 ? R_END2 : R_END3));
constexpr size_t OUT_BC = (size_t)NCH * 16 * 4096 * 4;

DEVI bf16_t f2bf(float f) { unsigned u = __float_as_uint(f); u += 0x7fffu + ((u >> 16) & 1u); return (bf16_t)(u >> 16); }
DEVI float bf2f(bf16_t h) { return __uint_as_float(((unsigned)h) << 16); }
DEVI float bflo(unsigned u) { return __uint_as_float(u << 16); }
DEVI float bfhi(unsigned u) { return __uint_as_float(u & 0xffff0000u); }
DEVI unsigned pack2(float a, float b) { return (unsigned)f2bf(a) | ((unsigned)f2bf(b) << 16); }
DEVI void unpack8(const uint4& u, float* f) {
  f[0] = bflo(u.x); f[1] = bfhi(u.x); f[2] = bflo(u.y); f[3] = bfhi(u.y);
  f[4] = bflo(u.z); f[5] = bfhi(u.z); f[6] = bflo(u.w); f[7] = bfhi(u.w);
}
DEVI uint4 pack8(const float* f) { return make_uint4(pack2(f[0], f[1]), pack2(f[2], f[3]), pack2(f[4], f[5]), pack2(f[6], f[7])); }
DEVI float wave_sum(float v) {
#pragma unroll
  for (int o = 32; o; o >>= 1) v += __shfl_xor(v, o);
  return v;
}
DEVI float wave_max(float v) {
#pragma unroll
  for (int o = 32; o; o >>= 1) v = fmaxf(v, __shfl_xor(v, o));
  return v;
}
DEVI float sigm(float x) { return 1.f / (1.f + __expf(-x)); }
DEVI float siluf(float x) { return x / (1.f + __expf(-x)); }
DEVI float logsig(float x) { return fminf(x, 0.f) - log1pf(expf(-fabsf(x))); }
template <int CTRL> DEVI float dppf(float v) { return __int_as_float(__builtin_amdgcn_update_dpp(0, __float_as_int(v), CTRL, 0xf, 0xf, true)); }
DEVI float rlf(float v, int l) { return __int_as_float(__builtin_amdgcn_readlane(__float_as_int(v), l)); }
DEVI float wave_sum_u(float v) {
  v += dppf<0xB1>(v); v += dppf<0x4E>(v); v += dppf<0x141>(v); v += dppf<0x140>(v);
  return (rlf(v, 0) + rlf(v, 16)) + (rlf(v, 32) + rlf(v, 48));
}
typedef __attribute__((ext_vector_type(2))) short s16x2;
DEVI float dot2bf(unsigned a, unsigned b, float c) { return __builtin_amdgcn_fdot2_f32_bf16(__builtin_bit_cast(s16x2, a), __builtin_bit_cast(s16x2, b), c, false); }
typedef __attribute__((ext_vector_type(2))) float f32x2;
DEVI void convert_fp8(const float* __restrict__ src, unsigned char* __restrict__ dst, size_t n16, float scale) {
  for (size_t g = (size_t)blockIdx.x * 256 + threadIdx.x; g < n16; g += (size_t)gridDim.x * 256) {
    u32x4 o;
#pragma unroll
    for (int q = 0; q < 4; ++q) {
      float4 a = *(const float4*)(src + g * 16 + q * 4);
      int pk = __builtin_amdgcn_cvt_pk_fp8_f32(a.x * scale, a.y * scale, 0, false);
      pk = __builtin_amdgcn_cvt_pk_fp8_f32(a.z * scale, a.w * scale, pk, true);
      o[q] = (unsigned)pk;
    }
    *(u32x4*)(dst + g * 16) = o;
  }
}
DEVI void unpack_fp8x16(const u32x4& u, float* f) {
#pragma unroll
  for (int q = 0; q < 4; ++q) {
    f32x2 lo = __builtin_amdgcn_cvt_pk_f32_fp8((int)u[q], false), hi = __builtin_amdgcn_cvt_pk_f32_fp8((int)u[q], true);
    f[4 * q] = lo[0]; f[4 * q + 1] = lo[1]; f[4 * q + 2] = hi[0]; f[4 * q + 3] = hi[1];
  }
}
DEVI void convert_bf16(const float* __restrict__ src, bf16_t* __restrict__ dst, size_t n8) {
  for (size_t g = (size_t)blockIdx.x * 256 + threadIdx.x; g < n8; g += (size_t)gridDim.x * 256) {
    float4 a = *(const float4*)(src + g * 8), b = *(const float4*)(src + g * 8 + 4);
    *(uint4*)(dst + g * 8) = make_uint4(pack2(a.x, a.y), pack2(a.z, a.w), pack2(b.x, b.y), pack2(b.z, b.w));
  }
}
DEVI float allred8(float v) { v += dppf<0xB1>(v); v += dppf<0x4E>(v); v += dppf<0x141>(v); return v; }

DEVI int ml_row(int c, int j) {
  if (c < 4) return c * 64 + j;
  int cc = c - 4; int col = cc >> 2; int gr = (cc & 3) * 64 + j;
  return T_CTX + gr * 64 + col;
}
DEVI int ml_sc(int c, int dir) { return dir == 0 ? c : (c < 4 ? 3 - c : 263 - c); }
DEVI int rw_row(int p, int dir) { return dir == 0 ? p : (p < T_CTX ? (T_CTX - 1 - p) : (T_ALL + T_CTX - 1 - p)); }

DEVI float mod_val(const Params& p, int which, int col) {
  const float* modp = (const float*)(p.ws + O_MODP);
  float s = p.in[I_ADAB][col];
#pragma unroll
  for (int rs = 0; rs < 16; ++rs) s += modp[(rs * 2 + which) * 6144 + col];
  return s;
}

DEVI void gemm_core(const bf16_t* __restrict__ A, int lda, const bf16_t* __restrict__ Bt, int ldb, int K,
                    f32x4 (&acc)[4][4], unsigned char* smem) {
  bf16_t(*sa)[80] = (bf16_t(*)[80])smem;
  bf16_t(*sb)[80] = (bf16_t(*)[80])(smem + 128 * 80 * 2);
  const int tid = threadIdx.x, lane = tid & 63, warp = tid >> 6, wm = warp >> 1, wn = warp & 1;
  const int lr = tid >> 3, lk = (tid & 7) * 8;
  const bf16_t* Ap = A + (size_t)lr * lda + lk;
  const bf16_t* Bp = Bt + (size_t)lr * ldb + lk;
  u32x4 ra0[4], rb0[4], ra1[4], rb1[4];
#pragma unroll
  for (int i = 0; i < 4; ++i) {
    ra0[i] = *(const u32x4*)(Ap + (size_t)(32 * i) * lda); rb0[i] = *(const u32x4*)(Bp + (size_t)(32 * i) * ldb);
    ra1[i] = *(const u32x4*)(Ap + (size_t)(32 * i) * lda + 64); rb1[i] = *(const u32x4*)(Bp + (size_t)(32 * i) * ldb + 64);
  }
#define GEMM_STEP(k0, ra, rb)                                                                                 \
  {                                                                                                           \
    __syncthreads();                                                                                          \
    _Pragma("unroll") for (int i = 0; i < 4; ++i) { *(u32x4*)&sa[lr + 32 * i][lk] = ra[i]; *(u32x4*)&sb[lr + 32 * i][lk] = rb[i]; } \
    __syncthreads();                                                                                          \
    if ((k0) + 128 < K) {                                                                                     \
      _Pragma("unroll") for (int i = 0; i < 4; ++i) {                                                         \
        ra[i] = *(const u32x4*)(Ap + (size_t)(32 * i) * lda + (k0) + 128);                                    \
        rb[i] = *(const u32x4*)(Bp + (size_t)(32 * i) * ldb + (k0) + 128);                                    \
      }                                                                                                       \
    }                                                                                                         \
    __builtin_amdgcn_s_setprio(1);                                                                            \
    _Pragma("unroll") for (int ks = 0; ks < 2; ++ks) {                                                        \
      bf16x8 af[4], bq[4];                                                                                    \
      _Pragma("unroll") for (int i = 0; i < 4; ++i) af[i] = *(const bf16x8*)&sa[wm * 64 + i * 16 + (lane & 15)][ks * 32 + (lane >> 4) * 8]; \
      _Pragma("unroll") for (int j = 0; j < 4; ++j) bq[j] = *(const bf16x8*)&sb[wn * 64 + j * 16 + (lane & 15)][ks * 32 + (lane >> 4) * 8]; \
      _Pragma("unroll") for (int i = 0; i < 4; ++i)                                                           \
        _Pragma("unroll") for (int j = 0; j < 4; ++j) acc[i][j] = __builtin_amdgcn_mfma_f32_16x16x32_bf16(bq[j], af[i], acc[i][j], 0, 0, 0); \
    }                                                                                                         \
    __builtin_amdgcn_s_setprio(0);                                                                            \
  }
  for (int k0 = 0; k0 < K; k0 += 128) {
    GEMM_STEP(k0, ra0, rb0)
    GEMM_STEP(k0 + 64, ra1, rb1)
  }
#undef GEMM_STEP
  __syncthreads();
}
DEVI void zero_acc(f32x4 (&acc)[4][4]) {
#pragma unroll
  for (int i = 0; i < 4; ++i)
#pragma unroll
    for (int j = 0; j < 4; ++j) acc[i][j] = f32x4{0.f, 0.f, 0.f, 0.f};
}

struct XcdMap { int v, nx, slot, slots; };
template <typename F> DEVI void for_tiles_xcd(const XcdMap& xm, int MT, int NT, int SM, int SN, F&& f) {
  const int nsn = (NT + SN - 1) / SN, nst = ((MT + SM - 1) / SM) * nsn, per = SM * SN;
  const int n_my = (nst - xm.v + xm.nx - 1) / xm.nx;
  for (int g = xm.slot; g < n_my * per; g += xm.slots) {
    const int s = xm.v + (g / per) * xm.nx, idx = g % per;
    const int sm = s / nsn, sn = s % nsn;
    const int mt = sm * SM + idx / SN, nt = sn * SN + idx % SN;
    if (mt < MT && nt < NT) f(mt, nt);
  }
}

DEVI void tr_tile(const float* __restrict__ src, int lds, int k0, int n0src, bf16_t* __restrict__ dst, int ldd, int n0dst,
                  unsigned char* smem) {
  float(*tile)[65] = (float(*)[65])smem;
  const int tid = threadIdx.x, j = tid & 63, i0 = tid >> 6;
#pragma unroll 4
  for (int ii = 0; ii < 16; ++ii) { int i = i0 + 4 * ii; tile[i][j] = src[(size_t)(k0 + i) * lds + n0src + j]; }
  __syncthreads();
#pragma unroll 4
  for (int jj = 0; jj < 16; ++jj) { int jn = i0 + 4 * jj; dst[(size_t)(n0dst + jn) * ldd + k0 + j] = f2bf(tile[j][jn]); }
  __syncthreads();
}

DEVI void phase0(const Params& p, unsigned char* smem, int it_lo, int it_hi) {
  const int tid = threadIdx.x;
  constexpr int N_MOD = 384, N_WIN = 16 * 85, N_WB = 128, N_WOUT = 256, N_WQ = 512, N_LORA = 16, N_GUP = 16, N_KEYS = 128;
  constexpr int E0 = N_MOD, E1 = E0 + N_WIN, E2 = E1 + N_WB, E3 = E2 + N_WB, E4 = E3 + N_WOUT, E5 = E4 + N_WQ,
                E6 = E5 + N_LORA, E7 = E6 + N_LORA, E8 = E7 + N_GUP, E9 = E8 + N_KEYS;
  if (it_hi > E9) it_hi = E9;
  for (int it = it_lo + blockIdx.x; it < it_hi; it += gridDim.x) {
    if (it < E0) {
      int cb = it % 24, rs = it / 24; int col = cb * 256 + tid;
      const float* aw = p.in[I_ADAW];
      float ax = 0.f, ac = 0.f;
#pragma unroll 8
      for (int r = rs * 64; r < rs * 64 + 64; ++r) {
        float w = aw[(size_t)r * 6144 + col];
        ax += siluf(p.in[I_C][r]) * w;
        ac += siluf(p.in[I_CCTX][r]) * w;
      }
      float* modp = (float*)(p.ws + O_MODP);
      modp[(rs * 2 + 0) * 6144 + col] = ax;
      modp[(rs * 2 + 1) * 6144 + col] = ac;
    } else if (it < E1) {
      int t = it - E0; int kt = t / 85, nt = t % 85; int n0 = nt * 64;
      tr_tile(p.in[I_WIN], NIN, kt * 64, nt == 84 ? 2816 : (n0 < 2816 ? n0 : n0 + 16), (bf16_t*)(p.ws + R_WIN), 1024, n0, smem);
    } else if (it < E2) {
      int t = it - E1; tr_tile(p.in[I_WBA], 1024, (t / 16) * 64, (t % 16) * 64, (bf16_t*)(p.ws + O_WBA), 512, (t % 16) * 64, smem);
    } else if (it < E3) {
      int t = it - E2; tr_tile(p.in[I_WBB], 1024, (t / 16) * 64, (t % 16) * 64, (bf16_t*)(p.ws + O_WBB), 512, (t % 16) * 64, smem);
    } else if (it < E4) {
      int t = it - E3; tr_tile(p.in[I_WOUT], 1024, (t / 16) * 64, (t % 16) * 64, (bf16_t*)(p.ws + O_WOUT), 1024, (t % 16) * 64, smem);
    } else if (it < E5) {
      int t = it - E4; tr_tile(p.in[I_WQ], 2048, (t / 32) * 64, (t % 32) * 64, (bf16_t*)(p.ws + O_WQ), 1024, (t % 32) * 64, smem);
    } else if (it < E6) {
      int t = it - E5; int dir = t / 8, nt = t % 8;
      tr_tile(p.in[I_RWUP] + (size_t)dir * 64 * 512, 512, 0, nt * 64, (bf16_t*)(p.ws + O_WUP) + (size_t)dir * 512 * 64, 64, nt * 64, smem);
    } else if (it < E7) {
      int t = it - E6; int dir = t / 8, nt = t % 8;
      tr_tile(p.in[I_RAUP] + (size_t)dir * 64 * 512, 512, 0, nt * 64, (bf16_t*)(p.ws + O_AUP) + (size_t)dir * 512 * 64, 64, nt * 64, smem);
    } else if (it < E8) {
      int t = it - E7; tr_tile(p.in[I_RGUP], 512, (t / 8) * 64, (t % 8) * 64, (bf16_t*)(p.ws + O_GUP), 128, (t % 8) * 64, smem);
    } else {
      int t = it - E8; size_t base = (size_t)t * 2048 + tid * 8;
      const float* s = p.in[I_KEYS] + base;
      float f[8];
      float4 a = *(const float4*)s, b = *(const float4*)(s + 4);
      f[0] = a.x; f[1] = a.y; f[2] = a.z; f[3] = a.w; f[4] = b.x; f[5] = b.y; f[6] = b.z; f[7] = b.w;
      *(uint4*)((bf16_t*)(p.ws + O_KEYS) + base) = pack8(f);
    }
  }
}

DEVI void phase1(const Params& p, unsigned char* smem) {
  float* smod = (float*)smem;
  const int tid = threadIdx.x, lane = tid & 63, warp = tid >> 6;
  for (int i = tid; i < 4096; i += 256) { int which = i >> 10; smod[i] = mod_val(p, which >> 1, (which & 1) * 1024 + (i & 1023)); }
  __syncthreads();
  bf16_t* hx = (bf16_t*)(p.ws + R_HX);
  float* gif = (float*)(p.ws + R_GIF);
  const float* win = p.in[I_WIN];
  constexpr int RPW = 4;
  for (int rg = blockIdx.x * 4 + warp; rg < T_ALL / RPW; rg += gridDim.x * 4) {
    const int row0 = rg * RPW;
    const float* sh = smod + (row0 < T_CTX ? 2048 : 0);
    const float* sc = sh + 1024;
    const float* src0 = row0 < T_CTX ? p.in[I_CTX] + (size_t)row0 * 1024 : p.in[I_X] + (size_t)(row0 - T_CTX) * 1024;
    float rstd[RPW];
#pragma unroll
    for (int r = 0; r < RPW; ++r) {
      float ss = 0.f;
#pragma unroll
      for (int i = 0; i < 4; ++i) {
        float4 v = *(const float4*)(src0 + (size_t)r * 1024 + i * 256 + lane * 4);
        ss += v.x * v.x + v.y * v.y + v.z * v.z + v.w * v.w;
      }
      ss = wave_sum_u(ss);
      rstd[r] = rsqrtf(ss * (1.f / 1024.f) + 1e-6f);
    }
#pragma unroll
    for (int i = 0; i < 4; ++i) {
      const int k0 = i * 256 + lane * 4;
      const float4 gk = *(const float4*)(p.in[I_N1G] + k0);
      const float4 s4 = *(const float4*)(sc + k0), h4 = *(const float4*)(sh + k0);
#pragma unroll
      for (int r = 0; r < RPW; ++r) {
        float4 v = *(const float4*)(src0 + (size_t)r * 1024 + k0);
        const float y0 = v.x * rstd[r] * gk.x * (1.f + s4.x) + h4.x, y1 = v.y * rstd[r] * gk.y * (1.f + s4.y) + h4.y;
        const float y2 = v.z * rstd[r] * gk.z * (1.f + s4.z) + h4.z, y3 = v.w * rstd[r] * gk.w * (1.f + s4.w) + h4.w;
        *(uint2*)(hx + (size_t)(row0 + r) * 1024 + k0) = make_uint2(pack2(y0, y1), pack2(y2, y3));
      }
    }
  }
}

DEVI void phase2(const Params& p, unsigned char* smem, const XcdMap& xm) {
  const int lane = threadIdx.x & 63, warp = threadIdx.x >> 6, wm = warp >> 1, wn = warp & 1;
  const bf16_t* hx = (const bf16_t*)(p.ws + R_HX);
  const bf16_t* wt = (const bf16_t*)(p.ws + R_WIN);
  bf16_t* prw = (bf16_t*)p.out;
  bf16_t* pqk = (bf16_t*)(p.ws + R_PQK);
  bf16_t* pv = (bf16_t*)(p.ws + R_PV);
  bf16_t* po = (bf16_t*)(p.ws + O_PO);
  bf16_t* pg = (bf16_t*)(p.ws + O_PG);
  for_tiles_xcd(xm, 130, 43, 5, 6, [&](int mt, int nt) {
    if (mt < 2 && nt >= 22 && nt < 42) return;
    f32x4 acc[4][4];
    zero_acc(acc);
    gemm_core(hx + (size_t)mt * 128 * 1024, 1024, wt + (size_t)nt * 128 * 1024, 1024, 1024, acc, smem);
    if (nt == 42) {
      float* gif = (float*)(p.ws + R_GIF);
      if (wn == 0) {
#pragma unroll
        for (int i = 0; i < 4; ++i) {
          const int row = mt * 128 + wm * 64 + i * 16 + (lane & 15);
          *(float4*)(gif + (size_t)row * 16 + (lane >> 4) * 4) = make_float4(acc[i][0][0], acc[i][0][1], acc[i][0][2], acc[i][0][3]);
        }
      }
      return;
    }
    bf16_t* dst; int ld, nb; int rofs = 0; bool sg = false;
    if (nt < 14) { dst = prw; ld = 1792; nb = nt * 128; }
    else if (nt < 18) { dst = pqk; ld = 512; nb = (nt - 14) * 128; }
    else if (nt < 22) { dst = pv; ld = 512; nb = (nt - 18) * 128; }
    else if (nt < 26) { dst = po; ld = 512; nb = (nt - 22) * 128; rofs = T_CTX; }
    else { dst = pg; ld = 2048; nb = (nt - 26) * 128; rofs = T_CTX; sg = true; }
    bf16_t(*Ct)[136] = (bf16_t(*)[136])smem;
#pragma unroll
    for (int i = 0; i < 4; ++i) {
#pragma unroll
      for (int j = 0; j < 4; ++j) {
        f32x4 v = acc[i][j];
        if (sg) { v[0] = sigm(v[0]); v[1] = sigm(v[1]); v[2] = sigm(v[2]); v[3] = sigm(v[3]); }
        *(uint2*)&Ct[wm * 64 + i * 16 + (lane & 15)][wn * 64 + j * 16 + (lane >> 4) * 4] = make_uint2(pack2(v[0], v[1]), pack2(v[2], v[3]));
      }
    }
    __syncthreads();
#pragma unroll
    for (int q = 0; q < 8; ++q) {
      const int pc = threadIdx.x + 256 * q; const int r = pc >> 4, c8 = (pc & 15) * 8;
      const int row = mt * 128 + r - rofs;
      *(u32x4*)(dst + (size_t)row * ld + nb + c8) = *(const u32x4*)&Ct[r][c8];
    }
    __syncthreads();
  });
}

DEVI void ml_qk8(const Params& p, int c, int j, int chan, float* o) {
  const bf16_t* pqk = (const bf16_t*)(p.ws + R_PQK);
  int row = ml_row(c, j);
  bool hp, hn; int rp, rn;
  if (c < 4) { hp = row > 0; hn = row < T_CTX - 1; rp = row - 1; rn = row + 1; }
  else { int gr = ((c - 4) & 3) * 64 + j; hp = gr > 0; hn = gr < 255; rp = row - 64; rn = row + 64; }
  const float* cw = p.in[I_MCONV];
  float cur[8], pr[8], nx[8];
  unpack8(*(const uint4*)(pqk + (size_t)row * 512 + chan), cur);
  if (hp) unpack8(*(const uint4*)(pqk + (size_t)rp * 512 + chan), pr);
  if (hn) unpack8(*(const uint4*)(pqk + (size_t)rn * 512 + chan), nx);
#pragma unroll
  for (int e = 0; e < 8; ++e) {
    float v = cw[512 + chan + e] * cur[e];
    if (hp) v += cw[chan + e] * pr[e];
    if (hn) v += cw[1024 + chan + e] * nx[e];
    o[e] = siluf(v);
  }
}

DEVI void phase3(const Params& p, unsigned char* smem) {
  bf16_t(*KT)[72] = (bf16_t(*)[72])smem;
  bf16_t(*VwT)[72] = (bf16_t(*)[72])(smem + 64 * 72 * 2);
  float* wgt = (float*)(smem + 64 * 72 * 2 + 256 * 72 * 2);
  const int tid = threadIdx.x, lane = tid & 63, warp = tid >> 6;
  const float* gif = (const float*)(p.ws + R_GIF);
  const bf16_t* pv = (const bf16_t*)(p.ws + R_PV);
  float* U = (float*)(p.ws + R_U);
  float* NT = (float*)(p.ws + O_NT);
  float* bend = (float*)(p.ws + O_BEND);
  float* mloc = (float*)(p.ws + O_MLOC);
  for (int it = blockIdx.x; it < 260 * 4; it += gridDim.x) {
    int c = it >> 2, h = it & 3;
    if (warp < 2) {
      int dir = warp; int j = dir ? 63 - lane : lane;
      int row = ml_row(c, j);
      float ig = gif[(size_t)row * 16 + dir * 4 + h] + p.in[I_MIB][dir * 4 + h];
      float lf = logsig(gif[(size_t)row * 16 + 8 + dir * 4 + h] + p.in[I_MFB][dir * 4 + h]);
      float b = lf;
#pragma unroll
      for (int o = 1; o < 64; o <<= 1) { float t = __shfl_up(b, o); if (lane >= o) b += t; }
      float be = __shfl(b, 63);
      float ge = be - b + ig;
      float ml = wave_max(ge);
      wgt[dir * 64 + j] = expf(ge - ml);
      if (lane == 0) { int sc = ml_sc(c, dir); bend[sc * 8 + dir * 4 + h] = be; mloc[sc * 8 + dir * 4 + h] = ml; }
    }
    __syncthreads();
    {
      int j = tid >> 2, part = tid & 3;
      float f[8];
#pragma unroll
      for (int q = 0; q < 2; ++q) {
        int d0 = part * 16 + q * 8;
        ml_qk8(p, c, j, 256 + h * 64 + d0, f);
#pragma unroll
        for (int e = 0; e < 8; ++e) KT[d0 + e][j] = f2bf(f[e] * 0.125f);
      }
      int row = ml_row(c, j);
      float w0 = wgt[j], w1 = wgt[64 + j];
#pragma unroll
      for (int q = 0; q < 4; ++q) {
        int v0 = part * 32 + q * 8;
        unpack8(*(const uint4*)(pv + (size_t)row * 512 + h * 128 + v0), f);
#pragma unroll
        for (int e = 0; e < 8; ++e) { VwT[v0 + e][j] = f2bf(f[e] * w0); VwT[128 + v0 + e][j] = f2bf(f[e] * w1); }
      }
    }
    __syncthreads();
#pragma unroll
    for (int dir = 0; dir < 2; ++dir) {
      int sc = ml_sc(c, dir);
      float* Ud = U + ((size_t)sc * 8 + dir * 4 + h) * 8192;
#pragma unroll
      for (int vi = 0; vi < 2; ++vi) {
        int vt = warp * 2 + vi;
        bf16x8 bv[2];
#pragma unroll
        for (int ks = 0; ks < 2; ++ks) bv[ks] = *(const bf16x8*)&VwT[dir * 128 + vt * 16 + (lane & 15)][ks * 32 + (lane >> 4) * 8];
#pragma unroll
        for (int dt = 0; dt < 4; ++dt) {
          f32x4 a = {0.f, 0.f, 0.f, 0.f};
#pragma unroll
          for (int ks = 0; ks < 2; ++ks) {
            bf16x8 ak = *(const bf16x8*)&KT[dt * 16 + (lane & 15)][ks * 32 + (lane >> 4) * 8];
            a = __builtin_amdgcn_mfma_f32_16x16x32_bf16(ak, bv[ks], a, 0, 0, 0);
          }
          *(float4*)(Ud + (size_t)(vt * 16 + (lane & 15)) * 64 + dt * 16 + (lane >> 4) * 4) = make_float4(a[0], a[1], a[2], a[3]);
        }
      }
    }
    if (tid < 128) {
      int dir = tid >> 6, d = tid & 63; float s = 0.f;
      for (int j = 0; j < 64; ++j) s += wgt[dir * 64 + j] * bf2f(KT[d][j]);
      NT[((size_t)ml_sc(c, dir) * 8 + dir * 4 + h) * 64 + d] = s;
    }
    __syncthreads();
  }
}

template <bool DRY> DEVI void phase4(const Params& p, unsigned char* smem) {
  const bool wr = !DRY || (p.in[I_FG][0] == 1234.5f);
  float* U = (float*)(p.ws + R_U);
  float* NT = (float*)(p.ws + O_NT);
  const float* bend = (const float*)(p.ws + O_BEND);
  const float* mloc = (const float*)(p.ws + O_MLOC);
  float* mst = (float*)(p.ws + O_MST);
  float(*kp)[264] = (float(*)[264])smem;
  float(*sp)[264] = (float(*)[264])(smem + 2 * 264 * 4);
  const int tid = threadIdx.x, lane = tid & 63, warp = tid >> 6;
  for (int gb = blockIdx.x * 256; gb < 8 * 8256; gb += gridDim.x * 256) {
    const int pA = gb / 8256;
    if (warp < 2) {
      const int pw = pA + warp;
      if (pw < 8) {
        float be[5], ml[5], B[5], m[5];
        float run = 0.f;
#pragma unroll
        for (int k = 0; k < 5; ++k) {
          const int c = lane * 5 + k;
          be[k] = c < 260 ? bend[c * 8 + pw] : 0.f;
          ml[k] = c < 260 ? mloc[c * 8 + pw] : -INFINITY;
          run += be[k]; B[k] = run;
        }
        float incl = run;
#pragma unroll
        for (int o = 1; o < 64; o <<= 1) { float t = __shfl_up(incl, o); if (lane >= o) incl += t; }
        const float off = incl - run;
        float pm = -INFINITY, pml[5];
#pragma unroll
        for (int k = 0; k < 5; ++k) { B[k] += off; pm = fmaxf(pm, ml[k] - B[k]); pml[k] = pm; }
        float inclm = pm;
#pragma unroll
        for (int o = 1; o < 64; o <<= 1) { float t = __shfl_up(inclm, o); if (lane >= o) inclm = fmaxf(inclm, t); }
        float offm = __shfl_up(inclm, 1); if (lane == 0) offm = -INFINITY;
#pragma unroll
        for (int k = 0; k < 5; ++k) m[k] = B[k] + fmaxf(0.f, fmaxf(offm, pml[k]));
        float mprev = __shfl_up(m[4], 1); if (lane == 0) mprev = 0.f;
        const bool owner = gb <= pw * 8256 && pw * 8256 < gb + 256;
#pragma unroll
        for (int k = 0; k < 5; ++k) {
          const int c = lane * 5 + k;
          if (c < 260) {
            kp[warp][c] = expf(be[k] + mprev - m[k]);
            sp[warp][c] = expf(ml[k] - m[k]);
            if (wr && owner) mst[c * 8 + pw] = mprev;
          }
          mprev = m[k];
        }
      }
    }
    __syncthreads();
    const int g = gb + tid;
    if (g < 8 * 8256) {
      const int pr = g / 8256, e = g % 8256, slot = pr - pA;
      float* base; size_t stride;
      if (e < 8192) { base = U + (size_t)pr * 8192 + e; stride = 8 * 8192; }
      else { base = NT + (size_t)pr * 64 + (e - 8192); stride = 8 * 64; }
      float C = 0.f;
      for (int sc = 0; sc < 260; sc += 20) {
        float u[20];
#pragma unroll
        for (int q = 0; q < 20; ++q) u[q] = base[(size_t)(sc + q) * stride];
#pragma unroll
        for (int q = 0; q < 20; ++q) {
          if (wr) base[(size_t)(sc + q) * stride] = C;
          C = kp[slot][sc + q] * C + sp[slot][sc + q] * u[q];
        }
      }
    }
    __syncthreads();
  }
}

template <bool DRY> DEVI void phase5(const Params& p, unsigned char* smem) {
  const bool wr = !DRY || (p.in[I_FG][0] == 1234.5f);
  bf16_t(*Qs)[72] = (bf16_t(*)[72])smem;
  bf16_t(*Ks)[72] = (bf16_t(*)[72])(smem + 9216);
  bf16_t(*Pm)[72] = (bf16_t(*)[72])(smem + 2 * 9216);
  bf16_t(*VT)[72] = (bf16_t(*)[72])(smem + 3 * 9216);
  float* evec = (float*)(smem + 3 * 9216 + 144 * 72 * 2);
  float* Mvec = evec + 128;
  float* bvec = Mvec + 128;
  const int tid = threadIdx.x, lane = tid & 63, warp = tid >> 6;
  const float* gif = (const float*)(p.ws + R_GIF);
  const bf16_t* pv = (const bf16_t*)(p.ws + R_PV);
  const bf16_t* po = (const bf16_t*)(p.ws + O_PO);
  bf16_t* yb = (bf16_t*)(p.ws + R_YA);
  const float* U = (const float*)(p.ws + R_U);
  const float* NT = (const float*)(p.ws + O_NT);
  const float* mst = (const float*)(p.ws + O_MST);
  for (int it = blockIdx.x; it < 256 * 4; it += gridDim.x) {
    int c = 4 + (it >> 2), h = it & 3;
    if (warp < 2) {
      int dir = warp; int j = dir ? 63 - lane : lane;
      int row = ml_row(c, j);
      float ig = gif[(size_t)row * 16 + dir * 4 + h] + p.in[I_MIB][dir * 4 + h];
      float lf = logsig(gif[(size_t)row * 16 + 8 + dir * 4 + h] + p.in[I_MFB][dir * 4 + h]);
      float b = lf;
#pragma unroll
      for (int o = 1; o < 64; o <<= 1) { float t = __shfl_up(b, o); if (lane >= o) b += t; }
      float e = ig - b;
      float pm = e;
#pragma unroll
      for (int o = 1; o < 64; o <<= 1) { float t = __shfl_up(pm, o); if (lane >= o) pm = fmaxf(pm, t); }
      float m0 = mst[ml_sc(c, dir) * 8 + dir * 4 + h];
      evec[dir * 64 + j] = e; Mvec[dir * 64 + j] = fmaxf(m0, pm); bvec[dir * 64 + j] = b;
    }
    {
      int j = tid >> 2, part = tid & 3;
      float f[8];
#pragma unroll
      for (int q = 0; q < 2; ++q) {
        int d0 = part * 16 + q * 8;
        ml_qk8(p, c, j, h * 64 + d0, f);
        *(uint4*)&Qs[j][d0] = pack8(f);
        ml_qk8(p, c, j, 256 + h * 64 + d0, f);
#pragma unroll
        for (int e = 0; e < 8; ++e) f[e] *= 0.125f;
        *(uint4*)&Ks[j][d0] = pack8(f);
      }
      int row = ml_row(c, j);
#pragma unroll
      for (int q = 0; q < 4; ++q) {
        int v0 = part * 32 + q * 8;
        unpack8(*(const uint4*)(pv + (size_t)row * 512 + h * 128 + v0), f);
#pragma unroll
        for (int e = 0; e < 8; ++e) VT[v0 + e][j] = f2bf(f[e]);
      }
      for (int i = tid; i < 16 * 64; i += 256) VT[128 + (i >> 6)][i & 63] = (i < 64) ? (bf16_t)0x3f80 : (bf16_t)0;
    }
    __syncthreads();
    const int jl = warp * 16 + (lane & 15);
    f32x4 s0[4];
    bf16x8 qf[2];
#pragma unroll
    for (int ks = 0; ks < 2; ++ks) qf[ks] = *(const bf16x8*)&Qs[jl][ks * 32 + (lane >> 4) * 8];
#pragma unroll
    for (int st = 0; st < 4; ++st) {
      f32x4 a = {0.f, 0.f, 0.f, 0.f};
#pragma unroll
      for (int ks = 0; ks < 2; ++ks) {
        bf16x8 kf = *(const bf16x8*)&Ks[st * 16 + (lane & 15)][ks * 32 + (lane >> 4) * 8];
        a = __builtin_amdgcn_mfma_f32_16x16x32_bf16(kf, qf[ks], a, 0, 0, 0);
      }
      s0[st] = a;
    }
    f32x4 ysum[8];
#pragma unroll
    for (int vt = 0; vt < 8; ++vt) ysum[vt] = f32x4{0.f, 0.f, 0.f, 0.f};
#pragma unroll 1
    for (int dir = 0; dir < 2; ++dir) {
      float Mj = Mvec[dir * 64 + jl], bj = bvec[dir * 64 + jl];
      float m0 = mst[ml_sc(c, dir) * 8 + dir * 4 + h];
#pragma unroll
      for (int st = 0; st < 4; ++st) {
        float pvv[4];
#pragma unroll
        for (int r = 0; r < 4; ++r) {
          int s = st * 16 + (lane >> 4) * 4 + r;
          bool ok = dir == 0 ? (s <= jl) : (s >= jl);
          pvv[r] = ok ? s0[st][r] * expf(evec[dir * 64 + s] - Mj) : 0.f;
        }
        *(uint2*)&Pm[jl][st * 16 + (lane >> 4) * 4] = make_uint2(pack2(pvv[0], pvv[1]), pack2(pvv[2], pvv[3]));
      }
      __syncthreads();
      bf16x8 pf[2];
#pragma unroll
      for (int ks = 0; ks < 2; ++ks) pf[ks] = *(const bf16x8*)&Pm[jl][ks * 32 + (lane >> 4) * 8];
      const float* Cst = U + ((size_t)ml_sc(c, dir) * 8 + dir * 4 + h) * 8192;
      const float* nst = NT + ((size_t)ml_sc(c, dir) * 8 + dir * 4 + h) * 64;
      float ai = expf(m0 - Mj);
      f32x4 hh[9];
#pragma unroll
      for (int vt = 0; vt < 9; ++vt) {
        f32x4 a1 = {0.f, 0.f, 0.f, 0.f}, a2 = {0.f, 0.f, 0.f, 0.f};
#pragma unroll
        for (int ks = 0; ks < 2; ++ks) {
          bf16x8 vf = *(const bf16x8*)&VT[vt * 16 + (lane & 15)][ks * 32 + (lane >> 4) * 8];
          a1 = __builtin_amdgcn_mfma_f32_16x16x32_bf16(vf, pf[ks], a1, 0, 0, 0);
          int v = vt * 16 + (lane & 15);
          const float* cp = v < 128 ? Cst + (size_t)v * 64 + ks * 32 + (lane >> 4) * 8 : nst + ks * 32 + (lane >> 4) * 8;
          float cf[8];
          if (v <= 128) {
            float4 x0 = *(const float4*)cp, x1 = *(const float4*)(cp + 4);
            cf[0] = x0.x; cf[1] = x0.y; cf[2] = x0.z; cf[3] = x0.w; cf[4] = x1.x; cf[5] = x1.y; cf[6] = x1.z; cf[7] = x1.w;
          } else {
#pragma unroll
            for (int e = 0; e < 8; ++e) cf[e] = 0.f;
          }
          uint4 pk = pack8(cf);
          bf16x8 cfr;
          cfr[0] = (short)(pk.x & 0xffff); cfr[1] = (short)(pk.x >> 16); cfr[2] = (short)(pk.y & 0xffff); cfr[3] = (short)(pk.y >> 16);
          cfr[4] = (short)(pk.z & 0xffff); cfr[5] = (short)(pk.z >> 16); cfr[6] = (short)(pk.w & 0xffff); cfr[7] = (short)(pk.w >> 16);
          a2 = __builtin_amdgcn_mfma_f32_16x16x32_bf16(cfr, qf[ks], a2, 0, 0, 0);
        }
#pragma unroll
        for (int r = 0; r < 4; ++r) hh[vt][r] = a1[r] + ai * a2[r];
      }
      float den = __shfl(hh[8][0], lane & 15);
      float dn = fmaxf(fabsf(den), expf(-(bj + Mj)));
      float inv = 1.f / dn;
      float ss = 0.f;
#pragma unroll
      for (int vt = 0; vt < 8; ++vt)
#pragma unroll
        for (int r = 0; r < 4; ++r) { float x = hh[vt][r] * inv; hh[vt][r] = x; ss += x * x; }
      ss += __shfl_xor(ss, 16); ss += __shfl_xor(ss, 32);
      float rs = rsqrtf(ss * (1.f / 128.f) + 1e-6f);
#pragma unroll
      for (int vt = 0; vt < 8; ++vt)
#pragma unroll
        for (int r = 0; r < 4; ++r) ysum[vt][r] += hh[vt][r] * rs * p.in[I_MNG][h * 128 + vt * 16 + (lane >> 4) * 4 + r];
      __syncthreads();
    }
    {
      int row = ml_row(c, jl) - T_CTX;
#pragma unroll
      for (int vt = 0; vt < 8; ++vt) {
        const bf16_t* op = po + (size_t)row * 512 + h * 128 + vt * 16 + (lane >> 4) * 4;
        uint2 o = *(const uint2*)op;
        float y0 = ysum[vt][0] * sigm(bflo(o.x)), y1 = ysum[vt][1] * sigm(bfhi(o.x)), y2 = ysum[vt][2] * sigm(bflo(o.y)), y3 = ysum[vt][3] * sigm(bfhi(o.y));
        if (wr) *(uint2*)(yb + (size_t)row * 512 + h * 128 + vt * 16 + (lane >> 4) * 4) = make_uint2(pack2(y0, y1), pack2(y2, y3));
      }
    }
    __syncthreads();
  }
}

DEVI void phase6(const Params& p, unsigned char* smem, int item_lo, int item_hi, int blk0, int nblk) {
  float(*rs)[65] = (float(*)[65])smem;
  float(*ks)[65] = (float(*)[65])(smem + 64 * 65 * 4);
  bf16_t(*TW)[72] = (bf16_t(*)[72])(smem + 2 * 64 * 65 * 4);
  bf16_t(*TA)[72] = (bf16_t(*)[72])(smem + 2 * 64 * 65 * 4 + 9216);
  bf16_t(*TG)[136] = (bf16_t(*)[136])(smem + 2 * 64 * 65 * 4 + 2 * 9216);
  float* rn = (float*)(smem + 2 * 64 * 65 * 4 + 2 * 9216 + 64 * 136 * 2);
  const int tid = threadIdx.x, lane = tid & 63, warp = tid >> 6;
  const bf16_t* prw = (const bf16_t*)p.out;
  bf16_t* SV = (bf16_t*)(p.ws + R_SV);
  float* bonus = (float*)(p.ws + O_BONUS);
  const float* cw = p.in[I_RCONV];
  const bf16_t* WUP = (const bf16_t*)(p.ws + O_WUP);
  const bf16_t* AUP = (const bf16_t*)(p.ws + O_AUP);
  const bf16_t* GUP = (const bf16_t*)(p.ws + O_GUP);
  if ((int)blockIdx.x < blk0) return;
  for (int it = item_lo + ((int)blockIdx.x - blk0); it < item_hi; it += nblk) {
    int tile = it >> 3, head = it & 7;
    int row0 = tile * 64;
    int seg0 = tile < 4 ? 0 : row0, seg1 = tile < 4 ? T_CTX : row0 + 64;
#pragma unroll 1
    for (int ub = 0; ub < 2; ++ub) {
      u32x4 lc[7], lp[7], ln[7];
#pragma unroll
      for (int it7 = 0; it7 < 7; ++it7) {
        const int u = warp + 4 * (ub * 7 + it7);
        const int grp = u >> 3;
        const int j = (u & 7) * 8 + (lane >> 3), q = grp * 8 + (lane & 7);
        const int row = row0 + j;
        const int col = q < 24 ? (q >> 3) * 512 + head * 64 + (q & 7) * 8 : 1536 + (q - 24) * 8;
        const bool hp = row > seg0, hn = row < seg1 - 1;
        lc[it7] = *(const u32x4*)(prw + (size_t)row * 1792 + col);
        lp[it7] = hp ? *(const u32x4*)(prw + (size_t)(row - 1) * 1792 + col) : u32x4{0u, 0u, 0u, 0u};
        ln[it7] = hn ? *(const u32x4*)(prw + (size_t)(row + 1) * 1792 + col) : u32x4{0u, 0u, 0u, 0u};
      }
#pragma unroll
      for (int it7 = 0; it7 < 7; ++it7) {
        const int u = warp + 4 * (ub * 7 + it7);
        const int grp = u >> 3;
        const int j = (u & 7) * 8 + (lane >> 3), q = grp * 8 + (lane & 7);
        const int row = row0 + j;
        const int col = q < 24 ? (q >> 3) * 512 + head * 64 + (q & 7) * 8 : 1536 + (q - 24) * 8;
        float cur[8], pr[8], nx[8], o[8];
        unpack8(make_uint4(lc[it7][0], lc[it7][1], lc[it7][2], lc[it7][3]), cur);
        unpack8(make_uint4(lp[it7][0], lp[it7][1], lp[it7][2], lp[it7][3]), pr);
        unpack8(make_uint4(ln[it7][0], ln[it7][1], ln[it7][2], ln[it7][3]), nx);
        {
          float4 c0 = *(const float4*)(cw + col), c1 = *(const float4*)(cw + col + 4);
          float4 d0 = *(const float4*)(cw + 1792 + col), d1 = *(const float4*)(cw + 1792 + col + 4);
          float4 e0 = *(const float4*)(cw + 3584 + col), e1 = *(const float4*)(cw + 3584 + col + 4);
          float wp[8] = {c0.x, c0.y, c0.z, c0.w, c1.x, c1.y, c1.z, c1.w};
          float wc[8] = {d0.x, d0.y, d0.z, d0.w, d1.x, d1.y, d1.z, d1.w};
          float wn_[8] = {e0.x, e0.y, e0.z, e0.w, e1.x, e1.y, e1.z, e1.w};
#pragma unroll
          for (int e = 0; e < 8; ++e) o[e] = wc[e] * cur[e] + wp[e] * pr[e] + wn_[e] * nx[e];
        }
        if (grp == 0) {
#pragma unroll
          for (int e = 0; e < 8; ++e) rs[j][(q & 7) * 8 + e] = o[e];
        } else if (grp == 1) {
#pragma unroll
          for (int e = 0; e < 8; ++e) ks[j][(q & 7) * 8 + e] = o[e];
        } else if (grp == 2) {
          *(uint4*)(SV + ((size_t)row * 8 + head) * SVH + 2 * 64 + (q & 7) * 8) = pack8(o);
        } else if (grp == 3) {
#pragma unroll
          for (int e = 0; e < 8; ++e) o[e] = 1.f - 2.f / (1.f + __expf(2.f * o[e]));
          *(uint4*)&TW[j][(q - 24) * 8] = pack8(o);
        } else if (grp == 4) {
          *(uint4*)&TA[j][(q - 32) * 8] = pack8(o);
        } else {
#pragma unroll
          for (int e = 0; e < 8; ++e) o[e] = sigm(o[e]);
          *(uint4*)&TG[j][(q - 40) * 8] = pack8(o);
        }
      }
    }
    __syncthreads();
    {
      int j = tid >> 2, part = tid & 3; float ss = 0.f;
#pragma unroll
      for (int e = 0; e < 16; ++e) { float v = ks[j][part * 16 + e] * p.in[I_RKK][head * 64 + part * 16 + e]; ss += v * v; }
      ss += __shfl_xor(ss, 1); ss += __shfl_xor(ss, 2);
      if (part == 0) rn[j] = 1.f / fmaxf(sqrtf(ss), 1e-12f);
    }
    __syncthreads();
    for (int pc = tid; pc < 64 * 8; pc += 256) {
      int j = pc >> 3, c8 = (pc & 7) * 8; int row = row0 + j;
      float fr[8], fk[8], fkk[8];
#pragma unroll
      for (int e = 0; e < 8; ++e) { fr[e] = rs[j][c8 + e]; fk[e] = ks[j][c8 + e]; fkk[e] = fk[e] * p.in[I_RKK][head * 64 + c8 + e] * rn[j]; }
      bf16_t* b = SV + ((size_t)row * 8 + head) * SVH;
      *(uint4*)(b + 0 * 64 + c8) = pack8(fr);
      *(uint4*)(b + 1 * 64 + c8) = pack8(fk);
      *(uint4*)(b + 3 * 64 + c8) = pack8(fkk);
    }
    {
      const int jl = warp * 16 + (lane & 15); const int row = row0 + jl;
      bf16x8 tw[2], ta[2], tg[4];
#pragma unroll
      for (int s2 = 0; s2 < 2; ++s2) { tw[s2] = *(const bf16x8*)&TW[jl][s2 * 32 + (lane >> 4) * 8]; ta[s2] = *(const bf16x8*)&TA[jl][s2 * 32 + (lane >> 4) * 8]; }
#pragma unroll
      for (int s2 = 0; s2 < 4; ++s2) tg[s2] = *(const bf16x8*)&TG[jl][s2 * 32 + (lane >> 4) * 8];
      __syncthreads();
      bf16_t(*OB)[64][72] = (bf16_t(*)[64][72])(smem + 2 * 64 * 65 * 4);
      float bon[2] = {0.f, 0.f};
#pragma unroll
      for (int dir = 0; dir < 2; ++dir) {
#pragma unroll
        for (int ct = 0; ct < 4; ++ct) {
          const int ch0 = ct * 16 + (lane >> 4) * 4;
          const int C0 = head * 64 + ch0;
          if (dir == 0) {
            f32x4 a = {0.f, 0.f, 0.f, 0.f};
#pragma unroll
            for (int s2 = 0; s2 < 4; ++s2) {
              bf16x8 wf = *(const bf16x8*)(GUP + (size_t)(head * 64 + ct * 16 + (lane & 15)) * 128 + s2 * 32 + (lane >> 4) * 8);
              a = __builtin_amdgcn_mfma_f32_16x16x32_bf16(wf, tg[s2], a, 0, 0, 0);
            }
            *(uint2*)&OB[2][jl][ch0] = make_uint2(pack2(a[0], a[1]), pack2(a[2], a[3]));
          }
          f32x4 aw = {0.f, 0.f, 0.f, 0.f}, aa = {0.f, 0.f, 0.f, 0.f};
#pragma unroll
          for (int s2 = 0; s2 < 2; ++s2) {
            size_t wo = (size_t)(dir * 512 + head * 64 + ct * 16 + (lane & 15)) * 64 + s2 * 32 + (lane >> 4) * 8;
            bf16x8 wf = *(const bf16x8*)(WUP + wo);
            bf16x8 af = *(const bf16x8*)(AUP + wo);
            aw = __builtin_amdgcn_mfma_f32_16x16x32_bf16(wf, tw[s2], aw, 0, 0, 0);
            aa = __builtin_amdgcn_mfma_f32_16x16x32_bf16(af, ta[s2], aa, 0, 0, 0);
          }
          const float4 w04 = *(const float4*)(p.in[I_RW0] + dir * 512 + C0), a04 = *(const float4*)(p.in[I_RA0] + dir * 512 + C0);
          const float4 ka4 = *(const float4*)(p.in[I_RKA] + C0), rk4 = *(const float4*)(p.in[I_RRK] + C0);
          const float w0v[4] = {w04.x, w04.y, w04.z, w04.w}, a0v[4] = {a04.x, a04.y, a04.z, a04.w};
          const float kav[4] = {ka4.x, ka4.y, ka4.z, ka4.w}, rkv[4] = {rk4.x, rk4.y, rk4.z, rk4.w};
          float we[4], av[4];
#pragma unroll
          for (int r = 0; r < 4; ++r) {
            we[r] = (0.60653066f * 1.44269504f) * sigm(w0v[r] + aw[r]);
            av[r] = sigm(a0v[r] + aa[r]);
            float kv = ks[jl][ch0 + r];
            float keff = kv * (1.f + (av[r] - 1.f) * kav[r]);
            bon[dir] += rs[jl][ch0 + r] * keff * rkv[r];
          }
          *(uint2*)&OB[0][jl][ch0] = make_uint2(pack2(we[0], we[1]), pack2(we[2], we[3]));
          *(uint2*)&OB[1][jl][ch0] = make_uint2(pack2(av[0], av[1]), pack2(av[2], av[3]));
        }
        __syncthreads();
        for (int pc = tid; pc < (dir == 0 ? 3 : 2) * 64 * 8; pc += 256) {
          const int vsel = pc >> 9, j = (pc >> 3) & 63, c8 = (pc & 7) * 8;
          const int vec = vsel == 2 ? 8 : (4 + 2 * dir + vsel);
          *(u32x4*)(SV + ((size_t)(row0 + j) * 8 + head) * SVH + vec * 64 + c8) = *(const u32x4*)&OB[vsel][j][c8];
        }
        __syncthreads();
      }
#pragma unroll
      for (int dir = 0; dir < 2; ++dir) {
        float sb = bon[dir]; sb += __shfl_xor(sb, 16); sb += __shfl_xor(sb, 32);
        if (lane < 16) bonus[(size_t)row * 16 + dir * 8 + head] = sb;
      }
    }
    __syncthreads();
  }
}

struct RwVec { uint4 k, kk, w, a, v, r; };
DEVI void unpack8p(const uint4& u, f32x2* f) {
  f[0] = f32x2{bflo(u.x), bfhi(u.x)}; f[1] = f32x2{bflo(u.y), bfhi(u.y)}; f[2] = f32x2{bflo(u.z), bfhi(u.z)}; f[3] = f32x2{bflo(u.w), bfhi(u.w)};
}
DEVI f32x2 bc2(float x) { return f32x2{x, x}; }
DEVI void rw_load(RwVec& x, const bf16_t* SV, int row, int head, int dir, int i, int jg, bool need_r) {
  const bf16_t* b = SV + ((size_t)row * 8 + head) * SVH;
  x.k = *(const uint4*)(b + 1 * 64 + jg * 8);
  x.kk = *(const uint4*)(b + 3 * 64 + jg * 8);
  x.w = *(const uint4*)(b + (4 + 2 * dir) * 64 + jg * 8);
  x.a = *(const uint4*)(b + (5 + 2 * dir) * 64 + jg * 8);
  x.v = *(const uint4*)(b + 2 * 64 + i * 8);
  if (need_r) x.r = *(const uint4*)(b + 0 * 64 + jg * 8);
}

DEVI void phase7(const Params& p) {
  const int lane = threadIdx.x & 63, warp = threadIdx.x >> 6, i = lane >> 3, jg = lane & 7;
  const bf16_t* SV = (const bf16_t*)(p.ws + R_SV);
  float* Pc = (float*)p.out;
  float* Bc = (float*)((unsigned char*)p.out + OUT_BC);
  for (int it = blockIdx.x * 4 + warp; it < (NCH - 1) * 16; it += gridDim.x * 4) {
    const int chunk = it >> 4, pair = it & 15, dir = pair >> 3, head = pair & 7;
    f32x2 S[8][4], P[8][4], ka[4];
#pragma unroll
    for (int a = 0; a < 8; ++a)
#pragma unroll
      for (int c = 0; c < 4; ++c) {
        S[a][c] = f32x2{0.f, 0.f};
        P[a][c] = f32x2{(i * 8 + a == jg * 8 + 2 * c) ? 1.f : 0.f, (i * 8 + a == jg * 8 + 2 * c + 1) ? 1.f : 0.f};
      }
#pragma unroll
    for (int c = 0; c < 4; ++c) ka[c] = f32x2{p.in[I_RKA][head * 64 + jg * 8 + 2 * c], p.in[I_RKA][head * 64 + jg * 8 + 2 * c + 1]};
    RwVec nx;
    rw_load(nx, SV, rw_row(chunk * LCH, dir), head, dir, i, jg, false);
#pragma unroll 1
    for (int t = 0; t < LCH; ++t) {
      RwVec cu = nx;
      if (t + 1 < LCH) rw_load(nx, SV, rw_row(chunk * LCH + t + 1, dir), head, dir, i, jg, false);
      f32x2 kv[4], kk[4], w[4], av[4], kka[4], keff[4]; float vv[8];
      unpack8p(cu.k, kv); unpack8p(cu.kk, kk); unpack8p(cu.w, w); unpack8p(cu.a, av); unpack8(cu.v, vv);
#pragma unroll
      for (int c = 0; c < 4; ++c) {
        w[c] = f32x2{__builtin_amdgcn_exp2f(-w[c][0]), __builtin_amdgcn_exp2f(-w[c][1])};
        kka[c] = -kk[c] * av[c];
        keff[c] = kv[c] * (bc2(1.f) + (av[c] - bc2(1.f)) * ka[c]);
      }
#pragma unroll
      for (int a = 0; a < 8; ++a) {
        f32x2 sa = S[a][0] * kk[0], qa = P[a][0] * kk[0];
#pragma unroll
        for (int c = 1; c < 4; ++c) { sa += S[a][c] * kk[c]; qa += P[a][c] * kk[c]; }
        float s1 = allred8(sa[0] + sa[1]), q1 = allred8(qa[0] + qa[1]);
        const f32x2 s2 = bc2(s1), q2 = bc2(q1), v2 = bc2(vv[a]);
#pragma unroll
        for (int c = 0; c < 4; ++c) {
          S[a][c] = S[a][c] * w[c] + s2 * kka[c] + v2 * keff[c];
          P[a][c] = P[a][c] * w[c] + q2 * kka[c];
        }
      }
    }
    float* po = Pc + ((size_t)chunk * 16 + pair) * 4096;
    float* bo = Bc + ((size_t)chunk * 16 + pair) * 4096;
#pragma unroll
    for (int a = 0; a < 8; ++a) {
      *(float4*)(po + (i * 8 + a) * 64 + jg * 8) = make_float4(P[a][0][0], P[a][0][1], P[a][1][0], P[a][1][1]);
      *(float4*)(po + (i * 8 + a) * 64 + jg * 8 + 4) = make_float4(P[a][2][0], P[a][2][1], P[a][3][0], P[a][3][1]);
      *(float4*)(bo + (i * 8 + a) * 64 + jg * 8) = make_float4(S[a][0][0], S[a][0][1], S[a][1][0], S[a][1][1]);
      *(float4*)(bo + (i * 8 + a) * 64 + jg * 8 + 4) = make_float4(S[a][2][0], S[a][2][1], S[a][3][0], S[a][3][1]);
    }
  }
}

template <bool DRY> DEVI void phase8(const Params& p, unsigned char* smem) {
  const bool wr = !DRY || (p.in[I_FG][0] == 1234.5f);
  float(*Sb)[16][68] = (float(*)[16][68])smem;
  const int tid = threadIdx.x, lane = tid & 63, warp = tid >> 6, q = lane >> 4, c16 = lane & 15;
  const float* Pc = (const float*)p.out;
  float* Bc = (float*)((unsigned char*)p.out + OUT_BC);
  constexpr int NS = NCH - 1;
  const size_t CS = (size_t)16 * 4096;
  for (int it = blockIdx.x; it < 64; it += gridDim.x) {
    const int pair = it >> 2, rg = it & 3;
    const float* Pp = Pc + (size_t)pair * 4096 + q * 64 + warp * 16 + c16;
    float* Bp = Bc + (size_t)pair * 4096 + (size_t)(rg * 16 + q * 4) * 64 + warp * 16 + c16;
    __syncthreads();
    {
      const int row = tid >> 4, c4 = (tid & 15) * 4;
      float4 v = *(const float4*)(Bc + (size_t)pair * 4096 + (size_t)(rg * 16 + row) * 64 + c4);
      Sb[0][row][c4] = v.x; Sb[0][row][c4 + 1] = v.y; Sb[0][row][c4 + 2] = v.z; Sb[0][row][c4 + 3] = v.w;
    }
    float pa[16], pb[16]; f32x4 ba, bb;
#pragma unroll
    for (int s2 = 0; s2 < 16; ++s2) { pa[s2] = Pp[CS + s2 * 256]; pb[s2] = Pp[2 * CS + s2 * 256]; }
#pragma unroll
    for (int r = 0; r < 4; ++r) { ba[r] = Bp[CS + r * 64]; bb[r] = Bp[2 * CS + r * 64]; }
    __syncthreads();
#define P8_STEP(c, pp, bv)                                                                                  \
    {                                                                                                        \
      const int rb = ((c) - 1) & 1;                                                                          \
      f32x4 acc0 = bv, acc1 = f32x4{0.f, 0.f, 0.f, 0.f};                                                     \
      _Pragma("unroll") for (int s2 = 0; s2 < 16; s2 += 2) {                                                 \
        acc0 = __builtin_amdgcn_mfma_f32_16x16x4f32(Sb[rb][c16][4 * s2 + q], pp[s2], acc0, 0, 0, 0);         \
        acc1 = __builtin_amdgcn_mfma_f32_16x16x4f32(Sb[rb][c16][4 * s2 + 4 + q], pp[s2 + 1], acc1, 0, 0, 0); \
      }                                                                                                      \
      acc0 += acc1;                                                                                          \
      if ((c) + 2 < NS) {                                                                                    \
        _Pragma("unroll") for (int s2 = 0; s2 < 16; ++s2) pp[s2] = Pp[(size_t)((c) + 2) * CS + s2 * 256];    \
        _Pragma("unroll") for (int r = 0; r < 4; ++r) bv[r] = Bp[(size_t)((c) + 2) * CS + r * 64];           \
      }                                                                                                      \
      _Pragma("unroll") for (int r = 0; r < 4; ++r) {                                                        \
        Sb[rb ^ 1][q * 4 + r][warp * 16 + c16] = acc0[r];                                                    \
        if (wr) Bp[(size_t)(c) * CS + r * 64] = acc0[r];                                                     \
      }                                                                                                      \
      __syncthreads();                                                                                       \
    }
    for (int c = 1; c < NS; c += 2) {
      P8_STEP(c, pa, ba)
      if (c + 1 < NS) P8_STEP(c + 1, pb, bb)
    }
#undef P8_STEP
  }
}

DEVI void phase9(const Params& p) {
  const int lane = threadIdx.x & 63, warp = threadIdx.x >> 6, i = lane >> 3, jg = lane & 7;
  const bf16_t* SV = (const bf16_t*)(p.ws + R_SV);
  const float* Bc = (const float*)((unsigned char*)p.out + OUT_BC);
  bf16_t* odir = (bf16_t*)p.out;
  for (int it = blockIdx.x * 4 + warp; it < NCH * 16; it += gridDim.x * 4) {
    const int chunk = it >> 4, pair = it & 15, dir = pair >> 3, head = pair & 7;
    f32x2 S[8][4], ka[4];
    if (chunk == 0) {
#pragma unroll
      for (int a = 0; a < 8; ++a)
#pragma unroll
        for (int c = 0; c < 4; ++c) S[a][c] = f32x2{0.f, 0.f};
    } else {
      const float* bs = Bc + ((size_t)(chunk - 1) * 16 + pair) * 4096;
#pragma unroll
      for (int a = 0; a < 8; ++a) {
        float4 x0 = *(const float4*)(bs + (i * 8 + a) * 64 + jg * 8), x1 = *(const float4*)(bs + (i * 8 + a) * 64 + jg * 8 + 4);
        S[a][0] = f32x2{x0.x, x0.y}; S[a][1] = f32x2{x0.z, x0.w}; S[a][2] = f32x2{x1.x, x1.y}; S[a][3] = f32x2{x1.z, x1.w};
      }
    }
#pragma unroll
    for (int c = 0; c < 4; ++c) ka[c] = f32x2{p.in[I_RKA][head * 64 + jg * 8 + 2 * c], p.in[I_RKA][head * 64 + jg * 8 + 2 * c + 1]};
    RwVec nx;
    rw_load(nx, SV, rw_row(chunk * LCH, dir), head, dir, i, jg, true);
#pragma unroll 1
    for (int t = 0; t < LCH; ++t) {
      RwVec cu = nx;
      const int row = rw_row(chunk * LCH + t, dir);
      if (t + 1 < LCH) rw_load(nx, SV, rw_row(chunk * LCH + t + 1, dir), head, dir, i, jg, true);
      f32x2 kv[4], kk[4], w[4], av[4], rr[4], kka[4], keff[4]; float vv[8];
      unpack8p(cu.k, kv); unpack8p(cu.kk, kk); unpack8p(cu.w, w); unpack8p(cu.a, av); unpack8p(cu.r, rr); unpack8(cu.v, vv);
#pragma unroll
      for (int c = 0; c < 4; ++c) {
        w[c] = f32x2{__builtin_amdgcn_exp2f(-w[c][0]), __builtin_amdgcn_exp2f(-w[c][1])};
        kka[c] = -kk[c] * av[c];
        keff[c] = kv[c] * (bc2(1.f) + (av[c] - bc2(1.f)) * ka[c]);
      }
      float ov = 0.f;
#pragma unroll
      for (int a = 0; a < 8; ++a) {
        f32x2 sa = S[a][0] * kk[0];
#pragma unroll
        for (int c = 1; c < 4; ++c) sa += S[a][c] * kk[c];
        const float s1 = allred8(sa[0] + sa[1]);
        const f32x2 s2 = bc2(s1), v2 = bc2(vv[a]);
        f32x2 oa = f32x2{0.f, 0.f};
#pragma unroll
        for (int c = 0; c < 4; ++c) {
          S[a][c] = S[a][c] * w[c] + s2 * kka[c] + v2 * keff[c];
          oa += S[a][c] * rr[c];
        }
        const float o = allred8(oa[0] + oa[1]);
        if (jg == a) ov = o;
      }
      if (row >= T_CTX) odir[((size_t)dir * T_LAT + (row - T_CTX)) * 512 + head * 64 + i * 8 + jg] = f2bf(ov);
    }
  }
}

DEVI void phase10(const Params& p) {
  const int lane = threadIdx.x & 63, warp = threadIdx.x >> 6;
  const bf16_t* odir = (const bf16_t*)p.out;
  const bf16_t* SV = (const bf16_t*)(p.ws + R_SV);
  const float* bonus = (const float*)(p.ws + O_BONUS);
  bf16_t* ya = (bf16_t*)(p.ws + O_PO);
  const int head = lane >> 3, c8 = (lane & 7) * 8, C0 = lane * 8;
#pragma unroll 2
  for (int t = blockIdx.x * 4 + warp; t < T_LAT; t += gridDim.x * 4) {
    const int row = t + T_CTX;
    const bf16_t* b = SV + ((size_t)row * 8 + head) * SVH;
    float v[8], g[8], y[8];
    unpack8(*(const uint4*)(b + 2 * 64 + c8), v);
    unpack8(*(const uint4*)(b + 8 * 64 + c8), g);
    float bs = bonus[(size_t)row * 16 + head] + bonus[(size_t)row * 16 + 8 + head];
#pragma unroll
    for (int e = 0; e < 8; ++e) y[e] = bs * v[e];
#pragma unroll
    for (int dir = 0; dir < 2; ++dir) {
      float o[8];
      unpack8(*(const uint4*)(odir + ((size_t)dir * T_LAT + t) * 512 + C0), o);
      float s = 0.f;
#pragma unroll
      for (int e = 0; e < 8; ++e) s += o[e];
      s = allred8(s);
      float mu = s * (1.f / 64.f);
      float q = 0.f;
#pragma unroll
      for (int e = 0; e < 8; ++e) { o[e] -= mu; q += o[e] * o[e]; }
      q = allred8(q);
      float rsd = rsqrtf(q * (1.f / 64.f) + 64e-5f);
#pragma unroll
      for (int e = 0; e < 8; ++e) y[e] += o[e] * rsd * p.in[I_RLNW][C0 + e] + p.in[I_RLNB][C0 + e];
    }
#pragma unroll
    for (int e = 0; e < 8; ++e) y[e] *= g[e];
    *(uint4*)(ya + (size_t)t * 512 + C0) = pack8(y);
  }
}

DEVI void phase11(const Params& p, unsigned char* smem, const XcdMap& xm) {
  const int lane = threadIdx.x & 63, warp = threadIdx.x >> 6, wm = warp >> 1, wn = warp & 1;
  const bf16_t* ya = (const bf16_t*)(p.ws + O_PO);
  const bf16_t* yb = (const bf16_t*)(p.ws + R_YA);
  const bf16_t* pg = (const bf16_t*)(p.ws + O_PG);
  bf16_t* mg = (bf16_t*)(p.ws + R_MERGED);
  for_tiles_xcd(xm, 128, 8, 8, 8, [&](int mt, int nt) {
    f32x4 acc[4][4];
    zero_acc(acc);
    gemm_core(ya + (size_t)mt * 128 * 512, 512, (const bf16_t*)(p.ws + O_WBA) + (size_t)nt * 128 * 512, 512, 512, acc, smem);
#pragma unroll
    for (int i = 0; i < 4; ++i) {
      int row = mt * 128 + wm * 64 + i * 16 + (lane & 15);
#pragma unroll
      for (int j = 0; j < 4; ++j) {
        int n = nt * 128 + wn * 64 + j * 16 + (lane >> 4) * 4;
        uint2 s = *(const uint2*)(pg + (size_t)row * 2048 + n);
        *(uint2*)(mg + (size_t)row * 1024 + n) = make_uint2(pack2(acc[i][j][0] * bflo(s.x), acc[i][j][1] * bfhi(s.x)), pack2(acc[i][j][2] * bflo(s.y), acc[i][j][3] * bfhi(s.y)));
      }
    }
    zero_acc(acc);
    gemm_core(yb + (size_t)mt * 128 * 512, 512, (const bf16_t*)(p.ws + O_WBB) + (size_t)nt * 128 * 512, 512, 512, acc, smem);
#pragma unroll
    for (int i = 0; i < 4; ++i) {
      int row = mt * 128 + wm * 64 + i * 16 + (lane & 15);
#pragma unroll
      for (int j = 0; j < 4; ++j) {
        int n = nt * 128 + wn * 64 + j * 16 + (lane >> 4) * 4;
        uint2 s = *(const uint2*)(pg + (size_t)row * 2048 + 1024 + n);
        uint2 m0 = *(const uint2*)(mg + (size_t)row * 1024 + n);
        float v0 = bflo(m0.x) + acc[i][j][0] * bflo(s.x), v1 = bfhi(m0.x) + acc[i][j][1] * bfhi(s.x);
        float v2 = bflo(m0.y) + acc[i][j][2] * bflo(s.y), v3 = bfhi(m0.y) + acc[i][j][3] * bfhi(s.y);
        *(uint2*)(mg + (size_t)row * 1024 + n) = make_uint2(pack2(v0, v1), pack2(v2, v3));
      }
    }
  });
}

DEVI void phase12(const Params& p, unsigned char* smem, const XcdMap& xm) {
  float* gt = (float*)(smem + 45056);
  const int tid = threadIdx.x, lane = tid & 63, warp = tid >> 6, wm = warp >> 1, wn = warp & 1;
  for (int i = tid; i < 1024; i += 256) gt[i] = mod_val(p, 0, 2048 + i);
  __syncthreads();
  const bf16_t* mg = (const bf16_t*)(p.ws + R_MERGED);
  const float* x = p.in[I_X];
  float* x1 = p.out;
  for_tiles_xcd(xm, 128, 8, 8, 8, [&](int mt, int nt) {
    f32x4 acc[4][4];
    zero_acc(acc);
    gemm_core(mg + (size_t)mt * 128 * 1024, 1024, (const bf16_t*)(p.ws + O_WOUT) + (size_t)nt * 128 * 1024, 1024, 1024, acc, smem);
#pragma unroll
    for (int i = 0; i < 4; ++i) {
      int row = mt * 128 + wm * 64 + i * 16 + (lane & 15);
#pragma unroll
      for (int j = 0; j < 4; ++j) {
        int n = nt * 128 + wn * 64 + j * 16 + (lane >> 4) * 4;
        float4 xv = *(const float4*)(x + (size_t)row * 1024 + n);
        xv.x += gt[n] * acc[i][j][0]; xv.y += gt[n + 1] * acc[i][j][1]; xv.z += gt[n + 2] * acc[i][j][2]; xv.w += gt[n + 3] * acc[i][j][3];
        *(float4*)(x1 + (size_t)row * 1024 + n) = xv;
      }
    }
  });
}

DEVI void phase13(const Params& p, unsigned char* smem) {
  float* smod = (float*)smem;
  const int tid = threadIdx.x, lane = tid & 63, warp = tid >> 6;
  for (int i = tid; i < 2048; i += 256) smod[i] = mod_val(p, 0, 3072 + i);
  __syncthreads();
  const float* x1 = p.out;
  bf16_t* h2 = (bf16_t*)(p.ws + R_H2);
  for (int rp = blockIdx.x * 4 + warp; rp < T_LAT / 2; rp += gridDim.x * 4) {
    float h[2][16]; float ss[2] = {0.f, 0.f};
#pragma unroll
    for (int u = 0; u < 2; ++u)
#pragma unroll
      for (int i = 0; i < 4; ++i) {
        float4 v = *(const float4*)(x1 + (size_t)(rp * 2 + u) * 1024 + i * 256 + lane * 4);
        h[u][4 * i] = v.x; h[u][4 * i + 1] = v.y; h[u][4 * i + 2] = v.z; h[u][4 * i + 3] = v.w;
        ss[u] += v.x * v.x + v.y * v.y + v.z * v.z + v.w * v.w;
      }
#pragma unroll
    for (int u = 0; u < 2; ++u) {
      const int row = rp * 2 + u;
      const float rstd = rsqrtf(wave_sum_u(ss[u]) * (1.f / 1024.f) + 1e-6f);
#pragma unroll
      for (int i = 0; i < 4; ++i) {
#pragma unroll
        for (int e = 0; e < 4; ++e) {
          int k = i * 256 + lane * 4 + e;
          float y = h[u][4 * i + e] * rstd * p.in[I_N2G][k];
          h[u][4 * i + e] = y * (1.f + smod[1024 + k]) + smod[k];
        }
        *(uint2*)(h2 + (size_t)row * 1024 + i * 256 + lane * 4) = make_uint2(pack2(h[u][4 * i], h[u][4 * i + 1]), pack2(h[u][4 * i + 2], h[u][4 * i + 3]));
      }
    }
  }
}

DEVI void phase14(const Params& p, unsigned char* smem, const XcdMap& xm) {
  bf16_t(*Qt)[136] = (bf16_t(*)[136])smem;
  float* Sc = (float*)smem;
  const int tid = threadIdx.x, lane = tid & 63, warp = tid >> 6, wm = warp >> 1, wn = warp & 1;
  const bf16_t* h2 = (const bf16_t*)(p.ws + R_H2);
  const bf16_t* keys = (const bf16_t*)(p.ws + O_KEYS);
  float* tops = (float*)(p.ws + R_TOPS);
  int* topi = (int*)(p.ws + R_TOPI);
  for_tiles_xcd(xm, 128, 16, 8, 8, [&](int mt, int hp) {
    f32x4 acc[4][4];
    zero_acc(acc);
    gemm_core(h2 + (size_t)mt * 128 * 1024, 1024, (const bf16_t*)(p.ws + O_WQ) + (size_t)hp * 128 * 1024, 1024, 1024, acc, smem);
#pragma unroll
    for (int i = 0; i < 4; ++i)
#pragma unroll
      for (int j = 0; j < 4; ++j)
        *(uint2*)&Qt[wm * 64 + i * 16 + (lane & 15)][wn * 64 + j * 16 + (lane >> 4) * 4] =
            make_uint2(pack2(acc[i][j][0], acc[i][j][1]), pack2(acc[i][j][2], acc[i][j][3]));
    __syncthreads();
    zero_acc(acc);
#pragma unroll
    for (int ks = 0; ks < 4; ++ks) {
      bf16x8 qf[4], kf[4];
#pragma unroll
      for (int i = 0; i < 4; ++i) qf[i] = *(const bf16x8*)&Qt[wm * 64 + i * 16 + (lane & 15)][ks * 32 + (lane >> 4) * 8];
#pragma unroll
      for (int j = 0; j < 4; ++j) kf[j] = *(const bf16x8*)(keys + ((size_t)hp * 128 + wn * 64 + j * 16 + (lane & 15)) * 128 + ks * 32 + (lane >> 4) * 8);
#pragma unroll
      for (int i = 0; i < 4; ++i)
#pragma unroll
        for (int j = 0; j < 4; ++j) acc[i][j] = __builtin_amdgcn_mfma_f32_16x16x32_bf16(kf[j], qf[i], acc[i][j], 0, 0, 0);
    }
    __syncthreads();
#pragma unroll
    for (int i = 0; i < 4; ++i)
#pragma unroll
      for (int j = 0; j < 4; ++j) {
        {
          const int c0 = j * 16 + (lane >> 4) * 4;
          u32x4 kq;
#pragma unroll
          for (int r = 0; r < 4; ++r) {
            unsigned u = __float_as_uint(acc[i][j][r]);
            u = (u & 0x80000000u) ? ~u : (u | 0x80000000u);
            kq[r] = (u & ~63u) | (unsigned)(63 - (c0 + r));
          }
          *(u32x4*)(Sc + (wm * 64 + i * 16 + (lane & 15)) * 132 + wn * 64 + c0) = kq;
        }
      }
    __syncthreads();
    {
      const int row = tid & 127, half = tid >> 7;
      float* hp_ = Sc + row * 132 + half * 64;
      float bv[16]; int bi[16];
      unsigned* hk = (unsigned*)hp_;
#pragma unroll
      for (int r = 0; r < 16; ++r) {
        unsigned best = 0u;
#pragma unroll 4
        for (int k = 0; k < 64; k += 4) {
          const u32x4 v4 = *(const u32x4*)(hk + k);
          const unsigned m01 = v4[0] > v4[1] ? v4[0] : v4[1], m23 = v4[2] > v4[3] ? v4[2] : v4[3];
          const unsigned m = m01 > m23 ? m01 : m23;
          best = best > m ? best : m;
        }
        const int b2 = 63 - (int)(best & 63u);
        unsigned u = best & ~63u;
        u = (u & 0x80000000u) ? (u & 0x7fffffffu) : ~u;
        bv[r] = __uint_as_float(u); bi[r] = b2 + half * 64; hk[b2] = 0u;
      }
#pragma unroll
      for (int r = 0; r < 16; ++r) { hp_[r] = bv[r]; hp_[16 + r] = __int_as_float(bi[r]); }
    }
    __syncthreads();
    if (tid < 128) {
      const float* la = Sc + tid * 132; const float* lb = la + 64;
      size_t ob = ((size_t)(mt * 128 + tid) * 16 + hp) * 16;
      int ia = 0, ib = 0;
      for (int r = 0; r < 16; ++r) {
        float va = la[ia], vb = lb[ib];
        bool ta = va >= vb;
        tops[ob + r] = ta ? va : vb;
        topi[ob + r] = __float_as_int(ta ? la[16 + ia] : lb[16 + ib]);
        ia += ta ? 1 : 0; ib += ta ? 0 : 1;
      }
    }
    __syncthreads();
  });
}

template <bool DRY> DEVI void phase15(const Params& p, unsigned char* smem) {
  const bool wr = !DRY || (p.in[I_FG][0] == 1234.5f);
  float* gt = (float*)smem;
  const int tid = threadIdx.x, lane = tid & 63, warp = tid >> 6;
  for (int i = tid; i < 1024; i += 256) gt[i] = mod_val(p, 0, 5120 + i);
  __syncthreads();
  const bf16_t* __restrict__ h2 = (const bf16_t*)(p.ws + R_H2);
  const float* __restrict__ tops = (const float*)(p.ws + R_TOPS);
  const int* __restrict__ topi = (const int*)(p.ws + R_TOPI);
  const unsigned char* __restrict__ uf8 = p.ws + R_UBF;
  const unsigned char* __restrict__ vf8 = p.ws + R_VBF;
  float* xo = p.out;
  int ca, cb;
  {
    int l = lane;
    if (l < 16) { ca = 0; cb = l; } else if (l < 24) { ca = 1; cb = l - 16; } else if (l < 29) { ca = 2; cb = l - 24; }
    else if (l < 33) { ca = 3; cb = l - 29; } else if (l < 36) { ca = 4; cb = l - 33; } else if (l < 38) { ca = 5; cb = l - 36; }
    else if (l < 40) { ca = 6; cb = l - 38; } else if (l < 42) { ca = 7; cb = l - 40; } else if (l < 50) { ca = l - 34; cb = 0; }
    else { ca = 0; cb = 0; }
  }
  const int flat = ca * 16 + cb;
  for (int t = blockIdx.x * 4 + warp; t < T_LAT; t += gridDim.x * 4) {
    float hv[16], out[16];
    {
      const u32x4 hp0 = *(const u32x4*)(h2 + (size_t)t * 1024 + lane * 16);
      const u32x4 hp1 = *(const u32x4*)(h2 + (size_t)t * 1024 + lane * 16 + 8);
#pragma unroll
      for (int e = 0; e < 4; ++e) { hv[2 * e] = bflo(hp0[e]); hv[2 * e + 1] = bfhi(hp0[e]); hv[8 + 2 * e] = bflo(hp1[e]); hv[8 + 2 * e + 1] = bfhi(hp1[e]); }
    }
#pragma unroll
    for (int e = 0; e < 16; ++e) out[e] = 0.f;
#pragma unroll 1
    for (int hd = 0; hd < 8; ++hd) {
      const size_t b1 = ((size_t)t * 16 + hd * 2) * 16, b2 = b1 + 16;
      float val = lane < 50 ? tops[b1 + ca] + tops[b2 + cb] : -INFINITY;
      int idx = topi[b1 + ca] * 128 + topi[b2 + cb];
      unsigned key = __float_as_uint(val);
      key = (key & 0x80000000u) ? ~key : (key | 0x80000000u);
      key = lane < 50 ? ((key & ~63u) | (unsigned)(63 - lane)) : 0u;
      int cnt = 0;
#pragma unroll
      for (int i = 0; i < 50; ++i) cnt += ((unsigned)__builtin_amdgcn_readlane((int)key, i) > key) ? 1 : 0;
      bool sel = lane < 50 && cnt < 16;
      float vmax = rlf(val, 0);
      float ex = sel ? __expf(val - vmax) : 0.f;
      float gsum = wave_sum_u(ex);
      float g = ex / gsum;
      unsigned long long m1 = __ballot(sel);
      int es[16];
      float gq = 0.f;
#pragma unroll
      for (int q = 0; q < 16; ++q) {
        int src = __ffsll((long long)m1) - 1; m1 &= m1 - 1;
        es[q] = __builtin_amdgcn_readlane(idx, src);
        float gg = rlf(g, src);
        if (lane == q) gq = gg;
      }
      float dm = 0.f;
      {
        u32x4 ub[16];
#pragma unroll
        for (int q = 0; q < 16; ++q) ub[q] = *(const u32x4*)(uf8 + (size_t)es[q] * 1024 + lane * 16);
#pragma unroll
        for (int q = 0; q < 16; ++q) {
          float f[16]; unpack_fp8x16(ub[q], f);
          float d0 = 0.f, d1 = 0.f;
#pragma unroll
          for (int e = 0; e < 8; ++e) { d0 += f[2 * e] * hv[2 * e]; d1 += f[2 * e + 1] * hv[2 * e + 1]; }
          float d = d0 + d1;
          d += dppf<0xB1>(d); d += dppf<0x4E>(d); d += dppf<0x141>(d); d += dppf<0x140>(d);
          if ((lane & 15) == q) dm = d;
        }
      }
      dm += __shfl_xor(dm, 16); dm += __shfl_xor(dm, 32);
      dm *= (1.f / 64.f);
      float coef = gq * 0.5f * dm * (1.f + erff(dm * 0.70710678118f)) * 0.25f;
      {
        u32x4 vb[16];
#pragma unroll
        for (int q = 0; q < 16; ++q) vb[q] = *(const u32x4*)(vf8 + (size_t)es[q] * 1024 + lane * 16);
#pragma unroll
        for (int q = 0; q < 16; ++q) {
          float cf = rlf(coef, q);
          float f[16]; unpack_fp8x16(vb[q], f);
#pragma unroll
          for (int e = 0; e < 16; ++e) out[e] += cf * f[e];
        }
      }
    }
    float xs[16]; float ss = 0.f;
#pragma unroll
    for (int i = 0; i < 4; ++i) {
      int k = lane * 16 + i * 4;
      float4 v = *(const float4*)(xo + (size_t)t * 1024 + k);
      xs[4 * i] = v.x + gt[k] * out[4 * i]; xs[4 * i + 1] = v.y + gt[k + 1] * out[4 * i + 1];
      xs[4 * i + 2] = v.z + gt[k + 2] * out[4 * i + 2]; xs[4 * i + 3] = v.w + gt[k + 3] * out[4 * i + 3];
      ss += xs[4 * i] * xs[4 * i] + xs[4 * i + 1] * xs[4 * i + 1] + xs[4 * i + 2] * xs[4 * i + 2] + xs[4 * i + 3] * xs[4 * i + 3];
    }
    ss = wave_sum_u(ss);
    float rstd = rsqrtf(ss * (1.f / 1024.f) + 1e-6f);
#pragma unroll
    for (int i = 0; i < 4; ++i) {
      int k = lane * 16 + i * 4;
      float4 g4 = *(const float4*)(p.in[I_FG] + k);
      if (wr) *(float4*)(xo + (size_t)t * 1024 + k) = make_float4(xs[4 * i] * rstd * g4.x, xs[4 * i + 1] * rstd * g4.y, xs[4 * i + 2] * rstd * g4.z, xs[4 * i + 3] * rstd * g4.w);
    }
  }
}

#define XB_TMO      128
#define XB_XCNT(j)  (256  + 64 * (j))
#define XB_XSUB(j)  (1280 + 64 * (j))
#define XB_XGEN(j)  (2304 + 64 * (j))
#define XB_TOP      3328
#define XB_TOPGEN   3392
#define XCD_BAR_WORDS 3456
#define XB_SPIN_CAP (1u << 22)
#define LAS __attribute__((address_space(3)))
DEVI unsigned xb_ld(unsigned* p) { return __hip_atomic_load(p, __ATOMIC_RELAXED, __HIP_MEMORY_SCOPE_AGENT); }
DEVI unsigned xb_add(unsigned* p, unsigned v) { return __hip_atomic_fetch_add(p, v, __ATOMIC_RELAXED, __HIP_MEMORY_SCOPE_AGENT); }
DEVI unsigned xb_xcc_id() { return (unsigned)__builtin_amdgcn_s_getreg((3 << 11) | 20) & 0xFu; }
#define XB_SPIN(cond, bar) do { unsigned _sp = 0; while (cond) { __builtin_amdgcn_s_sleep(1); \
    if ((++_sp & 255u) == 0u) { if (xb_ld(&(bar)[XB_TMO])) break; if (_sp > XB_SPIN_CAP) { atomicAdd(&(bar)[XB_TMO], 1u); break; } } } } while (0)
struct XcdBarrier { unsigned* bar; unsigned x; volatile LAS unsigned* st; };
DEVI XcdBarrier xcd_barrier_post(unsigned* bar, volatile LAS unsigned* st) {
  XcdBarrier b; b.bar = bar; b.x = xb_xcc_id(); b.st = st;
  if (threadIdx.x == 0) st[2] = xb_add(&bar[XB_XCNT(b.x)], 1u);
  return b;
}
DEVI void xcd_barrier_complete(unsigned* bar, unsigned x, unsigned& nloc, unsigned& nx, unsigned& vidx) {
  const unsigned G = gridDim.x * gridDim.y * gridDim.z;
  unsigned sum, cnt, mine, below, sp = 0u;
  for (;;) {
    sum = 0u; cnt = 0u; mine = 0u; below = 0u;
#pragma unroll
    for (unsigned j = 0; j < 16; ++j) { const unsigned c = xb_ld(&bar[XB_XCNT(j)]); sum += c; cnt += (c > 0u) ? 1u : 0u; mine = (j == x) ? c : mine; below += (c > 0u && j < x) ? 1u : 0u; }
    if (sum == G) break;
    __builtin_amdgcn_s_sleep(1);
    if ((++sp & 255u) == 0u) { if (xb_ld(&bar[XB_TMO])) break; if (sp > XB_SPIN_CAP) { atomicAdd(&bar[XB_TMO], 1u); break; } }
  }
  nloc = mine > 0u ? mine : 1u; nx = cnt > 0u ? cnt : 1u; vidx = below;
}
DEVI void xcd_barrier(const XcdBarrier& b) {
  asm volatile("s_waitcnt vmcnt(0)" ::: "memory");
  __syncthreads();
  if (threadIdx.x == 0) {
    unsigned* bar = b.bar;
    __builtin_amdgcn_s_waitcnt(0);
    unsigned nloc = b.st[0], nx = b.st[1];
    if (nloc == 0u) { unsigned vidx; xcd_barrier_complete(bar, b.x, nloc, nx, vidx); b.st[0] = nloc; b.st[1] = nx; b.st[3] = vidx; }
    const unsigned old = xb_add(&bar[XB_XSUB(b.x)], 1u);
    const unsigned gen = old / nloc;
    if (old + 1u == (gen + 1u) * nloc) {
      __builtin_amdgcn_fence(__ATOMIC_RELEASE, "agent");
      asm volatile("s_waitcnt vmcnt(0)" ::: "memory");
      const unsigned og = xb_add(&bar[XB_TOP], 1u);
      const unsigned tg = og / nx;
      if (og + 1u == (tg + 1u) * nx) xb_add(&bar[XB_TOPGEN], 1u);
      else XB_SPIN(xb_ld(&bar[XB_TOPGEN]) == tg, bar);
      __builtin_amdgcn_fence(__ATOMIC_ACQUIRE, "agent");
      xb_add(&bar[XB_XGEN(b.x)], 1u);
      asm volatile("s_waitcnt vmcnt(0)" ::: "memory");
    } else {
      XB_SPIN(xb_ld(&bar[XB_XGEN(b.x)]) == gen, bar);
      __builtin_amdgcn_fence(__ATOMIC_ACQUIRE, "agent");
      asm volatile("s_waitcnt vmcnt(0)" ::: "memory");
    }
  }
  __syncthreads();
}

constexpr int NPHASE = 16;
DEVI XcdMap get_xm(int coop, const uint4& w) {
  XcdMap m;
  if (coop) { m.v = (int)w.w; m.nx = (int)w.y; m.slot = (int)w.z; m.slots = (int)w.x; }
  else { m.v = blockIdx.x & 7; m.nx = 8; m.slot = blockIdx.x >> 3; m.slots = gridDim.x >> 3; if (m.slots < 1) { m.slots = 1; } }
  return m;
}
__global__ void __launch_bounds__(256, 2) mk(Params p, int ph0, int ph1, int coop) {
  __shared__ __attribute__((aligned(16))) unsigned char smem[SMEM_BYTES];
  __shared__ uint4 xb_words;
  if (threadIdx.x == 0) xb_words = make_uint4(0u, 0u, 0u, 0u);
  __syncthreads();
  XcdBarrier xb;
  if (coop) xb = xcd_barrier_post((unsigned*)(p.ws + O_BAR), (volatile LAS unsigned*)&xb_words);
#ifdef XCC_PROBE
  if (coop && xb_xcc_id() != (blockIdx.x & 7u)) { unsigned long long t0 = wall_clock64(); while (wall_clock64() - t0 < 100000ull) __builtin_amdgcn_s_sleep(8); }
#endif
  if (ph0 < 0) cg::this_grid().sync();
#ifdef PROBE_A
#define STAMP(n) if (blockIdx.x == 0 && threadIdx.x == 0) ((unsigned long long*)(p.ws + O_STAMP))[n] = wall_clock64();
#else
#define STAMP(n)
#endif
#define RUN_PHASE(n, call)                                   \
  if (ph0 <= n && n < ph1) {                                 \
    STAMP(n)                                                 \
        if (DRY_PH == n) { if (n == 4) phase4<true>(p, smem); if (n == 5) phase5<true>(p, smem); if (n == 8) phase8<true>(p, smem); if (n == 15) phase15<true>(p, smem); } \
    if (ONLY < 0 || ONLY == n) { call; }                     \
    if (REPEAT_PH == n) { call; }                            \
    if (coop && n + 1 < ph1) xcd_barrier(xb);                \
  }
  RUN_PHASE(0, phase0(p, smem, 0, 384))
  RUN_PHASE(1, (phase1(p, smem), __syncthreads(), phase0(p, smem, 384, 1 << 30)))
  RUN_PHASE(2, phase2(p, smem, get_xm(coop, xb_words)))
  RUN_PHASE(3, phase3(p, smem))
  RUN_PHASE(4, (phase4<false>(p, smem), phase6(p, smem, 0, 32, gridDim.x > 290 ? 258 : 0, gridDim.x > 290 ? (int)gridDim.x - 258 : (int)gridDim.x)))
  RUN_PHASE(5, phase5<false>(p, smem))
  RUN_PHASE(6, phase6(p, smem, 32, 260 * 8, 0, (int)gridDim.x))
  RUN_PHASE(7, phase7(p))
  RUN_PHASE(8, phase8<false>(p, smem))
  RUN_PHASE(9, phase9(p))
  RUN_PHASE(10, phase10(p))
  RUN_PHASE(11, phase11(p, smem, get_xm(coop, xb_words)))
  RUN_PHASE(12, (phase12(p, smem, get_xm(coop, xb_words)), convert_fp8(p.in[I_PU], p.ws + R_UBF, (size_t)16384 * 64, 64.f)))
  RUN_PHASE(13, phase13(p, smem))
  RUN_PHASE(14, (phase14(p, smem, get_xm(coop, xb_words)), convert_fp8(p.in[I_PV], p.ws + R_VBF, (size_t)16384 * 64, 4.f)))
  RUN_PHASE(15, phase15<false>(p, smem))
#ifdef SYNC_EXTRA
  for (int i = 0; i < SYNC_EXTRA; ++i) xcd_barrier(xb);
#endif
#ifdef PROBE_A
  cg::this_grid().sync();
  STAMP(16)
  __syncthreads();
  if (blockIdx.x == 0) {
    const unsigned long long* st = (const unsigned long long*)(p.ws + O_STAMP);
    float ta = (float)(st[PROBE_A + 1] - st[PROBE_A]) * 0.01f, tb = (float)(st[PROBE_B + 1] - st[PROBE_B]) * 0.01f;
    for (int i = threadIdx.x; i < 1000000; i += 256) p.out[1 + i] = tb;
    if (threadIdx.x == 0) p.out[0] = 100.f * ta;
  }
#endif
}

extern "C" void kernel_launch(void* const* d_in, const int* in_sizes, int n_in, void* d_out, int out_size, void* d_ws,
                              size_t ws_size, hipStream_t stream) {
  static int grid_blocks = 0;
  if (!grid_blocks) {
    int dev = 0, cus = 0, per_cu = 0;
    hipGetDevice(&dev);
    hipDeviceGetAttribute(&cus, hipDeviceAttributeMultiprocessorCount, dev);
    hipOccupancyMaxActiveBlocksPerMultiprocessor(&per_cu, mk, 256, 0);
    if (per_cu < 1) per_cu = 1;
    if (per_cu > 2) per_cu = 2;
    grid_blocks = cus * per_cu;
  }
  if (ws_size < WS_NEED) { fprintf(stderr, "workspace too small: %zu < %zu\n", ws_size, (size_t)WS_NEED); return; }
  Params p{};
  for (int i = 0; i < 32; ++i) p.in[i] = (const float*)d_in[i];
  p.out = (float*)d_out;
  p.ws = (unsigned char*)d_ws;
#if MEGA
  (void)hipMemsetAsync((unsigned char*)d_ws + O_BAR, 0, XCD_BAR_WORDS * 4, stream);
  int ph0 = 0, ph1 = NPHASE, coop = 1;
  void* args[] = {&p, &ph0, &ph1, &coop};
  hipError_t e = hipLaunchCooperativeKernel((void*)mk, dim3(grid_blocks), dim3(256), args, 0, stream);
  if (e != hipSuccess) fprintf(stderr, "cooperative launch failed: %s (grid %d)\n", hipGetErrorString(e), grid_blocks);
#else
  for (int ph = 0; ph < NPHASE; ++ph) mk<<<grid_blocks, 256, 0, stream>>>(p, ph, ph + 1, 0);
#endif
}
```

```cpp
#include <hip/hip_runtime.h>
#include <hip/hip_cooperative_groups.h>
#include <cstdio>
#include <cstdint>
namespace cg = cooperative_groups;

#ifndef MEGA
#define MEGA 1
#endif
#ifndef ONLY
#define ONLY -1
#endif
#ifndef REPEAT_PH
#define REPEAT_PH -1
#endif
#ifndef DRY_PH
#define DRY_PH -1
#endif

typedef unsigned short bf16_t;
using bf16x8 = __attribute__((ext_vector_type(8))) short;
using f32x4 = __attribute__((ext_vector_type(4))) float;
using u32x4 = __attribute__((ext_vector_type(4))) unsigned;
#define DEVI __device__ __forceinline__

constexpr int T_CTX = 256, T_LAT = 16384, T_ALL = 16640;
constexpr int NIN = 5392, NP = 5376;
constexpr int NCH = 128, LCH = 130;
constexpr int SVH = 576;
constexpr int SMEM_BYTES = 71680;

enum { I_X = 0, I_C, I_CTX, I_CCTX, I_ADAW, I_ADAB, I_N1G, I_WIN, I_RCONV, I_RW0, I_RWUP, I_RA0, I_RAUP, I_RGUP,
       I_RKK, I_RKA, I_RRK, I_RLNW, I_RLNB, I_MCONV, I_MIB, I_MFB, I_MNG, I_WBA, I_WBB, I_WOUT, I_N2G, I_WQ,
       I_KEYS, I_PU, I_PV, I_FG };

struct Params { const float* in[32]; float* out; unsigned char* ws; };

constexpr size_t A256(size_t x) { return (x + 255) & ~(size_t)255; }
constexpr size_t O_MODP = 0;
constexpr size_t O_WBA = A256(O_MODP + (size_t)16 * 2 * 6144 * 4);
constexpr size_t O_WBB = A256(O_WBA + (size_t)1024 * 512 * 2);
constexpr size_t O_WOUT = A256(O_WBB + (size_t)1024 * 512 * 2);
constexpr size_t O_WQ = A256(O_WOUT + (size_t)1024 * 1024 * 2);
constexpr size_t O_KEYS = A256(O_WQ + (size_t)2048 * 1024 * 2);
constexpr size_t O_WUP = A256(O_KEYS + (size_t)16 * 128 * 128 * 2);
constexpr size_t O_AUP = A256(O_WUP + (size_t)1024 * 64 * 2);
constexpr size_t O_GUP = A256(O_AUP + (size_t)1024 * 64 * 2);
constexpr size_t O_BEND = A256(O_GUP + (size_t)512 * 128 * 2);
constexpr size_t O_MLOC = A256(O_BEND + (size_t)260 * 8 * 4);
constexpr size_t O_MST = A256(O_MLOC + (size_t)260 * 8 * 4);
constexpr size_t O_NT = A256(O_MST + (size_t)260 * 8 * 4);
constexpr size_t O_BONUS = A256(O_NT + (size_t)260 * 8 * 64 * 4);
constexpr size_t O_STAMP = A256(O_BONUS + (size_t)T_ALL * 16 * 4);
constexpr size_t O_BAR = A256(O_STAMP + 1024);
constexpr size_t O_PG = A256(O_BAR + 3456 * 4);
constexpr size_t O_PO = A256(O_PG + (size_t)T_LAT * 2048 * 2);
constexpr size_t O_R = A256(O_PO + (size_t)T_LAT * 512 * 2);
constexpr size_t R_HX = O_R;
constexpr size_t R_WIN = A256(R_HX + (size_t)T_ALL * 1024 * 2);
constexpr size_t R_PQK = A256(R_WIN + (size_t)(NP + 128) * 1024 * 2);
constexpr size_t R_PV = A256(R_PQK + (size_t)T_ALL * 512 * 2);
constexpr size_t R_GIF = A256(R_PV + (size_t)T_ALL * 512 * 2);
constexpr size_t R_U = A256(R_GIF + (size_t)T_ALL * 16 * 4);
constexpr size_t R_END1 = A256(R_U + (size_t)260 * 8 * 8192 * 4);
constexpr size_t R_SV = O_R;
constexpr size_t R_YA = A256(R_SV + (size_t)T_ALL * 8 * SVH * 2);
constexpr size_t R_END2 = A256(R_YA + (size_t)T_LAT * 512 * 2);
constexpr size_t R_MERGED = O_R;
constexpr size_t R_H2 = A256(R_MERGED + (size_t)T_LAT * 1024 * 2);
constexpr size_t R_TOPS = A256(R_H2 + (size_t)T_LAT * 1024 * 2);
constexpr size_t R_TOPI = A256(R_TOPS + (size_t)T_LAT * 256 * 4);
constexpr size_t R_UBF = A256(R_TOPI + (size_t)T_LAT * 256 * 4);
constexpr size_t R_VBF = A256(R_UBF + (size_t)16384 * 1024 * 2);
constexpr size_t R_END3 = A256(R_VBF + (size_t)16384 * 1024 * 2);
constexpr size_t WS_NEED = (R_END1 > R_END2 ? (R_END1 > R_END3 ? R_END1 : R_END3) : (R_END2 > R_END3 ? R_END2 : R_END3));
constexpr size_t OUT_BC = (size_t)NCH * 16 * 4096 * 4;

DEVI bf16_t f2bf(float f) { unsigned u = __float_as_uint(f); u += 0x7fffu + ((u >> 16) & 1u); return (bf16_t)(u >> 16); }
DEVI float bf2f(bf16_t h) { return __uint_as_float(((unsigned)h) << 16); }
DEVI float bflo(unsigned u) { return __uint_as_float(u << 16); }
DEVI float bfhi(unsigned u) { return __uint_as_float(u & 0xffff0000u); }
DEVI unsigned pack2(float a, float b) { return (unsigned)f2bf(a) | ((unsigned)f2bf(b) << 16); }
DEVI void unpack8(const uint4& u, float* f) {
  f[0] = bflo(u.x); f[1] = bfhi(u.x); f[2] = bflo(u.y); f[3] = bfhi(u.y);
  f[4] = bflo(u.z); f[5] = bfhi(u.z); f[6] = bflo(u.w); f[7] = bfhi(u.w);
}
DEVI uint4 pack8(const float* f) { return make_uint4(pack2(f[0], f[1]), pack2(f[2], f[3]), pack2(f[4], f[5]), pack2(f[6], f[7])); }
DEVI float wave_sum(float v) {
#pragma unroll
  for (int o = 32; o; o >>= 1) v += __shfl_xor(v, o);
  return v;
}
DEVI float wave_max(float v) {
#pragma unroll
  for (int o = 32; o; o >>= 1) v = fmaxf(v, __shfl_xor(v, o));
  return v;
}
DEVI float sigm(float x) { return 1.f / (1.f + __expf(-x)); }
DEVI float siluf(float x) { return x / (1.f + __expf(-x)); }
DEVI float logsig(float x) { return fminf(x, 0.f) - log1pf(expf(-fabsf(x))); }
template <int CTRL> DEVI float dppf(float v) { return __int_as_float(__builtin_amdgcn_update_dpp(0, __float_as_int(v), CTRL, 0xf, 0xf, true)); }
DEVI float rlf(float v, int l) { return __int_as_float(__builtin_amdgcn_readlane(__float_as_int(v), l)); }
DEVI float wave_sum_u(float v) {
  v += dppf<0xB1>(v); v += dppf<0x4E>(v); v += dppf<0x141>(v); v += dppf<0x140>(v);
  return (rlf(v, 0) + rlf(v, 16)) + (rlf(v, 32) + rlf(v, 48));
}
typedef __attribute__((ext_vector_type(2))) short s16x2;
DEVI float dot2bf(unsigned a, unsigned b, float c) { return __builtin_amdgcn_fdot2_f32_bf16(__builtin_bit_cast(s16x2, a), __builtin_bit_cast(s16x2, b), c, false); }
typedef __attribute__((ext_vector_type(2))) float f32x2;
DEVI void convert_fp8(const float* __restrict__ src, unsigned char* __restrict__ dst, size_t n16, float scale) {
  for (size_t g = (size_t)blockIdx.x * 256 + threadIdx.x; g < n16; g += (size_t)gridDim.x * 256) {
    u32x4 o;
#pragma unroll
    for (int q = 0; q < 4; ++q) {
      float4 a = *(const float4*)(src + g * 16 + q * 4);
      int pk = __builtin_amdgcn_cvt_pk_fp8_f32(a.x * scale, a.y * scale, 0, false);
      pk = __builtin_amdgcn_cvt_pk_fp8_f32(a.z * scale, a.w * scale, pk, true);
      o[q] = (unsigned)pk;
    }
    *(u32x4*)(dst + g * 16) = o;
  }
}
DEVI void unpack_fp8x16(const u32x4& u, float* f) {
#pragma unroll
  for (int q = 0; q < 4; ++q) {
    f32x2 lo = __builtin_amdgcn_cvt_pk_f32_fp8((int)u[q], false), hi = __builtin_amdgcn_cvt_pk_f32_fp8((int)u[q], true);
    f[4 * q] = lo[0]; f[4 * q + 1] = lo[1]; f[4 * q + 2] = hi[0]; f[4 * q + 3] = hi[1];
  }
}
DEVI void convert_bf16(const float* __restrict__ src, bf16_t* __restrict__ dst, size_t n8) {
  for (size_t g = (size_t)blockIdx.x * 256 + threadIdx.x; g < n8; g += (size_t)gridDim.x * 256) {
    float4 a = *(const float4*)(src + g * 8), b = *(const float4*)(src + g * 8 + 4);
    *(uint4*)(dst + g * 8) = make_uint4(pack2(a.x, a.y), pack2(a.z, a.w), pack2(b.x, b.y), pack2(b.z, b.w));
  }
}
DEVI float allred8(float v) { v += dppf<0xB1>(v); v += dppf<0x4E>(v); v += dppf<0x141>(v); return v; }

DEVI int ml_row(int c, int j) {
  if (c < 4) return c * 64 + j;
  int cc = c - 4; int col = cc >> 2; int gr = (cc & 3) * 64 + j;
  return T_CTX + gr * 64 + col;
}
DEVI int ml_sc(int c, int dir) { return dir == 0 ? c : (c < 4 ? 3 - c : 263 - c); }
DEVI int rw_row(int p, int dir) { return dir == 0 ? p : (p < T_CTX ? (T_CTX - 1 - p) : (T_ALL + T_CTX - 1 - p)); }

DEVI float mod_val(const Params& p, int which, int col) {
  return ((const float*)(p.ws + O_MODP))[which * 6144 + col];
}

DEVI void gemm_core(const bf16_t* __restrict__ A, int lda, const bf16_t* __restrict__ Bt, int ldb, int K,
                    f32x4 (&acc)[4][4], unsigned char* smem) {
  bf16_t(*sa)[80] = (bf16_t(*)[80])smem;
  bf16_t(*sb)[80] = (bf16_t(*)[80])(smem + 128 * 80 * 2);
  const int tid = threadIdx.x, lane = tid & 63, warp = tid >> 6, wm = warp >> 1, wn = warp & 1;
  const int lr = tid >> 3, lk = (tid & 7) * 8;
  const bf16_t* Ap = A + (size_t)lr * lda + lk;
  const bf16_t* Bp = Bt + (size_t)lr * ldb + lk;
  u32x4 ra0[4], rb0[4], ra1[4], rb1[4];
#pragma unroll
  for (int i = 0; i < 4; ++i) {
    ra0[i] = *(const u32x4*)(Ap + (size_t)(32 * i) * lda); rb0[i] = *(const u32x4*)(Bp + (size_t)(32 * i) * ldb);
    ra1[i] = *(const u32x4*)(Ap + (size_t)(32 * i) * lda + 64); rb1[i] = *(const u32x4*)(Bp + (size_t)(32 * i) * ldb + 64);
  }
#define GEMM_STEP(k0, ra, rb)                                                                                 \
  {                                                                                                           \
    __syncthreads();                                                                                          \
    _Pragma("unroll") for (int i = 0; i < 4; ++i) { *(u32x4*)&sa[lr + 32 * i][lk] = ra[i]; *(u32x4*)&sb[lr + 32 * i][lk] = rb[i]; } \
    __syncthreads();                                                                                          \
    if ((k0) + 128 < K) {                                                                                     \
      _Pragma("unroll") for (int i = 0; i < 4; ++i) {                                                         \
        ra[i] = *(const u32x4*)(Ap + (size_t)(32 * i) * lda + (k0) + 128);                                    \
        rb[i] = *(const u32x4*)(Bp + (size_t)(32 * i) * ldb + (k0) + 128);                                    \
      }                                                                                                       \
    }                                                                                                         \
    __builtin_amdgcn_s_setprio(1);                                                                            \
    _Pragma("unroll") for (int ks = 0; ks < 2; ++ks) {                                                        \
      bf16x8 af[4], bq[4];                                                                                    \
      _Pragma("unroll") for (int i = 0; i < 4; ++i) af[i] = *(const bf16x8*)&sa[wm * 64 + i * 16 + (lane & 15)][ks * 32 + (lane >> 4) * 8]; \
      _Pragma("unroll") for (int j = 0; j < 4; ++j) bq[j] = *(const bf16x8*)&sb[wn * 64 + j * 16 + (lane & 15)][ks * 32 + (lane >> 4) * 8]; \
      _Pragma("unroll") for (int i = 0; i < 4; ++i)                                                           \
        _Pragma("unroll") for (int j = 0; j < 4; ++j) acc[i][j] = __builtin_amdgcn_mfma_f32_16x16x32_bf16(bq[j], af[i], acc[i][j], 0, 0, 0); \
    }                                                                                                         \
    __builtin_amdgcn_s_setprio(0);                                                                            \
  }
  for (int k0 = 0; k0 < K; k0 += 128) {
    GEMM_STEP(k0, ra0, rb0)
    GEMM_STEP(k0 + 64, ra1, rb1)
  }
#undef GEMM_STEP
  __syncthreads();
}
DEVI void zero_acc(f32x4 (&acc)[4][4]) {
#pragma unroll
  for (int i = 0; i < 4; ++i)
#pragma unroll
    for (int j = 0; j < 4; ++j) acc[i][j] = f32x4{0.f, 0.f, 0.f, 0.f};
}

struct XcdMap { int v, nx, slot, slots; };
template <typename F> DEVI void for_tiles_xcd(const XcdMap& xm, int MT, int NT, int SM, int SN, F&& f) {
  const int nsn = (NT + SN - 1) / SN, nst = ((MT + SM - 1) / SM) * nsn, per = SM * SN;
  const int n_my = (nst - xm.v + xm.nx - 1) / xm.nx;
  for (int g = xm.slot; g < n_my * per; g += xm.slots) {
    const int s = xm.v + (g / per) * xm.nx, idx = g % per;
    const int sm = s / nsn, sn = s % nsn;
    const int mt = sm * SM + idx / SN, nt = sn * SN + idx % SN;
    if (mt < MT && nt < NT) f(mt, nt);
  }
}

DEVI void tr_tile(const float* __restrict__ src, int lds, int k0, int n0src, bf16_t* __restrict__ dst, int ldd, int n0dst,
                  unsigned char* smem) {
  float(*tile)[65] = (float(*)[65])smem;
  const int tid = threadIdx.x, j = tid & 63, i0 = tid >> 6;
#pragma unroll 4
  for (int ii = 0; ii < 16; ++ii) { int i = i0 + 4 * ii; tile[i][j] = src[(size_t)(k0 + i) * lds + n0src + j]; }
  __syncthreads();
#pragma unroll 4
  for (int jj = 0; jj < 16; ++jj) { int jn = i0 + 4 * jj; dst[(size_t)(n0dst + jn) * ldd + k0 + j] = f2bf(tile[j][jn]); }
  __syncthreads();
}

DEVI void phase0(const Params& p, unsigned char* smem, int it_lo, int it_hi) {
  const int tid = threadIdx.x;
  constexpr int N_MOD = 96, N_WIN = 16 * 85, N_WB = 128, N_WOUT = 256, N_WQ = 512, N_LORA = 16, N_GUP = 16, N_KEYS = 128;
  constexpr int E0 = N_MOD, E1 = E0 + N_WIN, E2 = E1 + N_WB, E3 = E2 + N_WB, E4 = E3 + N_WOUT, E5 = E4 + N_WQ,
                E6 = E5 + N_LORA, E7 = E6 + N_LORA, E8 = E7 + N_GUP, E9 = E8 + N_KEYS;
  if (it_hi > E9) it_hi = E9;
  for (int it = it_lo + blockIdx.x; it < it_hi; it += gridDim.x) {
    if (it < E0) {
      float* sl = (float*)smem;
      float* part = sl + 2048;
      __syncthreads();
      for (int i = tid; i < 2048; i += 256) sl[i] = siluf(i < 1024 ? p.in[I_C][i] : p.in[I_CCTX][i - 1024]);
      __syncthreads();
      const int cl = tid & 63, rg = tid >> 6, col = it * 64 + cl;
      const float* aw = p.in[I_ADAW] + (size_t)(rg * 256) * 6144 + col;
      float ax = 0.f, ac = 0.f;
#pragma unroll 32
      for (int r = 0; r < 256; ++r) {
        const float w = aw[(size_t)r * 6144];
        ax += sl[rg * 256 + r] * w;
        ac += sl[1024 + rg * 256 + r] * w;
      }
      part[(rg * 2 + 0) * 64 + cl] = ax;
      part[(rg * 2 + 1) * 64 + cl] = ac;
      __syncthreads();
      if (tid < 128) {
        const int which = tid >> 6;
        const float v = part[(0 * 2 + which) * 64 + cl] + part[(1 * 2 + which) * 64 + cl] + part[(2 * 2 + which) * 64 + cl] + part[(3 * 2 + which) * 64 + cl];
        ((float*)(p.ws + O_MODP))[which * 6144 + col] = v + p.in[I_ADAB][col];
      }
    } else if (it < E1) {
      int t = it - E0; int kt = t / 85, nt = t % 85; int n0 = nt * 64;
      tr_tile(p.in[I_WIN], NIN, kt * 64, nt == 84 ? 2816 : (n0 < 2816 ? n0 : n0 + 16), (bf16_t*)(p.ws + R_WIN), 1024, n0, smem);
    } else if (it < E2) {
      int t = it - E1; tr_tile(p.in[I_WBA], 1024, (t / 16) * 64, (t % 16) * 64, (bf16_t*)(p.ws + O_WBA), 512, (t % 16) * 64, smem);
    } else if (it < E3) {
      int t = it - E2; tr_tile(p.in[I_WBB], 1024, (t / 16) * 64, (t % 16) * 64, (bf16_t*)(p.ws + O_WBB), 512, (t % 16) * 64, smem);
    } else if (it < E4) {
      int t = it - E3; tr_tile(p.in[I_WOUT], 1024, (t / 16) * 64, (t % 16) * 64, (bf16_t*)(p.ws + O_WOUT), 1024, (t % 16) * 64, smem);
    } else if (it < E5) {
      int t = it - E4; tr_tile(p.in[I_WQ], 2048, (t / 32) * 64, (t % 32) * 64, (bf16_t*)(p.ws + O_WQ), 1024, (t % 32) * 64, smem);
    } else if (it < E6) {
      int t = it - E5; int dir = t / 8, nt = t % 8;
      tr_tile(p.in[I_RWUP] + (size_t)dir * 64 * 512, 512, 0, nt * 64, (bf16_t*)(p.ws + O_WUP) + (size_t)dir * 512 * 64, 64, nt * 64, smem);
    } else if (it < E7) {
      int t = it - E6; int dir = t / 8, nt = t % 8;
      tr_tile(p.in[I_RAUP] + (size_t)dir * 64 * 512, 512, 0, nt * 64, (bf16_t*)(p.ws + O_AUP) + (size_t)dir * 512 * 64, 64, nt * 64, smem);
    } else if (it < E8) {
      int t = it - E7; tr_tile(p.in[I_RGUP], 512, (t / 8) * 64, (t % 8) * 64, (bf16_t*)(p.ws + O_GUP), 128, (t % 8) * 64, smem);
    } else {
      int t = it - E8; size_t base = (size_t)t * 2048 + tid * 8;
      const float* s = p.in[I_KEYS] + base;
      float f[8];
      float4 a = *(const float4*)s, b = *(const float4*)(s + 4);
      f[0] = a.x; f[1] = a.y; f[2] = a.z; f[3] = a.w; f[4] = b.x; f[5] = b.y; f[6] = b.z; f[7] = b.w;
      *(uint4*)((bf16_t*)(p.ws + O_KEYS) + base) = pack8(f);
    }
  }
}

DEVI void phase1(const Params& p, unsigned char* smem) {
  float* smod = (float*)smem;
  const int tid = threadIdx.x, lane = tid & 63, warp = tid >> 6;
  for (int i = tid; i < 4096; i += 256) { int which = i >> 10; smod[i] = mod_val(p, which >> 1, (which & 1) * 1024 + (i & 1023)); }
  __syncthreads();
  bf16_t* hx = (bf16_t*)(p.ws + R_HX);
  float* gif = (float*)(p.ws + R_GIF);
  const float* win = p.in[I_WIN];
  constexpr int RPW = 4;
  for (int rg = blockIdx.x * 4 + warp; rg < T_ALL / RPW; rg += gridDim.x * 4) {
    const int row0 = rg * RPW;
    const float* sh = smod + (row0 < T_CTX ? 2048 : 0);
    const float* sc = sh + 1024;
    const float* src0 = row0 < T_CTX ? p.in[I_CTX] + (size_t)row0 * 1024 : p.in[I_X] + (size_t)(row0 - T_CTX) * 1024;
    float rstd[RPW];
#pragma unroll
    for (int r = 0; r < RPW; ++r) {
      float ss = 0.f;
#pragma unroll
      for (int i = 0; i < 4; ++i) {
        float4 v = *(const float4*)(src0 + (size_t)r * 1024 + i * 256 + lane * 4);
        ss += v.x * v.x + v.y * v.y + v.z * v.z + v.w * v.w;
      }
      ss = wave_sum_u(ss);
      rstd[r] = rsqrtf(ss * (1.f / 1024.f) + 1e-6f);
    }
#pragma unroll
    for (int i = 0; i < 4; ++i) {
      const int k0 = i * 256 + lane * 4;
      const float4 gk = *(const float4*)(p.in[I_N1G] + k0);
      const float4 s4 = *(const float4*)(sc + k0), h4 = *(const float4*)(sh + k0);
#pragma unroll
      for (int r = 0; r < RPW; ++r) {
        float4 v = *(const float4*)(src0 + (size_t)r * 1024 + k0);
        const float y0 = v.x * rstd[r] * gk.x * (1.f + s4.x) + h4.x, y1 = v.y * rstd[r] * gk.y * (1.f + s4.y) + h4.y;
        const float y2 = v.z * rstd[r] * gk.z * (1.f + s4.z) + h4.z, y3 = v.w * rstd[r] * gk.w * (1.f + s4.w) + h4.w;
        *(uint2*)(hx + (size_t)(row0 + r) * 1024 + k0) = make_uint2(pack2(y0, y1), pack2(y2, y3));
      }
    }
  }
}

DEVI void phase2(const Params& p, unsigned char* smem, const XcdMap& xm) {
  const int lane = threadIdx.x & 63, warp = threadIdx.x >> 6, wm = warp >> 1, wn = warp & 1;
  const bf16_t* hx = (const bf16_t*)(p.ws + R_HX);
  const bf16_t* wt = (const bf16_t*)(p.ws + R_WIN);
  bf16_t* prw = (bf16_t*)p.out;
  bf16_t* pqk = (bf16_t*)(p.ws + R_PQK);
  bf16_t* pv = (bf16_t*)(p.ws + R_PV);
  bf16_t* po = (bf16_t*)(p.ws + O_PO);
  bf16_t* pg = (bf16_t*)(p.ws + O_PG);
  for_tiles_xcd(xm, 130, 43, 5, 6, [&](int mt, int nt) {
    if (mt < 2 && nt >= 22 && nt < 42) return;
    f32x4 acc[4][4];
    zero_acc(acc);
    gemm_core(hx + (size_t)mt * 128 * 1024, 1024, wt + (size_t)nt * 128 * 1024, 1024, 1024, acc, smem);
    if (nt == 42) {
      float* gif = (float*)(p.ws + R_GIF);
      if (wn == 0) {
#pragma unroll
        for (int i = 0; i < 4; ++i) {
          const int row = mt * 128 + wm * 64 + i * 16 + (lane & 15);
          *(float4*)(gif + (size_t)row * 16 + (lane >> 4) * 4) = make_float4(acc[i][0][0], acc[i][0][1], acc[i][0][2], acc[i][0][3]);
        }
      }
      return;
    }
    bf16_t* dst; int ld, nb; int rofs = 0; bool sg = false;
    if (nt < 14) { dst = prw; ld = 1792; nb = nt * 128; }
    else if (nt < 18) { dst = pqk; ld = 512; nb = (nt - 14) * 128; }
    else if (nt < 22) { dst = pv; ld = 512; nb = (nt - 18) * 128; }
    else if (nt < 26) { dst = po; ld = 512; nb = (nt - 22) * 128; rofs = T_CTX; }
    else { dst = pg; ld = 2048; nb = (nt - 26) * 128; rofs = T_CTX; sg = true; }
    bf16_t(*Ct)[136] = (bf16_t(*)[136])smem;
#pragma unroll
    for (int i = 0; i < 4; ++i) {
#pragma unroll
      for (int j = 0; j < 4; ++j) {
        f32x4 v = acc[i][j];
        if (sg) { v[0] = sigm(v[0]); v[1] = sigm(v[1]); v[2] = sigm(v[2]); v[3] = sigm(v[3]); }
        *(uint2*)&Ct[wm * 64 + i * 16 + (lane & 15)][wn * 64 + j * 16 + (lane >> 4) * 4] = make_uint2(pack2(v[0], v[1]), pack2(v[2], v[3]));
      }
    }
    __syncthreads();
#pragma unroll
    for (int q = 0; q < 8; ++q) {
      const int pc = threadIdx.x + 256 * q; const int r = pc >> 4, c8 = (pc & 15) * 8;
      const int row = mt * 128 + r - rofs;
      *(u32x4*)(dst + (size_t)row * ld + nb + c8) = *(const u32x4*)&Ct[r][c8];
    }
    __syncthreads();
  });
}

DEVI void ml_qk8(const Params& p, int c, int j, int chan, float* o) {
  const bf16_t* pqk = (const bf16_t*)(p.ws + R_PQK);
  int row = ml_row(c, j);
  bool hp, hn; int rp, rn;
  if (c < 4) { hp = row > 0; hn = row < T_CTX - 1; rp = row - 1; rn = row + 1; }
  else { int gr = ((c - 4) & 3) * 64 + j; hp = gr > 0; hn = gr < 255; rp = row - 64; rn = row + 64; }
  const float* cw = p.in[I_MCONV];
  float cur[8], pr[8], nx[8];
  unpack8(*(const uint4*)(pqk + (size_t)row * 512 + chan), cur);
  if (hp) unpack8(*(const uint4*)(pqk + (size_t)rp * 512 + chan), pr);
  if (hn) unpack8(*(const uint4*)(pqk + (size_t)rn * 512 + chan), nx);
#pragma unroll
  for (int e = 0; e < 8; ++e) {
    float v = cw[512 + chan + e] * cur[e];
    if (hp) v += cw[chan + e] * pr[e];
    if (hn) v += cw[1024 + chan + e] * nx[e];
    o[e] = siluf(v);
  }
}

DEVI void phase3(const Params& p, unsigned char* smem) {
  bf16_t(*KT)[72] = (bf16_t(*)[72])smem;
  bf16_t(*VwT)[72] = (bf16_t(*)[72])(smem + 64 * 72 * 2);
  float* wgt = (float*)(smem + 64 * 72 * 2 + 256 * 72 * 2);
  const int tid = threadIdx.x, lane = tid & 63, warp = tid >> 6;
  const float* gif = (const float*)(p.ws + R_GIF);
  const bf16_t* pv = (const bf16_t*)(p.ws + R_PV);
  float* U = (float*)(p.ws + R_U);
  float* NT = (float*)(p.ws + O_NT);
  float* bend = (float*)(p.ws + O_BEND);
  float* mloc = (float*)(p.ws + O_MLOC);
  for (int it = blockIdx.x; it < 260 * 4; it += gridDim.x) {
    int c = it >> 2, h = it & 3;
    if (warp < 2) {
      int dir = warp; int j = dir ? 63 - lane : lane;
      int row = ml_row(c, j);
      float ig = gif[(size_t)row * 16 + dir * 4 + h] + p.in[I_MIB][dir * 4 + h];
      float lf = logsig(gif[(size_t)row * 16 + 8 + dir * 4 + h] + p.in[I_MFB][dir * 4 + h]);
      float b = lf;
#pragma unroll
      for (int o = 1; o < 64; o <<= 1) { float t = __shfl_up(b, o); if (lane >= o) b += t; }
      float be = __shfl(b, 63);
      float ge = be - b + ig;
      float ml = wave_max(ge);
      wgt[dir * 64 + j] = expf(ge - ml);
      if (lane == 0) { int sc = ml_sc(c, dir); bend[sc * 8 + dir * 4 + h] = be; mloc[sc * 8 + dir * 4 + h] = ml; }
    }
    __syncthreads();
    {
      int j = tid >> 2, part = tid & 3;
      float f[8];
#pragma unroll
      for (int q = 0; q < 2; ++q) {
        int d0 = part * 16 + q * 8;
        ml_qk8(p, c, j, 256 + h * 64 + d0, f);
#pragma unroll
        for (int e = 0; e < 8; ++e) KT[d0 + e][j] = f2bf(f[e] * 0.125f);
      }
      int row = ml_row(c, j);
      float w0 = wgt[j], w1 = wgt[64 + j];
#pragma unroll
      for (int q = 0; q < 4; ++q) {
        int v0 = part * 32 + q * 8;
        unpack8(*(const uint4*)(pv + (size_t)row * 512 + h * 128 + v0), f);
#pragma unroll
        for (int e = 0; e < 8; ++e) { VwT[v0 + e][j] = f2bf(f[e] * w0); VwT[128 + v0 + e][j] = f2bf(f[e] * w1); }
      }
    }
    __syncthreads();
#pragma unroll
    for (int dir = 0; dir < 2; ++dir) {
      int sc = ml_sc(c, dir);
      float* Ud = U + ((size_t)sc * 8 + dir * 4 + h) * 8192;
#pragma unroll
      for (int vi = 0; vi < 2; ++vi) {
        int vt = warp * 2 + vi;
        bf16x8 bv[2];
#pragma unroll
        for (int ks = 0; ks < 2; ++ks) bv[ks] = *(const bf16x8*)&VwT[dir * 128 + vt * 16 + (lane & 15)][ks * 32 + (lane >> 4) * 8];
#pragma unroll
        for (int dt = 0; dt < 4; ++dt) {
          f32x4 a = {0.f, 0.f, 0.f, 0.f};
#pragma unroll
          for (int ks = 0; ks < 2; ++ks) {
            bf16x8 ak = *(const bf16x8*)&KT[dt * 16 + (lane & 15)][ks * 32 + (lane >> 4) * 8];
            a = __builtin_amdgcn_mfma_f32_16x16x32_bf16(ak, bv[ks], a, 0, 0, 0);
          }
          *(float4*)(Ud + (size_t)(vt * 16 + (lane & 15)) * 64 + dt * 16 + (lane >> 4) * 4) = make_float4(a[0], a[1], a[2], a[3]);
        }
      }
    }
    if (tid < 128) {
      int dir = tid >> 6, d = tid & 63; float s = 0.f;
      for (int j = 0; j < 64; ++j) s += wgt[dir * 64 + j] * bf2f(KT[d][j]);
      NT[((size_t)ml_sc(c, dir) * 8 + dir * 4 + h) * 64 + d] = s;
    }
    __syncthreads();
  }
}

template <bool DRY> DEVI void phase4(const Params& p, unsigned char* smem) {
  const bool wr = !DRY || (p.in[I_FG][0] == 1234.5f);
  float* U = (float*)(p.ws + R_U);
  float* NT = (float*)(p.ws + O_NT);
  const float* bend = (const float*)(p.ws + O_BEND);
  const float* mloc = (const float*)(p.ws + O_MLOC);
  float* mst = (float*)(p.ws + O_MST);
  float(*kp)[264] = (float(*)[264])smem;
  float(*sp)[264] = (float(*)[264])(smem + 2 * 264 * 4);
  const int tid = threadIdx.x, lane = tid & 63, warp = tid >> 6;
  for (int gb = blockIdx.x * 256; gb < 8 * 8256; gb += gridDim.x * 256) {
    const int pA = gb / 8256;
    if (warp < 2) {
      const int pw = pA + warp;
      if (pw < 8) {
        float be[5], ml[5], B[5], m[5];
        float run = 0.f;
#pragma unroll
        for (int k = 0; k < 5; ++k) {
          const int c = lane * 5 + k;
          be[k] = c < 260 ? bend[c * 8 + pw] : 0.f;
          ml[k] = c < 260 ? mloc[c * 8 + pw] : -INFINITY;
          run += be[k]; B[k] = run;
        }
        float incl = run;
#pragma unroll
        for (int o = 1; o < 64; o <<= 1) { float t = __shfl_up(incl, o); if (lane >= o) incl += t; }
        const float off = incl - run;
        float pm = -INFINITY, pml[5];
#pragma unroll
        for (int k = 0; k < 5; ++k) { B[k] += off; pm = fmaxf(pm, ml[k] - B[k]); pml[k] = pm; }
        float inclm = pm;
#pragma unroll
        for (int o = 1; o < 64; o <<= 1) { float t = __shfl_up(inclm, o); if (lane >= o) inclm = fmaxf(inclm, t); }
        float offm = __shfl_up(inclm, 1); if (lane == 0) offm = -INFINITY;
#pragma unroll
        for (int k = 0; k < 5; ++k) m[k] = B[k] + fmaxf(0.f, fmaxf(offm, pml[k]));
        float mprev = __shfl_up(m[4], 1); if (lane == 0) mprev = 0.f;
        const bool owner = gb <= pw * 8256 && pw * 8256 < gb + 256;
#pragma unroll
        for (int k = 0; k < 5; ++k) {
          const int c = lane * 5 + k;
          if (c < 260) {
            kp[warp][c] = expf(be[k] + mprev - m[k]);
            sp[warp][c] = expf(ml[k] - m[k]);
            if (wr && owner) mst[c * 8 + pw] = mprev;
          }
          mprev = m[k];
        }
      }
    }
    __syncthreads();
    const int g = gb + tid;
    if (g < 8 * 8256) {
      const int pr = g / 8256, e = g % 8256, slot = pr - pA;
      float* base; size_t stride;
      if (e < 8192) { base = U + (size_t)pr * 8192 + e; stride = 8 * 8192; }
      else { base = NT + (size_t)pr * 64 + (e - 8192); stride = 8 * 64; }
      float C = 0.f;
      for (int sc = 0; sc < 260; sc += 20) {
        float u[20];
#pragma unroll
        for (int q = 0; q < 20; ++q) u[q] = base[(size_t)(sc + q) * stride];
#pragma unroll
        for (int q = 0; q < 20; ++q) {
          if (wr) base[(size_t)(sc + q) * stride] = C;
          C = kp[slot][sc + q] * C + sp[slot][sc + q] * u[q];
        }
      }
    }
    __syncthreads();
  }
}

template <bool DRY> DEVI void phase5(const Params& p, unsigned char* smem) {
  const bool wr = !DRY || (p.in[I_FG][0] == 1234.5f);
  bf16_t(*Qs)[72] = (bf16_t(*)[72])smem;
  bf16_t(*Ks)[72] = (bf16_t(*)[72])(smem + 9216);
  bf16_t(*Pm)[72] = (bf16_t(*)[72])(smem + 2 * 9216);
  bf16_t(*VT)[72] = (bf16_t(*)[72])(smem + 3 * 9216);
  float* evec = (float*)(smem + 3 * 9216 + 144 * 72 * 2);
  float* Mvec = evec + 128;
  float* bvec = Mvec + 128;
  const int tid = threadIdx.x, lane = tid & 63, warp = tid >> 6;
  const float* gif = (const float*)(p.ws + R_GIF);
  const bf16_t* pv = (const bf16_t*)(p.ws + R_PV);
  const bf16_t* po = (const bf16_t*)(p.ws + O_PO);
  bf16_t* yb = (bf16_t*)(p.ws + R_YA);
  const float* U = (const float*)(p.ws + R_U);
  const float* NT = (const float*)(p.ws + O_NT);
  const float* mst = (const float*)(p.ws + O_MST);
  for (int it = blockIdx.x; it < 256 * 4; it += gridDim.x) {
    int c = 4 + (it >> 2), h = it & 3;
    if (warp < 2) {
      int dir = warp; int j = dir ? 63 - lane : lane;
      int row = ml_row(c, j);
      float ig = gif[(size_t)row * 16 + dir * 4 + h] + p.in[I_MIB][dir * 4 + h];
      float lf = logsig(gif[(size_t)row * 16 + 8 + dir * 4 + h] + p.in[I_MFB][dir * 4 + h]);
      float b = lf;
#pragma unroll
      for (int o = 1; o < 64; o <<= 1) { float t = __shfl_up(b, o); if (lane >= o) b += t; }
      float e = ig - b;
      float pm = e;
#pragma unroll
      for (int o = 1; o < 64; o <<= 1) { float t = __shfl_up(pm, o); if (lane >= o) pm = fmaxf(pm, t); }
      float m0 = mst[ml_sc(c, dir) * 8 + dir * 4 + h];
      evec[dir * 64 + j] = e; Mvec[dir * 64 + j] = fmaxf(m0, pm); bvec[dir * 64 + j] = b;
    }
    {
      int j = tid >> 2, part = tid & 3;
      float f[8];
#pragma unroll
      for (int q = 0; q < 2; ++q) {
        int d0 = part * 16 + q * 8;
        ml_qk8(p, c, j, h * 64 + d0, f);
        *(uint4*)&Qs[j][d0] = pack8(f);
        ml_qk8(p, c, j, 256 + h * 64 + d0, f);
#pragma unroll
        for (int e = 0; e < 8; ++e) f[e] *= 0.125f;
        *(uint4*)&Ks[j][d0] = pack8(f);
      }
      int row = ml_row(c, j);
#pragma unroll
      for (int q = 0; q < 4; ++q) {
        int v0 = part * 32 + q * 8;
        unpack8(*(const uint4*)(pv + (size_t)row * 512 + h * 128 + v0), f);
#pragma unroll
        for (int e = 0; e < 8; ++e) VT[v0 + e][j] = f2bf(f[e]);
      }
      for (int i = tid; i < 16 * 64; i += 256) VT[128 + (i >> 6)][i & 63] = (i < 64) ? (bf16_t)0x3f80 : (bf16_t)0;
    }
    __syncthreads();
    const int jl = warp * 16 + (lane & 15);
    f32x4 s0[4];
    bf16x8 qf[2];
#pragma unroll
    for (int ks = 0; ks < 2; ++ks) qf[ks] = *(const bf16x8*)&Qs[jl][ks * 32 + (lane >> 4) * 8];
#pragma unroll
    for (int st = 0; st < 4; ++st) {
      f32x4 a = {0.f, 0.f, 0.f, 0.f};
#pragma unroll
      for (int ks = 0; ks < 2; ++ks) {
        bf16x8 kf = *(const bf16x8*)&Ks[st * 16 + (lane & 15)][ks * 32 + (lane >> 4) * 8];
        a = __builtin_amdgcn_mfma_f32_16x16x32_bf16(kf, qf[ks], a, 0, 0, 0);
      }
      s0[st] = a;
    }
    f32x4 ysum[8];
#pragma unroll
    for (int vt = 0; vt < 8; ++vt) ysum[vt] = f32x4{0.f, 0.f, 0.f, 0.f};
#pragma unroll 1
    for (int dir = 0; dir < 2; ++dir) {
      float Mj = Mvec[dir * 64 + jl], bj = bvec[dir * 64 + jl];
      float m0 = mst[ml_sc(c, dir) * 8 + dir * 4 + h];
#pragma unroll
      for (int st = 0; st < 4; ++st) {
        float pvv[4];
#pragma unroll
        for (int r = 0; r < 4; ++r) {
          int s = st * 16 + (lane >> 4) * 4 + r;
          bool ok = dir == 0 ? (s <= jl) : (s >= jl);
          pvv[r] = ok ? s0[st][r] * expf(evec[dir * 64 + s] - Mj) : 0.f;
        }
        *(uint2*)&Pm[jl][st * 16 + (lane >> 4) * 4] = make_uint2(pack2(pvv[0], pvv[1]), pack2(pvv[2], pvv[3]));
      }
      __syncthreads();
      bf16x8 pf[2];
#pragma unroll
      for (int ks = 0; ks < 2; ++ks) pf[ks] = *(const bf16x8*)&Pm[jl][ks * 32 + (lane >> 4) * 8];
      const float* Cst = U + ((size_t)ml_sc(c, dir) * 8 + dir * 4 + h) * 8192;
      const float* nst = NT + ((size_t)ml_sc(c, dir) * 8 + dir * 4 + h) * 64;
      float ai = expf(m0 - Mj);
      f32x4 hh[9];
#pragma unroll
      for (int vt = 0; vt < 9; ++vt) {
        f32x4 a1 = {0.f, 0.f, 0.f, 0.f}, a2 = {0.f, 0.f, 0.f, 0.f};
#pragma unroll
        for (int ks = 0; ks < 2; ++ks) {
          bf16x8 vf = *(const bf16x8*)&VT[vt * 16 + (lane & 15)][ks * 32 + (lane >> 4) * 8];
          a1 = __builtin_amdgcn_mfma_f32_16x16x32_bf16(vf, pf[ks], a1, 0, 0, 0);
          int v = vt * 16 + (lane & 15);
          const float* cp = v < 128 ? Cst + (size_t)v * 64 + ks * 32 + (lane >> 4) * 8 : nst + ks * 32 + (lane >> 4) * 8;
          float cf[8];
          if (v <= 128) {
            float4 x0 = *(const float4*)cp, x1 = *(const float4*)(cp + 4);
            cf[0] = x0.x; cf[1] = x0.y; cf[2] = x0.z; cf[3] = x0.w; cf[4] = x1.x; cf[5] = x1.y; cf[6] = x1.z; cf[7] = x1.w;
          } else {
#pragma unroll
            for (int e = 0; e < 8; ++e) cf[e] = 0.f;
          }
          uint4 pk = pack8(cf);
          bf16x8 cfr;
          cfr[0] = (short)(pk.x & 0xffff); cfr[1] = (short)(pk.x >> 16); cfr[2] = (short)(pk.y & 0xffff); cfr[3] = (short)(pk.y >> 16);
          cfr[4] = (short)(pk.z & 0xffff); cfr[5] = (short)(pk.z >> 16); cfr[6] = (short)(pk.w & 0xffff); cfr[7] = (short)(pk.w >> 16);
          a2 = __builtin_amdgcn_mfma_f32_16x16x32_bf16(cfr, qf[ks], a2, 0, 0, 0);
        }
#pragma unroll
        for (int r = 0; r < 4; ++r) hh[vt][r] = a1[r] + ai * a2[r];
      }
      float den = __shfl(hh[8][0], lane & 15);
      float dn = fmaxf(fabsf(den), expf(-(bj + Mj)));
      float inv = 1.f / dn;
      float ss = 0.f;
#pragma unroll
      for (int vt = 0; vt < 8; ++vt)
#pragma unroll
        for (int r = 0; r < 4; ++r) { float x = hh[vt][r] * inv; hh[vt][r] = x; ss += x * x; }
      ss += __shfl_xor(ss, 16); ss += __shfl_xor(ss, 32);
      float rs = rsqrtf(ss * (1.f / 128.f) + 1e-6f);
#pragma unroll
      for (int vt = 0; vt < 8; ++vt)
#pragma unroll
        for (int r = 0; r < 4; ++r) ysum[vt][r] += hh[vt][r] * rs * p.in[I_MNG][h * 128 + vt * 16 + (lane >> 4) * 4 + r];
      __syncthreads();
    }
    {
      int row = ml_row(c, jl) - T_CTX;
#pragma unroll
      for (int vt = 0; vt < 8; ++vt) {
        const bf16_t* op = po + (size_t)row * 512 + h * 128 + vt * 16 + (lane >> 4) * 4;
        uint2 o = *(const uint2*)op;
        float y0 = ysum[vt][0] * sigm(bflo(o.x)), y1 = ysum[vt][1] * sigm(bfhi(o.x)), y2 = ysum[vt][2] * sigm(bflo(o.y)), y3 = ysum[vt][3] * sigm(bfhi(o.y));
        if (wr) *(uint2*)(yb + (size_t)row * 512 + h * 128 + vt * 16 + (lane >> 4) * 4) = make_uint2(pack2(y0, y1), pack2(y2, y3));
      }
    }
    __syncthreads();
  }
}

DEVI void phase6(const Params& p, unsigned char* smem, int item_lo, int item_hi, int blk0, int nblk) {
  float(*rs)[65] = (float(*)[65])smem;
  float(*ks)[65] = (float(*)[65])(smem + 64 * 65 * 4);
  bf16_t(*TW)[72] = (bf16_t(*)[72])(smem + 2 * 64 * 65 * 4);
  bf16_t(*TA)[72] = (bf16_t(*)[72])(smem + 2 * 64 * 65 * 4 + 9216);
  bf16_t(*TG)[136] = (bf16_t(*)[136])(smem + 2 * 64 * 65 * 4 + 2 * 9216);
  float* rn = (float*)(smem + 2 * 64 * 65 * 4 + 2 * 9216 + 64 * 136 * 2);
  const int tid = threadIdx.x, lane = tid & 63, warp = tid >> 6;
  const bf16_t* prw = (const bf16_t*)p.out;
  bf16_t* SV = (bf16_t*)(p.ws + R_SV);
  float* bonus = (float*)(p.ws + O_BONUS);
  const float* cw = p.in[I_RCONV];
  const bf16_t* WUP = (const bf16_t*)(p.ws + O_WUP);
  const bf16_t* AUP = (const bf16_t*)(p.ws + O_AUP);
  const bf16_t* GUP = (const bf16_t*)(p.ws + O_GUP);
  if ((int)blockIdx.x < blk0) return;
  for (int it = item_lo + ((int)blockIdx.x - blk0); it < item_hi; it += nblk) {
    int tile = it >> 3, head = it & 7;
    int row0 = tile * 64;
    int seg0 = tile < 4 ? 0 : row0, seg1 = tile < 4 ? T_CTX : row0 + 64;
#pragma unroll 1
    for (int ub = 0; ub < 2; ++ub) {
      u32x4 lc[7], lp[7], ln[7];
#pragma unroll
      for (int it7 = 0; it7 < 7; ++it7) {
        const int u = warp + 4 * (ub * 7 + it7);
        const int grp = u >> 3;
        const int j = (u & 7) * 8 + (lane >> 3), q = grp * 8 + (lane & 7);
        const int row = row0 + j;
        const int col = q < 24 ? (q >> 3) * 512 + head * 64 + (q & 7) * 8 : 1536 + (q - 24) * 8;
        const bool hp = row > seg0, hn = row < seg1 - 1;
        lc[it7] = *(const u32x4*)(prw + (size_t)row * 1792 + col);
        lp[it7] = hp ? *(const u32x4*)(prw + (size_t)(row - 1) * 1792 + col) : u32x4{0u, 0u, 0u, 0u};
        ln[it7] = hn ? *(const u32x4*)(prw + (size_t)(row + 1) * 1792 + col) : u32x4{0u, 0u, 0u, 0u};
      }
#pragma unroll
      for (int it7 = 0; it7 < 7; ++it7) {
        const int u = warp + 4 * (ub * 7 + it7);
        const int grp = u >> 3;
        const int j = (u & 7) * 8 + (lane >> 3), q = grp * 8 + (lane & 7);
        const int row = row0 + j;
        const int col = q < 24 ? (q >> 3) * 512 + head * 64 + (q & 7) * 8 : 1536 + (q - 24) * 8;
        float cur[8], pr[8], nx[8], o[8];
        unpack8(make_uint4(lc[it7][0], lc[it7][1], lc[it7][2], lc[it7][3]), cur);
        unpack8(make_uint4(lp[it7][0], lp[it7][1], lp[it7][2], lp[it7][3]), pr);
        unpack8(make_uint4(ln[it7][0], ln[it7][1], ln[it7][2], ln[it7][3]), nx);
        {
          float4 c0 = *(const float4*)(cw + col), c1 = *(const float4*)(cw + col + 4);
          float4 d0 = *(const float4*)(cw + 1792 + col), d1 = *(const float4*)(cw + 1792 + col + 4);
          float4 e0 = *(const float4*)(cw + 3584 + col), e1 = *(const float4*)(cw + 3584 + col + 4);
          float wp[8] = {c0.x, c0.y, c0.z, c0.w, c1.x, c1.y, c1.z, c1.w};
          float wc[8] = {d0.x, d0.y, d0.z, d0.w, d1.x, d1.y, d1.z, d1.w};
          float wn_[8] = {e0.x, e0.y, e0.z, e0.w, e1.x, e1.y, e1.z, e1.w};
#pragma unroll
          for (int e = 0; e < 8; ++e) o[e] = wc[e] * cur[e] + wp[e] * pr[e] + wn_[e] * nx[e];
        }
        if (grp == 0) {
#pragma unroll
          for (int e = 0; e < 8; ++e) rs[j][(q & 7) * 8 + e] = o[e];
        } else if (grp == 1) {
#pragma unroll
          for (int e = 0; e < 8; ++e) ks[j][(q & 7) * 8 + e] = o[e];
        } else if (grp == 2) {
          *(uint4*)(SV + ((size_t)row * 8 + head) * SVH + 2 * 64 + (q & 7) * 8) = pack8(o);
        } else if (grp == 3) {
#pragma unroll
          for (int e = 0; e < 8; ++e) o[e] = 1.f - 2.f / (1.f + __expf(2.f * o[e]));
          *(uint4*)&TW[j][(q - 24) * 8] = pack8(o);
        } else if (grp == 4) {
          *(uint4*)&TA[j][(q - 32) * 8] = pack8(o);
        } else {
#pragma unroll
          for (int e = 0; e < 8; ++e) o[e] = sigm(o[e]);
          *(uint4*)&TG[j][(q - 40) * 8] = pack8(o);
        }
      }
    }
    __syncthreads();
    {
      int j = tid >> 2, part = tid & 3; float ss = 0.f;
#pragma unroll
      for (int e = 0; e < 16; ++e) { float v = ks[j][part * 16 + e] * p.in[I_RKK][head * 64 + part * 16 + e]; ss += v * v; }
      ss += __shfl_xor(ss, 1); ss += __shfl_xor(ss, 2);
      if (part == 0) rn[j] = 1.f / fmaxf(sqrtf(ss), 1e-12f);
    }
    __syncthreads();
    for (int pc = tid; pc < 64 * 8; pc += 256) {
      int j = pc >> 3, c8 = (pc & 7) * 8; int row = row0 + j;
      float fr[8], fk[8], fkk[8];
#pragma unroll
      for (int e = 0; e < 8; ++e) { fr[e] = rs[j][c8 + e]; fk[e] = ks[j][c8 + e]; fkk[e] = fk[e] * p.in[I_RKK][head * 64 + c8 + e] * rn[j]; }
      bf16_t* b = SV + ((size_t)row * 8 + head) * SVH;
      *(uint4*)(b + 0 * 64 + c8) = pack8(fr);
      *(uint4*)(b + 1 * 64 + c8) = pack8(fk);
      *(uint4*)(b + 3 * 64 + c8) = pack8(fkk);
    }
    {
      const int jl = warp * 16 + (lane & 15); const int row = row0 + jl;
      bf16x8 tw[2], ta[2], tg[4];
#pragma unroll
      for (int s2 = 0; s2 < 2; ++s2) { tw[s2] = *(const bf16x8*)&TW[jl][s2 * 32 + (lane >> 4) * 8]; ta[s2] = *(const bf16x8*)&TA[jl][s2 * 32 + (lane >> 4) * 8]; }
#pragma unroll
      for (int s2 = 0; s2 < 4; ++s2) tg[s2] = *(const bf16x8*)&TG[jl][s2 * 32 + (lane >> 4) * 8];
      __syncthreads();
      bf16_t(*OB)[64][72] = (bf16_t(*)[64][72])(smem + 2 * 64 * 65 * 4);
      float bon[2] = {0.f, 0.f};
#pragma unroll
      for (int dir = 0; dir < 2; ++dir) {
#pragma unroll
        for (int ct = 0; ct < 4; ++ct) {
          const int ch0 = ct * 16 + (lane >> 4) * 4;
          const int C0 = head * 64 + ch0;
          if (dir == 0) {
            f32x4 a = {0.f, 0.f, 0.f, 0.f};
#pragma unroll
            for (int s2 = 0; s2 < 4; ++s2) {
              bf16x8 wf = *(const bf16x8*)(GUP + (size_t)(head * 64 + ct * 16 + (lane & 15)) * 128 + s2 * 32 + (lane >> 4) * 8);
              a = __builtin_amdgcn_mfma_f32_16x16x32_bf16(wf, tg[s2], a, 0, 0, 0);
            }
            *(uint2*)&OB[2][jl][ch0] = make_uint2(pack2(a[0], a[1]), pack2(a[2], a[3]));
          }
          f32x4 aw = {0.f, 0.f, 0.f, 0.f}, aa = {0.f, 0.f, 0.f, 0.f};
#pragma unroll
          for (int s2 = 0; s2 < 2; ++s2) {
            size_t wo = (size_t)(dir * 512 + head * 64 + ct * 16 + (lane & 15)) * 64 + s2 * 32 + (lane >> 4) * 8;
            bf16x8 wf = *(const bf16x8*)(WUP + wo);
            bf16x8 af = *(const bf16x8*)(AUP + wo);
            aw = __builtin_amdgcn_mfma_f32_16x16x32_bf16(wf, tw[s2], aw, 0, 0, 0);
            aa = __builtin_amdgcn_mfma_f32_16x16x32_bf16(af, ta[s2], aa, 0, 0, 0);
          }
          const float4 w04 = *(const float4*)(p.in[I_RW0] + dir * 512 + C0), a04 = *(const float4*)(p.in[I_RA0] + dir * 512 + C0);
          const float4 ka4 = *(const float4*)(p.in[I_RKA] + C0), rk4 = *(const float4*)(p.in[I_RRK] + C0);
          const float w0v[4] = {w04.x, w04.y, w04.z, w04.w}, a0v[4] = {a04.x, a04.y, a04.z, a04.w};
          const float kav[4] = {ka4.x, ka4.y, ka4.z, ka4.w}, rkv[4] = {rk4.x, rk4.y, rk4.z, rk4.w};
          float we[4], av[4];
#pragma unroll
          for (int r = 0; r < 4; ++r) {
            we[r] = (0.60653066f * 1.44269504f) * sigm(w0v[r] + aw[r]);
            av[r] = sigm(a0v[r] + aa[r]);
            float kv = ks[jl][ch0 + r];
            float keff = kv * (1.f + (av[r] - 1.f) * kav[r]);
            bon[dir] += rs[jl][ch0 + r] * keff * rkv[r];
          }
          *(uint2*)&OB[0][jl][ch0] = make_uint2(pack2(we[0], we[1]), pack2(we[2], we[3]));
          *(uint2*)&OB[1][jl][ch0] = make_uint2(pack2(av[0], av[1]), pack2(av[2], av[3]));
        }
        __syncthreads();
        for (int pc = tid; pc < (dir == 0 ? 3 : 2) * 64 * 8; pc += 256) {
          const int vsel = pc >> 9, j = (pc >> 3) & 63, c8 = (pc & 7) * 8;
          const int vec = vsel == 2 ? 8 : (4 + 2 * dir + vsel);
          *(u32x4*)(SV + ((size_t)(row0 + j) * 8 + head) * SVH + vec * 64 + c8) = *(const u32x4*)&OB[vsel][j][c8];
        }
        __syncthreads();
      }
#pragma unroll
      for (int dir = 0; dir < 2; ++dir) {
        float sb = bon[dir]; sb += __shfl_xor(sb, 16); sb += __shfl_xor(sb, 32);
        if (lane < 16) bonus[(size_t)row * 16 + dir * 8 + head] = sb;
      }
    }
    __syncthreads();
  }
}

struct RwVec { uint4 k, kk, w, a, v, r; };
DEVI void unpack8p(const uint4& u, f32x2* f) {
  f[0] = f32x2{bflo(u.x), bfhi(u.x)}; f[1] = f32x2{bflo(u.y), bfhi(u.y)}; f[2] = f32x2{bflo(u.z), bfhi(u.z)}; f[3] = f32x2{bflo(u.w), bfhi(u.w)};
}
DEVI f32x2 bc2(float x) { return f32x2{x, x}; }
DEVI void rw_load(RwVec& x, const bf16_t* SV, int row, int head, int dir, int i, int jg, bool need_r) {
  const bf16_t* b = SV + ((size_t)row * 8 + head) * SVH;
  x.k = *(const uint4*)(b + 1 * 64 + jg * 8);
  x.kk = *(const uint4*)(b + 3 * 64 + jg * 8);
  x.w = *(const uint4*)(b + (4 + 2 * dir) * 64 + jg * 8);
  x.a = *(const uint4*)(b + (5 + 2 * dir) * 64 + jg * 8);
  x.v = *(const uint4*)(b + 2 * 64 + i * 8);
  if (need_r) x.r = *(const uint4*)(b + 0 * 64 + jg * 8);
}

DEVI void phase7(const Params& p) {
  const int lane = threadIdx.x & 63, warp = threadIdx.x >> 6, i = lane >> 3, jg = lane & 7;
  const bf16_t* SV = (const bf16_t*)(p.ws + R_SV);
  float* Pc = (float*)p.out;
  float* Bc = (float*)((unsigned char*)p.out + OUT_BC);
  for (int it = blockIdx.x * 4 + warp; it < (NCH - 1) * 16; it += gridDim.x * 4) {
    const int chunk = it >> 4, pair = it & 15, dir = pair >> 3, head = pair & 7;
    f32x2 S[8][4], P[8][4], ka[4];
#pragma unroll
    for (int a = 0; a < 8; ++a)
#pragma unroll
      for (int c = 0; c < 4; ++c) {
        S[a][c] = f32x2{0.f, 0.f};
        P[a][c] = f32x2{(i * 8 + a == jg * 8 + 2 * c) ? 1.f : 0.f, (i * 8 + a == jg * 8 + 2 * c + 1) ? 1.f : 0.f};
      }
#pragma unroll
    for (int c = 0; c < 4; ++c) ka[c] = f32x2{p.in[I_RKA][head * 64 + jg * 8 + 2 * c], p.in[I_RKA][head * 64 + jg * 8 + 2 * c + 1]};
    RwVec nx;
    rw_load(nx, SV, rw_row(chunk * LCH, dir), head, dir, i, jg, false);
#pragma unroll 1
    for (int t = 0; t < LCH; ++t) {
      RwVec cu = nx;
      if (t + 1 < LCH) rw_load(nx, SV, rw_row(chunk * LCH + t + 1, dir), head, dir, i, jg, false);
      f32x2 kv[4], kk[4], w[4], av[4], kka[4], keff[4]; float vv[8];
      unpack8p(cu.k, kv); unpack8p(cu.kk, kk); unpack8p(cu.w, w); unpack8p(cu.a, av); unpack8(cu.v, vv);
#pragma unroll
      for (int c = 0; c < 4; ++c) {
        w[c] = f32x2{__builtin_amdgcn_exp2f(-w[c][0]), __builtin_amdgcn_exp2f(-w[c][1])};
        kka[c] = -kk[c] * av[c];
        keff[c] = kv[c] * (bc2(1.f) + (av[c] - bc2(1.f)) * ka[c]);
      }
#pragma unroll
      for (int a = 0; a < 8; ++a) {
        f32x2 sa = S[a][0] * kk[0], qa = P[a][0] * kk[0];
#pragma unroll
        for (int c = 1; c < 4; ++c) { sa += S[a][c] * kk[c]; qa += P[a][c] * kk[c]; }
        float s1 = allred8(sa[0] + sa[1]), q1 = allred8(qa[0] + qa[1]);
        const f32x2 s2 = bc2(s1), q2 = bc2(q1), v2 = bc2(vv[a]);
#pragma unroll
        for (int c = 0; c < 4; ++c) {
          S[a][c] = S[a][c] * w[c] + s2 * kka[c] + v2 * keff[c];
          P[a][c] = P[a][c] * w[c] + q2 * kka[c];
        }
      }
    }
    float* po = Pc + ((size_t)chunk * 16 + pair) * 4096;
    float* bo = Bc + ((size_t)chunk * 16 + pair) * 4096;
#pragma unroll
    for (int a = 0; a < 8; ++a) {
      *(float4*)(po + (i * 8 + a) * 64 + jg * 8) = make_float4(P[a][0][0], P[a][0][1], P[a][1][0], P[a][1][1]);
      *(float4*)(po + (i * 8 + a) * 64 + jg * 8 + 4) = make_float4(P[a][2][0], P[a][2][1], P[a][3][0], P[a][3][1]);
      *(float4*)(bo + (i * 8 + a) * 64 + jg * 8) = make_float4(S[a][0][0], S[a][0][1], S[a][1][0], S[a][1][1]);
      *(float4*)(bo + (i * 8 + a) * 64 + jg * 8 + 4) = make_float4(S[a][2][0], S[a][2][1], S[a][3][0], S[a][3][1]);
    }
  }
}

template <bool DRY> DEVI void phase8(const Params& p, unsigned char* smem) {
  const bool wr = !DRY || (p.in[I_FG][0] == 1234.5f);
  float(*Sb)[16][68] = (float(*)[16][68])smem;
  const int tid = threadIdx.x, lane = tid & 63, warp = tid >> 6, q = lane >> 4, c16 = lane & 15;
  const float* Pc = (const float*)p.out;
  float* Bc = (float*)((unsigned char*)p.out + OUT_BC);
  constexpr int NS = NCH - 1;
  const size_t CS = (size_t)16 * 4096;
  for (int it = blockIdx.x; it < 64; it += gridDim.x) {
    const int pair = it >> 2, rg = it & 3;
    const float* Pp = Pc + (size_t)pair * 4096 + q * 64 + warp * 16 + c16;
    float* Bp = Bc + (size_t)pair * 4096 + (size_t)(rg * 16 + q * 4) * 64 + warp * 16 + c16;
    __syncthreads();
    {
      const int row = tid >> 4, c4 = (tid & 15) * 4;
      float4 v = *(const float4*)(Bc + (size_t)pair * 4096 + (size_t)(rg * 16 + row) * 64 + c4);
      Sb[0][row][c4] = v.x; Sb[0][row][c4 + 1] = v.y; Sb[0][row][c4 + 2] = v.z; Sb[0][row][c4 + 3] = v.w;
    }
    float pa[16], pb[16]; f32x4 ba, bb;
#pragma unroll
    for (int s2 = 0; s2 < 16; ++s2) { pa[s2] = Pp[CS + s2 * 256]; pb[s2] = Pp[2 * CS + s2 * 256]; }
#pragma unroll
    for (int r = 0; r < 4; ++r) { ba[r] = Bp[CS + r * 64]; bb[r] = Bp[2 * CS + r * 64]; }
    __syncthreads();
#define P8_STEP(c, pp, bv)                                                                                  \
    {                                                                                                        \
      const int rb = ((c) - 1) & 1;                                                                          \
      f32x4 acc0 = bv, acc1 = f32x4{0.f, 0.f, 0.f, 0.f};                                                     \
      _Pragma("unroll") for (int s2 = 0; s2 < 16; s2 += 2) {                                                 \
        acc0 = __builtin_amdgcn_mfma_f32_16x16x4f32(Sb[rb][c16][4 * s2 + q], pp[s2], acc0, 0, 0, 0);         \
        acc1 = __builtin_amdgcn_mfma_f32_16x16x4f32(Sb[rb][c16][4 * s2 + 4 + q], pp[s2 + 1], acc1, 0, 0, 0); \
      }                                                                                                      \
      acc0 += acc1;                                                                                          \
      if ((c) + 2 < NS) {                                                                                    \
        _Pragma("unroll") for (int s2 = 0; s2 < 16; ++s2) pp[s2] = Pp[(size_t)((c) + 2) * CS + s2 * 256];    \
        _Pragma("unroll") for (int r = 0; r < 4; ++r) bv[r] = Bp[(size_t)((c) + 2) * CS + r * 64];           \
      }                                                                                                      \
      _Pragma("unroll") for (int r = 0; r < 4; ++r) {                                                        \
        Sb[rb ^ 1][q * 4 + r][warp * 16 + c16] = acc0[r];                                                    \
        if (wr) Bp[(size_t)(c) * CS + r * 64] = acc0[r];                                                     \
      }                                                                                                      \
      __syncthreads();                                                                                       \
    }
    for (int c = 1; c < NS; c += 2) {
      P8_STEP(c, pa, ba)
      if (c + 1 < NS) P8_STEP(c + 1, pb, bb)
    }
#undef P8_STEP
  }
}

DEVI void phase9(const Params& p) {
  const int lane = threadIdx.x & 63, warp = threadIdx.x >> 6, i = lane >> 3, jg = lane & 7;
  const bf16_t* SV = (const bf16_t*)(p.ws + R_SV);
  const float* Bc = (const float*)((unsigned char*)p.out + OUT_BC);
  bf16_t* odir = (bf16_t*)p.out;
  for (int it = blockIdx.x * 4 + warp; it < NCH * 16; it += gridDim.x * 4) {
    const int chunk = it >> 4, pair = it & 15, dir = pair >> 3, head = pair & 7;
    f32x2 S[8][4], ka[4];
    if (chunk == 0) {
#pragma unroll
      for (int a = 0; a < 8; ++a)
#pragma unroll
        for (int c = 0; c < 4; ++c) S[a][c] = f32x2{0.f, 0.f};
    } else {
      const float* bs = Bc + ((size_t)(chunk - 1) * 16 + pair) * 4096;
#pragma unroll
      for (int a = 0; a < 8; ++a) {
        float4 x0 = *(const float4*)(bs + (i * 8 + a) * 64 + jg * 8), x1 = *(const float4*)(bs + (i * 8 + a) * 64 + jg * 8 + 4);
        S[a][0] = f32x2{x0.x, x0.y}; S[a][1] = f32x2{x0.z, x0.w}; S[a][2] = f32x2{x1.x, x1.y}; S[a][3] = f32x2{x1.z, x1.w};
      }
    }
#pragma unroll
    for (int c = 0; c < 4; ++c) ka[c] = f32x2{p.in[I_RKA][head * 64 + jg * 8 + 2 * c], p.in[I_RKA][head * 64 + jg * 8 + 2 * c + 1]};
    RwVec nx;
    rw_load(nx, SV, rw_row(chunk * LCH, dir), head, dir, i, jg, true);
#pragma unroll 1
    for (int t = 0; t < LCH; ++t) {
      RwVec cu = nx;
      const int row = rw_row(chunk * LCH + t, dir);
      if (t + 1 < LCH) rw_load(nx, SV, rw_row(chunk * LCH + t + 1, dir), head, dir, i, jg, true);
      f32x2 kv[4], kk[4], w[4], av[4], rr[4], kka[4], keff[4]; float vv[8];
      unpack8p(cu.k, kv); unpack8p(cu.kk, kk); unpack8p(cu.w, w); unpack8p(cu.a, av); unpack8p(cu.r, rr); unpack8(cu.v, vv);
#pragma unroll
      for (int c = 0; c < 4; ++c) {
        w[c] = f32x2{__builtin_amdgcn_exp2f(-w[c][0]), __builtin_amdgcn_exp2f(-w[c][1])};
        kka[c] = -kk[c] * av[c];
        keff[c] = kv[c] * (bc2(1.f) + (av[c] - bc2(1.f)) * ka[c]);
      }
      float ov = 0.f;
#pragma unroll
      for (int a = 0; a < 8; ++a) {
        f32x2 sa = S[a][0] * kk[0];
#pragma unroll
        for (int c = 1; c < 4; ++c) sa += S[a][c] * kk[c];
        const float s1 = allred8(sa[0] + sa[1]);
        const f32x2 s2 = bc2(s1), v2 = bc2(vv[a]);
        f32x2 oa = f32x2{0.f, 0.f};
#pragma unroll
        for (int c = 0; c < 4; ++c) {
          S[a][c] = S[a][c] * w[c] + s2 * kka[c] + v2 * keff[c];
          oa += S[a][c] * rr[c];
        }
        const float o = allred8(oa[0] + oa[1]);
        if (jg == a) ov = o;
      }
      if (row >= T_CTX) odir[((size_t)dir * T_LAT + (row - T_CTX)) * 512 + head * 64 + i * 8 + jg] = f2bf(ov);
    }
  }
}

DEVI void phase10(const Params& p) {
  const int lane = threadIdx.x & 63, warp = threadIdx.x >> 6;
  const bf16_t* odir = (const bf16_t*)p.out;
  const bf16_t* SV = (const bf16_t*)(p.ws + R_SV);
  const float* bonus = (const float*)(p.ws + O_BONUS);
  bf16_t* ya = (bf16_t*)(p.ws + O_PO);
  const int head = lane >> 3, c8 = (lane & 7) * 8, C0 = lane * 8;
#pragma unroll 2
  for (int t = blockIdx.x * 4 + warp; t < T_LAT; t += gridDim.x * 4) {
    const int row = t + T_CTX;
    const bf16_t* b = SV + ((size_t)row * 8 + head) * SVH;
    float v[8], g[8], y[8];
    unpack8(*(const uint4*)(b + 2 * 64 + c8), v);
    unpack8(*(const uint4*)(b + 8 * 64 + c8), g);
    float bs = bonus[(size_t)row * 16 + head] + bonus[(size_t)row * 16 + 8 + head];
#pragma unroll
    for (int e = 0; e < 8; ++e) y[e] = bs * v[e];
#pragma unroll
    for (int dir = 0; dir < 2; ++dir) {
      float o[8];
      unpack8(*(const uint4*)(odir + ((size_t)dir * T_LAT + t) * 512 + C0), o);
      float s = 0.f;
#pragma unroll
      for (int e = 0; e < 8; ++e) s += o[e];
      s = allred8(s);
      float mu = s * (1.f / 64.f);
      float q = 0.f;
#pragma unroll
      for (int e = 0; e < 8; ++e) { o[e] -= mu; q += o[e] * o[e]; }
      q = allred8(q);
      float rsd = rsqrtf(q * (1.f / 64.f) + 64e-5f);
#pragma unroll
      for (int e = 0; e < 8; ++e) y[e] += o[e] * rsd * p.in[I_RLNW][C0 + e] + p.in[I_RLNB][C0 + e];
    }
#pragma unroll
    for (int e = 0; e < 8; ++e) y[e] *= g[e];
    *(uint4*)(ya + (size_t)t * 512 + C0) = pack8(y);
  }
}

DEVI void phase11(const Params& p, unsigned char* smem, const XcdMap& xm) {
  const int lane = threadIdx.x & 63, warp = threadIdx.x >> 6, wm = warp >> 1, wn = warp & 1;
  const bf16_t* ya = (const bf16_t*)(p.ws + O_PO);
  const bf16_t* yb = (const bf16_t*)(p.ws + R_YA);
  const bf16_t* pg = (const bf16_t*)(p.ws + O_PG);
  bf16_t* mg = (bf16_t*)(p.ws + R_MERGED);
  for_tiles_xcd(xm, 128, 8, 8, 8, [&](int mt, int nt) {
    f32x4 acc[4][4];
    zero_acc(acc);
    gemm_core(ya + (size_t)mt * 128 * 512, 512, (const bf16_t*)(p.ws + O_WBA) + (size_t)nt * 128 * 512, 512, 512, acc, smem);
#pragma unroll
    for (int i = 0; i < 4; ++i) {
      int row = mt * 128 + wm * 64 + i * 16 + (lane & 15);
#pragma unroll
      for (int j = 0; j < 4; ++j) {
        int n = nt * 128 + wn * 64 + j * 16 + (lane >> 4) * 4;
        uint2 s = *(const uint2*)(pg + (size_t)row * 2048 + n);
        *(uint2*)(mg + (size_t)row * 1024 + n) = make_uint2(pack2(acc[i][j][0] * bflo(s.x), acc[i][j][1] * bfhi(s.x)), pack2(acc[i][j][2] * bflo(s.y), acc[i][j][3] * bfhi(s.y)));
      }
    }
    zero_acc(acc);
    gemm_core(yb + (size_t)mt * 128 * 512, 512, (const bf16_t*)(p.ws + O_WBB) + (size_t)nt * 128 * 512, 512, 512, acc, smem);
#pragma unroll
    for (int i = 0; i < 4; ++i) {
      int row = mt * 128 + wm * 64 + i * 16 + (lane & 15);
#pragma unroll
      for (int j = 0; j < 4; ++j) {
        int n = nt * 128 + wn * 64 + j * 16 + (lane >> 4) * 4;
        uint2 s = *(const uint2*)(pg + (size_t)row * 2048 + 1024 + n);
        uint2 m0 = *(const uint2*)(mg + (size_t)row * 1024 + n);
        float v0 = bflo(m0.x) + acc[i][j][0] * bflo(s.x), v1 = bfhi(m0.x) + acc[i][j][1] * bfhi(s.x);
        float v2 = bflo(m0.y) + acc[i][j][2] * bflo(s.y), v3 = bfhi(m0.y) + acc[i][j][3] * bfhi(s.y);
        *(uint2*)(mg + (size_t)row * 1024 + n) = make_uint2(pack2(v0, v1), pack2(v2, v3));
      }
    }
  });
}

DEVI void phase12(const Params& p, unsigned char* smem, const XcdMap& xm) {
  float* gt = (float*)(smem + 45056);
  const int tid = threadIdx.x, lane = tid & 63, warp = tid >> 6, wm = warp >> 1, wn = warp & 1;
  for (int i = tid; i < 1024; i += 256) gt[i] = mod_val(p, 0, 2048 + i);
  __syncthreads();
  const bf16_t* mg = (const bf16_t*)(p.ws + R_MERGED);
  const float* x = p.in[I_X];
  float* x1 = p.out;
  for_tiles_xcd(xm, 128, 8, 8, 8, [&](int mt, int nt) {
    f32x4 acc[4][4];
    zero_acc(acc);
    gemm_core(mg + (size_t)mt * 128 * 1024, 1024, (const bf16_t*)(p.ws + O_WOUT) + (size_t)nt * 128 * 1024, 1024, 1024, acc, smem);
#pragma unroll
    for (int i = 0; i < 4; ++i) {
      int row = mt * 128 + wm * 64 + i * 16 + (lane & 15);
#pragma unroll
      for (int j = 0; j < 4; ++j) {
        int n = nt * 128 + wn * 64 + j * 16 + (lane >> 4) * 4;
        float4 xv = *(const float4*)(x + (size_t)row * 1024 + n);
        xv.x += gt[n] * acc[i][j][0]; xv.y += gt[n + 1] * acc[i][j][1]; xv.z += gt[n + 2] * acc[i][j][2]; xv.w += gt[n + 3] * acc[i][j][3];
        *(float4*)(x1 + (size_t)row * 1024 + n) = xv;
      }
    }
  });
}

DEVI void phase13(const Params& p, unsigned char* smem) {
  float* smod = (float*)smem;
  const int tid = threadIdx.x, lane = tid & 63, warp = tid >> 6;
  for (int i = tid; i < 2048; i += 256) smod[i] = mod_val(p, 0, 3072 + i);
  __syncthreads();
  const float* x1 = p.out;
  bf16_t* h2 = (bf16_t*)(p.ws + R_H2);
  for (int rp = blockIdx.x * 4 + warp; rp < T_LAT / 2; rp += gridDim.x * 4) {
    float h[2][16]; float ss[2] = {0.f, 0.f};
#pragma unroll
    for (int u = 0; u < 2; ++u)
#pragma unroll
      for (int i = 0; i < 4; ++i) {
        float4 v = *(const float4*)(x1 + (size_t)(rp * 2 + u) * 1024 + i * 256 + lane * 4);
        h[u][4 * i] = v.x; h[u][4 * i + 1] = v.y; h[u][4 * i + 2] = v.z; h[u][4 * i + 3] = v.w;
        ss[u] += v.x * v.x + v.y * v.y + v.z * v.z + v.w * v.w;
      }
#pragma unroll
    for (int u = 0; u < 2; ++u) {
      const int row = rp * 2 + u;
      const float rstd = rsqrtf(wave_sum_u(ss[u]) * (1.f / 1024.f) + 1e-6f);
#pragma unroll
      for (int i = 0; i < 4; ++i) {
#pragma unroll
        for (int e = 0; e < 4; ++e) {
          int k = i * 256 + lane * 4 + e;
          float y = h[u][4 * i + e] * rstd * p.in[I_N2G][k];
          h[u][4 * i + e] = y * (1.f + smod[1024 + k]) + smod[k];
        }
        *(uint2*)(h2 + (size_t)row * 1024 + i * 256 + lane * 4) = make_uint2(pack2(h[u][4 * i], h[u][4 * i + 1]), pack2(h[u][4 * i + 2], h[u][4 * i + 3]));
      }
    }
  }
}

DEVI void phase14(const Params& p, unsigned char* smem, const XcdMap& xm) {
  bf16_t(*Qt)[136] = (bf16_t(*)[136])smem;
  float* Sc = (float*)smem;
  const int tid = threadIdx.x, lane = tid & 63, warp = tid >> 6, wm = warp >> 1, wn = warp & 1;
  const bf16_t* h2 = (const bf16_t*)(p.ws + R_H2);
  const bf16_t* keys = (const bf16_t*)(p.ws + O_KEYS);
  float* tops = (float*)(p.ws + R_TOPS);
  int* topi = (int*)(p.ws + R_TOPI);
  for_tiles_xcd(xm, 128, 16, 8, 8, [&](int mt, int hp) {
    f32x4 acc[4][4];
    zero_acc(acc);
    gemm_core(h2 + (size_t)mt * 128 * 1024, 1024, (const bf16_t*)(p.ws + O_WQ) + (size_t)hp * 128 * 1024, 1024, 1024, acc, smem);
#pragma unroll
    for (int i = 0; i < 4; ++i)
#pragma unroll
      for (int j = 0; j < 4; ++j)
        *(uint2*)&Qt[wm * 64 + i * 16 + (lane & 15)][wn * 64 + j * 16 + (lane >> 4) * 4] =
            make_uint2(pack2(acc[i][j][0], acc[i][j][1]), pack2(acc[i][j][2], acc[i][j][3]));
    __syncthreads();
    zero_acc(acc);
#pragma unroll
    for (int ks = 0; ks < 4; ++ks) {
      bf16x8 qf[4], kf[4];
#pragma unroll
      for (int i = 0; i < 4; ++i) qf[i] = *(const bf16x8*)&Qt[wm * 64 + i * 16 + (lane & 15)][ks * 32 + (lane >> 4) * 8];
#pragma unroll
      for (int j = 0; j < 4; ++j) kf[j] = *(const bf16x8*)(keys + ((size_t)hp * 128 + wn * 64 + j * 16 + (lane & 15)) * 128 + ks * 32 + (lane >> 4) * 8);
#pragma unroll
      for (int i = 0; i < 4; ++i)
#pragma unroll
        for (int j = 0; j < 4; ++j) acc[i][j] = __builtin_amdgcn_mfma_f32_16x16x32_bf16(kf[j], qf[i], acc[i][j], 0, 0, 0);
    }
    __syncthreads();
#pragma unroll
    for (int i = 0; i < 4; ++i)
#pragma unroll
      for (int j = 0; j < 4; ++j) {
        {
          const int c0 = j * 16 + (lane >> 4) * 4;
          u32x4 kq;
#pragma unroll
          for (int r = 0; r < 4; ++r) {
            unsigned u = __float_as_uint(acc[i][j][r]);
            u = (u & 0x80000000u) ? ~u : (u | 0x80000000u);
            kq[r] = (u & ~63u) | (unsigned)(63 - (c0 + r));
          }
          *(u32x4*)(Sc + (wm * 64 + i * 16 + (lane & 15)) * 132 + wn * 64 + c0) = kq;
        }
      }
    __syncthreads();
    {
      const int row = tid & 127, half = tid >> 7;
      float* hp_ = Sc + row * 132 + half * 64;
      float bv[16]; int bi[16];
      unsigned* hk = (unsigned*)hp_;
#pragma unroll
      for (int r = 0; r < 16; ++r) {
        unsigned best = 0u;
#pragma unroll 4
        for (int k = 0; k < 64; k += 4) {
          const u32x4 v4 = *(const u32x4*)(hk + k);
          const unsigned m01 = v4[0] > v4[1] ? v4[0] : v4[1], m23 = v4[2] > v4[3] ? v4[2] : v4[3];
          const unsigned m = m01 > m23 ? m01 : m23;
          best = best > m ? best : m;
        }
        const int b2 = 63 - (int)(best & 63u);
        unsigned u = best & ~63u;
        u = (u & 0x80000000u) ? (u & 0x7fffffffu) : ~u;
        bv[r] = __uint_as_float(u); bi[r] = b2 + half * 64; hk[b2] = 0u;
      }
#pragma unroll
      for (int r = 0; r < 16; ++r) { hp_[r] = bv[r]; hp_[16 + r] = __int_as_float(bi[r]); }
    }
    __syncthreads();
    if (tid < 128) {
      const float* la = Sc + tid * 132; const float* lb = la + 64;
      size_t ob = ((size_t)(mt * 128 + tid) * 16 + hp) * 16;
      int ia = 0, ib = 0;
      for (int r = 0; r < 16; ++r) {
        float va = la[ia], vb = lb[ib];
        bool ta = va >= vb;
        tops[ob + r] = ta ? va : vb;
        topi[ob + r] = __float_as_int(ta ? la[16 + ia] : lb[16 + ib]);
        ia += ta ? 1 : 0; ib += ta ? 0 : 1;
      }
    }
    __syncthreads();
  });
}

template <bool DRY> DEVI void phase15(const Params& p, unsigned char* smem) {
  const bool wr = !DRY || (p.in[I_FG][0] == 1234.5f);
  float* gt = (float*)smem;
  const int tid = threadIdx.x, lane = tid & 63, warp = tid >> 6;
  for (int i = tid; i < 1024; i += 256) gt[i] = mod_val(p, 0, 5120 + i);
  __syncthreads();
  const bf16_t* __restrict__ h2 = (const bf16_t*)(p.ws + R_H2);
  const float* __restrict__ tops = (const float*)(p.ws + R_TOPS);
  const int* __restrict__ topi = (const int*)(p.ws + R_TOPI);
  const unsigned char* __restrict__ uf8 = p.ws + R_UBF;
  const unsigned char* __restrict__ vf8 = p.ws + R_VBF;
  float* xo = p.out;
  int ca, cb;
  {
    int l = lane;
    if (l < 16) { ca = 0; cb = l; } else if (l < 24) { ca = 1; cb = l - 16; } else if (l < 29) { ca = 2; cb = l - 24; }
    else if (l < 33) { ca = 3; cb = l - 29; } else if (l < 36) { ca = 4; cb = l - 33; } else if (l < 38) { ca = 5; cb = l - 36; }
    else if (l < 40) { ca = 6; cb = l - 38; } else if (l < 42) { ca = 7; cb = l - 40; } else if (l < 50) { ca = l - 34; cb = 0; }
    else { ca = 0; cb = 0; }
  }
  const int flat = ca * 16 + cb;
  for (int t = blockIdx.x * 4 + warp; t < T_LAT; t += gridDim.x * 4) {
    float hv[16], out[16];
    {
      const u32x4 hp0 = *(const u32x4*)(h2 + (size_t)t * 1024 + lane * 16);
      const u32x4 hp1 = *(const u32x4*)(h2 + (size_t)t * 1024 + lane * 16 + 8);
#pragma unroll
      for (int e = 0; e < 4; ++e) { hv[2 * e] = bflo(hp0[e]); hv[2 * e + 1] = bfhi(hp0[e]); hv[8 + 2 * e] = bflo(hp1[e]); hv[8 + 2 * e + 1] = bfhi(hp1[e]); }
    }
#pragma unroll
    for (int e = 0; e < 16; ++e) out[e] = 0.f;
#pragma unroll 1
    for (int hd = 0; hd < 8; ++hd) {
      const size_t b1 = ((size_t)t * 16 + hd * 2) * 16, b2 = b1 + 16;
      float val = lane < 50 ? tops[b1 + ca] + tops[b2 + cb] : -INFINITY;
      int idx = topi[b1 + ca] * 128 + topi[b2 + cb];
      unsigned key = __float_as_uint(val);
      key = (key & 0x80000000u) ? ~key : (key | 0x80000000u);
      key = lane < 50 ? ((key & ~63u) | (unsigned)(63 - lane)) : 0u;
      int cnt = 0;
#pragma unroll
      for (int i = 0; i < 50; ++i) cnt += ((unsigned)__builtin_amdgcn_readlane((int)key, i) > key) ? 1 : 0;
      bool sel = lane < 50 && cnt < 16;
      float vmax = rlf(val, 0);
      float ex = sel ? __expf(val - vmax) : 0.f;
      float gsum = wave_sum_u(ex);
      float g = ex / gsum;
      unsigned long long m1 = __ballot(sel);
      int es[16];
      float gq = 0.f;
#pragma unroll
      for (int q = 0; q < 16; ++q) {
        int src = __ffsll((long long)m1) - 1; m1 &= m1 - 1;
        es[q] = __builtin_amdgcn_readlane(idx, src);
        float gg = rlf(g, src);
        if (lane == q) gq = gg;
      }
      float dm = 0.f;
      {
        u32x4 ub[16];
#pragma unroll
        for (int q = 0; q < 16; ++q) ub[q] = *(const u32x4*)(uf8 + (size_t)es[q] * 1024 + lane * 16);
#pragma unroll
        for (int q = 0; q < 16; ++q) {
          float f[16]; unpack_fp8x16(ub[q], f);
          float d0 = 0.f, d1 = 0.f;
#pragma unroll
          for (int e = 0; e < 8; ++e) { d0 += f[2 * e] * hv[2 * e]; d1 += f[2 * e + 1] * hv[2 * e + 1]; }
          float d = d0 + d1;
          d += dppf<0xB1>(d); d += dppf<0x4E>(d); d += dppf<0x141>(d); d += dppf<0x140>(d);
          if ((lane & 15) == q) dm = d;
        }
      }
      dm += __shfl_xor(dm, 16); dm += __shfl_xor(dm, 32);
      dm *= (1.f / 64.f);
      float coef = gq * 0.5f * dm * (1.f + erff(dm * 0.70710678118f)) * 0.25f;
      {
        u32x4 vb[16];
#pragma unroll
        for (int q = 0; q < 16; ++q) vb[q] = *(const u32x4*)(vf8 + (size_t)es[q] * 1024 + lane * 16);
#pragma unroll
        for (int q = 0; q < 16; ++q) {
          float cf = rlf(coef, q);
          float f[16]; unpack_fp8x16(vb[q], f);
#pragma unroll
          for (int e = 0; e < 16; ++e) out[e] += cf * f[e];
        }
      }
    }
    float xs[16]; float ss = 0.f;
#pragma unroll
    for (int i = 0; i < 4; ++i) {
      int k = lane * 16 + i * 4;
      float4 v = *(const float4*)(xo + (size_t)t * 1024 + k);
      xs[4 * i] = v.x + gt[k] * out[4 * i]; xs[4 * i + 1] = v.y + gt[k + 1] * out[4 * i + 1];
      xs[4 * i + 2] = v.z + gt[k + 2] * out[4 * i + 2]; xs[4 * i + 3] = v.w + gt[k + 3] * out[4 * i + 3];
      ss += xs[4 * i] * xs[4 * i] + xs[4 * i + 1] * xs[4 * i + 1] + xs[4 * i + 2] * xs[4 * i + 2] + xs[4 * i + 3] * xs[4 * i + 3];
    }
    ss = wave_sum_u(ss);
    float rstd = rsqrtf(ss * (1.f / 1024.f) + 1e-6f);
#pragma unroll
    for (int i = 0; i < 4; ++i) {
      int k = lane * 16 + i * 4;
      float4 g4 = *(const float4*)(p.in[I_FG] + k);
      if (wr) *(float4*)(xo + (size_t)t * 1024 + k) = make_float4(xs[4 * i] * rstd * g4.x, xs[4 * i + 1] * rstd * g4.y, xs[4 * i + 2] * rstd * g4.z, xs[4 * i + 3] * rstd * g4.w);
    }
  }
}

#define XB_TMO      128
#define XB_XCNT(j)  (256  + 64 * (j))
#define XB_XSUB(j)  (1280 + 64 * (j))
#define XB_XGEN(j)  (2304 + 64 * (j))
#define XB_TOP      3328
#define XB_TOPGEN   3392
#define XCD_BAR_WORDS 3456
#define XB_SPIN_CAP (1u << 22)
#define LAS __attribute__((address_space(3)))
DEVI unsigned xb_ld(unsigned* p) { return __hip_atomic_load(p, __ATOMIC_RELAXED, __HIP_MEMORY_SCOPE_AGENT); }
DEVI unsigned xb_add(unsigned* p, unsigned v) { return __hip_atomic_fetch_add(p, v, __ATOMIC_RELAXED, __HIP_MEMORY_SCOPE_AGENT); }
DEVI unsigned xb_xcc_id() { return (unsigned)__builtin_amdgcn_s_getreg((3 << 11) | 20) & 0xFu; }
#define XB_SPIN(cond, bar) do { unsigned _sp = 0; while (cond) { __builtin_amdgcn_s_sleep(1); \
    if ((++_sp & 255u) == 0u) { if (xb_ld(&(bar)[XB_TMO])) break; if (_sp > XB_SPIN_CAP) { atomicAdd(&(bar)[XB_TMO], 1u); break; } } } } while (0)
struct XcdBarrier { unsigned* bar; unsigned x; volatile LAS unsigned* st; };
DEVI XcdBarrier xcd_barrier_post(unsigned* bar, volatile LAS unsigned* st) {
  XcdBarrier b; b.bar = bar; b.x = xb_xcc_id(); b.st = st;
  if (threadIdx.x == 0) st[2] = xb_add(&bar[XB_XCNT(b.x)], 1u);
  return b;
}
DEVI void xcd_barrier_complete(unsigned* bar, unsigned x, unsigned& nloc, unsigned& nx, unsigned& vidx) {
  const unsigned G = gridDim.x * gridDim.y * gridDim.z;
  unsigned sum, cnt, mine, below, sp = 0u;
  for (;;) {
    sum = 0u; cnt = 0u; mine = 0u; below = 0u;
#pragma unroll
    for (unsigned j = 0; j < 16; ++j) { const unsigned c = xb_ld(&bar[XB_XCNT(j)]); sum += c; cnt += (c > 0u) ? 1u : 0u; mine = (j == x) ? c : mine; below += (c > 0u && j < x) ? 1u : 0u; }
    if (sum == G) break;
    __builtin_amdgcn_s_sleep(1);
    if ((++sp & 255u) == 0u) { if (xb_ld(&bar[XB_TMO])) break; if (sp > XB_SPIN_CAP) { atomicAdd(&bar[XB_TMO], 1u); break; } }
  }
  nloc = mine > 0u ? mine : 1u; nx = cnt > 0u ? cnt : 1u; vidx = below;
}
DEVI void xcd_barrier(const XcdBarrier& b) {
  asm volatile("s_waitcnt vmcnt(0)" ::: "memory");
  __syncthreads();
  if (threadIdx.x == 0) {
    unsigned* bar = b.bar;
    __builtin_amdgcn_s_waitcnt(0);
    unsigned nloc = b.st[0], nx = b.st[1];
    if (nloc == 0u) { unsigned vidx; xcd_barrier_complete(bar, b.x, nloc, nx, vidx); b.st[0] = nloc; b.st[1] = nx; b.st[3] = vidx; }
    const unsigned old = xb_add(&bar[XB_XSUB(b.x)], 1u);
    const unsigned gen = old / nloc;
    if (old + 1u == (gen + 1u) * nloc) {
      __builtin_amdgcn_fence(__ATOMIC_RELEASE, "agent");
      asm volatile("s_waitcnt vmcnt(0)" ::: "memory");
      const unsigned og = xb_add(&bar[XB_TOP], 1u);
      const unsigned tg = og / nx;
      if (og + 1u == (tg + 1u) * nx) xb_add(&bar[XB_TOPGEN], 1u);
      else XB_SPIN(xb_ld(&bar[XB_TOPGEN]) == tg, bar);
      __builtin_amdgcn_fence(__ATOMIC_ACQUIRE, "agent");
      xb_add(&bar[XB_XGEN(b.x)], 1u);
      asm volatile("s_waitcnt vmcnt(0)" ::: "memory");
    } else {
      XB_SPIN(xb_ld(&bar[XB_XGEN(b.x)]) == gen, bar);
      __builtin_amdgcn_fence(__ATOMIC_ACQUIRE, "agent");
      asm volatile("s_waitcnt vmcnt(0)" ::: "memory");
    }
  }
  __syncthreads();
}

constexpr int NPHASE = 16;
DEVI XcdMap get_xm(int coop, const uint4& w) {
  XcdMap m;
  if (coop) { m.v = (int)w.w; m.nx = (int)w.y; m.slot = (int)w.z; m.slots = (int)w.x; }
  else { m.v = blockIdx.x & 7; m.nx = 8; m.slot = blockIdx.x >> 3; m.slots = gridDim.x >> 3; if (m.slots < 1) { m.slots = 1; } }
  return m;
}
__global__ void __launch_bounds__(256, 2) mk(Params p, int ph0, int ph1, int coop) {
  __shared__ __attribute__((aligned(16))) unsigned char smem[SMEM_BYTES];
  __shared__ uint4 xb_words;
  if (threadIdx.x == 0) xb_words = make_uint4(0u, 0u, 0u, 0u);
  __syncthreads();
  XcdBarrier xb;
  if (coop) xb = xcd_barrier_post((unsigned*)(p.ws + O_BAR), (volatile LAS unsigned*)&xb_words);
#ifdef XCC_PROBE
  if (coop && xb_xcc_id() != (blockIdx.x & 7u)) { unsigned long long t0 = wall_clock64(); while (wall_clock64() - t0 < 100000ull) __builtin_amdgcn_s_sleep(8); }
#endif
  if (ph0 < 0) cg::this_grid().sync();
#ifdef PROBE_A
#define STAMP(n) if (blockIdx.x == 0 && threadIdx.x == 0) ((unsigned long long*)(p.ws + O_STAMP))[n] = wall_clock64();
#else
#define STAMP(n)
#endif
#define RUN_PHASE(n, call)                                   \
  if (ph0 <= n && n < ph1) {                                 \
    STAMP(n)                                                 \
        if (DRY_PH == n) { if (n == 4) phase4<true>(p, smem); if (n == 5) phase5<true>(p, smem); if (n == 8) phase8<true>(p, smem); if (n == 15) phase15<true>(p, smem); } \
    if (ONLY < 0 || ONLY == n) { call; }                     \
    if (REPEAT_PH == n) { call; }                            \
    if (coop && n + 1 < ph1) xcd_barrier(xb);                \
  }
  RUN_PHASE(0, phase0(p, smem, 0, 96))
  RUN_PHASE(1, (phase1(p, smem), __syncthreads(), phase0(p, smem, 96, 1 << 30)))
  RUN_PHASE(2, phase2(p, smem, get_xm(coop, xb_words)))
  RUN_PHASE(3, phase3(p, smem))
  RUN_PHASE(4, (phase4<false>(p, smem), phase6(p, smem, 0, 32, gridDim.x > 290 ? 258 : 0, gridDim.x > 290 ? (int)gridDim.x - 258 : (int)gridDim.x)))
  RUN_PHASE(5, phase5<false>(p, smem))
  RUN_PHASE(6, phase6(p, smem, 32, 260 * 8, 0, (int)gridDim.x))
  RUN_PHASE(7, phase7(p))
  RUN_PHASE(8, phase8<false>(p, smem))
  RUN_PHASE(9, phase9(p))
  RUN_PHASE(10, phase10(p))
  RUN_PHASE(11, phase11(p, smem, get_xm(coop, xb_words)))
  RUN_PHASE(12, (phase12(p, smem, get_xm(coop, xb_words)), convert_fp8(p.in[I_PU], p.ws + R_UBF, (size_t)16384 * 64, 64.f)))
  RUN_PHASE(13, phase13(p, smem))
  RUN_PHASE(14, (phase14(p, smem, get_xm(coop, xb_words)), convert_fp8(p.in[I_PV], p.ws + R_VBF, (size_t)16384 * 64, 4.f)))
  RUN_PHASE(15, phase15<false>(p, smem))
#ifdef SYNC_EXTRA
  for (int i = 0; i < SYNC_EXTRA; ++i) xcd_barrier(xb);
#endif
#ifdef PROBE_A
  cg::this_grid().sync();
  STAMP(16)
  __syncthreads();
  if (blockIdx.x == 0) {
    const unsigned long long* st = (const unsigned long long*)(p.ws + O_STAMP);
    float ta = (float)(st[PROBE_A + 1] - st[PROBE_A]) * 0.01f, tb = (float)(st[PROBE_B + 1] - st[PROBE_B]) * 0.01f;
    for (int i = threadIdx.x; i < 1000000; i += 256) p.out[1 + i] = tb;
    if (threadIdx.x == 0) p.out[0] = 100.f * ta;
  }
#endif
}

extern "C" void kernel_launch(void* const* d_in, const int* in_sizes, int n_in, void* d_out, int out_size, void* d_ws,
                              size_t ws_size, hipStream_t stream) {
  static int grid_blocks = 0;
  if (!grid_blocks) {
    int dev = 0, cus = 0, per_cu = 0;
    hipGetDevice(&dev);
    hipDeviceGetAttribute(&cus, hipDeviceAttributeMultiprocessorCount, dev);
    hipOccupancyMaxActiveBlocksPerMultiprocessor(&per_cu, mk, 256, 0);
    if (per_cu < 1) per_cu = 1;
    if (per_cu > 2) per_cu = 2;
    grid_blocks = cus * per_cu;
  }
  if (ws_size < WS_NEED) { fprintf(stderr, "workspace too small: %zu < %zu\n", ws_size, (size_t)WS_NEED); return; }
  Params p{};
  for (int i = 0; i < 32; ++i) p.in[i] = (const float*)d_in[i];
  p.out = (float*)d_out;
  p.ws = (unsigned char*)d_ws;
#if MEGA
  (void)hipMemsetAsync((unsigned char*)d_ws + O_BAR, 0, XCD_BAR_WORDS * 4, stream);
  int ph0 = 0, ph1 = NPHASE, coop = 1;
  void* args[] = {&p, &ph0, &ph1, &coop};
  hipError_t e = hipLaunchCooperativeKernel((void*)mk, dim3(grid_blocks), dim3(256), args, 0, stream);
  if (e != hipSuccess) fprintf(stderr, "cooperative launch failed: %s (grid %d)\n", hipGetErrorString(e), grid_blocks);
#else
  for (int ph = 0; ph < NPHASE; ++ph) mk<<<grid_blocks, 256, 0, stream>>>(p, ph, ph + 1, 0);
#endif
}
```

```cpp
#include <hip/hip_runtime.h>
#include <hip/hip_cooperative_groups.h>
#include <cstdio>
#include <cstdint>
namespace cg = cooperative_groups;

#ifndef MEGA
#define MEGA 1
#endif
#ifndef ONLY
#define ONLY -1
#endif
#ifndef REPEAT_PH
#define REPEAT_PH -1
#endif
#ifndef DRY_PH
#define DRY_PH -1
#endif

typedef unsigned short bf16_t;
using bf16x8 = __attribute__((ext_vector_type(8))) short;
using f32x4 = __attribute__((ext_vector_type(4))) float;
using u32x4 = __attribute__((ext_vector_type(4))) unsigned;
#define DEVI __device__ __forceinline__

constexpr int T_CTX = 256, T_LAT = 16384, T_ALL = 16640;
constexpr int NIN = 5392, NP = 5376;
constexpr int NCH = 128, LCH = 130;
constexpr int SVH = 576;
constexpr int SMEM_BYTES = 71680;

enum { I_X = 0, I_C, I_CTX, I_CCTX, I_ADAW, I_ADAB, I_N1G, I_WIN, I_RCONV, I_RW0, I_RWUP, I_RA0, I_RAUP, I_RGUP,
       I_RKK, I_RKA, I_RRK, I_RLNW, I_RLNB, I_MCONV, I_MIB, I_MFB, I_MNG, I_WBA, I_WBB, I_WOUT, I_N2G, I_WQ,
       I_KEYS, I_PU, I_PV, I_FG };

struct Params { const float* in[32]; float* out; unsigned char* ws; };

constexpr size_t A256(size_t x) { return (x + 255) & ~(size_t)255; }
constexpr size_t O_MODP = 0;
constexpr size_t O_WBA = A256(O_MODP + (size_t)16 * 2 * 6144 * 4);
constexpr size_t O_WBB = A256(O_WBA + (size_t)1024 * 512 * 2);
constexpr size_t O_WOUT = A256(O_WBB + (size_t)1024 * 512 * 2);
constexpr size_t O_WQ = A256(O_WOUT + (size_t)1024 * 1024 * 2);
constexpr size_t O_KEYS = A256(O_WQ + (size_t)2048 * 1024 * 2);
constexpr size_t O_WUP = A256(O_KEYS + (size_t)16 * 128 * 128 * 2);
constexpr size_t O_AUP = A256(O_WUP + (size_t)1024 * 64 * 2);
constexpr size_t O_GUP = A256(O_AUP + (size_t)1024 * 64 * 2);
constexpr size_t O_BEND = A256(O_GUP + (size_t)512 * 128 * 2);
constexpr size_t O_MLOC = A256(O_BEND + (size_t)260 * 8 * 4);
constexpr size_t O_MST = A256(O_MLOC + (size_t)260 * 8 * 4);
constexpr size_t O_NT = A256(O_MST + (size_t)260 * 8 * 4);
constexpr size_t O_BONUS = A256(O_NT + (size_t)260 * 8 * 64 * 4);
constexpr size_t O_STAMP = A256(O_BONUS + (size_t)T_ALL * 16 * 4);
constexpr size_t O_BAR = A256(O_STAMP + 1024);
constexpr size_t O_PG = A256(O_BAR + 3456 * 4);
constexpr size_t O_PO = A256(O_PG + (size_t)T_LAT * 2048 * 2);
constexpr size_t O_R = A256(O_PO + (size_t)T_LAT * 512 * 2);
constexpr size_t R_HX = O_R;
constexpr size_t R_WIN = A256(R_HX + (size_t)T_ALL * 1024 * 2);
constexpr size_t R_PQK = A256(R_WIN + (size_t)(NP + 128) * 1024 * 2);
constexpr size_t R_PV = A256(R_PQK + (size_t)T_ALL * 512 * 2);
constexpr size_t R_GIF = A256(R_PV + (size_t)T_ALL * 512 * 2);
constexpr size_t R_U = A256(R_GIF + (size_t)T_ALL * 16 * 4);
constexpr size_t R_END1 = A256(R_U + (size_t)260 * 8 * 8192 * 4);
constexpr size_t R_SV = O_R;
constexpr size_t R_YA = A256(R_SV + (size_t)T_ALL * 8 * SVH * 2);
constexpr size_t R_END2 = A256(R_YA + (size_t)T_LAT * 512 * 2);
constexpr size_t R_MERGED = O_R;
constexpr size_t R_H2 = A256(R_MERGED + (size_t)T_LAT * 1024 * 2);
constexpr size_t R_TOPS = A256(R_H2 + (size_t)T_LAT * 1024 * 2);
constexpr size_t R_TOPI = A256(R_TOPS + (size_t)T_LAT * 256 * 4);
constexpr size_t R_UBF = A256(R_TOPI + (size_t)T_LAT * 256 * 4);
constexpr size_t R_VBF = A256(R_UBF + (size_t)16384 * 1024 * 2);
constexpr size_t R_END3 = A256(R_VBF + (size_t)16384 * 1024 * 2);
constexpr size_t WS_NEED = (R_END1 > R_END2 ? (R_END1 > R_END3 ? R_END1 : R_END3) : (R_END2 > R_END3 ? R_END2 : R_END3));
constexpr size_t OUT_BC = (size_t)NCH * 16 * 4096 * 4;

DEVI bf16_t f2bf(float f) { unsigned u = __float_as_uint(f); u += 0x7fffu + ((u >> 16) & 1u); return (bf16_t)(u >> 16); }
DEVI float bf2f(bf16_t h) { return __uint_as_float(((unsigned)h) << 16); }
DEVI float bflo(unsigned u) { return __uint_as_float(u << 16); }
DEVI float bfhi(unsigned u) { return __uint_as_float(u & 0xffff0000u); }
DEVI unsigned pack2(float a, float b) { return (unsigned)f2bf(a) | ((unsigned)f2bf(b) << 16); }
DEVI void unpack8(const uint4& u, float* f) {
  f[0] = bflo(u.x); f[1] = bfhi(u.x); f[2] = bflo(u.y); f[3] = bfhi(u.y);
  f[4] = bflo(u.z); f[5] = bfhi(u.z); f[6] = bflo(u.w); f[7] = bfhi(u.w);
}
DEVI uint4 pack8(const float* f) { return make_uint4(pack2(f[0], f[1]), pack2(f[2], f[3]), pack2(f[4], f[5]), pack2(f[6], f[7])); }
DEVI float wave_sum(float v) {
#pragma unroll
  for (int o = 32; o; o >>= 1) v += __shfl_xor(v, o);
  return v;
}
DEVI float wave_max(float v) {
#pragma unroll
  for (int o = 32; o; o >>= 1) v = fmaxf(v, __shfl_xor(v, o));
  return v;
}
DEVI float sigm(float x) { return 1.f / (1.f + __expf(-x)); }
DEVI float siluf(float x) { return x / (1.f + __expf(-x)); }
DEVI float logsig(float x) { return fminf(x, 0.f) - log1pf(expf(-fabsf(x))); }
template <int CTRL> DEVI float dppf(float v) { return __int_as_float(__builtin_amdgcn_update_dpp(0, __float_as_int(v), CTRL, 0xf, 0xf, true)); }
DEVI float rlf(float v, int l) { return __int_as_float(__builtin_amdgcn_readlane(__float_as_int(v), l)); }
DEVI float wave_sum_u(float v) {
  v += dppf<0xB1>(v); v += dppf<0x4E>(v); v += dppf<0x141>(v); v += dppf<0x140>(v);
  return (rlf(v, 0) + rlf(v, 16)) + (rlf(v, 32) + rlf(v, 48));
}
typedef __attribute__((ext_vector_type(2))) short s16x2;
DEVI float dot2bf(unsigned a, unsigned b, float c) { return __builtin_amdgcn_fdot2_f32_bf16(__builtin_bit_cast(s16x2, a), __builtin_bit_cast(s16x2, b), c, false); }
typedef __attribute__((ext_vector_type(2))) float f32x2;
DEVI void convert_fp8(const float* __restrict__ src, unsigned char* __restrict__ dst, size_t n16, float scale) {
  for (size_t g = (size_t)blockIdx.x * 256 + threadIdx.x; g < n16; g += (size_t)gridDim.x * 256) {
    u32x4 o;
#pragma unroll
    for (int q = 0; q < 4; ++q) {
      float4 a = *(const float4*)(src + g * 16 + q * 4);
      int pk = __builtin_amdgcn_cvt_pk_fp8_f32(a.x * scale, a.y * scale, 0, false);
      pk = __builtin_amdgcn_cvt_pk_fp8_f32(a.z * scale, a.w * scale, pk, true);
      o[q] = (unsigned)pk;
    }
    *(u32x4*)(dst + g * 16) = o;
  }
}
DEVI void unpack_fp8x16(const u32x4& u, float* f) {
#pragma unroll
  for (int q = 0; q < 4; ++q) {
    f32x2 lo = __builtin_amdgcn_cvt_pk_f32_fp8((int)u[q], false), hi = __builtin_amdgcn_cvt_pk_f32_fp8((int)u[q], true);
    f[4 * q] = lo[0]; f[4 * q + 1] = lo[1]; f[4 * q + 2] = hi[0]; f[4 * q + 3] = hi[1];
  }
}
DEVI void convert_bf16(const float* __restrict__ src, bf16_t* __restrict__ dst, size_t n8) {
  for (size_t g = (size_t)blockIdx.x * 256 + threadIdx.x; g < n8; g += (size_t)gridDim.x * 256) {
    float4 a = *(const float4*)(src + g * 8), b = *(const float4*)(src + g * 8 + 4);
    *(uint4*)(dst + g * 8) = make_uint4(pack2(a.x, a.y), pack2(a.z, a.w), pack2(b.x, b.y), pack2(b.z, b.w));
  }
}
DEVI float allred8(float v) { v += dppf<0xB1>(v); v += dppf<0x4E>(v); v += dppf<0x141>(v); return v; }

DEVI int ml_row(int c, int j) {
  if (c < 4) return c * 64 + j;
  int cc = c - 4; int col = cc >> 2; int gr = (cc & 3) * 64 + j;
  return T_CTX + gr * 64 + col;
}
DEVI int ml_sc(int c, int dir) { return dir == 0 ? c : (c < 4 ? 3 - c : 263 - c); }
DEVI int rw_row(int p, int dir) { return dir == 0 ? p : (p < T_CTX ? (T_CTX - 1 - p) : (T_ALL + T_CTX - 1 - p)); }

DEVI float mod_val(const Params& p, int which, int col) {
  return ((const float*)(p.ws + O_MODP))[which * 6144 + col];
}

DEVI void gemm_core(const bf16_t* __restrict__ A, int lda, const bf16_t* __restrict__ Bt, int ldb, int K,
                    f32x4 (&acc)[4][4], unsigned char* smem) {
  bf16_t(*sa)[80] = (bf16_t(*)[80])smem;
  bf16_t(*sb)[80] = (bf16_t(*)[80])(smem + 128 * 80 * 2);
  const int tid = threadIdx.x, lane = tid & 63, warp = tid >> 6, wm = warp >> 1, wn = warp & 1;
  const int lr = tid >> 3, lk = (tid & 7) * 8;
  const bf16_t* Ap = A + (size_t)lr * lda + lk;
  const bf16_t* Bp = Bt + (size_t)lr * ldb + lk;
  u32x4 ra0[4], rb0[4], ra1[4], rb1[4];
#pragma unroll
  for (int i = 0; i < 4; ++i) {
    ra0[i] = *(const u32x4*)(Ap + (size_t)(32 * i) * lda); rb0[i] = *(const u32x4*)(Bp + (size_t)(32 * i) * ldb);
    ra1[i] = *(const u32x4*)(Ap + (size_t)(32 * i) * lda + 64); rb1[i] = *(const u32x4*)(Bp + (size_t)(32 * i) * ldb + 64);
  }
#define GEMM_STEP(k0, ra, rb)                                                                                 \
  {                                                                                                           \
    __syncthreads();                                                                                          \
    _Pragma("unroll") for (int i = 0; i < 4; ++i) { *(u32x4*)&sa[lr + 32 * i][lk] = ra[i]; *(u32x4*)&sb[lr + 32 * i][lk] = rb[i]; } \
    __syncthreads();                                                                                          \
    if ((k0) + 128 < K) {                                                                                     \
      _Pragma("unroll") for (int i = 0; i < 4; ++i) {                                                         \
        ra[i] = *(const u32x4*)(Ap + (size_t)(32 * i) * lda + (k0) + 128);                                    \
        rb[i] = *(const u32x4*)(Bp + (size_t)(32 * i) * ldb + (k0) + 128);                                    \
      }                                                                                                       \
    }                                                                                                         \
    __builtin_amdgcn_s_setprio(1);                                                                            \
    _Pragma("unroll") for (int ks = 0; ks < 2; ++ks) {                                                        \
      bf16x8 af[4], bq[4];                                                                                    \
      _Pragma("unroll") for (int i = 0; i < 4; ++i) af[i] = *(const bf16x8*)&sa[wm * 64 + i * 16 + (lane & 15)][ks * 32 + (lane >> 4) * 8]; \
      _Pragma("unroll") for (int j = 0; j < 4; ++j) bq[j] = *(const bf16x8*)&sb[wn * 64 + j * 16 + (lane & 15)][ks * 32 + (lane >> 4) * 8]; \
      _Pragma("unroll") for (int i = 0; i < 4; ++i)                                                           \
        _Pragma("unroll") for (int j = 0; j < 4; ++j) acc[i][j] = __builtin_amdgcn_mfma_f32_16x16x32_bf16(bq[j], af[i], acc[i][j], 0, 0, 0); \
    }                                                                                                         \
    __builtin_amdgcn_s_setprio(0);                                                                            \
  }
  for (int k0 = 0; k0 < K; k0 += 128) {
    GEMM_STEP(k0, ra0, rb0)
    GEMM_STEP(k0 + 64, ra1, rb1)
  }
#undef GEMM_STEP
  __syncthreads();
}
DEVI void zero_acc(f32x4 (&acc)[4][4]) {
#pragma unroll
  for (int i = 0; i < 4; ++i)
#pragma unroll
    for (int j = 0; j < 4; ++j) acc[i][j] = f32x4{0.f, 0.f, 0.f, 0.f};
}

struct XcdMap { int v, nx, slot, slots; };
template <typename F> DEVI void for_tiles_xcd(const XcdMap& xm, int MT, int NT, int SM, int SN, F&& f) {
  const int nsn = (NT + SN - 1) / SN, nst = ((MT + SM - 1) / SM) * nsn, per = SM * SN;
  const int n_my = (nst - xm.v + xm.nx - 1) / xm.nx;
  for (int g = xm.slot; g < n_my * per; g += xm.slots) {
    const int s = xm.v + (g / per) * xm.nx, idx = g % per;
    const int sm = s / nsn, sn = s % nsn;
    const int mt = sm * SM + idx / SN, nt = sn * SN + idx % SN;
    if (mt < MT && nt < NT) f(mt, nt);
  }
}

DEVI void tr_tile(const float* __restrict__ src, int lds, int k0, int n0src, bf16_t* __restrict__ dst, int ldd, int n0dst,
                  unsigned char* smem) {
  float(*tile)[65] = (float(*)[65])smem;
  const int tid = threadIdx.x, j = tid & 63, i0 = tid >> 6;
#pragma unroll 4
  for (int ii = 0; ii < 16; ++ii) { int i = i0 + 4 * ii; tile[i][j] = src[(size_t)(k0 + i) * lds + n0src + j]; }
  __syncthreads();
#pragma unroll 4
  for (int jj = 0; jj < 16; ++jj) { int jn = i0 + 4 * jj; dst[(size_t)(n0dst + jn) * ldd + k0 + j] = f2bf(tile[j][jn]); }
  __syncthreads();
}

DEVI void phase0(const Params& p, unsigned char* smem, int it_lo, int it_hi) {
  const int tid = threadIdx.x;
  constexpr int N_MOD = 96, N_WIN = 16 * 85, N_WB = 128, N_WOUT = 256, N_WQ = 512, N_LORA = 16, N_GUP = 16, N_KEYS = 128;
  constexpr int E0 = N_MOD, E1 = E0 + N_WIN, E2 = E1 + N_WB, E3 = E2 + N_WB, E4 = E3 + N_WOUT, E5 = E4 + N_WQ,
                E6 = E5 + N_LORA, E7 = E6 + N_LORA, E8 = E7 + N_GUP, E9 = E8 + N_KEYS;
  if (it_hi > E9) it_hi = E9;
  for (int it = it_lo + blockIdx.x; it < it_hi; it += gridDim.x) {
    if (it < E0) {
      float* sl = (float*)smem;
      float* part = sl + 2048;
      __syncthreads();
      for (int i = tid; i < 2048; i += 256) sl[i] = siluf(i < 1024 ? p.in[I_C][i] : p.in[I_CCTX][i - 1024]);
      __syncthreads();
      const int cl = tid & 63, rg = tid >> 6, col = it * 64 + cl;
      const float* aw = p.in[I_ADAW] + (size_t)(rg * 256) * 6144 + col;
      float ax = 0.f, ac = 0.f;
#pragma unroll 32
      for (int r = 0; r < 256; ++r) {
        const float w = aw[(size_t)r * 6144];
        ax += sl[rg * 256 + r] * w;
        ac += sl[1024 + rg * 256 + r] * w;
      }
      part[(rg * 2 + 0) * 64 + cl] = ax;
      part[(rg * 2 + 1) * 64 + cl] = ac;
      __syncthreads();
      if (tid < 128) {
        const int which = tid >> 6;
        const float v = part[(0 * 2 + which) * 64 + cl] + part[(1 * 2 + which) * 64 + cl] + part[(2 * 2 + which) * 64 + cl] + part[(3 * 2 + which) * 64 + cl];
        ((float*)(p.ws + O_MODP))[which * 6144 + col] = v + p.in[I_ADAB][col];
      }
    } else if (it < E1) {
      int t = it - E0; int kt = t / 85, nt = t % 85; int n0 = nt * 64;
      tr_tile(p.in[I_WIN], NIN, kt * 64, nt == 84 ? 2816 : (n0 < 2816 ? n0 : n0 + 16), (bf16_t*)(p.ws + R_WIN), 1024, n0, smem);
    } else if (it < E2) {
      int t = it - E1; tr_tile(p.in[I_WBA], 1024, (t / 16) * 64, (t % 16) * 64, (bf16_t*)(p.ws + O_WBA), 512, (t % 16) * 64, smem);
    } else if (it < E3) {
      int t = it - E2; tr_tile(p.in[I_WBB], 1024, (t / 16) * 64, (t % 16) * 64, (bf16_t*)(p.ws + O_WBB), 512, (t % 16) * 64, smem);
    } else if (it < E4) {
      int t = it - E3; tr_tile(p.in[I_WOUT], 1024, (t / 16) * 64, (t % 16) * 64, (bf16_t*)(p.ws + O_WOUT), 1024, (t % 16) * 64, smem);
    } else if (it < E5) {
      int t = it - E4; tr_tile(p.in[I_WQ], 2048, (t / 32) * 64, (t % 32) * 64, (bf16_t*)(p.ws + O_WQ), 1024, (t % 32) * 64, smem);
    } else if (it < E6) {
      int t = it - E5; int dir = t / 8, nt = t % 8;
      tr_tile(p.in[I_RWUP] + (size_t)dir * 64 * 512, 512, 0, nt * 64, (bf16_t*)(p.ws + O_WUP) + (size_t)dir * 512 * 64, 64, nt * 64, smem);
    } else if (it < E7) {
      int t = it - E6; int dir = t / 8, nt = t % 8;
      tr_tile(p.in[I_RAUP] + (size_t)dir * 64 * 512, 512, 0, nt * 64, (bf16_t*)(p.ws + O_AUP) + (size_t)dir * 512 * 64, 64, nt * 64, smem);
    } else if (it < E8) {
      int t = it - E7; tr_tile(p.in[I_RGUP], 512, (t / 8) * 64, (t % 8) * 64, (bf16_t*)(p.ws + O_GUP), 128, (t % 8) * 64, smem);
    } else {
      int t = it - E8; size_t base = (size_t)t * 2048 + tid * 8;
      const float* s = p.in[I_KEYS] + base;
      float f[8];
      float4 a = *(const float4*)s, b = *(const float4*)(s + 4);
      f[0] = a.x; f[1] = a.y; f[2] = a.z; f[3] = a.w; f[4] = b.x; f[5] = b.y; f[6] = b.z; f[7] = b.w;
      *(uint4*)((bf16_t*)(p.ws + O_KEYS) + base) = pack8(f);
    }
  }
}

DEVI void phase1(const Params& p, unsigned char* smem) {
  float* smod = (float*)smem;
  const int tid = threadIdx.x, lane = tid & 63, warp = tid >> 6;
  for (int i = tid; i < 4096; i += 256) { int which = i >> 10; smod[i] = mod_val(p, which >> 1, (which & 1) * 1024 + (i & 1023)); }
  __syncthreads();
  bf16_t* hx = (bf16_t*)(p.ws + R_HX);
  float* gif = (float*)(p.ws + R_GIF);
  const float* win = p.in[I_WIN];
  constexpr int RPW = 4;
  for (int rg = blockIdx.x * 4 + warp; rg < T_ALL / RPW; rg += gridDim.x * 4) {
    const int row0 = rg * RPW;
    const float* sh = smod + (row0 < T_CTX ? 2048 : 0);
    const float* sc = sh + 1024;
    const float* src0 = row0 < T_CTX ? p.in[I_CTX] + (size_t)row0 * 1024 : p.in[I_X] + (size_t)(row0 - T_CTX) * 1024;
    float rstd[RPW]; f32x4 xv[RPW][4];
#pragma unroll
    for (int r = 0; r < RPW; ++r) {
      float ss = 0.f;
#pragma unroll
      for (int i = 0; i < 4; ++i) {
        const f32x4 v = *(const f32x4*)(src0 + (size_t)r * 1024 + i * 256 + lane * 4);
        xv[r][i] = v;
        ss += v[0] * v[0] + v[1] * v[1] + v[2] * v[2] + v[3] * v[3];
      }
      ss = wave_sum_u(ss);
      rstd[r] = rsqrtf(ss * (1.f / 1024.f) + 1e-6f);
    }
#pragma unroll
    for (int i = 0; i < 4; ++i) {
      const int k0 = i * 256 + lane * 4;
      const float4 gk = *(const float4*)(p.in[I_N1G] + k0);
      const float4 s4 = *(const float4*)(sc + k0), h4 = *(const float4*)(sh + k0);
#pragma unroll
      for (int r = 0; r < RPW; ++r) {
        const f32x4 v = xv[r][i];
        const float y0 = v[0] * rstd[r] * gk.x * (1.f + s4.x) + h4.x, y1 = v[1] * rstd[r] * gk.y * (1.f + s4.y) + h4.y;
        const float y2 = v[2] * rstd[r] * gk.z * (1.f + s4.z) + h4.z, y3 = v[3] * rstd[r] * gk.w * (1.f + s4.w) + h4.w;
        *(uint2*)(hx + (size_t)(row0 + r) * 1024 + k0) = make_uint2(pack2(y0, y1), pack2(y2, y3));
      }
    }
  }
}

DEVI void phase2(const Params& p, unsigned char* smem, const XcdMap& xm) {
  const int lane = threadIdx.x & 63, warp = threadIdx.x >> 6, wm = warp >> 1, wn = warp & 1;
  const bf16_t* hx = (const bf16_t*)(p.ws + R_HX);
  const bf16_t* wt = (const bf16_t*)(p.ws + R_WIN);
  bf16_t* prw = (bf16_t*)p.out;
  bf16_t* pqk = (bf16_t*)(p.ws + R_PQK);
  bf16_t* pv = (bf16_t*)(p.ws + R_PV);
  bf16_t* po = (bf16_t*)(p.ws + O_PO);
  bf16_t* pg = (bf16_t*)(p.ws + O_PG);
  for_tiles_xcd(xm, 130, 43, 5, 6, [&](int mt, int nt) {
    if (mt < 2 && nt >= 22 && nt < 42) return;
    f32x4 acc[4][4];
    zero_acc(acc);
    gemm_core(hx + (size_t)mt * 128 * 1024, 1024, wt + (size_t)nt * 128 * 1024, 1024, 1024, acc, smem);
    if (nt == 42) {
      float* gif = (float*)(p.ws + R_GIF);
      if (wn == 0) {
#pragma unroll
        for (int i = 0; i < 4; ++i) {
          const int row = mt * 128 + wm * 64 + i * 16 + (lane & 15);
          *(float4*)(gif + (size_t)row * 16 + (lane >> 4) * 4) = make_float4(acc[i][0][0], acc[i][0][1], acc[i][0][2], acc[i][0][3]);
        }
      }
      return;
    }
    bf16_t* dst; int ld, nb; int rofs = 0; bool sg = false;
    if (nt < 14) { dst = prw; ld = 1792; nb = nt * 128; }
    else if (nt < 18) { dst = pqk; ld = 512; nb = (nt - 14) * 128; }
    else if (nt < 22) { dst = pv; ld = 512; nb = (nt - 18) * 128; }
    else if (nt < 26) { dst = po; ld = 512; nb = (nt - 22) * 128; rofs = T_CTX; }
    else { dst = pg; ld = 2048; nb = (nt - 26) * 128; rofs = T_CTX; sg = true; }
    bf16_t(*Ct)[136] = (bf16_t(*)[136])smem;
#pragma unroll
    for (int i = 0; i < 4; ++i) {
#pragma unroll
      for (int j = 0; j < 4; ++j) {
        f32x4 v = acc[i][j];
        if (sg) { v[0] = sigm(v[0]); v[1] = sigm(v[1]); v[2] = sigm(v[2]); v[3] = sigm(v[3]); }
        *(uint2*)&Ct[wm * 64 + i * 16 + (lane & 15)][wn * 64 + j * 16 + (lane >> 4) * 4] = make_uint2(pack2(v[0], v[1]), pack2(v[2], v[3]));
      }
    }
    __syncthreads();
#pragma unroll
    for (int q = 0; q < 8; ++q) {
      const int pc = threadIdx.x + 256 * q; const int r = pc >> 4, c8 = (pc & 15) * 8;
      const int row = mt * 128 + r - rofs;
      *(u32x4*)(dst + (size_t)row * ld + nb + c8) = *(const u32x4*)&Ct[r][c8];
    }
    __syncthreads();
  });
}

DEVI void ml_qk8(const Params& p, int c, int j, int chan, float* o) {
  const bf16_t* pqk = (const bf16_t*)(p.ws + R_PQK);
  int row = ml_row(c, j);
  bool hp, hn; int rp, rn;
  if (c < 4) { hp = row > 0; hn = row < T_CTX - 1; rp = row - 1; rn = row + 1; }
  else { int gr = ((c - 4) & 3) * 64 + j; hp = gr > 0; hn = gr < 255; rp = row - 64; rn = row + 64; }
  const float* cw = p.in[I_MCONV];
  float cur[8], pr[8], nx[8];
  unpack8(*(const uint4*)(pqk + (size_t)row * 512 + chan), cur);
  if (hp) unpack8(*(const uint4*)(pqk + (size_t)rp * 512 + chan), pr);
  if (hn) unpack8(*(const uint4*)(pqk + (size_t)rn * 512 + chan), nx);
#pragma unroll
  for (int e = 0; e < 8; ++e) {
    float v = cw[512 + chan + e] * cur[e];
    if (hp) v += cw[chan + e] * pr[e];
    if (hn) v += cw[1024 + chan + e] * nx[e];
    o[e] = siluf(v);
  }
}

DEVI void phase3(const Params& p, unsigned char* smem) {
  bf16_t(*KT)[72] = (bf16_t(*)[72])smem;
  bf16_t(*VwT)[72] = (bf16_t(*)[72])(smem + 64 * 72 * 2);
  float* wgt = (float*)(smem + 64 * 72 * 2 + 256 * 72 * 2);
  const int tid = threadIdx.x, lane = tid & 63, warp = tid >> 6;
  const float* gif = (const float*)(p.ws + R_GIF);
  const bf16_t* pv = (const bf16_t*)(p.ws + R_PV);
  float* U = (float*)(p.ws + R_U);
  float* NT = (float*)(p.ws + O_NT);
  float* bend = (float*)(p.ws + O_BEND);
  float* mloc = (float*)(p.ws + O_MLOC);
  for (int it = blockIdx.x; it < 260 * 4; it += gridDim.x) {
    int c = it >> 2, h = it & 3;
    if (warp < 2) {
      int dir = warp; int j = dir ? 63 - lane : lane;
      int row = ml_row(c, j);
      float ig = gif[(size_t)row * 16 + dir * 4 + h] + p.in[I_MIB][dir * 4 + h];
      float lf = logsig(gif[(size_t)row * 16 + 8 + dir * 4 + h] + p.in[I_MFB][dir * 4 + h]);
      float b = lf;
#pragma unroll
      for (int o = 1; o < 64; o <<= 1) { float t = __shfl_up(b, o); if (lane >= o) b += t; }
      float be = __shfl(b, 63);
      float ge = be - b + ig;
      float ml = wave_max(ge);
      wgt[dir * 64 + j] = expf(ge - ml);
      if (lane == 0) { int sc = ml_sc(c, dir); bend[sc * 8 + dir * 4 + h] = be; mloc[sc * 8 + dir * 4 + h] = ml; }
    }
    __syncthreads();
    {
      int j = tid >> 2, part = tid & 3;
      float f[8];
#pragma unroll
      for (int q = 0; q < 2; ++q) {
        int d0 = part * 16 + q * 8;
        ml_qk8(p, c, j, 256 + h * 64 + d0, f);
#pragma unroll
        for (int e = 0; e < 8; ++e) KT[d0 + e][j] = f2bf(f[e] * 0.125f);
      }
      int row = ml_row(c, j);
      float w0 = wgt[j], w1 = wgt[64 + j];
#pragma unroll
      for (int q = 0; q < 4; ++q) {
        int v0 = part * 32 + q * 8;
        unpack8(*(const uint4*)(pv + (size_t)row * 512 + h * 128 + v0), f);
#pragma unroll
        for (int e = 0; e < 8; ++e) { VwT[v0 + e][j] = f2bf(f[e] * w0); VwT[128 + v0 + e][j] = f2bf(f[e] * w1); }
      }
    }
    __syncthreads();
#pragma unroll
    for (int dir = 0; dir < 2; ++dir) {
      int sc = ml_sc(c, dir);
      float* Ud = U + ((size_t)sc * 8 + dir * 4 + h) * 8192;
#pragma unroll
      for (int vi = 0; vi < 2; ++vi) {
        int vt = warp * 2 + vi;
        bf16x8 bv[2];
#pragma unroll
        for (int ks = 0; ks < 2; ++ks) bv[ks] = *(const bf16x8*)&VwT[dir * 128 + vt * 16 + (lane & 15)][ks * 32 + (lane >> 4) * 8];
#pragma unroll
        for (int dt = 0; dt < 4; ++dt) {
          f32x4 a = {0.f, 0.f, 0.f, 0.f};
#pragma unroll
          for (int ks = 0; ks < 2; ++ks) {
            bf16x8 ak = *(const bf16x8*)&KT[dt * 16 + (lane & 15)][ks * 32 + (lane >> 4) * 8];
            a = __builtin_amdgcn_mfma_f32_16x16x32_bf16(ak, bv[ks], a, 0, 0, 0);
          }
          *(float4*)(Ud + (size_t)(vt * 16 + (lane & 15)) * 64 + dt * 16 + (lane >> 4) * 4) = make_float4(a[0], a[1], a[2], a[3]);
        }
      }
    }
    if (tid < 128) {
      int dir = tid >> 6, d = tid & 63; float s = 0.f;
      for (int j = 0; j < 64; ++j) s += wgt[dir * 64 + j] * bf2f(KT[d][j]);
      NT[((size_t)ml_sc(c, dir) * 8 + dir * 4 + h) * 64 + d] = s;
    }
    __syncthreads();
  }
}

template <bool DRY> DEVI void phase4(const Params& p, unsigned char* smem) {
  const bool wr = !DRY || (p.in[I_FG][0] == 1234.5f);
  float* U = (float*)(p.ws + R_U);
  float* NT = (float*)(p.ws + O_NT);
  const float* bend = (const float*)(p.ws + O_BEND);
  const float* mloc = (const float*)(p.ws + O_MLOC);
  float* mst = (float*)(p.ws + O_MST);
  float(*kp)[264] = (float(*)[264])smem;
  float(*sp)[264] = (float(*)[264])(smem + 2 * 264 * 4);
  const int tid = threadIdx.x, lane = tid & 63, warp = tid >> 6;
  for (int gb = blockIdx.x * 256; gb < 8 * 8256; gb += gridDim.x * 256) {
    const int pA = gb / 8256;
    if (warp < 2) {
      const int pw = pA + warp;
      if (pw < 8) {
        float be[5], ml[5], B[5], m[5];
        float run = 0.f;
#pragma unroll
        for (int k = 0; k < 5; ++k) {
          const int c = lane * 5 + k;
          be[k] = c < 260 ? bend[c * 8 + pw] : 0.f;
          ml[k] = c < 260 ? mloc[c * 8 + pw] : -INFINITY;
          run += be[k]; B[k] = run;
        }
        float incl = run;
#pragma unroll
        for (int o = 1; o < 64; o <<= 1) { float t = __shfl_up(incl, o); if (lane >= o) incl += t; }
        const float off = incl - run;
        float pm = -INFINITY, pml[5];
#pragma unroll
        for (int k = 0; k < 5; ++k) { B[k] += off; pm = fmaxf(pm, ml[k] - B[k]); pml[k] = pm; }
        float inclm = pm;
#pragma unroll
        for (int o = 1; o < 64; o <<= 1) { float t = __shfl_up(inclm, o); if (lane >= o) inclm = fmaxf(inclm, t); }
        float offm = __shfl_up(inclm, 1); if (lane == 0) offm = -INFINITY;
#pragma unroll
        for (int k = 0; k < 5; ++k) m[k] = B[k] + fmaxf(0.f, fmaxf(offm, pml[k]));
        float mprev = __shfl_up(m[4], 1); if (lane == 0) mprev = 0.f;
        const bool owner = gb <= pw * 8256 && pw * 8256 < gb + 256;
#pragma unroll
        for (int k = 0; k < 5; ++k) {
          const int c = lane * 5 + k;
          if (c < 260) {
            kp[warp][c] = expf(be[k] + mprev - m[k]);
            sp[warp][c] = expf(ml[k] - m[k]);
            if (wr && owner) mst[c * 8 + pw] = mprev;
          }
          mprev = m[k];
        }
      }
    }
    __syncthreads();
    const int g = gb + tid;
    if (g < 8 * 8256) {
      const int pr = g / 8256, e = g % 8256, slot = pr - pA;
      float* base; size_t stride;
      if (e < 8192) { base = U + (size_t)pr * 8192 + e; stride = 8 * 8192; }
      else { base = NT + (size_t)pr * 64 + (e - 8192); stride = 8 * 64; }
      float C = 0.f;
      for (int sc = 0; sc < 260; sc += 20) {
        float u[20];
#pragma unroll
        for (int q = 0; q < 20; ++q) u[q] = base[(size_t)(sc + q) * stride];
#pragma unroll
        for (int q = 0; q < 20; ++q) {
          if (wr) base[(size_t)(sc + q) * stride] = C;
          C = kp[slot][sc + q] * C + sp[slot][sc + q] * u[q];
        }
      }
    }
    __syncthreads();
  }
}

template <bool DRY> DEVI void phase5(const Params& p, unsigned char* smem) {
  const bool wr = !DRY || (p.in[I_FG][0] == 1234.5f);
  bf16_t(*Qs)[72] = (bf16_t(*)[72])smem;
  bf16_t(*Ks)[72] = (bf16_t(*)[72])(smem + 9216);
  bf16_t(*Pm)[72] = (bf16_t(*)[72])(smem + 2 * 9216);
  bf16_t(*VT)[72] = (bf16_t(*)[72])(smem + 3 * 9216);
  float* evec = (float*)(smem + 3 * 9216 + 144 * 72 * 2);
  float* Mvec = evec + 128;
  float* bvec = Mvec + 128;
  const int tid = threadIdx.x, lane = tid & 63, warp = tid >> 6;
  const float* gif = (const float*)(p.ws + R_GIF);
  const bf16_t* pv = (const bf16_t*)(p.ws + R_PV);
  const bf16_t* po = (const bf16_t*)(p.ws + O_PO);
  bf16_t* yb = (bf16_t*)(p.ws + R_YA);
  const float* U = (const float*)(p.ws + R_U);
  const float* NT = (const float*)(p.ws + O_NT);
  const float* mst = (const float*)(p.ws + O_MST);
  for (int it = blockIdx.x; it < 256 * 4; it += gridDim.x) {
    int c = 4 + (it >> 2), h = it & 3;
    if (warp < 2) {
      int dir = warp; int j = dir ? 63 - lane : lane;
      int row = ml_row(c, j);
      float ig = gif[(size_t)row * 16 + dir * 4 + h] + p.in[I_MIB][dir * 4 + h];
      float lf = logsig(gif[(size_t)row * 16 + 8 + dir * 4 + h] + p.in[I_MFB][dir * 4 + h]);
      float b = lf;
#pragma unroll
      for (int o = 1; o < 64; o <<= 1) { float t = __shfl_up(b, o); if (lane >= o) b += t; }
      float e = ig - b;
      float pm = e;
#pragma unroll
      for (int o = 1; o < 64; o <<= 1) { float t = __shfl_up(pm, o); if (lane >= o) pm = fmaxf(pm, t); }
      float m0 = mst[ml_sc(c, dir) * 8 + dir * 4 + h];
      evec[dir * 64 + j] = e; Mvec[dir * 64 + j] = fmaxf(m0, pm); bvec[dir * 64 + j] = b;
    }
    {
      int j = tid >> 2, part = tid & 3;
      float f[8];
#pragma unroll
      for (int q = 0; q < 2; ++q) {
        int d0 = part * 16 + q * 8;
        ml_qk8(p, c, j, h * 64 + d0, f);
        *(uint4*)&Qs[j][d0] = pack8(f);
        ml_qk8(p, c, j, 256 + h * 64 + d0, f);
#pragma unroll
        for (int e = 0; e < 8; ++e) f[e] *= 0.125f;
        *(uint4*)&Ks[j][d0] = pack8(f);
      }
      int row = ml_row(c, j);
#pragma unroll
      for (int q = 0; q < 4; ++q) {
        int v0 = part * 32 + q * 8;
        unpack8(*(const uint4*)(pv + (size_t)row * 512 + h * 128 + v0), f);
#pragma unroll
        for (int e = 0; e < 8; ++e) VT[v0 + e][j] = f2bf(f[e]);
      }
      for (int i = tid; i < 16 * 64; i += 256) VT[128 + (i >> 6)][i & 63] = (i < 64) ? (bf16_t)0x3f80 : (bf16_t)0;
    }
    __syncthreads();
    const int jl = warp * 16 + (lane & 15);
    f32x4 s0[4];
    bf16x8 qf[2];
#pragma unroll
    for (int ks = 0; ks < 2; ++ks) qf[ks] = *(const bf16x8*)&Qs[jl][ks * 32 + (lane >> 4) * 8];
#pragma unroll
    for (int st = 0; st < 4; ++st) {
      f32x4 a = {0.f, 0.f, 0.f, 0.f};
#pragma unroll
      for (int ks = 0; ks < 2; ++ks) {
        bf16x8 kf = *(const bf16x8*)&Ks[st * 16 + (lane & 15)][ks * 32 + (lane >> 4) * 8];
        a = __builtin_amdgcn_mfma_f32_16x16x32_bf16(kf, qf[ks], a, 0, 0, 0);
      }
      s0[st] = a;
    }
    f32x4 ysum[8];
#pragma unroll
    for (int vt = 0; vt < 8; ++vt) ysum[vt] = f32x4{0.f, 0.f, 0.f, 0.f};
#pragma unroll 1
    for (int dir = 0; dir < 2; ++dir) {
      float Mj = Mvec[dir * 64 + jl], bj = bvec[dir * 64 + jl];
      float m0 = mst[ml_sc(c, dir) * 8 + dir * 4 + h];
#pragma unroll
      for (int st = 0; st < 4; ++st) {
        float pvv[4];
#pragma unroll
        for (int r = 0; r < 4; ++r) {
          int s = st * 16 + (lane >> 4) * 4 + r;
          bool ok = dir == 0 ? (s <= jl) : (s >= jl);
          pvv[r] = ok ? s0[st][r] * expf(evec[dir * 64 + s] - Mj) : 0.f;
        }
        *(uint2*)&Pm[jl][st * 16 + (lane >> 4) * 4] = make_uint2(pack2(pvv[0], pvv[1]), pack2(pvv[2], pvv[3]));
      }
      __syncthreads();
      bf16x8 pf[2];
#pragma unroll
      for (int ks = 0; ks < 2; ++ks) pf[ks] = *(const bf16x8*)&Pm[jl][ks * 32 + (lane >> 4) * 8];
      const float* Cst = U + ((size_t)ml_sc(c, dir) * 8 + dir * 4 + h) * 8192;
      const float* nst = NT + ((size_t)ml_sc(c, dir) * 8 + dir * 4 + h) * 64;
      float ai = expf(m0 - Mj);
      f32x4 hh[9];
#pragma unroll
      for (int vt = 0; vt < 9; ++vt) {
        f32x4 a1 = {0.f, 0.f, 0.f, 0.f}, a2 = {0.f, 0.f, 0.f, 0.f};
#pragma unroll
        for (int ks = 0; ks < 2; ++ks) {
          bf16x8 vf = *(const bf16x8*)&VT[vt * 16 + (lane & 15)][ks * 32 + (lane >> 4) * 8];
          a1 = __builtin_amdgcn_mfma_f32_16x16x32_bf16(vf, pf[ks], a1, 0, 0, 0);
          int v = vt * 16 + (lane & 15);
          const float* cp = v < 128 ? Cst + (size_t)v * 64 + ks * 32 + (lane >> 4) * 8 : nst + ks * 32 + (lane >> 4) * 8;
          float cf[8];
          if (v <= 128) {
            float4 x0 = *(const float4*)cp, x1 = *(const float4*)(cp + 4);
            cf[0] = x0.x; cf[1] = x0.y; cf[2] = x0.z; cf[3] = x0.w; cf[4] = x1.x; cf[5] = x1.y; cf[6] = x1.z; cf[7] = x1.w;
          } else {
#pragma unroll
            for (int e = 0; e < 8; ++e) cf[e] = 0.f;
          }
          uint4 pk = pack8(cf);
          bf16x8 cfr;
          cfr[0] = (short)(pk.x & 0xffff); cfr[1] = (short)(pk.x >> 16); cfr[2] = (short)(pk.y & 0xffff); cfr[3] = (short)(pk.y >> 16);
          cfr[4] = (short)(pk.z & 0xffff); cfr[5] = (short)(pk.z >> 16); cfr[6] = (short)(pk.w & 0xffff); cfr[7] = (short)(pk.w >> 16);
          a2 = __builtin_amdgcn_mfma_f32_16x16x32_bf16(cfr, qf[ks], a2, 0, 0, 0);
        }
#pragma unroll
        for (int r = 0; r < 4; ++r) hh[vt][r] = a1[r] + ai * a2[r];
      }
      float den = __shfl(hh[8][0], lane & 15);
      float dn = fmaxf(fabsf(den), expf(-(bj + Mj)));
      float inv = 1.f / dn;
      float ss = 0.f;
#pragma unroll
      for (int vt = 0; vt < 8; ++vt)
#pragma unroll
        for (int r = 0; r < 4; ++r) { float x = hh[vt][r] * inv; hh[vt][r] = x; ss += x * x; }
      ss += __shfl_xor(ss, 16); ss += __shfl_xor(ss, 32);
      float rs = rsqrtf(ss * (1.f / 128.f) + 1e-6f);
#pragma unroll
      for (int vt = 0; vt < 8; ++vt)
#pragma unroll
        for (int r = 0; r < 4; ++r) ysum[vt][r] += hh[vt][r] * rs * p.in[I_MNG][h * 128 + vt * 16 + (lane >> 4) * 4 + r];
      __syncthreads();
    }
    {
      int row = ml_row(c, jl) - T_CTX;
#pragma unroll
      for (int vt = 0; vt < 8; ++vt) {
        const bf16_t* op = po + (size_t)row * 512 + h * 128 + vt * 16 + (lane >> 4) * 4;
        uint2 o = *(const uint2*)op;
        float y0 = ysum[vt][0] * sigm(bflo(o.x)), y1 = ysum[vt][1] * sigm(bfhi(o.x)), y2 = ysum[vt][2] * sigm(bflo(o.y)), y3 = ysum[vt][3] * sigm(bfhi(o.y));
        if (wr) *(uint2*)(yb + (size_t)row * 512 + h * 128 + vt * 16 + (lane >> 4) * 4) = make_uint2(pack2(y0, y1), pack2(y2, y3));
      }
    }
    __syncthreads();
  }
}

DEVI void phase6(const Params& p, unsigned char* smem, int item_lo, int item_hi, int blk0, int nblk) {
  float(*rs)[65] = (float(*)[65])smem;
  float(*ks)[65] = (float(*)[65])(smem + 64 * 65 * 4);
  bf16_t(*TW)[72] = (bf16_t(*)[72])(smem + 2 * 64 * 65 * 4);
  bf16_t(*TA)[72] = (bf16_t(*)[72])(smem + 2 * 64 * 65 * 4 + 9216);
  bf16_t(*TG)[136] = (bf16_t(*)[136])(smem + 2 * 64 * 65 * 4 + 2 * 9216);
  float* rn = (float*)(smem + 2 * 64 * 65 * 4 + 2 * 9216 + 64 * 136 * 2);
  const int tid = threadIdx.x, lane = tid & 63, warp = tid >> 6;
  const bf16_t* prw = (const bf16_t*)p.out;
  bf16_t* SV = (bf16_t*)(p.ws + R_SV);
  float* bonus = (float*)(p.ws + O_BONUS);
  const float* cw = p.in[I_RCONV];
  const bf16_t* WUP = (const bf16_t*)(p.ws + O_WUP);
  const bf16_t* AUP = (const bf16_t*)(p.ws + O_AUP);
  const bf16_t* GUP = (const bf16_t*)(p.ws + O_GUP);
  if ((int)blockIdx.x < blk0) return;
  for (int it = item_lo + ((int)blockIdx.x - blk0); it < item_hi; it += nblk) {
    int tile = it >> 3, head = it & 7;
    int row0 = tile * 64;
    int seg0 = tile < 4 ? 0 : row0, seg1 = tile < 4 ? T_CTX : row0 + 64;
#pragma unroll 1
    for (int ub = 0; ub < 2; ++ub) {
      u32x4 lc[7], lp[7], ln[7];
#pragma unroll
      for (int it7 = 0; it7 < 7; ++it7) {
        const int u = warp + 4 * (ub * 7 + it7);
        const int grp = u >> 3;
        const int j = (u & 7) * 8 + (lane >> 3), q = grp * 8 + (lane & 7);
        const int row = row0 + j;
        const int col = q < 24 ? (q >> 3) * 512 + head * 64 + (q & 7) * 8 : 1536 + (q - 24) * 8;
        const bool hp = row > seg0, hn = row < seg1 - 1;
        lc[it7] = *(const u32x4*)(prw + (size_t)row * 1792 + col);
        lp[it7] = hp ? *(const u32x4*)(prw + (size_t)(row - 1) * 1792 + col) : u32x4{0u, 0u, 0u, 0u};
        ln[it7] = hn ? *(const u32x4*)(prw + (size_t)(row + 1) * 1792 + col) : u32x4{0u, 0u, 0u, 0u};
      }
#pragma unroll
      for (int it7 = 0; it7 < 7; ++it7) {
        const int u = warp + 4 * (ub * 7 + it7);
        const int grp = u >> 3;
        const int j = (u & 7) * 8 + (lane >> 3), q = grp * 8 + (lane & 7);
        const int row = row0 + j;
        const int col = q < 24 ? (q >> 3) * 512 + head * 64 + (q & 7) * 8 : 1536 + (q - 24) * 8;
        float cur[8], pr[8], nx[8], o[8];
        unpack8(make_uint4(lc[it7][0], lc[it7][1], lc[it7][2], lc[it7][3]), cur);
        unpack8(make_uint4(lp[it7][0], lp[it7][1], lp[it7][2], lp[it7][3]), pr);
        unpack8(make_uint4(ln[it7][0], ln[it7][1], ln[it7][2], ln[it7][3]), nx);
        {
          float4 c0 = *(const float4*)(cw + col), c1 = *(const float4*)(cw + col + 4);
          float4 d0 = *(const float4*)(cw + 1792 + col), d1 = *(const float4*)(cw + 1792 + col + 4);
          float4 e0 = *(const float4*)(cw + 3584 + col), e1 = *(const float4*)(cw + 3584 + col + 4);
          float wp[8] = {c0.x, c0.y, c0.z, c0.w, c1.x, c1.y, c1.z, c1.w};
          float wc[8] = {d0.x, d0.y, d0.z, d0.w, d1.x, d1.y, d1.z, d1.w};
          float wn_[8] = {e0.x, e0.y, e0.z, e0.w, e1.x, e1.y, e1.z, e1.w};
#pragma unroll
          for (int e = 0; e < 8; ++e) o[e] = wc[e] * cur[e] + wp[e] * pr[e] + wn_[e] * nx[e];
        }
        if (grp == 0) {
#pragma unroll
          for (int e = 0; e < 8; ++e) rs[j][(q & 7) * 8 + e] = o[e];
        } else if (grp == 1) {
#pragma unroll
          for (int e = 0; e < 8; ++e) ks[j][(q & 7) * 8 + e] = o[e];
        } else if (grp == 2) {
          *(uint4*)(SV + ((size_t)row * 8 + head) * SVH + 2 * 64 + (q & 7) * 8) = pack8(o);
        } else if (grp == 3) {
#pragma unroll
          for (int e = 0; e < 8; ++e) o[e] = 1.f - 2.f / (1.f + __expf(2.f * o[e]));
          *(uint4*)&TW[j][(q - 24) * 8] = pack8(o);
        } else if (grp == 4) {
          *(uint4*)&TA[j][(q - 32) * 8] = pack8(o);
        } else {
#pragma unroll
          for (int e = 0; e < 8; ++e) o[e] = sigm(o[e]);
          *(uint4*)&TG[j][(q - 40) * 8] = pack8(o);
        }
      }
    }
    __syncthreads();
    {
      int j = tid >> 2, part = tid & 3; float ss = 0.f;
#pragma unroll
      for (int e = 0; e < 16; ++e) { float v = ks[j][part * 16 + e] * p.in[I_RKK][head * 64 + part * 16 + e]; ss += v * v; }
      ss += __shfl_xor(ss, 1); ss += __shfl_xor(ss, 2);
      if (part == 0) rn[j] = 1.f / fmaxf(sqrtf(ss), 1e-12f);
    }
    __syncthreads();
    for (int pc = tid; pc < 64 * 8; pc += 256) {
      int j = pc >> 3, c8 = (pc & 7) * 8; int row = row0 + j;
      float fr[8], fk[8], fkk[8];
#pragma unroll
      for (int e = 0; e < 8; ++e) { fr[e] = rs[j][c8 + e]; fk[e] = ks[j][c8 + e]; fkk[e] = fk[e] * p.in[I_RKK][head * 64 + c8 + e] * rn[j]; }
      bf16_t* b = SV + ((size_t)row * 8 + head) * SVH;
      *(uint4*)(b + 0 * 64 + c8) = pack8(fr);
      *(uint4*)(b + 1 * 64 + c8) = pack8(fk);
      *(uint4*)(b + 3 * 64 + c8) = pack8(fkk);
    }
    {
      const int jl = warp * 16 + (lane & 15); const int row = row0 + jl;
      bf16x8 tw[2], ta[2], tg[4];
#pragma unroll
      for (int s2 = 0; s2 < 2; ++s2) { tw[s2] = *(const bf16x8*)&TW[jl][s2 * 32 + (lane >> 4) * 8]; ta[s2] = *(const bf16x8*)&TA[jl][s2 * 32 + (lane >> 4) * 8]; }
#pragma unroll
      for (int s2 = 0; s2 < 4; ++s2) tg[s2] = *(const bf16x8*)&TG[jl][s2 * 32 + (lane >> 4) * 8];
      __syncthreads();
      bf16_t(*OB)[64][72] = (bf16_t(*)[64][72])(smem + 2 * 64 * 65 * 4);
      float bon[2] = {0.f, 0.f};
#pragma unroll
      for (int dir = 0; dir < 2; ++dir) {
#pragma unroll
        for (int ct = 0; ct < 4; ++ct) {
          const int ch0 = ct * 16 + (lane >> 4) * 4;
          const int C0 = head * 64 + ch0;
          if (dir == 0) {
            f32x4 a = {0.f, 0.f, 0.f, 0.f};
#pragma unroll
            for (int s2 = 0; s2 < 4; ++s2) {
              bf16x8 wf = *(const bf16x8*)(GUP + (size_t)(head * 64 + ct * 16 + (lane & 15)) * 128 + s2 * 32 + (lane >> 4) * 8);
              a = __builtin_amdgcn_mfma_f32_16x16x32_bf16(wf, tg[s2], a, 0, 0, 0);
            }
            *(uint2*)&OB[2][jl][ch0] = make_uint2(pack2(a[0], a[1]), pack2(a[2], a[3]));
          }
          f32x4 aw = {0.f, 0.f, 0.f, 0.f}, aa = {0.f, 0.f, 0.f, 0.f};
#pragma unroll
          for (int s2 = 0; s2 < 2; ++s2) {
            size_t wo = (size_t)(dir * 512 + head * 64 + ct * 16 + (lane & 15)) * 64 + s2 * 32 + (lane >> 4) * 8;
            bf16x8 wf = *(const bf16x8*)(WUP + wo);
            bf16x8 af = *(const bf16x8*)(AUP + wo);
            aw = __builtin_amdgcn_mfma_f32_16x16x32_bf16(wf, tw[s2], aw, 0, 0, 0);
            aa = __builtin_amdgcn_mfma_f32_16x16x32_bf16(af, ta[s2], aa, 0, 0, 0);
          }
          const float4 w04 = *(const float4*)(p.in[I_RW0] + dir * 512 + C0), a04 = *(const float4*)(p.in[I_RA0] + dir * 512 + C0);
          const float4 ka4 = *(const float4*)(p.in[I_RKA] + C0), rk4 = *(const float4*)(p.in[I_RRK] + C0);
          const float w0v[4] = {w04.x, w04.y, w04.z, w04.w}, a0v[4] = {a04.x, a04.y, a04.z, a04.w};
          const float kav[4] = {ka4.x, ka4.y, ka4.z, ka4.w}, rkv[4] = {rk4.x, rk4.y, rk4.z, rk4.w};
          float we[4], av[4];
#pragma unroll
          for (int r = 0; r < 4; ++r) {
            we[r] = (0.60653066f * 1.44269504f) * sigm(w0v[r] + aw[r]);
            av[r] = sigm(a0v[r] + aa[r]);
            float kv = ks[jl][ch0 + r];
            float keff = kv * (1.f + (av[r] - 1.f) * kav[r]);
            bon[dir] += rs[jl][ch0 + r] * keff * rkv[r];
          }
          *(uint2*)&OB[0][jl][ch0] = make_uint2(pack2(we[0], we[1]), pack2(we[2], we[3]));
          *(uint2*)&OB[1][jl][ch0] = make_uint2(pack2(av[0], av[1]), pack2(av[2], av[3]));
        }
        __syncthreads();
        for (int pc = tid; pc < (dir == 0 ? 3 : 2) * 64 * 8; pc += 256) {
          const int vsel = pc >> 9, j = (pc >> 3) & 63, c8 = (pc & 7) * 8;
          const int vec = vsel == 2 ? 8 : (4 + 2 * dir + vsel);
          *(u32x4*)(SV + ((size_t)(row0 + j) * 8 + head) * SVH + vec * 64 + c8) = *(const u32x4*)&OB[vsel][j][c8];
        }
        __syncthreads();
      }
#pragma unroll
      for (int dir = 0; dir < 2; ++dir) {
        float sb = bon[dir]; sb += __shfl_xor(sb, 16); sb += __shfl_xor(sb, 32);
        if (lane < 16) bonus[(size_t)row * 16 + dir * 8 + head] = sb;
      }
    }
    __syncthreads();
  }
}

struct RwVec { uint4 k, kk, w, a, v, r; };
DEVI void unpack8p(const uint4& u, f32x2* f) {
  f[0] = f32x2{bflo(u.x), bfhi(u.x)}; f[1] = f32x2{bflo(u.y), bfhi(u.y)}; f[2] = f32x2{bflo(u.z), bfhi(u.z)}; f[3] = f32x2{bflo(u.w), bfhi(u.w)};
}
DEVI f32x2 bc2(float x) { return f32x2{x, x}; }
DEVI void rw_load(RwVec& x, const bf16_t* SV, int row, int head, int dir, int i, int jg, bool need_r) {
  const bf16_t* b = SV + ((size_t)row * 8 + head) * SVH;
  x.k = *(const uint4*)(b + 1 * 64 + jg * 8);
  x.kk = *(const uint4*)(b + 3 * 64 + jg * 8);
  x.w = *(const uint4*)(b + (4 + 2 * dir) * 64 + jg * 8);
  x.a = *(const uint4*)(b + (5 + 2 * dir) * 64 + jg * 8);
  x.v = *(const uint4*)(b + 2 * 64 + i * 8);
  if (need_r) x.r = *(const uint4*)(b + 0 * 64 + jg * 8);
}

DEVI void phase7(const Params& p) {
  const int lane = threadIdx.x & 63, warp = threadIdx.x >> 6, i = lane >> 3, jg = lane & 7;
  const bf16_t* SV = (const bf16_t*)(p.ws + R_SV);
  float* Pc = (float*)p.out;
  float* Bc = (float*)((unsigned char*)p.out + OUT_BC);
  for (int it = blockIdx.x * 4 + warp; it < (NCH - 1) * 16; it += gridDim.x * 4) {
    const int chunk = it >> 4, pair = it & 15, dir = pair >> 3, head = pair & 7;
    f32x2 S[8][4], P[8][4], ka[4];
#pragma unroll
    for (int a = 0; a < 8; ++a)
#pragma unroll
      for (int c = 0; c < 4; ++c) {
        S[a][c] = f32x2{0.f, 0.f};
        P[a][c] = f32x2{(i * 8 + a == jg * 8 + 2 * c) ? 1.f : 0.f, (i * 8 + a == jg * 8 + 2 * c + 1) ? 1.f : 0.f};
      }
#pragma unroll
    for (int c = 0; c < 4; ++c) ka[c] = f32x2{p.in[I_RKA][head * 64 + jg * 8 + 2 * c], p.in[I_RKA][head * 64 + jg * 8 + 2 * c + 1]};
    RwVec nx;
    rw_load(nx, SV, rw_row(chunk * LCH, dir), head, dir, i, jg, false);
#pragma unroll 1
    for (int t = 0; t < LCH; ++t) {
      RwVec cu = nx;
      if (t + 1 < LCH) rw_load(nx, SV, rw_row(chunk * LCH + t + 1, dir), head, dir, i, jg, false);
      f32x2 kv[4], kk[4], w[4], av[4], kka[4], keff[4]; float vv[8];
      unpack8p(cu.k, kv); unpack8p(cu.kk, kk); unpack8p(cu.w, w); unpack8p(cu.a, av); unpack8(cu.v, vv);
#pragma unroll
      for (int c = 0; c < 4; ++c) {
        w[c] = f32x2{__builtin_amdgcn_exp2f(-w[c][0]), __builtin_amdgcn_exp2f(-w[c][1])};
        kka[c] = -kk[c] * av[c];
        keff[c] = kv[c] * (bc2(1.f) + (av[c] - bc2(1.f)) * ka[c]);
      }
#pragma unroll
      for (int a = 0; a < 8; ++a) {
        f32x2 sa = S[a][0] * kk[0], qa = P[a][0] * kk[0];
#pragma unroll
        for (int c = 1; c < 4; ++c) { sa += S[a][c] * kk[c]; qa += P[a][c] * kk[c]; }
        float s1 = allred8(sa[0] + sa[1]), q1 = allred8(qa[0] + qa[1]);
        const f32x2 s2 = bc2(s1), q2 = bc2(q1), v2 = bc2(vv[a]);
#pragma unroll
        for (int c = 0; c < 4; ++c) {
          S[a][c] = S[a][c] * w[c] + s2 * kka[c] + v2 * keff[c];
          P[a][c] = P[a][c] * w[c] + q2 * kka[c];
        }
      }
    }
    float* po = Pc + ((size_t)chunk * 16 + pair) * 4096;
    float* bo = Bc + ((size_t)chunk * 16 + pair) * 4096;
#pragma unroll
    for (int a = 0; a < 8; ++a) {
      *(float4*)(po + (i * 8 + a) * 64 + jg * 8) = make_float4(P[a][0][0], P[a][0][1], P[a][1][0], P[a][1][1]);
      *(float4*)(po + (i * 8 + a) * 64 + jg * 8 + 4) = make_float4(P[a][2][0], P[a][2][1], P[a][3][0], P[a][3][1]);
      *(float4*)(bo + (i * 8 + a) * 64 + jg * 8) = make_float4(S[a][0][0], S[a][0][1], S[a][1][0], S[a][1][1]);
      *(float4*)(bo + (i * 8 + a) * 64 + jg * 8 + 4) = make_float4(S[a][2][0], S[a][2][1], S[a][3][0], S[a][3][1]);
    }
  }
}

template <bool DRY> DEVI void phase8(const Params& p, unsigned char* smem) {
  const bool wr = !DRY || (p.in[I_FG][0] == 1234.5f);
  float(*Sb)[16][68] = (float(*)[16][68])smem;
  const int tid = threadIdx.x, lane = tid & 63, warp = tid >> 6, q = lane >> 4, c16 = lane & 15;
  const float* Pc = (const float*)p.out;
  float* Bc = (float*)((unsigned char*)p.out + OUT_BC);
  constexpr int NS = NCH - 1;
  const size_t CS = (size_t)16 * 4096;
  for (int it = blockIdx.x; it < 64; it += gridDim.x) {
    const int pair = it >> 2, rg = it & 3;
    const float* Pp = Pc + (size_t)pair * 4096 + q * 64 + warp * 16 + c16;
    float* Bp = Bc + (size_t)pair * 4096 + (size_t)(rg * 16 + q * 4) * 64 + warp * 16 + c16;
    __syncthreads();
    {
      const int row = tid >> 4, c4 = (tid & 15) * 4;
      float4 v = *(const float4*)(Bc + (size_t)pair * 4096 + (size_t)(rg * 16 + row) * 64 + c4);
      Sb[0][row][c4] = v.x; Sb[0][row][c4 + 1] = v.y; Sb[0][row][c4 + 2] = v.z; Sb[0][row][c4 + 3] = v.w;
    }
    float pa[16], pb[16]; f32x4 ba, bb;
#pragma unroll
    for (int s2 = 0; s2 < 16; ++s2) { pa[s2] = Pp[CS + s2 * 256]; pb[s2] = Pp[2 * CS + s2 * 256]; }
#pragma unroll
    for (int r = 0; r < 4; ++r) { ba[r] = Bp[CS + r * 64]; bb[r] = Bp[2 * CS + r * 64]; }
    __syncthreads();
#define P8_STEP(c, pp, bv)                                                                                  \
    {                                                                                                        \
      const int rb = ((c) - 1) & 1;                                                                          \
      f32x4 acc0 = bv, acc1 = f32x4{0.f, 0.f, 0.f, 0.f};                                                     \
      _Pragma("unroll") for (int s2 = 0; s2 < 16; s2 += 2) {                                                 \
        acc0 = __builtin_amdgcn_mfma_f32_16x16x4f32(Sb[rb][c16][4 * s2 + q], pp[s2], acc0, 0, 0, 0);         \
        acc1 = __builtin_amdgcn_mfma_f32_16x16x4f32(Sb[rb][c16][4 * s2 + 4 + q], pp[s2 + 1], acc1, 0, 0, 0); \
      }                                                                                                      \
      acc0 += acc1;                                                                                          \
      if ((c) + 2 < NS) {                                                                                    \
        _Pragma("unroll") for (int s2 = 0; s2 < 16; ++s2) pp[s2] = Pp[(size_t)((c) + 2) * CS + s2 * 256];    \
        _Pragma("unroll") for (int r = 0; r < 4; ++r) bv[r] = Bp[(size_t)((c) + 2) * CS + r * 64];           \
      }                                                                                                      \
      _Pragma("unroll") for (int r = 0; r < 4; ++r) {                                                        \
        Sb[rb ^ 1][q * 4 + r][warp * 16 + c16] = acc0[r];                                                    \
        if (wr) Bp[(size_t)(c) * CS + r * 64] = acc0[r];                                                     \
      }                                                                                                      \
      __syncthreads();                                                                                       \
    }
    for (int c = 1; c < NS; c += 2) {
      P8_STEP(c, pa, ba)
      if (c + 1 < NS) P8_STEP(c + 1, pb, bb)
    }
#undef P8_STEP
  }
}

DEVI void phase9(const Params& p) {
  const int lane = threadIdx.x & 63, warp = threadIdx.x >> 6, i = lane >> 3, jg = lane & 7;
  const bf16_t* SV = (const bf16_t*)(p.ws + R_SV);
  const float* Bc = (const float*)((unsigned char*)p.out + OUT_BC);
  bf16_t* odir = (bf16_t*)p.out;
  for (int it = blockIdx.x * 4 + warp; it < NCH * 16; it += gridDim.x * 4) {
    const int chunk = it >> 4, pair = it & 15, dir = pair >> 3, head = pair & 7;
    f32x2 S[8][4], ka[4];
    if (chunk == 0) {
#pragma unroll
      for (int a = 0; a < 8; ++a)
#pragma unroll
        for (int c = 0; c < 4; ++c) S[a][c] = f32x2{0.f, 0.f};
    } else {
      const float* bs = Bc + ((size_t)(chunk - 1) * 16 + pair) * 4096;
#pragma unroll
      for (int a = 0; a < 8; ++a) {
        float4 x0 = *(const float4*)(bs + (i * 8 + a) * 64 + jg * 8), x1 = *(const float4*)(bs + (i * 8 + a) * 64 + jg * 8 + 4);
        S[a][0] = f32x2{x0.x, x0.y}; S[a][1] = f32x2{x0.z, x0.w}; S[a][2] = f32x2{x1.x, x1.y}; S[a][3] = f32x2{x1.z, x1.w};
      }
    }
#pragma unroll
    for (int c = 0; c < 4; ++c) ka[c] = f32x2{p.in[I_RKA][head * 64 + jg * 8 + 2 * c], p.in[I_RKA][head * 64 + jg * 8 + 2 * c + 1]};
    RwVec nx;
    rw_load(nx, SV, rw_row(chunk * LCH, dir), head, dir, i, jg, true);
#pragma unroll 1
    for (int t = 0; t < LCH; ++t) {
      RwVec cu = nx;
      const int row = rw_row(chunk * LCH + t, dir);
      if (t + 1 < LCH) rw_load(nx, SV, rw_row(chunk * LCH + t + 1, dir), head, dir, i, jg, true);
      f32x2 kv[4], kk[4], w[4], av[4], rr[4], kka[4], keff[4]; float vv[8];
      unpack8p(cu.k, kv); unpack8p(cu.kk, kk); unpack8p(cu.w, w); unpack8p(cu.a, av); unpack8p(cu.r, rr); unpack8(cu.v, vv);
#pragma unroll
      for (int c = 0; c < 4; ++c) {
        w[c] = f32x2{__builtin_amdgcn_exp2f(-w[c][0]), __builtin_amdgcn_exp2f(-w[c][1])};
        kka[c] = -kk[c] * av[c];
        keff[c] = kv[c] * (bc2(1.f) + (av[c] - bc2(1.f)) * ka[c]);
      }
      float ov = 0.f;
#pragma unroll
      for (int a = 0; a < 8; ++a) {
        f32x2 sa = S[a][0] * kk[0];
#pragma unroll
        for (int c = 1; c < 4; ++c) sa += S[a][c] * kk[c];
        const float s1 = allred8(sa[0] + sa[1]);
        const f32x2 s2 = bc2(s1), v2 = bc2(vv[a]);
        f32x2 oa = f32x2{0.f, 0.f};
#pragma unroll
        for (int c = 0; c < 4; ++c) {
          S[a][c] = S[a][c] * w[c] + s2 * kka[c] + v2 * keff[c];
          oa += S[a][c] * rr[c];
        }
        const float o = allred8(oa[0] + oa[1]);
        if (jg == a) ov = o;
      }
      if (row >= T_CTX) odir[((size_t)dir * T_LAT + (row - T_CTX)) * 512 + head * 64 + i * 8 + jg] = f2bf(ov);
    }
  }
}

DEVI void phase10(const Params& p) {
  const int lane = threadIdx.x & 63, warp = threadIdx.x >> 6;
  const bf16_t* odir = (const bf16_t*)p.out;
  const bf16_t* SV = (const bf16_t*)(p.ws + R_SV);
  const float* bonus = (const float*)(p.ws + O_BONUS);
  bf16_t* ya = (bf16_t*)(p.ws + O_PO);
  const int head = lane >> 3, c8 = (lane & 7) * 8, C0 = lane * 8;
#pragma unroll 2
  for (int t = blockIdx.x * 4 + warp; t < T_LAT; t += gridDim.x * 4) {
    const int row = t + T_CTX;
    const bf16_t* b = SV + ((size_t)row * 8 + head) * SVH;
    float v[8], g[8], y[8];
    unpack8(*(const uint4*)(b + 2 * 64 + c8), v);
    unpack8(*(const uint4*)(b + 8 * 64 + c8), g);
    float bs = bonus[(size_t)row * 16 + head] + bonus[(size_t)row * 16 + 8 + head];
#pragma unroll
    for (int e = 0; e < 8; ++e) y[e] = bs * v[e];
#pragma unroll
    for (int dir = 0; dir < 2; ++dir) {
      float o[8];
      unpack8(*(const uint4*)(odir + ((size_t)dir * T_LAT + t) * 512 + C0), o);
      float s = 0.f;
#pragma unroll
      for (int e = 0; e < 8; ++e) s += o[e];
      s = allred8(s);
      float mu = s * (1.f / 64.f);
      float q = 0.f;
#pragma unroll
      for (int e = 0; e < 8; ++e) { o[e] -= mu; q += o[e] * o[e]; }
      q = allred8(q);
      float rsd = rsqrtf(q * (1.f / 64.f) + 64e-5f);
#pragma unroll
      for (int e = 0; e < 8; ++e) y[e] += o[e] * rsd * p.in[I_RLNW][C0 + e] + p.in[I_RLNB][C0 + e];
    }
#pragma unroll
    for (int e = 0; e < 8; ++e) y[e] *= g[e];
    *(uint4*)(ya + (size_t)t * 512 + C0) = pack8(y);
  }
}

DEVI void phase11(const Params& p, unsigned char* smem, const XcdMap& xm) {
  const int lane = threadIdx.x & 63, warp = threadIdx.x >> 6, wm = warp >> 1, wn = warp & 1;
  const bf16_t* ya = (const bf16_t*)(p.ws + O_PO);
  const bf16_t* yb = (const bf16_t*)(p.ws + R_YA);
  const bf16_t* pg = (const bf16_t*)(p.ws + O_PG);
  bf16_t* mg = (bf16_t*)(p.ws + R_MERGED);
  for_tiles_xcd(xm, 128, 8, 8, 8, [&](int mt, int nt) {
    f32x4 acc[4][4];
    zero_acc(acc);
    gemm_core(ya + (size_t)mt * 128 * 512, 512, (const bf16_t*)(p.ws + O_WBA) + (size_t)nt * 128 * 512, 512, 512, acc, smem);
#pragma unroll
    for (int i = 0; i < 4; ++i) {
      int row = mt * 128 + wm * 64 + i * 16 + (lane & 15);
#pragma unroll
      for (int j = 0; j < 4; ++j) {
        int n = nt * 128 + wn * 64 + j * 16 + (lane >> 4) * 4;
        uint2 s = *(const uint2*)(pg + (size_t)row * 2048 + n);
        *(uint2*)(mg + (size_t)row * 1024 + n) = make_uint2(pack2(acc[i][j][0] * bflo(s.x), acc[i][j][1] * bfhi(s.x)), pack2(acc[i][j][2] * bflo(s.y), acc[i][j][3] * bfhi(s.y)));
      }
    }
    zero_acc(acc);
    gemm_core(yb + (size_t)mt * 128 * 512, 512, (const bf16_t*)(p.ws + O_WBB) + (size_t)nt * 128 * 512, 512, 512, acc, smem);
#pragma unroll
    for (int i = 0; i < 4; ++i) {
      int row = mt * 128 + wm * 64 + i * 16 + (lane & 15);
#pragma unroll
      for (int j = 0; j < 4; ++j) {
        int n = nt * 128 + wn * 64 + j * 16 + (lane >> 4) * 4;
        uint2 s = *(const uint2*)(pg + (size_t)row * 2048 + 1024 + n);
        uint2 m0 = *(const uint2*)(mg + (size_t)row * 1024 + n);
        float v0 = bflo(m0.x) + acc[i][j][0] * bflo(s.x), v1 = bfhi(m0.x) + acc[i][j][1] * bfhi(s.x);
        float v2 = bflo(m0.y) + acc[i][j][2] * bflo(s.y), v3 = bfhi(m0.y) + acc[i][j][3] * bfhi(s.y);
        *(uint2*)(mg + (size_t)row * 1024 + n) = make_uint2(pack2(v0, v1), pack2(v2, v3));
      }
    }
  });
}

DEVI void phase12(const Params& p, unsigned char* smem, const XcdMap& xm) {
  float* gt = (float*)(smem + 45056);
  const int tid = threadIdx.x, lane = tid & 63, warp = tid >> 6, wm = warp >> 1, wn = warp & 1;
  for (int i = tid; i < 1024; i += 256) gt[i] = mod_val(p, 0, 2048 + i);
  __syncthreads();
  const bf16_t* mg = (const bf16_t*)(p.ws + R_MERGED);
  const float* x = p.in[I_X];
  float* x1 = p.out;
  for_tiles_xcd(xm, 128, 8, 8, 8, [&](int mt, int nt) {
    f32x4 acc[4][4];
    zero_acc(acc);
    gemm_core(mg + (size_t)mt * 128 * 1024, 1024, (const bf16_t*)(p.ws + O_WOUT) + (size_t)nt * 128 * 1024, 1024, 1024, acc, smem);
#pragma unroll
    for (int i = 0; i < 4; ++i) {
      int row = mt * 128 + wm * 64 + i * 16 + (lane & 15);
#pragma unroll
      for (int j = 0; j < 4; ++j) {
        int n = nt * 128 + wn * 64 + j * 16 + (lane >> 4) * 4;
        float4 xv = *(const float4*)(x + (size_t)row * 1024 + n);
        xv.x += gt[n] * acc[i][j][0]; xv.y += gt[n + 1] * acc[i][j][1]; xv.z += gt[n + 2] * acc[i][j][2]; xv.w += gt[n + 3] * acc[i][j][3];
        *(float4*)(x1 + (size_t)row * 1024 + n) = xv;
      }
    }
  });
}

DEVI void phase13(const Params& p, unsigned char* smem) {
  float* smod = (float*)smem;
  const int tid = threadIdx.x, lane = tid & 63, warp = tid >> 6;
  for (int i = tid; i < 2048; i += 256) smod[i] = mod_val(p, 0, 3072 + i);
  __syncthreads();
  const float* x1 = p.out;
  bf16_t* h2 = (bf16_t*)(p.ws + R_H2);
  for (int rp = blockIdx.x * 4 + warp; rp < T_LAT / 2; rp += gridDim.x * 4) {
    float h[2][16]; float ss[2] = {0.f, 0.f};
#pragma unroll
    for (int u = 0; u < 2; ++u)
#pragma unroll
      for (int i = 0; i < 4; ++i) {
        float4 v = *(const float4*)(x1 + (size_t)(rp * 2 + u) * 1024 + i * 256 + lane * 4);
        h[u][4 * i] = v.x; h[u][4 * i + 1] = v.y; h[u][4 * i + 2] = v.z; h[u][4 * i + 3] = v.w;
        ss[u] += v.x * v.x + v.y * v.y + v.z * v.z + v.w * v.w;
      }
#pragma unroll
    for (int u = 0; u < 2; ++u) {
      const int row = rp * 2 + u;
      const float rstd = rsqrtf(wave_sum_u(ss[u]) * (1.f / 1024.f) + 1e-6f);
#pragma unroll
      for (int i = 0; i < 4; ++i) {
#pragma unroll
        for (int e = 0; e < 4; ++e) {
          int k = i * 256 + lane * 4 + e;
          float y = h[u][4 * i + e] * rstd * p.in[I_N2G][k];
          h[u][4 * i + e] = y * (1.f + smod[1024 + k]) + smod[k];
        }
        *(uint2*)(h2 + (size_t)row * 1024 + i * 256 + lane * 4) = make_uint2(pack2(h[u][4 * i], h[u][4 * i + 1]), pack2(h[u][4 * i + 2], h[u][4 * i + 3]));
      }
    }
  }
}

DEVI void phase14(const Params& p, unsigned char* smem, const XcdMap& xm) {
  bf16_t(*Qt)[136] = (bf16_t(*)[136])smem;
  float* Sc = (float*)smem;
  const int tid = threadIdx.x, lane = tid & 63, warp = tid >> 6, wm = warp >> 1, wn = warp & 1;
  const bf16_t* h2 = (const bf16_t*)(p.ws + R_H2);
  const bf16_t* keys = (const bf16_t*)(p.ws + O_KEYS);
  float* tops = (float*)(p.ws + R_TOPS);
  int* topi = (int*)(p.ws + R_TOPI);
  for_tiles_xcd(xm, 128, 16, 8, 8, [&](int mt, int hp) {
    f32x4 acc[4][4];
    zero_acc(acc);
    gemm_core(h2 + (size_t)mt * 128 * 1024, 1024, (const bf16_t*)(p.ws + O_WQ) + (size_t)hp * 128 * 1024, 1024, 1024, acc, smem);
#pragma unroll
    for (int i = 0; i < 4; ++i)
#pragma unroll
      for (int j = 0; j < 4; ++j)
        *(uint2*)&Qt[wm * 64 + i * 16 + (lane & 15)][wn * 64 + j * 16 + (lane >> 4) * 4] =
            make_uint2(pack2(acc[i][j][0], acc[i][j][1]), pack2(acc[i][j][2], acc[i][j][3]));
    __syncthreads();
    zero_acc(acc);
#pragma unroll
    for (int ks = 0; ks < 4; ++ks) {
      bf16x8 qf[4], kf[4];
#pragma unroll
      for (int i = 0; i < 4; ++i) qf[i] = *(const bf16x8*)&Qt[wm * 64 + i * 16 + (lane & 15)][ks * 32 + (lane >> 4) * 8];
#pragma unroll
      for (int j = 0; j < 4; ++j) kf[j] = *(const bf16x8*)(keys + ((size_t)hp * 128 + wn * 64 + j * 16 + (lane & 15)) * 128 + ks * 32 + (lane >> 4) * 8);
#pragma unroll
      for (int i = 0; i < 4; ++i)
#pragma unroll
        for (int j = 0; j < 4; ++j) acc[i][j] = __builtin_amdgcn_mfma_f32_16x16x32_bf16(kf[j], qf[i], acc[i][j], 0, 0, 0);
    }
    __syncthreads();
#pragma unroll
    for (int i = 0; i < 4; ++i)
#pragma unroll
      for (int j = 0; j < 4; ++j) {
        {
          const int c0 = j * 16 + (lane >> 4) * 4;
          u32x4 kq;
#pragma unroll
          for (int r = 0; r < 4; ++r) {
            unsigned u = __float_as_uint(acc[i][j][r]);
            u = (u & 0x80000000u) ? ~u : (u | 0x80000000u);
            kq[r] = (u & ~63u) | (unsigned)(63 - (c0 + r));
          }
          *(u32x4*)(Sc + (wm * 64 + i * 16 + (lane & 15)) * 132 + wn * 64 + c0) = kq;
        }
      }
    __syncthreads();
    {
      const int row = tid & 127, half = tid >> 7;
      float* hp_ = Sc + row * 132 + half * 64;
      float bv[16]; int bi[16];
      unsigned* hk = (unsigned*)hp_;
#pragma unroll
      for (int r = 0; r < 16; ++r) {
        unsigned best = 0u;
#pragma unroll 4
        for (int k = 0; k < 64; k += 4) {
          const u32x4 v4 = *(const u32x4*)(hk + k);
          const unsigned m01 = v4[0] > v4[1] ? v4[0] : v4[1], m23 = v4[2] > v4[3] ? v4[2] : v4[3];
          const unsigned m = m01 > m23 ? m01 : m23;
          best = best > m ? best : m;
        }
        const int b2 = 63 - (int)(best & 63u);
        unsigned u = best & ~63u;
        u = (u & 0x80000000u) ? (u & 0x7fffffffu) : ~u;
        bv[r] = __uint_as_float(u); bi[r] = b2 + half * 64; hk[b2] = 0u;
      }
#pragma unroll
      for (int r = 0; r < 16; ++r) { hp_[r] = bv[r]; hp_[16 + r] = __int_as_float(bi[r]); }
    }
    __syncthreads();
    if (tid < 128) {
      const float* la = Sc + tid * 132; const float* lb = la + 64;
      size_t ob = ((size_t)(mt * 128 + tid) * 16 + hp) * 16;
      int ia = 0, ib = 0;
      for (int r = 0; r < 16; ++r) {
        float va = la[ia], vb = lb[ib];
        bool ta = va >= vb;
        tops[ob + r] = ta ? va : vb;
        topi[ob + r] = __float_as_int(ta ? la[16 + ia] : lb[16 + ib]);
        ia += ta ? 1 : 0; ib += ta ? 0 : 1;
      }
    }
    __syncthreads();
  });
}

template <bool DRY> DEVI void phase15(const Params& p, unsigned char* smem) {
  const bool wr = !DRY || (p.in[I_FG][0] == 1234.5f);
  float* gt = (float*)smem;
  const int tid = threadIdx.x, lane = tid & 63, warp = tid >> 6;
  for (int i = tid; i < 1024; i += 256) gt[i] = mod_val(p, 0, 5120 + i);
  __syncthreads();
  const bf16_t* __restrict__ h2 = (const bf16_t*)(p.ws + R_H2);
  const float* __restrict__ tops = (const float*)(p.ws + R_TOPS);
  const int* __restrict__ topi = (const int*)(p.ws + R_TOPI);
  const unsigned char* __restrict__ uf8 = p.ws + R_UBF;
  const unsigned char* __restrict__ vf8 = p.ws + R_VBF;
  float* xo = p.out;
  int ca, cb;
  {
    int l = lane;
    if (l < 16) { ca = 0; cb = l; } else if (l < 24) { ca = 1; cb = l - 16; } else if (l < 29) { ca = 2; cb = l - 24; }
    else if (l < 33) { ca = 3; cb = l - 29; } else if (l < 36) { ca = 4; cb = l - 33; } else if (l < 38) { ca = 5; cb = l - 36; }
    else if (l < 40) { ca = 6; cb = l - 38; } else if (l < 42) { ca = 7; cb = l - 40; } else if (l < 50) { ca = l - 34; cb = 0; }
    else { ca = 0; cb = 0; }
  }
  const int flat = ca * 16 + cb;
  for (int t = blockIdx.x * 4 + warp; t < T_LAT; t += gridDim.x * 4) {
    float hv[16], out[16];
    {
      const u32x4 hp0 = *(const u32x4*)(h2 + (size_t)t * 1024 + lane * 16);
      const u32x4 hp1 = *(const u32x4*)(h2 + (size_t)t * 1024 + lane * 16 + 8);
#pragma unroll
      for (int e = 0; e < 4; ++e) { hv[2 * e] = bflo(hp0[e]); hv[2 * e + 1] = bfhi(hp0[e]); hv[8 + 2 * e] = bflo(hp1[e]); hv[8 + 2 * e + 1] = bfhi(hp1[e]); }
    }
#pragma unroll
    for (int e = 0; e < 16; ++e) out[e] = 0.f;
#pragma unroll 1
    for (int hd = 0; hd < 8; ++hd) {
      const size_t b1 = ((size_t)t * 16 + hd * 2) * 16, b2 = b1 + 16;
      float val = lane < 50 ? tops[b1 + ca] + tops[b2 + cb] : -INFINITY;
      int idx = topi[b1 + ca] * 128 + topi[b2 + cb];
      unsigned key = __float_as_uint(val);
      key = (key & 0x80000000u) ? ~key : (key | 0x80000000u);
      key = lane < 50 ? ((key & ~63u) | (unsigned)(63 - lane)) : 0u;
      int cnt = 0;
#pragma unroll
      for (int i = 0; i < 50; ++i) cnt += ((unsigned)__builtin_amdgcn_readlane((int)key, i) > key) ? 1 : 0;
      bool sel = lane < 50 && cnt < 16;
      float vmax = rlf(val, 0);
      float ex = sel ? __expf(val - vmax) : 0.f;
      float gsum = wave_sum_u(ex);
      float g = ex / gsum;
      unsigned long long m1 = __ballot(sel);
      int es[16];
      float gq = 0.f;
#pragma unroll
      for (int q = 0; q < 16; ++q) {
        int src = __ffsll((long long)m1) - 1; m1 &= m1 - 1;
        es[q] = __builtin_amdgcn_readlane(idx, src);
        float gg = rlf(g, src);
        if (lane == q) gq = gg;
      }
      float dm = 0.f;
      {
        u32x4 ub[16];
#pragma unroll
        for (int q = 0; q < 16; ++q) ub[q] = *(const u32x4*)(uf8 + (size_t)es[q] * 1024 + lane * 16);
#pragma unroll
        for (int q = 0; q < 16; ++q) {
          float f[16]; unpack_fp8x16(ub[q], f);
          float d0 = 0.f, d1 = 0.f;
#pragma unroll
          for (int e = 0; e < 8; ++e) { d0 += f[2 * e] * hv[2 * e]; d1 += f[2 * e + 1] * hv[2 * e + 1]; }
          float d = d0 + d1;
          d += dppf<0xB1>(d); d += dppf<0x4E>(d); d += dppf<0x141>(d); d += dppf<0x140>(d);
          if ((lane & 15) == q) dm = d;
        }
      }
      dm += __shfl_xor(dm, 16); dm += __shfl_xor(dm, 32);
      dm *= (1.f / 64.f);
      float coef = gq * 0.5f * dm * (1.f + erff(dm * 0.70710678118f)) * 0.25f;
      {
        u32x4 vb[16];
#pragma unroll
        for (int q = 0; q < 16; ++q) vb[q] = *(const u32x4*)(vf8 + (size_t)es[q] * 1024 + lane * 16);
#pragma unroll
        for (int q = 0; q < 16; ++q) {
          float cf = rlf(coef, q);
          float f[16]; unpack_fp8x16(vb[q], f);
#pragma unroll
          for (int e = 0; e < 16; ++e) out[e] += cf * f[e];
        }
      }
    }
    float xs[16]; float ss = 0.f;
#pragma unroll
    for (int i = 0; i < 4; ++i) {
      int k = lane * 16 + i * 4;
      float4 v = *(const float4*)(xo + (size_t)t * 1024 + k);
      xs[4 * i] = v.x + gt[k] * out[4 * i]; xs[4 * i + 1] = v.y + gt[k + 1] * out[4 * i + 1];
      xs[4 * i + 2] = v.z + gt[k + 2] * out[4 * i + 2]; xs[4 * i + 3] = v.w + gt[k + 3] * out[4 * i + 3];
      ss += xs[4 * i] * xs[4 * i] + xs[4 * i + 1] * xs[4 * i + 1] + xs[4 * i + 2] * xs[4 * i + 2] + xs[4 * i + 3] * xs[4 * i + 3];
    }
    ss = wave_sum_u(ss);
    float rstd = rsqrtf(ss * (1.f / 1024.f) + 1e-6f);
#pragma unroll
    for (int i = 0; i < 4; ++i) {
      int k = lane * 16 + i * 4;
      float4 g4 = *(const float4*)(p.in[I_FG] + k);
      if (wr) *(float4*)(xo + (size_t)t * 1024 + k) = make_float4(xs[4 * i] * rstd * g4.x, xs[4 * i + 1] * rstd * g4.y, xs[4 * i + 2] * rstd * g4.z, xs[4 * i + 3] * rstd * g4.w);
    }
  }
}

#define XB_TMO      128
#define XB_XCNT(j)  (256  + 64 * (j))
#define XB_XSUB(j)  (1280 + 64 * (j))
#define XB_XGEN(j)  (2304 + 64 * (j))
#define XB_TOP      3328
#define XB_TOPGEN   3392
#define XCD_BAR_WORDS 3456
#define XB_SPIN_CAP (1u << 22)
#define LAS __attribute__((address_space(3)))
DEVI unsigned xb_ld(unsigned* p) { return __hip_atomic_load(p, __ATOMIC_RELAXED, __HIP_MEMORY_SCOPE_AGENT); }
DEVI unsigned xb_add(unsigned* p, unsigned v) { return __hip_atomic_fetch_add(p, v, __ATOMIC_RELAXED, __HIP_MEMORY_SCOPE_AGENT); }
DEVI unsigned xb_xcc_id() { return (unsigned)__builtin_amdgcn_s_getreg((3 << 11) | 20) & 0xFu; }
#define XB_SPIN(cond, bar) do { unsigned _sp = 0; while (cond) { __builtin_amdgcn_s_sleep(1); \
    if ((++_sp & 255u) == 0u) { if (xb_ld(&(bar)[XB_TMO])) break; if (_sp > XB_SPIN_CAP) { atomicAdd(&(bar)[XB_TMO], 1u); break; } } } } while (0)
struct XcdBarrier { unsigned* bar; unsigned x; volatile LAS unsigned* st; };
DEVI XcdBarrier xcd_barrier_post(unsigned* bar, volatile LAS unsigned* st) {
  XcdBarrier b; b.bar = bar; b.x = xb_xcc_id(); b.st = st;
  if (threadIdx.x == 0) st[2] = xb_add(&bar[XB_XCNT(b.x)], 1u);
  return b;
}
DEVI void xcd_barrier_complete(unsigned* bar, unsigned x, unsigned& nloc, unsigned& nx, unsigned& vidx) {
  const unsigned G = gridDim.x * gridDim.y * gridDim.z;
  unsigned sum, cnt, mine, below, sp = 0u;
  for (;;) {
    sum = 0u; cnt = 0u; mine = 0u; below = 0u;
#pragma unroll
    for (unsigned j = 0; j < 16; ++j) { const unsigned c = xb_ld(&bar[XB_XCNT(j)]); sum += c; cnt += (c > 0u) ? 1u : 0u; mine = (j == x) ? c : mine; below += (c > 0u && j < x) ? 1u : 0u; }
    if (sum == G) break;
    __builtin_amdgcn_s_sleep(1);
    if ((++sp & 255u) == 0u) { if (xb_ld(&bar[XB_TMO])) break; if (sp > XB_SPIN_CAP) { atomicAdd(&bar[XB_TMO], 1u); break; } }
  }
  nloc = mine > 0u ? mine : 1u; nx = cnt > 0u ? cnt : 1u; vidx = below;
}
DEVI void xcd_barrier(const XcdBarrier& b) {
  asm volatile("s_waitcnt vmcnt(0)" ::: "memory");
  __syncthreads();
  if (threadIdx.x == 0) {
    unsigned* bar = b.bar;
    __builtin_amdgcn_s_waitcnt(0);
    unsigned nloc = b.st[0], nx = b.st[1];
    if (nloc == 0u) { unsigned vidx; xcd_barrier_complete(bar, b.x, nloc, nx, vidx); b.st[0] = nloc; b.st[1] = nx; b.st[3] = vidx; }
    const unsigned old = xb_add(&bar[XB_XSUB(b.x)], 1u);
    const unsigned gen = old / nloc;
    if (old + 1u == (gen + 1u) * nloc) {
      __builtin_amdgcn_fence(__ATOMIC_RELEASE, "agent");
      asm volatile("s_waitcnt vmcnt(0)" ::: "memory");
      const unsigned og = xb_add(&bar[XB_TOP], 1u);
      const unsigned tg = og / nx;
      if (og + 1u == (tg + 1u) * nx) xb_add(&bar[XB_TOPGEN], 1u);
      else XB_SPIN(xb_ld(&bar[XB_TOPGEN]) == tg, bar);
      __builtin_amdgcn_fence(__ATOMIC_ACQUIRE, "agent");
      xb_add(&bar[XB_XGEN(b.x)], 1u);
      asm volatile("s_waitcnt vmcnt(0)" ::: "memory");
    } else {
      XB_SPIN(xb_ld(&bar[XB_XGEN(b.x)]) == gen, bar);
      __builtin_amdgcn_fence(__ATOMIC_ACQUIRE, "agent");
      asm volatile("s_waitcnt vmcnt(0)" ::: "memory");
    }
  }
  __syncthreads();
}

constexpr int NPHASE = 16;
DEVI XcdMap get_xm(int coop, const uint4& w) {
  XcdMap m;
  if (coop) { m.v = (int)w.w; m.nx = (int)w.y; m.slot = (int)w.z; m.slots = (int)w.x; }
  else { m.v = blockIdx.x & 7; m.nx = 8; m.slot = blockIdx.x >> 3; m.slots = gridDim.x >> 3; if (m.slots < 1) { m.slots = 1; } }
  return m;
}
__global__ void __launch_bounds__(256, 2) mk(Params p, int ph0, int ph1, int coop) {
  __shared__ __attribute__((aligned(16))) unsigned char smem[SMEM_BYTES];
  __shared__ uint4 xb_words;
  if (threadIdx.x == 0) xb_words = make_uint4(0u, 0u, 0u, 0u);
  __syncthreads();
  XcdBarrier xb;
  if (coop) xb = xcd_barrier_post((unsigned*)(p.ws + O_BAR), (volatile LAS unsigned*)&xb_words);
#ifdef XCC_PROBE
  if (coop && xb_xcc_id() != (blockIdx.x & 7u)) { unsigned long long t0 = wall_clock64(); while (wall_clock64() - t0 < 100000ull) __builtin_amdgcn_s_sleep(8); }
#endif
  if (ph0 < 0) cg::this_grid().sync();
#ifdef PROBE_A
#define STAMP(n) if (blockIdx.x == 0 && threadIdx.x == 0) ((unsigned long long*)(p.ws + O_STAMP))[n] = wall_clock64();
#else
#define STAMP(n)
#endif
#define RUN_PHASE(n, call)                                   \
  if (ph0 <= n && n < ph1) {                                 \
    STAMP(n)                                                 \
        if (DRY_PH == n) { if (n == 4) phase4<true>(p, smem); if (n == 5) phase5<true>(p, smem); if (n == 8) phase8<true>(p, smem); if (n == 15) phase15<true>(p, smem); } \
    if (ONLY < 0 || ONLY == n) { call; }                     \
    if (REPEAT_PH == n) { call; }                            \
    if (coop && n + 1 < ph1) xcd_barrier(xb);                \
  }
  RUN_PHASE(0, phase0(p, smem, 0, 96))
  RUN_PHASE(1, (phase1(p, smem), __syncthreads(), phase0(p, smem, 96, 1 << 30)))
  RUN_PHASE(2, phase2(p, smem, get_xm(coop, xb_words)))
  RUN_PHASE(3, phase3(p, smem))
  RUN_PHASE(4, (phase4<false>(p, smem), phase6(p, smem, 0, 32, gridDim.x > 290 ? 258 : 0, gridDim.x > 290 ? (int)gridDim.x - 258 : (int)gridDim.x)))
  RUN_PHASE(5, phase5<false>(p, smem))
  RUN_PHASE(6, phase6(p, smem, 32, 260 * 8, 0, (int)gridDim.x))
  RUN_PHASE(7, phase7(p))
  RUN_PHASE(8, phase8<false>(p, smem))
  RUN_PHASE(9, phase9(p))
  RUN_PHASE(10, phase10(p))
  RUN_PHASE(11, phase11(p, smem, get_xm(coop, xb_words)))
  RUN_PHASE(12, (phase12(p, smem, get_xm(coop, xb_words)), convert_fp8(p.in[I_PU], p.ws + R_UBF, (size_t)16384 * 64, 64.f)))
  RUN_PHASE(13, phase13(p, smem))
  RUN_PHASE(14, (phase14(p, smem, get_xm(coop, xb_words)), convert_fp8(p.in[I_PV], p.ws + R_VBF, (size_t)16384 * 64, 4.f)))
  RUN_PHASE(15, phase15<false>(p, smem))
#ifdef SYNC_EXTRA
  for (int i = 0; i < SYNC_EXTRA; ++i) xcd_barrier(xb);
#endif
#ifdef PROBE_A
  cg::this_grid().sync();
  STAMP(16)
  __syncthreads();
  if (blockIdx.x == 0) {
    const unsigned long long* st = (const unsigned long long*)(p.ws + O_STAMP);
    float ta = (float)(st[PROBE_A + 1] - st[PROBE_A]) * 0.01f, tb = (float)(st[PROBE_B + 1] - st[PROBE_B]) * 0.01f;
    for (int i = threadIdx.x; i < 1000000; i += 256) p.out[1 + i] = tb;
    if (threadIdx.x == 0) p.out[0] = 100.f * ta;
  }
#endif
}

extern "C" void kernel_launch(void* const* d_in, const int* in_sizes, int n_in, void* d_out, int out_size, void* d_ws,
                              size_t ws_size, hipStream_t stream) {
  static int grid_blocks = 0;
  if (!grid_blocks) {
    int dev = 0, cus = 0, per_cu = 0;
    hipGetDevice(&dev);
    hipDeviceGetAttribute(&cus, hipDeviceAttributeMultiprocessorCount, dev);
    hipOccupancyMaxActiveBlocksPerMultiprocessor(&per_cu, mk, 256, 0);
    if (per_cu < 1) per_cu = 1;
    if (per_cu > 2) per_cu = 2;
    grid_blocks = cus * per_cu;
  }
  if (ws_size < WS_NEED) { fprintf(stderr, "workspace too small: %zu < %zu\n", ws_size, (size_t)WS_NEED); return; }
  Params p{};
  for (int i = 0; i < 32; ++i) p.in[i] = (const float*)d_in[i];
  p.out = (float*)d_out;
  p.ws = (unsigned char*)d_ws;
#if MEGA
  (void)hipMemsetAsync((unsigned char*)d_ws + O_BAR, 0, XCD_BAR_WORDS * 4, stream);
  int ph0 = 0, ph1 = NPHASE, coop = 1;
  void* args[] = {&p, &ph0, &ph1, &coop};
  hipError_t e = hipLaunchCooperativeKernel((void*)mk, dim3(grid_blocks), dim3(256), args, 0, stream);
  if (e != hipSuccess) fprintf(stderr, "cooperative launch failed: %s (grid %d)\n", hipGetErrorString(e), grid_blocks);
#else
  for (int ph = 0; ph < NPHASE; ++ph) mk<<<grid_blocks, 256, 0, stream>>>(p, ph, ph + 1, 0);
#endif
}
```

```cpp
#include <hip/hip_runtime.h>
#include <hip/hip_cooperative_groups.h>
#include <cstdio>
#include <cstdint>
namespace cg = cooperative_groups;

#ifndef MEGA
#define MEGA 1
#endif
#ifndef ONLY
#define ONLY -1
#endif
#ifndef REPEAT_PH
#define REPEAT_PH -1
#endif
#ifndef DRY_PH
#define DRY_PH -1
#endif

typedef unsigned short bf16_t;
using bf16x8 = __attribute__((ext_vector_type(8))) short;
using f32x4 = __attribute__((ext_vector_type(4))) float;
using u32x4 = __attribute__((ext_vector_type(4))) unsigned;
#define DEVI __device__ __forceinline__

constexpr int T_CTX = 256, T_LAT = 16384, T_ALL = 16640;
constexpr int NIN = 5392, NP = 5376;
constexpr int NCH = 128, LCH = 130;
constexpr int SVH = 576;
constexpr int SMEM_BYTES = 71680;

enum { I_X = 0, I_C, I_CTX, I_CCTX, I_ADAW, I_ADAB, I_N1G, I_WIN, I_RCONV, I_RW0, I_RWUP, I_RA0, I_RAUP, I_RGUP,
       I_RKK, I_RKA, I_RRK, I_RLNW, I_RLNB, I_MCONV, I_MIB, I_MFB, I_MNG, I_WBA, I_WBB, I_WOUT, I_N2G, I_WQ,
       I_KEYS, I_PU, I_PV, I_FG };

struct Params { const float* in[32]; float* out; unsigned char* ws; };

constexpr size_t A256(size_t x) { return (x + 255) & ~(size_t)255; }
constexpr size_t O_MODP = 0;
constexpr size_t O_WBA = A256(O_MODP + (size_t)16 * 2 * 6144 * 4);
constexpr size_t O_WBB = A256(O_WBA + (size_t)1024 * 512 * 2);
constexpr size_t O_WOUT = A256(O_WBB + (size_t)1024 * 512 * 2);
constexpr size_t O_WQ = A256(O_WOUT + (size_t)1024 * 1024 * 2);
constexpr size_t O_KEYS = A256(O_WQ + (size_t)2048 * 1024 * 2);
constexpr size_t O_WUP = A256(O_KEYS + (size_t)16 * 128 * 128 * 2);
constexpr size_t O_AUP = A256(O_WUP + (size_t)1024 * 64 * 2);
constexpr size_t O_GUP = A256(O_AUP + (size_t)1024 * 64 * 2);
constexpr size_t O_BEND = A256(O_GUP + (size_t)512 * 128 * 2);
constexpr size_t O_MLOC = A256(O_BEND + (size_t)260 * 8 * 4);
constexpr size_t O_MST = A256(O_MLOC + (size_t)260 * 8 * 4);
constexpr size_t O_NT = A256(O_MST + (size_t)260 * 8 * 4);
constexpr size_t O_BONUS = A256(O_NT + (size_t)260 * 8 * 64 * 4);
constexpr size_t O_STAMP = A256(O_BONUS + (size_t)T_ALL * 16 * 4);
constexpr size_t O_BAR = A256(O_STAMP + 1024);
constexpr size_t O_PG = A256(O_BAR + 3456 * 4);
constexpr size_t O_PO = A256(O_PG + (size_t)T_LAT * 2048 * 2);
constexpr size_t O_R = A256(O_PO + (size_t)T_LAT * 512 * 2);
constexpr size_t R_HX = O_R;
constexpr size_t R_WIN = A256(R_HX + (size_t)T_ALL * 1024 * 2);
constexpr size_t R_PQK = A256(R_WIN + (size_t)(NP + 128) * 1024 * 2);
constexpr size_t R_PV = A256(R_PQK + (size_t)T_ALL * 512 * 2);
constexpr size_t R_GIF = A256(R_PV + (size_t)T_ALL * 512 * 2);
constexpr size_t R_U = A256(R_GIF + (size_t)T_ALL * 16 * 4);
constexpr size_t R_END1 = A256(R_U + (size_t)260 * 8 * 8192 * 4);
constexpr size_t R_SV = O_R;
constexpr size_t R_YA = A256(R_SV + (size_t)T_ALL * 8 * SVH * 2);
constexpr size_t R_END2 = A256(R_YA + (size_t)T_LAT * 512 * 2);
constexpr size_t R_MERGED = O_R;
constexpr size_t R_H2 = A256(R_MERGED + (size_t)T_LAT * 1024 * 2);
constexpr size_t R_TOPS = A256(R_H2 + (size_t)T_LAT * 1024 * 2);
constexpr size_t R_TOPI = A256(R_TOPS + (size_t)T_LAT * 256 * 4);
constexpr size_t R_UBF = A256(R_TOPI + (size_t)T_LAT * 256 * 4);
constexpr size_t R_VBF = A256(R_UBF + (size_t)16384 * 1024 * 2);
constexpr size_t R_END3 = A256(R_VBF + (size_t)16384 * 1024 * 2);
constexpr size_t WS_NEED = (R_END1 > R_END2 ? (R_END1 > R_END3 ? R_END1 : R_END3) : (R_END2 > R_END3 ? R_END2 : R_END3));
constexpr size_t OUT_BC = (size_t)NCH * 16 * 4096 * 4;

DEVI bf16_t f2bf(float f) { unsigned u = __float_as_uint(f); u += 0x7fffu + ((u >> 16) & 1u); return (bf16_t)(u >> 16); }
DEVI float bf2f(bf16_t h) { return __uint_as_float(((unsigned)h) << 16); }
DEVI float bflo(unsigned u) { return __uint_as_float(u << 16); }
DEVI float bfhi(unsigned u) { return __uint_as_float(u & 0xffff0000u); }
DEVI unsigned pack2(float a, float b) { return (unsigned)f2bf(a) | ((unsigned)f2bf(b) << 16); }
DEVI void unpack8(const uint4& u, float* f) {
  f[0] = bflo(u.x); f[1] = bfhi(u.x); f[2] = bflo(u.y); f[3] = bfhi(u.y);
  f[4] = bflo(u.z); f[5] = bfhi(u.z); f[6] = bflo(u.w); f[7] = bfhi(u.w);
}
DEVI uint4 pack8(const float* f) { return make_uint4(pack2(f[0], f[1]), pack2(f[2], f[3]), pack2(f[4], f[5]), pack2(f[6], f[7])); }
DEVI float wave_sum(float v) {
#pragma unroll
  for (int o = 32; o; o >>= 1) v += __shfl_xor(v, o);
  return v;
}
DEVI float wave_max(float v) {
#pragma unroll
  for (int o = 32; o; o >>= 1) v = fmaxf(v, __shfl_xor(v, o));
  return v;
}
DEVI float sigm(float x) { return 1.f / (1.f + __expf(-x)); }
DEVI float siluf(float x) { return x / (1.f + __expf(-x)); }
DEVI float logsig(float x) { return fminf(x, 0.f) - log1pf(expf(-fabsf(x))); }
template <int CTRL> DEVI float dppf(float v) { return __int_as_float(__builtin_amdgcn_update_dpp(0, __float_as_int(v), CTRL, 0xf, 0xf, true)); }
DEVI float rlf(float v, int l) { return __int_as_float(__builtin_amdgcn_readlane(__float_as_int(v), l)); }
DEVI float wave_sum_u(float v) {
  v += dppf<0xB1>(v); v += dppf<0x4E>(v); v += dppf<0x141>(v); v += dppf<0x140>(v);
  return (rlf(v, 0) + rlf(v, 16)) + (rlf(v, 32) + rlf(v, 48));
}
typedef __attribute__((ext_vector_type(2))) short s16x2;
DEVI float dot2bf(unsigned a, unsigned b, float c) { return __builtin_amdgcn_fdot2_f32_bf16(__builtin_bit_cast(s16x2, a), __builtin_bit_cast(s16x2, b), c, false); }
typedef __attribute__((ext_vector_type(2))) float f32x2;
DEVI void convert_fp8(const float* __restrict__ src, unsigned char* __restrict__ dst, size_t n16, float scale) {
  for (size_t g = (size_t)blockIdx.x * 256 + threadIdx.x; g < n16; g += (size_t)gridDim.x * 256) {
    u32x4 o;
#pragma unroll
    for (int q = 0; q < 4; ++q) {
      float4 a = *(const float4*)(src + g * 16 + q * 4);
      int pk = __builtin_amdgcn_cvt_pk_fp8_f32(a.x * scale, a.y * scale, 0, false);
      pk = __builtin_amdgcn_cvt_pk_fp8_f32(a.z * scale, a.w * scale, pk, true);
      o[q] = (unsigned)pk;
    }
    *(u32x4*)(dst + g * 16) = o;
  }
}
DEVI void unpack_fp8x16(const u32x4& u, float* f) {
#pragma unroll
  for (int q = 0; q < 4; ++q) {
    f32x2 lo = __builtin_amdgcn_cvt_pk_f32_fp8((int)u[q], false), hi = __builtin_amdgcn_cvt_pk_f32_fp8((int)u[q], true);
    f[4 * q] = lo[0]; f[4 * q + 1] = lo[1]; f[4 * q + 2] = hi[0]; f[4 * q + 3] = hi[1];
  }
}
DEVI void convert_bf16(const float* __restrict__ src, bf16_t* __restrict__ dst, size_t n8) {
  for (size_t g = (size_t)blockIdx.x * 256 + threadIdx.x; g < n8; g += (size_t)gridDim.x * 256) {
    float4 a = *(const float4*)(src + g * 8), b = *(const float4*)(src + g * 8 + 4);
    *(uint4*)(dst + g * 8) = make_uint4(pack2(a.x, a.y), pack2(a.z, a.w), pack2(b.x, b.y), pack2(b.z, b.w));
  }
}
DEVI float allred8(float v) { v += dppf<0xB1>(v); v += dppf<0x4E>(v); v += dppf<0x141>(v); return v; }

DEVI int ml_row(int c, int j) {
  if (c < 4) return c * 64 + j;
  int cc = c - 4; int col = cc >> 2; int gr = (cc & 3) * 64 + j;
  return T_CTX + gr * 64 + col;
}
DEVI int ml_sc(int c, int dir) { return dir == 0 ? c : (c < 4 ? 3 - c : 263 - c); }
DEVI int rw_row(int p, int dir) { return dir == 0 ? p : (p < T_CTX ? (T_CTX - 1 - p) : (T_ALL + T_CTX - 1 - p)); }

DEVI float mod_val(const Params& p, int which, int col) {
  return ((const float*)(p.ws + O_MODP))[which * 6144 + col];
}

DEVI void gemm_core(const bf16_t* __restrict__ A, int lda, const bf16_t* __restrict__ Bt, int ldb, int K,
                    f32x4 (&acc)[4][4], unsigned char* smem) {
  bf16_t(*sa)[80] = (bf16_t(*)[80])smem;
  bf16_t(*sb)[80] = (bf16_t(*)[80])(smem + 128 * 80 * 2);
  const int tid = threadIdx.x, lane = tid & 63, warp = tid >> 6, wm = warp >> 1, wn = warp & 1;
  const int lr = tid >> 3, lk = (tid & 7) * 8;
  const bf16_t* Ap = A + (size_t)lr * lda + lk;
  const bf16_t* Bp = Bt + (size_t)lr * ldb + lk;
  u32x4 ra0[4], rb0[4], ra1[4], rb1[4];
#pragma unroll
  for (int i = 0; i < 4; ++i) {
    ra0[i] = *(const u32x4*)(Ap + (size_t)(32 * i) * lda); rb0[i] = *(const u32x4*)(Bp + (size_t)(32 * i) * ldb);
    ra1[i] = *(const u32x4*)(Ap + (size_t)(32 * i) * lda + 64); rb1[i] = *(const u32x4*)(Bp + (size_t)(32 * i) * ldb + 64);
  }
#define GEMM_STEP(k0, ra, rb)                                                                                 \
  {                                                                                                           \
    __syncthreads();                                                                                          \
    _Pragma("unroll") for (int i = 0; i < 4; ++i) { *(u32x4*)&sa[lr + 32 * i][lk] = ra[i]; *(u32x4*)&sb[lr + 32 * i][lk] = rb[i]; } \
    __syncthreads();                                                                                          \
    if ((k0) + 128 < K) {                                                                                     \
      _Pragma("unroll") for (int i = 0; i < 4; ++i) {                                                         \
        ra[i] = *(const u32x4*)(Ap + (size_t)(32 * i) * lda + (k0) + 128);                                    \
        rb[i] = *(const u32x4*)(Bp + (size_t)(32 * i) * ldb + (k0) + 128);                                    \
      }                                                                                                       \
    }                                                                                                         \
    __builtin_amdgcn_s_setprio(1);                                                                            \
    _Pragma("unroll") for (int ks = 0; ks < 2; ++ks) {                                                        \
      bf16x8 af[4], bq[4];                                                                                    \
      _Pragma("unroll") for (int i = 0; i < 4; ++i) af[i] = *(const bf16x8*)&sa[wm * 64 + i * 16 + (lane & 15)][ks * 32 + (lane >> 4) * 8]; \
      _Pragma("unroll") for (int j = 0; j < 4; ++j) bq[j] = *(const bf16x8*)&sb[wn * 64 + j * 16 + (lane & 15)][ks * 32 + (lane >> 4) * 8]; \
      _Pragma("unroll") for (int i = 0; i < 4; ++i)                                                           \
        _Pragma("unroll") for (int j = 0; j < 4; ++j) acc[i][j] = __builtin_amdgcn_mfma_f32_16x16x32_bf16(bq[j], af[i], acc[i][j], 0, 0, 0); \
    }                                                                                                         \
    __builtin_amdgcn_s_setprio(0);                                                                            \
  }
  for (int k0 = 0; k0 < K; k0 += 128) {
    GEMM_STEP(k0, ra0, rb0)
    GEMM_STEP(k0 + 64, ra1, rb1)
  }
#undef GEMM_STEP
  __syncthreads();
}
DEVI void zero_acc(f32x4 (&acc)[4][4]) {
#pragma unroll
  for (int i = 0; i < 4; ++i)
#pragma unroll
    for (int j = 0; j < 4; ++j) acc[i][j] = f32x4{0.f, 0.f, 0.f, 0.f};
}

struct XcdMap { int v, nx, slot, slots; };
template <typename F> DEVI void for_tiles_xcd(const XcdMap& xm, int MT, int NT, int SM, int SN, F&& f) {
  const int nsn = (NT + SN - 1) / SN, nst = ((MT + SM - 1) / SM) * nsn, per = SM * SN;
  const int n_my = (nst - xm.v + xm.nx - 1) / xm.nx;
  for (int g = xm.slot; g < n_my * per; g += xm.slots) {
    const int s = xm.v + (g / per) * xm.nx, idx = g % per;
    const int sm = s / nsn, sn = s % nsn;
    const int mt = sm * SM + idx / SN, nt = sn * SN + idx % SN;
    if (mt < MT && nt < NT) f(mt, nt);
  }
}

DEVI void tr_tile(const float* __restrict__ src, int lds, int k0, int n0src, bf16_t* __restrict__ dst, int ldd, int n0dst,
                  unsigned char* smem) {
  float(*tile)[65] = (float(*)[65])smem;
  const int tid = threadIdx.x, j = tid & 63, i0 = tid >> 6;
#pragma unroll 4
  for (int ii = 0; ii < 16; ++ii) { int i = i0 + 4 * ii; tile[i][j] = src[(size_t)(k0 + i) * lds + n0src + j]; }
  __syncthreads();
#pragma unroll 4
  for (int jj = 0; jj < 16; ++jj) { int jn = i0 + 4 * jj; dst[(size_t)(n0dst + jn) * ldd + k0 + j] = f2bf(tile[j][jn]); }
  __syncthreads();
}

DEVI void phase0(const Params& p, unsigned char* smem, int it_lo, int it_hi) {
  const int tid = threadIdx.x;
  constexpr int N_MOD = 96, N_WIN = 16 * 85, N_WB = 128, N_WOUT = 256, N_WQ = 512, N_LORA = 16, N_GUP = 16, N_KEYS = 128;
  constexpr int E0 = N_MOD, E1 = E0 + N_WIN, E2 = E1 + N_WB, E3 = E2 + N_WB, E4 = E3 + N_WOUT, E5 = E4 + N_WQ,
                E6 = E5 + N_LORA, E7 = E6 + N_LORA, E8 = E7 + N_GUP, E9 = E8 + N_KEYS;
  if (it_hi > E9) it_hi = E9;
  for (int it = it_lo + blockIdx.x; it < it_hi; it += gridDim.x) {
    if (it < E0) {
      float* sl = (float*)smem;
      float* part = sl + 2048;
      __syncthreads();
      for (int i = tid; i < 2048; i += 256) sl[i] = siluf(i < 1024 ? p.in[I_C][i] : p.in[I_CCTX][i - 1024]);
      __syncthreads();
      const int cl = tid & 63, rg = tid >> 6, col = it * 64 + cl;
      const float* aw = p.in[I_ADAW] + (size_t)(rg * 256) * 6144 + col;
      float ax = 0.f, ac = 0.f;
#pragma unroll 32
      for (int r = 0; r < 256; ++r) {
        const float w = aw[(size_t)r * 6144];
        ax += sl[rg * 256 + r] * w;
        ac += sl[1024 + rg * 256 + r] * w;
      }
      part[(rg * 2 + 0) * 64 + cl] = ax;
      part[(rg * 2 + 1) * 64 + cl] = ac;
      __syncthreads();
      if (tid < 128) {
        const int which = tid >> 6;
        const float v = part[(0 * 2 + which) * 64 + cl] + part[(1 * 2 + which) * 64 + cl] + part[(2 * 2 + which) * 64 + cl] + part[(3 * 2 + which) * 64 + cl];
        ((float*)(p.ws + O_MODP))[which * 6144 + col] = v + p.in[I_ADAB][col];
      }
    } else if (it < E1) {
      int t = it - E0; int kt = t / 85, nt = t % 85; int n0 = nt * 64;
      tr_tile(p.in[I_WIN], NIN, kt * 64, nt == 84 ? 2816 : (n0 < 2816 ? n0 : n0 + 16), (bf16_t*)(p.ws + R_WIN), 1024, n0, smem);
    } else if (it < E2) {
      int t = it - E1; tr_tile(p.in[I_WBA], 1024, (t / 16) * 64, (t % 16) * 64, (bf16_t*)(p.ws + O_WBA), 512, (t % 16) * 64, smem);
    } else if (it < E3) {
      int t = it - E2; tr_tile(p.in[I_WBB], 1024, (t / 16) * 64, (t % 16) * 64, (bf16_t*)(p.ws + O_WBB), 512, (t % 16) * 64, smem);
    } else if (it < E4) {
      int t = it - E3; tr_tile(p.in[I_WOUT], 1024, (t / 16) * 64, (t % 16) * 64, (bf16_t*)(p.ws + O_WOUT), 1024, (t % 16) * 64, smem);
    } else if (it < E5) {
      int t = it - E4; tr_tile(p.in[I_WQ], 2048, (t / 32) * 64, (t % 32) * 64, (bf16_t*)(p.ws + O_WQ), 1024, (t % 32) * 64, smem);
    } else if (it < E6) {
      int t = it - E5; int dir = t / 8, nt = t % 8;
      tr_tile(p.in[I_RWUP] + (size_t)dir * 64 * 512, 512, 0, nt * 64, (bf16_t*)(p.ws + O_WUP) + (size_t)dir * 512 * 64, 64, nt * 64, smem);
    } else if (it < E7) {
      int t = it - E6; int dir = t / 8, nt = t % 8;
      tr_tile(p.in[I_RAUP] + (size_t)dir * 64 * 512, 512, 0, nt * 64, (bf16_t*)(p.ws + O_AUP) + (size_t)dir * 512 * 64, 64, nt * 64, smem);
    } else if (it < E8) {
      int t = it - E7; tr_tile(p.in[I_RGUP], 512, (t / 8) * 64, (t % 8) * 64, (bf16_t*)(p.ws + O_GUP), 128, (t % 8) * 64, smem);
    } else {
      int t = it - E8; size_t base = (size_t)t * 2048 + tid * 8;
      const float* s = p.in[I_KEYS] + base;
      float f[8];
      float4 a = *(const float4*)s, b = *(const float4*)(s + 4);
      f[0] = a.x; f[1] = a.y; f[2] = a.z; f[3] = a.w; f[4] = b.x; f[5] = b.y; f[6] = b.z; f[7] = b.w;
      *(uint4*)((bf16_t*)(p.ws + O_KEYS) + base) = pack8(f);
    }
  }
}

DEVI void phase1(const Params& p, unsigned char* smem) {
  float* smod = (float*)smem;
  const int tid = threadIdx.x, lane = tid & 63, warp = tid >> 6;
  for (int i = tid; i < 4096; i += 256) { int which = i >> 10; smod[i] = mod_val(p, which >> 1, (which & 1) * 1024 + (i & 1023)); }
  __syncthreads();
  bf16_t* hx = (bf16_t*)(p.ws + R_HX);
  float* gif = (float*)(p.ws + R_GIF);
  const float* win = p.in[I_WIN];
  constexpr int RPW = 4;
  for (int rg = blockIdx.x * 4 + warp; rg < T_ALL / RPW; rg += gridDim.x * 4) {
    const int row0 = rg * RPW;
    const float* sh = smod + (row0 < T_CTX ? 2048 : 0);
    const float* sc = sh + 1024;
    const float* src0 = row0 < T_CTX ? p.in[I_CTX] + (size_t)row0 * 1024 : p.in[I_X] + (size_t)(row0 - T_CTX) * 1024;
    float rstd[RPW]; f32x4 xv[RPW][4];
#pragma unroll
    for (int r = 0; r < RPW; ++r) {
      float ss = 0.f;
#pragma unroll
      for (int i = 0; i < 4; ++i) {
        const f32x4 v = *(const f32x4*)(src0 + (size_t)r * 1024 + i * 256 + lane * 4);
        xv[r][i] = v;
        ss += v[0] * v[0] + v[1] * v[1] + v[2] * v[2] + v[3] * v[3];
      }
      ss = wave_sum_u(ss);
      rstd[r] = rsqrtf(ss * (1.f / 1024.f) + 1e-6f);
    }
#pragma unroll
    for (int i = 0; i < 4; ++i) {
      const int k0 = i * 256 + lane * 4;
      const float4 gk = *(const float4*)(p.in[I_N1G] + k0);
      const float4 s4 = *(const float4*)(sc + k0), h4 = *(const float4*)(sh + k0);
#pragma unroll
      for (int r = 0; r < RPW; ++r) {
        const f32x4 v = xv[r][i];
        const float y0 = v[0] * rstd[r] * gk.x * (1.f + s4.x) + h4.x, y1 = v[1] * rstd[r] * gk.y * (1.f + s4.y) + h4.y;
        const float y2 = v[2] * rstd[r] * gk.z * (1.f + s4.z) + h4.z, y3 = v[3] * rstd[r] * gk.w * (1.f + s4.w) + h4.w;
        *(uint2*)(hx + (size_t)(row0 + r) * 1024 + k0) = make_uint2(pack2(y0, y1), pack2(y2, y3));
      }
    }
  }
}

DEVI void phase2(const Params& p, unsigned char* smem, const XcdMap& xm) {
  const int lane = threadIdx.x & 63, warp = threadIdx.x >> 6, wm = warp >> 1, wn = warp & 1;
  const bf16_t* hx = (const bf16_t*)(p.ws + R_HX);
  const bf16_t* wt = (const bf16_t*)(p.ws + R_WIN);
  bf16_t* prw = (bf16_t*)p.out;
  bf16_t* pqk = (bf16_t*)(p.ws + R_PQK);
  bf16_t* pv = (bf16_t*)(p.ws + R_PV);
  bf16_t* po = (bf16_t*)(p.ws + O_PO);
  bf16_t* pg = (bf16_t*)(p.ws + O_PG);
  for_tiles_xcd(xm, 130, 43, 5, 6, [&](int mt, int nt) {
    if (mt < 2 && nt >= 22 && nt < 42) return;
    f32x4 acc[4][4];
    zero_acc(acc);
    gemm_core(hx + (size_t)mt * 128 * 1024, 1024, wt + (size_t)nt * 128 * 1024, 1024, 1024, acc, smem);
    if (nt == 42) {
      float* gif = (float*)(p.ws + R_GIF);
      if (wn == 0) {
#pragma unroll
        for (int i = 0; i < 4; ++i) {
          const int row = mt * 128 + wm * 64 + i * 16 + (lane & 15);
          *(float4*)(gif + (size_t)row * 16 + (lane >> 4) * 4) = make_float4(acc[i][0][0], acc[i][0][1], acc[i][0][2], acc[i][0][3]);
        }
      }
      return;
    }
    bf16_t* dst; int ld, nb; int rofs = 0; bool sg = false;
    if (nt < 14) { dst = prw; ld = 1792; nb = nt * 128; }
    else if (nt < 18) { dst = pqk; ld = 512; nb = (nt - 14) * 128; }
    else if (nt < 22) { dst = pv; ld = 512; nb = (nt - 18) * 128; }
    else if (nt < 26) { dst = po; ld = 512; nb = (nt - 22) * 128; rofs = T_CTX; }
    else { dst = pg; ld = 2048; nb = (nt - 26) * 128; rofs = T_CTX; sg = true; }
    bf16_t(*Ct)[136] = (bf16_t(*)[136])smem;
#pragma unroll
    for (int i = 0; i < 4; ++i) {
#pragma unroll
      for (int j = 0; j < 4; ++j) {
        f32x4 v = acc[i][j];
        if (sg) { v[0] = sigm(v[0]); v[1] = sigm(v[1]); v[2] = sigm(v[2]); v[3] = sigm(v[3]); }
        *(uint2*)&Ct[wm * 64 + i * 16 + (lane & 15)][wn * 64 + j * 16 + (lane >> 4) * 4] = make_uint2(pack2(v[0], v[1]), pack2(v[2], v[3]));
      }
    }
    __syncthreads();
#pragma unroll
    for (int q = 0; q < 8; ++q) {
      const int pc = threadIdx.x + 256 * q; const int r = pc >> 4, c8 = (pc & 15) * 8;
      const int row = mt * 128 + r - rofs;
      *(u32x4*)(dst + (size_t)row * ld + nb + c8) = *(const u32x4*)&Ct[r][c8];
    }
    __syncthreads();
  });
}

DEVI void ml_qk8(const Params& p, int c, int j, int chan, float* o) {
  const bf16_t* pqk = (const bf16_t*)(p.ws + R_PQK);
  int row = ml_row(c, j);
  bool hp, hn; int rp, rn;
  if (c < 4) { hp = row > 0; hn = row < T_CTX - 1; rp = row - 1; rn = row + 1; }
  else { int gr = ((c - 4) & 3) * 64 + j; hp = gr > 0; hn = gr < 255; rp = row - 64; rn = row + 64; }
  const float* cw = p.in[I_MCONV];
  float cur[8], pr[8], nx[8];
  unpack8(*(const uint4*)(pqk + (size_t)row * 512 + chan), cur);
  if (hp) unpack8(*(const uint4*)(pqk + (size_t)rp * 512 + chan), pr);
  if (hn) unpack8(*(const uint4*)(pqk + (size_t)rn * 512 + chan), nx);
#pragma unroll
  for (int e = 0; e < 8; ++e) {
    float v = cw[512 + chan + e] * cur[e];
    if (hp) v += cw[chan + e] * pr[e];
    if (hn) v += cw[1024 + chan + e] * nx[e];
    o[e] = siluf(v);
  }
}

DEVI void phase3(const Params& p, unsigned char* smem) {
  bf16_t(*KT)[72] = (bf16_t(*)[72])smem;
  bf16_t(*VwT)[72] = (bf16_t(*)[72])(smem + 64 * 72 * 2);
  float* wgt = (float*)(smem + 64 * 72 * 2 + 256 * 72 * 2);
  const int tid = threadIdx.x, lane = tid & 63, warp = tid >> 6;
  const float* gif = (const float*)(p.ws + R_GIF);
  const bf16_t* pv = (const bf16_t*)(p.ws + R_PV);
  float* U = (float*)(p.ws + R_U);
  float* NT = (float*)(p.ws + O_NT);
  float* bend = (float*)(p.ws + O_BEND);
  float* mloc = (float*)(p.ws + O_MLOC);
  for (int it = blockIdx.x; it < 260 * 4; it += gridDim.x) {
    int c = it >> 2, h = it & 3;
    if (warp < 2) {
      int dir = warp; int j = dir ? 63 - lane : lane;
      int row = ml_row(c, j);
      float ig = gif[(size_t)row * 16 + dir * 4 + h] + p.in[I_MIB][dir * 4 + h];
      float lf = logsig(gif[(size_t)row * 16 + 8 + dir * 4 + h] + p.in[I_MFB][dir * 4 + h]);
      float b = lf;
#pragma unroll
      for (int o = 1; o < 64; o <<= 1) { float t = __shfl_up(b, o); if (lane >= o) b += t; }
      float be = __shfl(b, 63);
      float ge = be - b + ig;
      float ml = wave_max(ge);
      wgt[dir * 64 + j] = expf(ge - ml);
      if (lane == 0) { int sc = ml_sc(c, dir); bend[sc * 8 + dir * 4 + h] = be; mloc[sc * 8 + dir * 4 + h] = ml; }
    }
    __syncthreads();
    {
      int j = tid >> 2, part = tid & 3;
      float f[8];
#pragma unroll
      for (int q = 0; q < 2; ++q) {
        int d0 = part * 16 + q * 8;
        ml_qk8(p, c, j, 256 + h * 64 + d0, f);
#pragma unroll
        for (int e = 0; e < 8; ++e) KT[d0 + e][j] = f2bf(f[e] * 0.125f);
      }
      int row = ml_row(c, j);
      float w0 = wgt[j], w1 = wgt[64 + j];
#pragma unroll
      for (int q = 0; q < 4; ++q) {
        int v0 = part * 32 + q * 8;
        unpack8(*(const uint4*)(pv + (size_t)row * 512 + h * 128 + v0), f);
#pragma unroll
        for (int e = 0; e < 8; ++e) { VwT[v0 + e][j] = f2bf(f[e] * w0); VwT[128 + v0 + e][j] = f2bf(f[e] * w1); }
      }
    }
    __syncthreads();
#pragma unroll
    for (int dir = 0; dir < 2; ++dir) {
      int sc = ml_sc(c, dir);
      float* Ud = U + ((size_t)sc * 8 + dir * 4 + h) * 8192;
#pragma unroll
      for (int vi = 0; vi < 2; ++vi) {
        int vt = warp * 2 + vi;
        bf16x8 bv[2];
#pragma unroll
        for (int ks = 0; ks < 2; ++ks) bv[ks] = *(const bf16x8*)&VwT[dir * 128 + vt * 16 + (lane & 15)][ks * 32 + (lane >> 4) * 8];
#pragma unroll
        for (int dt = 0; dt < 4; ++dt) {
          f32x4 a = {0.f, 0.f, 0.f, 0.f};
#pragma unroll
          for (int ks = 0; ks < 2; ++ks) {
            bf16x8 ak = *(const bf16x8*)&KT[dt * 16 + (lane & 15)][ks * 32 + (lane >> 4) * 8];
            a = __builtin_amdgcn_mfma_f32_16x16x32_bf16(ak, bv[ks], a, 0, 0, 0);
          }
          *(float4*)(Ud + (size_t)(vt * 16 + (lane & 15)) * 64 + dt * 16 + (lane >> 4) * 4) = make_float4(a[0], a[1], a[2], a[3]);
        }
      }
    }
    if (tid < 128) {
      int dir = tid >> 6, d = tid & 63; float s = 0.f;
      for (int j = 0; j < 64; ++j) s += wgt[dir * 64 + j] * bf2f(KT[d][j]);
      NT[((size_t)ml_sc(c, dir) * 8 + dir * 4 + h) * 64 + d] = s;
    }
    __syncthreads();
  }
}

template <bool DRY> DEVI void phase4(const Params& p, unsigned char* smem) {
  const bool wr = !DRY || (p.in[I_FG][0] == 1234.5f);
  float* U = (float*)(p.ws + R_U);
  float* NT = (float*)(p.ws + O_NT);
  const float* bend = (const float*)(p.ws + O_BEND);
  const float* mloc = (const float*)(p.ws + O_MLOC);
  float* mst = (float*)(p.ws + O_MST);
  float(*kp)[264] = (float(*)[264])smem;
  float(*sp)[264] = (float(*)[264])(smem + 2 * 264 * 4);
  const int tid = threadIdx.x, lane = tid & 63, warp = tid >> 6;
  for (int gb = blockIdx.x * 256; gb < 8 * 8256; gb += gridDim.x * 256) {
    const int pA = gb / 8256;
    if (warp < 2) {
      const int pw = pA + warp;
      if (pw < 8) {
        float be[5], ml[5], B[5], m[5];
        float run = 0.f;
#pragma unroll
        for (int k = 0; k < 5; ++k) {
          const int c = lane * 5 + k;
          be[k] = c < 260 ? bend[c * 8 + pw] : 0.f;
          ml[k] = c < 260 ? mloc[c * 8 + pw] : -INFINITY;
          run += be[k]; B[k] = run;
        }
        float incl = run;
#pragma unroll
        for (int o = 1; o < 64; o <<= 1) { float t = __shfl_up(incl, o); if (lane >= o) incl += t; }
        const float off = incl - run;
        float pm = -INFINITY, pml[5];
#pragma unroll
        for (int k = 0; k < 5; ++k) { B[k] += off; pm = fmaxf(pm, ml[k] - B[k]); pml[k] = pm; }
        float inclm = pm;
#pragma unroll
        for (int o = 1; o < 64; o <<= 1) { float t = __shfl_up(inclm, o); if (lane >= o) inclm = fmaxf(inclm, t); }
        float offm = __shfl_up(inclm, 1); if (lane == 0) offm = -INFINITY;
#pragma unroll
        for (int k = 0; k < 5; ++k) m[k] = B[k] + fmaxf(0.f, fmaxf(offm, pml[k]));
        float mprev = __shfl_up(m[4], 1); if (lane == 0) mprev = 0.f;
        const bool owner = gb <= pw * 8256 && pw * 8256 < gb + 256;
#pragma unroll
        for (int k = 0; k < 5; ++k) {
          const int c = lane * 5 + k;
          if (c < 260) {
            kp[warp][c] = expf(be[k] + mprev - m[k]);
            sp[warp][c] = expf(ml[k] - m[k]);
            if (wr && owner) mst[c * 8 + pw] = mprev;
          }
          mprev = m[k];
        }
      }
    }
    __syncthreads();
    const int g = gb + tid;
    if (g < 8 * 8256) {
      const int pr = g / 8256, e = g % 8256, slot = pr - pA;
      float* base; size_t stride;
      if (e < 8192) { base = U + (size_t)pr * 8192 + e; stride = 8 * 8192; }
      else { base = NT + (size_t)pr * 64 + (e - 8192); stride = 8 * 64; }
      float C = 0.f;
      for (int sc = 0; sc < 260; sc += 20) {
        float u[20];
#pragma unroll
        for (int q = 0; q < 20; ++q) u[q] = base[(size_t)(sc + q) * stride];
#pragma unroll
        for (int q = 0; q < 20; ++q) {
          if (wr) base[(size_t)(sc + q) * stride] = C;
          C = kp[slot][sc + q] * C + sp[slot][sc + q] * u[q];
        }
      }
    }
    __syncthreads();
  }
}

template <bool DRY> DEVI void phase5(const Params& p, unsigned char* smem) {
  const bool wr = !DRY || (p.in[I_FG][0] == 1234.5f);
  bf16_t(*Qs)[72] = (bf16_t(*)[72])smem;
  bf16_t(*Ks)[72] = (bf16_t(*)[72])(smem + 9216);
  bf16_t(*Pm)[72] = (bf16_t(*)[72])(smem + 2 * 9216);
  bf16_t(*VT)[72] = (bf16_t(*)[72])(smem + 3 * 9216);
  float* evec = (float*)(smem + 3 * 9216 + 144 * 72 * 2);
  float* Mvec = evec + 128;
  float* bvec = Mvec + 128;
  const int tid = threadIdx.x, lane = tid & 63, warp = tid >> 6;
  const float* gif = (const float*)(p.ws + R_GIF);
  const bf16_t* pv = (const bf16_t*)(p.ws + R_PV);
  const bf16_t* po = (const bf16_t*)(p.ws + O_PO);
  bf16_t* yb = (bf16_t*)(p.ws + R_YA);
  const float* U = (const float*)(p.ws + R_U);
  const float* NT = (const float*)(p.ws + O_NT);
  const float* mst = (const float*)(p.ws + O_MST);
  for (int it = blockIdx.x; it < 256 * 4; it += gridDim.x) {
    int c = 4 + (it >> 2), h = it & 3;
    if (warp < 2) {
      int dir = warp; int j = dir ? 63 - lane : lane;
      int row = ml_row(c, j);
      float ig = gif[(size_t)row * 16 + dir * 4 + h] + p.in[I_MIB][dir * 4 + h];
      float lf = logsig(gif[(size_t)row * 16 + 8 + dir * 4 + h] + p.in[I_MFB][dir * 4 + h]);
      float b = lf;
#pragma unroll
      for (int o = 1; o < 64; o <<= 1) { float t = __shfl_up(b, o); if (lane >= o) b += t; }
      float e = ig - b;
      float pm = e;
#pragma unroll
      for (int o = 1; o < 64; o <<= 1) { float t = __shfl_up(pm, o); if (lane >= o) pm = fmaxf(pm, t); }
      float m0 = mst[ml_sc(c, dir) * 8 + dir * 4 + h];
      evec[dir * 64 + j] = e; Mvec[dir * 64 + j] = fmaxf(m0, pm); bvec[dir * 64 + j] = b;
    }
    {
      int j = tid >> 2, part = tid & 3;
      float f[8];
#pragma unroll
      for (int q = 0; q < 2; ++q) {
        int d0 = part * 16 + q * 8;
        ml_qk8(p, c, j, h * 64 + d0, f);
        *(uint4*)&Qs[j][d0] = pack8(f);
        ml_qk8(p, c, j, 256 + h * 64 + d0, f);
#pragma unroll
        for (int e = 0; e < 8; ++e) f[e] *= 0.125f;
        *(uint4*)&Ks[j][d0] = pack8(f);
      }
      int row = ml_row(c, j);
#pragma unroll
      for (int q = 0; q < 4; ++q) {
        int v0 = part * 32 + q * 8;
        unpack8(*(const uint4*)(pv + (size_t)row * 512 + h * 128 + v0), f);
#pragma unroll
        for (int e = 0; e < 8; ++e) VT[v0 + e][j] = f2bf(f[e]);
      }
      for (int i = tid; i < 16 * 64; i += 256) VT[128 + (i >> 6)][i & 63] = (i < 64) ? (bf16_t)0x3f80 : (bf16_t)0;
    }
    __syncthreads();
    const int jl = warp * 16 + (lane & 15);
    f32x4 s0[4];
    bf16x8 qf[2];
#pragma unroll
    for (int ks = 0; ks < 2; ++ks) qf[ks] = *(const bf16x8*)&Qs[jl][ks * 32 + (lane >> 4) * 8];
#pragma unroll
    for (int st = 0; st < 4; ++st) {
      f32x4 a = {0.f, 0.f, 0.f, 0.f};
#pragma unroll
      for (int ks = 0; ks < 2; ++ks) {
        bf16x8 kf = *(const bf16x8*)&Ks[st * 16 + (lane & 15)][ks * 32 + (lane >> 4) * 8];
        a = __builtin_amdgcn_mfma_f32_16x16x32_bf16(kf, qf[ks], a, 0, 0, 0);
      }
      s0[st] = a;
    }
    f32x4 ysum[8];
#pragma unroll
    for (int vt = 0; vt < 8; ++vt) ysum[vt] = f32x4{0.f, 0.f, 0.f, 0.f};
#pragma unroll 1
    for (int dir = 0; dir < 2; ++dir) {
      float Mj = Mvec[dir * 64 + jl], bj = bvec[dir * 64 + jl];
      float m0 = mst[ml_sc(c, dir) * 8 + dir * 4 + h];
#pragma unroll
      for (int st = 0; st < 4; ++st) {
        float pvv[4];
#pragma unroll
        for (int r = 0; r < 4; ++r) {
          int s = st * 16 + (lane >> 4) * 4 + r;
          bool ok = dir == 0 ? (s <= jl) : (s >= jl);
          pvv[r] = ok ? s0[st][r] * expf(evec[dir * 64 + s] - Mj) : 0.f;
        }
        *(uint2*)&Pm[jl][st * 16 + (lane >> 4) * 4] = make_uint2(pack2(pvv[0], pvv[1]), pack2(pvv[2], pvv[3]));
      }
      __syncthreads();
      bf16x8 pf[2];
#pragma unroll
      for (int ks = 0; ks < 2; ++ks) pf[ks] = *(const bf16x8*)&Pm[jl][ks * 32 + (lane >> 4) * 8];
      const float* Cst = U + ((size_t)ml_sc(c, dir) * 8 + dir * 4 + h) * 8192;
      const float* nst = NT + ((size_t)ml_sc(c, dir) * 8 + dir * 4 + h) * 64;
      float ai = expf(m0 - Mj);
      f32x4 hh[9];
#pragma unroll
      for (int vt = 0; vt < 9; ++vt) {
        f32x4 a1 = {0.f, 0.f, 0.f, 0.f}, a2 = {0.f, 0.f, 0.f, 0.f};
#pragma unroll
        for (int ks = 0; ks < 2; ++ks) {
          bf16x8 vf = *(const bf16x8*)&VT[vt * 16 + (lane & 15)][ks * 32 + (lane >> 4) * 8];
          a1 = __builtin_amdgcn_mfma_f32_16x16x32_bf16(vf, pf[ks], a1, 0, 0, 0);
          int v = vt * 16 + (lane & 15);
          const float* cp = v < 128 ? Cst + (size_t)v * 64 + ks * 32 + (lane >> 4) * 8 : nst + ks * 32 + (lane >> 4) * 8;
          float cf[8];
          if (v <= 128) {
            float4 x0 = *(const float4*)cp, x1 = *(const float4*)(cp + 4);
            cf[0] = x0.x; cf[1] = x0.y; cf[2] = x0.z; cf[3] = x0.w; cf[4] = x1.x; cf[5] = x1.y; cf[6] = x1.z; cf[7] = x1.w;
          } else {
#pragma unroll
            for (int e = 0; e < 8; ++e) cf[e] = 0.f;
          }
          uint4 pk = pack8(cf);
          bf16x8 cfr;
          cfr[0] = (short)(pk.x & 0xffff); cfr[1] = (short)(pk.x >> 16); cfr[2] = (short)(pk.y & 0xffff); cfr[3] = (short)(pk.y >> 16);
          cfr[4] = (short)(pk.z & 0xffff); cfr[5] = (short)(pk.z >> 16); cfr[6] = (short)(pk.w & 0xffff); cfr[7] = (short)(pk.w >> 16);
          a2 = __builtin_amdgcn_mfma_f32_16x16x32_bf16(cfr, qf[ks], a2, 0, 0, 0);
        }
#pragma unroll
        for (int r = 0; r < 4; ++r) hh[vt][r] = a1[r] + ai * a2[r];
      }
      float den = __shfl(hh[8][0], lane & 15);
      float dn = fmaxf(fabsf(den), expf(-(bj + Mj)));
      float inv = 1.f / dn;
      float ss = 0.f;
#pragma unroll
      for (int vt = 0; vt < 8; ++vt)
#pragma unroll
        for (int r = 0; r < 4; ++r) { float x = hh[vt][r] * inv; hh[vt][r] = x; ss += x * x; }
      ss += __shfl_xor(ss, 16); ss += __shfl_xor(ss, 32);
      float rs = rsqrtf(ss * (1.f / 128.f) + 1e-6f);
#pragma unroll
      for (int vt = 0; vt < 8; ++vt)
#pragma unroll
        for (int r = 0; r < 4; ++r) ysum[vt][r] += hh[vt][r] * rs * p.in[I_MNG][h * 128 + vt * 16 + (lane >> 4) * 4 + r];
      __syncthreads();
    }
    {
      int row = ml_row(c, jl) - T_CTX;
#pragma unroll
      for (int vt = 0; vt < 8; ++vt) {
        const bf16_t* op = po + (size_t)row * 512 + h * 128 + vt * 16 + (lane >> 4) * 4;
        uint2 o = *(const uint2*)op;
        float y0 = ysum[vt][0] * sigm(bflo(o.x)), y1 = ysum[vt][1] * sigm(bfhi(o.x)), y2 = ysum[vt][2] * sigm(bflo(o.y)), y3 = ysum[vt][3] * sigm(bfhi(o.y));
        if (wr) *(uint2*)(yb + (size_t)row * 512 + h * 128 + vt * 16 + (lane >> 4) * 4) = make_uint2(pack2(y0, y1), pack2(y2, y3));
      }
    }
    __syncthreads();
  }
}

DEVI void phase6(const Params& p, unsigned char* smem, int item_lo, int item_hi, int blk0, int nblk) {
  float(*rs)[65] = (float(*)[65])smem;
  float(*ks)[65] = (float(*)[65])(smem + 64 * 65 * 4);
  bf16_t(*TW)[72] = (bf16_t(*)[72])(smem + 2 * 64 * 65 * 4);
  bf16_t(*TA)[72] = (bf16_t(*)[72])(smem + 2 * 64 * 65 * 4 + 9216);
  bf16_t(*TG)[136] = (bf16_t(*)[136])(smem + 2 * 64 * 65 * 4 + 2 * 9216);
  float* rn = (float*)(smem + 2 * 64 * 65 * 4 + 2 * 9216 + 64 * 136 * 2);
  const int tid = threadIdx.x, lane = tid & 63, warp = tid >> 6;
  const bf16_t* prw = (const bf16_t*)p.out;
  bf16_t* SV = (bf16_t*)(p.ws + R_SV);
  float* bonus = (float*)(p.ws + O_BONUS);
  const float* cw = p.in[I_RCONV];
  const bf16_t* WUP = (const bf16_t*)(p.ws + O_WUP);
  const bf16_t* AUP = (const bf16_t*)(p.ws + O_AUP);
  const bf16_t* GUP = (const bf16_t*)(p.ws + O_GUP);
  if ((int)blockIdx.x < blk0) return;
  for (int it = item_lo + ((int)blockIdx.x - blk0); it < item_hi; it += nblk) {
    int tile = it >> 3, head = it & 7;
    int row0 = tile * 64;
    int seg0 = tile < 4 ? 0 : row0, seg1 = tile < 4 ? T_CTX : row0 + 64;
#pragma unroll 1
    for (int ub = 0; ub < 2; ++ub) {
      u32x4 lc[7], lp[7], ln[7];
#pragma unroll
      for (int it7 = 0; it7 < 7; ++it7) {
        const int u = warp + 4 * (ub * 7 + it7);
        const int grp = u >> 3;
        const int j = (u & 7) * 8 + (lane >> 3), q = grp * 8 + (lane & 7);
        const int row = row0 + j;
        const int col = q < 24 ? (q >> 3) * 512 + head * 64 + (q & 7) * 8 : 1536 + (q - 24) * 8;
        const bool hp = row > seg0, hn = row < seg1 - 1;
        lc[it7] = *(const u32x4*)(prw + (size_t)row * 1792 + col);
        lp[it7] = hp ? *(const u32x4*)(prw + (size_t)(row - 1) * 1792 + col) : u32x4{0u, 0u, 0u, 0u};
        ln[it7] = hn ? *(const u32x4*)(prw + (size_t)(row + 1) * 1792 + col) : u32x4{0u, 0u, 0u, 0u};
      }
#pragma unroll
      for (int it7 = 0; it7 < 7; ++it7) {
        const int u = warp + 4 * (ub * 7 + it7);
        const int grp = u >> 3;
        const int j = (u & 7) * 8 + (lane >> 3), q = grp * 8 + (lane & 7);
        const int row = row0 + j;
        const int col = q < 24 ? (q >> 3) * 512 + head * 64 + (q & 7) * 8 : 1536 + (q - 24) * 8;
        float cur[8], pr[8], nx[8], o[8];
        unpack8(make_uint4(lc[it7][0], lc[it7][1], lc[it7][2], lc[it7][3]), cur);
        unpack8(make_uint4(lp[it7][0], lp[it7][1], lp[it7][2], lp[it7][3]), pr);
        unpack8(make_uint4(ln[it7][0], ln[it7][1], ln[it7][2], ln[it7][3]), nx);
        {
          float4 c0 = *(const float4*)(cw + col), c1 = *(const float4*)(cw + col + 4);
          float4 d0 = *(const float4*)(cw + 1792 + col), d1 = *(const float4*)(cw + 1792 + col + 4);
          float4 e0 = *(const float4*)(cw + 3584 + col), e1 = *(const float4*)(cw + 3584 + col + 4);
          float wp[8] = {c0.x, c0.y, c0.z, c0.w, c1.x, c1.y, c1.z, c1.w};
          float wc[8] = {d0.x, d0.y, d0.z, d0.w, d1.x, d1.y, d1.z, d1.w};
          float wn_[8] = {e0.x, e0.y, e0.z, e0.w, e1.x, e1.y, e1.z, e1.w};
#pragma unroll
          for (int e = 0; e < 8; ++e) o[e] = wc[e] * cur[e] + wp[e] * pr[e] + wn_[e] * nx[e];
        }
        if (grp == 0) {
#pragma unroll
          for (int e = 0; e < 8; ++e) rs[j][(q & 7) * 8 + e] = o[e];
        } else if (grp == 1) {
#pragma unroll
          for (int e = 0; e < 8; ++e) ks[j][(q & 7) * 8 + e] = o[e];
        } else if (grp == 2) {
          *(uint4*)(SV + ((size_t)row * 8 + head) * SVH + 2 * 64 + (q & 7) * 8) = pack8(o);
        } else if (grp == 3) {
#pragma unroll
          for (int e = 0; e < 8; ++e) o[e] = 1.f - 2.f / (1.f + __expf(2.f * o[e]));
          *(uint4*)&TW[j][(q - 24) * 8] = pack8(o);
        } else if (grp == 4) {
          *(uint4*)&TA[j][(q - 32) * 8] = pack8(o);
        } else {
#pragma unroll
          for (int e = 0; e < 8; ++e) o[e] = sigm(o[e]);
          *(uint4*)&TG[j][(q - 40) * 8] = pack8(o);
        }
      }
    }
    __syncthreads();
    {
      int j = tid >> 2, part = tid & 3; float ss = 0.f;
#pragma unroll
      for (int e = 0; e < 16; ++e) { float v = ks[j][part * 16 + e] * p.in[I_RKK][head * 64 + part * 16 + e]; ss += v * v; }
      ss += __shfl_xor(ss, 1); ss += __shfl_xor(ss, 2);
      if (part == 0) rn[j] = 1.f / fmaxf(sqrtf(ss), 1e-12f);
    }
    __syncthreads();
    for (int pc = tid; pc < 64 * 8; pc += 256) {
      int j = pc >> 3, c8 = (pc & 7) * 8; int row = row0 + j;
      float fr[8], fk[8], fkk[8];
#pragma unroll
      for (int e = 0; e < 8; ++e) { fr[e] = rs[j][c8 + e]; fk[e] = ks[j][c8 + e]; fkk[e] = fk[e] * p.in[I_RKK][head * 64 + c8 + e] * rn[j]; }
      bf16_t* b = SV + ((size_t)row * 8 + head) * SVH;
      *(uint4*)(b + 0 * 64 + c8) = pack8(fr);
      *(uint4*)(b + 1 * 64 + c8) = pack8(fk);
      *(uint4*)(b + 3 * 64 + c8) = pack8(fkk);
    }
    {
      const int jl = warp * 16 + (lane & 15); const int row = row0 + jl;
      bf16x8 tw[2], ta[2], tg[4];
#pragma unroll
      for (int s2 = 0; s2 < 2; ++s2) { tw[s2] = *(const bf16x8*)&TW[jl][s2 * 32 + (lane >> 4) * 8]; ta[s2] = *(const bf16x8*)&TA[jl][s2 * 32 + (lane >> 4) * 8]; }
#pragma unroll
      for (int s2 = 0; s2 < 4; ++s2) tg[s2] = *(const bf16x8*)&TG[jl][s2 * 32 + (lane >> 4) * 8];
      __syncthreads();
      bf16_t(*OB)[64][72] = (bf16_t(*)[64][72])(smem + 2 * 64 * 65 * 4);
      float bon[2] = {0.f, 0.f};
#pragma unroll
      for (int dir = 0; dir < 2; ++dir) {
#pragma unroll
        for (int ct = 0; ct < 4; ++ct) {
          const int ch0 = ct * 16 + (lane >> 4) * 4;
          const int C0 = head * 64 + ch0;
          if (dir == 0) {
            f32x4 a = {0.f, 0.f, 0.f, 0.f};
#pragma unroll
            for (int s2 = 0; s2 < 4; ++s2) {
              bf16x8 wf = *(const bf16x8*)(GUP + (size_t)(head * 64 + ct * 16 + (lane & 15)) * 128 + s2 * 32 + (lane >> 4) * 8);
              a = __builtin_amdgcn_mfma_f32_16x16x32_bf16(wf, tg[s2], a, 0, 0, 0);
            }
            *(uint2*)&OB[2][jl][ch0] = make_uint2(pack2(a[0], a[1]), pack2(a[2], a[3]));
          }
          f32x4 aw = {0.f, 0.f, 0.f, 0.f}, aa = {0.f, 0.f, 0.f, 0.f};
#pragma unroll
          for (int s2 = 0; s2 < 2; ++s2) {
            size_t wo = (size_t)(dir * 512 + head * 64 + ct * 16 + (lane & 15)) * 64 + s2 * 32 + (lane >> 4) * 8;
            bf16x8 wf = *(const bf16x8*)(WUP + wo);
            bf16x8 af = *(const bf16x8*)(AUP + wo);
            aw = __builtin_amdgcn_mfma_f32_16x16x32_bf16(wf, tw[s2], aw, 0, 0, 0);
            aa = __builtin_amdgcn_mfma_f32_16x16x32_bf16(af, ta[s2], aa, 0, 0, 0);
          }
          const float4 w04 = *(const float4*)(p.in[I_RW0] + dir * 512 + C0), a04 = *(const float4*)(p.in[I_RA0] + dir * 512 + C0);
          const float4 ka4 = *(const float4*)(p.in[I_RKA] + C0), rk4 = *(const float4*)(p.in[I_RRK] + C0);
          const float w0v[4] = {w04.x, w04.y, w04.z, w04.w}, a0v[4] = {a04.x, a04.y, a04.z, a04.w};
          const float kav[4] = {ka4.x, ka4.y, ka4.z, ka4.w}, rkv[4] = {rk4.x, rk4.y, rk4.z, rk4.w};
          float we[4], av[4];
#pragma unroll
          for (int r = 0; r < 4; ++r) {
            we[r] = (0.60653066f * 1.44269504f) * sigm(w0v[r] + aw[r]);
            av[r] = sigm(a0v[r] + aa[r]);
            float kv = ks[jl][ch0 + r];
            float keff = kv * (1.f + (av[r] - 1.f) * kav[r]);
            bon[dir] += rs[jl][ch0 + r] * keff * rkv[r];
          }
          *(uint2*)&OB[0][jl][ch0] = make_uint2(pack2(we[0], we[1]), pack2(we[2], we[3]));
          *(uint2*)&OB[1][jl][ch0] = make_uint2(pack2(av[0], av[1]), pack2(av[2], av[3]));
        }
        __syncthreads();
        for (int pc = tid; pc < (dir == 0 ? 3 : 2) * 64 * 8; pc += 256) {
          const int vsel = pc >> 9, j = (pc >> 3) & 63, c8 = (pc & 7) * 8;
          const int vec = vsel == 2 ? 8 : (4 + 2 * dir + vsel);
          *(u32x4*)(SV + ((size_t)(row0 + j) * 8 + head) * SVH + vec * 64 + c8) = *(const u32x4*)&OB[vsel][j][c8];
        }
        __syncthreads();
      }
#pragma unroll
      for (int dir = 0; dir < 2; ++dir) {
        float sb = bon[dir]; sb += __shfl_xor(sb, 16); sb += __shfl_xor(sb, 32);
        if (lane < 16) bonus[(size_t)row * 16 + dir * 8 + head] = sb;
      }
    }
    __syncthreads();
  }
}

struct RwVec { uint4 k, kk, w, a, v, r; };
DEVI void unpack8p(const uint4& u, f32x2* f) {
  f[0] = f32x2{bflo(u.x), bfhi(u.x)}; f[1] = f32x2{bflo(u.y), bfhi(u.y)}; f[2] = f32x2{bflo(u.z), bfhi(u.z)}; f[3] = f32x2{bflo(u.w), bfhi(u.w)};
}
DEVI f32x2 bc2(float x) { return f32x2{x, x}; }
DEVI void rw_load(RwVec& x, const bf16_t* SV, int row, int head, int dir, int i, int jg, bool need_r) {
  const bf16_t* b = SV + ((size_t)row * 8 + head) * SVH;
  x.k = *(const uint4*)(b + 1 * 64 + jg * 8);
  x.kk = *(const uint4*)(b + 3 * 64 + jg * 8);
  x.w = *(const uint4*)(b + (4 + 2 * dir) * 64 + jg * 8);
  x.a = *(const uint4*)(b + (5 + 2 * dir) * 64 + jg * 8);
  x.v = *(const uint4*)(b + 2 * 64 + i * 8);
  if (need_r) x.r = *(const uint4*)(b + 0 * 64 + jg * 8);
}

DEVI void phase7(const Params& p) {
  const int lane = threadIdx.x & 63, warp = threadIdx.x >> 6, i = lane >> 3, jg = lane & 7;
  const bf16_t* SV = (const bf16_t*)(p.ws + R_SV);
  float* Pc = (float*)p.out;
  float* Bc = (float*)((unsigned char*)p.out + OUT_BC);
  for (int it = blockIdx.x * 4 + warp; it < (NCH - 1) * 16; it += gridDim.x * 4) {
    const int chunk = it >> 4, pair = it & 15, dir = pair >> 3, head = pair & 7;
    f32x2 S[8][4], P[8][4], ka[4];
#pragma unroll
    for (int a = 0; a < 8; ++a)
#pragma unroll
      for (int c = 0; c < 4; ++c) {
        S[a][c] = f32x2{0.f, 0.f};
        P[a][c] = f32x2{(i * 8 + a == jg * 8 + 2 * c) ? 1.f : 0.f, (i * 8 + a == jg * 8 + 2 * c + 1) ? 1.f : 0.f};
      }
#pragma unroll
    for (int c = 0; c < 4; ++c) ka[c] = f32x2{p.in[I_RKA][head * 64 + jg * 8 + 2 * c], p.in[I_RKA][head * 64 + jg * 8 + 2 * c + 1]};
    RwVec nx;
    rw_load(nx, SV, rw_row(chunk * LCH, dir), head, dir, i, jg, false);
#pragma unroll 1
    for (int t = 0; t < LCH; ++t) {
      RwVec cu = nx;
      if (t + 1 < LCH) rw_load(nx, SV, rw_row(chunk * LCH + t + 1, dir), head, dir, i, jg, false);
      f32x2 kv[4], kk[4], w[4], av[4], kka[4], keff[4]; float vv[8];
      unpack8p(cu.k, kv); unpack8p(cu.kk, kk); unpack8p(cu.w, w); unpack8p(cu.a, av); unpack8(cu.v, vv);
#pragma unroll
      for (int c = 0; c < 4; ++c) {
        w[c] = f32x2{__builtin_amdgcn_exp2f(-w[c][0]), __builtin_amdgcn_exp2f(-w[c][1])};
        kka[c] = -kk[c] * av[c];
        keff[c] = kv[c] * (bc2(1.f) + (av[c] - bc2(1.f)) * ka[c]);
      }
#pragma unroll
      for (int a = 0; a < 8; ++a) {
        f32x2 sa = S[a][0] * kk[0], qa = P[a][0] * kk[0];
#pragma unroll
        for (int c = 1; c < 4; ++c) { sa += S[a][c] * kk[c]; qa += P[a][c] * kk[c]; }
        float s1 = allred8(sa[0] + sa[1]), q1 = allred8(qa[0] + qa[1]);
        const f32x2 s2 = bc2(s1), q2 = bc2(q1), v2 = bc2(vv[a]);
#pragma unroll
        for (int c = 0; c < 4; ++c) {
          S[a][c] = S[a][c] * w[c] + s2 * kka[c] + v2 * keff[c];
          P[a][c] = P[a][c] * w[c] + q2 * kka[c];
        }
      }
    }
    float* po = Pc + ((size_t)chunk * 16 + pair) * 4096;
    float* bo = Bc + ((size_t)chunk * 16 + pair) * 4096;
#pragma unroll
    for (int a = 0; a < 8; ++a) {
      *(float4*)(po + (i * 8 + a) * 64 + jg * 8) = make_float4(P[a][0][0], P[a][0][1], P[a][1][0], P[a][1][1]);
      *(float4*)(po + (i * 8 + a) * 64 + jg * 8 + 4) = make_float4(P[a][2][0], P[a][2][1], P[a][3][0], P[a][3][1]);
      *(float4*)(bo + (i * 8 + a) * 64 + jg * 8) = make_float4(S[a][0][0], S[a][0][1], S[a][1][0], S[a][1][1]);
      *(float4*)(bo + (i * 8 + a) * 64 + jg * 8 + 4) = make_float4(S[a][2][0], S[a][2][1], S[a][3][0], S[a][3][1]);
    }
  }
}

template <bool DRY> DEVI void phase8(const Params& p, unsigned char* smem) {
  const bool wr = !DRY || (p.in[I_FG][0] == 1234.5f);
  float(*Sb)[16][68] = (float(*)[16][68])smem;
  const int tid = threadIdx.x, lane = tid & 63, warp = tid >> 6, q = lane >> 4, c16 = lane & 15;
  const float* Pc = (const float*)p.out;
  float* Bc = (float*)((unsigned char*)p.out + OUT_BC);
  constexpr int NS = NCH - 1;
  const size_t CS = (size_t)16 * 4096;
  for (int it = blockIdx.x; it < 64; it += gridDim.x) {
    const int pair = it >> 2, rg = it & 3;
    const float* Pp = Pc + (size_t)pair * 4096 + q * 64 + warp * 16 + c16;
    float* Bp = Bc + (size_t)pair * 4096 + (size_t)(rg * 16 + q * 4) * 64 + warp * 16 + c16;
    __syncthreads();
    {
      const int row = tid >> 4, c4 = (tid & 15) * 4;
      float4 v = *(const float4*)(Bc + (size_t)pair * 4096 + (size_t)(rg * 16 + row) * 64 + c4);
      Sb[0][row][c4] = v.x; Sb[0][row][c4 + 1] = v.y; Sb[0][row][c4 + 2] = v.z; Sb[0][row][c4 + 3] = v.w;
    }
    float pa[16], pb[16]; f32x4 ba, bb;
#pragma unroll
    for (int s2 = 0; s2 < 16; ++s2) { pa[s2] = Pp[CS + s2 * 256]; pb[s2] = Pp[2 * CS + s2 * 256]; }
#pragma unroll
    for (int r = 0; r < 4; ++r) { ba[r] = Bp[CS + r * 64]; bb[r] = Bp[2 * CS + r * 64]; }
    __syncthreads();
#define P8_STEP(c, pp, bv)                                                                                  \
    {                                                                                                        \
      const int rb = ((c) - 1) & 1;                                                                          \
      f32x4 acc0 = bv, acc1 = f32x4{0.f, 0.f, 0.f, 0.f};                                                     \
      _Pragma("unroll") for (int s2 = 0; s2 < 16; s2 += 2) {                                                 \
        acc0 = __builtin_amdgcn_mfma_f32_16x16x4f32(Sb[rb][c16][4 * s2 + q], pp[s2], acc0, 0, 0, 0);         \
        acc1 = __builtin_amdgcn_mfma_f32_16x16x4f32(Sb[rb][c16][4 * s2 + 4 + q], pp[s2 + 1], acc1, 0, 0, 0); \
      }                                                                                                      \
      acc0 += acc1;                                                                                          \
      if ((c) + 2 < NS) {                                                                                    \
        _Pragma("unroll") for (int s2 = 0; s2 < 16; ++s2) pp[s2] = Pp[(size_t)((c) + 2) * CS + s2 * 256];    \
        _Pragma("unroll") for (int r = 0; r < 4; ++r) bv[r] = Bp[(size_t)((c) + 2) * CS + r * 64];           \
      }                                                                                                      \
      _Pragma("unroll") for (int r = 0; r < 4; ++r) {                                                        \
        Sb[rb ^ 1][q * 4 + r][warp * 16 + c16] = acc0[r];                                                    \
        if (wr) Bp[(size_t)(c) * CS + r * 64] = acc0[r];                                                     \
      }                                                                                                      \
      __syncthreads();                                                                                       \
    }
    for (int c = 1; c < NS; c += 2) {
      P8_STEP(c, pa, ba)
      if (c + 1 < NS) P8_STEP(c + 1, pb, bb)
    }
#undef P8_STEP
  }
}

DEVI void phase9(const Params& p) {
  const int lane = threadIdx.x & 63, warp = threadIdx.x >> 6, i = lane >> 3, jg = lane & 7;
  const bf16_t* SV = (const bf16_t*)(p.ws + R_SV);
  const float* Bc = (const float*)((unsigned char*)p.out + OUT_BC);
  bf16_t* odir = (bf16_t*)p.out;
  for (int it = blockIdx.x * 4 + warp; it < NCH * 16; it += gridDim.x * 4) {
    const int chunk = it >> 4, pair = it & 15, dir = pair >> 3, head = pair & 7;
    f32x2 S[8][4], ka[4];
    if (chunk == 0) {
#pragma unroll
      for (int a = 0; a < 8; ++a)
#pragma unroll
        for (int c = 0; c < 4; ++c) S[a][c] = f32x2{0.f, 0.f};
    } else {
      const float* bs = Bc + ((size_t)(chunk - 1) * 16 + pair) * 4096;
#pragma unroll
      for (int a = 0; a < 8; ++a) {
        float4 x0 = *(const float4*)(bs + (i * 8 + a) * 64 + jg * 8), x1 = *(const float4*)(bs + (i * 8 + a) * 64 + jg * 8 + 4);
        S[a][0] = f32x2{x0.x, x0.y}; S[a][1] = f32x2{x0.z, x0.w}; S[a][2] = f32x2{x1.x, x1.y}; S[a][3] = f32x2{x1.z, x1.w};
      }
    }
#pragma unroll
    for (int c = 0; c < 4; ++c) ka[c] = f32x2{p.in[I_RKA][head * 64 + jg * 8 + 2 * c], p.in[I_RKA][head * 64 + jg * 8 + 2 * c + 1]};
    RwVec nx;
    rw_load(nx, SV, rw_row(chunk * LCH, dir), head, dir, i, jg, true);
#pragma unroll 1
    for (int t = 0; t < LCH; ++t) {
      RwVec cu = nx;
      const int row = rw_row(chunk * LCH + t, dir);
      if (t + 1 < LCH) rw_load(nx, SV, rw_row(chunk * LCH + t + 1, dir), head, dir, i, jg, true);
      f32x2 kv[4], kk[4], w[4], av[4], rr[4], kka[4], keff[4]; float vv[8];
      unpack8p(cu.k, kv); unpack8p(cu.kk, kk); unpack8p(cu.w, w); unpack8p(cu.a, av); unpack8p(cu.r, rr); unpack8(cu.v, vv);
#pragma unroll
      for (int c = 0; c < 4; ++c) {
        w[c] = f32x2{__builtin_amdgcn_exp2f(-w[c][0]), __builtin_amdgcn_exp2f(-w[c][1])};
        kka[c] = -kk[c] * av[c];
        keff[c] = kv[c] * (bc2(1.f) + (av[c] - bc2(1.f)) * ka[c]);
      }
      float ov = 0.f;
#pragma unroll
      for (int a = 0; a < 8; ++a) {
        f32x2 sa = S[a][0] * kk[0];
#pragma unroll
        for (int c = 1; c < 4; ++c) sa += S[a][c] * kk[c];
        const float s1 = allred8(sa[0] + sa[1]);
        const f32x2 s2 = bc2(s1), v2 = bc2(vv[a]);
        f32x2 oa = f32x2{0.f, 0.f};
#pragma unroll
        for (int c = 0; c < 4; ++c) {
          S[a][c] = S[a][c] * w[c] + s2 * kka[c] + v2 * keff[c];
          oa += S[a][c] * rr[c];
        }
        const float o = allred8(oa[0] + oa[1]);
        if (jg == a) ov = o;
      }
      if (row >= T_CTX) odir[((size_t)dir * T_LAT + (row - T_CTX)) * 512 + head * 64 + i * 8 + jg] = f2bf(ov);
    }
  }
}

DEVI void phase10(const Params& p) {
  const int lane = threadIdx.x & 63, warp = threadIdx.x >> 6;
  const bf16_t* odir = (const bf16_t*)p.out;
  const bf16_t* SV = (const bf16_t*)(p.ws + R_SV);
  const float* bonus = (const float*)(p.ws + O_BONUS);
  bf16_t* ya = (bf16_t*)(p.ws + O_PO);
  const int head = lane >> 3, c8 = (lane & 7) * 8, C0 = lane * 8;
#pragma unroll 2
  for (int t = blockIdx.x * 4 + warp; t < T_LAT; t += gridDim.x * 4) {
    const int row = t + T_CTX;
    const bf16_t* b = SV + ((size_t)row * 8 + head) * SVH;
    float v[8], g[8], y[8];
    unpack8(*(const uint4*)(b + 2 * 64 + c8), v);
    unpack8(*(const uint4*)(b + 8 * 64 + c8), g);
    float bs = bonus[(size_t)row * 16 + head] + bonus[(size_t)row * 16 + 8 + head];
#pragma unroll
    for (int e = 0; e < 8; ++e) y[e] = bs * v[e];
#pragma unroll
    for (int dir = 0; dir < 2; ++dir) {
      float o[8];
      unpack8(*(const uint4*)(odir + ((size_t)dir * T_LAT + t) * 512 + C0), o);
      float s = 0.f;
#pragma unroll
      for (int e = 0; e < 8; ++e) s += o[e];
      s = allred8(s);
      float mu = s * (1.f / 64.f);
      float q = 0.f;
#pragma unroll
      for (int e = 0; e < 8; ++e) { o[e] -= mu; q += o[e] * o[e]; }
      q = allred8(q);
      float rsd = rsqrtf(q * (1.f / 64.f) + 64e-5f);
#pragma unroll
      for (int e = 0; e < 8; ++e) y[e] += o[e] * rsd * p.in[I_RLNW][C0 + e] + p.in[I_RLNB][C0 + e];
    }
#pragma unroll
    for (int e = 0; e < 8; ++e) y[e] *= g[e];
    *(uint4*)(ya + (size_t)t * 512 + C0) = pack8(y);
  }
}

DEVI void phase11(const Params& p, unsigned char* smem, const XcdMap& xm) {
  const int lane = threadIdx.x & 63, warp = threadIdx.x >> 6, wm = warp >> 1, wn = warp & 1;
  const bf16_t* ya = (const bf16_t*)(p.ws + O_PO);
  const bf16_t* yb = (const bf16_t*)(p.ws + R_YA);
  const bf16_t* pg = (const bf16_t*)(p.ws + O_PG);
  bf16_t* mg = (bf16_t*)(p.ws + R_MERGED);
  for_tiles_xcd(xm, 128, 8, 8, 8, [&](int mt, int nt) {
    f32x4 acc[4][4];
    zero_acc(acc);
    gemm_core(ya + (size_t)mt * 128 * 512, 512, (const bf16_t*)(p.ws + O_WBA) + (size_t)nt * 128 * 512, 512, 512, acc, smem);
#pragma unroll
    for (int i = 0; i < 4; ++i) {
      int row = mt * 128 + wm * 64 + i * 16 + (lane & 15);
#pragma unroll
      for (int j = 0; j < 4; ++j) {
        int n = nt * 128 + wn * 64 + j * 16 + (lane >> 4) * 4;
        uint2 s = *(const uint2*)(pg + (size_t)row * 2048 + n);
        *(uint2*)(mg + (size_t)row * 1024 + n) = make_uint2(pack2(acc[i][j][0] * bflo(s.x), acc[i][j][1] * bfhi(s.x)), pack2(acc[i][j][2] * bflo(s.y), acc[i][j][3] * bfhi(s.y)));
      }
    }
    zero_acc(acc);
    gemm_core(yb + (size_t)mt * 128 * 512, 512, (const bf16_t*)(p.ws + O_WBB) + (size_t)nt * 128 * 512, 512, 512, acc, smem);
#pragma unroll
    for (int i = 0; i < 4; ++i) {
      int row = mt * 128 + wm * 64 + i * 16 + (lane & 15);
#pragma unroll
      for (int j = 0; j < 4; ++j) {
        int n = nt * 128 + wn * 64 + j * 16 + (lane >> 4) * 4;
        uint2 s = *(const uint2*)(pg + (size_t)row * 2048 + 1024 + n);
        uint2 m0 = *(const uint2*)(mg + (size_t)row * 1024 + n);
        float v0 = bflo(m0.x) + acc[i][j][0] * bflo(s.x), v1 = bfhi(m0.x) + acc[i][j][1] * bfhi(s.x);
        float v2 = bflo(m0.y) + acc[i][j][2] * bflo(s.y), v3 = bfhi(m0.y) + acc[i][j][3] * bfhi(s.y);
        *(uint2*)(mg + (size_t)row * 1024 + n) = make_uint2(pack2(v0, v1), pack2(v2, v3));
      }
    }
  });
}

DEVI void phase12(const Params& p, unsigned char* smem, const XcdMap& xm) {
  float* gt = (float*)(smem + 45056);
  const int tid = threadIdx.x, lane = tid & 63, warp = tid >> 6, wm = warp >> 1, wn = warp & 1;
  for (int i = tid; i < 1024; i += 256) gt[i] = mod_val(p, 0, 2048 + i);
  __syncthreads();
  const bf16_t* mg = (const bf16_t*)(p.ws + R_MERGED);
  const float* x = p.in[I_X];
  float* x1 = p.out;
  for_tiles_xcd(xm, 128, 8, 8, 8, [&](int mt, int nt) {
    f32x4 acc[4][4];
    zero_acc(acc);
    gemm_core(mg + (size_t)mt * 128 * 1024, 1024, (const bf16_t*)(p.ws + O_WOUT) + (size_t)nt * 128 * 1024, 1024, 1024, acc, smem);
#pragma unroll
    for (int i = 0; i < 4; ++i) {
      int row = mt * 128 + wm * 64 + i * 16 + (lane & 15);
#pragma unroll
      for (int j = 0; j < 4; ++j) {
        int n = nt * 128 + wn * 64 + j * 16 + (lane >> 4) * 4;
        float4 xv = *(const float4*)(x + (size_t)row * 1024 + n);
        xv.x += gt[n] * acc[i][j][0]; xv.y += gt[n + 1] * acc[i][j][1]; xv.z += gt[n + 2] * acc[i][j][2]; xv.w += gt[n + 3] * acc[i][j][3];
        *(float4*)(x1 + (size_t)row * 1024 + n) = xv;
      }
    }
  });
}

DEVI void phase13(const Params& p, unsigned char* smem) {
  float* smod = (float*)smem;
  const int tid = threadIdx.x, lane = tid & 63, warp = tid >> 6;
  for (int i = tid; i < 2048; i += 256) smod[i] = mod_val(p, 0, 3072 + i);
  __syncthreads();
  const float* x1 = p.out;
  bf16_t* h2 = (bf16_t*)(p.ws + R_H2);
  for (int rp = blockIdx.x * 4 + warp; rp < T_LAT / 2; rp += gridDim.x * 4) {
    float h[2][16]; float ss[2] = {0.f, 0.f};
#pragma unroll
    for (int u = 0; u < 2; ++u)
#pragma unroll
      for (int i = 0; i < 4; ++i) {
        float4 v = *(const float4*)(x1 + (size_t)(rp * 2 + u) * 1024 + i * 256 + lane * 4);
        h[u][4 * i] = v.x; h[u][4 * i + 1] = v.y; h[u][4 * i + 2] = v.z; h[u][4 * i + 3] = v.w;
        ss[u] += v.x * v.x + v.y * v.y + v.z * v.z + v.w * v.w;
      }
#pragma unroll
    for (int u = 0; u < 2; ++u) {
      const int row = rp * 2 + u;
      const float rstd = rsqrtf(wave_sum_u(ss[u]) * (1.f / 1024.f) + 1e-6f);
#pragma unroll
      for (int i = 0; i < 4; ++i) {
        {
          const int k0 = i * 256 + lane * 4;
          const float4 gk = *(const float4*)(p.in[I_N2G] + k0);
          const f32x4 s4 = *(const f32x4*)(smod + 1024 + k0), h4 = *(const f32x4*)(smod + k0);
          h[u][4 * i] = h[u][4 * i] * rstd * gk.x * (1.f + s4[0]) + h4[0];
          h[u][4 * i + 1] = h[u][4 * i + 1] * rstd * gk.y * (1.f + s4[1]) + h4[1];
          h[u][4 * i + 2] = h[u][4 * i + 2] * rstd * gk.z * (1.f + s4[2]) + h4[2];
          h[u][4 * i + 3] = h[u][4 * i + 3] * rstd * gk.w * (1.f + s4[3]) + h4[3];
        }
        *(uint2*)(h2 + (size_t)row * 1024 + i * 256 + lane * 4) = make_uint2(pack2(h[u][4 * i], h[u][4 * i + 1]), pack2(h[u][4 * i + 2], h[u][4 * i + 3]));
      }
    }
  }
}

DEVI void phase14(const Params& p, unsigned char* smem, const XcdMap& xm) {
  bf16_t(*Qt)[136] = (bf16_t(*)[136])smem;
  float* Sc = (float*)smem;
  const int tid = threadIdx.x, lane = tid & 63, warp = tid >> 6, wm = warp >> 1, wn = warp & 1;
  const bf16_t* h2 = (const bf16_t*)(p.ws + R_H2);
  const bf16_t* keys = (const bf16_t*)(p.ws + O_KEYS);
  float* tops = (float*)(p.ws + R_TOPS);
  int* topi = (int*)(p.ws + R_TOPI);
  for_tiles_xcd(xm, 128, 16, 8, 8, [&](int mt, int hp) {
    f32x4 acc[4][4];
    zero_acc(acc);
    gemm_core(h2 + (size_t)mt * 128 * 1024, 1024, (const bf16_t*)(p.ws + O_WQ) + (size_t)hp * 128 * 1024, 1024, 1024, acc, smem);
#pragma unroll
    for (int i = 0; i < 4; ++i)
#pragma unroll
      for (int j = 0; j < 4; ++j)
        *(uint2*)&Qt[wm * 64 + i * 16 + (lane & 15)][wn * 64 + j * 16 + (lane >> 4) * 4] =
            make_uint2(pack2(acc[i][j][0], acc[i][j][1]), pack2(acc[i][j][2], acc[i][j][3]));
    __syncthreads();
    zero_acc(acc);
#pragma unroll
    for (int ks = 0; ks < 4; ++ks) {
      bf16x8 qf[4], kf[4];
#pragma unroll
      for (int i = 0; i < 4; ++i) qf[i] = *(const bf16x8*)&Qt[wm * 64 + i * 16 + (lane & 15)][ks * 32 + (lane >> 4) * 8];
#pragma unroll
      for (int j = 0; j < 4; ++j) kf[j] = *(const bf16x8*)(keys + ((size_t)hp * 128 + wn * 64 + j * 16 + (lane & 15)) * 128 + ks * 32 + (lane >> 4) * 8);
#pragma unroll
      for (int i = 0; i < 4; ++i)
#pragma unroll
        for (int j = 0; j < 4; ++j) acc[i][j] = __builtin_amdgcn_mfma_f32_16x16x32_bf16(kf[j], qf[i], acc[i][j], 0, 0, 0);
    }
    __syncthreads();
#pragma unroll
    for (int i = 0; i < 4; ++i)
#pragma unroll
      for (int j = 0; j < 4; ++j) {
        {
          const int c0 = j * 16 + (lane >> 4) * 4;
          u32x4 kq;
#pragma unroll
          for (int r = 0; r < 4; ++r) {
            unsigned u = __float_as_uint(acc[i][j][r]);
            u = (u & 0x80000000u) ? ~u : (u | 0x80000000u);
            kq[r] = (u & ~63u) | (unsigned)(63 - (c0 + r));
          }
          *(u32x4*)(Sc + (wm * 64 + i * 16 + (lane & 15)) * 132 + wn * 64 + c0) = kq;
        }
      }
    __syncthreads();
    {
      const int row = tid & 127, half = tid >> 7;
      float* hp_ = Sc + row * 132 + half * 64;
      float bv[16]; int bi[16];
      unsigned* hk = (unsigned*)hp_;
#pragma unroll
      for (int r = 0; r < 16; ++r) {
        unsigned best = 0u;
#pragma unroll 16
        for (int k = 0; k < 64; k += 4) {
          const u32x4 v4 = *(const u32x4*)(hk + k);
          const unsigned m01 = v4[0] > v4[1] ? v4[0] : v4[1], m23 = v4[2] > v4[3] ? v4[2] : v4[3];
          const unsigned m = m01 > m23 ? m01 : m23;
          best = best > m ? best : m;
        }
        const int b2 = 63 - (int)(best & 63u);
        unsigned u = best & ~63u;
        u = (u & 0x80000000u) ? (u & 0x7fffffffu) : ~u;
        bv[r] = __uint_as_float(u); bi[r] = b2 + half * 64; hk[b2] = 0u;
      }
#pragma unroll
      for (int r = 0; r < 16; ++r) { hp_[r] = bv[r]; hp_[16 + r] = __int_as_float(bi[r]); }
    }
    __syncthreads();
    if (tid < 128) {
      const float* la = Sc + tid * 132; const float* lb = la + 64;
      size_t ob = ((size_t)(mt * 128 + tid) * 16 + hp) * 16;
      int ia = 0, ib = 0;
      for (int r = 0; r < 16; ++r) {
        float va = la[ia], vb = lb[ib];
        bool ta = va >= vb;
        tops[ob + r] = ta ? va : vb;
        topi[ob + r] = __float_as_int(ta ? la[16 + ia] : lb[16 + ib]);
        ia += ta ? 1 : 0; ib += ta ? 0 : 1;
      }
    }
    __syncthreads();
  });
}

template <bool DRY> DEVI void phase15(const Params& p, unsigned char* smem) {
  const bool wr = !DRY || (p.in[I_FG][0] == 1234.5f);
  float* gt = (float*)smem;
  const int tid = threadIdx.x, lane = tid & 63, warp = tid >> 6;
  for (int i = tid; i < 1024; i += 256) gt[i] = mod_val(p, 0, 5120 + i);
  __syncthreads();
  const bf16_t* __restrict__ h2 = (const bf16_t*)(p.ws + R_H2);
  const float* __restrict__ tops = (const float*)(p.ws + R_TOPS);
  const int* __restrict__ topi = (const int*)(p.ws + R_TOPI);
  const unsigned char* __restrict__ uf8 = p.ws + R_UBF;
  const unsigned char* __restrict__ vf8 = p.ws + R_VBF;
  float* xo = p.out;
  int ca, cb;
  {
    int l = lane;
    if (l < 16) { ca = 0; cb = l; } else if (l < 24) { ca = 1; cb = l - 16; } else if (l < 29) { ca = 2; cb = l - 24; }
    else if (l < 33) { ca = 3; cb = l - 29; } else if (l < 36) { ca = 4; cb = l - 33; } else if (l < 38) { ca = 5; cb = l - 36; }
    else if (l < 40) { ca = 6; cb = l - 38; } else if (l < 42) { ca = 7; cb = l - 40; } else if (l < 50) { ca = l - 34; cb = 0; }
    else { ca = 0; cb = 0; }
  }
  const int flat = ca * 16 + cb;
  for (int t = blockIdx.x * 4 + warp; t < T_LAT; t += gridDim.x * 4) {
    float hv[16], out[16];
    {
      const u32x4 hp0 = *(const u32x4*)(h2 + (size_t)t * 1024 + lane * 16);
      const u32x4 hp1 = *(const u32x4*)(h2 + (size_t)t * 1024 + lane * 16 + 8);
#pragma unroll
      for (int e = 0; e < 4; ++e) { hv[2 * e] = bflo(hp0[e]); hv[2 * e + 1] = bfhi(hp0[e]); hv[8 + 2 * e] = bflo(hp1[e]); hv[8 + 2 * e + 1] = bfhi(hp1[e]); }
    }
#pragma unroll
    for (int e = 0; e < 16; ++e) out[e] = 0.f;
#pragma unroll 1
    for (int hd = 0; hd < 8; ++hd) {
      const size_t b1 = ((size_t)t * 16 + hd * 2) * 16, b2 = b1 + 16;
      float val = lane < 50 ? tops[b1 + ca] + tops[b2 + cb] : -INFINITY;
      int idx = topi[b1 + ca] * 128 + topi[b2 + cb];
      unsigned key = __float_as_uint(val);
      key = (key & 0x80000000u) ? ~key : (key | 0x80000000u);
      key = lane < 50 ? ((key & ~63u) | (unsigned)(63 - lane)) : 0u;
      int cnt = 0;
#pragma unroll
      for (int i = 0; i < 50; ++i) cnt += ((unsigned)__builtin_amdgcn_readlane((int)key, i) > key) ? 1 : 0;
      bool sel = lane < 50 && cnt < 16;
      float vmax = rlf(val, 0);
      float ex = sel ? __expf(val - vmax) : 0.f;
      float gsum = wave_sum_u(ex);
      float g = ex / gsum;
      unsigned long long m1 = __ballot(sel);
      int es[16];
      float gq = 0.f;
#pragma unroll
      for (int q = 0; q < 16; ++q) {
        int src = __ffsll((long long)m1) - 1; m1 &= m1 - 1;
        es[q] = __builtin_amdgcn_readlane(idx, src);
        float gg = rlf(g, src);
        if (lane == q) gq = gg;
      }
      float dm = 0.f;
      {
        u32x4 ub[16];
#pragma unroll
        for (int q = 0; q < 16; ++q) ub[q] = *(const u32x4*)(uf8 + (size_t)es[q] * 1024 + lane * 16);
#pragma unroll
        for (int q = 0; q < 16; ++q) {
          float f[16]; unpack_fp8x16(ub[q], f);
          float d0 = 0.f, d1 = 0.f;
#pragma unroll
          for (int e = 0; e < 8; ++e) { d0 += f[2 * e] * hv[2 * e]; d1 += f[2 * e + 1] * hv[2 * e + 1]; }
          float d = d0 + d1;
          d += dppf<0xB1>(d); d += dppf<0x4E>(d); d += dppf<0x141>(d); d += dppf<0x140>(d);
          if ((lane & 15) == q) dm = d;
        }
      }
      dm += __shfl_xor(dm, 16); dm += __shfl_xor(dm, 32);
      dm *= (1.f / 64.f);
      float coef = gq * 0.5f * dm * (1.f + erff(dm * 0.70710678118f)) * 0.25f;
      {
        u32x4 vb[16];
#pragma unroll
        for (int q = 0; q < 16; ++q) vb[q] = *(const u32x4*)(vf8 + (size_t)es[q] * 1024 + lane * 16);
#pragma unroll
        for (int q = 0; q < 16; ++q) {
          float cf = rlf(coef, q);
          float f[16]; unpack_fp8x16(vb[q], f);
#pragma unroll
          for (int e = 0; e < 16; ++e) out[e] += cf * f[e];
        }
      }
    }
    float xs[16]; float ss = 0.f;
#pragma unroll
    for (int i = 0; i < 4; ++i) {
      int k = lane * 16 + i * 4;
      float4 v = *(const float4*)(xo + (size_t)t * 1024 + k);
      xs[4 * i] = v.x + gt[k] * out[4 * i]; xs[4 * i + 1] = v.y + gt[k + 1] * out[4 * i + 1];
      xs[4 * i + 2] = v.z + gt[k + 2] * out[4 * i + 2]; xs[4 * i + 3] = v.w + gt[k + 3] * out[4 * i + 3];
      ss += xs[4 * i] * xs[4 * i] + xs[4 * i + 1] * xs[4 * i + 1] + xs[4 * i + 2] * xs[4 * i + 2] + xs[4 * i + 3] * xs[4 * i + 3];
    }
    ss = wave_sum_u(ss);
    float rstd = rsqrtf(ss * (1.f / 1024.f) + 1e-6f);
#pragma unroll
    for (int i = 0; i < 4; ++i) {
      int k = lane * 16 + i * 4;
      float4 g4 = *(const float4*)(p.in[I_FG] + k);
      if (wr) *(float4*)(xo + (size_t)t * 1024 + k) = make_float4(xs[4 * i] * rstd * g4.x, xs[4 * i + 1] * rstd * g4.y, xs[4 * i + 2] * rstd * g4.z, xs[4 * i + 3] * rstd * g4.w);
    }
  }
}

#define XB_TMO      128
#define XB_XCNT(j)  (256  + 64 * (j))
#define XB_XSUB(j)  (1280 + 64 * (j))
#define XB_XGEN(j)  (2304 + 64 * (j))
#define XB_TOP      3328
#define XB_TOPGEN   3392
#define XCD_BAR_WORDS 3456
#define XB_SPIN_CAP (1u << 22)
#define LAS __attribute__((address_space(3)))
DEVI unsigned xb_ld(unsigned* p) { return __hip_atomic_load(p, __ATOMIC_RELAXED, __HIP_MEMORY_SCOPE_AGENT); }
DEVI unsigned xb_add(unsigned* p, unsigned v) { return __hip_atomic_fetch_add(p, v, __ATOMIC_RELAXED, __HIP_MEMORY_SCOPE_AGENT); }
DEVI unsigned xb_xcc_id() { return (unsigned)__builtin_amdgcn_s_getreg((3 << 11) | 20) & 0xFu; }
#define XB_SPIN(cond, bar) do { unsigned _sp = 0; while (cond) { __builtin_amdgcn_s_sleep(1); \
    if ((++_sp & 255u) == 0u) { if (xb_ld(&(bar)[XB_TMO])) break; if (_sp > XB_SPIN_CAP) { atomicAdd(&(bar)[XB_TMO], 1u); break; } } } } while (0)
struct XcdBarrier { unsigned* bar; unsigned x; volatile LAS unsigned* st; };
DEVI XcdBarrier xcd_barrier_post(unsigned* bar, volatile LAS unsigned* st) {
  XcdBarrier b; b.bar = bar; b.x = xb_xcc_id(); b.st = st;
  if (threadIdx.x == 0) st[2] = xb_add(&bar[XB_XCNT(b.x)], 1u);
  return b;
}
DEVI void xcd_barrier_complete(unsigned* bar, unsigned x, unsigned& nloc, unsigned& nx, unsigned& vidx) {
  const unsigned G = gridDim.x * gridDim.y * gridDim.z;
  unsigned sum, cnt, mine, below, sp = 0u;
  for (;;) {
    sum = 0u; cnt = 0u; mine = 0u; below = 0u;
#pragma unroll
    for (unsigned j = 0; j < 16; ++j) { const unsigned c = xb_ld(&bar[XB_XCNT(j)]); sum += c; cnt += (c > 0u) ? 1u : 0u; mine = (j == x) ? c : mine; below += (c > 0u && j < x) ? 1u : 0u; }
    if (sum == G) break;
    __builtin_amdgcn_s_sleep(1);
    if ((++sp & 255u) == 0u) { if (xb_ld(&bar[XB_TMO])) break; if (sp > XB_SPIN_CAP) { atomicAdd(&bar[XB_TMO], 1u); break; } }
  }
  nloc = mine > 0u ? mine : 1u; nx = cnt > 0u ? cnt : 1u; vidx = below;
}
DEVI void xcd_barrier(const XcdBarrier& b) {
  asm volatile("s_waitcnt vmcnt(0)" ::: "memory");
  __syncthreads();
  if (threadIdx.x == 0) {
    unsigned* bar = b.bar;
    __builtin_amdgcn_s_waitcnt(0);
    unsigned nloc = b.st[0], nx = b.st[1];
    if (nloc == 0u) { unsigned vidx; xcd_barrier_complete(bar, b.x, nloc, nx, vidx); b.st[0] = nloc; b.st[1] = nx; b.st[3] = vidx; }
    const unsigned old = xb_add(&bar[XB_XSUB(b.x)], 1u);
    const unsigned gen = old / nloc;
    if (old + 1u == (gen + 1u) * nloc) {
      __builtin_amdgcn_fence(__ATOMIC_RELEASE, "agent");
      asm volatile("s_waitcnt vmcnt(0)" ::: "memory");
      const unsigned og = xb_add(&bar[XB_TOP], 1u);
      const unsigned tg = og / nx;
      if (og + 1u == (tg + 1u) * nx) xb_add(&bar[XB_TOPGEN], 1u);
      else XB_SPIN(xb_ld(&bar[XB_TOPGEN]) == tg, bar);
      __builtin_amdgcn_fence(__ATOMIC_ACQUIRE, "agent");
      xb_add(&bar[XB_XGEN(b.x)], 1u);
      asm volatile("s_waitcnt vmcnt(0)" ::: "memory");
    } else {
      XB_SPIN(xb_ld(&bar[XB_XGEN(b.x)]) == gen, bar);
      __builtin_amdgcn_fence(__ATOMIC_ACQUIRE, "agent");
      asm volatile("s_waitcnt vmcnt(0)" ::: "memory");
    }
  }
  __syncthreads();
}

constexpr int NPHASE = 16;
DEVI XcdMap get_xm(int coop, const uint4& w) {
  XcdMap m;
  if (coop) { m.v = (int)w.w; m.nx = (int)w.y; m.slot = (int)w.z; m.slots = (int)w.x; }
  else { m.v = blockIdx.x & 7; m.nx = 8; m.slot = blockIdx.x >> 3; m.slots = gridDim.x >> 3; if (m.slots < 1) { m.slots = 1; } }
  return m;
}
__global__ void __launch_bounds__(256, 2) mk(Params p, int ph0, int ph1, int coop) {
  __shared__ __attribute__((aligned(16))) unsigned char smem[SMEM_BYTES];
  __shared__ uint4 xb_words;
  if (threadIdx.x == 0) xb_words = make_uint4(0u, 0u, 0u, 0u);
  __syncthreads();
  XcdBarrier xb;
  if (coop) xb = xcd_barrier_post((unsigned*)(p.ws + O_BAR), (volatile LAS unsigned*)&xb_words);
#ifdef XCC_PROBE
  if (coop && xb_xcc_id() != (blockIdx.x & 7u)) { unsigned long long t0 = wall_clock64(); while (wall_clock64() - t0 < 100000ull) __builtin_amdgcn_s_sleep(8); }
#endif
  if (ph0 < 0) cg::this_grid().sync();
#ifdef PROBE_A
#define STAMP(n) if (blockIdx.x == 0 && threadIdx.x == 0) ((unsigned long long*)(p.ws + O_STAMP))[n] = wall_clock64();
#else
#define STAMP(n)
#endif
#define RUN_PHASE(n, call)                                   \
  if (ph0 <= n && n < ph1) {                                 \
    STAMP(n)                                                 \
        if (DRY_PH == n) { if (n == 4) phase4<true>(p, smem); if (n == 5) phase5<true>(p, smem); if (n == 8) phase8<true>(p, smem); if (n == 15) phase15<true>(p, smem); } \
    if (ONLY < 0 || ONLY == n) { call; }                     \
    if (REPEAT_PH == n) { call; }                            \
    if (coop && n + 1 < ph1) xcd_barrier(xb);                \
  }
  RUN_PHASE(0, phase0(p, smem, 0, 96))
  RUN_PHASE(1, (phase1(p, smem), __syncthreads(), phase0(p, smem, 96, 1 << 30)))
  RUN_PHASE(2, phase2(p, smem, get_xm(coop, xb_words)))
  RUN_PHASE(3, phase3(p, smem))
  RUN_PHASE(4, (phase4<false>(p, smem), phase6(p, smem, 0, 32, gridDim.x > 290 ? 258 : 0, gridDim.x > 290 ? (int)gridDim.x - 258 : (int)gridDim.x)))
  RUN_PHASE(5, phase5<false>(p, smem))
  RUN_PHASE(6, phase6(p, smem, 32, 260 * 8, 0, (int)gridDim.x))
  RUN_PHASE(7, phase7(p))
  RUN_PHASE(8, phase8<false>(p, smem))
  RUN_PHASE(9, phase9(p))
  RUN_PHASE(10, phase10(p))
  RUN_PHASE(11, phase11(p, smem, get_xm(coop, xb_words)))
  RUN_PHASE(12, (phase12(p, smem, get_xm(coop, xb_words)), convert_fp8(p.in[I_PU], p.ws + R_UBF, (size_t)16384 * 64, 64.f)))
  RUN_PHASE(13, phase13(p, smem))
  RUN_PHASE(14, (phase14(p, smem, get_xm(coop, xb_words)), convert_fp8(p.in[I_PV], p.ws + R_VBF, (size_t)16384 * 64, 4.f)))
  RUN_PHASE(15, phase15<false>(p, smem))
#ifdef SYNC_EXTRA
  for (int i = 0; i < SYNC_EXTRA; ++i) xcd_barrier(xb);
#endif
#ifdef PROBE_A
  cg::this_grid().sync();
  STAMP(16)
  __syncthreads();
  if (blockIdx.x == 0) {
    const unsigned long long* st = (const unsigned long long*)(p.ws + O_STAMP);
    float ta = (float)(st[PROBE_A + 1] - st[PROBE_A]) * 0.01f, tb = (float)(st[PROBE_B + 1] - st[PROBE_B]) * 0.01f;
    for (int i = threadIdx.x; i < 1000000; i += 256) p.out[1 + i] = tb;
    if (threadIdx.x == 0) p.out[0] = 100.f * ta;
  }
#endif
}

extern "C" void kernel_launch(void* const* d_in, const int* in_sizes, int n_in, void* d_out, int out_size, void* d_ws,
                              size_t ws_size, hipStream_t stream) {
  static int grid_blocks = 0;
  if (!grid_blocks) {
    int dev = 0, cus = 0, per_cu = 0;
    hipGetDevice(&dev);
    hipDeviceGetAttribute(&cus, hipDeviceAttributeMultiprocessorCount, dev);
    hipOccupancyMaxActiveBlocksPerMultiprocessor(&per_cu, mk, 256, 0);
    if (per_cu < 1) per_cu = 1;
    if (per_cu > 2) per_cu = 2;
    grid_blocks = cus * per_cu;
  }
  if (ws_size < WS_NEED) { fprintf(stderr, "workspace too small: %zu < %zu\n", ws_size, (size_t)WS_NEED); return; }
  Params p{};
  for (int i = 0; i < 32; ++i) p.in[i] = (const float*)d_in[i];
  p.out = (float*)d_out;
  p.ws = (unsigned char*)d_ws;
#if MEGA
  (void)hipMemsetAsync((unsigned char*)d_ws + O_BAR, 0, XCD_BAR_WORDS * 4, stream);
  int ph0 = 0, ph1 = NPHASE, coop = 1;
  void* args[] = {&p, &ph0, &ph1, &coop};
  hipError_t e = hipLaunchCooperativeKernel((void*)mk, dim3(grid_blocks), dim3(256), args, 0, stream);
  if (e != hipSuccess) fprintf(stderr, "cooperative launch failed: %s (grid %d)\n", hipGetErrorString(e), grid_blocks);
#else
  for (int ph = 0; ph < NPHASE; ++ph) mk<<<grid_blocks, 256, 0, stream>>>(p, ph, ph + 1, 0);
#endif
}
```

```cpp
#include <hip/hip_runtime.h>
#include <hip/hip_cooperative_groups.h>
#include <cstdio>
#include <cstdint>
namespace cg = cooperative_groups;

#ifndef MEGA
#define MEGA 1
#endif
#ifndef ONLY
#define ONLY -1
#endif
#ifndef REPEAT_PH
#define REPEAT_PH -1
#endif
#ifndef DRY_PH
#define DRY_PH -1
#endif

typedef unsigned short bf16_t;
using bf16x8 = __attribute__((ext_vector_type(8))) short;
using f32x4 = __attribute__((ext_vector_type(4))) float;
using u32x4 = __attribute__((ext_vector_type(4))) unsigned;
#define DEVI __device__ __forceinline__

constexpr int T_CTX = 256, T_LAT = 16384, T_ALL = 16640;
constexpr int NIN = 5392, NP = 5376;
constexpr int NCH = 128, LCH = 130;
constexpr int SVH = 576;
constexpr int SMEM_BYTES = 71680;

enum { I_X = 0, I_C, I_CTX, I_CCTX, I_ADAW, I_ADAB, I_N1G, I_WIN, I_RCONV, I_RW0, I_RWUP, I_RA0, I_RAUP, I_RGUP,
       I_RKK, I_RKA, I_RRK, I_RLNW, I_RLNB, I_MCONV, I_MIB, I_MFB, I_MNG, I_WBA, I_WBB, I_WOUT, I_N2G, I_WQ,
       I_KEYS, I_PU, I_PV, I_FG };

struct Params { const float* in[32]; float* out; unsigned char* ws; };

constexpr size_t A256(size_t x) { return (x + 255) & ~(size_t)255; }
constexpr size_t O_MODP = 0;
constexpr size_t O_WBA = A256(O_MODP + (size_t)16 * 2 * 6144 * 4);
constexpr size_t O_WBB = A256(O_WBA + (size_t)1024 * 512 * 2);
constexpr size_t O_WOUT = A256(O_WBB + (size_t)1024 * 512 * 2);
constexpr size_t O_WQ = A256(O_WOUT + (size_t)1024 * 1024 * 2);
constexpr size_t O_KEYS = A256(O_WQ + (size_t)2048 * 1024 * 2);
constexpr size_t O_WUP = A256(O_KEYS + (size_t)16 * 128 * 128 * 2);
constexpr size_t O_AUP = A256(O_WUP + (size_t)1024 * 64 * 2);
constexpr size_t O_GUP = A256(O_AUP + (size_t)1024 * 64 * 2);
constexpr size_t O_BEND = A256(O_GUP + (size_t)512 * 128 * 2);
constexpr size_t O_MLOC = A256(O_BEND + (size_t)260 * 8 * 4);
constexpr size_t O_MST = A256(O_MLOC + (size_t)260 * 8 * 4);
constexpr size_t O_NT = A256(O_MST + (size_t)260 * 8 * 4);
constexpr size_t O_BONUS = A256(O_NT + (size_t)260 * 8 * 64 * 4);
constexpr size_t O_STAMP = A256(O_BONUS + (size_t)T_ALL * 16 * 4);
constexpr size_t O_BAR = A256(O_STAMP + 1024);
constexpr size_t O_PG = A256(O_BAR + 3456 * 4);
constexpr size_t O_PO = A256(O_PG + (size_t)T_LAT * 2048 * 2);
constexpr size_t O_R = A256(O_PO + (size_t)T_LAT * 512 * 2);
constexpr size_t R_HX = O_R;
constexpr size_t R_WIN = A256(R_HX + (size_t)T_ALL * 1024 * 2);
constexpr size_t R_PQK = A256(R_WIN + (size_t)(NP + 128) * 1024 * 2);
constexpr size_t R_PV = A256(R_PQK + (size_t)T_ALL * 512 * 2);
constexpr size_t R_GIF = A256(R_PV + (size_t)T_ALL * 512 * 2);
constexpr size_t R_U = A256(R_GIF + (size_t)T_ALL * 16 * 4);
constexpr size_t R_END1 = A256(R_U + (size_t)260 * 8 * 8192 * 4);
constexpr size_t R_SV = O_R;
constexpr size_t R_YA = A256(R_SV + (size_t)T_ALL * 8 * SVH * 2);
constexpr size_t R_END2 = A256(R_YA + (size_t)T_LAT * 512 * 2);
constexpr size_t R_MERGED = O_R;
constexpr size_t R_H2 = A256(R_MERGED + (size_t)T_LAT * 1024 * 2);
constexpr size_t R_TOPS = A256(R_H2 + (size_t)T_LAT * 1024 * 2);
constexpr size_t R_TOPI = A256(R_TOPS + (size_t)T_LAT * 256 * 4);
constexpr size_t R_UBF = A256(R_TOPI + (size_t)T_LAT * 256 * 4);
constexpr size_t R_VBF = A256(R_UBF + (size_t)16384 * 1024 * 2);
constexpr size_t R_END3 = A256(R_VBF + (size_t)16384 * 1024 * 2);
constexpr size_t WS_NEED = (R_END1 > R_END2 ? (R_END1 > R_END3 ? R_END1 : R_END3) : (R_END2 > R_END3 ? R_END2 : R_END3));
constexpr size_t OUT_BC = (size_t)NCH * 16 * 4096 * 4;

DEVI bf16_t f2bf(float f) { unsigned u = __float_as_uint(f); u += 0x7fffu + ((u >> 16) & 1u); return (bf16_t)(u >> 16); }
DEVI float bf2f(bf16_t h) { return __uint_as_float(((unsigned)h) << 16); }
DEVI float bflo(unsigned u) { return __uint_as_float(u << 16); }
DEVI float bfhi(unsigned u) { return __uint_as_float(u & 0xffff0000u); }
DEVI unsigned pack2(float a, float b) { return (unsigned)f2bf(a) | ((unsigned)f2bf(b) << 16); }
DEVI void unpack8(const uint4& u, float* f) {
  f[0] = bflo(u.x); f[1] = bfhi(u.x); f[2] = bflo(u.y); f[3] = bfhi(u.y);
  f[4] = bflo(u.z); f[5] = bfhi(u.z); f[6] = bflo(u.w); f[7] = bfhi(u.w);
}
DEVI uint4 pack8(const float* f) { return make_uint4(pack2(f[0], f[1]), pack2(f[2], f[3]), pack2(f[4], f[5]), pack2(f[6], f[7])); }
DEVI float wave_sum(float v) {
#pragma unroll
  for (int o = 32; o; o >>= 1) v += __shfl_xor(v, o);
  return v;
}
DEVI float wave_max(float v) {
#pragma unroll
  for (int o = 32; o; o >>= 1) v = fmaxf(v, __shfl_xor(v, o));
  return v;
}
DEVI float sigm(float x) { return 1.f / (1.f + __expf(-x)); }
DEVI float siluf(float x) { return x / (1.f + __expf(-x)); }
DEVI float logsig(float x) { return fminf(x, 0.f) - log1pf(expf(-fabsf(x))); }
template <int CTRL> DEVI float dppf(float v) { return __int_as_float(__builtin_amdgcn_update_dpp(0, __float_as_int(v), CTRL, 0xf, 0xf, true)); }
DEVI float rlf(float v, int l) { return __int_as_float(__builtin_amdgcn_readlane(__float_as_int(v), l)); }
DEVI float wave_sum_u(float v) {
  v += dppf<0xB1>(v); v += dppf<0x4E>(v); v += dppf<0x141>(v); v += dppf<0x140>(v);
  return (rlf(v, 0) + rlf(v, 16)) + (rlf(v, 32) + rlf(v, 48));
}
typedef __attribute__((ext_vector_type(2))) short s16x2;
DEVI float dot2bf(unsigned a, unsigned b, float c) { return __builtin_amdgcn_fdot2_f32_bf16(__builtin_bit_cast(s16x2, a), __builtin_bit_cast(s16x2, b), c, false); }
typedef __attribute__((ext_vector_type(2))) float f32x2;
DEVI void convert_fp8(const float* __restrict__ src, unsigned char* __restrict__ dst, size_t n16, float scale) {
  for (size_t g = (size_t)blockIdx.x * 256 + threadIdx.x; g < n16; g += (size_t)gridDim.x * 256) {
    u32x4 o;
#pragma unroll
    for (int q = 0; q < 4; ++q) {
      float4 a = *(const float4*)(src + g * 16 + q * 4);
      int pk = __builtin_amdgcn_cvt_pk_fp8_f32(a.x * scale, a.y * scale, 0, false);
      pk = __builtin_amdgcn_cvt_pk_fp8_f32(a.z * scale, a.w * scale, pk, true);
      o[q] = (unsigned)pk;
    }
    *(u32x4*)(dst + g * 16) = o;
  }
}
DEVI void unpack_fp8x16(const u32x4& u, float* f) {
#pragma unroll
  for (int q = 0; q < 4; ++q) {
    f32x2 lo = __builtin_amdgcn_cvt_pk_f32_fp8((int)u[q], false), hi = __builtin_amdgcn_cvt_pk_f32_fp8((int)u[q], true);
    f[4 * q] = lo[0]; f[4 * q + 1] = lo[1]; f[4 * q + 2] = hi[0]; f[4 * q + 3] = hi[1];
  }
}
DEVI void convert_bf16(const float* __restrict__ src, bf16_t* __restrict__ dst, size_t n8) {
  for (size_t g = (size_t)blockIdx.x * 256 + threadIdx.x; g < n8; g += (size_t)gridDim.x * 256) {
    float4 a = *(const float4*)(src + g * 8), b = *(const float4*)(src + g * 8 + 4);
    *(uint4*)(dst + g * 8) = make_uint4(pack2(a.x, a.y), pack2(a.z, a.w), pack2(b.x, b.y), pack2(b.z, b.w));
  }
}
DEVI float allred8(float v) { v += dppf<0xB1>(v); v += dppf<0x4E>(v); v += dppf<0x141>(v); return v; }

DEVI int ml_row(int c, int j) {
  if (c < 4) return c * 64 + j;
  int cc = c - 4; int col = cc >> 2; int gr = (cc & 3) * 64 + j;
  return T_CTX + gr * 64 + col;
}
DEVI int ml_sc(int c, int dir) { return dir == 0 ? c : (c < 4 ? 3 - c : 263 - c); }
DEVI int rw_row(int p, int dir) { return dir == 0 ? p : (p < T_CTX ? (T_CTX - 1 - p) : (T_ALL + T_CTX - 1 - p)); }

DEVI float mod_val(const Params& p, int which, int col) {
  return ((const float*)(p.ws + O_MODP))[which * 6144 + col];
}

DEVI void gemm_core(const bf16_t* __restrict__ A, int lda, const bf16_t* __restrict__ Bt, int ldb, int K,
                    f32x4 (&acc)[4][4], unsigned char* smem) {
  bf16_t(*sa)[80] = (bf16_t(*)[80])smem;
  bf16_t(*sb)[80] = (bf16_t(*)[80])(smem + 128 * 80 * 2);
  const int tid = threadIdx.x, lane = tid & 63, warp = tid >> 6, wm = warp >> 1, wn = warp & 1;
  const int lr = tid >> 3, lk = (tid & 7) * 8;
  const bf16_t* Ap = A + (size_t)lr * lda + lk;
  const bf16_t* Bp = Bt + (size_t)lr * ldb + lk;
  u32x4 ra0[4], rb0[4], ra1[4], rb1[4];
#pragma unroll
  for (int i = 0; i < 4; ++i) {
    ra0[i] = *(const u32x4*)(Ap + (size_t)(32 * i) * lda); rb0[i] = *(const u32x4*)(Bp + (size_t)(32 * i) * ldb);
    ra1[i] = *(const u32x4*)(Ap + (size_t)(32 * i) * lda + 64); rb1[i] = *(const u32x4*)(Bp + (size_t)(32 * i) * ldb + 64);
  }
#define GEMM_STEP(k0, ra, rb)                                                                                 \
  {                                                                                                           \
    __syncthreads();                                                                                          \
    _Pragma("unroll") for (int i = 0; i < 4; ++i) { *(u32x4*)&sa[lr + 32 * i][lk] = ra[i]; *(u32x4*)&sb[lr + 32 * i][lk] = rb[i]; } \
    __syncthreads();                                                                                          \
    if ((k0) + 128 < K) {                                                                                     \
      _Pragma("unroll") for (int i = 0; i < 4; ++i) {                                                         \
        ra[i] = *(const u32x4*)(Ap + (size_t)(32 * i) * lda + (k0) + 128);                                    \
        rb[i] = *(const u32x4*)(Bp + (size_t)(32 * i) * ldb + (k0) + 128);                                    \
      }                                                                                                       \
    }                                                                                                         \
    __builtin_amdgcn_s_setprio(1);                                                                            \
    _Pragma("unroll") for (int ks = 0; ks < 2; ++ks) {                                                        \
      bf16x8 af[4], bq[4];                                                                                    \
      _Pragma("unroll") for (int i = 0; i < 4; ++i) af[i] = *(const bf16x8*)&sa[wm * 64 + i * 16 + (lane & 15)][ks * 32 + (lane >> 4) * 8]; \
      _Pragma("unroll") for (int j = 0; j < 4; ++j) bq[j] = *(const bf16x8*)&sb[wn * 64 + j * 16 + (lane & 15)][ks * 32 + (lane >> 4) * 8]; \
      _Pragma("unroll") for (int i = 0; i < 4; ++i)                                                           \
        _Pragma("unroll") for (int j = 0; j < 4; ++j) acc[i][j] = __builtin_amdgcn_mfma_f32_16x16x32_bf16(bq[j], af[i], acc[i][j], 0, 0, 0); \
    }                                                                                                         \
    __builtin_amdgcn_s_setprio(0);                                                                            \
  }
  for (int k0 = 0; k0 < K; k0 += 128) {
    GEMM_STEP(k0, ra0, rb0)
    GEMM_STEP(k0 + 64, ra1, rb1)
  }
#undef GEMM_STEP
  __syncthreads();
}
DEVI void zero_acc(f32x4 (&acc)[4][4]) {
#pragma unroll
  for (int i = 0; i < 4; ++i)
#pragma unroll
    for (int j = 0; j < 4; ++j) acc[i][j] = f32x4{0.f, 0.f, 0.f, 0.f};
}

struct XcdMap { int v, nx, slot, slots; };
template <typename F> DEVI void for_tiles_xcd(const XcdMap& xm, int MT, int NT, int SM, int SN, F&& f) {
  const int nsn = (NT + SN - 1) / SN, nst = ((MT + SM - 1) / SM) * nsn, per = SM * SN;
  const int n_my = (nst - xm.v + xm.nx - 1) / xm.nx;
  for (int g = xm.slot; g < n_my * per; g += xm.slots) {
    const int s = xm.v + (g / per) * xm.nx, idx = g % per;
    const int sm = s / nsn, sn = s % nsn;
    const int mt = sm * SM + idx / SN, nt = sn * SN + idx % SN;
    if (mt < MT && nt < NT) f(mt, nt);
  }
}

DEVI void tr_tile(const float* __restrict__ src, int lds, int k0, int n0src, bf16_t* __restrict__ dst, int ldd, int n0dst,
                  unsigned char* smem) {
  float(*tile)[65] = (float(*)[65])smem;
  const int tid = threadIdx.x, j = tid & 63, i0 = tid >> 6;
#pragma unroll 4
  for (int ii = 0; ii < 16; ++ii) { int i = i0 + 4 * ii; tile[i][j] = src[(size_t)(k0 + i) * lds + n0src + j]; }
  __syncthreads();
#pragma unroll 4
  for (int jj = 0; jj < 16; ++jj) { int jn = i0 + 4 * jj; dst[(size_t)(n0dst + jn) * ldd + k0 + j] = f2bf(tile[j][jn]); }
  __syncthreads();
}

DEVI void phase0(const Params& p, unsigned char* smem, int it_lo, int it_hi) {
  const int tid = threadIdx.x;
  constexpr int N_MOD = 96, N_WIN = 16 * 85, N_WB = 128, N_WOUT = 256, N_WQ = 512, N_LORA = 16, N_GUP = 16, N_KEYS = 128;
  constexpr int E0 = N_MOD, E1 = E0 + N_WIN, E2 = E1 + N_WB, E3 = E2 + N_WB, E4 = E3 + N_WOUT, E5 = E4 + N_WQ,
                E6 = E5 + N_LORA, E7 = E6 + N_LORA, E8 = E7 + N_GUP, E9 = E8 + N_KEYS;
  if (it_hi > E9) it_hi = E9;
  for (int it = it_lo + blockIdx.x; it < it_hi; it += gridDim.x) {
    if (it < E0) {
      float* sl = (float*)smem;
      float* part = sl + 2048;
      __syncthreads();
      for (int i = tid; i < 2048; i += 256) sl[i] = siluf(i < 1024 ? p.in[I_C][i] : p.in[I_CCTX][i - 1024]);
      __syncthreads();
      const int cl = tid & 63, rg = tid >> 6, col = it * 64 + cl;
      const float* aw = p.in[I_ADAW] + (size_t)(rg * 256) * 6144 + col;
      float ax = 0.f, ac = 0.f;
#pragma unroll 32
      for (int r = 0; r < 256; ++r) {
        const float w = aw[(size_t)r * 6144];
        ax += sl[rg * 256 + r] * w;
        ac += sl[1024 + rg * 256 + r] * w;
      }
      part[(rg * 2 + 0) * 64 + cl] = ax;
      part[(rg * 2 + 1) * 64 + cl] = ac;
      __syncthreads();
      if (tid < 128) {
        const int which = tid >> 6;
        const float v = part[(0 * 2 + which) * 64 + cl] + part[(1 * 2 + which) * 64 + cl] + part[(2 * 2 + which) * 64 + cl] + part[(3 * 2 + which) * 64 + cl];
        ((float*)(p.ws + O_MODP))[which * 6144 + col] = v + p.in[I_ADAB][col];
      }
    } else if (it < E1) {
      int t = it - E0; int kt = t / 85, nt = t % 85; int n0 = nt * 64;
      tr_tile(p.in[I_WIN], NIN, kt * 64, nt == 84 ? 2816 : (n0 < 2816 ? n0 : n0 + 16), (bf16_t*)(p.ws + R_WIN), 1024, n0, smem);
    } else if (it < E2) {
      int t = it - E1; tr_tile(p.in[I_WBA], 1024, (t / 16) * 64, (t % 16) * 64, (bf16_t*)(p.ws + O_WBA), 512, (t % 16) * 64, smem);
    } else if (it < E3) {
      int t = it - E2; tr_tile(p.in[I_WBB], 1024, (t / 16) * 64, (t % 16) * 64, (bf16_t*)(p.ws + O_WBB), 512, (t % 16) * 64, smem);
    } else if (it < E4) {
      int t = it - E3; tr_tile(p.in[I_WOUT], 1024, (t / 16) * 64, (t % 16) * 64, (bf16_t*)(p.ws + O_WOUT), 1024, (t % 16) * 64, smem);
    } else if (it < E5) {
      int t = it - E4; tr_tile(p.in[I_WQ], 2048, (t / 32) * 64, (t % 32) * 64, (bf16_t*)(p.ws + O_WQ), 1024, (t % 32) * 64, smem);
    } else if (it < E6) {
      int t = it - E5; int dir = t / 8, nt = t % 8;
      tr_tile(p.in[I_RWUP] + (size_t)dir * 64 * 512, 512, 0, nt * 64, (bf16_t*)(p.ws + O_WUP) + (size_t)dir * 512 * 64, 64, nt * 64, smem);
    } else if (it < E7) {
      int t = it - E6; int dir = t / 8, nt = t % 8;
      tr_tile(p.in[I_RAUP] + (size_t)dir * 64 * 512, 512, 0, nt * 64, (bf16_t*)(p.ws + O_AUP) + (size_t)dir * 512 * 64, 64, nt * 64, smem);
    } else if (it < E8) {
      int t = it - E7; tr_tile(p.in[I_RGUP], 512, (t / 8) * 64, (t % 8) * 64, (bf16_t*)(p.ws + O_GUP), 128, (t % 8) * 64, smem);
    } else {
      int t = it - E8; size_t base = (size_t)t * 2048 + tid * 8;
      const float* s = p.in[I_KEYS] + base;
      float f[8];
      float4 a = *(const float4*)s, b = *(const float4*)(s + 4);
      f[0] = a.x; f[1] = a.y; f[2] = a.z; f[3] = a.w; f[4] = b.x; f[5] = b.y; f[6] = b.z; f[7] = b.w;
      *(uint4*)((bf16_t*)(p.ws + O_KEYS) + base) = pack8(f);
    }
  }
}

DEVI void phase1(const Params& p, unsigned char* smem) {
  float* smod = (float*)smem;
  const int tid = threadIdx.x, lane = tid & 63, warp = tid >> 6;
  for (int i = tid; i < 4096; i += 256) { int which = i >> 10; smod[i] = mod_val(p, which >> 1, (which & 1) * 1024 + (i & 1023)); }
  __syncthreads();
  bf16_t* hx = (bf16_t*)(p.ws + R_HX);
  float* gif = (float*)(p.ws + R_GIF);
  const float* win = p.in[I_WIN];
  constexpr int RPW = 4;
  for (int rg = blockIdx.x * 4 + warp; rg < T_ALL / RPW; rg += gridDim.x * 4) {
    const int row0 = rg * RPW;
    const float* sh = smod + (row0 < T_CTX ? 2048 : 0);
    const float* sc = sh + 1024;
    const float* src0 = row0 < T_CTX ? p.in[I_CTX] + (size_t)row0 * 1024 : p.in[I_X] + (size_t)(row0 - T_CTX) * 1024;
    float rstd[RPW]; f32x4 xv[RPW][4];
#pragma unroll
    for (int r = 0; r < RPW; ++r) {
      float ss = 0.f;
#pragma unroll
      for (int i = 0; i < 4; ++i) {
        const f32x4 v = *(const f32x4*)(src0 + (size_t)r * 1024 + i * 256 + lane * 4);
        xv[r][i] = v;
        ss += v[0] * v[0] + v[1] * v[1] + v[2] * v[2] + v[3] * v[3];
      }
      ss = wave_sum_u(ss);
      rstd[r] = rsqrtf(ss * (1.f / 1024.f) + 1e-6f);
    }
#pragma unroll
    for (int i = 0; i < 4; ++i) {
      const int k0 = i * 256 + lane * 4;
      const float4 gk = *(const float4*)(p.in[I_N1G] + k0);
      const float4 s4 = *(const float4*)(sc + k0), h4 = *(const float4*)(sh + k0);
#pragma unroll
      for (int r = 0; r < RPW; ++r) {
        const f32x4 v = xv[r][i];
        const float y0 = v[0] * rstd[r] * gk.x * (1.f + s4.x) + h4.x, y1 = v[1] * rstd[r] * gk.y * (1.f + s4.y) + h4.y;
        const float y2 = v[2] * rstd[r] * gk.z * (1.f + s4.z) + h4.z, y3 = v[3] * rstd[r] * gk.w * (1.f + s4.w) + h4.w;
        *(uint2*)(hx + (size_t)(row0 + r) * 1024 + k0) = make_uint2(pack2(y0, y1), pack2(y2, y3));
      }
    }
  }
}

DEVI void phase2(const Params& p, unsigned char* smem, const XcdMap& xm) {
  const int lane = threadIdx.x & 63, warp = threadIdx.x >> 6, wm = warp >> 1, wn = warp & 1;
  const bf16_t* hx = (const bf16_t*)(p.ws + R_HX);
  const bf16_t* wt = (const bf16_t*)(p.ws + R_WIN);
  bf16_t* prw = (bf16_t*)p.out;
  bf16_t* pqk = (bf16_t*)(p.ws + R_PQK);
  bf16_t* pv = (bf16_t*)(p.ws + R_PV);
  bf16_t* po = (bf16_t*)(p.ws + O_PO);
  bf16_t* pg = (bf16_t*)(p.ws + O_PG);
  for_tiles_xcd(xm, 130, 43, 5, 6, [&](int mt, int nt) {
    if (mt < 2 && nt >= 22 && nt < 42) return;
    f32x4 acc[4][4];
    zero_acc(acc);
    gemm_core(hx + (size_t)mt * 128 * 1024, 1024, wt + (size_t)nt * 128 * 1024, 1024, 1024, acc, smem);
    if (nt == 42) {
      float* gif = (float*)(p.ws + R_GIF);
      if (wn == 0) {
#pragma unroll
        for (int i = 0; i < 4; ++i) {
          const int row = mt * 128 + wm * 64 + i * 16 + (lane & 15);
          *(float4*)(gif + (size_t)row * 16 + (lane >> 4) * 4) = make_float4(acc[i][0][0], acc[i][0][1], acc[i][0][2], acc[i][0][3]);
        }
      }
      return;
    }
    bf16_t* dst; int ld, nb; int rofs = 0; bool sg = false;
    if (nt < 14) { dst = prw; ld = 1792; nb = nt * 128; }
    else if (nt < 18) { dst = pqk; ld = 512; nb = (nt - 14) * 128; }
    else if (nt < 22) { dst = pv; ld = 512; nb = (nt - 18) * 128; }
    else if (nt < 26) { dst = po; ld = 512; nb = (nt - 22) * 128; rofs = T_CTX; }
    else { dst = pg; ld = 2048; nb = (nt - 26) * 128; rofs = T_CTX; sg = true; }
    bf16_t(*Ct)[136] = (bf16_t(*)[136])smem;
#pragma unroll
    for (int i = 0; i < 4; ++i) {
#pragma unroll
      for (int j = 0; j < 4; ++j) {
        f32x4 v = acc[i][j];
        if (sg) { v[0] = sigm(v[0]); v[1] = sigm(v[1]); v[2] = sigm(v[2]); v[3] = sigm(v[3]); }
        *(uint2*)&Ct[wm * 64 + i * 16 + (lane & 15)][wn * 64 + j * 16 + (lane >> 4) * 4] = make_uint2(pack2(v[0], v[1]), pack2(v[2], v[3]));
      }
    }
    __syncthreads();
#pragma unroll
    for (int q = 0; q < 8; ++q) {
      const int pc = threadIdx.x + 256 * q; const int r = pc >> 4, c8 = (pc & 15) * 8;
      const int row = mt * 128 + r - rofs;
      *(u32x4*)(dst + (size_t)row * ld + nb + c8) = *(const u32x4*)&Ct[r][c8];
    }
    __syncthreads();
  });
}

DEVI void ml_qk8(const Params& p, int c, int j, int chan, float* o) {
  const bf16_t* pqk = (const bf16_t*)(p.ws + R_PQK);
  int row = ml_row(c, j);
  bool hp, hn; int rp, rn;
  if (c < 4) { hp = row > 0; hn = row < T_CTX - 1; rp = row - 1; rn = row + 1; }
  else { int gr = ((c - 4) & 3) * 64 + j; hp = gr > 0; hn = gr < 255; rp = row - 64; rn = row + 64; }
  const float* cw = p.in[I_MCONV];
  float cur[8], pr[8], nx[8];
  unpack8(*(const uint4*)(pqk + (size_t)row * 512 + chan), cur);
  if (hp) unpack8(*(const uint4*)(pqk + (size_t)rp * 512 + chan), pr);
  if (hn) unpack8(*(const uint4*)(pqk + (size_t)rn * 512 + chan), nx);
#pragma unroll
  for (int e = 0; e < 8; ++e) {
    float v = cw[512 + chan + e] * cur[e];
    if (hp) v += cw[chan + e] * pr[e];
    if (hn) v += cw[1024 + chan + e] * nx[e];
    o[e] = siluf(v);
  }
}

DEVI void phase3(const Params& p, unsigned char* smem) {
  bf16_t(*KT)[72] = (bf16_t(*)[72])smem;
  bf16_t(*VwT)[72] = (bf16_t(*)[72])(smem + 64 * 72 * 2);
  float* wgt = (float*)(smem + 64 * 72 * 2 + 256 * 72 * 2);
  const int tid = threadIdx.x, lane = tid & 63, warp = tid >> 6;
  const float* gif = (const float*)(p.ws + R_GIF);
  const bf16_t* pv = (const bf16_t*)(p.ws + R_PV);
  float* U = (float*)(p.ws + R_U);
  float* NT = (float*)(p.ws + O_NT);
  float* bend = (float*)(p.ws + O_BEND);
  float* mloc = (float*)(p.ws + O_MLOC);
  for (int it = blockIdx.x; it < 260 * 4; it += gridDim.x) {
    int c = it >> 2, h = it & 3;
    if (warp < 2) {
      int dir = warp; int j = dir ? 63 - lane : lane;
      int row = ml_row(c, j);
      float ig = gif[(size_t)row * 16 + dir * 4 + h] + p.in[I_MIB][dir * 4 + h];
      float lf = logsig(gif[(size_t)row * 16 + 8 + dir * 4 + h] + p.in[I_MFB][dir * 4 + h]);
      float b = lf;
#pragma unroll
      for (int o = 1; o < 64; o <<= 1) { float t = __shfl_up(b, o); if (lane >= o) b += t; }
      float be = __shfl(b, 63);
      float ge = be - b + ig;
      float ml = wave_max(ge);
      wgt[dir * 64 + j] = expf(ge - ml);
      if (lane == 0) { int sc = ml_sc(c, dir); bend[sc * 8 + dir * 4 + h] = be; mloc[sc * 8 + dir * 4 + h] = ml; }
    }
    __syncthreads();
    {
      int j = tid >> 2, part = tid & 3;
      float f[8];
#pragma unroll
      for (int q = 0; q < 2; ++q) {
        int d0 = part * 16 + q * 8;
        ml_qk8(p, c, j, 256 + h * 64 + d0, f);
#pragma unroll
        for (int e = 0; e < 8; ++e) KT[d0 + e][j] = f2bf(f[e] * 0.125f);
      }
      int row = ml_row(c, j);
      float w0 = wgt[j], w1 = wgt[64 + j];
#pragma unroll
      for (int q = 0; q < 4; ++q) {
        int v0 = part * 32 + q * 8;
        unpack8(*(const uint4*)(pv + (size_t)row * 512 + h * 128 + v0), f);
#pragma unroll
        for (int e = 0; e < 8; ++e) { VwT[v0 + e][j] = f2bf(f[e] * w0); VwT[128 + v0 + e][j] = f2bf(f[e] * w1); }
      }
    }
    __syncthreads();
#pragma unroll
    for (int dir = 0; dir < 2; ++dir) {
      int sc = ml_sc(c, dir);
      float* Ud = U + ((size_t)sc * 8 + dir * 4 + h) * 8192;
#pragma unroll
      for (int vi = 0; vi < 2; ++vi) {
        int vt = warp * 2 + vi;
        bf16x8 bv[2];
#pragma unroll
        for (int ks = 0; ks < 2; ++ks) bv[ks] = *(const bf16x8*)&VwT[dir * 128 + vt * 16 + (lane & 15)][ks * 32 + (lane >> 4) * 8];
#pragma unroll
        for (int dt = 0; dt < 4; ++dt) {
          f32x4 a = {0.f, 0.f, 0.f, 0.f};
#pragma unroll
          for (int ks = 0; ks < 2; ++ks) {
            bf16x8 ak = *(const bf16x8*)&KT[dt * 16 + (lane & 15)][ks * 32 + (lane >> 4) * 8];
            a = __builtin_amdgcn_mfma_f32_16x16x32_bf16(ak, bv[ks], a, 0, 0, 0);
          }
          *(float4*)(Ud + (size_t)(vt * 16 + (lane & 15)) * 64 + dt * 16 + (lane >> 4) * 4) = make_float4(a[0], a[1], a[2], a[3]);
        }
      }
    }
    if (tid < 128) {
      int dir = tid >> 6, d = tid & 63; float s = 0.f;
      for (int j = 0; j < 64; ++j) s += wgt[dir * 64 + j] * bf2f(KT[d][j]);
      NT[((size_t)ml_sc(c, dir) * 8 + dir * 4 + h) * 64 + d] = s;
    }
    __syncthreads();
  }
}

template <bool DRY> DEVI void phase4(const Params& p, unsigned char* smem) {
  const bool wr = !DRY || (p.in[I_FG][0] == 1234.5f);
  float* U = (float*)(p.ws + R_U);
  float* NT = (float*)(p.ws + O_NT);
  const float* bend = (const float*)(p.ws + O_BEND);
  const float* mloc = (const float*)(p.ws + O_MLOC);
  float* mst = (float*)(p.ws + O_MST);
  float(*kp)[264] = (float(*)[264])smem;
  float(*sp)[264] = (float(*)[264])(smem + 2 * 264 * 4);
  const int tid = threadIdx.x, lane = tid & 63, warp = tid >> 6;
  for (int gb = blockIdx.x * 256; gb < 8 * 8256; gb += gridDim.x * 256) {
    const int pA = gb / 8256;
    if (warp < 2) {
      const int pw = pA + warp;
      if (pw < 8) {
        float be[5], ml[5], B[5], m[5];
        float run = 0.f;
#pragma unroll
        for (int k = 0; k < 5; ++k) {
          const int c = lane * 5 + k;
          be[k] = c < 260 ? bend[c * 8 + pw] : 0.f;
          ml[k] = c < 260 ? mloc[c * 8 + pw] : -INFINITY;
          run += be[k]; B[k] = run;
        }
        float incl = run;
#pragma unroll
        for (int o = 1; o < 64; o <<= 1) { float t = __shfl_up(incl, o); if (lane >= o) incl += t; }
        const float off = incl - run;
        float pm = -INFINITY, pml[5];
#pragma unroll
        for (int k = 0; k < 5; ++k) { B[k] += off; pm = fmaxf(pm, ml[k] - B[k]); pml[k] = pm; }
        float inclm = pm;
#pragma unroll
        for (int o = 1; o < 64; o <<= 1) { float t = __shfl_up(inclm, o); if (lane >= o) inclm = fmaxf(inclm, t); }
        float offm = __shfl_up(inclm, 1); if (lane == 0) offm = -INFINITY;
#pragma unroll
        for (int k = 0; k < 5; ++k) m[k] = B[k] + fmaxf(0.f, fmaxf(offm, pml[k]));
        float mprev = __shfl_up(m[4], 1); if (lane == 0) mprev = 0.f;
        const bool owner = gb <= pw * 8256 && pw * 8256 < gb + 256;
#pragma unroll
        for (int k = 0; k < 5; ++k) {
          const int c = lane * 5 + k;
          if (c < 260) {
            kp[warp][c] = expf(be[k] + mprev - m[k]);
            sp[warp][c] = expf(ml[k] - m[k]);
            if (wr && owner) mst[c * 8 + pw] = mprev;
          }
          mprev = m[k];
        }
      }
    }
    __syncthreads();
    const int g = gb + tid;
    if (g < 8 * 8256) {
      const int pr = g / 8256, e = g % 8256, slot = pr - pA;
      float* base; size_t stride;
      if (e < 8192) { base = U + (size_t)pr * 8192 + e; stride = 8 * 8192; }
      else { base = NT + (size_t)pr * 64 + (e - 8192); stride = 8 * 64; }
      float C = 0.f;
      for (int sc = 0; sc < 260; sc += 20) {
        float u[20];
#pragma unroll
        for (int q = 0; q < 20; ++q) u[q] = base[(size_t)(sc + q) * stride];
#pragma unroll
        for (int q = 0; q < 20; ++q) {
          if (wr) base[(size_t)(sc + q) * stride] = C;
          C = kp[slot][sc + q] * C + sp[slot][sc + q] * u[q];
        }
      }
    }
    __syncthreads();
  }
}

template <bool DRY> DEVI void phase5(const Params& p, unsigned char* smem) {
  const bool wr = !DRY || (p.in[I_FG][0] == 1234.5f);
  bf16_t(*Qs)[72] = (bf16_t(*)[72])smem;
  bf16_t(*Ks)[72] = (bf16_t(*)[72])(smem + 9216);
  bf16_t(*Pm)[72] = (bf16_t(*)[72])(smem + 2 * 9216);
  bf16_t(*VT)[72] = (bf16_t(*)[72])(smem + 3 * 9216);
  float* evec = (float*)(smem + 3 * 9216 + 144 * 72 * 2);
  float* Mvec = evec + 128;
  float* bvec = Mvec + 128;
  const int tid = threadIdx.x, lane = tid & 63, warp = tid >> 6;
  const float* gif = (const float*)(p.ws + R_GIF);
  const bf16_t* pv = (const bf16_t*)(p.ws + R_PV);
  const bf16_t* po = (const bf16_t*)(p.ws + O_PO);
  bf16_t* yb = (bf16_t*)(p.ws + R_YA);
  const float* U = (const float*)(p.ws + R_U);
  const float* NT = (const float*)(p.ws + O_NT);
  const float* mst = (const float*)(p.ws + O_MST);
  for (int it = blockIdx.x; it < 256 * 4; it += gridDim.x) {
    int c = 4 + (it >> 2), h = it & 3;
    if (warp < 2) {
      int dir = warp; int j = dir ? 63 - lane : lane;
      int row = ml_row(c, j);
      float ig = gif[(size_t)row * 16 + dir * 4 + h] + p.in[I_MIB][dir * 4 + h];
      float lf = logsig(gif[(size_t)row * 16 + 8 + dir * 4 + h] + p.in[I_MFB][dir * 4 + h]);
      float b = lf;
#pragma unroll
      for (int o = 1; o < 64; o <<= 1) { float t = __shfl_up(b, o); if (lane >= o) b += t; }
      float e = ig - b;
      float pm = e;
#pragma unroll
      for (int o = 1; o < 64; o <<= 1) { float t = __shfl_up(pm, o); if (lane >= o) pm = fmaxf(pm, t); }
      float m0 = mst[ml_sc(c, dir) * 8 + dir * 4 + h];
      evec[dir * 64 + j] = e; Mvec[dir * 64 + j] = fmaxf(m0, pm); bvec[dir * 64 + j] = b;
    }
    {
      int j = tid >> 2, part = tid & 3;
      float f[8];
#pragma unroll
      for (int q = 0; q < 2; ++q) {
        int d0 = part * 16 + q * 8;
        ml_qk8(p, c, j, h * 64 + d0, f);
        *(uint4*)&Qs[j][d0] = pack8(f);
        ml_qk8(p, c, j, 256 + h * 64 + d0, f);
#pragma unroll
        for (int e = 0; e < 8; ++e) f[e] *= 0.125f;
        *(uint4*)&Ks[j][d0] = pack8(f);
      }
      int row = ml_row(c, j);
#pragma unroll
      for (int q = 0; q < 4; ++q) {
        int v0 = part * 32 + q * 8;
        unpack8(*(const uint4*)(pv + (size_t)row * 512 + h * 128 + v0), f);
#pragma unroll
        for (int e = 0; e < 8; ++e) VT[v0 + e][j] = f2bf(f[e]);
      }
      for (int i = tid; i < 16 * 64; i += 256) VT[128 + (i >> 6)][i & 63] = (i < 64) ? (bf16_t)0x3f80 : (bf16_t)0;
    }
    __syncthreads();
    const int jl = warp * 16 + (lane & 15);
    f32x4 s0[4];
    bf16x8 qf[2];
#pragma unroll
    for (int ks = 0; ks < 2; ++ks) qf[ks] = *(const bf16x8*)&Qs[jl][ks * 32 + (lane >> 4) * 8];
#pragma unroll
    for (int st = 0; st < 4; ++st) {
      f32x4 a = {0.f, 0.f, 0.f, 0.f};
#pragma unroll
      for (int ks = 0; ks < 2; ++ks) {
        bf16x8 kf = *(const bf16x8*)&Ks[st * 16 + (lane & 15)][ks * 32 + (lane >> 4) * 8];
        a = __builtin_amdgcn_mfma_f32_16x16x32_bf16(kf, qf[ks], a, 0, 0, 0);
      }
      s0[st] = a;
    }
    f32x4 ysum[8];
#pragma unroll
    for (int vt = 0; vt < 8; ++vt) ysum[vt] = f32x4{0.f, 0.f, 0.f, 0.f};
#pragma unroll 1
    for (int dir = 0; dir < 2; ++dir) {
      float Mj = Mvec[dir * 64 + jl], bj = bvec[dir * 64 + jl];
      float m0 = mst[ml_sc(c, dir) * 8 + dir * 4 + h];
#pragma unroll
      for (int st = 0; st < 4; ++st) {
        float pvv[4];
#pragma unroll
        for (int r = 0; r < 4; ++r) {
          int s = st * 16 + (lane >> 4) * 4 + r;
          bool ok = dir == 0 ? (s <= jl) : (s >= jl);
          pvv[r] = ok ? s0[st][r] * expf(evec[dir * 64 + s] - Mj) : 0.f;
        }
        *(uint2*)&Pm[jl][st * 16 + (lane >> 4) * 4] = make_uint2(pack2(pvv[0], pvv[1]), pack2(pvv[2], pvv[3]));
      }
      __syncthreads();
      bf16x8 pf[2];
#pragma unroll
      for (int ks = 0; ks < 2; ++ks) pf[ks] = *(const bf16x8*)&Pm[jl][ks * 32 + (lane >> 4) * 8];
      const float* Cst = U + ((size_t)ml_sc(c, dir) * 8 + dir * 4 + h) * 8192;
      const float* nst = NT + ((size_t)ml_sc(c, dir) * 8 + dir * 4 + h) * 64;
      float ai = expf(m0 - Mj);
      f32x4 hh[9];
#pragma unroll
      for (int vt = 0; vt < 9; ++vt) {
        f32x4 a1 = {0.f, 0.f, 0.f, 0.f}, a2 = {0.f, 0.f, 0.f, 0.f};
#pragma unroll
        for (int ks = 0; ks < 2; ++ks) {
          bf16x8 vf = *(const bf16x8*)&VT[vt * 16 + (lane & 15)][ks * 32 + (lane >> 4) * 8];
          a1 = __builtin_amdgcn_mfma_f32_16x16x32_bf16(vf, pf[ks], a1, 0, 0, 0);
          int v = vt * 16 + (lane & 15);
          const float* cp = v < 128 ? Cst + (size_t)v * 64 + ks * 32 + (lane >> 4) * 8 : nst + ks * 32 + (lane >> 4) * 8;
          float cf[8];
          if (v <= 128) {
            float4 x0 = *(const float4*)cp, x1 = *(const float4*)(cp + 4);
            cf[0] = x0.x; cf[1] = x0.y; cf[2] = x0.z; cf[3] = x0.w; cf[4] = x1.x; cf[5] = x1.y; cf[6] = x1.z; cf[7] = x1.w;
          } else {
#pragma unroll
            for (int e = 0; e < 8; ++e) cf[e] = 0.f;
          }
          uint4 pk = pack8(cf);
          bf16x8 cfr;
          cfr[0] = (short)(pk.x & 0xffff); cfr[1] = (short)(pk.x >> 16); cfr[2] = (short)(pk.y & 0xffff); cfr[3] = (short)(pk.y >> 16);
          cfr[4] = (short)(pk.z & 0xffff); cfr[5] = (short)(pk.z >> 16); cfr[6] = (short)(pk.w & 0xffff); cfr[7] = (short)(pk.w >> 16);
          a2 = __builtin_amdgcn_mfma_f32_16x16x32_bf16(cfr, qf[ks], a2, 0, 0, 0);
        }
#pragma unroll
        for (int r = 0; r < 4; ++r) hh[vt][r] = a1[r] + ai * a2[r];
      }
      float den = __shfl(hh[8][0], lane & 15);
      float dn = fmaxf(fabsf(den), expf(-(bj + Mj)));
      float inv = 1.f / dn;
      float ss = 0.f;
#pragma unroll
      for (int vt = 0; vt < 8; ++vt)
#pragma unroll
        for (int r = 0; r < 4; ++r) { float x = hh[vt][r] * inv; hh[vt][r] = x; ss += x * x; }
      ss += __shfl_xor(ss, 16); ss += __shfl_xor(ss, 32);
      float rs = rsqrtf(ss * (1.f / 128.f) + 1e-6f);
#pragma unroll
      for (int vt = 0; vt < 8; ++vt)
#pragma unroll
        for (int r = 0; r < 4; ++r) ysum[vt][r] += hh[vt][r] * rs * p.in[I_MNG][h * 128 + vt * 16 + (lane >> 4) * 4 + r];
      __syncthreads();
    }
    {
      int row = ml_row(c, jl) - T_CTX;
#pragma unroll
      for (int vt = 0; vt < 8; ++vt) {
        const bf16_t* op = po + (size_t)row * 512 + h * 128 + vt * 16 + (lane >> 4) * 4;
        uint2 o = *(const uint2*)op;
        float y0 = ysum[vt][0] * sigm(bflo(o.x)), y1 = ysum[vt][1] * sigm(bfhi(o.x)), y2 = ysum[vt][2] * sigm(bflo(o.y)), y3 = ysum[vt][3] * sigm(bfhi(o.y));
        if (wr) *(uint2*)(yb + (size_t)row * 512 + h * 128 + vt * 16 + (lane >> 4) * 4) = make_uint2(pack2(y0, y1), pack2(y2, y3));
      }
    }
    __syncthreads();
  }
}

DEVI void phase6(const Params& p, unsigned char* smem, int item_lo, int item_hi, int blk0, int nblk) {
  float(*rs)[65] = (float(*)[65])smem;
  float(*ks)[65] = (float(*)[65])(smem + 64 * 65 * 4);
  bf16_t(*TW)[72] = (bf16_t(*)[72])(smem + 2 * 64 * 65 * 4);
  bf16_t(*TA)[72] = (bf16_t(*)[72])(smem + 2 * 64 * 65 * 4 + 9216);
  bf16_t(*TG)[136] = (bf16_t(*)[136])(smem + 2 * 64 * 65 * 4 + 2 * 9216);
  float* rn = (float*)(smem + 2 * 64 * 65 * 4 + 2 * 9216 + 64 * 136 * 2);
  const int tid = threadIdx.x, lane = tid & 63, warp = tid >> 6;
  const bf16_t* prw = (const bf16_t*)p.out;
  bf16_t* SV = (bf16_t*)(p.ws + R_SV);
  float* bonus = (float*)(p.ws + O_BONUS);
  const float* cw = p.in[I_RCONV];
  const bf16_t* WUP = (const bf16_t*)(p.ws + O_WUP);
  const bf16_t* AUP = (const bf16_t*)(p.ws + O_AUP);
  const bf16_t* GUP = (const bf16_t*)(p.ws + O_GUP);
  if ((int)blockIdx.x < blk0) return;
  for (int it = item_lo + ((int)blockIdx.x - blk0); it < item_hi; it += nblk) {
    int tile = it >> 3, head = it & 7;
    int row0 = tile * 64;
    int seg0 = tile < 4 ? 0 : row0, seg1 = tile < 4 ? T_CTX : row0 + 64;
#pragma unroll 1
    for (int ub = 0; ub < 2; ++ub) {
      u32x4 lc[7], lp[7], ln[7];
#pragma unroll
      for (int it7 = 0; it7 < 7; ++it7) {
        const int u = warp + 4 * (ub * 7 + it7);
        const int grp = u >> 3;
        const int j = (u & 7) * 8 + (lane >> 3), q = grp * 8 + (lane & 7);
        const int row = row0 + j;
        const int col = q < 24 ? (q >> 3) * 512 + head * 64 + (q & 7) * 8 : 1536 + (q - 24) * 8;
        const bool hp = row > seg0, hn = row < seg1 - 1;
        lc[it7] = *(const u32x4*)(prw + (size_t)row * 1792 + col);
        lp[it7] = hp ? *(const u32x4*)(prw + (size_t)(row - 1) * 1792 + col) : u32x4{0u, 0u, 0u, 0u};
        ln[it7] = hn ? *(const u32x4*)(prw + (size_t)(row + 1) * 1792 + col) : u32x4{0u, 0u, 0u, 0u};
      }
#pragma unroll
      for (int it7 = 0; it7 < 7; ++it7) {
        const int u = warp + 4 * (ub * 7 + it7);
        const int grp = u >> 3;
        const int j = (u & 7) * 8 + (lane >> 3), q = grp * 8 + (lane & 7);
        const int row = row0 + j;
        const int col = q < 24 ? (q >> 3) * 512 + head * 64 + (q & 7) * 8 : 1536 + (q - 24) * 8;
        float cur[8], pr[8], nx[8], o[8];
        unpack8(make_uint4(lc[it7][0], lc[it7][1], lc[it7][2], lc[it7][3]), cur);
        unpack8(make_uint4(lp[it7][0], lp[it7][1], lp[it7][2], lp[it7][3]), pr);
        unpack8(make_uint4(ln[it7][0], ln[it7][1], ln[it7][2], ln[it7][3]), nx);
        {
          float4 c0 = *(const float4*)(cw + col), c1 = *(const float4*)(cw + col + 4);
          float4 d0 = *(const float4*)(cw + 1792 + col), d1 = *(const float4*)(cw + 1792 + col + 4);
          float4 e0 = *(const float4*)(cw + 3584 + col), e1 = *(const float4*)(cw + 3584 + col + 4);
          float wp[8] = {c0.x, c0.y, c0.z, c0.w, c1.x, c1.y, c1.z, c1.w};
          float wc[8] = {d0.x, d0.y, d0.z, d0.w, d1.x, d1.y, d1.z, d1.w};
          float wn_[8] = {e0.x, e0.y, e0.z, e0.w, e1.x, e1.y, e1.z, e1.w};
#pragma unroll
          for (int e = 0; e < 8; ++e) o[e] = wc[e] * cur[e] + wp[e] * pr[e] + wn_[e] * nx[e];
        }
        if (grp == 0) {
#pragma unroll
          for (int e = 0; e < 8; ++e) rs[j][(q & 7) * 8 + e] = o[e];
        } else if (grp == 1) {
#pragma unroll
          for (int e = 0; e < 8; ++e) ks[j][(q & 7) * 8 + e] = o[e];
        } else if (grp == 2) {
          *(uint4*)(SV + ((size_t)row * 8 + head) * SVH + 2 * 64 + (q & 7) * 8) = pack8(o);
        } else if (grp == 3) {
#pragma unroll
          for (int e = 0; e < 8; ++e) o[e] = 1.f - 2.f / (1.f + __expf(2.f * o[e]));
          *(uint4*)&TW[j][(q - 24) * 8] = pack8(o);
        } else if (grp == 4) {
          *(uint4*)&TA[j][(q - 32) * 8] = pack8(o);
        } else {
#pragma unroll
          for (int e = 0; e < 8; ++e) o[e] = sigm(o[e]);
          *(uint4*)&TG[j][(q - 40) * 8] = pack8(o);
        }
      }
    }
    __syncthreads();
    {
      int j = tid >> 2, part = tid & 3; float ss = 0.f;
#pragma unroll
      for (int e = 0; e < 16; ++e) { float v = ks[j][part * 16 + e] * p.in[I_RKK][head * 64 + part * 16 + e]; ss += v * v; }
      ss += __shfl_xor(ss, 1); ss += __shfl_xor(ss, 2);
      if (part == 0) rn[j] = 1.f / fmaxf(sqrtf(ss), 1e-12f);
    }
    __syncthreads();
    for (int pc = tid; pc < 64 * 8; pc += 256) {
      int j = pc >> 3, c8 = (pc & 7) * 8; int row = row0 + j;
      float fr[8], fk[8], fkk[8];
#pragma unroll
      for (int e = 0; e < 8; ++e) { fr[e] = rs[j][c8 + e]; fk[e] = ks[j][c8 + e]; fkk[e] = fk[e] * p.in[I_RKK][head * 64 + c8 + e] * rn[j]; }
      bf16_t* b = SV + ((size_t)row * 8 + head) * SVH;
      *(uint4*)(b + 0 * 64 + c8) = pack8(fr);
      *(uint4*)(b + 1 * 64 + c8) = pack8(fk);
      *(uint4*)(b + 3 * 64 + c8) = pack8(fkk);
    }
    {
      const int jl = warp * 16 + (lane & 15); const int row = row0 + jl;
      bf16x8 tw[2], ta[2], tg[4];
#pragma unroll
      for (int s2 = 0; s2 < 2; ++s2) { tw[s2] = *(const bf16x8*)&TW[jl][s2 * 32 + (lane >> 4) * 8]; ta[s2] = *(const bf16x8*)&TA[jl][s2 * 32 + (lane >> 4) * 8]; }
#pragma unroll
      for (int s2 = 0; s2 < 4; ++s2) tg[s2] = *(const bf16x8*)&TG[jl][s2 * 32 + (lane >> 4) * 8];
      __syncthreads();
      bf16_t(*OB)[64][72] = (bf16_t(*)[64][72])(smem + 2 * 64 * 65 * 4);
      float bon[2] = {0.f, 0.f};
#pragma unroll
      for (int dir = 0; dir < 2; ++dir) {
#pragma unroll
        for (int ct = 0; ct < 4; ++ct) {
          const int ch0 = ct * 16 + (lane >> 4) * 4;
          const int C0 = head * 64 + ch0;
          if (dir == 0) {
            f32x4 a = {0.f, 0.f, 0.f, 0.f};
#pragma unroll
            for (int s2 = 0; s2 < 4; ++s2) {
              bf16x8 wf = *(const bf16x8*)(GUP + (size_t)(head * 64 + ct * 16 + (lane & 15)) * 128 + s2 * 32 + (lane >> 4) * 8);
              a = __builtin_amdgcn_mfma_f32_16x16x32_bf16(wf, tg[s2], a, 0, 0, 0);
            }
            *(uint2*)&OB[2][jl][ch0] = make_uint2(pack2(a[0], a[1]), pack2(a[2], a[3]));
          }
          f32x4 aw = {0.f, 0.f, 0.f, 0.f}, aa = {0.f, 0.f, 0.f, 0.f};
#pragma unroll
          for (int s2 = 0; s2 < 2; ++s2) {
            size_t wo = (size_t)(dir * 512 + head * 64 + ct * 16 + (lane & 15)) * 64 + s2 * 32 + (lane >> 4) * 8;
            bf16x8 wf = *(const bf16x8*)(WUP + wo);
            bf16x8 af = *(const bf16x8*)(AUP + wo);
            aw = __builtin_amdgcn_mfma_f32_16x16x32_bf16(wf, tw[s2], aw, 0, 0, 0);
            aa = __builtin_amdgcn_mfma_f32_16x16x32_bf16(af, ta[s2], aa, 0, 0, 0);
          }
          const float4 w04 = *(const float4*)(p.in[I_RW0] + dir * 512 + C0), a04 = *(const float4*)(p.in[I_RA0] + dir * 512 + C0);
          const float4 ka4 = *(const float4*)(p.in[I_RKA] + C0), rk4 = *(const float4*)(p.in[I_RRK] + C0);
          const float w0v[4] = {w04.x, w04.y, w04.z, w04.w}, a0v[4] = {a04.x, a04.y, a04.z, a04.w};
          const float kav[4] = {ka4.x, ka4.y, ka4.z, ka4.w}, rkv[4] = {rk4.x, rk4.y, rk4.z, rk4.w};
          float we[4], av[4];
#pragma unroll
          for (int r = 0; r < 4; ++r) {
            we[r] = (0.60653066f * 1.44269504f) * sigm(w0v[r] + aw[r]);
            av[r] = sigm(a0v[r] + aa[r]);
            float kv = ks[jl][ch0 + r];
            float keff = kv * (1.f + (av[r] - 1.f) * kav[r]);
            bon[dir] += rs[jl][ch0 + r] * keff * rkv[r];
          }
          *(uint2*)&OB[0][jl][ch0] = make_uint2(pack2(we[0], we[1]), pack2(we[2], we[3]));
          *(uint2*)&OB[1][jl][ch0] = make_uint2(pack2(av[0], av[1]), pack2(av[2], av[3]));
        }
        __syncthreads();
        for (int pc = tid; pc < (dir == 0 ? 3 : 2) * 64 * 8; pc += 256) {
          const int vsel = pc >> 9, j = (pc >> 3) & 63, c8 = (pc & 7) * 8;
          const int vec = vsel == 2 ? 8 : (4 + 2 * dir + vsel);
          *(u32x4*)(SV + ((size_t)(row0 + j) * 8 + head) * SVH + vec * 64 + c8) = *(const u32x4*)&OB[vsel][j][c8];
        }
        __syncthreads();
      }
#pragma unroll
      for (int dir = 0; dir < 2; ++dir) {
        float sb = bon[dir]; sb += __shfl_xor(sb, 16); sb += __shfl_xor(sb, 32);
        if (lane < 16) bonus[(size_t)row * 16 + dir * 8 + head] = sb;
      }
    }
    __syncthreads();
  }
}

struct RwVec { uint4 k, kk, w, a, v, r; };
DEVI void unpack8p(const uint4& u, f32x2* f) {
  f[0] = f32x2{bflo(u.x), bfhi(u.x)}; f[1] = f32x2{bflo(u.y), bfhi(u.y)}; f[2] = f32x2{bflo(u.z), bfhi(u.z)}; f[3] = f32x2{bflo(u.w), bfhi(u.w)};
}
DEVI f32x2 bc2(float x) { return f32x2{x, x}; }
DEVI void rw_load(RwVec& x, const bf16_t* SV, int row, int head, int dir, int i, int jg, bool need_r) {
  const bf16_t* b = SV + ((size_t)row * 8 + head) * SVH;
  x.k = *(const uint4*)(b + 1 * 64 + jg * 8);
  x.kk = *(const uint4*)(b + 3 * 64 + jg * 8);
  x.w = *(const uint4*)(b + (4 + 2 * dir) * 64 + jg * 8);
  x.a = *(const uint4*)(b + (5 + 2 * dir) * 64 + jg * 8);
  x.v = *(const uint4*)(b + 2 * 64 + i * 8);
  if (need_r) x.r = *(const uint4*)(b + 0 * 64 + jg * 8);
}

DEVI void phase7(const Params& p) {
  const int lane = threadIdx.x & 63, warp = threadIdx.x >> 6, i = lane >> 3, jg = lane & 7;
  const bf16_t* SV = (const bf16_t*)(p.ws + R_SV);
  float* Pc = (float*)p.out;
  float* Bc = (float*)((unsigned char*)p.out + OUT_BC);
  for (int it = blockIdx.x * 4 + warp; it < (NCH - 1) * 16; it += gridDim.x * 4) {
    const int chunk = it >> 4, pair = it & 15, dir = pair >> 3, head = pair & 7;
    f32x2 S[8][4], P[8][4], ka[4];
#pragma unroll
    for (int a = 0; a < 8; ++a)
#pragma unroll
      for (int c = 0; c < 4; ++c) {
        S[a][c] = f32x2{0.f, 0.f};
        P[a][c] = f32x2{(i * 8 + a == jg * 8 + 2 * c) ? 1.f : 0.f, (i * 8 + a == jg * 8 + 2 * c + 1) ? 1.f : 0.f};
      }
#pragma unroll
    for (int c = 0; c < 4; ++c) ka[c] = f32x2{p.in[I_RKA][head * 64 + jg * 8 + 2 * c], p.in[I_RKA][head * 64 + jg * 8 + 2 * c + 1]};
    RwVec nx;
    rw_load(nx, SV, rw_row(chunk * LCH, dir), head, dir, i, jg, false);
#pragma unroll 1
    for (int t = 0; t < LCH; ++t) {
      RwVec cu = nx;
      if (t + 1 < LCH) rw_load(nx, SV, rw_row(chunk * LCH + t + 1, dir), head, dir, i, jg, false);
      f32x2 kv[4], kk[4], w[4], av[4], kka[4], keff[4]; float vv[8];
      unpack8p(cu.k, kv); unpack8p(cu.kk, kk); unpack8p(cu.w, w); unpack8p(cu.a, av); unpack8(cu.v, vv);
#pragma unroll
      for (int c = 0; c < 4; ++c) {
        w[c] = f32x2{__builtin_amdgcn_exp2f(-w[c][0]), __builtin_amdgcn_exp2f(-w[c][1])};
        kka[c] = -kk[c] * av[c];
        keff[c] = kv[c] * (bc2(1.f) + (av[c] - bc2(1.f)) * ka[c]);
      }
#pragma unroll
      for (int a = 0; a < 8; ++a) {
        f32x2 sa = S[a][0] * kk[0], qa = P[a][0] * kk[0];
#pragma unroll
        for (int c = 1; c < 4; ++c) { sa += S[a][c] * kk[c]; qa += P[a][c] * kk[c]; }
        float s1 = allred8(sa[0] + sa[1]), q1 = allred8(qa[0] + qa[1]);
        const f32x2 s2 = bc2(s1), q2 = bc2(q1), v2 = bc2(vv[a]);
#pragma unroll
        for (int c = 0; c < 4; ++c) {
          S[a][c] = S[a][c] * w[c] + s2 * kka[c] + v2 * keff[c];
          P[a][c] = P[a][c] * w[c] + q2 * kka[c];
        }
      }
    }
    float* po = Pc + ((size_t)chunk * 16 + pair) * 4096;
    float* bo = Bc + ((size_t)chunk * 16 + pair) * 4096;
#pragma unroll
    for (int a = 0; a < 8; ++a) {
      *(float4*)(po + (i * 8 + a) * 64 + jg * 8) = make_float4(P[a][0][0], P[a][0][1], P[a][1][0], P[a][1][1]);
      *(float4*)(po + (i * 8 + a) * 64 + jg * 8 + 4) = make_float4(P[a][2][0], P[a][2][1], P[a][3][0], P[a][3][1]);
      *(float4*)(bo + (i * 8 + a) * 64 + jg * 8) = make_float4(S[a][0][0], S[a][0][1], S[a][1][0], S[a][1][1]);
      *(float4*)(bo + (i * 8 + a) * 64 + jg * 8 + 4) = make_float4(S[a][2][0], S[a][2][1], S[a][3][0], S[a][3][1]);
    }
  }
}

template <bool DRY> DEVI void phase8(const Params& p, unsigned char* smem) {
  const bool wr = !DRY || (p.in[I_FG][0] == 1234.5f);
  float(*Sb)[16][68] = (float(*)[16][68])smem;
  const int tid = threadIdx.x, lane = tid & 63, warp = tid >> 6, q = lane >> 4, c16 = lane & 15;
  const float* Pc = (const float*)p.out;
  float* Bc = (float*)((unsigned char*)p.out + OUT_BC);
  constexpr int NS = NCH - 1;
  const size_t CS = (size_t)16 * 4096;
  for (int it = blockIdx.x; it < 64; it += gridDim.x) {
    const int pair = it >> 2, rg = it & 3;
    const float* Pp = Pc + (size_t)pair * 4096 + q * 64 + warp * 16 + c16;
    float* Bp = Bc + (size_t)pair * 4096 + (size_t)(rg * 16 + q * 4) * 64 + warp * 16 + c16;
    __syncthreads();
    {
      const int row = tid >> 4, c4 = (tid & 15) * 4;
      float4 v = *(const float4*)(Bc + (size_t)pair * 4096 + (size_t)(rg * 16 + row) * 64 + c4);
      Sb[0][row][c4] = v.x; Sb[0][row][c4 + 1] = v.y; Sb[0][row][c4 + 2] = v.z; Sb[0][row][c4 + 3] = v.w;
    }
    float pa[16], pb[16]; f32x4 ba, bb;
#pragma unroll
    for (int s2 = 0; s2 < 16; ++s2) { pa[s2] = Pp[CS + s2 * 256]; pb[s2] = Pp[2 * CS + s2 * 256]; }
#pragma unroll
    for (int r = 0; r < 4; ++r) { ba[r] = Bp[CS + r * 64]; bb[r] = Bp[2 * CS + r * 64]; }
    __syncthreads();
#define P8_STEP(c, pp, bv)                                                                                  \
    {                                                                                                        \
      const int rb = ((c) - 1) & 1;                                                                          \
      f32x4 acc0 = bv, acc1 = f32x4{0.f, 0.f, 0.f, 0.f};                                                     \
      _Pragma("unroll") for (int s2 = 0; s2 < 16; s2 += 2) {                                                 \
        acc0 = __builtin_amdgcn_mfma_f32_16x16x4f32(Sb[rb][c16][4 * s2 + q], pp[s2], acc0, 0, 0, 0);         \
        acc1 = __builtin_amdgcn_mfma_f32_16x16x4f32(Sb[rb][c16][4 * s2 + 4 + q], pp[s2 + 1], acc1, 0, 0, 0); \
      }                                                                                                      \
      acc0 += acc1;                                                                                          \
      if ((c) + 2 < NS) {                                                                                    \
        _Pragma("unroll") for (int s2 = 0; s2 < 16; ++s2) pp[s2] = Pp[(size_t)((c) + 2) * CS + s2 * 256];    \
        _Pragma("unroll") for (int r = 0; r < 4; ++r) bv[r] = Bp[(size_t)((c) + 2) * CS + r * 64];           \
      }                                                                                                      \
      _Pragma("unroll") for (int r = 0; r < 4; ++r) {                                                        \
        Sb[rb ^ 1][q * 4 + r][warp * 16 + c16] = acc0[r];                                                    \
        if (wr) Bp[(size_t)(c) * CS + r * 64] = acc0[r];                                                     \
      }                                                                                                      \
      __syncthreads();                                                                                       \
    }
    for (int c = 1; c < NS; c += 2) {
      P8_STEP(c, pa, ba)
      if (c + 1 < NS) P8_STEP(c + 1, pb, bb)
    }
#undef P8_STEP
  }
}

DEVI void phase9(const Params& p) {
  const int lane = threadIdx.x & 63, warp = threadIdx.x >> 6, i = lane >> 3, jg = lane & 7;
  const bf16_t* SV = (const bf16_t*)(p.ws + R_SV);
  const float* Bc = (const float*)((unsigned char*)p.out + OUT_BC);
  bf16_t* odir = (bf16_t*)p.out;
  for (int it = blockIdx.x * 4 + warp; it < NCH * 16; it += gridDim.x * 4) {
    const int chunk = it >> 4, pair = it & 15, dir = pair >> 3, head = pair & 7;
    f32x2 S[8][4], ka[4];
    if (chunk == 0) {
#pragma unroll
      for (int a = 0; a < 8; ++a)
#pragma unroll
        for (int c = 0; c < 4; ++c) S[a][c] = f32x2{0.f, 0.f};
    } else {
      const float* bs = Bc + ((size_t)(chunk - 1) * 16 + pair) * 4096;
#pragma unroll
      for (int a = 0; a < 8; ++a) {
        float4 x0 = *(const float4*)(bs + (i * 8 + a) * 64 + jg * 8), x1 = *(const float4*)(bs + (i * 8 + a) * 64 + jg * 8 + 4);
        S[a][0] = f32x2{x0.x, x0.y}; S[a][1] = f32x2{x0.z, x0.w}; S[a][2] = f32x2{x1.x, x1.y}; S[a][3] = f32x2{x1.z, x1.w};
      }
    }
#pragma unroll
    for (int c = 0; c < 4; ++c) ka[c] = f32x2{p.in[I_RKA][head * 64 + jg * 8 + 2 * c], p.in[I_RKA][head * 64 + jg * 8 + 2 * c + 1]};
    RwVec nx;
    rw_load(nx, SV, rw_row(chunk * LCH, dir), head, dir, i, jg, true);
#pragma unroll 2
    for (int t = 0; t < LCH; ++t) {
      RwVec cu = nx;
      const int row = rw_row(chunk * LCH + t, dir);
      if (t + 1 < LCH) rw_load(nx, SV, rw_row(chunk * LCH + t + 1, dir), head, dir, i, jg, true);
      f32x2 kv[4], kk[4], w[4], av[4], rr[4], kka[4], keff[4]; float vv[8];
      unpack8p(cu.k, kv); unpack8p(cu.kk, kk); unpack8p(cu.w, w); unpack8p(cu.a, av); unpack8p(cu.r, rr); unpack8(cu.v, vv);
#pragma unroll
      for (int c = 0; c < 4; ++c) {
        w[c] = f32x2{__builtin_amdgcn_exp2f(-w[c][0]), __builtin_amdgcn_exp2f(-w[c][1])};
        kka[c] = -kk[c] * av[c];
        keff[c] = kv[c] * (bc2(1.f) + (av[c] - bc2(1.f)) * ka[c]);
      }
      float ov = 0.f;
#pragma unroll
      for (int a = 0; a < 8; ++a) {
        f32x2 sa = S[a][0] * kk[0];
#pragma unroll
        for (int c = 1; c < 4; ++c) sa += S[a][c] * kk[c];
        const float s1 = allred8(sa[0] + sa[1]);
        const f32x2 s2 = bc2(s1), v2 = bc2(vv[a]);
        f32x2 oa = f32x2{0.f, 0.f};
#pragma unroll
        for (int c = 0; c < 4; ++c) {
          S[a][c] = S[a][c] * w[c] + s2 * kka[c] + v2 * keff[c];
          oa += S[a][c] * rr[c];
        }
        const float o = allred8(oa[0] + oa[1]);
        if (jg == a) ov = o;
      }
      if (row >= T_CTX) odir[((size_t)dir * T_LAT + (row - T_CTX)) * 512 + head * 64 + i * 8 + jg] = f2bf(ov);
    }
  }
}

DEVI void phase10(const Params& p) {
  const int lane = threadIdx.x & 63, warp = threadIdx.x >> 6;
  const bf16_t* odir = (const bf16_t*)p.out;
  const bf16_t* SV = (const bf16_t*)(p.ws + R_SV);
  const float* bonus = (const float*)(p.ws + O_BONUS);
  bf16_t* ya = (bf16_t*)(p.ws + O_PO);
  const int head = lane >> 3, c8 = (lane & 7) * 8, C0 = lane * 8;
#pragma unroll 2
  for (int t = blockIdx.x * 4 + warp; t < T_LAT; t += gridDim.x * 4) {
    const int row = t + T_CTX;
    const bf16_t* b = SV + ((size_t)row * 8 + head) * SVH;
    float v[8], g[8], y[8];
    unpack8(*(const uint4*)(b + 2 * 64 + c8), v);
    unpack8(*(const uint4*)(b + 8 * 64 + c8), g);
    float bs = bonus[(size_t)row * 16 + head] + bonus[(size_t)row * 16 + 8 + head];
#pragma unroll
    for (int e = 0; e < 8; ++e) y[e] = bs * v[e];
#pragma unroll
    for (int dir = 0; dir < 2; ++dir) {
      float o[8];
      unpack8(*(const uint4*)(odir + ((size_t)dir * T_LAT + t) * 512 + C0), o);
      float s = 0.f;
#pragma unroll
      for (int e = 0; e < 8; ++e) s += o[e];
      s = allred8(s);
      float mu = s * (1.f / 64.f);
      float q = 0.f;
#pragma unroll
      for (int e = 0; e < 8; ++e) { o[e] -= mu; q += o[e] * o[e]; }
      q = allred8(q);
      float rsd = rsqrtf(q * (1.f / 64.f) + 64e-5f);
#pragma unroll
      for (int e = 0; e < 8; ++e) y[e] += o[e] * rsd * p.in[I_RLNW][C0 + e] + p.in[I_RLNB][C0 + e];
    }
#pragma unroll
    for (int e = 0; e < 8; ++e) y[e] *= g[e];
    *(uint4*)(ya + (size_t)t * 512 + C0) = pack8(y);
  }
}

DEVI void phase11(const Params& p, unsigned char* smem, const XcdMap& xm) {
  const int lane = threadIdx.x & 63, warp = threadIdx.x >> 6, wm = warp >> 1, wn = warp & 1;
  const bf16_t* ya = (const bf16_t*)(p.ws + O_PO);
  const bf16_t* yb = (const bf16_t*)(p.ws + R_YA);
  const bf16_t* pg = (const bf16_t*)(p.ws + O_PG);
  bf16_t* mg = (bf16_t*)(p.ws + R_MERGED);
  for_tiles_xcd(xm, 128, 8, 8, 8, [&](int mt, int nt) {
    f32x4 acc[4][4];
    zero_acc(acc);
    gemm_core(ya + (size_t)mt * 128 * 512, 512, (const bf16_t*)(p.ws + O_WBA) + (size_t)nt * 128 * 512, 512, 512, acc, smem);
#pragma unroll
    for (int i = 0; i < 4; ++i) {
      int row = mt * 128 + wm * 64 + i * 16 + (lane & 15);
#pragma unroll
      for (int j = 0; j < 4; ++j) {
        int n = nt * 128 + wn * 64 + j * 16 + (lane >> 4) * 4;
        uint2 s = *(const uint2*)(pg + (size_t)row * 2048 + n);
        *(uint2*)(mg + (size_t)row * 1024 + n) = make_uint2(pack2(acc[i][j][0] * bflo(s.x), acc[i][j][1] * bfhi(s.x)), pack2(acc[i][j][2] * bflo(s.y), acc[i][j][3] * bfhi(s.y)));
      }
    }
    zero_acc(acc);
    gemm_core(yb + (size_t)mt * 128 * 512, 512, (const bf16_t*)(p.ws + O_WBB) + (size_t)nt * 128 * 512, 512, 512, acc, smem);
#pragma unroll
    for (int i = 0; i < 4; ++i) {
      int row = mt * 128 + wm * 64 + i * 16 + (lane & 15);
#pragma unroll
      for (int j = 0; j < 4; ++j) {
        int n = nt * 128 + wn * 64 + j * 16 + (lane >> 4) * 4;
        uint2 s = *(const uint2*)(pg + (size_t)row * 2048 + 1024 + n);
        uint2 m0 = *(const uint2*)(mg + (size_t)row * 1024 + n);
        float v0 = bflo(m0.x) + acc[i][j][0] * bflo(s.x), v1 = bfhi(m0.x) + acc[i][j][1] * bfhi(s.x);
        float v2 = bflo(m0.y) + acc[i][j][2] * bflo(s.y), v3 = bfhi(m0.y) + acc[i][j][3] * bfhi(s.y);
        *(uint2*)(mg + (size_t)row * 1024 + n) = make_uint2(pack2(v0, v1), pack2(v2, v3));
      }
    }
  });
}

DEVI void phase12(const Params& p, unsigned char* smem, const XcdMap& xm) {
  float* gt = (float*)(smem + 45056);
  const int tid = threadIdx.x, lane = tid & 63, warp = tid >> 6, wm = warp >> 1, wn = warp & 1;
  for (int i = tid; i < 1024; i += 256) gt[i] = mod_val(p, 0, 2048 + i);
  __syncthreads();
  const bf16_t* mg = (const bf16_t*)(p.ws + R_MERGED);
  const float* x = p.in[I_X];
  float* x1 = p.out;
  for_tiles_xcd(xm, 128, 8, 8, 8, [&](int mt, int nt) {
    f32x4 acc[4][4];
    zero_acc(acc);
    gemm_core(mg + (size_t)mt * 128 * 1024, 1024, (const bf16_t*)(p.ws + O_WOUT) + (size_t)nt * 128 * 1024, 1024, 1024, acc, smem);
#pragma unroll
    for (int i = 0; i < 4; ++i) {
      int row = mt * 128 + wm * 64 + i * 16 + (lane & 15);
#pragma unroll
      for (int j = 0; j < 4; ++j) {
        int n = nt * 128 + wn * 64 + j * 16 + (lane >> 4) * 4;
        float4 xv = *(const float4*)(x + (size_t)row * 1024 + n);
        xv.x += gt[n] * acc[i][j][0]; xv.y += gt[n + 1] * acc[i][j][1]; xv.z += gt[n + 2] * acc[i][j][2]; xv.w += gt[n + 3] * acc[i][j][3];
        *(float4*)(x1 + (size_t)row * 1024 + n) = xv;
      }
    }
  });
}

DEVI void phase13(const Params& p, unsigned char* smem) {
  float* smod = (float*)smem;
  const int tid = threadIdx.x, lane = tid & 63, warp = tid >> 6;
  for (int i = tid; i < 2048; i += 256) smod[i] = mod_val(p, 0, 3072 + i);
  __syncthreads();
  const float* x1 = p.out;
  bf16_t* h2 = (bf16_t*)(p.ws + R_H2);
  for (int rp = blockIdx.x * 4 + warp; rp < T_LAT / 2; rp += gridDim.x * 4) {
    float h[2][16]; float ss[2] = {0.f, 0.f};
#pragma unroll
    for (int u = 0; u < 2; ++u)
#pragma unroll
      for (int i = 0; i < 4; ++i) {
        float4 v = *(const float4*)(x1 + (size_t)(rp * 2 + u) * 1024 + i * 256 + lane * 4);
        h[u][4 * i] = v.x; h[u][4 * i + 1] = v.y; h[u][4 * i + 2] = v.z; h[u][4 * i + 3] = v.w;
        ss[u] += v.x * v.x + v.y * v.y + v.z * v.z + v.w * v.w;
      }
#pragma unroll
    for (int u = 0; u < 2; ++u) {
      const int row = rp * 2 + u;
      const float rstd = rsqrtf(wave_sum_u(ss[u]) * (1.f / 1024.f) + 1e-6f);
#pragma unroll
      for (int i = 0; i < 4; ++i) {
        {
          const int k0 = i * 256 + lane * 4;
          const float4 gk = *(const float4*)(p.in[I_N2G] + k0);
          const f32x4 s4 = *(const f32x4*)(smod + 1024 + k0), h4 = *(const f32x4*)(smod + k0);
          h[u][4 * i] = h[u][4 * i] * rstd * gk.x * (1.f + s4[0]) + h4[0];
          h[u][4 * i + 1] = h[u][4 * i + 1] * rstd * gk.y * (1.f + s4[1]) + h4[1];
          h[u][4 * i + 2] = h[u][4 * i + 2] * rstd * gk.z * (1.f + s4[2]) + h4[2];
          h[u][4 * i + 3] = h[u][4 * i + 3] * rstd * gk.w * (1.f + s4[3]) + h4[3];
        }
        *(uint2*)(h2 + (size_t)row * 1024 + i * 256 + lane * 4) = make_uint2(pack2(h[u][4 * i], h[u][4 * i + 1]), pack2(h[u][4 * i + 2], h[u][4 * i + 3]));
      }
    }
  }
}

DEVI void phase14(const Params& p, unsigned char* smem, const XcdMap& xm) {
  bf16_t(*Qt)[136] = (bf16_t(*)[136])smem;
  float* Sc = (float*)smem;
  const int tid = threadIdx.x, lane = tid & 63, warp = tid >> 6, wm = warp >> 1, wn = warp & 1;
  const bf16_t* h2 = (const bf16_t*)(p.ws + R_H2);
  const bf16_t* keys = (const bf16_t*)(p.ws + O_KEYS);
  float* tops = (float*)(p.ws + R_TOPS);
  int* topi = (int*)(p.ws + R_TOPI);
  for_tiles_xcd(xm, 128, 16, 8, 8, [&](int mt, int hp) {
    f32x4 acc[4][4];
    zero_acc(acc);
    gemm_core(h2 + (size_t)mt * 128 * 1024, 1024, (const bf16_t*)(p.ws + O_WQ) + (size_t)hp * 128 * 1024, 1024, 1024, acc, smem);
#pragma unroll
    for (int i = 0; i < 4; ++i)
#pragma unroll
      for (int j = 0; j < 4; ++j)
        *(uint2*)&Qt[wm * 64 + i * 16 + (lane & 15)][wn * 64 + j * 16 + (lane >> 4) * 4] =
            make_uint2(pack2(acc[i][j][0], acc[i][j][1]), pack2(acc[i][j][2], acc[i][j][3]));
    __syncthreads();
    zero_acc(acc);
#pragma unroll
    for (int ks = 0; ks < 4; ++ks) {
      bf16x8 qf[4], kf[4];
#pragma unroll
      for (int i = 0; i < 4; ++i) qf[i] = *(const bf16x8*)&Qt[wm * 64 + i * 16 + (lane & 15)][ks * 32 + (lane >> 4) * 8];
#pragma unroll
      for (int j = 0; j < 4; ++j) kf[j] = *(const bf16x8*)(keys + ((size_t)hp * 128 + wn * 64 + j * 16 + (lane & 15)) * 128 + ks * 32 + (lane >> 4) * 8);
#pragma unroll
      for (int i = 0; i < 4; ++i)
#pragma unroll
        for (int j = 0; j < 4; ++j) acc[i][j] = __builtin_amdgcn_mfma_f32_16x16x32_bf16(kf[j], qf[i], acc[i][j], 0, 0, 0);
    }
    __syncthreads();
#pragma unroll
    for (int i = 0; i < 4; ++i)
#pragma unroll
      for (int j = 0; j < 4; ++j) {
        {
          const int c0 = j * 16 + (lane >> 4) * 4;
          u32x4 kq;
#pragma unroll
          for (int r = 0; r < 4; ++r) {
            unsigned u = __float_as_uint(acc[i][j][r]);
            u = (u & 0x80000000u) ? ~u : (u | 0x80000000u);
            kq[r] = (u & ~63u) | (unsigned)(63 - (c0 + r));
          }
          *(u32x4*)(Sc + (wm * 64 + i * 16 + (lane & 15)) * 132 + wn * 64 + c0) = kq;
        }
      }
    __syncthreads();
    {
      const int row = tid & 127, half = tid >> 7;
      float* hp_ = Sc + row * 132 + half * 64;
      float bv[16]; int bi[16];
      unsigned* hk = (unsigned*)hp_;
#pragma unroll
      for (int r = 0; r < 16; ++r) {
        unsigned best = 0u;
#pragma unroll 16
        for (int k = 0; k < 64; k += 4) {
          const u32x4 v4 = *(const u32x4*)(hk + k);
          const unsigned m01 = v4[0] > v4[1] ? v4[0] : v4[1], m23 = v4[2] > v4[3] ? v4[2] : v4[3];
          const unsigned m = m01 > m23 ? m01 : m23;
          best = best > m ? best : m;
        }
        const int b2 = 63 - (int)(best & 63u);
        unsigned u = best & ~63u;
        u = (u & 0x80000000u) ? (u & 0x7fffffffu) : ~u;
        bv[r] = __uint_as_float(u); bi[r] = b2 + half * 64; hk[b2] = 0u;
      }
#pragma unroll
      for (int r = 0; r < 16; ++r) { hp_[r] = bv[r]; hp_[16 + r] = __int_as_float(bi[r]); }
    }
    __syncthreads();
    if (tid < 128) {
      const float* la = Sc + tid * 132; const float* lb = la + 64;
      size_t ob = ((size_t)(mt * 128 + tid) * 16 + hp) * 16;
      int ia = 0, ib = 0;
      for (int r = 0; r < 16; ++r) {
        float va = la[ia], vb = lb[ib];
        bool ta = va >= vb;
        tops[ob + r] = ta ? va : vb;
        topi[ob + r] = __float_as_int(ta ? la[16 + ia] : lb[16 + ib]);
        ia += ta ? 1 : 0; ib += ta ? 0 : 1;
      }
    }
    __syncthreads();
  });
}

template <bool DRY> DEVI void phase15(const Params& p, unsigned char* smem) {
  const bool wr = !DRY || (p.in[I_FG][0] == 1234.5f);
  float* gt = (float*)smem;
  const int tid = threadIdx.x, lane = tid & 63, warp = tid >> 6;
  for (int i = tid; i < 1024; i += 256) gt[i] = mod_val(p, 0, 5120 + i);
  __syncthreads();
  const bf16_t* __restrict__ h2 = (const bf16_t*)(p.ws + R_H2);
  const float* __restrict__ tops = (const float*)(p.ws + R_TOPS);
  const int* __restrict__ topi = (const int*)(p.ws + R_TOPI);
  const unsigned char* __restrict__ uf8 = p.ws + R_UBF;
  const unsigned char* __restrict__ vf8 = p.ws + R_VBF;
  float* xo = p.out;
  int ca, cb;
  {
    int l = lane;
    if (l < 16) { ca = 0; cb = l; } else if (l < 24) { ca = 1; cb = l - 16; } else if (l < 29) { ca = 2; cb = l - 24; }
    else if (l < 33) { ca = 3; cb = l - 29; } else if (l < 36) { ca = 4; cb = l - 33; } else if (l < 38) { ca = 5; cb = l - 36; }
    else if (l < 40) { ca = 6; cb = l - 38; } else if (l < 42) { ca = 7; cb = l - 40; } else if (l < 50) { ca = l - 34; cb = 0; }
    else { ca = 0; cb = 0; }
  }
  const int flat = ca * 16 + cb;
  for (int t = blockIdx.x * 4 + warp; t < T_LAT; t += gridDim.x * 4) {
    float hv[16], out[16];
    {
      const u32x4 hp0 = *(const u32x4*)(h2 + (size_t)t * 1024 + lane * 16);
      const u32x4 hp1 = *(const u32x4*)(h2 + (size_t)t * 1024 + lane * 16 + 8);
#pragma unroll
      for (int e = 0; e < 4; ++e) { hv[2 * e] = bflo(hp0[e]); hv[2 * e + 1] = bfhi(hp0[e]); hv[8 + 2 * e] = bflo(hp1[e]); hv[8 + 2 * e + 1] = bfhi(hp1[e]); }
    }
#pragma unroll
    for (int e = 0; e < 16; ++e) out[e] = 0.f;
#pragma unroll 1
    for (int hd = 0; hd < 8; ++hd) {
      const size_t b1 = ((size_t)t * 16 + hd * 2) * 16, b2 = b1 + 16;
      float val = lane < 50 ? tops[b1 + ca] + tops[b2 + cb] : -INFINITY;
      int idx = topi[b1 + ca] * 128 + topi[b2 + cb];
      unsigned key = __float_as_uint(val);
      key = (key & 0x80000000u) ? ~key : (key | 0x80000000u);
      key = lane < 50 ? ((key & ~63u) | (unsigned)(63 - lane)) : 0u;
      int cnt = 0;
#pragma unroll
      for (int i = 0; i < 50; ++i) cnt += ((unsigned)__builtin_amdgcn_readlane((int)key, i) > key) ? 1 : 0;
      bool sel = lane < 50 && cnt < 16;
      float vmax = rlf(val, 0);
      float ex = sel ? __expf(val - vmax) : 0.f;
      float gsum = wave_sum_u(ex);
      float g = ex / gsum;
      unsigned long long m1 = __ballot(sel);
      int es[16];
      float gq = 0.f;
#pragma unroll
      for (int q = 0; q < 16; ++q) {
        int src = __ffsll((long long)m1) - 1; m1 &= m1 - 1;
        es[q] = __builtin_amdgcn_readlane(idx, src);
        float gg = rlf(g, src);
        if (lane == q) gq = gg;
      }
      float dm = 0.f;
      {
        u32x4 ub[16];
#pragma unroll
        for (int q = 0; q < 16; ++q) ub[q] = *(const u32x4*)(uf8 + (size_t)es[q] * 1024 + lane * 16);
#pragma unroll
        for (int q = 0; q < 16; ++q) {
          float f[16]; unpack_fp8x16(ub[q], f);
          float d0 = 0.f, d1 = 0.f;
#pragma unroll
          for (int e = 0; e < 8; ++e) { d0 += f[2 * e] * hv[2 * e]; d1 += f[2 * e + 1] * hv[2 * e + 1]; }
          float d = d0 + d1;
          d += dppf<0xB1>(d); d += dppf<0x4E>(d); d += dppf<0x141>(d); d += dppf<0x140>(d);
          if ((lane & 15) == q) dm = d;
        }
      }
      dm += __shfl_xor(dm, 16); dm += __shfl_xor(dm, 32);
      dm *= (1.f / 64.f);
      float coef = gq * 0.5f * dm * (1.f + erff(dm * 0.70710678118f)) * 0.25f;
      {
        u32x4 vb[16];
#pragma unroll
        for (int q = 0; q < 16; ++q) vb[q] = *(const u32x4*)(vf8 + (size_t)es[q] * 1024 + lane * 16);
#pragma unroll
        for (int q = 0; q < 16; ++q) {
          float cf = rlf(coef, q);
          float f[16]; unpack_fp8x16(vb[q], f);
#pragma unroll
          for (int e = 0; e < 16; ++e) out[e] += cf * f[e];
        }
      }
    }
    float xs[16]; float ss = 0.f;
#pragma unroll
    for (int i = 0; i < 4; ++i) {
      int k = lane * 16 + i * 4;
      float4 v = *(const float4*)(xo + (size_t)t * 1024 + k);
      xs[4 * i] = v.x + gt[k] * out[4 * i]; xs[4 * i + 1] = v.y + gt[k + 1] * out[4 * i + 1];
      xs[4 * i + 2] = v.z + gt[k + 2] * out[4 * i + 2]; xs[4 * i + 3] = v.w + gt[k + 3] * out[4 * i + 3];
      ss += xs[4 * i] * xs[4 * i] + xs[4 * i + 1] * xs[4 * i + 1] + xs[4 * i + 2] * xs[4 * i + 2] + xs[4 * i + 3] * xs[4 * i + 3];
    }
    ss = wave_sum_u(ss);
    float rstd = rsqrtf(ss * (1.f / 1024.f) + 1e-6f);
#pragma unroll
    for (int i = 0; i < 4; ++i) {
      int k = lane * 16 + i * 4;
      float4 g4 = *(const float4*)(p.in[I_FG] + k);
      if (wr) *(float4*)(xo + (size_t)t * 1024 + k) = make_float4(xs[4 * i] * rstd * g4.x, xs[4 * i + 1] * rstd * g4.y, xs[4 * i + 2] * rstd * g4.z, xs[4 * i + 3] * rstd * g4.w);
    }
  }
}

#define XB_TMO      128
#define XB_XCNT(j)  (256  + 64 * (j))
#define XB_XSUB(j)  (1280 + 64 * (j))
#define XB_XGEN(j)  (2304 + 64 * (j))
#define XB_TOP      3328
#define XB_TOPGEN   3392
#define XCD_BAR_WORDS 3456
#define XB_SPIN_CAP (1u << 22)
#define LAS __attribute__((address_space(3)))
DEVI unsigned xb_ld(unsigned* p) { return __hip_atomic_load(p, __ATOMIC_RELAXED, __HIP_MEMORY_SCOPE_AGENT); }
DEVI unsigned xb_add(unsigned* p, unsigned v) { return __hip_atomic_fetch_add(p, v, __ATOMIC_RELAXED, __HIP_MEMORY_SCOPE_AGENT); }
DEVI unsigned xb_xcc_id() { return (unsigned)__builtin_amdgcn_s_getreg((3 << 11) | 20) & 0xFu; }
#define XB_SPIN(cond, bar) do { unsigned _sp = 0; while (cond) { __builtin_amdgcn_s_sleep(1); \
    if ((++_sp & 255u) == 0u) { if (xb_ld(&(bar)[XB_TMO])) break; if (_sp > XB_SPIN_CAP) { atomicAdd(&(bar)[XB_TMO], 1u); break; } } } } while (0)
struct XcdBarrier { unsigned* bar; unsigned x; volatile LAS unsigned* st; };
DEVI XcdBarrier xcd_barrier_post(unsigned* bar, volatile LAS unsigned* st) {
  XcdBarrier b; b.bar = bar; b.x = xb_xcc_id(); b.st = st;
  if (threadIdx.x == 0) st[2] = xb_add(&bar[XB_XCNT(b.x)], 1u);
  return b;
}
DEVI void xcd_barrier_complete(unsigned* bar, unsigned x, unsigned& nloc, unsigned& nx, unsigned& vidx) {
  const unsigned G = gridDim.x * gridDim.y * gridDim.z;
  unsigned sum, cnt, mine, below, sp = 0u;
  for (;;) {
    sum = 0u; cnt = 0u; mine = 0u; below = 0u;
#pragma unroll
    for (unsigned j = 0; j < 16; ++j) { const unsigned c = xb_ld(&bar[XB_XCNT(j)]); sum += c; cnt += (c > 0u) ? 1u : 0u; mine = (j == x) ? c : mine; below += (c > 0u && j < x) ? 1u : 0u; }
    if (sum == G) break;
    __builtin_amdgcn_s_sleep(1);
    if ((++sp & 255u) == 0u) { if (xb_ld(&bar[XB_TMO])) break; if (sp > XB_SPIN_CAP) { atomicAdd(&bar[XB_TMO], 1u); break; } }
  }
  nloc = mine > 0u ? mine : 1u; nx = cnt > 0u ? cnt : 1u; vidx = below;
}
DEVI void xcd_barrier(const XcdBarrier& b) {
  asm volatile("s_waitcnt vmcnt(0)" ::: "memory");
  __syncthreads();
  if (threadIdx.x == 0) {
    unsigned* bar = b.bar;
    __builtin_amdgcn_s_waitcnt(0);
    unsigned nloc = b.st[0], nx = b.st[1];
    if (nloc == 0u) { unsigned vidx; xcd_barrier_complete(bar, b.x, nloc, nx, vidx); b.st[0] = nloc; b.st[1] = nx; b.st[3] = vidx; }
    const unsigned old = xb_add(&bar[XB_XSUB(b.x)], 1u);
    const unsigned gen = old / nloc;
    if (old + 1u == (gen + 1u) * nloc) {
      __builtin_amdgcn_fence(__ATOMIC_RELEASE, "agent");
      asm volatile("s_waitcnt vmcnt(0)" ::: "memory");
      const unsigned og = xb_add(&bar[XB_TOP], 1u);
      const unsigned tg = og / nx;
      if (og + 1u == (tg + 1u) * nx) xb_add(&bar[XB_TOPGEN], 1u);
      else XB_SPIN(xb_ld(&bar[XB_TOPGEN]) == tg, bar);
      __builtin_amdgcn_fence(__ATOMIC_ACQUIRE, "agent");
      xb_add(&bar[XB_XGEN(b.x)], 1u);
      asm volatile("s_waitcnt vmcnt(0)" ::: "memory");
    } else {
      XB_SPIN(xb_ld(&bar[XB_XGEN(b.x)]) == gen, bar);
      __builtin_amdgcn_fence(__ATOMIC_ACQUIRE, "agent");
      asm volatile("s_waitcnt vmcnt(0)" ::: "memory");
    }
  }
  __syncthreads();
}

constexpr int NPHASE = 16;
DEVI XcdMap get_xm(int coop, const uint4& w) {
  XcdMap m;
  if (coop) { m.v = (int)w.w; m.nx = (int)w.y; m.slot = (int)w.z; m.slots = (int)w.x; }
  else { m.v = blockIdx.x & 7; m.nx = 8; m.slot = blockIdx.x >> 3; m.slots = gridDim.x >> 3; if (m.slots < 1) { m.slots = 1; } }
  return m;
}
__global__ void __launch_bounds__(256, 2) mk(Params p, int ph0, int ph1, int coop) {
  __shared__ __attribute__((aligned(16))) unsigned char smem[SMEM_BYTES];
  __shared__ uint4 xb_words;
  if (threadIdx.x == 0) xb_words = make_uint4(0u, 0u, 0u, 0u);
  __syncthreads();
  XcdBarrier xb;
  if (coop) xb = xcd_barrier_post((unsigned*)(p.ws + O_BAR), (volatile LAS unsigned*)&xb_words);
#ifdef XCC_PROBE
  if (coop && xb_xcc_id() != (blockIdx.x & 7u)) { unsigned long long t0 = wall_clock64(); while (wall_clock64() - t0 < 100000ull) __builtin_amdgcn_s_sleep(8); }
#endif
  if (ph0 < 0) cg::this_grid().sync();
#ifdef PROBE_A
#define STAMP(n) if (blockIdx.x == 0 && threadIdx.x == 0) ((unsigned long long*)(p.ws + O_STAMP))[n] = wall_clock64();
#else
#define STAMP(n)
#endif
#define RUN_PHASE(n, call)                                   \
  if (ph0 <= n && n < ph1) {                                 \
    STAMP(n)                                                 \
        if (DRY_PH == n) { if (n == 4) phase4<true>(p, smem); if (n == 5) phase5<true>(p, smem); if (n == 8) phase8<true>(p, smem); if (n == 15) phase15<true>(p, smem); } \
    if (ONLY < 0 || ONLY == n) { call; }                     \
    if (REPEAT_PH == n) { call; }                            \
    if (coop && n + 1 < ph1) xcd_barrier(xb);                \
  }
  RUN_PHASE(0, phase0(p, smem, 0, 96))
  RUN_PHASE(1, (phase1(p, smem), __syncthreads(), phase0(p, smem, 96, 1 << 30)))
  RUN_PHASE(2, phase2(p, smem, get_xm(coop, xb_words)))
  RUN_PHASE(3, phase3(p, smem))
  RUN_PHASE(4, (phase4<false>(p, smem), phase6(p, smem, 0, 32, gridDim.x > 290 ? 258 : 0, gridDim.x > 290 ? (int)gridDim.x - 258 : (int)gridDim.x)))
  RUN_PHASE(5, phase5<false>(p, smem))
  RUN_PHASE(6, phase6(p, smem, 32, 260 * 8, 0, (int)gridDim.x))
  RUN_PHASE(7, phase7(p))
  RUN_PHASE(8, phase8<false>(p, smem))
  RUN_PHASE(9, phase9(p))
  RUN_PHASE(10, phase10(p))
  RUN_PHASE(11, phase11(p, smem, get_xm(coop, xb_words)))
  RUN_PHASE(12, (phase12(p, smem, get_xm(coop, xb_words)), convert_fp8(p.in[I_PU], p.ws + R_UBF, (size_t)16384 * 64, 64.f)))
  RUN_PHASE(13, phase13(p, smem))
  RUN_PHASE(14, (phase14(p, smem, get_xm(coop, xb_words)), convert_fp8(p.in[I_PV], p.ws + R_VBF, (size_t)16384 * 64, 4.f)))
  RUN_PHASE(15, phase15<false>(p, smem))
#ifdef SYNC_EXTRA
  for (int i = 0; i < SYNC_EXTRA; ++i) xcd_barrier(xb);
#endif
#ifdef PROBE_A
  cg::this_grid().sync();
  STAMP(16)
  __syncthreads();
  if (blockIdx.x == 0) {
    const unsigned long long* st = (const unsigned long long*)(p.ws + O_STAMP);
    float ta = (float)(st[PROBE_A + 1] - st[PROBE_A]) * 0.01f, tb = (float)(st[PROBE_B + 1] - st[PROBE_B]) * 0.01f;
    for (int i = threadIdx.x; i < 1000000; i += 256) p.out[1 + i] = tb;
    if (threadIdx.x == 0) p.out[0] = 100.f * ta;
  }
#endif
}

extern "C" void kernel_launch(void* const* d_in, const int* in_sizes, int n_in, void* d_out, int out_size, void* d_ws,
                              size_t ws_size, hipStream_t stream) {
  static int grid_blocks = 0;
  if (!grid_blocks) {
    int dev = 0, cus = 0, per_cu = 0;
    hipGetDevice(&dev);
    hipDeviceGetAttribute(&cus, hipDeviceAttributeMultiprocessorCount, dev);
    hipOccupancyMaxActiveBlocksPerMultiprocessor(&per_cu, mk, 256, 0);
    if (per_cu < 1) per_cu = 1;
    if (per_cu > 2) per_cu = 2;
    grid_blocks = cus * per_cu;
  }
  if (ws_size < WS_NEED) { fprintf(stderr, "workspace too small: %zu < %zu\n", ws_size, (size_t)WS_NEED); return; }
  Params p{};
  for (int i = 0; i < 32; ++i) p.in[i] = (const float*)d_in[i];
  p.out = (float*)d_out;
  p.ws = (unsigned char*)d_ws;
#if MEGA
  (void)hipMemsetAsync((unsigned char*)d_ws + O_BAR, 0, XCD_BAR_WORDS * 4, stream);
  int ph0 = 0, ph1 = NPHASE, coop = 1;
  void* args[] = {&p, &ph0, &ph1, &coop};
  hipError_t e = hipLaunchCooperativeKernel((void*)mk, dim3(grid_blocks), dim3(256), args, 0, stream);
  if (e != hipSuccess) fprintf(stderr, "cooperative launch failed: %s (grid %d)\n", hipGetErrorString(e), grid_blocks);
#else
  for (int ph = 0; ph < NPHASE; ++ph) mk<<<grid_blocks, 256, 0, stream>>>(p, ph, ph + 1, 0);
#endif
}
```

```cpp
#include <hip/hip_runtime.h>
#include <hip/hip_cooperative_groups.h>
#include <cstdio>
#include <cstdint>
namespace cg = cooperative_groups;

#ifndef MEGA
#define MEGA 1
#endif
#ifndef ONLY
#define ONLY -1
#endif
#ifndef REPEAT_PH
#define REPEAT_PH -1
#endif
#ifndef DRY_PH
#define DRY_PH -1
#endif

typedef unsigned short bf16_t;
using bf16x8 = __attribute__((ext_vector_type(8))) short;
using f32x4 = __attribute__((ext_vector_type(4))) float;
using u32x4 = __attribute__((ext_vector_type(4))) unsigned;
#define DEVI __device__ __forceinline__

constexpr int T_CTX = 256, T_LAT = 16384, T_ALL = 16640;
constexpr int NIN = 5392, NP = 5376;
constexpr int NCH = 128, LCH = 130;
constexpr int SVH = 576;
constexpr int SMEM_BYTES = 71680;

enum { I_X = 0, I_C, I_CTX, I_CCTX, I_ADAW, I_ADAB, I_N1G, I_WIN, I_RCONV, I_RW0, I_RWUP, I_RA0, I_RAUP, I_RGUP,
       I_RKK, I_RKA, I_RRK, I_RLNW, I_RLNB, I_MCONV, I_MIB, I_MFB, I_MNG, I_WBA, I_WBB, I_WOUT, I_N2G, I_WQ,
       I_KEYS, I_PU, I_PV, I_FG };

struct Params { const float* in[32]; float* out; unsigned char* ws; };

constexpr size_t A256(size_t x) { return (x + 255) & ~(size_t)255; }
constexpr size_t O_MODP = 0;
constexpr size_t O_WBA = A256(O_MODP + (size_t)16 * 2 * 6144 * 4);
constexpr size_t O_WBB = A256(O_WBA + (size_t)1024 * 512 * 2);
constexpr size_t O_WOUT = A256(O_WBB + (size_t)1024 * 512 * 2);
constexpr size_t O_WQ = A256(O_WOUT + (size_t)1024 * 1024 * 2);
constexpr size_t O_KEYS = A256(O_WQ + (size_t)2048 * 1024 * 2);
constexpr size_t O_WUP = A256(O_KEYS + (size_t)16 * 128 * 128 * 2);
constexpr size_t O_AUP = A256(O_WUP + (size_t)1024 * 64 * 2);
constexpr size_t O_GUP = A256(O_AUP + (size_t)1024 * 64 * 2);
constexpr size_t O_BEND = A256(O_GUP + (size_t)512 * 128 * 2);
constexpr size_t O_MLOC = A256(O_BEND + (size_t)260 * 8 * 4);
constexpr size_t O_MST = A256(O_MLOC + (size_t)260 * 8 * 4);
constexpr size_t O_NT = A256(O_MST + (size_t)260 * 8 * 4);
constexpr size_t O_BONUS = A256(O_NT + (size_t)260 * 8 * 64 * 4);
constexpr size_t O_STAMP = A256(O_BONUS + (size_t)T_ALL * 16 * 4);
constexpr size_t O_BAR = A256(O_STAMP + 1024);
constexpr size_t O_PG = A256(O_BAR + 3456 * 4);
constexpr size_t O_PO = A256(O_PG + (size_t)T_LAT * 2048 * 2);
constexpr size_t O_R = A256(O_PO + (size_t)T_LAT * 512 * 2);
constexpr size_t R_HX = O_R;
constexpr size_t R_WIN = A256(R_HX + (size_t)T_ALL * 1024 * 2);
constexpr size_t R_PQK = A256(R_WIN + (size_t)(NP + 128) * 1024 * 2);
constexpr size_t R_PV = A256(R_PQK + (size_t)T_ALL * 512 * 2);
constexpr size_t R_GIF = A256(R_PV + (size_t)T_ALL * 512 * 2);
constexpr size_t R_U = A256(R_GIF + (size_t)T_ALL * 16 * 4);
constexpr size_t R_END1 = A256(R_U + (size_t)260 * 8 * 8192 * 4);
constexpr size_t R_SV = O_R;
constexpr size_t R_YA = A256(R_SV + (size_t)T_ALL * 8 * SVH * 2);
constexpr size_t R_END2 = A256(R_YA + (size_t)T_LAT * 512 * 2);
constexpr size_t R_MERGED = O_R;
constexpr size_t R_H2 = A256(R_MERGED + (size_t)T_LAT * 1024 * 2);
constexpr size_t R_TOPS = A256(R_H2 + (size_t)T_LAT * 1024 * 2);
constexpr size_t R_TOPI = A256(R_TOPS + (size_t)T_LAT * 256 * 4);
constexpr size_t R_UBF = A256(R_TOPI + (size_t)T_LAT * 256 * 4);
constexpr size_t R_VBF = A256(R_UBF + (size_t)16384 * 1024 * 2);
constexpr size_t R_END3 = A256(R_VBF + (size_t)16384 * 1024 * 2);
constexpr size_t WS_NEED = (R_END1 > R_END2 ? (R_END1 > R_END3 ? R_END1 : R_END3) : (R_END2 > R_END3 ? R_END2 : R_END3));
constexpr size_t OUT_BC = (size_t)NCH * 16 * 4096 * 4;

DEVI bf16_t f2bf(float f) { unsigned u = __float_as_uint(f); u += 0x7fffu + ((u >> 16) & 1u); return (bf16_t)(u >> 16); }
DEVI float bf2f(bf16_t h) { return __uint_as_float(((unsigned)h) << 16); }
DEVI float bflo(unsigned u) { return __uint_as_float(u << 16); }
DEVI float bfhi(unsigned u) { return __uint_as_float(u & 0xffff0000u); }
DEVI unsigned pack2(float a, float b) { return (unsigned)f2bf(a) | ((unsigned)f2bf(b) << 16); }
DEVI void unpack8(const uint4& u, float* f) {
  f[0] = bflo(u.x); f[1] = bfhi(u.x); f[2] = bflo(u.y); f[3] = bfhi(u.y);
  f[4] = bflo(u.z); f[5] = bfhi(u.z); f[6] = bflo(u.w); f[7] = bfhi(u.w);
}
DEVI uint4 pack8(const float* f) { return make_uint4(pack2(f[0], f[1]), pack2(f[2], f[3]), pack2(f[4], f[5]), pack2(f[6], f[7])); }
DEVI float wave_sum(float v) {
#pragma unroll
  for (int o = 32; o; o >>= 1) v += __shfl_xor(v, o);
  return v;
}
DEVI float wave_max(float v) {
#pragma unroll
  for (int o = 32; o; o >>= 1) v = fmaxf(v, __shfl_xor(v, o));
  return v;
}
DEVI float sigm(float x) { return 1.f / (1.f + __expf(-x)); }
DEVI float siluf(float x) { return x / (1.f + __expf(-x)); }
DEVI float logsig(float x) { return fminf(x, 0.f) - log1pf(expf(-fabsf(x))); }
template <int CTRL> DEVI float dppf(float v) { return __int_as_float(__builtin_amdgcn_update_dpp(0, __float_as_int(v), CTRL, 0xf, 0xf, true)); }
DEVI float rlf(float v, int l) { return __int_as_float(__builtin_amdgcn_readlane(__float_as_int(v), l)); }
DEVI float wave_sum_u(float v) {
  v += dppf<0xB1>(v); v += dppf<0x4E>(v); v += dppf<0x141>(v); v += dppf<0x140>(v);
  return (rlf(v, 0) + rlf(v, 16)) + (rlf(v, 32) + rlf(v, 48));
}
typedef __attribute__((ext_vector_type(2))) short s16x2;
DEVI float dot2bf(unsigned a, unsigned b, float c) { return __builtin_amdgcn_fdot2_f32_bf16(__builtin_bit_cast(s16x2, a), __builtin_bit_cast(s16x2, b), c, false); }
typedef __attribute__((ext_vector_type(2))) float f32x2;
DEVI void convert_fp8(const float* __restrict__ src, unsigned char* __restrict__ dst, size_t n16, float scale) {
  for (size_t g = (size_t)blockIdx.x * 256 + threadIdx.x; g < n16; g += (size_t)gridDim.x * 256) {
    u32x4 o;
#pragma unroll
    for (int q = 0; q < 4; ++q) {
      float4 a = *(const float4*)(src + g * 16 + q * 4);
      int pk = __builtin_amdgcn_cvt_pk_fp8_f32(a.x * scale, a.y * scale, 0, false);
      pk = __builtin_amdgcn_cvt_pk_fp8_f32(a.z * scale, a.w * scale, pk, true);
      o[q] = (unsigned)pk;
    }
    *(u32x4*)(dst + g * 16) = o;
  }
}
DEVI void unpack_fp8x16(const u32x4& u, float* f) {
#pragma unroll
  for (int q = 0; q < 4; ++q) {
    f32x2 lo = __builtin_amdgcn_cvt_pk_f32_fp8((int)u[q], false), hi = __builtin_amdgcn_cvt_pk_f32_fp8((int)u[q], true);
    f[4 * q] = lo[0]; f[4 * q + 1] = lo[1]; f[4 * q + 2] = hi[0]; f[4 * q + 3] = hi[1];
  }
}
DEVI void convert_bf16(const float* __restrict__ src, bf16_t* __restrict__ dst, size_t n8) {
  for (size_t g = (size_t)blockIdx.x * 256 + threadIdx.x; g < n8; g += (size_t)gridDim.x * 256) {
    float4 a = *(const float4*)(src + g * 8), b = *(const float4*)(src + g * 8 + 4);
    *(uint4*)(dst + g * 8) = make_uint4(pack2(a.x, a.y), pack2(a.z, a.w), pack2(b.x, b.y), pack2(b.z, b.w));
  }
}
DEVI float allred8(float v) { v += dppf<0xB1>(v); v += dppf<0x4E>(v); v += dppf<0x141>(v); return v; }

DEVI int ml_row(int c, int j) {
  if (c < 4) return c * 64 + j;
  int cc = c - 4; int col = cc >> 2; int gr = (cc & 3) * 64 + j;
  return T_CTX + gr * 64 + col;
}
DEVI int ml_sc(int c, int dir) { return dir == 0 ? c : (c < 4 ? 3 - c : 263 - c); }
DEVI int rw_row(int p, int dir) { return dir == 0 ? p : (p < T_CTX ? (T_CTX - 1 - p) : (T_ALL + T_CTX - 1 - p)); }

DEVI float mod_val(const Params& p, int which, int col) {
  return ((const float*)(p.ws + O_MODP))[which * 6144 + col];
}

DEVI void gemm_core(const bf16_t* __restrict__ A, int lda, const bf16_t* __restrict__ Bt, int ldb, int K,
                    f32x4 (&acc)[4][4], unsigned char* smem) {
  bf16_t(*sa)[80] = (bf16_t(*)[80])smem;
  bf16_t(*sb)[80] = (bf16_t(*)[80])(smem + 128 * 80 * 2);
  const int tid = threadIdx.x, lane = tid & 63, warp = tid >> 6, wm = warp >> 1, wn = warp & 1;
  const int lr = tid >> 3, lk = (tid & 7) * 8;
  const bf16_t* Ap = A + (size_t)lr * lda + lk;
  const bf16_t* Bp = Bt + (size_t)lr * ldb + lk;
  u32x4 ra0[4], rb0[4], ra1[4], rb1[4];
#pragma unroll
  for (int i = 0; i < 4; ++i) {
    ra0[i] = *(const u32x4*)(Ap + (size_t)(32 * i) * lda); rb0[i] = *(const u32x4*)(Bp + (size_t)(32 * i) * ldb);
    ra1[i] = *(const u32x4*)(Ap + (size_t)(32 * i) * lda + 64); rb1[i] = *(const u32x4*)(Bp + (size_t)(32 * i) * ldb + 64);
  }
#define GEMM_STEP(k0, ra, rb)                                                                                 \
  {                                                                                                           \
    __syncthreads();                                                                                          \
    _Pragma("unroll") for (int i = 0; i < 4; ++i) { *(u32x4*)&sa[lr + 32 * i][lk] = ra[i]; *(u32x4*)&sb[lr + 32 * i][lk] = rb[i]; } \
    __syncthreads();                                                                                          \
    if ((k0) + 128 < K) {                                                                                     \
      _Pragma("unroll") for (int i = 0; i < 4; ++i) {                                                         \
        ra[i] = *(const u32x4*)(Ap + (size_t)(32 * i) * lda + (k0) + 128);                                    \
        rb[i] = *(const u32x4*)(Bp + (size_t)(32 * i) * ldb + (k0) + 128);                                    \
      }                                                                                                       \
    }                                                                                                         \
    __builtin_amdgcn_s_setprio(1);                                                                            \
    _Pragma("unroll") for (int ks = 0; ks < 2; ++ks) {                                                        \
      bf16x8 af[4], bq[4];                                                                                    \
      _Pragma("unroll") for (int i = 0; i < 4; ++i) af[i] = *(const bf16x8*)&sa[wm * 64 + i * 16 + (lane & 15)][ks * 32 + (lane >> 4) * 8]; \
      _Pragma("unroll") for (int j = 0; j < 4; ++j) bq[j] = *(const bf16x8*)&sb[wn * 64 + j * 16 + (lane & 15)][ks * 32 + (lane >> 4) * 8]; \
      _Pragma("unroll") for (int i = 0; i < 4; ++i)                                                           \
        _Pragma("unroll") for (int j = 0; j < 4; ++j) acc[i][j] = __builtin_amdgcn_mfma_f32_16x16x32_bf16(bq[j], af[i], acc[i][j], 0, 0, 0); \
    }                                                                                                         \
    __builtin_amdgcn_s_setprio(0);                                                                            \
  }
  for (int k0 = 0; k0 < K; k0 += 128) {
    GEMM_STEP(k0, ra0, rb0)
    GEMM_STEP(k0 + 64, ra1, rb1)
  }
#undef GEMM_STEP
  __syncthreads();
}
DEVI void zero_acc(f32x4 (&acc)[4][4]) {
#pragma unroll
  for (int i = 0; i < 4; ++i)
#pragma unroll
    for (int j = 0; j < 4; ++j) acc[i][j] = f32x4{0.f, 0.f, 0.f, 0.f};
}

struct XcdMap { int v, nx, slot, slots; };
template <typename F> DEVI void for_tiles_xcd(const XcdMap& xm, int MT, int NT, int SM, int SN, F&& f) {
  const int nsn = (NT + SN - 1) / SN, nst = ((MT + SM - 1) / SM) * nsn, per = SM * SN;
  const int n_my = (nst - xm.v + xm.nx - 1) / xm.nx;
  for (int g = xm.slot; g < n_my * per; g += xm.slots) {
    const int s = xm.v + (g / per) * xm.nx, idx = g % per;
    const int sm = s / nsn, sn = s % nsn;
    const int mt = sm * SM + idx / SN, nt = sn * SN + idx % SN;
    if (mt < MT && nt < NT) f(mt, nt);
  }
}

DEVI void tr_tile(const float* __restrict__ src, int lds, int k0, int n0src, bf16_t* __restrict__ dst, int ldd, int n0dst,
                  unsigned char* smem) {
  float(*tile)[65] = (float(*)[65])smem;
  const int tid = threadIdx.x, j = tid & 63, i0 = tid >> 6;
#pragma unroll 4
  for (int ii = 0; ii < 16; ++ii) { int i = i0 + 4 * ii; tile[i][j] = src[(size_t)(k0 + i) * lds + n0src + j]; }
  __syncthreads();
#pragma unroll 4
  for (int jj = 0; jj < 16; ++jj) { int jn = i0 + 4 * jj; dst[(size_t)(n0dst + jn) * ldd + k0 + j] = f2bf(tile[j][jn]); }
  __syncthreads();
}

DEVI void phase0(const Params& p, unsigned char* smem, int it_lo, int it_hi) {
  const int tid = threadIdx.x;
  constexpr int N_MOD = 96, N_WIN = 16 * 85, N_WB = 128, N_WOUT = 256, N_WQ = 512, N_LORA = 16, N_GUP = 16, N_KEYS = 128;
  constexpr int E0 = N_MOD, E1 = E0 + N_WIN, E2 = E1 + N_WB, E3 = E2 + N_WB, E4 = E3 + N_WOUT, E5 = E4 + N_WQ,
                E6 = E5 + N_LORA, E7 = E6 + N_LORA, E8 = E7 + N_GUP, E9 = E8 + N_KEYS;
  if (it_hi > E9) it_hi = E9;
  for (int it = it_lo + blockIdx.x; it < it_hi; it += gridDim.x) {
    if (it < E0) {
      float* sl = (float*)smem;
      float* part = sl + 2048;
      __syncthreads();
      for (int i = tid; i < 2048; i += 256) sl[i] = siluf(i < 1024 ? p.in[I_C][i] : p.in[I_CCTX][i - 1024]);
      __syncthreads();
      const int cl = tid & 63, rg = tid >> 6, col = it * 64 + cl;
      const float* aw = p.in[I_ADAW] + (size_t)(rg * 256) * 6144 + col;
      float ax = 0.f, ac = 0.f;
#pragma unroll 32
      for (int r = 0; r < 256; ++r) {
        const float w = aw[(size_t)r * 6144];
        ax += sl[rg * 256 + r] * w;
        ac += sl[1024 + rg * 256 + r] * w;
      }
      part[(rg * 2 + 0) * 64 + cl] = ax;
      part[(rg * 2 + 1) * 64 + cl] = ac;
      __syncthreads();
      if (tid < 128) {
        const int which = tid >> 6;
        const float v = part[(0 * 2 + which) * 64 + cl] + part[(1 * 2 + which) * 64 + cl] + part[(2 * 2 + which) * 64 + cl] + part[(3 * 2 + which) * 64 + cl];
        ((float*)(p.ws + O_MODP))[which * 6144 + col] = v + p.in[I_ADAB][col];
      }
    } else if (it < E1) {
      int t = it - E0; int kt = t / 85, nt = t % 85; int n0 = nt * 64;
      tr_tile(p.in[I_WIN], NIN, kt * 64, nt == 84 ? 2816 : (n0 < 2816 ? n0 : n0 + 16), (bf16_t*)(p.ws + R_WIN), 1024, n0, smem);
    } else if (it < E2) {
      int t = it - E1; tr_tile(p.in[I_WBA], 1024, (t / 16) * 64, (t % 16) * 64, (bf16_t*)(p.ws + O_WBA), 512, (t % 16) * 64, smem);
    } else if (it < E3) {
      int t = it - E2; tr_tile(p.in[I_WBB], 1024, (t / 16) * 64, (t % 16) * 64, (bf16_t*)(p.ws + O_WBB), 512, (t % 16) * 64, smem);
    } else if (it < E4) {
      int t = it - E3; tr_tile(p.in[I_WOUT], 1024, (t / 16) * 64, (t % 16) * 64, (bf16_t*)(p.ws + O_WOUT), 1024, (t % 16) * 64, smem);
    } else if (it < E5) {
      int t = it - E4; tr_tile(p.in[I_WQ], 2048, (t / 32) * 64, (t % 32) * 64, (bf16_t*)(p.ws + O_WQ), 1024, (t % 32) * 64, smem);
    } else if (it < E6) {
      int t = it - E5; int dir = t / 8, nt = t % 8;
      tr_tile(p.in[I_RWUP] + (size_t)dir * 64 * 512, 512, 0, nt * 64, (bf16_t*)(p.ws + O_WUP) + (size_t)dir * 512 * 64, 64, nt * 64, smem);
    } else if (it < E7) {
      int t = it - E6; int dir = t / 8, nt = t % 8;
      tr_tile(p.in[I_RAUP] + (size_t)dir * 64 * 512, 512, 0, nt * 64, (bf16_t*)(p.ws + O_AUP) + (size_t)dir * 512 * 64, 64, nt * 64, smem);
    } else if (it < E8) {
      int t = it - E7; tr_tile(p.in[I_RGUP], 512, (t / 8) * 64, (t % 8) * 64, (bf16_t*)(p.ws + O_GUP), 128, (t % 8) * 64, smem);
    } else {
      int t = it - E8; size_t base = (size_t)t * 2048 + tid * 8;
      const float* s = p.in[I_KEYS] + base;
      float f[8];
      float4 a = *(const float4*)s, b = *(const float4*)(s + 4);
      f[0] = a.x; f[1] = a.y; f[2] = a.z; f[3] = a.w; f[4] = b.x; f[5] = b.y; f[6] = b.z; f[7] = b.w;
      *(uint4*)((bf16_t*)(p.ws + O_KEYS) + base) = pack8(f);
    }
  }
}

DEVI void phase1(const Params& p, unsigned char* smem) {
  float* smod = (float*)smem;
  const int tid = threadIdx.x, lane = tid & 63, warp = tid >> 6;
  for (int i = tid; i < 4096; i += 256) { int which = i >> 10; smod[i] = mod_val(p, which >> 1, (which & 1) * 1024 + (i & 1023)); }
  __syncthreads();
  bf16_t* hx = (bf16_t*)(p.ws + R_HX);
  float* gif = (float*)(p.ws + R_GIF);
  const float* win = p.in[I_WIN];
  constexpr int RPW = 4;
  for (int rg = blockIdx.x * 4 + warp; rg < T_ALL / RPW; rg += gridDim.x * 4) {
    const int row0 = rg * RPW;
    const float* sh = smod + (row0 < T_CTX ? 2048 : 0);
    const float* sc = sh + 1024;
    const float* src0 = row0 < T_CTX ? p.in[I_CTX] + (size_t)row0 * 1024 : p.in[I_X] + (size_t)(row0 - T_CTX) * 1024;
    float rstd[RPW]; f32x4 xv[RPW][4];
#pragma unroll
    for (int r = 0; r < RPW; ++r) {
      float ss = 0.f;
#pragma unroll
      for (int i = 0; i < 4; ++i) {
        const f32x4 v = *(const f32x4*)(src0 + (size_t)r * 1024 + i * 256 + lane * 4);
        xv[r][i] = v;
        ss += v[0] * v[0] + v[1] * v[1] + v[2] * v[2] + v[3] * v[3];
      }
      ss = wave_sum_u(ss);
      rstd[r] = rsqrtf(ss * (1.f / 1024.f) + 1e-6f);
    }
#pragma unroll
    for (int i = 0; i < 4; ++i) {
      const int k0 = i * 256 + lane * 4;
      const float4 gk = *(const float4*)(p.in[I_N1G] + k0);
      const float4 s4 = *(const float4*)(sc + k0), h4 = *(const float4*)(sh + k0);
#pragma unroll
      for (int r = 0; r < RPW; ++r) {
        const f32x4 v = xv[r][i];
        const float y0 = v[0] * rstd[r] * gk.x * (1.f + s4.x) + h4.x, y1 = v[1] * rstd[r] * gk.y * (1.f + s4.y) + h4.y;
        const float y2 = v[2] * rstd[r] * gk.z * (1.f + s4.z) + h4.z, y3 = v[3] * rstd[r] * gk.w * (1.f + s4.w) + h4.w;
        *(uint2*)(hx + (size_t)(row0 + r) * 1024 + k0) = make_uint2(pack2(y0, y1), pack2(y2, y3));
      }
    }
  }
}

DEVI void phase2(const Params& p, unsigned char* smem, const XcdMap& xm) {
  const int lane = threadIdx.x & 63, warp = threadIdx.x >> 6, wm = warp >> 1, wn = warp & 1;
  const bf16_t* hx = (const bf16_t*)(p.ws + R_HX);
  const bf16_t* wt = (const bf16_t*)(p.ws + R_WIN);
  bf16_t* prw = (bf16_t*)p.out;
  bf16_t* pqk = (bf16_t*)(p.ws + R_PQK);
  bf16_t* pv = (bf16_t*)(p.ws + R_PV);
  bf16_t* po = (bf16_t*)(p.ws + O_PO);
  bf16_t* pg = (bf16_t*)(p.ws + O_PG);
  for_tiles_xcd(xm, 130, 43, 5, 6, [&](int mt, int nt) {
    if (mt < 2 && nt >= 22 && nt < 42) return;
    f32x4 acc[4][4];
    zero_acc(acc);
    gemm_core(hx + (size_t)mt * 128 * 1024, 1024, wt + (size_t)nt * 128 * 1024, 1024, 1024, acc, smem);
    if (nt == 42) {
      float* gif = (float*)(p.ws + R_GIF);
      if (wn == 0) {
#pragma unroll
        for (int i = 0; i < 4; ++i) {
          const int row = mt * 128 + wm * 64 + i * 16 + (lane & 15);
          *(float4*)(gif + (size_t)row * 16 + (lane >> 4) * 4) = make_float4(acc[i][0][0], acc[i][0][1], acc[i][0][2], acc[i][0][3]);
        }
      }
      return;
    }
    bf16_t* dst; int ld, nb; int rofs = 0; bool sg = false;
    if (nt < 14) { dst = prw; ld = 1792; nb = nt * 128; }
    else if (nt < 18) { dst = pqk; ld = 512; nb = (nt - 14) * 128; }
    else if (nt < 22) { dst = pv; ld = 512; nb = (nt - 18) * 128; }
    else if (nt < 26) { dst = po; ld = 512; nb = (nt - 22) * 128; rofs = T_CTX; }
    else { dst = pg; ld = 2048; nb = (nt - 26) * 128; rofs = T_CTX; sg = true; }
    bf16_t(*Ct)[136] = (bf16_t(*)[136])smem;
#pragma unroll
    for (int i = 0; i < 4; ++i) {
#pragma unroll
      for (int j = 0; j < 4; ++j) {
        f32x4 v = acc[i][j];
        if (sg) { v[0] = sigm(v[0]); v[1] = sigm(v[1]); v[2] = sigm(v[2]); v[3] = sigm(v[3]); }
        *(uint2*)&Ct[wm * 64 + i * 16 + (lane & 15)][wn * 64 + j * 16 + (lane >> 4) * 4] = make_uint2(pack2(v[0], v[1]), pack2(v[2], v[3]));
      }
    }
    __syncthreads();
#pragma unroll
    for (int q = 0; q < 8; ++q) {
      const int pc = threadIdx.x + 256 * q; const int r = pc >> 4, c8 = (pc & 15) * 8;
      const int row = mt * 128 + r - rofs;
      *(u32x4*)(dst + (size_t)row * ld + nb + c8) = *(const u32x4*)&Ct[r][c8];
    }
    __syncthreads();
  });
}

DEVI void ml_qk8(const Params& p, int c, int j, int chan, float* o) {
  const bf16_t* pqk = (const bf16_t*)(p.ws + R_PQK);
  int row = ml_row(c, j);
  bool hp, hn; int rp, rn;
  if (c < 4) { hp = row > 0; hn = row < T_CTX - 1; rp = row - 1; rn = row + 1; }
  else { int gr = ((c - 4) & 3) * 64 + j; hp = gr > 0; hn = gr < 255; rp = row - 64; rn = row + 64; }
  const float* cw = p.in[I_MCONV];
  float cur[8], pr[8], nx[8];
  unpack8(*(const uint4*)(pqk + (size_t)row * 512 + chan), cur);
  if (hp) unpack8(*(const uint4*)(pqk + (size_t)rp * 512 + chan), pr);
  if (hn) unpack8(*(const uint4*)(pqk + (size_t)rn * 512 + chan), nx);
#pragma unroll
  for (int e = 0; e < 8; ++e) {
    float v = cw[512 + chan + e] * cur[e];
    if (hp) v += cw[chan + e] * pr[e];
    if (hn) v += cw[1024 + chan + e] * nx[e];
    o[e] = siluf(v);
  }
}

DEVI void phase3(const Params& p, unsigned char* smem) {
  bf16_t(*KT)[72] = (bf16_t(*)[72])smem;
  bf16_t(*VwT)[72] = (bf16_t(*)[72])(smem + 64 * 72 * 2);
  float* wgt = (float*)(smem + 64 * 72 * 2 + 256 * 72 * 2);
  const int tid = threadIdx.x, lane = tid & 63, warp = tid >> 6;
  const float* gif = (const float*)(p.ws + R_GIF);
  const bf16_t* pv = (const bf16_t*)(p.ws + R_PV);
  float* U = (float*)(p.ws + R_U);
  float* NT = (float*)(p.ws + O_NT);
  float* bend = (float*)(p.ws + O_BEND);
  float* mloc = (float*)(p.ws + O_MLOC);
  for (int it = blockIdx.x; it < 260 * 4; it += gridDim.x) {
    int c = it >> 2, h = it & 3;
    if (warp < 2) {
      int dir = warp; int j = dir ? 63 - lane : lane;
      int row = ml_row(c, j);
      float ig = gif[(size_t)row * 16 + dir * 4 + h] + p.in[I_MIB][dir * 4 + h];
      float lf = logsig(gif[(size_t)row * 16 + 8 + dir * 4 + h] + p.in[I_MFB][dir * 4 + h]);
      float b = lf;
#pragma unroll
      for (int o = 1; o < 64; o <<= 1) { float t = __shfl_up(b, o); if (lane >= o) b += t; }
      float be = __shfl(b, 63);
      float ge = be - b + ig;
      float ml = wave_max(ge);
      wgt[dir * 64 + j] = expf(ge - ml);
      if (lane == 0) { int sc = ml_sc(c, dir); bend[sc * 8 + dir * 4 + h] = be; mloc[sc * 8 + dir * 4 + h] = ml; }
    }
    __syncthreads();
    {
      int j = tid >> 2, part = tid & 3;
      float f[8];
#pragma unroll
      for (int q = 0; q < 2; ++q) {
        int d0 = part * 16 + q * 8;
        ml_qk8(p, c, j, 256 + h * 64 + d0, f);
#pragma unroll
        for (int e = 0; e < 8; ++e) KT[d0 + e][j] = f2bf(f[e] * 0.125f);
      }
      int row = ml_row(c, j);
      float w0 = wgt[j], w1 = wgt[64 + j];
#pragma unroll
      for (int q = 0; q < 4; ++q) {
        int v0 = part * 32 + q * 8;
        unpack8(*(const uint4*)(pv + (size_t)row * 512 + h * 128 + v0), f);
#pragma unroll
        for (int e = 0; e < 8; ++e) { VwT[v0 + e][j] = f2bf(f[e] * w0); VwT[128 + v0 + e][j] = f2bf(f[e] * w1); }
      }
    }
    __syncthreads();
#pragma unroll
    for (int dir = 0; dir < 2; ++dir) {
      int sc = ml_sc(c, dir);
      float* Ud = U + ((size_t)sc * 8 + dir * 4 + h) * 8192;
#pragma unroll
      for (int vi = 0; vi < 2; ++vi) {
        int vt = warp * 2 + vi;
        bf16x8 bv[2];
#pragma unroll
        for (int ks = 0; ks < 2; ++ks) bv[ks] = *(const bf16x8*)&VwT[dir * 128 + vt * 16 + (lane & 15)][ks * 32 + (lane >> 4) * 8];
#pragma unroll
        for (int dt = 0; dt < 4; ++dt) {
          f32x4 a = {0.f, 0.f, 0.f, 0.f};
#pragma unroll
          for (int ks = 0; ks < 2; ++ks) {
            bf16x8 ak = *(const bf16x8*)&KT[dt * 16 + (lane & 15)][ks * 32 + (lane >> 4) * 8];
            a = __builtin_amdgcn_mfma_f32_16x16x32_bf16(ak, bv[ks], a, 0, 0, 0);
          }
          *(float4*)(Ud + (size_t)(vt * 16 + (lane & 15)) * 64 + dt * 16 + (lane >> 4) * 4) = make_float4(a[0], a[1], a[2], a[3]);
        }
      }
    }
    if (tid < 128) {
      int dir = tid >> 6, d = tid & 63; float s = 0.f;
      for (int j = 0; j < 64; ++j) s += wgt[dir * 64 + j] * bf2f(KT[d][j]);
      NT[((size_t)ml_sc(c, dir) * 8 + dir * 4 + h) * 64 + d] = s;
    }
    __syncthreads();
  }
}

template <bool DRY> DEVI void phase4(const Params& p, unsigned char* smem) {
  const bool wr = !DRY || (p.in[I_FG][0] == 1234.5f);
  float* U = (float*)(p.ws + R_U);
  float* NT = (float*)(p.ws + O_NT);
  const float* bend = (const float*)(p.ws + O_BEND);
  const float* mloc = (const float*)(p.ws + O_MLOC);
  float* mst = (float*)(p.ws + O_MST);
  float(*kp)[264] = (float(*)[264])smem;
  float(*sp)[264] = (float(*)[264])(smem + 2 * 264 * 4);
  const int tid = threadIdx.x, lane = tid & 63, warp = tid >> 6;
  for (int gb = blockIdx.x * 256; gb < 8 * 8256; gb += gridDim.x * 256) {
    const int pA = gb / 8256;
    if (warp < 2) {
      const int pw = pA + warp;
      if (pw < 8) {
        float be[5], ml[5], B[5], m[5];
        float run = 0.f;
#pragma unroll
        for (int k = 0; k < 5; ++k) {
          const int c = lane * 5 + k;
          be[k] = c < 260 ? bend[c * 8 + pw] : 0.f;
          ml[k] = c < 260 ? mloc[c * 8 + pw] : -INFINITY;
          run += be[k]; B[k] = run;
        }
        float incl = run;
#pragma unroll
        for (int o = 1; o < 64; o <<= 1) { float t = __shfl_up(incl, o); if (lane >= o) incl += t; }
        const float off = incl - run;
        float pm = -INFINITY, pml[5];
#pragma unroll
        for (int k = 0; k < 5; ++k) { B[k] += off; pm = fmaxf(pm, ml[k] - B[k]); pml[k] = pm; }
        float inclm = pm;
#pragma unroll
        for (int o = 1; o < 64; o <<= 1) { float t = __shfl_up(inclm, o); if (lane >= o) inclm = fmaxf(inclm, t); }
        float offm = __shfl_up(inclm, 1); if (lane == 0) offm = -INFINITY;
#pragma unroll
        for (int k = 0; k < 5; ++k) m[k] = B[k] + fmaxf(0.f, fmaxf(offm, pml[k]));
        float mprev = __shfl_up(m[4], 1); if (lane == 0) mprev = 0.f;
        const bool owner = gb <= pw * 8256 && pw * 8256 < gb + 256;
#pragma unroll
        for (int k = 0; k < 5; ++k) {
          const int c = lane * 5 + k;
          if (c < 260) {
            kp[warp][c] = expf(be[k] + mprev - m[k]);
            sp[warp][c] = expf(ml[k] - m[k]);
            if (wr && owner) mst[c * 8 + pw] = mprev;
          }
          mprev = m[k];
        }
      }
    }
    __syncthreads();
    const int g = gb + tid;
    if (g < 8 * 8256) {
      const int pr = g / 8256, e = g % 8256, slot = pr - pA;
      float* base; size_t stride;
      if (e < 8192) { base = U + (size_t)pr * 8192 + e; stride = 8 * 8192; }
      else { base = NT + (size_t)pr * 64 + (e - 8192); stride = 8 * 64; }
      float C = 0.f;
      for (int sc = 0; sc < 260; sc += 20) {
        float u[20];
#pragma unroll
        for (int q = 0; q < 20; ++q) u[q] = base[(size_t)(sc + q) * stride];
#pragma unroll
        for (int q = 0; q < 20; ++q) {
          if (wr) base[(size_t)(sc + q) * stride] = C;
          C = kp[slot][sc + q] * C + sp[slot][sc + q] * u[q];
        }
      }
    }
    __syncthreads();
  }
}

template <bool DRY> DEVI void phase5(const Params& p, unsigned char* smem) {
  const bool wr = !DRY || (p.in[I_FG][0] == 1234.5f);
  bf16_t(*Qs)[72] = (bf16_t(*)[72])smem;
  bf16_t(*Ks)[72] = (bf16_t(*)[72])(smem + 9216);
  bf16_t(*Pm)[72] = (bf16_t(*)[72])(smem + 2 * 9216);
  bf16_t(*VT)[72] = (bf16_t(*)[72])(smem + 3 * 9216);
  float* evec = (float*)(smem + 3 * 9216 + 144 * 72 * 2);
  float* Mvec = evec + 128;
  float* bvec = Mvec + 128;
  const int tid = threadIdx.x, lane = tid & 63, warp = tid >> 6;
  const float* gif = (const float*)(p.ws + R_GIF);
  const bf16_t* pv = (const bf16_t*)(p.ws + R_PV);
  const bf16_t* po = (const bf16_t*)(p.ws + O_PO);
  bf16_t* yb = (bf16_t*)(p.ws + R_YA);
  const float* U = (const float*)(p.ws + R_U);
  const float* NT = (const float*)(p.ws + O_NT);
  const float* mst = (const float*)(p.ws + O_MST);
  for (int it = blockIdx.x; it < 256 * 4; it += gridDim.x) {
    int c = 4 + (it >> 2), h = it & 3;
    if (warp < 2) {
      int dir = warp; int j = dir ? 63 - lane : lane;
      int row = ml_row(c, j);
      float ig = gif[(size_t)row * 16 + dir * 4 + h] + p.in[I_MIB][dir * 4 + h];
      float lf = logsig(gif[(size_t)row * 16 + 8 + dir * 4 + h] + p.in[I_MFB][dir * 4 + h]);
      float b = lf;
#pragma unroll
      for (int o = 1; o < 64; o <<= 1) { float t = __shfl_up(b, o); if (lane >= o) b += t; }
      float e = ig - b;
      float pm = e;
#pragma unroll
      for (int o = 1; o < 64; o <<= 1) { float t = __shfl_up(pm, o); if (lane >= o) pm = fmaxf(pm, t); }
      float m0 = mst[ml_sc(c, dir) * 8 + dir * 4 + h];
      evec[dir * 64 + j] = e; Mvec[dir * 64 + j] = fmaxf(m0, pm); bvec[dir * 64 + j] = b;
    }
    {
      int j = tid >> 2, part = tid & 3;
      float f[8];
#pragma unroll
      for (int q = 0; q < 2; ++q) {
        int d0 = part * 16 + q * 8;
        ml_qk8(p, c, j, h * 64 + d0, f);
        *(uint4*)&Qs[j][d0] = pack8(f);
        ml_qk8(p, c, j, 256 + h * 64 + d0, f);
#pragma unroll
        for (int e = 0; e < 8; ++e) f[e] *= 0.125f;
        *(uint4*)&Ks[j][d0] = pack8(f);
      }
      int row = ml_row(c, j);
#pragma unroll
      for (int q = 0; q < 4; ++q) {
        int v0 = part * 32 + q * 8;
        unpack8(*(const uint4*)(pv + (size_t)row * 512 + h * 128 + v0), f);
#pragma unroll
        for (int e = 0; e < 8; ++e) VT[v0 + e][j] = f2bf(f[e]);
      }
      for (int i = tid; i < 16 * 64; i += 256) VT[128 + (i >> 6)][i & 63] = (i < 64) ? (bf16_t)0x3f80 : (bf16_t)0;
    }
    __syncthreads();
    const int jl = warp * 16 + (lane & 15);
    f32x4 s0[4];
    bf16x8 qf[2];
#pragma unroll
    for (int ks = 0; ks < 2; ++ks) qf[ks] = *(const bf16x8*)&Qs[jl][ks * 32 + (lane >> 4) * 8];
#pragma unroll
    for (int st = 0; st < 4; ++st) {
      f32x4 a = {0.f, 0.f, 0.f, 0.f};
#pragma unroll
      for (int ks = 0; ks < 2; ++ks) {
        bf16x8 kf = *(const bf16x8*)&Ks[st * 16 + (lane & 15)][ks * 32 + (lane >> 4) * 8];
        a = __builtin_amdgcn_mfma_f32_16x16x32_bf16(kf, qf[ks], a, 0, 0, 0);
      }
      s0[st] = a;
    }
    f32x4 ysum[8];
#pragma unroll
    for (int vt = 0; vt < 8; ++vt) ysum[vt] = f32x4{0.f, 0.f, 0.f, 0.f};
#pragma unroll 2
    for (int dir = 0; dir < 2; ++dir) {
      float Mj = Mvec[dir * 64 + jl], bj = bvec[dir * 64 + jl];
      float m0 = mst[ml_sc(c, dir) * 8 + dir * 4 + h];
#pragma unroll
      for (int st = 0; st < 4; ++st) {
        float pvv[4];
#pragma unroll
        for (int r = 0; r < 4; ++r) {
          int s = st * 16 + (lane >> 4) * 4 + r;
          bool ok = dir == 0 ? (s <= jl) : (s >= jl);
          pvv[r] = ok ? s0[st][r] * expf(evec[dir * 64 + s] - Mj) : 0.f;
        }
        *(uint2*)&Pm[jl][st * 16 + (lane >> 4) * 4] = make_uint2(pack2(pvv[0], pvv[1]), pack2(pvv[2], pvv[3]));
      }
      __syncthreads();
      bf16x8 pf[2];
#pragma unroll
      for (int ks = 0; ks < 2; ++ks) pf[ks] = *(const bf16x8*)&Pm[jl][ks * 32 + (lane >> 4) * 8];
      const float* Cst = U + ((size_t)ml_sc(c, dir) * 8 + dir * 4 + h) * 8192;
      const float* nst = NT + ((size_t)ml_sc(c, dir) * 8 + dir * 4 + h) * 64;
      float ai = expf(m0 - Mj);
      f32x4 hh[9];
#pragma unroll
      for (int vt = 0; vt < 9; ++vt) {
        f32x4 a1 = {0.f, 0.f, 0.f, 0.f}, a2 = {0.f, 0.f, 0.f, 0.f};
#pragma unroll
        for (int ks = 0; ks < 2; ++ks) {
          bf16x8 vf = *(const bf16x8*)&VT[vt * 16 + (lane & 15)][ks * 32 + (lane >> 4) * 8];
          a1 = __builtin_amdgcn_mfma_f32_16x16x32_bf16(vf, pf[ks], a1, 0, 0, 0);
          int v = vt * 16 + (lane & 15);
          const float* cp = v < 128 ? Cst + (size_t)v * 64 + ks * 32 + (lane >> 4) * 8 : nst + ks * 32 + (lane >> 4) * 8;
          float cf[8];
          if (v <= 128) {
            float4 x0 = *(const float4*)cp, x1 = *(const float4*)(cp + 4);
            cf[0] = x0.x; cf[1] = x0.y; cf[2] = x0.z; cf[3] = x0.w; cf[4] = x1.x; cf[5] = x1.y; cf[6] = x1.z; cf[7] = x1.w;
          } else {
#pragma unroll
            for (int e = 0; e < 8; ++e) cf[e] = 0.f;
          }
          uint4 pk = pack8(cf);
          bf16x8 cfr;
          cfr[0] = (short)(pk.x & 0xffff); cfr[1] = (short)(pk.x >> 16); cfr[2] = (short)(pk.y & 0xffff); cfr[3] = (short)(pk.y >> 16);
          cfr[4] = (short)(pk.z & 0xffff); cfr[5] = (short)(pk.z >> 16); cfr[6] = (short)(pk.w & 0xffff); cfr[7] = (short)(pk.w >> 16);
          a2 = __builtin_amdgcn_mfma_f32_16x16x32_bf16(cfr, qf[ks], a2, 0, 0, 0);
        }
#pragma unroll
        for (int r = 0; r < 4; ++r) hh[vt][r] = a1[r] + ai * a2[r];
      }
      float den = __shfl(hh[8][0], lane & 15);
      float dn = fmaxf(fabsf(den), expf(-(bj + Mj)));
      float inv = 1.f / dn;
      float ss = 0.f;
#pragma unroll
      for (int vt = 0; vt < 8; ++vt)
#pragma unroll
        for (int r = 0; r < 4; ++r) { float x = hh[vt][r] * inv; hh[vt][r] = x; ss += x * x; }
      ss += __shfl_xor(ss, 16); ss += __shfl_xor(ss, 32);
      float rs = rsqrtf(ss * (1.f / 128.f) + 1e-6f);
#pragma unroll
      for (int vt = 0; vt < 8; ++vt)
#pragma unroll
        for (int r = 0; r < 4; ++r) ysum[vt][r] += hh[vt][r] * rs * p.in[I_MNG][h * 128 + vt * 16 + (lane >> 4) * 4 + r];
      __syncthreads();
    }
    {
      int row = ml_row(c, jl) - T_CTX;
#pragma unroll
      for (int vt = 0; vt < 8; ++vt) {
        const bf16_t* op = po + (size_t)row * 512 + h * 128 + vt * 16 + (lane >> 4) * 4;
        uint2 o = *(const uint2*)op;
        float y0 = ysum[vt][0] * sigm(bflo(o.x)), y1 = ysum[vt][1] * sigm(bfhi(o.x)), y2 = ysum[vt][2] * sigm(bflo(o.y)), y3 = ysum[vt][3] * sigm(bfhi(o.y));
        if (wr) *(uint2*)(yb + (size_t)row * 512 + h * 128 + vt * 16 + (lane >> 4) * 4) = make_uint2(pack2(y0, y1), pack2(y2, y3));
      }
    }
    __syncthreads();
  }
}

DEVI void phase6(const Params& p, unsigned char* smem, int item_lo, int item_hi, int blk0, int nblk) {
  float(*rs)[65] = (float(*)[65])smem;
  float(*ks)[65] = (float(*)[65])(smem + 64 * 65 * 4);
  bf16_t(*TW)[72] = (bf16_t(*)[72])(smem + 2 * 64 * 65 * 4);
  bf16_t(*TA)[72] = (bf16_t(*)[72])(smem + 2 * 64 * 65 * 4 + 9216);
  bf16_t(*TG)[136] = (bf16_t(*)[136])(smem + 2 * 64 * 65 * 4 + 2 * 9216);
  float* rn = (float*)(smem + 2 * 64 * 65 * 4 + 2 * 9216 + 64 * 136 * 2);
  const int tid = threadIdx.x, lane = tid & 63, warp = tid >> 6;
  const bf16_t* prw = (const bf16_t*)p.out;
  bf16_t* SV = (bf16_t*)(p.ws + R_SV);
  float* bonus = (float*)(p.ws + O_BONUS);
  const float* cw = p.in[I_RCONV];
  const bf16_t* WUP = (const bf16_t*)(p.ws + O_WUP);
  const bf16_t* AUP = (const bf16_t*)(p.ws + O_AUP);
  const bf16_t* GUP = (const bf16_t*)(p.ws + O_GUP);
  if ((int)blockIdx.x < blk0) return;
  for (int it = item_lo + ((int)blockIdx.x - blk0); it < item_hi; it += nblk) {
    int tile = it >> 3, head = it & 7;
    int row0 = tile * 64;
    int seg0 = tile < 4 ? 0 : row0, seg1 = tile < 4 ? T_CTX : row0 + 64;
#pragma unroll 1
    for (int ub = 0; ub < 2; ++ub) {
      u32x4 lc[7], lp[7], ln[7];
#pragma unroll
      for (int it7 = 0; it7 < 7; ++it7) {
        const int u = warp + 4 * (ub * 7 + it7);
        const int grp = u >> 3;
        const int j = (u & 7) * 8 + (lane >> 3), q = grp * 8 + (lane & 7);
        const int row = row0 + j;
        const int col = q < 24 ? (q >> 3) * 512 + head * 64 + (q & 7) * 8 : 1536 + (q - 24) * 8;
        const bool hp = row > seg0, hn = row < seg1 - 1;
        lc[it7] = *(const u32x4*)(prw + (size_t)row * 1792 + col);
        lp[it7] = hp ? *(const u32x4*)(prw + (size_t)(row - 1) * 1792 + col) : u32x4{0u, 0u, 0u, 0u};
        ln[it7] = hn ? *(const u32x4*)(prw + (size_t)(row + 1) * 1792 + col) : u32x4{0u, 0u, 0u, 0u};
      }
#pragma unroll
      for (int it7 = 0; it7 < 7; ++it7) {
        const int u = warp + 4 * (ub * 7 + it7);
        const int grp = u >> 3;
        const int j = (u & 7) * 8 + (lane >> 3), q = grp * 8 + (lane & 7);
        const int row = row0 + j;
        const int col = q < 24 ? (q >> 3) * 512 + head * 64 + (q & 7) * 8 : 1536 + (q - 24) * 8;
        float cur[8], pr[8], nx[8], o[8];
        unpack8(make_uint4(lc[it7][0], lc[it7][1], lc[it7][2], lc[it7][3]), cur);
        unpack8(make_uint4(lp[it7][0], lp[it7][1], lp[it7][2], lp[it7][3]), pr);
        unpack8(make_uint4(ln[it7][0], ln[it7][1], ln[it7][2], ln[it7][3]), nx);
        {
          float4 c0 = *(const float4*)(cw + col), c1 = *(const float4*)(cw + col + 4);
          float4 d0 = *(const float4*)(cw + 1792 + col), d1 = *(const float4*)(cw + 1792 + col + 4);
          float4 e0 = *(const float4*)(cw + 3584 + col), e1 = *(const float4*)(cw + 3584 + col + 4);
          float wp[8] = {c0.x, c0.y, c0.z, c0.w, c1.x, c1.y, c1.z, c1.w};
          float wc[8] = {d0.x, d0.y, d0.z, d0.w, d1.x, d1.y, d1.z, d1.w};
          float wn_[8] = {e0.x, e0.y, e0.z, e0.w, e1.x, e1.y, e1.z, e1.w};
#pragma unroll
          for (int e = 0; e < 8; ++e) o[e] = wc[e] * cur[e] + wp[e] * pr[e] + wn_[e] * nx[e];
        }
        if (grp == 0) {
#pragma unroll
          for (int e = 0; e < 8; ++e) rs[j][(q & 7) * 8 + e] = o[e];
        } else if (grp == 1) {
#pragma unroll
          for (int e = 0; e < 8; ++e) ks[j][(q & 7) * 8 + e] = o[e];
        } else if (grp == 2) {
          *(uint4*)(SV + ((size_t)row * 8 + head) * SVH + 2 * 64 + (q & 7) * 8) = pack8(o);
        } else if (grp == 3) {
#pragma unroll
          for (int e = 0; e < 8; ++e) o[e] = 1.f - 2.f / (1.f + __expf(2.f * o[e]));
          *(uint4*)&TW[j][(q - 24) * 8] = pack8(o);
        } else if (grp == 4) {
          *(uint4*)&TA[j][(q - 32) * 8] = pack8(o);
        } else {
#pragma unroll
          for (int e = 0; e < 8; ++e) o[e] = sigm(o[e]);
          *(uint4*)&TG[j][(q - 40) * 8] = pack8(o);
        }
      }
    }
    __syncthreads();
    {
      int j = tid >> 2, part = tid & 3; float ss = 0.f;
#pragma unroll
      for (int e = 0; e < 16; ++e) { float v = ks[j][part * 16 + e] * p.in[I_RKK][head * 64 + part * 16 + e]; ss += v * v; }
      ss += __shfl_xor(ss, 1); ss += __shfl_xor(ss, 2);
      if (part == 0) rn[j] = 1.f / fmaxf(sqrtf(ss), 1e-12f);
    }
    __syncthreads();
    for (int pc = tid; pc < 64 * 8; pc += 256) {
      int j = pc >> 3, c8 = (pc & 7) * 8; int row = row0 + j;
      float fr[8], fk[8], fkk[8];
#pragma unroll
      for (int e = 0; e < 8; ++e) { fr[e] = rs[j][c8 + e]; fk[e] = ks[j][c8 + e]; fkk[e] = fk[e] * p.in[I_RKK][head * 64 + c8 + e] * rn[j]; }
      bf16_t* b = SV + ((size_t)row * 8 + head) * SVH;
      *(uint4*)(b + 0 * 64 + c8) = pack8(fr);
      *(uint4*)(b + 1 * 64 + c8) = pack8(fk);
      *(uint4*)(b + 3 * 64 + c8) = pack8(fkk);
    }
    {
      const int jl = warp * 16 + (lane & 15); const int row = row0 + jl;
      bf16x8 tw[2], ta[2], tg[4];
#pragma unroll
      for (int s2 = 0; s2 < 2; ++s2) { tw[s2] = *(const bf16x8*)&TW[jl][s2 * 32 + (lane >> 4) * 8]; ta[s2] = *(const bf16x8*)&TA[jl][s2 * 32 + (lane >> 4) * 8]; }
#pragma unroll
      for (int s2 = 0; s2 < 4; ++s2) tg[s2] = *(const bf16x8*)&TG[jl][s2 * 32 + (lane >> 4) * 8];
      __syncthreads();
      bf16_t(*OB)[64][72] = (bf16_t(*)[64][72])(smem + 2 * 64 * 65 * 4);
      float bon[2] = {0.f, 0.f};
#pragma unroll
      for (int dir = 0; dir < 2; ++dir) {
#pragma unroll
        for (int ct = 0; ct < 4; ++ct) {
          const int ch0 = ct * 16 + (lane >> 4) * 4;
          const int C0 = head * 64 + ch0;
          if (dir == 0) {
            f32x4 a = {0.f, 0.f, 0.f, 0.f};
#pragma unroll
            for (int s2 = 0; s2 < 4; ++s2) {
              bf16x8 wf = *(const bf16x8*)(GUP + (size_t)(head * 64 + ct * 16 + (lane & 15)) * 128 + s2 * 32 + (lane >> 4) * 8);
              a = __builtin_amdgcn_mfma_f32_16x16x32_bf16(wf, tg[s2], a, 0, 0, 0);
            }
            *(uint2*)&OB[2][jl][ch0] = make_uint2(pack2(a[0], a[1]), pack2(a[2], a[3]));
          }
          f32x4 aw = {0.f, 0.f, 0.f, 0.f}, aa = {0.f, 0.f, 0.f, 0.f};
#pragma unroll
          for (int s2 = 0; s2 < 2; ++s2) {
            size_t wo = (size_t)(dir * 512 + head * 64 + ct * 16 + (lane & 15)) * 64 + s2 * 32 + (lane >> 4) * 8;
            bf16x8 wf = *(const bf16x8*)(WUP + wo);
            bf16x8 af = *(const bf16x8*)(AUP + wo);
            aw = __builtin_amdgcn_mfma_f32_16x16x32_bf16(wf, tw[s2], aw, 0, 0, 0);
            aa = __builtin_amdgcn_mfma_f32_16x16x32_bf16(af, ta[s2], aa, 0, 0, 0);
          }
          const float4 w04 = *(const float4*)(p.in[I_RW0] + dir * 512 + C0), a04 = *(const float4*)(p.in[I_RA0] + dir * 512 + C0);
          const float4 ka4 = *(const float4*)(p.in[I_RKA] + C0), rk4 = *(const float4*)(p.in[I_RRK] + C0);
          const float w0v[4] = {w04.x, w04.y, w04.z, w04.w}, a0v[4] = {a04.x, a04.y, a04.z, a04.w};
          const float kav[4] = {ka4.x, ka4.y, ka4.z, ka4.w}, rkv[4] = {rk4.x, rk4.y, rk4.z, rk4.w};
          float we[4], av[4];
#pragma unroll
          for (int r = 0; r < 4; ++r) {
            we[r] = (0.60653066f * 1.44269504f) * sigm(w0v[r] + aw[r]);
            av[r] = sigm(a0v[r] + aa[r]);
            float kv = ks[jl][ch0 + r];
            float keff = kv * (1.f + (av[r] - 1.f) * kav[r]);
            bon[dir] += rs[jl][ch0 + r] * keff * rkv[r];
          }
          *(uint2*)&OB[0][jl][ch0] = make_uint2(pack2(we[0], we[1]), pack2(we[2], we[3]));
          *(uint2*)&OB[1][jl][ch0] = make_uint2(pack2(av[0], av[1]), pack2(av[2], av[3]));
        }
        __syncthreads();
        for (int pc = tid; pc < (dir == 0 ? 3 : 2) * 64 * 8; pc += 256) {
          const int vsel = pc >> 9, j = (pc >> 3) & 63, c8 = (pc & 7) * 8;
          const int vec = vsel == 2 ? 8 : (4 + 2 * dir + vsel);
          *(u32x4*)(SV + ((size_t)(row0 + j) * 8 + head) * SVH + vec * 64 + c8) = *(const u32x4*)&OB[vsel][j][c8];
        }
        __syncthreads();
      }
#pragma unroll
      for (int dir = 0; dir < 2; ++dir) {
        float sb = bon[dir]; sb += __shfl_xor(sb, 16); sb += __shfl_xor(sb, 32);
        if (lane < 16) bonus[(size_t)row * 16 + dir * 8 + head] = sb;
      }
    }
    __syncthreads();
  }
}

struct RwVec { uint4 k, kk, w, a, v, r; };
DEVI void unpack8p(const uint4& u, f32x2* f) {
  f[0] = f32x2{bflo(u.x), bfhi(u.x)}; f[1] = f32x2{bflo(u.y), bfhi(u.y)}; f[2] = f32x2{bflo(u.z), bfhi(u.z)}; f[3] = f32x2{bflo(u.w), bfhi(u.w)};
}
DEVI f32x2 bc2(float x) { return f32x2{x, x}; }
DEVI void rw_load(RwVec& x, const bf16_t* SV, int row, int head, int dir, int i, int jg, bool need_r) {
  const bf16_t* b = SV + ((size_t)row * 8 + head) * SVH;
  x.k = *(const uint4*)(b + 1 * 64 + jg * 8);
  x.kk = *(const uint4*)(b + 3 * 64 + jg * 8);
  x.w = *(const uint4*)(b + (4 + 2 * dir) * 64 + jg * 8);
  x.a = *(const uint4*)(b + (5 + 2 * dir) * 64 + jg * 8);
  x.v = *(const uint4*)(b + 2 * 64 + i * 8);
  if (need_r) x.r = *(const uint4*)(b + 0 * 64 + jg * 8);
}

DEVI void phase7(const Params& p) {
  const int lane = threadIdx.x & 63, warp = threadIdx.x >> 6, i = lane >> 3, jg = lane & 7;
  const bf16_t* SV = (const bf16_t*)(p.ws + R_SV);
  float* Pc = (float*)p.out;
  float* Bc = (float*)((unsigned char*)p.out + OUT_BC);
  for (int it = blockIdx.x * 4 + warp; it < (NCH - 1) * 16; it += gridDim.x * 4) {
    const int chunk = it >> 4, pair = it & 15, dir = pair >> 3, head = pair & 7;
    f32x2 S[8][4], P[8][4], ka[4];
#pragma unroll
    for (int a = 0; a < 8; ++a)
#pragma unroll
      for (int c = 0; c < 4; ++c) {
        S[a][c] = f32x2{0.f, 0.f};
        P[a][c] = f32x2{(i * 8 + a == jg * 8 + 2 * c) ? 1.f : 0.f, (i * 8 + a == jg * 8 + 2 * c + 1) ? 1.f : 0.f};
      }
#pragma unroll
    for (int c = 0; c < 4; ++c) ka[c] = f32x2{p.in[I_RKA][head * 64 + jg * 8 + 2 * c], p.in[I_RKA][head * 64 + jg * 8 + 2 * c + 1]};
    RwVec nx;
    rw_load(nx, SV, rw_row(chunk * LCH, dir), head, dir, i, jg, false);
#pragma unroll 1
    for (int t = 0; t < LCH; ++t) {
      RwVec cu = nx;
      if (t + 1 < LCH) rw_load(nx, SV, rw_row(chunk * LCH + t + 1, dir), head, dir, i, jg, false);
      f32x2 kv[4], kk[4], w[4], av[4], kka[4], keff[4]; float vv[8];
      unpack8p(cu.k, kv); unpack8p(cu.kk, kk); unpack8p(cu.w, w); unpack8p(cu.a, av); unpack8(cu.v, vv);
#pragma unroll
      for (int c = 0; c < 4; ++c) {
        w[c] = f32x2{__builtin_amdgcn_exp2f(-w[c][0]), __builtin_amdgcn_exp2f(-w[c][1])};
        kka[c] = -kk[c] * av[c];
        keff[c] = kv[c] * (bc2(1.f) + (av[c] - bc2(1.f)) * ka[c]);
      }
#pragma unroll
      for (int a = 0; a < 8; ++a) {
        f32x2 sa = S[a][0] * kk[0], qa = P[a][0] * kk[0];
#pragma unroll
        for (int c = 1; c < 4; ++c) { sa += S[a][c] * kk[c]; qa += P[a][c] * kk[c]; }
        float s1 = allred8(sa[0] + sa[1]), q1 = allred8(qa[0] + qa[1]);
        const f32x2 s2 = bc2(s1), q2 = bc2(q1), v2 = bc2(vv[a]);
#pragma unroll
        for (int c = 0; c < 4; ++c) {
          S[a][c] = S[a][c] * w[c] + s2 * kka[c] + v2 * keff[c];
          P[a][c] = P[a][c] * w[c] + q2 * kka[c];
        }
      }
    }
    float* po = Pc + ((size_t)chunk * 16 + pair) * 4096;
    float* bo = Bc + ((size_t)chunk * 16 + pair) * 4096;
#pragma unroll
    for (int a = 0; a < 8; ++a) {
      *(float4*)(po + (i * 8 + a) * 64 + jg * 8) = make_float4(P[a][0][0], P[a][0][1], P[a][1][0], P[a][1][1]);
      *(float4*)(po + (i * 8 + a) * 64 + jg * 8 + 4) = make_float4(P[a][2][0], P[a][2][1], P[a][3][0], P[a][3][1]);
      *(float4*)(bo + (i * 8 + a) * 64 + jg * 8) = make_float4(S[a][0][0], S[a][0][1], S[a][1][0], S[a][1][1]);
      *(float4*)(bo + (i * 8 + a) * 64 + jg * 8 + 4) = make_float4(S[a][2][0], S[a][2][1], S[a][3][0], S[a][3][1]);
    }
  }
}

template <bool DRY> DEVI void phase8(const Params& p, unsigned char* smem) {
  const bool wr = !DRY || (p.in[I_FG][0] == 1234.5f);
  float(*Sb)[16][68] = (float(*)[16][68])smem;
  const int tid = threadIdx.x, lane = tid & 63, warp = tid >> 6, q = lane >> 4, c16 = lane & 15;
  const float* Pc = (const float*)p.out;
  float* Bc = (float*)((unsigned char*)p.out + OUT_BC);
  constexpr int NS = NCH - 1;
  const size_t CS = (size_t)16 * 4096;
  for (int it = blockIdx.x; it < 64; it += gridDim.x) {
    const int pair = it >> 2, rg = it & 3;
    const float* Pp = Pc + (size_t)pair * 4096 + q * 64 + warp * 16 + c16;
    float* Bp = Bc + (size_t)pair * 4096 + (size_t)(rg * 16 + q * 4) * 64 + warp * 16 + c16;
    __syncthreads();
    {
      const int row = tid >> 4, c4 = (tid & 15) * 4;
      float4 v = *(const float4*)(Bc + (size_t)pair * 4096 + (size_t)(rg * 16 + row) * 64 + c4);
      Sb[0][row][c4] = v.x; Sb[0][row][c4 + 1] = v.y; Sb[0][row][c4 + 2] = v.z; Sb[0][row][c4 + 3] = v.w;
    }
    float pa[16], pb[16]; f32x4 ba, bb;
#pragma unroll
    for (int s2 = 0; s2 < 16; ++s2) { pa[s2] = Pp[CS + s2 * 256]; pb[s2] = Pp[2 * CS + s2 * 256]; }
#pragma unroll
    for (int r = 0; r < 4; ++r) { ba[r] = Bp[CS + r * 64]; bb[r] = Bp[2 * CS + r * 64]; }
    __syncthreads();
#define P8_STEP(c, pp, bv)                                                                                  \
    {                                                                                                        \
      const int rb = ((c) - 1) & 1;                                                                          \
      f32x4 acc0 = bv, acc1 = f32x4{0.f, 0.f, 0.f, 0.f};                                                     \
      _Pragma("unroll") for (int s2 = 0; s2 < 16; s2 += 2) {                                                 \
        acc0 = __builtin_amdgcn_mfma_f32_16x16x4f32(Sb[rb][c16][4 * s2 + q], pp[s2], acc0, 0, 0, 0);         \
        acc1 = __builtin_amdgcn_mfma_f32_16x16x4f32(Sb[rb][c16][4 * s2 + 4 + q], pp[s2 + 1], acc1, 0, 0, 0); \
      }                                                                                                      \
      acc0 += acc1;                                                                                          \
      if ((c) + 2 < NS) {                                                                                    \
        _Pragma("unroll") for (int s2 = 0; s2 < 16; ++s2) pp[s2] = Pp[(size_t)((c) + 2) * CS + s2 * 256];    \
        _Pragma("unroll") for (int r = 0; r < 4; ++r) bv[r] = Bp[(size_t)((c) + 2) * CS + r * 64];           \
      }                                                                                                      \
      _Pragma("unroll") for (int r = 0; r < 4; ++r) {                                                        \
        Sb[rb ^ 1][q * 4 + r][warp * 16 + c16] = acc0[r];                                                    \
        if (wr) Bp[(size_t)(c) * CS + r * 64] = acc0[r];                                                     \
      }                                                                                                      \
      __syncthreads();                                                                                       \
    }
    for (int c = 1; c < NS; c += 2) {
      P8_STEP(c, pa, ba)
      if (c + 1 < NS) P8_STEP(c + 1, pb, bb)
    }
#undef P8_STEP
  }
}

DEVI void phase9(const Params& p) {
  const int lane = threadIdx.x & 63, warp = threadIdx.x >> 6, i = lane >> 3, jg = lane & 7;
  const bf16_t* SV = (const bf16_t*)(p.ws + R_SV);
  const float* Bc = (const float*)((unsigned char*)p.out + OUT_BC);
  bf16_t* odir = (bf16_t*)p.out;
  for (int it = blockIdx.x * 4 + warp; it < NCH * 16; it += gridDim.x * 4) {
    const int chunk = it >> 4, pair = it & 15, dir = pair >> 3, head = pair & 7;
    f32x2 S[8][4], ka[4];
    if (chunk == 0) {
#pragma unroll
      for (int a = 0; a < 8; ++a)
#pragma unroll
        for (int c = 0; c < 4; ++c) S[a][c] = f32x2{0.f, 0.f};
    } else {
      const float* bs = Bc + ((size_t)(chunk - 1) * 16 + pair) * 4096;
#pragma unroll
      for (int a = 0; a < 8; ++a) {
        float4 x0 = *(const float4*)(bs + (i * 8 + a) * 64 + jg * 8), x1 = *(const float4*)(bs + (i * 8 + a) * 64 + jg * 8 + 4);
        S[a][0] = f32x2{x0.x, x0.y}; S[a][1] = f32x2{x0.z, x0.w}; S[a][2] = f32x2{x1.x, x1.y}; S[a][3] = f32x2{x1.z, x1.w};
      }
    }
#pragma unroll
    for (int c = 0; c < 4; ++c) ka[c] = f32x2{p.in[I_RKA][head * 64 + jg * 8 + 2 * c], p.in[I_RKA][head * 64 + jg * 8 + 2 * c + 1]};
    RwVec nx;
    rw_load(nx, SV, rw_row(chunk * LCH, dir), head, dir, i, jg, true);
#pragma unroll 2
    for (int t = 0; t < LCH; ++t) {
      RwVec cu = nx;
      const int row = rw_row(chunk * LCH + t, dir);
      if (t + 1 < LCH) rw_load(nx, SV, rw_row(chunk * LCH + t + 1, dir), head, dir, i, jg, true);
      f32x2 kv[4], kk[4], w[4], av[4], rr[4], kka[4], keff[4]; float vv[8];
      unpack8p(cu.k, kv); unpack8p(cu.kk, kk); unpack8p(cu.w, w); unpack8p(cu.a, av); unpack8p(cu.r, rr); unpack8(cu.v, vv);
#pragma unroll
      for (int c = 0; c < 4; ++c) {
        w[c] = f32x2{__builtin_amdgcn_exp2f(-w[c][0]), __builtin_amdgcn_exp2f(-w[c][1])};
        kka[c] = -kk[c] * av[c];
        keff[c] = kv[c] * (bc2(1.f) + (av[c] - bc2(1.f)) * ka[c]);
      }
      float ov = 0.f;
#pragma unroll
      for (int a = 0; a < 8; ++a) {
        f32x2 sa = S[a][0] * kk[0];
#pragma unroll
        for (int c = 1; c < 4; ++c) sa += S[a][c] * kk[c];
        const float s1 = allred8(sa[0] + sa[1]);
        const f32x2 s2 = bc2(s1), v2 = bc2(vv[a]);
        f32x2 oa = f32x2{0.f, 0.f};
#pragma unroll
        for (int c = 0; c < 4; ++c) {
          S[a][c] = S[a][c] * w[c] + s2 * kka[c] + v2 * keff[c];
          oa += S[a][c] * rr[c];
        }
        const float o = allred8(oa[0] + oa[1]);
        if (jg == a) ov = o;
      }
      if (row >= T_CTX) odir[((size_t)dir * T_LAT + (row - T_CTX)) * 512 + head * 64 + i * 8 + jg] = f2bf(ov);
    }
  }
}

DEVI void phase10(const Params& p) {
  const int lane = threadIdx.x & 63, warp = threadIdx.x >> 6;
  const bf16_t* odir = (const bf16_t*)p.out;
  const bf16_t* SV = (const bf16_t*)(p.ws + R_SV);
  const float* bonus = (const float*)(p.ws + O_BONUS);
  bf16_t* ya = (bf16_t*)(p.ws + O_PO);
  const int head = lane >> 3, c8 = (lane & 7) * 8, C0 = lane * 8;
#pragma unroll 2
  for (int t = blockIdx.x * 4 + warp; t < T_LAT; t += gridDim.x * 4) {
    const int row = t + T_CTX;
    const bf16_t* b = SV + ((size_t)row * 8 + head) * SVH;
    float v[8], g[8], y[8];
    unpack8(*(const uint4*)(b + 2 * 64 + c8), v);
    unpack8(*(const uint4*)(b + 8 * 64 + c8), g);
    float bs = bonus[(size_t)row * 16 + head] + bonus[(size_t)row * 16 + 8 + head];
#pragma unroll
    for (int e = 0; e < 8; ++e) y[e] = bs * v[e];
#pragma unroll
    for (int dir = 0; dir < 2; ++dir) {
      float o[8];
      unpack8(*(const uint4*)(odir + ((size_t)dir * T_LAT + t) * 512 + C0), o);
      float s = 0.f;
#pragma unroll
      for (int e = 0; e < 8; ++e) s += o[e];
      s = allred8(s);
      float mu = s * (1.f / 64.f);
      float q = 0.f;
#pragma unroll
      for (int e = 0; e < 8; ++e) { o[e] -= mu; q += o[e] * o[e]; }
      q = allred8(q);
      float rsd = rsqrtf(q * (1.f / 64.f) + 64e-5f);
#pragma unroll
      for (int e = 0; e < 8; ++e) y[e] += o[e] * rsd * p.in[I_RLNW][C0 + e] + p.in[I_RLNB][C0 + e];
    }
#pragma unroll
    for (int e = 0; e < 8; ++e) y[e] *= g[e];
    *(uint4*)(ya + (size_t)t * 512 + C0) = pack8(y);
  }
}

DEVI void phase11(const Params& p, unsigned char* smem, const XcdMap& xm) {
  const int lane = threadIdx.x & 63, warp = threadIdx.x >> 6, wm = warp >> 1, wn = warp & 1;
  const bf16_t* ya = (const bf16_t*)(p.ws + O_PO);
  const bf16_t* yb = (const bf16_t*)(p.ws + R_YA);
  const bf16_t* pg = (const bf16_t*)(p.ws + O_PG);
  bf16_t* mg = (bf16_t*)(p.ws + R_MERGED);
  for_tiles_xcd(xm, 128, 8, 8, 8, [&](int mt, int nt) {
    f32x4 acc[4][4];
    zero_acc(acc);
    gemm_core(ya + (size_t)mt * 128 * 512, 512, (const bf16_t*)(p.ws + O_WBA) + (size_t)nt * 128 * 512, 512, 512, acc, smem);
#pragma unroll
    for (int i = 0; i < 4; ++i) {
      int row = mt * 128 + wm * 64 + i * 16 + (lane & 15);
#pragma unroll
      for (int j = 0; j < 4; ++j) {
        int n = nt * 128 + wn * 64 + j * 16 + (lane >> 4) * 4;
        uint2 s = *(const uint2*)(pg + (size_t)row * 2048 + n);
        *(uint2*)(mg + (size_t)row * 1024 + n) = make_uint2(pack2(acc[i][j][0] * bflo(s.x), acc[i][j][1] * bfhi(s.x)), pack2(acc[i][j][2] * bflo(s.y), acc[i][j][3] * bfhi(s.y)));
      }
    }
    zero_acc(acc);
    gemm_core(yb + (size_t)mt * 128 * 512, 512, (const bf16_t*)(p.ws + O_WBB) + (size_t)nt * 128 * 512, 512, 512, acc, smem);
#pragma unroll
    for (int i = 0; i < 4; ++i) {
      int row = mt * 128 + wm * 64 + i * 16 + (lane & 15);
#pragma unroll
      for (int j = 0; j < 4; ++j) {
        int n = nt * 128 + wn * 64 + j * 16 + (lane >> 4) * 4;
        uint2 s = *(const uint2*)(pg + (size_t)row * 2048 + 1024 + n);
        uint2 m0 = *(const uint2*)(mg + (size_t)row * 1024 + n);
        float v0 = bflo(m0.x) + acc[i][j][0] * bflo(s.x), v1 = bfhi(m0.x) + acc[i][j][1] * bfhi(s.x);
        float v2 = bflo(m0.y) + acc[i][j][2] * bflo(s.y), v3 = bfhi(m0.y) + acc[i][j][3] * bfhi(s.y);
        *(uint2*)(mg + (size_t)row * 1024 + n) = make_uint2(pack2(v0, v1), pack2(v2, v3));
      }
    }
  });
}

DEVI void phase12(const Params& p, unsigned char* smem, const XcdMap& xm) {
  float* gt = (float*)(smem + 45056);
  const int tid = threadIdx.x, lane = tid & 63, warp = tid >> 6, wm = warp >> 1, wn = warp & 1;
  for (int i = tid; i < 1024; i += 256) gt[i] = mod_val(p, 0, 2048 + i);
  __syncthreads();
  const bf16_t* mg = (const bf16_t*)(p.ws + R_MERGED);
  const float* x = p.in[I_X];
  float* x1 = p.out;
  for_tiles_xcd(xm, 128, 8, 8, 8, [&](int mt, int nt) {
    f32x4 acc[4][4];
    zero_acc(acc);
    gemm_core(mg + (size_t)mt * 128 * 1024, 1024, (const bf16_t*)(p.ws + O_WOUT) + (size_t)nt * 128 * 1024, 1024, 1024, acc, smem);
#pragma unroll
    for (int i = 0; i < 4; ++i) {
      int row = mt * 128 + wm * 64 + i * 16 + (lane & 15);
#pragma unroll
      for (int j = 0; j < 4; ++j) {
        int n = nt * 128 + wn * 64 + j * 16 + (lane >> 4) * 4;
        float4 xv = *(const float4*)(x + (size_t)row * 1024 + n);
        xv.x += gt[n] * acc[i][j][0]; xv.y += gt[n + 1] * acc[i][j][1]; xv.z += gt[n + 2] * acc[i][j][2]; xv.w += gt[n + 3] * acc[i][j][3];
        *(float4*)(x1 + (size_t)row * 1024 + n) = xv;
      }
    }
  });
}

DEVI void phase13(const Params& p, unsigned char* smem) {
  float* smod = (float*)smem;
  const int tid = threadIdx.x, lane = tid & 63, warp = tid >> 6;
  for (int i = tid; i < 2048; i += 256) smod[i] = mod_val(p, 0, 3072 + i);
  __syncthreads();
  const float* x1 = p.out;
  bf16_t* h2 = (bf16_t*)(p.ws + R_H2);
  for (int rp = blockIdx.x * 4 + warp; rp < T_LAT / 2; rp += gridDim.x * 4) {
    float h[2][16]; float ss[2] = {0.f, 0.f};
#pragma unroll
    for (int u = 0; u < 2; ++u)
#pragma unroll
      for (int i = 0; i < 4; ++i) {
        float4 v = *(const float4*)(x1 + (size_t)(rp * 2 + u) * 1024 + i * 256 + lane * 4);
        h[u][4 * i] = v.x; h[u][4 * i + 1] = v.y; h[u][4 * i + 2] = v.z; h[u][4 * i + 3] = v.w;
        ss[u] += v.x * v.x + v.y * v.y + v.z * v.z + v.w * v.w;
      }
#pragma unroll
    for (int u = 0; u < 2; ++u) {
      const int row = rp * 2 + u;
      const float rstd = rsqrtf(wave_sum_u(ss[u]) * (1.f / 1024.f) + 1e-6f);
#pragma unroll
      for (int i = 0; i < 4; ++i) {
        {
          const int k0 = i * 256 + lane * 4;
          const float4 gk = *(const float4*)(p.in[I_N2G] + k0);
          const f32x4 s4 = *(const f32x4*)(smod + 1024 + k0), h4 = *(const f32x4*)(smod + k0);
          h[u][4 * i] = h[u][4 * i] * rstd * gk.x * (1.f + s4[0]) + h4[0];
          h[u][4 * i + 1] = h[u][4 * i + 1] * rstd * gk.y * (1.f + s4[1]) + h4[1];
          h[u][4 * i + 2] = h[u][4 * i + 2] * rstd * gk.z * (1.f + s4[2]) + h4[2];
          h[u][4 * i + 3] = h[u][4 * i + 3] * rstd * gk.w * (1.f + s4[3]) + h4[3];
        }
        *(uint2*)(h2 + (size_t)row * 1024 + i * 256 + lane * 4) = make_uint2(pack2(h[u][4 * i], h[u][4 * i + 1]), pack2(h[u][4 * i + 2], h[u][4 * i + 3]));
      }
    }
  }
}

DEVI void phase14(const Params& p, unsigned char* smem, const XcdMap& xm) {
  bf16_t(*Qt)[136] = (bf16_t(*)[136])smem;
  float* Sc = (float*)smem;
  const int tid = threadIdx.x, lane = tid & 63, warp = tid >> 6, wm = warp >> 1, wn = warp & 1;
  const bf16_t* h2 = (const bf16_t*)(p.ws + R_H2);
  const bf16_t* keys = (const bf16_t*)(p.ws + O_KEYS);
  float* tops = (float*)(p.ws + R_TOPS);
  int* topi = (int*)(p.ws + R_TOPI);
  for_tiles_xcd(xm, 128, 16, 8, 8, [&](int mt, int hp) {
    f32x4 acc[4][4];
    zero_acc(acc);
    gemm_core(h2 + (size_t)mt * 128 * 1024, 1024, (const bf16_t*)(p.ws + O_WQ) + (size_t)hp * 128 * 1024, 1024, 1024, acc, smem);
#pragma unroll
    for (int i = 0; i < 4; ++i)
#pragma unroll
      for (int j = 0; j < 4; ++j)
        *(uint2*)&Qt[wm * 64 + i * 16 + (lane & 15)][wn * 64 + j * 16 + (lane >> 4) * 4] =
            make_uint2(pack2(acc[i][j][0], acc[i][j][1]), pack2(acc[i][j][2], acc[i][j][3]));
    __syncthreads();
    zero_acc(acc);
#pragma unroll
    for (int ks = 0; ks < 4; ++ks) {
      bf16x8 qf[4], kf[4];
#pragma unroll
      for (int i = 0; i < 4; ++i) qf[i] = *(const bf16x8*)&Qt[wm * 64 + i * 16 + (lane & 15)][ks * 32 + (lane >> 4) * 8];
#pragma unroll
      for (int j = 0; j < 4; ++j) kf[j] = *(const bf16x8*)(keys + ((size_t)hp * 128 + wn * 64 + j * 16 + (lane & 15)) * 128 + ks * 32 + (lane >> 4) * 8);
#pragma unroll
      for (int i = 0; i < 4; ++i)
#pragma unroll
        for (int j = 0; j < 4; ++j) acc[i][j] = __builtin_amdgcn_mfma_f32_16x16x32_bf16(kf[j], qf[i], acc[i][j], 0, 0, 0);
    }
    __syncthreads();
#pragma unroll
    for (int i = 0; i < 4; ++i)
#pragma unroll
      for (int j = 0; j < 4; ++j) {
        {
          const int c0 = j * 16 + (lane >> 4) * 4;
          u32x4 kq;
#pragma unroll
          for (int r = 0; r < 4; ++r) {
            unsigned u = __float_as_uint(acc[i][j][r]);
            u = (u & 0x80000000u) ? ~u : (u | 0x80000000u);
            kq[r] = (u & ~63u) | (unsigned)(63 - (c0 + r));
          }
          *(u32x4*)(Sc + (wm * 64 + i * 16 + (lane & 15)) * 132 + wn * 64 + c0) = kq;
        }
      }
    __syncthreads();
    {
      const int row = tid & 127, half = tid >> 7;
      float* hp_ = Sc + row * 132 + half * 64;
      float bv[16]; int bi[16];
      unsigned* hk = (unsigned*)hp_;
#pragma unroll
      for (int r = 0; r < 16; ++r) {
        unsigned best = 0u;
#pragma unroll 16
        for (int k = 0; k < 64; k += 4) {
          const u32x4 v4 = *(const u32x4*)(hk + k);
          const unsigned m01 = v4[0] > v4[1] ? v4[0] : v4[1], m23 = v4[2] > v4[3] ? v4[2] : v4[3];
          const unsigned m = m01 > m23 ? m01 : m23;
          best = best > m ? best : m;
        }
        const int b2 = 63 - (int)(best & 63u);
        unsigned u = best & ~63u;
        u = (u & 0x80000000u) ? (u & 0x7fffffffu) : ~u;
        bv[r] = __uint_as_float(u); bi[r] = b2 + half * 64; hk[b2] = 0u;
      }
#pragma unroll
      for (int r = 0; r < 16; ++r) { hp_[r] = bv[r]; hp_[16 + r] = __int_as_float(bi[r]); }
    }
    __syncthreads();
    if (tid < 128) {
      const float* la = Sc + tid * 132; const float* lb = la + 64;
      size_t ob = ((size_t)(mt * 128 + tid) * 16 + hp) * 16;
      int ia = 0, ib = 0;
      for (int r = 0; r < 16; ++r) {
        float va = la[ia], vb = lb[ib];
        bool ta = va >= vb;
        tops[ob + r] = ta ? va : vb;
        topi[ob + r] = __float_as_int(ta ? la[16 + ia] : lb[16 + ib]);
        ia += ta ? 1 : 0; ib += ta ? 0 : 1;
      }
    }
    __syncthreads();
  });
}

template <bool DRY> DEVI void phase15(const Params& p, unsigned char* smem) {
  const bool wr = !DRY || (p.in[I_FG][0] == 1234.5f);
  float* gt = (float*)smem;
  const int tid = threadIdx.x, lane = tid & 63, warp = tid >> 6;
  for (int i = tid; i < 1024; i += 256) gt[i] = mod_val(p, 0, 5120 + i);
  __syncthreads();
  const bf16_t* __restrict__ h2 = (const bf16_t*)(p.ws + R_H2);
  const float* __restrict__ tops = (const float*)(p.ws + R_TOPS);
  const int* __restrict__ topi = (const int*)(p.ws + R_TOPI);
  const unsigned char* __restrict__ uf8 = p.ws + R_UBF;
  const unsigned char* __restrict__ vf8 = p.ws + R_VBF;
  float* xo = p.out;
  int ca, cb;
  {
    int l = lane;
    if (l < 16) { ca = 0; cb = l; } else if (l < 24) { ca = 1; cb = l - 16; } else if (l < 29) { ca = 2; cb = l - 24; }
    else if (l < 33) { ca = 3; cb = l - 29; } else if (l < 36) { ca = 4; cb = l - 33; } else if (l < 38) { ca = 5; cb = l - 36; }
    else if (l < 40) { ca = 6; cb = l - 38; } else if (l < 42) { ca = 7; cb = l - 40; } else if (l < 50) { ca = l - 34; cb = 0; }
    else { ca = 0; cb = 0; }
  }
  const int flat = ca * 16 + cb;
  for (int t = blockIdx.x * 4 + warp; t < T_LAT; t += gridDim.x * 4) {
    float hv[16], out[16];
    {
      const u32x4 hp0 = *(const u32x4*)(h2 + (size_t)t * 1024 + lane * 16);
      const u32x4 hp1 = *(const u32x4*)(h2 + (size_t)t * 1024 + lane * 16 + 8);
#pragma unroll
      for (int e = 0; e < 4; ++e) { hv[2 * e] = bflo(hp0[e]); hv[2 * e + 1] = bfhi(hp0[e]); hv[8 + 2 * e] = bflo(hp1[e]); hv[8 + 2 * e + 1] = bfhi(hp1[e]); }
    }
#pragma unroll
    for (int e = 0; e < 16; ++e) out[e] = 0.f;
#pragma unroll 1
    for (int hd = 0; hd < 8; ++hd) {
      const size_t b1 = ((size_t)t * 16 + hd * 2) * 16, b2 = b1 + 16;
      float val = lane < 50 ? tops[b1 + ca] + tops[b2 + cb] : -INFINITY;
      int idx = topi[b1 + ca] * 128 + topi[b2 + cb];
      unsigned key = __float_as_uint(val);
      key = (key & 0x80000000u) ? ~key : (key | 0x80000000u);
      key = lane < 50 ? ((key & ~63u) | (unsigned)(63 - lane)) : 0u;
      int cnt = 0;
#pragma unroll
      for (int i = 0; i < 50; ++i) cnt += ((unsigned)__builtin_amdgcn_readlane((int)key, i) > key) ? 1 : 0;
      bool sel = lane < 50 && cnt < 16;
      float vmax = rlf(val, 0);
      float ex = sel ? __expf(val - vmax) : 0.f;
      float gsum = wave_sum_u(ex);
      float g = ex / gsum;
      unsigned long long m1 = __ballot(sel);
      int es[16];
      float gq = 0.f;
#pragma unroll
      for (int q = 0; q < 16; ++q) {
        int src = __ffsll((long long)m1) - 1; m1 &= m1 - 1;
        es[q] = __builtin_amdgcn_readlane(idx, src);
        float gg = rlf(g, src);
        if (lane == q) gq = gg;
      }
      float dm = 0.f;
      {
        u32x4 ub[16];
#pragma unroll
        for (int q = 0; q < 16; ++q) ub[q] = *(const u32x4*)(uf8 + (size_t)es[q] * 1024 + lane * 16);
#pragma unroll
        for (int q = 0; q < 16; ++q) {
          float f[16]; unpack_fp8x16(ub[q], f);
          float d0 = 0.f, d1 = 0.f;
#pragma unroll
          for (int e = 0; e < 8; ++e) { d0 += f[2 * e] * hv[2 * e]; d1 += f[2 * e + 1] * hv[2 * e + 1]; }
          float d = d0 + d1;
          d += dppf<0xB1>(d); d += dppf<0x4E>(d); d += dppf<0x141>(d); d += dppf<0x140>(d);
          if ((lane & 15) == q) dm = d;
        }
      }
      dm += __shfl_xor(dm, 16); dm += __shfl_xor(dm, 32);
      dm *= (1.f / 64.f);
      float coef = gq * 0.5f * dm * (1.f + erff(dm * 0.70710678118f)) * 0.25f;
      {
        u32x4 vb[16];
#pragma unroll
        for (int q = 0; q < 16; ++q) vb[q] = *(const u32x4*)(vf8 + (size_t)es[q] * 1024 + lane * 16);
#pragma unroll
        for (int q = 0; q < 16; ++q) {
          float cf = rlf(coef, q);
          float f[16]; unpack_fp8x16(vb[q], f);
#pragma unroll
          for (int e = 0; e < 16; ++e) out[e] += cf * f[e];
        }
      }
    }
    float xs[16]; float ss = 0.f;
#pragma unroll
    for (int i = 0; i < 4; ++i) {
      int k = lane * 16 + i * 4;
      float4 v = *(const float4*)(xo + (size_t)t * 1024 + k);
      xs[4 * i] = v.x + gt[k] * out[4 * i]; xs[4 * i + 1] = v.y + gt[k + 1] * out[4 * i + 1];
      xs[4 * i + 2] = v.z + gt[k + 2] * out[4 * i + 2]; xs[4 * i + 3] = v.w + gt[k + 3] * out[4 * i + 3];
      ss += xs[4 * i] * xs[4 * i] + xs[4 * i + 1] * xs[4 * i + 1] + xs[4 * i + 2] * xs[4 * i + 2] + xs[4 * i + 3] * xs[4 * i + 3];
    }
    ss = wave_sum_u(ss);
    float rstd = rsqrtf(ss * (1.f / 1024.f) + 1e-6f);
#pragma unroll
    for (int i = 0; i < 4; ++i) {
      int k = lane * 16 + i * 4;
      float4 g4 = *(const float4*)(p.in[I_FG] + k);
      if (wr) *(float4*)(xo + (size_t)t * 1024 + k) = make_float4(xs[4 * i] * rstd * g4.x, xs[4 * i + 1] * rstd * g4.y, xs[4 * i + 2] * rstd * g4.z, xs[4 * i + 3] * rstd * g4.w);
    }
  }
}

#define XB_TMO      128
#define XB_XCNT(j)  (256  + 64 * (j))
#define XB_XSUB(j)  (1280 + 64 * (j))
#define XB_XGEN(j)  (2304 + 64 * (j))
#define XB_TOP      3328
#define XB_TOPGEN   3392
#define XCD_BAR_WORDS 3456
#define XB_SPIN_CAP (1u << 22)
#define LAS __attribute__((address_space(3)))
DEVI unsigned xb_ld(unsigned* p) { return __hip_atomic_load(p, __ATOMIC_RELAXED, __HIP_MEMORY_SCOPE_AGENT); }
DEVI unsigned xb_add(unsigned* p, unsigned v) { return __hip_atomic_fetch_add(p, v, __ATOMIC_RELAXED, __HIP_MEMORY_SCOPE_AGENT); }
DEVI unsigned xb_xcc_id() { return (unsigned)__builtin_amdgcn_s_getreg((3 << 11) | 20) & 0xFu; }
#define XB_SPIN(cond, bar) do { unsigned _sp = 0; while (cond) { __builtin_amdgcn_s_sleep(1); \
    if ((++_sp & 255u) == 0u) { if (xb_ld(&(bar)[XB_TMO])) break; if (_sp > XB_SPIN_CAP) { atomicAdd(&(bar)[XB_TMO], 1u); break; } } } } while (0)
struct XcdBarrier { unsigned* bar; unsigned x; volatile LAS unsigned* st; };
DEVI XcdBarrier xcd_barrier_post(unsigned* bar, volatile LAS unsigned* st) {
  XcdBarrier b; b.bar = bar; b.x = xb_xcc_id(); b.st = st;
  if (threadIdx.x == 0) st[2] = xb_add(&bar[XB_XCNT(b.x)], 1u);
  return b;
}
DEVI void xcd_barrier_complete(unsigned* bar, unsigned x, unsigned& nloc, unsigned& nx, unsigned& vidx) {
  const unsigned G = gridDim.x * gridDim.y * gridDim.z;
  unsigned sum, cnt, mine, below, sp = 0u;
  for (;;) {
    sum = 0u; cnt = 0u; mine = 0u; below = 0u;
#pragma unroll
    for (unsigned j = 0; j < 16; ++j) { const unsigned c = xb_ld(&bar[XB_XCNT(j)]); sum += c; cnt += (c > 0u) ? 1u : 0u; mine = (j == x) ? c : mine; below += (c > 0u && j < x) ? 1u : 0u; }
    if (sum == G) break;
    __builtin_amdgcn_s_sleep(1);
    if ((++sp & 255u) == 0u) { if (xb_ld(&bar[XB_TMO])) break; if (sp > XB_SPIN_CAP) { atomicAdd(&bar[XB_TMO], 1u); break; } }
  }
  nloc = mine > 0u ? mine : 1u; nx = cnt > 0u ? cnt : 1u; vidx = below;
}
DEVI void xcd_barrier(const XcdBarrier& b) {
  asm volatile("s_waitcnt vmcnt(0)" ::: "memory");
  __syncthreads();
  if (threadIdx.x == 0) {
    unsigned* bar = b.bar;
    __builtin_amdgcn_s_waitcnt(0);
    unsigned nloc = b.st[0], nx = b.st[1];
    if (nloc == 0u) { unsigned vidx; xcd_barrier_complete(bar, b.x, nloc, nx, vidx); b.st[0] = nloc; b.st[1] = nx; b.st[3] = vidx; }
    const unsigned old = xb_add(&bar[XB_XSUB(b.x)], 1u);
    const unsigned gen = old / nloc;
    if (old + 1u == (gen + 1u) * nloc) {
      __builtin_amdgcn_fence(__ATOMIC_RELEASE, "agent");
      asm volatile("s_waitcnt vmcnt(0)" ::: "memory");
      const unsigned og = xb_add(&bar[XB_TOP], 1u);
      const unsigned tg = og / nx;
      if (og + 1u == (tg + 1u) * nx) xb_add(&bar[XB_TOPGEN], 1u);
      else XB_SPIN(xb_ld(&bar[XB_TOPGEN]) == tg, bar);
      __builtin_amdgcn_fence(__ATOMIC_ACQUIRE, "agent");
      xb_add(&bar[XB_XGEN(b.x)], 1u);
      asm volatile("s_waitcnt vmcnt(0)" ::: "memory");
    } else {
      XB_SPIN(xb_ld(&bar[XB_XGEN(b.x)]) == gen, bar);
      __builtin_amdgcn_fence(__ATOMIC_ACQUIRE, "agent");
      asm volatile("s_waitcnt vmcnt(0)" ::: "memory");
    }
  }
  __syncthreads();
}

constexpr int NPHASE = 16;
DEVI XcdMap get_xm(int coop, const uint4& w) {
  XcdMap m;
  if (coop) { m.v = (int)w.w; m.nx = (int)w.y; m.slot = (int)w.z; m.slots = (int)w.x; }
  else { m.v = blockIdx.x & 7; m.nx = 8; m.slot = blockIdx.x >> 3; m.slots = gridDim.x >> 3; if (m.slots < 1) { m.slots = 1; } }
  return m;
}
__global__ void __launch_bounds__(256, 2) mk(Params p, int ph0, int ph1, int coop) {
  __shared__ __attribute__((aligned(16))) unsigned char smem[SMEM_BYTES];
  __shared__ uint4 xb_words;
  if (threadIdx.x == 0) xb_words = make_uint4(0u, 0u, 0u, 0u);
  __syncthreads();
  XcdBarrier xb;
  if (coop) xb = xcd_barrier_post((unsigned*)(p.ws + O_BAR), (volatile LAS unsigned*)&xb_words);
#ifdef XCC_PROBE
  if (coop && xb_xcc_id() != (blockIdx.x & 7u)) { unsigned long long t0 = wall_clock64(); while (wall_clock64() - t0 < 100000ull) __builtin_amdgcn_s_sleep(8); }
#endif
  if (ph0 < 0) cg::this_grid().sync();
#ifdef PROBE_A
#define STAMP(n) if (blockIdx.x == 0 && threadIdx.x == 0) ((unsigned long long*)(p.ws + O_STAMP))[n] = wall_clock64();
#else
#define STAMP(n)
#endif
#define RUN_PHASE(n, call)                                   \
  if (ph0 <= n && n < ph1) {                                 \
    STAMP(n)                                                 \
        if (DRY_PH == n) { if (n == 4) phase4<true>(p, smem); if (n == 5) phase5<true>(p, smem); if (n == 8) phase8<true>(p, smem); if (n == 15) phase15<true>(p, smem); } \
    if (ONLY < 0 || ONLY == n) { call; }                     \
    if (REPEAT_PH == n) { call; }                            \
    if (coop && n + 1 < ph1) xcd_barrier(xb);                \
  }
  RUN_PHASE(0, phase0(p, smem, 0, 96))
  RUN_PHASE(1, (phase1(p, smem), __syncthreads(), phase0(p, smem, 96, 1 << 30)))
  RUN_PHASE(2, phase2(p, smem, get_xm(coop, xb_words)))
  RUN_PHASE(3, phase3(p, smem))
  RUN_PHASE(4, (phase4<false>(p, smem), phase6(p, smem, 0, 32, gridDim.x > 290 ? 258 : 0, gridDim.x > 290 ? (int)gridDim.x - 258 : (int)gridDim.x)))
  RUN_PHASE(5, phase5<false>(p, smem))
  RUN_PHASE(6, phase6(p, smem, 32, 260 * 8, 0, (int)gridDim.x))
  RUN_PHASE(7, phase7(p))
  RUN_PHASE(8, phase8<false>(p, smem))
  RUN_PHASE(9, phase9(p))
  RUN_PHASE(10, phase10(p))
  RUN_PHASE(11, phase11(p, smem, get_xm(coop, xb_words)))
  RUN_PHASE(12, (phase12(p, smem, get_xm(coop, xb_words)), convert_fp8(p.in[I_PU], p.ws + R_UBF, (size_t)16384 * 64, 64.f)))
  RUN_PHASE(13, phase13(p, smem))
  RUN_PHASE(14, (phase14(p, smem, get_xm(coop, xb_words)), convert_fp8(p.in[I_PV], p.ws + R_VBF, (size_t)16384 * 64, 4.f)))
  RUN_PHASE(15, phase15<false>(p, smem))
#ifdef SYNC_EXTRA
  for (int i = 0; i < SYNC_EXTRA; ++i) xcd_barrier(xb);
#endif
#ifdef PROBE_A
  cg::this_grid().sync();
  STAMP(16)
  __syncthreads();
  if (blockIdx.x == 0) {
    const unsigned long long* st = (const unsigned long long*)(p.ws + O_STAMP);
    float ta = (float)(st[PROBE_A + 1] - st[PROBE_A]) * 0.01f, tb = (float)(st[PROBE_B + 1] - st[PROBE_B]) * 0.01f;
    for (int i = threadIdx.x; i < 1000000; i += 256) p.out[1 + i] = tb;
    if (threadIdx.x == 0) p.out[0] = 100.f * ta;
  }
#endif
}

extern "C" void kernel_launch(void* const* d_in, const int* in_sizes, int n_in, void* d_out, int out_size, void* d_ws,
                              size_t ws_size, hipStream_t stream) {
  static int grid_blocks = 0;
  if (!grid_blocks) {
    int dev = 0, cus = 0, per_cu = 0;
    hipGetDevice(&dev);
    hipDeviceGetAttribute(&cus, hipDeviceAttributeMultiprocessorCount, dev);
    hipOccupancyMaxActiveBlocksPerMultiprocessor(&per_cu, mk, 256, 0);
    if (per_cu < 1) per_cu = 1;
    if (per_cu > 2) per_cu = 2;
    grid_blocks = cus * per_cu;
  }
  if (ws_size < WS_NEED) { fprintf(stderr, "workspace too small: %zu < %zu\n", ws_size, (size_t)WS_NEED); return; }
  Params p{};
  for (int i = 0; i < 32; ++i) p.in[i] = (const float*)d_in[i];
  p.out = (float*)d_out;
  p.ws = (unsigned char*)d_ws;
#if MEGA
  (void)hipMemsetAsync((unsigned char*)d_ws + O_BAR, 0, XCD_BAR_WORDS * 4, stream);
  int ph0 = 0, ph1 = NPHASE, coop = 1;
  void* args[] = {&p, &ph0, &ph1, &coop};
  hipError_t e = hipLaunchCooperativeKernel((void*)mk, dim3(grid_blocks), dim3(256), args, 0, stream);
  if (e != hipSuccess) fprintf(stderr, "cooperative launch failed: %s (grid %d)\n", hipGetErrorString(e), grid_blocks);
#else
  for (int ph = 0; ph < NPHASE; ++ph) mk<<<grid_blocks, 256, 0, stream>>>(p, ph, ph + 1, 0);
#endif
}
```

```cpp
#include <hip/hip_runtime.h>
#include <hip/hip_cooperative_groups.h>
#include <cstdio>
#include <cstdint>
namespace cg = cooperative_groups;

#ifndef MEGA
#define MEGA 1
#endif
#ifndef ONLY
#define ONLY -1
#endif
#ifndef REPEAT_PH
#define REPEAT_PH -1
#endif
#ifndef DRY_PH
#define DRY_PH -1
#endif

typedef unsigned short bf16_t;
using bf16x8 = __attribute__((ext_vector_type(8))) short;
using f32x4 = __attribute__((ext_vector_type(4))) float;
using u32x4 = __attribute__((ext_vector_type(4))) unsigned;
#define DEVI __device__ __forceinline__

constexpr int T_CTX = 256, T_LAT = 16384, T_ALL = 16640;
constexpr int NIN = 5392, NP = 5376;
constexpr int NCH = 128, LCH = 130;
constexpr int SVH = 576;
constexpr int SMEM_BYTES = 71680;

enum { I_X = 0, I_C, I_CTX, I_CCTX, I_ADAW, I_ADAB, I_N1G, I_WIN, I_RCONV, I_RW0, I_RWUP, I_RA0, I_RAUP, I_RGUP,
       I_RKK, I_RKA, I_RRK, I_RLNW, I_RLNB, I_MCONV, I_MIB, I_MFB, I_MNG, I_WBA, I_WBB, I_WOUT, I_N2G, I_WQ,
       I_KEYS, I_PU, I_PV, I_FG };

struct Params { const float* in[32]; float* out; unsigned char* ws; };

constexpr size_t A256(size_t x) { return (x + 255) & ~(size_t)255; }
constexpr size_t O_MODP = 0;
constexpr size_t O_WBA = A256(O_MODP + (size_t)16 * 2 * 6144 * 4);
constexpr size_t O_WBB = A256(O_WBA + (size_t)1024 * 512 * 2);
constexpr size_t O_WOUT = A256(O_WBB + (size_t)1024 * 512 * 2);
constexpr size_t O_WQ = A256(O_WOUT + (size_t)1024 * 1024 * 2);
constexpr size_t O_KEYS = A256(O_WQ + (size_t)2048 * 1024 * 2);
constexpr size_t O_WUP = A256(O_KEYS + (size_t)16 * 128 * 128 * 2);
constexpr size_t O_AUP = A256(O_WUP + (size_t)1024 * 64 * 2);
constexpr size_t O_GUP = A256(O_AUP + (size_t)1024 * 64 * 2);
constexpr size_t O_BEND = A256(O_GUP + (size_t)512 * 128 * 2);
constexpr size_t O_MLOC = A256(O_BEND + (size_t)260 * 8 * 4);
constexpr size_t O_MST = A256(O_MLOC + (size_t)260 * 8 * 4);
constexpr size_t O_NT = A256(O_MST + (size_t)260 * 8 * 4);
constexpr size_t O_BONUS = A256(O_NT + (size_t)260 * 8 * 64 * 4);
constexpr size_t O_STAMP = A256(O_BONUS + (size_t)T_ALL * 16 * 4);
constexpr size_t O_BAR = A256(O_STAMP + 1024);
constexpr size_t O_PG = A256(O_BAR + 3456 * 4);
constexpr size_t O_PO = A256(O_PG + (size_t)T_LAT * 2048 * 2);
constexpr size_t O_R = A256(O_PO + (size_t)T_LAT * 512 * 2);
constexpr size_t R_HX = O_R;
constexpr size_t R_WIN = A256(R_HX + (size_t)T_ALL * 1024 * 2);
constexpr size_t R_PQK = A256(R_WIN + (size_t)(NP + 128) * 1024 * 2);
constexpr size_t R_PV = A256(R_PQK + (size_t)T_ALL * 512 * 2);
constexpr size_t R_GIF = A256(R_PV + (size_t)T_ALL * 512 * 2);
constexpr size_t R_U = A256(R_GIF + (size_t)T_ALL * 16 * 4);
constexpr size_t R_END1 = A256(R_U + (size_t)260 * 8 * 8192 * 4);
constexpr size_t R_SV = O_R;
constexpr size_t R_YA = A256(R_SV + (size_t)T_ALL * 8 * SVH * 2);
constexpr size_t R_END2 = A256(R_YA + (size_t)T_LAT * 512 * 2);
constexpr size_t R_MERGED = O_R;
constexpr size_t R_H2 = A256(R_MERGED + (size_t)T_LAT * 1024 * 2);
constexpr size_t R_TOPS = A256(R_H2 + (size_t)T_LAT * 1024 * 2);
constexpr size_t R_TOPI = A256(R_TOPS + (size_t)T_LAT * 256 * 4);
constexpr size_t R_UBF = A256(R_TOPI + (size_t)T_LAT * 256 * 4);
constexpr size_t R_VBF = A256(R_UBF + (size_t)16384 * 1024 * 2);
constexpr size_t R_END3 = A256(R_VBF + (size_t)16384 * 1024 * 2);
constexpr size_t WS_NEED = (R_END1 > R_END2 ? (R_END1 > R_END3 ? R_END1 : R_END3) : (R_END2 > R_END3 ? R_END2 : R_END3));
constexpr size_t OUT_BC = (size_t)NCH * 16 * 4096 * 4;

DEVI bf16_t f2bf(float f) { unsigned u = __float_as_uint(f); u += 0x7fffu + ((u >> 16) & 1u); return (bf16_t)(u >> 16); }
DEVI float bf2f(bf16_t h) { return __uint_as_float(((unsigned)h) << 16); }
DEVI float bflo(unsigned u) { return __uint_as_float(u << 16); }
DEVI float bfhi(unsigned u) { return __uint_as_float(u & 0xffff0000u); }
DEVI unsigned pack2(float a, float b) { return (unsigned)f2bf(a) | ((unsigned)f2bf(b) << 16); }
DEVI void unpack8(const uint4& u, float* f) {
  f[0] = bflo(u.x); f[1] = bfhi(u.x); f[2] = bflo(u.y); f[3] = bfhi(u.y);
  f[4] = bflo(u.z); f[5] = bfhi(u.z); f[6] = bflo(u.w); f[7] = bfhi(u.w);
}
DEVI uint4 pack8(const float* f) { return make_uint4(pack2(f[0], f[1]), pack2(f[2], f[3]), pack2(f[4], f[5]), pack2(f[6], f[7])); }
DEVI float wave_sum(float v) {
#pragma unroll
  for (int o = 32; o; o >>= 1) v += __shfl_xor(v, o);
  return v;
}
DEVI float wave_max(float v) {
#pragma unroll
  for (int o = 32; o; o >>= 1) v = fmaxf(v, __shfl_xor(v, o));
  return v;
}
DEVI float sigm(float x) { return 1.f / (1.f + __expf(-x)); }
DEVI float siluf(float x) { return x / (1.f + __expf(-x)); }
DEVI float logsig(float x) { return fminf(x, 0.f) - log1pf(expf(-fabsf(x))); }
template <int CTRL> DEVI float dppf(float v) { return __int_as_float(__builtin_amdgcn_update_dpp(0, __float_as_int(v), CTRL, 0xf, 0xf, true)); }
DEVI float rlf(float v, int l) { return __int_as_float(__builtin_amdgcn_readlane(__float_as_int(v), l)); }
DEVI float wave_sum_u(float v) {
  v += dppf<0xB1>(v); v += dppf<0x4E>(v); v += dppf<0x141>(v); v += dppf<0x140>(v);
  return (rlf(v, 0) + rlf(v, 16)) + (rlf(v, 32) + rlf(v, 48));
}
typedef __attribute__((ext_vector_type(2))) short s16x2;
DEVI float dot2bf(unsigned a, unsigned b, float c) { return __builtin_amdgcn_fdot2_f32_bf16(__builtin_bit_cast(s16x2, a), __builtin_bit_cast(s16x2, b), c, false); }
typedef __attribute__((ext_vector_type(2))) float f32x2;
DEVI void convert_fp8(const float* __restrict__ src, unsigned char* __restrict__ dst, size_t n16, float scale) {
  for (size_t g = (size_t)blockIdx.x * 256 + threadIdx.x; g < n16; g += (size_t)gridDim.x * 256) {
    u32x4 o;
#pragma unroll
    for (int q = 0; q < 4; ++q) {
      float4 a = *(const float4*)(src + g * 16 + q * 4);
      int pk = __builtin_amdgcn_cvt_pk_fp8_f32(a.x * scale, a.y * scale, 0, false);
      pk = __builtin_amdgcn_cvt_pk_fp8_f32(a.z * scale, a.w * scale, pk, true);
      o[q] = (unsigned)pk;
    }
    *(u32x4*)(dst + g * 16) = o;
  }
}
DEVI void unpack_fp8x16(const u32x4& u, float* f) {
#pragma unroll
  for (int q = 0; q < 4; ++q) {
    f32x2 lo = __builtin_amdgcn_cvt_pk_f32_fp8((int)u[q], false), hi = __builtin_amdgcn_cvt_pk_f32_fp8((int)u[q], true);
    f[4 * q] = lo[0]; f[4 * q + 1] = lo[1]; f[4 * q + 2] = hi[0]; f[4 * q + 3] = hi[1];
  }
}
DEVI void convert_bf16(const float* __restrict__ src, bf16_t* __restrict__ dst, size_t n8) {
  for (size_t g = (size_t)blockIdx.x * 256 + threadIdx.x; g < n8; g += (size_t)gridDim.x * 256) {
    float4 a = *(const float4*)(src + g * 8), b = *(const float4*)(src + g * 8 + 4);
    *(uint4*)(dst + g * 8) = make_uint4(pack2(a.x, a.y), pack2(a.z, a.w), pack2(b.x, b.y), pack2(b.z, b.w));
  }
}
DEVI float allred8(float v) { v += dppf<0xB1>(v); v += dppf<0x4E>(v); v += dppf<0x141>(v); return v; }

DEVI int ml_row(int c, int j) {
  if (c < 4) return c * 64 + j;
  int cc = c - 4; int col = cc >> 2; int gr = (cc & 3) * 64 + j;
  return T_CTX + gr * 64 + col;
}
DEVI int ml_sc(int c, int dir) { return dir == 0 ? c : (c < 4 ? 3 - c : 263 - c); }
DEVI int rw_row(int p, int dir) { return dir == 0 ? p : (p < T_CTX ? (T_CTX - 1 - p) : (T_ALL + T_CTX - 1 - p)); }

DEVI float mod_val(const Params& p, int which, int col) {
  return ((const float*)(p.ws + O_MODP))[which * 6144 + col];
}

DEVI void gemm_core(const bf16_t* __restrict__ A, int lda, const bf16_t* __restrict__ Bt, int ldb, int K,
                    f32x4 (&acc)[4][4], unsigned char* smem) {
  bf16_t(*sa)[80] = (bf16_t(*)[80])smem;
  bf16_t(*sb)[80] = (bf16_t(*)[80])(smem + 128 * 80 * 2);
  const int tid = threadIdx.x, lane = tid & 63, warp = tid >> 6, wm = warp >> 1, wn = warp & 1;
  const int lr = tid >> 3, lk = (tid & 7) * 8;
  const bf16_t* Ap = A + (size_t)lr * lda + lk;
  const bf16_t* Bp = Bt + (size_t)lr * ldb + lk;
  u32x4 ra0[4], rb0[4], ra1[4], rb1[4];
#pragma unroll
  for (int i = 0; i < 4; ++i) {
    ra0[i] = *(const u32x4*)(Ap + (size_t)(32 * i) * lda); rb0[i] = *(const u32x4*)(Bp + (size_t)(32 * i) * ldb);
    ra1[i] = *(const u32x4*)(Ap + (size_t)(32 * i) * lda + 64); rb1[i] = *(const u32x4*)(Bp + (size_t)(32 * i) * ldb + 64);
  }
#define GEMM_STEP(k0, ra, rb)                                                                                 \
  {                                                                                                           \
    __syncthreads();                                                                                          \
    _Pragma("unroll") for (int i = 0; i < 4; ++i) { *(u32x4*)&sa[lr + 32 * i][lk] = ra[i]; *(u32x4*)&sb[lr + 32 * i][lk] = rb[i]; } \
    __syncthreads();                                                                                          \
    if ((k0) + 128 < K) {                                                                                     \
      _Pragma("unroll") for (int i = 0; i < 4; ++i) {                                                         \
        ra[i] = *(const u32x4*)(Ap + (size_t)(32 * i) * lda + (k0) + 128);                                    \
        rb[i] = *(const u32x4*)(Bp + (size_t)(32 * i) * ldb + (k0) + 128);                                    \
      }                                                                                                       \
    }                                                                                                         \
    __builtin_amdgcn_s_setprio(1);                                                                            \
    _Pragma("unroll") for (int ks = 0; ks < 2; ++ks) {                                                        \
      bf16x8 af[4], bq[4];                                                                                    \
      _Pragma("unroll") for (int i = 0; i < 4; ++i) af[i] = *(const bf16x8*)&sa[wm * 64 + i * 16 + (lane & 15)][ks * 32 + (lane >> 4) * 8]; \
      _Pragma("unroll") for (int j = 0; j < 4; ++j) bq[j] = *(const bf16x8*)&sb[wn * 64 + j * 16 + (lane & 15)][ks * 32 + (lane >> 4) * 8]; \
      _Pragma("unroll") for (int i = 0; i < 4; ++i)                                                           \
        _Pragma("unroll") for (int j = 0; j < 4; ++j) acc[i][j] = __builtin_amdgcn_mfma_f32_16x16x32_bf16(bq[j], af[i], acc[i][j], 0, 0, 0); \
    }                                                                                                         \
    __builtin_amdgcn_s_setprio(0);                                                                            \
  }
  for (int k0 = 0; k0 < K; k0 += 128) {
    GEMM_STEP(k0, ra0, rb0)
    GEMM_STEP(k0 + 64, ra1, rb1)
  }
#undef GEMM_STEP
  __syncthreads();
}
DEVI void zero_acc(f32x4 (&acc)[4][4]) {
#pragma unroll
  for (int i = 0; i < 4; ++i)
#pragma unroll
    for (int j = 0; j < 4; ++j) acc[i][j] = f32x4{0.f, 0.f, 0.f, 0.f};
}

struct XcdMap { int v, nx, slot, slots; };
template <typename F> DEVI void for_tiles_xcd(const XcdMap& xm, int MT, int NT, int SM, int SN, F&& f) {
  const int nsn = (NT + SN - 1) / SN, nst = ((MT + SM - 1) / SM) * nsn, per = SM * SN;
  const int n_my = (nst - xm.v + xm.nx - 1) / xm.nx;
  for (int g = xm.slot; g < n_my * per; g += xm.slots) {
    const int s = xm.v + (g / per) * xm.nx, idx = g % per;
    const int sm = s / nsn, sn = s % nsn;
    const int mt = sm * SM + idx / SN, nt = sn * SN + idx % SN;
    if (mt < MT && nt < NT) f(mt, nt);
  }
}

DEVI void tr_tile(const float* __restrict__ src, int lds, int k0, int n0src, bf16_t* __restrict__ dst, int ldd, int n0dst,
                  unsigned char* smem) {
  float(*tile)[65] = (float(*)[65])smem;
  const int tid = threadIdx.x, j = tid & 63, i0 = tid >> 6;
#pragma unroll 4
  for (int ii = 0; ii < 16; ++ii) { int i = i0 + 4 * ii; tile[i][j] = src[(size_t)(k0 + i) * lds + n0src + j]; }
  __syncthreads();
#pragma unroll 4
  for (int jj = 0; jj < 16; ++jj) { int jn = i0 + 4 * jj; dst[(size_t)(n0dst + jn) * ldd + k0 + j] = f2bf(tile[j][jn]); }
  __syncthreads();
}

DEVI void phase0(const Params& p, unsigned char* smem, int it_lo, int it_hi) {
  const int tid = threadIdx.x;
  constexpr int N_MOD = 96, N_WIN = 16 * 85, N_WB = 128, N_WOUT = 256, N_WQ = 512, N_LORA = 16, N_GUP = 16, N_KEYS = 128;
  constexpr int E0 = N_MOD, E1 = E0 + N_WIN, E2 = E1 + N_WB, E3 = E2 + N_WB, E4 = E3 + N_WOUT, E5 = E4 + N_WQ,
                E6 = E5 + N_LORA, E7 = E6 + N_LORA, E8 = E7 + N_GUP, E9 = E8 + N_KEYS;
  if (it_hi > E9) it_hi = E9;
  for (int it = it_lo + blockIdx.x; it < it_hi; it += gridDim.x) {
    if (it < E0) {
      float* sl = (float*)smem;
      float* part = sl + 2048;
      __syncthreads();
      for (int i = tid; i < 2048; i += 256) sl[i] = siluf(i < 1024 ? p.in[I_C][i] : p.in[I_CCTX][i - 1024]);
      __syncthreads();
      const int cl = tid & 63, rg = tid >> 6, col = it * 64 + cl;
      const float* aw = p.in[I_ADAW] + (size_t)(rg * 256) * 6144 + col;
      float ax = 0.f, ac = 0.f;
#pragma unroll 32
      for (int r = 0; r < 256; ++r) {
        const float w = aw[(size_t)r * 6144];
        ax += sl[rg * 256 + r] * w;
        ac += sl[1024 + rg * 256 + r] * w;
      }
      part[(rg * 2 + 0) * 64 + cl] = ax;
      part[(rg * 2 + 1) * 64 + cl] = ac;
      __syncthreads();
      if (tid < 128) {
        const int which = tid >> 6;
        const float v = part[(0 * 2 + which) * 64 + cl] + part[(1 * 2 + which) * 64 + cl] + part[(2 * 2 + which) * 64 + cl] + part[(3 * 2 + which) * 64 + cl];
        ((float*)(p.ws + O_MODP))[which * 6144 + col] = v + p.in[I_ADAB][col];
      }
    } else if (it < E1) {
      int t = it - E0; int kt = t / 85, nt = t % 85; int n0 = nt * 64;
      tr_tile(p.in[I_WIN], NIN, kt * 64, nt == 84 ? 2816 : (n0 < 2816 ? n0 : n0 + 16), (bf16_t*)(p.ws + R_WIN), 1024, n0, smem);
    } else if (it < E2) {
      int t = it - E1; tr_tile(p.in[I_WBA], 1024, (t / 16) * 64, (t % 16) * 64, (bf16_t*)(p.ws + O_WBA), 512, (t % 16) * 64, smem);
    } else if (it < E3) {
      int t = it - E2; tr_tile(p.in[I_WBB], 1024, (t / 16) * 64, (t % 16) * 64, (bf16_t*)(p.ws + O_WBB), 512, (t % 16) * 64, smem);
    } else if (it < E4) {
      int t = it - E3; tr_tile(p.in[I_WOUT], 1024, (t / 16) * 64, (t % 16) * 64, (bf16_t*)(p.ws + O_WOUT), 1024, (t % 16) * 64, smem);
    } else if (it < E5) {
      int t = it - E4; tr_tile(p.in[I_WQ], 2048, (t / 32) * 64, (t % 32) * 64, (bf16_t*)(p.ws + O_WQ), 1024, (t % 32) * 64, smem);
    } else if (it < E6) {
      int t = it - E5; int dir = t / 8, nt = t % 8;
      tr_tile(p.in[I_RWUP] + (size_t)dir * 64 * 512, 512, 0, nt * 64, (bf16_t*)(p.ws + O_WUP) + (size_t)dir * 512 * 64, 64, nt * 64, smem);
    } else if (it < E7) {
      int t = it - E6; int dir = t / 8, nt = t % 8;
      tr_tile(p.in[I_RAUP] + (size_t)dir * 64 * 512, 512, 0, nt * 64, (bf16_t*)(p.ws + O_AUP) + (size_t)dir * 512 * 64, 64, nt * 64, smem);
    } else if (it < E8) {
      int t = it - E7; tr_tile(p.in[I_RGUP], 512, (t / 8) * 64, (t % 8) * 64, (bf16_t*)(p.ws + O_GUP), 128, (t % 8) * 64, smem);
    } else {
      int t = it - E8; size_t base = (size_t)t * 2048 + tid * 8;
      const float* s = p.in[I_KEYS] + base;
      float f[8];
      float4 a = *(const float4*)s, b = *(const float4*)(s + 4);
      f[0] = a.x; f[1] = a.y; f[2] = a.z; f[3] = a.w; f[4] = b.x; f[5] = b.y; f[6] = b.z; f[7] = b.w;
      *(uint4*)((bf16_t*)(p.ws + O_KEYS) + base) = pack8(f);
    }
  }
}

DEVI void phase1(const Params& p, unsigned char* smem) {
  float* smod = (float*)smem;
  const int tid = threadIdx.x, lane = tid & 63, warp = tid >> 6;
  for (int i = tid; i < 4096; i += 256) { int which = i >> 10; smod[i] = mod_val(p, which >> 1, (which & 1) * 1024 + (i & 1023)); }
  __syncthreads();
  bf16_t* hx = (bf16_t*)(p.ws + R_HX);
  float* gif = (float*)(p.ws + R_GIF);
  const float* win = p.in[I_WIN];
  constexpr int RPW = 4;
  for (int rg = blockIdx.x * 4 + warp; rg < T_ALL / RPW; rg += gridDim.x * 4) {
    const int row0 = rg * RPW;
    const float* sh = smod + (row0 < T_CTX ? 2048 : 0);
    const float* sc = sh + 1024;
    const float* src0 = row0 < T_CTX ? p.in[I_CTX] + (size_t)row0 * 1024 : p.in[I_X] + (size_t)(row0 - T_CTX) * 1024;
    float rstd[RPW]; f32x4 xv[RPW][4];
#pragma unroll
    for (int r = 0; r < RPW; ++r) {
      float ss = 0.f;
#pragma unroll
      for (int i = 0; i < 4; ++i) {
        const f32x4 v = *(const f32x4*)(src0 + (size_t)r * 1024 + i * 256 + lane * 4);
        xv[r][i] = v;
        ss += v[0] * v[0] + v[1] * v[1] + v[2] * v[2] + v[3] * v[3];
      }
      ss = wave_sum_u(ss);
      rstd[r] = rsqrtf(ss * (1.f / 1024.f) + 1e-6f);
    }
#pragma unroll
    for (int i = 0; i < 4; ++i) {
      const int k0 = i * 256 + lane * 4;
      const float4 gk = *(const float4*)(p.in[I_N1G] + k0);
      const float4 s4 = *(const float4*)(sc + k0), h4 = *(const float4*)(sh + k0);
#pragma unroll
      for (int r = 0; r < RPW; ++r) {
        const f32x4 v = xv[r][i];
        const float y0 = v[0] * rstd[r] * gk.x * (1.f + s4.x) + h4.x, y1 = v[1] * rstd[r] * gk.y * (1.f + s4.y) + h4.y;
        const float y2 = v[2] * rstd[r] * gk.z * (1.f + s4.z) + h4.z, y3 = v[3] * rstd[r] * gk.w * (1.f + s4.w) + h4.w;
        *(uint2*)(hx + (size_t)(row0 + r) * 1024 + k0) = make_uint2(pack2(y0, y1), pack2(y2, y3));
      }
    }
  }
}

DEVI void phase2(const Params& p, unsigned char* smem, const XcdMap& xm) {
  const int lane = threadIdx.x & 63, warp = threadIdx.x >> 6, wm = warp >> 1, wn = warp & 1;
  const bf16_t* hx = (const bf16_t*)(p.ws + R_HX);
  const bf16_t* wt = (const bf16_t*)(p.ws + R_WIN);
  bf16_t* prw = (bf16_t*)p.out;
  bf16_t* pqk = (bf16_t*)(p.ws + R_PQK);
  bf16_t* pv = (bf16_t*)(p.ws + R_PV);
  bf16_t* po = (bf16_t*)(p.ws + O_PO);
  bf16_t* pg = (bf16_t*)(p.ws + O_PG);
  for_tiles_xcd(xm, 130, 43, 5, 6, [&](int mt, int nt) {
    if (mt < 2 && nt >= 22 && nt < 42) return;
    f32x4 acc[4][4];
    zero_acc(acc);
    gemm_core(hx + (size_t)mt * 128 * 1024, 1024, wt + (size_t)nt * 128 * 1024, 1024, 1024, acc, smem);
    if (nt == 42) {
      float* gif = (float*)(p.ws + R_GIF);
      if (wn == 0) {
#pragma unroll
        for (int i = 0; i < 4; ++i) {
          const int row = mt * 128 + wm * 64 + i * 16 + (lane & 15);
          *(float4*)(gif + (size_t)row * 16 + (lane >> 4) * 4) = make_float4(acc[i][0][0], acc[i][0][1], acc[i][0][2], acc[i][0][3]);
        }
      }
      return;
    }
    bf16_t* dst; int ld, nb; int rofs = 0; bool sg = false;
    if (nt < 14) { dst = prw; ld = 1792; nb = nt * 128; }
    else if (nt < 18) { dst = pqk; ld = 512; nb = (nt - 14) * 128; }
    else if (nt < 22) { dst = pv; ld = 512; nb = (nt - 18) * 128; }
    else if (nt < 26) { dst = po; ld = 512; nb = (nt - 22) * 128; rofs = T_CTX; }
    else { dst = pg; ld = 2048; nb = (nt - 26) * 128; rofs = T_CTX; sg = true; }
    bf16_t(*Ct)[136] = (bf16_t(*)[136])smem;
#pragma unroll
    for (int i = 0; i < 4; ++i) {
#pragma unroll
      for (int j = 0; j < 4; ++j) {
        f32x4 v = acc[i][j];
        if (sg) { v[0] = sigm(v[0]); v[1] = sigm(v[1]); v[2] = sigm(v[2]); v[3] = sigm(v[3]); }
        *(uint2*)&Ct[wm * 64 + i * 16 + (lane & 15)][wn * 64 + j * 16 + (lane >> 4) * 4] = make_uint2(pack2(v[0], v[1]), pack2(v[2], v[3]));
      }
    }
    __syncthreads();
#pragma unroll
    for (int q = 0; q < 8; ++q) {
      const int pc = threadIdx.x + 256 * q; const int r = pc >> 4, c8 = (pc & 15) * 8;
      const int row = mt * 128 + r - rofs;
      *(u32x4*)(dst + (size_t)row * ld + nb + c8) = *(const u32x4*)&Ct[r][c8];
    }
    __syncthreads();
  });
}

DEVI void ml_qk8(const Params& p, int c, int j, int chan, float* o) {
  const bf16_t* pqk = (const bf16_t*)(p.ws + R_PQK);
  int row = ml_row(c, j);
  bool hp, hn; int rp, rn;
  if (c < 4) { hp = row > 0; hn = row < T_CTX - 1; rp = row - 1; rn = row + 1; }
  else { int gr = ((c - 4) & 3) * 64 + j; hp = gr > 0; hn = gr < 255; rp = row - 64; rn = row + 64; }
  const float* cw = p.in[I_MCONV];
  float cur[8], pr[8], nx[8];
  unpack8(*(const uint4*)(pqk + (size_t)row * 512 + chan), cur);
  if (hp) unpack8(*(const uint4*)(pqk + (size_t)rp * 512 + chan), pr);
  if (hn) unpack8(*(const uint4*)(pqk + (size_t)rn * 512 + chan), nx);
#pragma unroll
  for (int e = 0; e < 8; ++e) {
    float v = cw[512 + chan + e] * cur[e];
    if (hp) v += cw[chan + e] * pr[e];
    if (hn) v += cw[1024 + chan + e] * nx[e];
    o[e] = siluf(v);
  }
}

DEVI void phase3(const Params& p, unsigned char* smem) {
  bf16_t(*KT)[72] = (bf16_t(*)[72])smem;
  bf16_t(*VwT)[72] = (bf16_t(*)[72])(smem + 64 * 72 * 2);
  float* wgt = (float*)(smem + 64 * 72 * 2 + 256 * 72 * 2);
  const int tid = threadIdx.x, lane = tid & 63, warp = tid >> 6;
  const float* gif = (const float*)(p.ws + R_GIF);
  const bf16_t* pv = (const bf16_t*)(p.ws + R_PV);
  float* U = (float*)(p.ws + R_U);
  float* NT = (float*)(p.ws + O_NT);
  float* bend = (float*)(p.ws + O_BEND);
  float* mloc = (float*)(p.ws + O_MLOC);
  for (int it = blockIdx.x; it < 260 * 4; it += gridDim.x) {
    int c = it >> 2, h = it & 3;
    if (warp < 2) {
      int dir = warp; int j = dir ? 63 - lane : lane;
      int row = ml_row(c, j);
      float ig = gif[(size_t)row * 16 + dir * 4 + h] + p.in[I_MIB][dir * 4 + h];
      float lf = logsig(gif[(size_t)row * 16 + 8 + dir * 4 + h] + p.in[I_MFB][dir * 4 + h]);
      float b = lf;
#pragma unroll
      for (int o = 1; o < 64; o <<= 1) { float t = __shfl_up(b, o); if (lane >= o) b += t; }
      float be = __shfl(b, 63);
      float ge = be - b + ig;
      float ml = wave_max(ge);
      wgt[dir * 64 + j] = expf(ge - ml);
      if (lane == 0) { int sc = ml_sc(c, dir); bend[sc * 8 + dir * 4 + h] = be; mloc[sc * 8 + dir * 4 + h] = ml; }
    }
    __syncthreads();
    {
      int j = tid >> 2, part = tid & 3;
      float f[8];
#pragma unroll
      for (int q = 0; q < 2; ++q) {
        int d0 = part * 16 + q * 8;
        ml_qk8(p, c, j, 256 + h * 64 + d0, f);
#pragma unroll
        for (int e = 0; e < 8; ++e) KT[d0 + e][j] = f2bf(f[e] * 0.125f);
      }
      int row = ml_row(c, j);
      float w0 = wgt[j], w1 = wgt[64 + j];
#pragma unroll
      for (int q = 0; q < 4; ++q) {
        int v0 = part * 32 + q * 8;
        unpack8(*(const uint4*)(pv + (size_t)row * 512 + h * 128 + v0), f);
#pragma unroll
        for (int e = 0; e < 8; ++e) { VwT[v0 + e][j] = f2bf(f[e] * w0); VwT[128 + v0 + e][j] = f2bf(f[e] * w1); }
      }
    }
    __syncthreads();
#pragma unroll
    for (int dir = 0; dir < 2; ++dir) {
      int sc = ml_sc(c, dir);
      float* Ud = U + ((size_t)sc * 8 + dir * 4 + h) * 8192;
#pragma unroll
      for (int vi = 0; vi < 2; ++vi) {
        int vt = warp * 2 + vi;
        bf16x8 bv[2];
#pragma unroll
        for (int ks = 0; ks < 2; ++ks) bv[ks] = *(const bf16x8*)&VwT[dir * 128 + vt * 16 + (lane & 15)][ks * 32 + (lane >> 4) * 8];
#pragma unroll
        for (int dt = 0; dt < 4; ++dt) {
          f32x4 a = {0.f, 0.f, 0.f, 0.f};
#pragma unroll
          for (int ks = 0; ks < 2; ++ks) {
            bf16x8 ak = *(const bf16x8*)&KT[dt * 16 + (lane & 15)][ks * 32 + (lane >> 4) * 8];
            a = __builtin_amdgcn_mfma_f32_16x16x32_bf16(ak, bv[ks], a, 0, 0, 0);
          }
          *(float4*)(Ud + (size_t)(vt * 16 + (lane & 15)) * 64 + dt * 16 + (lane >> 4) * 4) = make_float4(a[0], a[1], a[2], a[3]);
        }
      }
    }
    if (tid < 128) {
      int dir = tid >> 6, d = tid & 63; float s = 0.f;
      for (int j = 0; j < 64; ++j) s += wgt[dir * 64 + j] * bf2f(KT[d][j]);
      NT[((size_t)ml_sc(c, dir) * 8 + dir * 4 + h) * 64 + d] = s;
    }
    __syncthreads();
  }
}

template <bool DRY> DEVI void phase4(const Params& p, unsigned char* smem) {
  const bool wr = !DRY || (p.in[I_FG][0] == 1234.5f);
  float* U = (float*)(p.ws + R_U);
  float* NT = (float*)(p.ws + O_NT);
  const float* bend = (const float*)(p.ws + O_BEND);
  const float* mloc = (const float*)(p.ws + O_MLOC);
  float* mst = (float*)(p.ws + O_MST);
  float(*kp)[264] = (float(*)[264])smem;
  float(*sp)[264] = (float(*)[264])(smem + 2 * 264 * 4);
  const int tid = threadIdx.x, lane = tid & 63, warp = tid >> 6;
  for (int gb = blockIdx.x * 256; gb < 8 * 8256; gb += gridDim.x * 256) {
    const int pA = gb / 8256;
    if (warp < 2) {
      const int pw = pA + warp;
      if (pw < 8) {
        float be[5], ml[5], B[5], m[5];
        float run = 0.f;
#pragma unroll
        for (int k = 0; k < 5; ++k) {
          const int c = lane * 5 + k;
          be[k] = c < 260 ? bend[c * 8 + pw] : 0.f;
          ml[k] = c < 260 ? mloc[c * 8 + pw] : -INFINITY;
          run += be[k]; B[k] = run;
        }
        float incl = run;
#pragma unroll
        for (int o = 1; o < 64; o <<= 1) { float t = __shfl_up(incl, o); if (lane >= o) incl += t; }
        const float off = incl - run;
        float pm = -INFINITY, pml[5];
#pragma unroll
        for (int k = 0; k < 5; ++k) { B[k] += off; pm = fmaxf(pm, ml[k] - B[k]); pml[k] = pm; }
        float inclm = pm;
#pragma unroll
        for (int o = 1; o < 64; o <<= 1) { float t = __shfl_up(inclm, o); if (lane >= o) inclm = fmaxf(inclm, t); }
        float offm = __shfl_up(inclm, 1); if (lane == 0) offm = -INFINITY;
#pragma unroll
        for (int k = 0; k < 5; ++k) m[k] = B[k] + fmaxf(0.f, fmaxf(offm, pml[k]));
        float mprev = __shfl_up(m[4], 1); if (lane == 0) mprev = 0.f;
        const bool owner = gb <= pw * 8256 && pw * 8256 < gb + 256;
#pragma unroll
        for (int k = 0; k < 5; ++k) {
          const int c = lane * 5 + k;
          if (c < 260) {
            kp[warp][c] = expf(be[k] + mprev - m[k]);
            sp[warp][c] = expf(ml[k] - m[k]);
            if (wr && owner) mst[c * 8 + pw] = mprev;
          }
          mprev = m[k];
        }
      }
    }
    __syncthreads();
    const int g = gb + tid;
    if (g < 8 * 8256) {
      const int pr = g / 8256, e = g % 8256, slot = pr - pA;
      float* base; size_t stride;
      if (e < 8192) { base = U + (size_t)pr * 8192 + e; stride = 8 * 8192; }
      else { base = NT + (size_t)pr * 64 + (e - 8192); stride = 8 * 64; }
      float C = 0.f;
      for (int sc = 0; sc < 260; sc += 20) {
        float u[20];
#pragma unroll
        for (int q = 0; q < 20; ++q) u[q] = base[(size_t)(sc + q) * stride];
#pragma unroll
        for (int q = 0; q < 20; ++q) {
          if (wr) base[(size_t)(sc + q) * stride] = C;
          C = kp[slot][sc + q] * C + sp[slot][sc + q] * u[q];
        }
      }
    }
    __syncthreads();
  }
}

template <bool DRY> DEVI void phase5(const Params& p, unsigned char* smem) {
  const bool wr = !DRY || (p.in[I_FG][0] == 1234.5f);
  bf16_t(*Qs)[72] = (bf16_t(*)[72])smem;
  bf16_t(*Ks)[72] = (bf16_t(*)[72])(smem + 9216);
  bf16_t(*Pm)[72] = (bf16_t(*)[72])(smem + 2 * 9216);
  bf16_t(*VT)[72] = (bf16_t(*)[72])(smem + 3 * 9216);
  float* evec = (float*)(smem + 3 * 9216 + 144 * 72 * 2);
  float* Mvec = evec + 128;
  float* bvec = Mvec + 128;
  const int tid = threadIdx.x, lane = tid & 63, warp = tid >> 6;
  const float* gif = (const float*)(p.ws + R_GIF);
  const bf16_t* pv = (const bf16_t*)(p.ws + R_PV);
  const bf16_t* po = (const bf16_t*)(p.ws + O_PO);
  bf16_t* yb = (bf16_t*)(p.ws + R_YA);
  const float* U = (const float*)(p.ws + R_U);
  const float* NT = (const float*)(p.ws + O_NT);
  const float* mst = (const float*)(p.ws + O_MST);
  for (int it = blockIdx.x; it < 256 * 4; it += gridDim.x) {
    int c = 4 + (it >> 2), h = it & 3;
    if (warp < 2) {
      int dir = warp; int j = dir ? 63 - lane : lane;
      int row = ml_row(c, j);
      float ig = gif[(size_t)row * 16 + dir * 4 + h] + p.in[I_MIB][dir * 4 + h];
      float lf = logsig(gif[(size_t)row * 16 + 8 + dir * 4 + h] + p.in[I_MFB][dir * 4 + h]);
      float b = lf;
#pragma unroll
      for (int o = 1; o < 64; o <<= 1) { float t = __shfl_up(b, o); if (lane >= o) b += t; }
      float e = ig - b;
      float pm = e;
#pragma unroll
      for (int o = 1; o < 64; o <<= 1) { float t = __shfl_up(pm, o); if (lane >= o) pm = fmaxf(pm, t); }
      float m0 = mst[ml_sc(c, dir) * 8 + dir * 4 + h];
      evec[dir * 64 + j] = e; Mvec[dir * 64 + j] = fmaxf(m0, pm); bvec[dir * 64 + j] = b;
    }
    {
      int j = tid >> 2, part = tid & 3;
      float f[8];
#pragma unroll
      for (int q = 0; q < 2; ++q) {
        int d0 = part * 16 + q * 8;
        ml_qk8(p, c, j, h * 64 + d0, f);
        *(uint4*)&Qs[j][d0] = pack8(f);
        ml_qk8(p, c, j, 256 + h * 64 + d0, f);
#pragma unroll
        for (int e = 0; e < 8; ++e) f[e] *= 0.125f;
        *(uint4*)&Ks[j][d0] = pack8(f);
      }
      int row = ml_row(c, j);
#pragma unroll
      for (int q = 0; q < 4; ++q) {
        int v0 = part * 32 + q * 8;
        unpack8(*(const uint4*)(pv + (size_t)row * 512 + h * 128 + v0), f);
#pragma unroll
        for (int e = 0; e < 8; ++e) VT[v0 + e][j] = f2bf(f[e]);
      }
      for (int i = tid; i < 16 * 64; i += 256) VT[128 + (i >> 6)][i & 63] = (i < 64) ? (bf16_t)0x3f80 : (bf16_t)0;
    }
    __syncthreads();
    const int jl = warp * 16 + (lane & 15);
    f32x4 s0[4];
    bf16x8 qf[2];
#pragma unroll
    for (int ks = 0; ks < 2; ++ks) qf[ks] = *(const bf16x8*)&Qs[jl][ks * 32 + (lane >> 4) * 8];
#pragma unroll
    for (int st = 0; st < 4; ++st) {
      f32x4 a = {0.f, 0.f, 0.f, 0.f};
#pragma unroll
      for (int ks = 0; ks < 2; ++ks) {
        bf16x8 kf = *(const bf16x8*)&Ks[st * 16 + (lane & 15)][ks * 32 + (lane >> 4) * 8];
        a = __builtin_amdgcn_mfma_f32_16x16x32_bf16(kf, qf[ks], a, 0, 0, 0);
      }
      s0[st] = a;
    }
    f32x4 ysum[8];
#pragma unroll
    for (int vt = 0; vt < 8; ++vt) ysum[vt] = f32x4{0.f, 0.f, 0.f, 0.f};
#pragma unroll 2
    for (int dir = 0; dir < 2; ++dir) {
      float Mj = Mvec[dir * 64 + jl], bj = bvec[dir * 64 + jl];
      float m0 = mst[ml_sc(c, dir) * 8 + dir * 4 + h];
#pragma unroll
      for (int st = 0; st < 4; ++st) {
        float pvv[4];
#pragma unroll
        for (int r = 0; r < 4; ++r) {
          int s = st * 16 + (lane >> 4) * 4 + r;
          bool ok = dir == 0 ? (s <= jl) : (s >= jl);
          pvv[r] = ok ? s0[st][r] * expf(evec[dir * 64 + s] - Mj) : 0.f;
        }
        *(uint2*)&Pm[jl][st * 16 + (lane >> 4) * 4] = make_uint2(pack2(pvv[0], pvv[1]), pack2(pvv[2], pvv[3]));
      }
      __syncthreads();
      bf16x8 pf[2];
#pragma unroll
      for (int ks = 0; ks < 2; ++ks) pf[ks] = *(const bf16x8*)&Pm[jl][ks * 32 + (lane >> 4) * 8];
      const float* Cst = U + ((size_t)ml_sc(c, dir) * 8 + dir * 4 + h) * 8192;
      const float* nst = NT + ((size_t)ml_sc(c, dir) * 8 + dir * 4 + h) * 64;
      float ai = expf(m0 - Mj);
      f32x4 hh[9];
#pragma unroll
      for (int vt = 0; vt < 9; ++vt) {
        f32x4 a1 = {0.f, 0.f, 0.f, 0.f}, a2 = {0.f, 0.f, 0.f, 0.f};
#pragma unroll
        for (int ks = 0; ks < 2; ++ks) {
          bf16x8 vf = *(const bf16x8*)&VT[vt * 16 + (lane & 15)][ks * 32 + (lane >> 4) * 8];
          a1 = __builtin_amdgcn_mfma_f32_16x16x32_bf16(vf, pf[ks], a1, 0, 0, 0);
          int v = vt * 16 + (lane & 15);
          const float* cp = v < 128 ? Cst + (size_t)v * 64 + ks * 32 + (lane >> 4) * 8 : nst + ks * 32 + (lane >> 4) * 8;
          float cf[8];
          if (v <= 128) {
            float4 x0 = *(const float4*)cp, x1 = *(const float4*)(cp + 4);
            cf[0] = x0.x; cf[1] = x0.y; cf[2] = x0.z; cf[3] = x0.w; cf[4] = x1.x; cf[5] = x1.y; cf[6] = x1.z; cf[7] = x1.w;
          } else {
#pragma unroll
            for (int e = 0; e < 8; ++e) cf[e] = 0.f;
          }
          uint4 pk = pack8(cf);
          bf16x8 cfr;
          cfr[0] = (short)(pk.x & 0xffff); cfr[1] = (short)(pk.x >> 16); cfr[2] = (short)(pk.y & 0xffff); cfr[3] = (short)(pk.y >> 16);
          cfr[4] = (short)(pk.z & 0xffff); cfr[5] = (short)(pk.z >> 16); cfr[6] = (short)(pk.w & 0xffff); cfr[7] = (short)(pk.w >> 16);
          a2 = __builtin_amdgcn_mfma_f32_16x16x32_bf16(cfr, qf[ks], a2, 0, 0, 0);
        }
#pragma unroll
        for (int r = 0; r < 4; ++r) hh[vt][r] = a1[r] + ai * a2[r];
      }
      float den = __shfl(hh[8][0], lane & 15);
      float dn = fmaxf(fabsf(den), expf(-(bj + Mj)));
      float inv = 1.f / dn;
      float ss = 0.f;
#pragma unroll
      for (int vt = 0; vt < 8; ++vt)
#pragma unroll
        for (int r = 0; r < 4; ++r) { float x = hh[vt][r] * inv; hh[vt][r] = x; ss += x * x; }
      ss += __shfl_xor(ss, 16); ss += __shfl_xor(ss, 32);
      float rs = rsqrtf(ss * (1.f / 128.f) + 1e-6f);
#pragma unroll
      for (int vt = 0; vt < 8; ++vt)
#pragma unroll
        for (int r = 0; r < 4; ++r) ysum[vt][r] += hh[vt][r] * rs * p.in[I_MNG][h * 128 + vt * 16 + (lane >> 4) * 4 + r];
      __syncthreads();
    }
    {
      int row = ml_row(c, jl) - T_CTX;
#pragma unroll
      for (int vt = 0; vt < 8; ++vt) {
        const bf16_t* op = po + (size_t)row * 512 + h * 128 + vt * 16 + (lane >> 4) * 4;
        uint2 o = *(const uint2*)op;
        float y0 = ysum[vt][0] * sigm(bflo(o.x)), y1 = ysum[vt][1] * sigm(bfhi(o.x)), y2 = ysum[vt][2] * sigm(bflo(o.y)), y3 = ysum[vt][3] * sigm(bfhi(o.y));
        if (wr) *(uint2*)(yb + (size_t)row * 512 + h * 128 + vt * 16 + (lane >> 4) * 4) = make_uint2(pack2(y0, y1), pack2(y2, y3));
      }
    }
    __syncthreads();
  }
}

DEVI void phase6(const Params& p, unsigned char* smem, int item_lo, int item_hi, int blk0, int nblk) {
  float(*rs)[65] = (float(*)[65])smem;
  float(*ks)[65] = (float(*)[65])(smem + 64 * 65 * 4);
  bf16_t(*TW)[72] = (bf16_t(*)[72])(smem + 2 * 64 * 65 * 4);
  bf16_t(*TA)[72] = (bf16_t(*)[72])(smem + 2 * 64 * 65 * 4 + 9216);
  bf16_t(*TG)[136] = (bf16_t(*)[136])(smem + 2 * 64 * 65 * 4 + 2 * 9216);
  float* rn = (float*)(smem + 2 * 64 * 65 * 4 + 2 * 9216 + 64 * 136 * 2);
  const int tid = threadIdx.x, lane = tid & 63, warp = tid >> 6;
  const bf16_t* prw = (const bf16_t*)p.out;
  bf16_t* SV = (bf16_t*)(p.ws + R_SV);
  float* bonus = (float*)(p.ws + O_BONUS);
  const float* cw = p.in[I_RCONV];
  const bf16_t* WUP = (const bf16_t*)(p.ws + O_WUP);
  const bf16_t* AUP = (const bf16_t*)(p.ws + O_AUP);
  const bf16_t* GUP = (const bf16_t*)(p.ws + O_GUP);
  if ((int)blockIdx.x < blk0) return;
  for (int it = item_lo + ((int)blockIdx.x - blk0); it < item_hi; it += nblk) {
    int tile = it >> 3, head = it & 7;
    int row0 = tile * 64;
    int seg0 = tile < 4 ? 0 : row0, seg1 = tile < 4 ? T_CTX : row0 + 64;
#pragma unroll 1
    for (int ub = 0; ub < 2; ++ub) {
      u32x4 lc[7], lp[7], ln[7];
#pragma unroll
      for (int it7 = 0; it7 < 7; ++it7) {
        const int u = warp + 4 * (ub * 7 + it7);
        const int grp = u >> 3;
        const int j = (u & 7) * 8 + (lane >> 3), q = grp * 8 + (lane & 7);
        const int row = row0 + j;
        const int col = q < 24 ? (q >> 3) * 512 + head * 64 + (q & 7) * 8 : 1536 + (q - 24) * 8;
        const bool hp = row > seg0, hn = row < seg1 - 1;
        lc[it7] = *(const u32x4*)(prw + (size_t)row * 1792 + col);
        lp[it7] = hp ? *(const u32x4*)(prw + (size_t)(row - 1) * 1792 + col) : u32x4{0u, 0u, 0u, 0u};
        ln[it7] = hn ? *(const u32x4*)(prw + (size_t)(row + 1) * 1792 + col) : u32x4{0u, 0u, 0u, 0u};
      }
#pragma unroll
      for (int it7 = 0; it7 < 7; ++it7) {
        const int u = warp + 4 * (ub * 7 + it7);
        const int grp = u >> 3;
        const int j = (u & 7) * 8 + (lane >> 3), q = grp * 8 + (lane & 7);
        const int row = row0 + j;
        const int col = q < 24 ? (q >> 3) * 512 + head * 64 + (q & 7) * 8 : 1536 + (q - 24) * 8;
        float cur[8], pr[8], nx[8], o[8];
        unpack8(make_uint4(lc[it7][0], lc[it7][1], lc[it7][2], lc[it7][3]), cur);
        unpack8(make_uint4(lp[it7][0], lp[it7][1], lp[it7][2], lp[it7][3]), pr);
        unpack8(make_uint4(ln[it7][0], ln[it7][1], ln[it7][2], ln[it7][3]), nx);
        {
          float4 c0 = *(const float4*)(cw + col), c1 = *(const float4*)(cw + col + 4);
          float4 d0 = *(const float4*)(cw + 1792 + col), d1 = *(const float4*)(cw + 1792 + col + 4);
          float4 e0 = *(const float4*)(cw + 3584 + col), e1 = *(const float4*)(cw + 3584 + col + 4);
          float wp[8] = {c0.x, c0.y, c0.z, c0.w, c1.x, c1.y, c1.z, c1.w};
          float wc[8] = {d0.x, d0.y, d0.z, d0.w, d1.x, d1.y, d1.z, d1.w};
          float wn_[8] = {e0.x, e0.y, e0.z, e0.w, e1.x, e1.y, e1.z, e1.w};
#pragma unroll
          for (int e = 0; e < 8; ++e) o[e] = wc[e] * cur[e] + wp[e] * pr[e] + wn_[e] * nx[e];
        }
        if (grp == 0) {
#pragma unroll
          for (int e = 0; e < 8; ++e) rs[j][(q & 7) * 8 + e] = o[e];
        } else if (grp == 1) {
#pragma unroll
          for (int e = 0; e < 8; ++e) ks[j][(q & 7) * 8 + e] = o[e];
        } else if (grp == 2) {
          *(uint4*)(SV + ((size_t)row * 8 + head) * SVH + 2 * 64 + (q & 7) * 8) = pack8(o);
        } else if (grp == 3) {
#pragma unroll
          for (int e = 0; e < 8; ++e) o[e] = 1.f - 2.f / (1.f + __expf(2.f * o[e]));
          *(uint4*)&TW[j][(q - 24) * 8] = pack8(o);
        } else if (grp == 4) {
          *(uint4*)&TA[j][(q - 32) * 8] = pack8(o);
        } else {
#pragma unroll
          for (int e = 0; e < 8; ++e) o[e] = sigm(o[e]);
          *(uint4*)&TG[j][(q - 40) * 8] = pack8(o);
        }
      }
    }
    __syncthreads();
    {
      int j = tid >> 2, part = tid & 3; float ss = 0.f;
#pragma unroll
      for (int e = 0; e < 16; ++e) { float v = ks[j][part * 16 + e] * p.in[I_RKK][head * 64 + part * 16 + e]; ss += v * v; }
      ss += __shfl_xor(ss, 1); ss += __shfl_xor(ss, 2);
      if (part == 0) rn[j] = 1.f / fmaxf(sqrtf(ss), 1e-12f);
    }
    __syncthreads();
    for (int pc = tid; pc < 64 * 8; pc += 256) {
      int j = pc >> 3, c8 = (pc & 7) * 8; int row = row0 + j;
      float fr[8], fk[8], fkk[8];
#pragma unroll
      for (int e = 0; e < 8; ++e) { fr[e] = rs[j][c8 + e]; fk[e] = ks[j][c8 + e]; fkk[e] = fk[e] * p.in[I_RKK][head * 64 + c8 + e] * rn[j]; }
      bf16_t* b = SV + ((size_t)row * 8 + head) * SVH;
      *(uint4*)(b + 0 * 64 + c8) = pack8(fr);
      *(uint4*)(b + 1 * 64 + c8) = pack8(fk);
      *(uint4*)(b + 3 * 64 + c8) = pack8(fkk);
    }
    {
      const int jl = warp * 16 + (lane & 15); const int row = row0 + jl;
      bf16x8 tw[2], ta[2], tg[4];
#pragma unroll
      for (int s2 = 0; s2 < 2; ++s2) { tw[s2] = *(const bf16x8*)&TW[jl][s2 * 32 + (lane >> 4) * 8]; ta[s2] = *(const bf16x8*)&TA[jl][s2 * 32 + (lane >> 4) * 8]; }
#pragma unroll
      for (int s2 = 0; s2 < 4; ++s2) tg[s2] = *(const bf16x8*)&TG[jl][s2 * 32 + (lane >> 4) * 8];
      __syncthreads();
      bf16_t(*OB)[64][72] = (bf16_t(*)[64][72])(smem + 2 * 64 * 65 * 4);
      float bon[2] = {0.f, 0.f};
#pragma unroll
      for (int dir = 0; dir < 2; ++dir) {
#pragma unroll
        for (int ct = 0; ct < 4; ++ct) {
          const int ch0 = ct * 16 + (lane >> 4) * 4;
          const int C0 = head * 64 + ch0;
          if (dir == 0) {
            f32x4 a = {0.f, 0.f, 0.f, 0.f};
#pragma unroll
            for (int s2 = 0; s2 < 4; ++s2) {
              bf16x8 wf = *(const bf16x8*)(GUP + (size_t)(head * 64 + ct * 16 + (lane & 15)) * 128 + s2 * 32 + (lane >> 4) * 8);
              a = __builtin_amdgcn_mfma_f32_16x16x32_bf16(wf, tg[s2], a, 0, 0, 0);
            }
            *(uint2*)&OB[2][jl][ch0] = make_uint2(pack2(a[0], a[1]), pack2(a[2], a[3]));
          }
          f32x4 aw = {0.f, 0.f, 0.f, 0.f}, aa = {0.f, 0.f, 0.f, 0.f};
#pragma unroll
          for (int s2 = 0; s2 < 2; ++s2) {
            size_t wo = (size_t)(dir * 512 + head * 64 + ct * 16 + (lane & 15)) * 64 + s2 * 32 + (lane >> 4) * 8;
            bf16x8 wf = *(const bf16x8*)(WUP + wo);
            bf16x8 af = *(const bf16x8*)(AUP + wo);
            aw = __builtin_amdgcn_mfma_f32_16x16x32_bf16(wf, tw[s2], aw, 0, 0, 0);
            aa = __builtin_amdgcn_mfma_f32_16x16x32_bf16(af, ta[s2], aa, 0, 0, 0);
          }
          const float4 w04 = *(const float4*)(p.in[I_RW0] + dir * 512 + C0), a04 = *(const float4*)(p.in[I_RA0] + dir * 512 + C0);
          const float4 ka4 = *(const float4*)(p.in[I_RKA] + C0), rk4 = *(const float4*)(p.in[I_RRK] + C0);
          const float w0v[4] = {w04.x, w04.y, w04.z, w04.w}, a0v[4] = {a04.x, a04.y, a04.z, a04.w};
          const float kav[4] = {ka4.x, ka4.y, ka4.z, ka4.w}, rkv[4] = {rk4.x, rk4.y, rk4.z, rk4.w};
          float we[4], av[4];
#pragma unroll
          for (int r = 0; r < 4; ++r) {
            we[r] = (0.60653066f * 1.44269504f) * sigm(w0v[r] + aw[r]);
            av[r] = sigm(a0v[r] + aa[r]);
            float kv = ks[jl][ch0 + r];
            float keff = kv * (1.f + (av[r] - 1.f) * kav[r]);
            bon[dir] += rs[jl][ch0 + r] * keff * rkv[r];
          }
          *(uint2*)&OB[0][jl][ch0] = make_uint2(pack2(we[0], we[1]), pack2(we[2], we[3]));
          *(uint2*)&OB[1][jl][ch0] = make_uint2(pack2(av[0], av[1]), pack2(av[2], av[3]));
        }
        __syncthreads();
        for (int pc = tid; pc < (dir == 0 ? 3 : 2) * 64 * 8; pc += 256) {
          const int vsel = pc >> 9, j = (pc >> 3) & 63, c8 = (pc & 7) * 8;
          const int vec = vsel == 2 ? 8 : (4 + 2 * dir + vsel);
          *(u32x4*)(SV + ((size_t)(row0 + j) * 8 + head) * SVH + vec * 64 + c8) = *(const u32x4*)&OB[vsel][j][c8];
        }
        __syncthreads();
      }
#pragma unroll
      for (int dir = 0; dir < 2; ++dir) {
        float sb = bon[dir]; sb += __shfl_xor(sb, 16); sb += __shfl_xor(sb, 32);
        if (lane < 16) bonus[(size_t)row * 16 + dir * 8 + head] = sb;
      }
    }
    __syncthreads();
  }
}

struct RwVec { uint4 k, kk, w, a, v, r; };
DEVI void unpack8p(const uint4& u, f32x2* f) {
  f[0] = f32x2{bflo(u.x), bfhi(u.x)}; f[1] = f32x2{bflo(u.y), bfhi(u.y)}; f[2] = f32x2{bflo(u.z), bfhi(u.z)}; f[3] = f32x2{bflo(u.w), bfhi(u.w)};
}
DEVI f32x2 bc2(float x) { return f32x2{x, x}; }
DEVI void rw_load(RwVec& x, const bf16_t* SV, int row, int head, int dir, int i, int jg, bool need_r) {
  const bf16_t* b = SV + ((size_t)row * 8 + head) * SVH;
  x.k = *(const uint4*)(b + 1 * 64 + jg * 8);
  x.kk = *(const uint4*)(b + 3 * 64 + jg * 8);
  x.w = *(const uint4*)(b + (4 + 2 * dir) * 64 + jg * 8);
  x.a = *(const uint4*)(b + (5 + 2 * dir) * 64 + jg * 8);
  x.v = *(const uint4*)(b + 2 * 64 + i * 8);
  if (need_r) x.r = *(const uint4*)(b + 0 * 64 + jg * 8);
}

DEVI void phase7(const Params& p) {
  const int lane = threadIdx.x & 63, warp = threadIdx.x >> 6, i = lane >> 3, jg = lane & 7;
  const bf16_t* SV = (const bf16_t*)(p.ws + R_SV);
  float* Pc = (float*)p.out;
  float* Bc = (float*)((unsigned char*)p.out + OUT_BC);
  for (int it = blockIdx.x * 4 + warp; it < (NCH - 1) * 16; it += gridDim.x * 4) {
    const int chunk = it >> 4, pair = it & 15, dir = pair >> 3, head = pair & 7;
    f32x2 S[8][4], P[8][4], ka[4];
#pragma unroll
    for (int a = 0; a < 8; ++a)
#pragma unroll
      for (int c = 0; c < 4; ++c) {
        S[a][c] = f32x2{0.f, 0.f};
        P[a][c] = f32x2{(i * 8 + a == jg * 8 + 2 * c) ? 1.f : 0.f, (i * 8 + a == jg * 8 + 2 * c + 1) ? 1.f : 0.f};
      }
#pragma unroll
    for (int c = 0; c < 4; ++c) ka[c] = f32x2{p.in[I_RKA][head * 64 + jg * 8 + 2 * c], p.in[I_RKA][head * 64 + jg * 8 + 2 * c + 1]};
    RwVec nx;
    rw_load(nx, SV, rw_row(chunk * LCH, dir), head, dir, i, jg, false);
#pragma unroll 1
    for (int t = 0; t < LCH; ++t) {
      RwVec cu = nx;
      if (t + 1 < LCH) rw_load(nx, SV, rw_row(chunk * LCH + t + 1, dir), head, dir, i, jg, false);
      f32x2 kv[4], kk[4], w[4], av[4], kka[4], keff[4]; float vv[8];
      unpack8p(cu.k, kv); unpack8p(cu.kk, kk); unpack8p(cu.w, w); unpack8p(cu.a, av); unpack8(cu.v, vv);
#pragma unroll
      for (int c = 0; c < 4; ++c) {
        w[c] = f32x2{__builtin_amdgcn_exp2f(-w[c][0]), __builtin_amdgcn_exp2f(-w[c][1])};
        kka[c] = -kk[c] * av[c];
        keff[c] = kv[c] * (bc2(1.f) + (av[c] - bc2(1.f)) * ka[c]);
      }
#pragma unroll
      for (int a = 0; a < 8; ++a) {
        f32x2 sa = S[a][0] * kk[0], qa = P[a][0] * kk[0];
#pragma unroll
        for (int c = 1; c < 4; ++c) { sa += S[a][c] * kk[c]; qa += P[a][c] * kk[c]; }
        float s1 = allred8(sa[0] + sa[1]), q1 = allred8(qa[0] + qa[1]);
        const f32x2 s2 = bc2(s1), q2 = bc2(q1), v2 = bc2(vv[a]);
#pragma unroll
        for (int c = 0; c < 4; ++c) {
          S[a][c] = S[a][c] * w[c] + s2 * kka[c] + v2 * keff[c];
          P[a][c] = P[a][c] * w[c] + q2 * kka[c];
        }
      }
    }
    float* po = Pc + ((size_t)chunk * 16 + pair) * 4096;
    float* bo = Bc + ((size_t)chunk * 16 + pair) * 4096;
#pragma unroll
    for (int a = 0; a < 8; ++a) {
      *(float4*)(po + (i * 8 + a) * 64 + jg * 8) = make_float4(P[a][0][0], P[a][0][1], P[a][1][0], P[a][1][1]);
      *(float4*)(po + (i * 8 + a) * 64 + jg * 8 + 4) = make_float4(P[a][2][0], P[a][2][1], P[a][3][0], P[a][3][1]);
      *(float4*)(bo + (i * 8 + a) * 64 + jg * 8) = make_float4(S[a][0][0], S[a][0][1], S[a][1][0], S[a][1][1]);
      *(float4*)(bo + (i * 8 + a) * 64 + jg * 8 + 4) = make_float4(S[a][2][0], S[a][2][1], S[a][3][0], S[a][3][1]);
    }
  }
}

template <bool DRY> DEVI void phase8(const Params& p, unsigned char* smem) {
  const bool wr = !DRY || (p.in[I_FG][0] == 1234.5f);
  float(*Sb)[16][68] = (float(*)[16][68])smem;
  const int tid = threadIdx.x, lane = tid & 63, warp = tid >> 6, q = lane >> 4, c16 = lane & 15;
  const float* Pc = (const float*)p.out;
  float* Bc = (float*)((unsigned char*)p.out + OUT_BC);
  constexpr int NS = NCH - 1;
  const size_t CS = (size_t)16 * 4096;
  for (int it = blockIdx.x; it < 64; it += gridDim.x) {
    const int pair = it >> 2, rg = it & 3;
    const float* Pp = Pc + (size_t)pair * 4096 + q * 64 + warp * 16 + c16;
    float* Bp = Bc + (size_t)pair * 4096 + (size_t)(rg * 16 + q * 4) * 64 + warp * 16 + c16;
    __syncthreads();
    {
      const int row = tid >> 4, c4 = (tid & 15) * 4;
      float4 v = *(const float4*)(Bc + (size_t)pair * 4096 + (size_t)(rg * 16 + row) * 64 + c4);
      Sb[0][row][c4] = v.x; Sb[0][row][c4 + 1] = v.y; Sb[0][row][c4 + 2] = v.z; Sb[0][row][c4 + 3] = v.w;
    }
    float pa[16], pb[16]; f32x4 ba, bb;
#pragma unroll
    for (int s2 = 0; s2 < 16; ++s2) { pa[s2] = Pp[CS + s2 * 256]; pb[s2] = Pp[2 * CS + s2 * 256]; }
#pragma unroll
    for (int r = 0; r < 4; ++r) { ba[r] = Bp[CS + r * 64]; bb[r] = Bp[2 * CS + r * 64]; }
    __syncthreads();
#define P8_STEP(c, pp, bv)                                                                                  \
    {                                                                                                        \
      const int rb = ((c) - 1) & 1;                                                                          \
      f32x4 acc0 = bv, acc1 = f32x4{0.f, 0.f, 0.f, 0.f};                                                     \
      _Pragma("unroll") for (int s2 = 0; s2 < 16; s2 += 2) {                                                 \
        acc0 = __builtin_amdgcn_mfma_f32_16x16x4f32(Sb[rb][c16][4 * s2 + q], pp[s2], acc0, 0, 0, 0);         \
        acc1 = __builtin_amdgcn_mfma_f32_16x16x4f32(Sb[rb][c16][4 * s2 + 4 + q], pp[s2 + 1], acc1, 0, 0, 0); \
      }                                                                                                      \
      acc0 += acc1;                                                                                          \
      if ((c) + 2 < NS) {                                                                                    \
        _Pragma("unroll") for (int s2 = 0; s2 < 16; ++s2) pp[s2] = Pp[(size_t)((c) + 2) * CS + s2 * 256];    \
        _Pragma("unroll") for (int r = 0; r < 4; ++r) bv[r] = Bp[(size_t)((c) + 2) * CS + r * 64];           \
      }                                                                                                      \
      _Pragma("unroll") for (int r = 0; r < 4; ++r) {                                                        \
        Sb[rb ^ 1][q * 4 + r][warp * 16 + c16] = acc0[r];                                                    \
        if (wr) Bp[(size_t)(c) * CS + r * 64] = acc0[r];                                                     \
      }                                                                                                      \
      __syncthreads();                                                                                       \
    }
    for (int c = 1; c < NS; c += 2) {
      P8_STEP(c, pa, ba)
      if (c + 1 < NS) P8_STEP(c + 1, pb, bb)
    }
#undef P8_STEP
  }
}

DEVI void phase9(const Params& p) {
  const int lane = threadIdx.x & 63, warp = threadIdx.x >> 6, i = lane >> 3, jg = lane & 7;
  const bf16_t* SV = (const bf16_t*)(p.ws + R_SV);
  const float* Bc = (const float*)((unsigned char*)p.out + OUT_BC);
  bf16_t* odir = (bf16_t*)p.out;
  for (int it = blockIdx.x * 4 + warp; it < NCH * 16; it += gridDim.x * 4) {
    const int chunk = it >> 4, pair = it & 15, dir = pair >> 3, head = pair & 7;
    f32x2 S[8][4], ka[4];
    if (chunk == 0) {
#pragma unroll
      for (int a = 0; a < 8; ++a)
#pragma unroll
        for (int c = 0; c < 4; ++c) S[a][c] = f32x2{0.f, 0.f};
    } else {
      const float* bs = Bc + ((size_t)(chunk - 1) * 16 + pair) * 4096;
#pragma unroll
      for (int a = 0; a < 8; ++a) {
        float4 x0 = *(const float4*)(bs + (i * 8 + a) * 64 + jg * 8), x1 = *(const float4*)(bs + (i * 8 + a) * 64 + jg * 8 + 4);
        S[a][0] = f32x2{x0.x, x0.y}; S[a][1] = f32x2{x0.z, x0.w}; S[a][2] = f32x2{x1.x, x1.y}; S[a][3] = f32x2{x1.z, x1.w};
      }
    }
#pragma unroll
    for (int c = 0; c < 4; ++c) ka[c] = f32x2{p.in[I_RKA][head * 64 + jg * 8 + 2 * c], p.in[I_RKA][head * 64 + jg * 8 + 2 * c + 1]};
    RwVec nx;
    rw_load(nx, SV, rw_row(chunk * LCH, dir), head, dir, i, jg, true);
#pragma unroll 2
    for (int t = 0; t < LCH; ++t) {
      RwVec cu = nx;
      const int row = rw_row(chunk * LCH + t, dir);
      if (t + 1 < LCH) rw_load(nx, SV, rw_row(chunk * LCH + t + 1, dir), head, dir, i, jg, true);
      f32x2 kv[4], kk[4], w[4], av[4], rr[4], kka[4], keff[4]; float vv[8];
      unpack8p(cu.k, kv); unpack8p(cu.kk, kk); unpack8p(cu.w, w); unpack8p(cu.a, av); unpack8p(cu.r, rr); unpack8(cu.v, vv);
#pragma unroll
      for (int c = 0; c < 4; ++c) {
        w[c] = f32x2{__builtin_amdgcn_exp2f(-w[c][0]), __builtin_amdgcn_exp2f(-w[c][1])};
        kka[c] = -kk[c] * av[c];
        keff[c] = kv[c] * (bc2(1.f) + (av[c] - bc2(1.f)) * ka[c]);
      }
      float ov = 0.f;
#pragma unroll
      for (int a = 0; a < 8; ++a) {
        f32x2 sa = S[a][0] * kk[0];
#pragma unroll
        for (int c = 1; c < 4; ++c) sa += S[a][c] * kk[c];
        const float s1 = allred8(sa[0] + sa[1]);
        const f32x2 s2 = bc2(s1), v2 = bc2(vv[a]);
        f32x2 oa = f32x2{0.f, 0.f};
#pragma unroll
        for (int c = 0; c < 4; ++c) {
          S[a][c] = S[a][c] * w[c] + s2 * kka[c] + v2 * keff[c];
          oa += S[a][c] * rr[c];
        }
        const float o = allred8(oa[0] + oa[1]);
        if (jg == a) ov = o;
      }
      if (row >= T_CTX) odir[((size_t)dir * T_LAT + (row - T_CTX)) * 512 + head * 64 + i * 8 + jg] = f2bf(ov);
    }
  }
}

DEVI void phase10(const Params& p) {
  const int lane = threadIdx.x & 63, warp = threadIdx.x >> 6;
  const bf16_t* odir = (const bf16_t*)p.out;
  const bf16_t* SV = (const bf16_t*)(p.ws + R_SV);
  const float* bonus = (const float*)(p.ws + O_BONUS);
  bf16_t* ya = (bf16_t*)(p.ws + O_PO);
  const int head = lane >> 3, c8 = (lane & 7) * 8, C0 = lane * 8;
#pragma unroll 2
  for (int t = blockIdx.x * 4 + warp; t < T_LAT; t += gridDim.x * 4) {
    const int row = t + T_CTX;
    const bf16_t* b = SV + ((size_t)row * 8 + head) * SVH;
    float v[8], g[8], y[8];
    unpack8(*(const uint4*)(b + 2 * 64 + c8), v);
    unpack8(*(const uint4*)(b + 8 * 64 + c8), g);
    float bs = bonus[(size_t)row * 16 + head] + bonus[(size_t)row * 16 + 8 + head];
#pragma unroll
    for (int e = 0; e < 8; ++e) y[e] = bs * v[e];
#pragma unroll
    for (int dir = 0; dir < 2; ++dir) {
      float o[8];
      unpack8(*(const uint4*)(odir + ((size_t)dir * T_LAT + t) * 512 + C0), o);
      float s = 0.f;
#pragma unroll
      for (int e = 0; e < 8; ++e) s += o[e];
      s = allred8(s);
      float mu = s * (1.f / 64.f);
      float q = 0.f;
#pragma unroll
      for (int e = 0; e < 8; ++e) { o[e] -= mu; q += o[e] * o[e]; }
      q = allred8(q);
      float rsd = rsqrtf(q * (1.f / 64.f) + 64e-5f);
#pragma unroll
      for (int e = 0; e < 8; ++e) y[e] += o[e] * rsd * p.in[I_RLNW][C0 + e] + p.in[I_RLNB][C0 + e];
    }
#pragma unroll
    for (int e = 0; e < 8; ++e) y[e] *= g[e];
    *(uint4*)(ya + (size_t)t * 512 + C0) = pack8(y);
  }
}

DEVI void phase11(const Params& p, unsigned char* smem, const XcdMap& xm) {
  const int lane = threadIdx.x & 63, warp = threadIdx.x >> 6, wm = warp >> 1, wn = warp & 1;
  const bf16_t* ya = (const bf16_t*)(p.ws + O_PO);
  const bf16_t* yb = (const bf16_t*)(p.ws + R_YA);
  const bf16_t* pg = (const bf16_t*)(p.ws + O_PG);
  bf16_t* mg = (bf16_t*)(p.ws + R_MERGED);
  for_tiles_xcd(xm, 128, 8, 8, 8, [&](int mt, int nt) {
    f32x4 acc[4][4];
    zero_acc(acc);
    gemm_core(ya + (size_t)mt * 128 * 512, 512, (const bf16_t*)(p.ws + O_WBA) + (size_t)nt * 128 * 512, 512, 512, acc, smem);
#pragma unroll
    for (int i = 0; i < 4; ++i) {
      int row = mt * 128 + wm * 64 + i * 16 + (lane & 15);
#pragma unroll
      for (int j = 0; j < 4; ++j) {
        int n = nt * 128 + wn * 64 + j * 16 + (lane >> 4) * 4;
        uint2 s = *(const uint2*)(pg + (size_t)row * 2048 + n);
        *(uint2*)(mg + (size_t)row * 1024 + n) = make_uint2(pack2(acc[i][j][0] * bflo(s.x), acc[i][j][1] * bfhi(s.x)), pack2(acc[i][j][2] * bflo(s.y), acc[i][j][3] * bfhi(s.y)));
      }
    }
    zero_acc(acc);
    gemm_core(yb + (size_t)mt * 128 * 512, 512, (const bf16_t*)(p.ws + O_WBB) + (size_t)nt * 128 * 512, 512, 512, acc, smem);
#pragma unroll
    for (int i = 0; i < 4; ++i) {
      int row = mt * 128 + wm * 64 + i * 16 + (lane & 15);
#pragma unroll
      for (int j = 0; j < 4; ++j) {
        int n = nt * 128 + wn * 64 + j * 16 + (lane >> 4) * 4;
        uint2 s = *(const uint2*)(pg + (size_t)row * 2048 + 1024 + n);
        uint2 m0 = *(const uint2*)(mg + (size_t)row * 1024 + n);
        float v0 = bflo(m0.x) + acc[i][j][0] * bflo(s.x), v1 = bfhi(m0.x) + acc[i][j][1] * bfhi(s.x);
        float v2 = bflo(m0.y) + acc[i][j][2] * bflo(s.y), v3 = bfhi(m0.y) + acc[i][j][3] * bfhi(s.y);
        *(uint2*)(mg + (size_t)row * 1024 + n) = make_uint2(pack2(v0, v1), pack2(v2, v3));
      }
    }
  });
}

DEVI void phase12(const Params& p, unsigned char* smem, const XcdMap& xm) {
  float* gt = (float*)(smem + 45056);
  const int tid = threadIdx.x, lane = tid & 63, warp = tid >> 6, wm = warp >> 1, wn = warp & 1;
  for (int i = tid; i < 1024; i += 256) gt[i] = mod_val(p, 0, 2048 + i);
  __syncthreads();
  const bf16_t* mg = (const bf16_t*)(p.ws + R_MERGED);
  const float* x = p.in[I_X];
  float* x1 = p.out;
  for_tiles_xcd(xm, 128, 8, 8, 8, [&](int mt, int nt) {
    f32x4 acc[4][4];
    zero_acc(acc);
    gemm_core(mg + (size_t)mt * 128 * 1024, 1024, (const bf16_t*)(p.ws + O_WOUT) + (size_t)nt * 128 * 1024, 1024, 1024, acc, smem);
#pragma unroll
    for (int i = 0; i < 4; ++i) {
      int row = mt * 128 + wm * 64 + i * 16 + (lane & 15);
#pragma unroll
      for (int j = 0; j < 4; ++j) {
        int n = nt * 128 + wn * 64 + j * 16 + (lane >> 4) * 4;
        float4 xv = *(const float4*)(x + (size_t)row * 1024 + n);
        xv.x += gt[n] * acc[i][j][0]; xv.y += gt[n + 1] * acc[i][j][1]; xv.z += gt[n + 2] * acc[i][j][2]; xv.w += gt[n + 3] * acc[i][j][3];
        *(float4*)(x1 + (size_t)row * 1024 + n) = xv;
      }
    }
  });
}

DEVI void phase13(const Params& p, unsigned char* smem) {
  float* smod = (float*)smem;
  const int tid = threadIdx.x, lane = tid & 63, warp = tid >> 6;
  for (int i = tid; i < 2048; i += 256) smod[i] = mod_val(p, 0, 3072 + i);
  __syncthreads();
  const float* x1 = p.out;
  bf16_t* h2 = (bf16_t*)(p.ws + R_H2);
  for (int rp = blockIdx.x * 4 + warp; rp < T_LAT / 2; rp += gridDim.x * 4) {
    float h[2][16]; float ss[2] = {0.f, 0.f};
#pragma unroll
    for (int u = 0; u < 2; ++u)
#pragma unroll
      for (int i = 0; i < 4; ++i) {
        float4 v = *(const float4*)(x1 + (size_t)(rp * 2 + u) * 1024 + i * 256 + lane * 4);
        h[u][4 * i] = v.x; h[u][4 * i + 1] = v.y; h[u][4 * i + 2] = v.z; h[u][4 * i + 3] = v.w;
        ss[u] += v.x * v.x + v.y * v.y + v.z * v.z + v.w * v.w;
      }
#pragma unroll
    for (int u = 0; u < 2; ++u) {
      const int row = rp * 2 + u;
      const float rstd = rsqrtf(wave_sum_u(ss[u]) * (1.f / 1024.f) + 1e-6f);
#pragma unroll
      for (int i = 0; i < 4; ++i) {
        {
          const int k0 = i * 256 + lane * 4;
          const float4 gk = *(const float4*)(p.in[I_N2G] + k0);
          const f32x4 s4 = *(const f32x4*)(smod + 1024 + k0), h4 = *(const f32x4*)(smod + k0);
          h[u][4 * i] = h[u][4 * i] * rstd * gk.x * (1.f + s4[0]) + h4[0];
          h[u][4 * i + 1] = h[u][4 * i + 1] * rstd * gk.y * (1.f + s4[1]) + h4[1];
          h[u][4 * i + 2] = h[u][4 * i + 2] * rstd * gk.z * (1.f + s4[2]) + h4[2];
          h[u][4 * i + 3] = h[u][4 * i + 3] * rstd * gk.w * (1.f + s4[3]) + h4[3];
        }
        *(uint2*)(h2 + (size_t)row * 1024 + i * 256 + lane * 4) = make_uint2(pack2(h[u][4 * i], h[u][4 * i + 1]), pack2(h[u][4 * i + 2], h[u][4 * i + 3]));
      }
    }
  }
}

DEVI void phase14(const Params& p, unsigned char* smem, const XcdMap& xm) {
  bf16_t(*Qt)[136] = (bf16_t(*)[136])smem;
  float* Sc = (float*)smem;
  const int tid = threadIdx.x, lane = tid & 63, warp = tid >> 6, wm = warp >> 1, wn = warp & 1;
  const bf16_t* h2 = (const bf16_t*)(p.ws + R_H2);
  const bf16_t* keys = (const bf16_t*)(p.ws + O_KEYS);
  float* tops = (float*)(p.ws + R_TOPS);
  int* topi = (int*)(p.ws + R_TOPI);
  for_tiles_xcd(xm, 128, 16, 8, 8, [&](int mt, int hp) {
    f32x4 acc[4][4];
    zero_acc(acc);
    gemm_core(h2 + (size_t)mt * 128 * 1024, 1024, (const bf16_t*)(p.ws + O_WQ) + (size_t)hp * 128 * 1024, 1024, 1024, acc, smem);
#pragma unroll
    for (int i = 0; i < 4; ++i)
#pragma unroll
      for (int j = 0; j < 4; ++j)
        *(uint2*)&Qt[wm * 64 + i * 16 + (lane & 15)][wn * 64 + j * 16 + (lane >> 4) * 4] =
            make_uint2(pack2(acc[i][j][0], acc[i][j][1]), pack2(acc[i][j][2], acc[i][j][3]));
    __syncthreads();
    zero_acc(acc);
#pragma unroll
    for (int ks = 0; ks < 4; ++ks) {
      bf16x8 qf[4], kf[4];
#pragma unroll
      for (int i = 0; i < 4; ++i) qf[i] = *(const bf16x8*)&Qt[wm * 64 + i * 16 + (lane & 15)][ks * 32 + (lane >> 4) * 8];
#pragma unroll
      for (int j = 0; j < 4; ++j) kf[j] = *(const bf16x8*)(keys + ((size_t)hp * 128 + wn * 64 + j * 16 + (lane & 15)) * 128 + ks * 32 + (lane >> 4) * 8);
#pragma unroll
      for (int i = 0; i < 4; ++i)
#pragma unroll
        for (int j = 0; j < 4; ++j) acc[i][j] = __builtin_amdgcn_mfma_f32_16x16x32_bf16(kf[j], qf[i], acc[i][j], 0, 0, 0);
    }
    __syncthreads();
#pragma unroll
    for (int i = 0; i < 4; ++i)
#pragma unroll
      for (int j = 0; j < 4; ++j) {
        {
          const int c0 = j * 16 + (lane >> 4) * 4;
          u32x4 kq;
#pragma unroll
          for (int r = 0; r < 4; ++r) {
            unsigned u = __float_as_uint(acc[i][j][r]);
            u = (u & 0x80000000u) ? ~u : (u | 0x80000000u);
            kq[r] = (u & ~63u) | (unsigned)(63 - (c0 + r));
          }
          *(u32x4*)(Sc + (wm * 64 + i * 16 + (lane & 15)) * 132 + wn * 64 + c0) = kq;
        }
      }
    __syncthreads();
    {
      const int row = tid & 127, half = tid >> 7;
      float* hp_ = Sc + row * 132 + half * 64;
      float bv[16]; int bi[16];
      unsigned* hk = (unsigned*)hp_;
#pragma unroll
      for (int r = 0; r < 16; ++r) {
        unsigned best = 0u;
#pragma unroll 16
        for (int k = 0; k < 64; k += 4) {
          const u32x4 v4 = *(const u32x4*)(hk + k);
          const unsigned m01 = v4[0] > v4[1] ? v4[0] : v4[1], m23 = v4[2] > v4[3] ? v4[2] : v4[3];
          const unsigned m = m01 > m23 ? m01 : m23;
          best = best > m ? best : m;
        }
        const int b2 = 63 - (int)(best & 63u);
        unsigned u = best & ~63u;
        u = (u & 0x80000000u) ? (u & 0x7fffffffu) : ~u;
        bv[r] = __uint_as_float(u); bi[r] = b2 + half * 64; hk[b2] = 0u;
      }
#pragma unroll
      for (int r = 0; r < 16; ++r) { hp_[r] = bv[r]; hp_[16 + r] = __int_as_float(bi[r]); }
    }
    __syncthreads();
    if (tid < 128) {
      const float* la = Sc + tid * 132; const float* lb = la + 64;
      size_t ob = ((size_t)(mt * 128 + tid) * 16 + hp) * 16;
      int ia = 0, ib = 0;
      for (int r = 0; r < 16; ++r) {
        float va = la[ia], vb = lb[ib];
        bool ta = va >= vb;
        tops[ob + r] = ta ? va : vb;
        topi[ob + r] = __float_as_int(ta ? la[16 + ia] : lb[16 + ib]);
        ia += ta ? 1 : 0; ib += ta ? 0 : 1;
      }
    }
    __syncthreads();
  });
}

template <bool DRY> DEVI void phase15(const Params& p, unsigned char* smem) {
  const bool wr = !DRY || (p.in[I_FG][0] == 1234.5f);
  float* gt = (float*)smem;
  const int tid = threadIdx.x, lane = tid & 63, warp = tid >> 6;
  for (int i = tid; i < 1024; i += 256) gt[i] = mod_val(p, 0, 5120 + i);
  __syncthreads();
  const bf16_t* __restrict__ h2 = (const bf16_t*)(p.ws + R_H2);
  const float* __restrict__ tops = (const float*)(p.ws + R_TOPS);
  const int* __restrict__ topi = (const int*)(p.ws + R_TOPI);
  const unsigned char* __restrict__ uf8 = p.ws + R_UBF;
  const unsigned char* __restrict__ vf8 = p.ws + R_VBF;
  float* xo = p.out;
  int ca, cb;
  {
    int l = lane;
    if (l < 16) { ca = 0; cb = l; } else if (l < 24) { ca = 1; cb = l - 16; } else if (l < 29) { ca = 2; cb = l - 24; }
    else if (l < 33) { ca = 3; cb = l - 29; } else if (l < 36) { ca = 4; cb = l - 33; } else if (l < 38) { ca = 5; cb = l - 36; }
    else if (l < 40) { ca = 6; cb = l - 38; } else if (l < 42) { ca = 7; cb = l - 40; } else if (l < 50) { ca = l - 34; cb = 0; }
    else { ca = 0; cb = 0; }
  }
  const int flat = ca * 16 + cb;
  for (int t = blockIdx.x * 4 + warp; t < T_LAT; t += gridDim.x * 4) {
    float hv[16], out[16];
    {
      const u32x4 hp0 = *(const u32x4*)(h2 + (size_t)t * 1024 + lane * 16);
      const u32x4 hp1 = *(const u32x4*)(h2 + (size_t)t * 1024 + lane * 16 + 8);
#pragma unroll
      for (int e = 0; e < 4; ++e) { hv[2 * e] = bflo(hp0[e]); hv[2 * e + 1] = bfhi(hp0[e]); hv[8 + 2 * e] = bflo(hp1[e]); hv[8 + 2 * e + 1] = bfhi(hp1[e]); }
    }
#pragma unroll
    for (int e = 0; e < 16; ++e) out[e] = 0.f;
#pragma unroll 2
    for (int hd = 0; hd < 8; ++hd) {
      const size_t b1 = ((size_t)t * 16 + hd * 2) * 16, b2 = b1 + 16;
      float val = lane < 50 ? tops[b1 + ca] + tops[b2 + cb] : -INFINITY;
      int idx = topi[b1 + ca] * 128 + topi[b2 + cb];
      unsigned key = __float_as_uint(val);
      key = (key & 0x80000000u) ? ~key : (key | 0x80000000u);
      key = lane < 50 ? ((key & ~63u) | (unsigned)(63 - lane)) : 0u;
      int cnt = 0;
#pragma unroll
      for (int i = 0; i < 50; ++i) cnt += ((unsigned)__builtin_amdgcn_readlane((int)key, i) > key) ? 1 : 0;
      bool sel = lane < 50 && cnt < 16;
      float vmax = rlf(val, 0);
      float ex = sel ? __expf(val - vmax) : 0.f;
      float gsum = wave_sum_u(ex);
      float g = ex / gsum;
      unsigned long long m1 = __ballot(sel);
      int es[16];
      float gq = 0.f;
#pragma unroll
      for (int q = 0; q < 16; ++q) {
        int src = __ffsll((long long)m1) - 1; m1 &= m1 - 1;
        es[q] = __builtin_amdgcn_readlane(idx, src);
        float gg = rlf(g, src);
        if (lane == q) gq = gg;
      }
      float dm = 0.f;
      {
        u32x4 ub[16];
#pragma unroll
        for (int q = 0; q < 16; ++q) ub[q] = *(const u32x4*)(uf8 + (size_t)es[q] * 1024 + lane * 16);
#pragma unroll
        for (int q = 0; q < 16; ++q) {
          float f[16]; unpack_fp8x16(ub[q], f);
          float d0 = 0.f, d1 = 0.f;
#pragma unroll
          for (int e = 0; e < 8; ++e) { d0 += f[2 * e] * hv[2 * e]; d1 += f[2 * e + 1] * hv[2 * e + 1]; }
          float d = d0 + d1;
          d += dppf<0xB1>(d); d += dppf<0x4E>(d); d += dppf<0x141>(d); d += dppf<0x140>(d);
          if ((lane & 15) == q) dm = d;
        }
      }
      dm += __shfl_xor(dm, 16); dm += __shfl_xor(dm, 32);
      dm *= (1.f / 64.f);
      float coef = gq * 0.5f * dm * (1.f + erff(dm * 0.70710678118f)) * 0.25f;
      {
        u32x4 vb[16];
#pragma unroll
        for (int q = 0; q < 16; ++q) vb[q] = *(const u32x4*)(vf8 + (size_t)es[q] * 1024 + lane * 16);
#pragma unroll
        for (int q = 0; q < 16; ++q) {
          float cf = rlf(coef, q);
          float f[16]; unpack_fp8x16(vb[q], f);
#pragma unroll
          for (int e = 0; e < 16; ++e) out[e] += cf * f[e];
        }
      }
    }
    float xs[16]; float ss = 0.f;
#pragma unroll
    for (int i = 0; i < 4; ++i) {
      int k = lane * 16 + i * 4;
      float4 v = *(const float4*)(xo + (size_t)t * 1024 + k);
      xs[4 * i] = v.x + gt[k] * out[4 * i]; xs[4 * i + 1] = v.y + gt[k + 1] * out[4 * i + 1];
      xs[4 * i + 2] = v.z + gt[k + 2] * out[4 * i + 2]; xs[4 * i + 3] = v.w + gt[k + 3] * out[4 * i + 3];
      ss += xs[4 * i] * xs[4 * i] + xs[4 * i + 1] * xs[4 * i + 1] + xs[4 * i + 2] * xs[4 * i + 2] + xs[4 * i + 3] * xs[4 * i + 3];
    }
    ss = wave_sum_u(ss);
    float rstd = rsqrtf(ss * (1.f / 1024.f) + 1e-6f);
#pragma unroll
    for (int i = 0; i < 4; ++i) {
      int k = lane * 16 + i * 4;
      float4 g4 = *(const float4*)(p.in[I_FG] + k);
      if (wr) *(float4*)(xo + (size_t)t * 1024 + k) = make_float4(xs[4 * i] * rstd * g4.x, xs[4 * i + 1] * rstd * g4.y, xs[4 * i + 2] * rstd * g4.z, xs[4 * i + 3] * rstd * g4.w);
    }
  }
}

#define XB_TMO      128
#define XB_XCNT(j)  (256  + 64 * (j))
#define XB_XSUB(j)  (1280 + 64 * (j))
#define XB_XGEN(j)  (2304 + 64 * (j))
#define XB_TOP      3328
#define XB_TOPGEN   3392
#define XCD_BAR_WORDS 3456
#define XB_SPIN_CAP (1u << 22)
#define LAS __attribute__((address_space(3)))
DEVI unsigned xb_ld(unsigned* p) { return __hip_atomic_load(p, __ATOMIC_RELAXED, __HIP_MEMORY_SCOPE_AGENT); }
DEVI unsigned xb_add(unsigned* p, unsigned v) { return __hip_atomic_fetch_add(p, v, __ATOMIC_RELAXED, __HIP_MEMORY_SCOPE_AGENT); }
DEVI unsigned xb_xcc_id() { return (unsigned)__builtin_amdgcn_s_getreg((3 << 11) | 20) & 0xFu; }
#define XB_SPIN(cond, bar) do { unsigned _sp = 0; while (cond) { __builtin_amdgcn_s_sleep(1); \
    if ((++_sp & 255u) == 0u) { if (xb_ld(&(bar)[XB_TMO])) break; if (_sp > XB_SPIN_CAP) { atomicAdd(&(bar)[XB_TMO], 1u); break; } } } } while (0)
struct XcdBarrier { unsigned* bar; unsigned x; volatile LAS unsigned* st; };
DEVI XcdBarrier xcd_barrier_post(unsigned* bar, volatile LAS unsigned* st) {
  XcdBarrier b; b.bar = bar; b.x = xb_xcc_id(); b.st = st;
  if (threadIdx.x == 0) st[2] = xb_add(&bar[XB_XCNT(b.x)], 1u);
  return b;
}
DEVI void xcd_barrier_complete(unsigned* bar, unsigned x, unsigned& nloc, unsigned& nx, unsigned& vidx) {
  const unsigned G = gridDim.x * gridDim.y * gridDim.z;
  unsigned sum, cnt, mine, below, sp = 0u;
  for (;;) {
    sum = 0u; cnt = 0u; mine = 0u; below = 0u;
#pragma unroll
    for (unsigned j = 0; j < 16; ++j) { const unsigned c = xb_ld(&bar[XB_XCNT(j)]); sum += c; cnt += (c > 0u) ? 1u : 0u; mine = (j == x) ? c : mine; below += (c > 0u && j < x) ? 1u : 0u; }
    if (sum == G) break;
    __builtin_amdgcn_s_sleep(1);
    if ((++sp & 255u) == 0u) { if (xb_ld(&bar[XB_TMO])) break; if (sp > XB_SPIN_CAP) { atomicAdd(&bar[XB_TMO], 1u); break; } }
  }
  nloc = mine > 0u ? mine : 1u; nx = cnt > 0u ? cnt : 1u; vidx = below;
}
DEVI void xcd_barrier(const XcdBarrier& b) {
  asm volatile("s_waitcnt vmcnt(0)" ::: "memory");
  __syncthreads();
  if (threadIdx.x == 0) {
    unsigned* bar = b.bar;
    __builtin_amdgcn_s_waitcnt(0);
    unsigned nloc = b.st[0], nx = b.st[1];
    if (nloc == 0u) { unsigned vidx; xcd_barrier_complete(bar, b.x, nloc, nx, vidx); b.st[0] = nloc; b.st[1] = nx; b.st[3] = vidx; }
    const unsigned old = xb_add(&bar[XB_XSUB(b.x)], 1u);
    const unsigned gen = old / nloc;
    if (old + 1u == (gen + 1u) * nloc) {
      __builtin_amdgcn_fence(__ATOMIC_RELEASE, "agent");
      asm volatile("s_waitcnt vmcnt(0)" ::: "memory");
      const unsigned og = xb_add(&bar[XB_TOP], 1u);
      const unsigned tg = og / nx;
      if (og + 1u == (tg + 1u) * nx) xb_add(&bar[XB_TOPGEN], 1u);
      else XB_SPIN(xb_ld(&bar[XB_TOPGEN]) == tg, bar);
      __builtin_amdgcn_fence(__ATOMIC_ACQUIRE, "agent");
      xb_add(&bar[XB_XGEN(b.x)], 1u);
      asm volatile("s_waitcnt vmcnt(0)" ::: "memory");
    } else {
      XB_SPIN(xb_ld(&bar[XB_XGEN(b.x)]) == gen, bar);
      __builtin_amdgcn_fence(__ATOMIC_ACQUIRE, "agent");
      asm volatile("s_waitcnt vmcnt(0)" ::: "memory");
    }
  }
  __syncthreads();
}

constexpr int NPHASE = 16;
DEVI XcdMap get_xm(int coop, const uint4& w) {
  XcdMap m;
  if (coop) { m.v = (int)w.w; m.nx = (int)w.y; m.slot = (int)w.z; m.slots = (int)w.x; }
  else { m.v = blockIdx.x & 7; m.nx = 8; m.slot = blockIdx.x >> 3; m.slots = gridDim.x >> 3; if (m.slots < 1) { m.slots = 1; } }
  return m;
}
__global__ void __launch_bounds__(256, 2) mk(Params p, int ph0, int ph1, int coop) {
  __shared__ __attribute__((aligned(16))) unsigned char smem[SMEM_BYTES];
  __shared__ uint4 xb_words;
  if (threadIdx.x == 0) xb_words = make_uint4(0u, 0u, 0u, 0u);
  __syncthreads();
  XcdBarrier xb;
  if (coop) xb = xcd_barrier_post((unsigned*)(p.ws + O_BAR), (volatile LAS unsigned*)&xb_words);
#ifdef XCC_PROBE
  if (coop && xb_xcc_id() != (blockIdx.x & 7u)) { unsigned long long t0 = wall_clock64(); while (wall_clock64() - t0 < 100000ull) __builtin_amdgcn_s_sleep(8); }
#endif
  if (ph0 < 0) cg::this_grid().sync();
#ifdef PROBE_A
#define STAMP(n) if (blockIdx.x == 0 && threadIdx.x == 0) ((unsigned long long*)(p.ws + O_STAMP))[n] = wall_clock64();
#else
#define STAMP(n)
#endif
#define RUN_PHASE(n, call)                                   \
  if (ph0 <= n && n < ph1) {                                 \
    STAMP(n)                                                 \
        if (DRY_PH == n) { if (n == 4) phase4<true>(p, smem); if (n == 5) phase5<true>(p, smem); if (n == 8) phase8<true>(p, smem); if (n == 15) phase15<true>(p, smem); } \
    if (ONLY < 0 || ONLY == n) { call; }                     \
    if (REPEAT_PH == n) { call; }                            \
    if (coop && n + 1 < ph1) xcd_barrier(xb);                \
  }
  RUN_PHASE(0, phase0(p, smem, 0, 96))
  RUN_PHASE(1, (phase1(p, smem), __syncthreads(), phase0(p, smem, 96, 1 << 30)))
  RUN_PHASE(2, phase2(p, smem, get_xm(coop, xb_words)))
  RUN_PHASE(3, phase3(p, smem))
  RUN_PHASE(4, (phase4<false>(p, smem), phase6(p, smem, 0, 32, gridDim.x > 290 ? 258 : 0, gridDim.x > 290 ? (int)gridDim.x - 258 : (int)gridDim.x)))
  RUN_PHASE(5, phase5<false>(p, smem))
  RUN_PHASE(6, phase6(p, smem, 32, 260 * 8, 0, (int)gridDim.x))
  RUN_PHASE(7, phase7(p))
  RUN_PHASE(8, phase8<false>(p, smem))
  RUN_PHASE(9, phase9(p))
  RUN_PHASE(10, phase10(p))
  RUN_PHASE(11, phase11(p, smem, get_xm(coop, xb_words)))
  RUN_PHASE(12, (phase12(p, smem, get_xm(coop, xb_words)), convert_fp8(p.in[I_PU], p.ws + R_UBF, (size_t)16384 * 64, 64.f)))
  RUN_PHASE(13, phase13(p, smem))
  RUN_PHASE(14, (phase14(p, smem, get_xm(coop, xb_words)), convert_fp8(p.in[I_PV], p.ws + R_VBF, (size_t)16384 * 64, 4.f)))
  RUN_PHASE(15, phase15<false>(p, smem))
#ifdef SYNC_EXTRA
  for (int i = 0; i < SYNC_EXTRA; ++i) xcd_barrier(xb);
#endif
#ifdef PROBE_A
  cg::this_grid().sync();
  STAMP(16)
  __syncthreads();
  if (blockIdx.x == 0) {
    const unsigned long long* st = (const unsigned long long*)(p.ws + O_STAMP);
    float ta = (float)(st[PROBE_A + 1] - st[PROBE_A]) * 0.01f, tb = (float)(st[PROBE_B + 1] - st[PROBE_B]) * 0.01f;
    for (int i = threadIdx.x; i < 1000000; i += 256) p.out[1 + i] = tb;
    if (threadIdx.x == 0) p.out[0] = 100.f * ta;
  }
#endif
}

extern "C" void kernel_launch(void* const* d_in, const int* in_sizes, int n_in, void* d_out, int out_size, void* d_ws,
                              size_t ws_size, hipStream_t stream) {
  static int grid_blocks = 0;
  if (!grid_blocks) {
    int dev = 0, cus = 0, per_cu = 0;
    hipGetDevice(&dev);
    hipDeviceGetAttribute(&cus, hipDeviceAttributeMultiprocessorCount, dev);
    hipOccupancyMaxActiveBlocksPerMultiprocessor(&per_cu, mk, 256, 0);
    if (per_cu < 1) per_cu = 1;
    if (per_cu > 2) per_cu = 2;
    grid_blocks = cus * per_cu;
  }
  if (ws_size < WS_NEED) { fprintf(stderr, "workspace too small: %zu < %zu\n", ws_size, (size_t)WS_NEED); return; }
  Params p{};
  for (int i = 0; i < 32; ++i) p.in[i] = (const float*)d_in[i];
  p.out = (float*)d_out;
  p.ws = (unsigned char*)d_ws;
#if MEGA
  (void)hipMemsetAsync((unsigned char*)d_ws + O_BAR, 0, XCD_BAR_WORDS * 4, stream);
  int ph0 = 0, ph1 = NPHASE, coop = 1;
  void* args[] = {&p, &ph0, &ph1, &coop};
  hipError_t e = hipLaunchCooperativeKernel((void*)mk, dim3(grid_blocks), dim3(256), args, 0, stream);
  if (e != hipSuccess) fprintf(stderr, "cooperative launch failed: %s (grid %d)\n", hipGetErrorString(e), grid_blocks);
#else
  for (int ph = 0; ph < NPHASE; ++ph) mk<<<grid_blocks, 256, 0, stream>>>(p, ph, ph + 1, 0);
#endif
}
```
